# Optimizing an MI355X kernel written in HIP

```python
import math
import functools
import jax
import jax.numpy as jnp
from jax import lax
import numpy as np

D_MODEL = 1024
BATCH = 4
SEQ = 8192
DEPTH = 4

GRID_W = 64
CTX_LEN = 256
N_MIXERS = 2
N_HYENA = (DEPTH + N_MIXERS - 1) // N_MIXERS
N_MLSTM = DEPTH // N_MIXERS
N_SUB = 3
N_MOD = 3 * N_SUB
D_FF = 2816
NORM_EPS = 1e-6
POS_BASE = 10000.0
HY_ORDER = 2
HY_SHORT = 3
HY_EMB = 33
HY_BANDS = (HY_EMB - 1) // 2
HY_FILT_HIDDEN = 64
HY_DECAY_SLOW = -math.log(1e-2) / 1.5
HY_DECAY_FAST = -math.log(1e-2) / 0.3
ML_INNER = 2 * D_MODEL
ML_HEADS = 4
ML_HEAD_DIM = ML_INNER // ML_HEADS
ML_QKV_BLOCK = 4
ML_CONV = 3
ML_CHUNK = 64
ML_NORM_EPS = 1e-5
ML_FGATE_BIAS_LO = 3.0
ML_FGATE_BIAS_HI = 6.0

kernel_name = 'hyena_mlstm_macaron_dit'


def rms_norm(x, g):
    xf = x.astype(jnp.float32)
    y = xf * lax.rsqrt(jnp.mean(xf * xf, axis=-1, keepdims=True) + NORM_EPS)
    return (y * g.astype(jnp.float32)).astype(x.dtype)


def ada_chunks(cond, w, b):
    return jnp.split(jax.nn.silu(cond) @ w + b, N_MOD, axis=-1)


def ada_pre(h, g, shift, scale):
    return rms_norm(h, g) * (1.0 + scale) + shift


def swiglu(u, w_in, w_out):
    gate, val = jnp.split(u @ w_in, 2, axis=-1)
    return (jax.nn.silu(gate) * val) @ w_out


def conv_centred(x, w, b):
    width = w.shape[0]
    pad = width // 2
    n = x.shape[1]
    xp = jnp.pad(x, ((0, 0), (pad, pad), (0, 0)))
    return sum(xp[:, i:i + n] * w[i] for i in range(width)) + b


def pos_embed_2d(n_tokens, d, dtype):
    rows = n_tokens // GRID_W
    quarter = d // 4
    omega = 1.0 / (POS_BASE ** (jnp.arange(quarter, dtype=jnp.float32) / quarter))
    ang_r = jnp.arange(rows, dtype=jnp.float32)[:, None] * omega
    ang_c = jnp.arange(GRID_W, dtype=jnp.float32)[:, None] * omega
    row_emb = jnp.concatenate([jnp.sin(ang_r), jnp.cos(ang_r)], axis=-1)
    col_emb = jnp.concatenate([jnp.sin(ang_c), jnp.cos(ang_c)], axis=-1)
    emb = jnp.concatenate([
        jnp.broadcast_to(row_emb[:, None, :], (rows, GRID_W, d // 2)),
        jnp.broadcast_to(col_emb[None, :, :], (rows, GRID_W, d // 2))], axis=-1)
    return emb.reshape(rows * GRID_W, d).astype(dtype)


def hyena_filters(n, f_w1, f_b1, f_w2, f_b2, f_w3, f_b3, f_freq, log_decay):
    f32 = jnp.float32
    d = log_decay.shape[-1]
    t = jnp.arange(n, dtype=f32)
    t_norm = t / max(n - 1, 1)
    bands = jnp.linspace(1e-4, HY_BANDS - 1, HY_BANDS, dtype=f32)
    ang = ((2.0 * math.pi / n) * t)[:, None] * bands[None, :]
    feats = jnp.concatenate([t_norm[:, None], jnp.cos(ang), -jnp.sin(ang)], axis=-1)
    h = jnp.sin(f_freq[0].astype(f32) * (feats @ f_w1.astype(f32) + f_b1.astype(f32)))
    h = jnp.sin(f_freq[1].astype(f32) * (h @ f_w2.astype(f32) + f_b2.astype(f32)))
    h = (h @ f_w3.astype(f32) + f_b3.astype(f32)).reshape(n, HY_ORDER, 2, d)
    h = h.transpose(1, 2, 0, 3)
    window = jnp.exp(-t_norm[None, None, :, None] * jnp.exp(log_decay.astype(f32))[:, :, None, :])
    h = h * window
    fwd = h[:, 0]
    bwd = h[:, 1, 1:][:, ::-1]
    k = jnp.concatenate([fwd, jnp.zeros((HY_ORDER, 1, d), f32), bwd], axis=1)
    return k * lax.rsqrt(jnp.sum(k * k, axis=1, keepdims=True) + 1e-12)


def long_conv(z, k_freq, skip):
    n = z.shape[1]
    zf = jnp.fft.rfft(z, n=2 * n, axis=1)
    y = jnp.fft.irfft(zf * k_freq[None], n=2 * n, axis=1)[:, :n]
    return y + z * skip.astype(jnp.float32)


def hyena_mixer(u, w_in, b_in, conv_w, conv_b, f_w1, f_b1, f_w2, f_b2, f_w3, f_b3,
                f_freq, log_decay, skip, w_out, b_out):
    n = u.shape[1]
    proj = conv_centred(u @ w_in + b_in, conv_w, conv_b).astype(jnp.float32)
    x1, x2, v = jnp.split(proj, 3, axis=-1)
    k = hyena_filters(n, f_w1, f_b1, f_w2, f_b2, f_w3, f_b3, f_freq, log_decay)
    k_freq = jnp.fft.rfft(k, axis=1)
    z = x1 * long_conv(v, k_freq[0], skip[0])
    z = x2 * long_conv(z, k_freq[1], skip[1])
    return z.astype(u.dtype) @ w_out + b_out


def blockdiag(x, w):
    bsz, n, ch = x.shape
    nb, bs, _ = w.shape
    return jnp.einsum('blnd,nde->blne', x.reshape(bsz, n, nb, bs), w).reshape(bsz, n, ch)


def mlstm_scan(q, k, v, i_pre, f_pre):
    bsz, n, nh, dh = q.shape
    n_chunks = n // ML_CHUNK

    def chunks(a):
        a = a.reshape(bsz, n_chunks, ML_CHUNK, nh, *a.shape[3:])
        return jnp.moveaxis(a, (1, 3), (0, 2))

    log_f = jax.nn.log_sigmoid(f_pre)
    mask = jnp.tril(jnp.ones((ML_CHUNK, ML_CHUNK), dtype=bool))

    def step(carry, inp):
        c_st, n_st, m_st = carry
        qc, kc, vc, ic, lfc = inp
        b = jnp.cumsum(lfc, axis=-1)
        a = b + m_st[..., None]
        dmat = jnp.where(mask, b[..., :, None] - b[..., None, :] + ic[..., None, :], -jnp.inf)
        m_j = jnp.maximum(a, jnp.max(dmat, axis=-1))
        w_inter = jnp.exp(a - m_j)
        s = jnp.einsum('bhjd,bhsd->bhjs', qc, kc) * jnp.exp(dmat - m_j[..., None])
        num = w_inter[..., None] * jnp.einsum('bhjd,bhde->bhje', qc, c_st) + jnp.einsum('bhjs,bhse->bhje', s, vc)
        qn = w_inter * jnp.einsum('bhjd,bhd->bhj', qc, n_st) + jnp.sum(s, axis=-1)
        h = num / jnp.maximum(jnp.abs(qn), jnp.exp(-m_j))[..., None]
        b_last = b[..., -1]
        g = b_last[..., None] - b + ic
        m_new = jnp.maximum(b_last + m_st, jnp.max(g, axis=-1))
        decay = jnp.exp(b_last + m_st - m_new)
        kw = kc * jnp.exp(g - m_new[..., None])[..., None]
        c_new = decay[..., None, None] * c_st + jnp.einsum('bhsd,bhse->bhde', kw, vc)
        n_new = decay[..., None] * n_st + jnp.sum(kw, axis=-2)
        return (c_new, n_new, m_new), h

    f32 = jnp.float32
    init = (jnp.zeros((bsz, nh, dh, dh), f32), jnp.zeros((bsz, nh, dh), f32), jnp.zeros((bsz, nh), f32))
    _, h = lax.scan(step, init, (chunks(q), chunks(k), chunks(v), chunks(i_pre), chunks(log_f)))
    return jnp.moveaxis(h, (0, 2), (1, 3)).reshape(bsz, n, nh, dh)


def mlstm_mixer(u_ctx, u_lat, w_up, conv_w, conv_b, w_q, w_k, w_v, w_gate, b_gate,
                norm_g, skip, w_down, with_ctx_out):
    n_ctx = u_ctx.shape[1]

    def branch(u):
        xm, z = jnp.split(u @ w_up, 2, axis=-1)
        xc = jax.nn.silu(conv_centred(xm, conv_w, conv_b))
        q = blockdiag(xc, w_q)
        k = blockdiag(xc, w_k)
        v = blockdiag(xm, w_v)
        gates = jnp.concatenate([q, k, v], axis=-1) @ w_gate + b_gate
        return xc, z, q, k, v, gates

    xc, z, q, k, v, gates = [jnp.concatenate([pc, pl], axis=1)
                             for pc, pl in zip(branch(u_ctx), branch(u_lat))]
    bsz, n, _ = q.shape

    def heads(a):
        return a.astype(jnp.float32).reshape(bsz, n, ML_HEADS, ML_HEAD_DIM)

    q, k, v = heads(q), heads(k) * (ML_HEAD_DIM ** -0.5), heads(v)
    gates = gates.astype(jnp.float32).reshape(bsz, n, 2, 2, ML_HEADS)

    def rev(a):
        return jnp.concatenate([a[:, :n_ctx][:, ::-1], a[:, n_ctx:][:, ::-1]], axis=1)

    h_fwd = mlstm_scan(q, k, v, gates[:, :, 0, 0], gates[:, :, 0, 1])
    h_bwd = rev(mlstm_scan(rev(q), rev(k), rev(v), rev(gates[:, :, 1, 0]), rev(gates[:, :, 1, 1])))
    h = h_fwd + h_bwd
    mu = jnp.mean(h, axis=-1, keepdims=True)
    var = jnp.mean(jnp.square(h - mu), axis=-1, keepdims=True)
    h = ((h - mu) * lax.rsqrt(var + ML_NORM_EPS)).reshape(bsz, n, ML_INNER) * norm_g.astype(jnp.float32)
    h = (h.astype(u_lat.dtype) + skip * xc) * jax.nn.silu(z)
    y_lat = h[:, n_ctx:] @ w_down
    y_ctx = h[:, :n_ctx] @ w_down if with_ctx_out else None
    return y_ctx, y_lat


def setup_inputs(seed: int = 0) -> dict:
    key = jax.random.key(seed)
    ks = iter(jax.random.split(key, 48))
    f32 = jnp.float32

    def nrm(shape, scale):
        return jax.random.normal(next(ks), shape, f32) * scale

    d, ff, inner, nh, qb, fh = D_MODEL, D_FF, ML_INNER, ML_HEADS, ML_QKV_BLOCK, HY_FILT_HIDDEN
    i_bias = nrm((N_MLSTM, 2, 1, nh), 0.1)
    f_bias = jax.random.uniform(next(ks), (N_MLSTM, 2, 1, nh), f32, ML_FGATE_BIAS_LO, ML_FGATE_BIAS_HI)
    return {
        'x': nrm((BATCH, SEQ, d), 1.0),
        'c': nrm((BATCH, d), 1.0),
        'ctx': nrm((BATCH, CTX_LEN, d), 1.0),
        'c_ctx': nrm((d,), 1.0),
        'ada_w': nrm((DEPTH, d, N_MOD * d), 0.5 * d ** -0.5),
        'ada_b': nrm((DEPTH, N_MOD * d), 0.01),
        'norm_g': 1.0 + nrm((DEPTH, N_SUB, d), 0.02),
        'final_g': 1.0 + nrm((d,), 0.02),
        'ffn_w_in': nrm((DEPTH, 2, d, 2 * ff), d ** -0.5),
        'ffn_w_out': nrm((DEPTH, 2, ff, d), ff ** -0.5),
        'hy_w_in': nrm((N_HYENA, d, 3 * d), d ** -0.5),
        'hy_b_in': nrm((N_HYENA, 3 * d), 0.01),
        'hy_conv_w': nrm((N_HYENA, HY_SHORT, 3 * d), HY_SHORT ** -0.5),
        'hy_conv_b': nrm((N_HYENA, 3 * d), 0.01),
        'hy_f_w1': nrm((N_HYENA, HY_EMB, fh), HY_EMB ** -0.5),
        'hy_f_b1': nrm((N_HYENA, fh), 0.01),
        'hy_f_w2': nrm((N_HYENA, fh, fh), fh ** -0.5),
        'hy_f_b2': nrm((N_HYENA, fh), 0.01),
        'hy_f_w3': nrm((N_HYENA, fh, HY_ORDER * 2 * d), fh ** -0.5),
        'hy_f_b3': nrm((N_HYENA, HY_ORDER * 2 * d), 0.01),
        'hy_f_freq': 1.0 + nrm((N_HYENA, 2, fh), 0.02),
        'hy_log_decay': jax.random.uniform(next(ks), (N_HYENA, HY_ORDER, 2, d), f32,
                                           math.log(HY_DECAY_SLOW), math.log(HY_DECAY_FAST)),
        'hy_skip': nrm((N_HYENA, HY_ORDER, d), 0.5),
        'hy_w_out': nrm((N_HYENA, d, d), d ** -0.5),
        'hy_b_out': nrm((N_HYENA, d), 0.01),
        'ml_w_up': nrm((N_MLSTM, d, 2 * inner), d ** -0.5),
        'ml_conv_w': nrm((N_MLSTM, ML_CONV, inner), ML_CONV ** -0.5),
        'ml_conv_b': nrm((N_MLSTM, inner), 0.01),
        'ml_w_q': nrm((N_MLSTM, inner // qb, qb, qb), qb ** -0.5),
        'ml_w_k': nrm((N_MLSTM, inner // qb, qb, qb), qb ** -0.5),
        'ml_w_v': nrm((N_MLSTM, inner // qb, qb, qb), qb ** -0.5),
        'ml_w_gate': nrm((N_MLSTM, 3 * inner, 4 * nh), 0.1 * (3 * inner) ** -0.5),
        'ml_b_gate': jnp.concatenate([i_bias, f_bias], axis=2).reshape(N_MLSTM, 4 * nh),
        'ml_norm_g': 1.0 + nrm((N_MLSTM, inner), 0.02),
        'ml_skip': 1.0 + nrm((N_MLSTM, inner), 0.02),
        'ml_w_down': nrm((N_MLSTM, inner, d), inner ** -0.5),
    }


def reference(x, c, ctx, c_ctx, ada_w, ada_b, norm_g, final_g, ffn_w_in, ffn_w_out,
              hy_w_in, hy_b_in, hy_conv_w, hy_conv_b, hy_f_w1, hy_f_b1, hy_f_w2, hy_f_b2,
              hy_f_w3, hy_f_b3, hy_f_freq, hy_log_decay, hy_skip, hy_w_out, hy_b_out,
              ml_w_up, ml_conv_w, ml_conv_b, ml_w_q, ml_w_k, ml_w_v, ml_w_gate, ml_b_gate,
              ml_norm_g, ml_skip, ml_w_down):
    n_lat = x.shape[1]
    h_lat = x + pos_embed_2d(n_lat, x.shape[-1], x.dtype)[None]
    h_ctx = ctx
    for l in range(DEPTH):
        last = l == DEPTH - 1
        j = l // N_MIXERS
        m_lat = [m[:, None, :] for m in ada_chunks(c, ada_w[l], ada_b[l])]
        m_ctx = ada_chunks(c_ctx, ada_w[l], ada_b[l])
        h_lat = h_lat + 0.5 * m_lat[2] * swiglu(ada_pre(h_lat, norm_g[l, 0], m_lat[0], m_lat[1]),
                                                ffn_w_in[l, 0], ffn_w_out[l, 0])
        h_ctx = h_ctx + 0.5 * m_ctx[2] * swiglu(ada_pre(h_ctx, norm_g[l, 0], m_ctx[0], m_ctx[1]),
                                                ffn_w_in[l, 0], ffn_w_out[l, 0])
        u_lat = ada_pre(h_lat, norm_g[l, 1], m_lat[3], m_lat[4])
        u_ctx = ada_pre(h_ctx, norm_g[l, 1], m_ctx[3], m_ctx[4])
        if l % N_MIXERS == 0:
            hy = functools.partial(
                hyena_mixer, w_in=hy_w_in[j], b_in=hy_b_in[j], conv_w=hy_conv_w[j], conv_b=hy_conv_b[j],
                f_w1=hy_f_w1[j], f_b1=hy_f_b1[j], f_w2=hy_f_w2[j], f_b2=hy_f_b2[j], f_w3=hy_f_w3[j],
                f_b3=hy_f_b3[j], f_freq=hy_f_freq[j], log_decay=hy_log_decay[j], skip=hy_skip[j],
                w_out=hy_w_out[j], b_out=hy_b_out[j])
            y_lat = hy(u_lat)
            y_ctx = None if last else hy(u_ctx)
        else:
            y_ctx, y_lat = mlstm_mixer(u_ctx, u_lat, ml_w_up[j], ml_conv_w[j], ml_conv_b[j], ml_w_q[j],
                                       ml_w_k[j], ml_w_v[j], ml_w_gate[j], ml_b_gate[j], ml_norm_g[j],
                                       ml_skip[j], ml_w_down[j], with_ctx_out=not last)
        h_lat = h_lat + m_lat[5] * y_lat
        h_lat = h_lat + 0.5 * m_lat[8] * swiglu(ada_pre(h_lat, norm_g[l, 2], m_lat[6], m_lat[7]),
                                                ffn_w_in[l, 1], ffn_w_out[l, 1])
        if not last:
            h_ctx = h_ctx + m_ctx[5] * y_ctx
            h_ctx = h_ctx + 0.5 * m_ctx[8] * swiglu(ada_pre(h_ctx, norm_g[l, 2], m_ctx[6], m_ctx[7]),
                                                    ffn_w_in[l, 1], ffn_w_out[l, 1])
    return rms_norm(h_lat, final_g)
```

```cpp
#include <hip/hip_runtime.h>
#include <hip/hip_cooperative_groups.h>
#include <cstdio>
namespace cg = cooperative_groups;
__device__ __forceinline__ int ltid() { int t = threadIdx.x; asm volatile("" : "+v"(t) :: "memory"); return t; }
__device__ __forceinline__ int lbid() { int t = blockIdx.x; asm volatile("" : "+s"(t) :: "memory"); return t; }
namespace pg8 {
#define PG8_LAS __attribute__((address_space(3)))
typedef unsigned short bf16_t;
typedef short bf16x8 __attribute__((ext_vector_type(8)));
typedef float f32x4 __attribute__((ext_vector_type(4)));
typedef unsigned u32x4 __attribute__((ext_vector_type(4)));
constexpr int BM = 256, BK = 64, HALF = 128, HTB = HALF * BK * 2  , STAGE_BYTES = 8 * HTB, NXCD = 8, WGM = 8;

__host__ __device__ __forceinline__ int lds_byte(int r, int c) { const int st = (r >> 4) * 2 + (c >> 5), rr = r & 15, cc = c & 31, ob = rr * 64 + cc * 2; return st * 1024 + (ob ^ (((ob >> 9) & 1) << 5)); }
__host__ __device__ __forceinline__ void stage_rc(int b, int& R, int& C) { const int st = b / 1024, sb = b % 1024, swz = sb ^ (((sb >> 9) & 1) << 5); R = (st >> 1) * 16 + swz / 64; C = (st & 1) * 32 + (swz % 64) / 2; }
__host__ __device__ __forceinline__ int perm32(int rho) { const int n = rho >> 4, i = rho & 15; return 8 * (i >> 2) + 4 * n + (i & 3); }

struct Unit { int pm, pn; };
struct Gemm { const bf16_t* A; const bf16_t* Bt; int M, N, K; };

struct StaticOrder {
    int nM, nN, nwg, G, c;
    __host__ __device__ void init(int M, int N, int G_, int c_) { nM = M / BM; nN = N / BM; nwg = nM * nN; G = G_; c = c_; }
    __host__ __device__ bool next(int i, Unit& u) const {
        const long L = (long)i * G + c; if (L >= nwg) return false;
        int wgid = (int)L; { const int q = nwg / NXCD, r = nwg % NXCD, xcd = wgid % NXCD, off = wgid / NXCD; wgid = (xcd < r ? xcd * (q + 1) : r * (q + 1) + (xcd - r) * q) + off; }
        const int nig = WGM * nN, gid = wgid / nig, fm = gid * WGM, gsz = (nM - fm) < WGM ? (nM - fm) : WGM;
        u.pm = fm + ((wgid % nig) % gsz); u.pn = (wgid % nig) / gsz; return true;
    }
    __device__ __forceinline__ void a_ready(const Unit&) const {}
    __device__ __forceinline__ void done(const Unit&) const {}
};
__device__ __forceinline__ unsigned cvt_pk_bf16(float lo, float hi) { unsigned r; asm volatile("v_cvt_pk_bf16_f32 %0, %1, %2" : "=v"(r) : "v"(lo), "v"(hi)); return r; }
template <class Epi, class Sched, bool STAMP = false>
__device__ __forceinline__ void gemm_phase(PG8_LAS unsigned char* lds, const Gemm g, const Sched& S, const Epi& E, unsigned long long* stamps) {
    const int tid = ltid(), wid = __builtin_amdgcn_readfirstlane(tid >> 6), lane = tid & 63, wr = wid >> 2, wc = wid & 3, fr = lane & 15, fq = lane >> 4;
    const int K = g.K, nt = K / BK;
    int ts_lo = 0, ts_hi = 0, nts = 0; const unsigned long long rt_entry = STAMP ? (unsigned long long)wall_clock64() : 0ull;
#define PG8_STAMP() do { if (STAMP && wid == 0 && nts < 64) { const unsigned long long _c = (unsigned long long)clock64(); \
        ts_lo = (lane == nts) ? (int)(unsigned)_c : ts_lo; ts_hi = (lane == nts) ? (int)(unsigned)(_c >> 32) : ts_hi; ++nts; } } while (0)
    PG8_STAMP();
    unsigned voffA[2], voffB[2];
#pragma unroll
    for (int i = 0; i < 2; ++i) { int R, C; stage_rc(tid * 16 + i * 8192, R, C); const int Rb = Epi::PERM ? ((R & ~31) + perm32(R & 31)) : R;
        voffA[i] = (unsigned)(R * K + C) * 2u; voffB[i] = (unsigned)(Rb * K + C) * 2u; }
    const size_t kstep = (size_t)(BK * 2);
    const size_t hstep = (size_t)HALF * K * 2;
    const size_t tstep = 2 * hstep;
    const unsigned ldsw = (unsigned)wid * 1024u;
    const int aoff = lds_byte(wr * 64 + fr, fq * 8), boff = lds_byte(wc * 32 + fr, fq * 8);
#define PG8_SA(b, h) (((b) * 2 + (h)) * HTB)
#define PG8_SB(b, h) ((4 + (b) * 2 + (h)) * HTB)
#define PG8_STAGE(bufoff, gbase, voff) do { _Pragma("unroll") for (int _i = 0; _i < 2; ++_i) \
        __builtin_amdgcn_global_load_lds((const unsigned*)((const char*)(gbase) + (voff)[_i]), (PG8_LAS unsigned*)(lds + (bufoff) + ldsw + _i * 8192), 16, 0, 0); } while (0)
#define PG8_LDA(dst, b, h) do { _Pragma("unroll") for (int m = 0; m < 4; ++m) _Pragma("unroll") for (int k = 0; k < 2; ++k) dst[m][k] = *(const PG8_LAS bf16x8*)(lds + PG8_SA(b, h) + aoff + m * 2048 + k * 1024); } while (0)
#define PG8_LDB(dst, b, h) do { _Pragma("unroll") for (int n = 0; n < 2; ++n) _Pragma("unroll") for (int k = 0; k < 2; ++k) dst[n][k] = *(const PG8_LAS bf16x8*)(lds + PG8_SB(b, h) + boff + n * 2048 + k * 1024); } while (0)
#define PG8_MMA(ai, bj, At, Bt) do { __builtin_amdgcn_s_setprio(1); _Pragma("unroll") for (int m = 0; m < 4; ++m) _Pragma("unroll") for (int n = 0; n < 2; ++n) _Pragma("unroll") for (int k = 0; k < 2; ++k) \
        acc[ai][bj][m][n] = __builtin_amdgcn_mfma_f32_16x16x32_bf16(Bt[n][k], At[m][k], acc[ai][bj][m][n], 0, 0, 0); __builtin_amdgcn_s_setprio(0); } while (0)
#define PG8_WAIT_V(n) asm volatile("s_waitcnt vmcnt(" #n ")" ::: "memory")
#define PG8_WAIT_L(n) asm volatile("s_waitcnt lgkmcnt(" #n ")" ::: "memory")
#define PG8_BAR __builtin_amdgcn_s_barrier()
#define PG8_SCHED __builtin_amdgcn_sched_barrier(0)
    Unit cur, nxt; int ui = 0;
    if (!S.next(0, cur)) return;
    f32x4 acc[2][2][4][2];
#pragma unroll
    for (int a = 0; a < 2; ++a)
#pragma unroll
        for (int b = 0; b < 2; ++b)
#pragma unroll
            for (int m = 0; m < 4; ++m)
#pragma unroll
                for (int n = 0; n < 2; ++n) acc[a][b][m][n] = (f32x4){0.f, 0.f, 0.f, 0.f};
    bf16x8 At[4][2], B0[2][2], B1[2][2];
    const char* cA = (const char*)g.A + (size_t)cur.pm * tstep; const char* cB = (const char*)g.Bt + (size_t)cur.pn * tstep;
    S.a_ready(cur);
    PG8_STAGE(PG8_SB(0, 0), cB, voffB); PG8_STAGE(PG8_SA(0, 0), cA, voffA); PG8_STAGE(PG8_SB(0, 1), cB + hstep, voffB); PG8_STAGE(PG8_SA(0, 1), cA + hstep, voffA);
    if (wr == 1) PG8_BAR;
    PG8_WAIT_V(4); PG8_BAR;
    PG8_STAGE(PG8_SB(1, 0), cB + kstep, voffB); PG8_STAGE(PG8_SA(1, 0), cA + kstep, voffA); PG8_STAGE(PG8_SB(1, 1), cB + hstep + kstep, voffB);
    PG8_WAIT_V(6); PG8_BAR;
    PG8_STAMP();
    for (;;) {
        const bool has_next = S.next(ui + 1, nxt);
        const char* nA = has_next ? (const char*)g.A + (size_t)nxt.pm * tstep : cA; const char* nB = has_next ? (const char*)g.Bt + (size_t)nxt.pn * tstep : cB;
        for (int t = 0; t < nt; t += 2) {
            const bool last = (t == nt - 2);
            const char* a1 = cA + (size_t)(t + 1) * kstep;
            const char* a2 = last ? nA : cA + (size_t)(t + 2) * kstep; const char* b2 = last ? nB : cB + (size_t)(t + 2) * kstep;
            const char* a3 = a2 + kstep; const char* b3 = b2 + kstep;
            if (last && has_next) S.a_ready(nxt);
            PG8_LDB(B0, 0, 0); PG8_SCHED; PG8_LDA(At, 0, 0); PG8_STAGE(PG8_SA(1, 1), a1 + hstep, voffA);
            PG8_WAIT_L(8); PG8_BAR; PG8_WAIT_L(0); PG8_MMA(0, 0, At, B0); PG8_BAR; PG8_SCHED;
            PG8_LDB(B1, 0, 1); PG8_STAGE(PG8_SB(0, 0), b2, voffB);
            PG8_BAR; PG8_WAIT_L(0); PG8_MMA(0, 1, At, B1); PG8_BAR;
            PG8_LDA(At, 0, 1); PG8_STAGE(PG8_SA(0, 0), a2, voffA);
            PG8_BAR; PG8_WAIT_L(0); PG8_MMA(1, 0, At, B0); PG8_BAR; PG8_SCHED;
            PG8_STAGE(PG8_SB(0, 1), b2 + hstep, voffB);
            PG8_WAIT_V(6); PG8_BAR; PG8_MMA(1, 1, At, B1); PG8_BAR;
            PG8_LDB(B0, 1, 0); PG8_SCHED; PG8_LDA(At, 1, 0); PG8_STAGE(PG8_SA(0, 1), a2 + hstep, voffA);
            PG8_WAIT_L(8); PG8_BAR; PG8_WAIT_L(0); PG8_MMA(0, 0, At, B0); PG8_BAR; PG8_SCHED;
            PG8_LDB(B1, 1, 1); PG8_STAGE(PG8_SB(1, 0), b3, voffB);
            PG8_BAR; PG8_WAIT_L(0); PG8_MMA(0, 1, At, B1); PG8_BAR;
            PG8_LDA(At, 1, 1); PG8_STAGE(PG8_SA(1, 0), a3, voffA);
            PG8_BAR; PG8_WAIT_L(0); PG8_MMA(1, 0, At, B0); PG8_BAR; PG8_SCHED;
            PG8_STAGE(PG8_SB(1, 1), b3 + hstep, voffB);
            PG8_WAIT_V(6); PG8_BAR; PG8_MMA(1, 1, At, B1); PG8_BAR;
        }
        PG8_STAMP();
        if constexpr (!Epi::AFTER_DRAIN) { E(acc, cur, wr, wc, fr, fq); S.done(cur); }
        PG8_STAMP();
        if (!has_next) break;
#pragma unroll
        for (int a = 0; a < 2; ++a)
#pragma unroll
            for (int b = 0; b < 2; ++b)
#pragma unroll
                for (int m = 0; m < 4; ++m)
#pragma unroll
                    for (int n = 0; n < 2; ++n) acc[a][b][m][n] = (f32x4){0.f, 0.f, 0.f, 0.f};
        cur = nxt; cA = nA; cB = nB; ++ui;
    }
    PG8_WAIT_V(0);
    if (wr == 0) PG8_BAR;
    PG8_BAR;
    if constexpr (Epi::AFTER_DRAIN) { E.fused(acc, cur, wr, wc, fr, fq, lds, wid, lane); S.done(cur); }
    PG8_STAMP();
    if (STAMP && wid == 0) { stamps[lane] = lane < nts ? (((unsigned long long)(unsigned)ts_hi << 32) | (unsigned)ts_lo) : 0ull;
        if (lane == 62) stamps[62] = rt_entry; if (lane == 63) stamps[63] = (unsigned long long)wall_clock64(); }
#undef PG8_STAMP
#undef PG8_SA
#undef PG8_SB
#undef PG8_STAGE
#undef PG8_LDA
#undef PG8_LDB
#undef PG8_MMA
#undef PG8_WAIT_V
#undef PG8_WAIT_L
#undef PG8_BAR
#undef PG8_SCHED
}
}

typedef unsigned short u16;
using pg8::f32x4; using pg8::bf16x8;
typedef float f32x2 __attribute__((ext_vector_type(2)));
typedef unsigned u32x2 __attribute__((ext_vector_type(2)));
typedef unsigned u32x4v __attribute__((ext_vector_type(4)));
#define LAS __attribute__((address_space(3)))
constexpr int D = 1024, NB = 4, SEQ = 8192, CTX = 256, TPB = 8448, NTOK = 33792, FF = 2816, NCH = 132, INNER = 2048, DH = 512, NFFT = 16384;
constexpr size_t MiB = 1u << 20;
constexpr size_t OFF_WB = 0, OFF_MOD = 48 * MiB, OFF_H = 49 * MiB, OFF_U = OFF_H + 132 * MiB, OFF_R1 = OFF_U + 66 * MiB, OFF_R2 = OFF_R1 + 264 * MiB,
                 OFF_HBC = OFF_R2 + 132 * MiB, OFF_GATES = OFF_HBC + 4 * MiB, OFF_H2 = OFF_GATES + 3 * MiB, OFF_KCTX = OFF_H2 + 3 * MiB, WS_NEED = OFF_KCTX + 4 * MiB;
constexpr size_t WB_FIN0 = 0, WB_FIN1 = 11 * MiB, WB_FOUT0 = 22 * MiB, WB_FOUT1 = 22 * MiB + 5632 * 1024, WB_MIN = 33 * MiB, WB_MOUT = 41 * MiB, WB_WGT = 45 * MiB;
constexpr int LDS_BYTES = 163840;
struct KP { const float* in[36]; float* out; unsigned char* ws; int ph_lo, ph_hi; };
typedef const KP __attribute__((address_space(4))) * KPC;
enum { I_X = 0, I_C, I_CTX, I_CCTX, I_ADAW, I_ADAB, I_NORMG, I_FINALG, I_FFNIN, I_FFNOUT, I_HYWIN, I_HYBIN, I_HYCW, I_HYCB, I_HYW1, I_HYB1, I_HYW2, I_HYB2, I_HYW3, I_HYB3,
       I_HYFREQ, I_HYDECAY, I_HYSKIP, I_HYWOUT, I_HYBOUT, I_MLUP, I_MLCW, I_MLCB, I_MLWQ, I_MLWK, I_MLWV, I_MLWG, I_MLBG, I_MLNG, I_MLSKIP, I_MLDOWN };

__device__ __forceinline__ float bf2f(u16 b) { return __uint_as_float(((unsigned)b) << 16); }
__device__ __forceinline__ float bflo(unsigned w) { return __uint_as_float(w << 16); }
__device__ __forceinline__ float bfhi(unsigned w) { return __uint_as_float(w & 0xffff0000u); }
__device__ __forceinline__ u16 f2bf(float f) { return (u16)(pg8::cvt_pk_bf16(f, 0.f) & 0xffffu); }
__device__ __forceinline__ float siluf(float x) { return x / (1.0f + __expf(-x)); }
__device__ __forceinline__ int modrow_of_token(int T) { const int b = T / TPB, t = T - b * TPB; return t < CTX ? 4 : b; }
__device__ __forceinline__ float lshfl(float v, int srclane) { return __int_as_float(__builtin_amdgcn_ds_bpermute(srclane << 2, __float_as_int(v))); }
__device__ __forceinline__ float wave_sum(float v) { const int lane = ltid() & 63;
#pragma unroll
    for (int o = 32; o > 0; o >>= 1) v += lshfl(v, lane ^ o);
    return v; }
__device__ __forceinline__ float wave_max(float v) { const int lane = ltid() & 63;
#pragma unroll
    for (int o = 32; o > 0; o >>= 1) v = fmaxf(v, lshfl(v, lane ^ o));
    return v; }

struct EpiSwiglu {
    static constexpr bool PERM = true, AFTER_DRAIN = false;
    u16* act;
    __device__ __forceinline__ void operator()(const f32x4 (&acc)[2][2][4][2], const pg8::Unit& u, int wr, int wc, int fr, int fq) const {
        const int row0 = u.pm * 256 + wr * 64 + fr, col0 = u.pn * 128 + wc * 32 + 8 * fq;
#pragma unroll
        for (int ai = 0; ai < 2; ++ai)
#pragma unroll
            for (int m = 0; m < 4; ++m) {
                const f32x4 g0 = acc[ai][0][m][0], g1 = acc[ai][0][m][1], v0 = acc[ai][1][m][0], v1 = acc[ai][1][m][1];
                u32x4v w;
                w.x = pg8::cvt_pk_bf16(siluf(g0[0]) * v0[0], siluf(g0[1]) * v0[1]); w.y = pg8::cvt_pk_bf16(siluf(g0[2]) * v0[2], siluf(g0[3]) * v0[3]);
                w.z = pg8::cvt_pk_bf16(siluf(g1[0]) * v1[0], siluf(g1[1]) * v1[1]); w.w = pg8::cvt_pk_bf16(siluf(g1[2]) * v1[2], siluf(g1[3]) * v1[3]);
                *(u32x4v*)(act + (size_t)(row0 + ai * 128 + m * 16) * FF + col0) = w; }
    }
};
struct EpiResid {
    static constexpr bool PERM = false, AFTER_DRAIN = false;
    float* h; const float* modl; int gidx; float scale; const float* bias;
    __device__ __forceinline__ void operator()(const f32x4 (&acc)[2][2][4][2], const pg8::Unit& u, int wr, int wc, int fr, int fq) const {
        const int row0 = u.pm * 256 + wr * 64 + fr, col0 = u.pn * 256 + wc * 32 + 4 * fq;
        const int mr = modrow_of_token(u.pm * 256);
        const float* gp = modl + (size_t)mr * 9216 + gidx * 1024;
        f32x4 gv[2][2], bv[2][2];
#pragma unroll
        for (int bj = 0; bj < 2; ++bj)
#pragma unroll
            for (int n = 0; n < 2; ++n) { gv[bj][n] = *(const f32x4*)(gp + col0 + bj * 128 + n * 16) * scale;
                bv[bj][n] = bias ? *(const f32x4*)(bias + col0 + bj * 128 + n * 16) : (f32x4){0.f, 0.f, 0.f, 0.f}; }
#pragma unroll
        for (int ai = 0; ai < 2; ++ai)
#pragma unroll
            for (int m = 0; m < 4; ++m) { float* rowp = h + (size_t)(row0 + ai * 128 + m * 16) * D + col0;
#pragma unroll
                for (int bj = 0; bj < 2; ++bj)
#pragma unroll
                    for (int n = 0; n < 2; ++n) { f32x4* q = (f32x4*)(rowp + bj * 128 + n * 16); *q = *q + gv[bj][n] * (acc[ai][bj][m][n] + bv[bj][n]); } }
    }
};
struct EpiBf {
    static constexpr bool PERM = true, AFTER_DRAIN = false;
    u16* O; int ldc;
    __device__ __forceinline__ void operator()(const f32x4 (&acc)[2][2][4][2], const pg8::Unit& u, int wr, int wc, int fr, int fq) const {
        const int row0 = u.pm * 256 + wr * 64 + fr, col0 = u.pn * 256 + wc * 32 + 8 * fq;
#pragma unroll
        for (int ai = 0; ai < 2; ++ai)
#pragma unroll
            for (int m = 0; m < 4; ++m)
#pragma unroll
                for (int bj = 0; bj < 2; ++bj) { const f32x4 a = acc[ai][bj][m][0], b = acc[ai][bj][m][1]; u32x4v w;
                    w.x = pg8::cvt_pk_bf16(a[0], a[1]); w.y = pg8::cvt_pk_bf16(a[2], a[3]); w.z = pg8::cvt_pk_bf16(b[0], b[1]); w.w = pg8::cvt_pk_bf16(b[2], b[3]);
                    *(u32x4v*)(O + (size_t)(row0 + ai * 128 + m * 16) * ldc + col0 + bj * 128) = w; }
    }
};
struct EpiProjT {
    static constexpr bool PERM = true, AFTER_DRAIN = false;
    u16* lat; u16* ctx; const float* bias;
    __device__ __forceinline__ void operator()(const f32x4 (&acc)[2][2][4][2], const pg8::Unit& u, int wr, int wc, int fr, int fq) const {
        const int row0 = u.pm * 256 + wr * 64 + fr, tc0 = wc * 32 + 8 * fq;
        const int b = u.pn / 33, tile = u.pn - b * 33;
#pragma unroll
        for (int ai = 0; ai < 2; ++ai)
#pragma unroll
            for (int m = 0; m < 4; ++m) { const int ch = row0 + ai * 128 + m * 16; const float bs = bias[ch];
                u16* dst = tile == 0 ? ctx + ((size_t)b * 3072 + ch) * CTX + tc0 : lat + ((size_t)b * 3072 + ch) * SEQ + (tile - 1) * 256 + tc0;
#pragma unroll
                for (int bj = 0; bj < 2; ++bj) { const f32x4 a = acc[ai][bj][m][0] + bs, c = acc[ai][bj][m][1] + bs; u32x4v w;
                    w.x = pg8::cvt_pk_bf16(a[0], a[1]); w.y = pg8::cvt_pk_bf16(a[2], a[3]); w.z = pg8::cvt_pk_bf16(c[0], c[1]); w.w = pg8::cvt_pk_bf16(c[2], c[3]);
                    *(u32x4v*)(dst + bj * 128) = w; } }
    }
};

__device__ __forceinline__ int colmap(int n, int mapmode) { return mapmode ? (((n >> 8) << 7) + (n & 127) + ((n >> 7) & 1) * FF) : n; }
__device__ __forceinline__ void convert_T(const float* __restrict__ src, int ld, int K, int Nd, int mapmode, u16* __restrict__ dst, LAS float* tile, int& tctr) {
    const int tid = ltid(), nkt = K / 64, ntile = (Nd / 64) * nkt;
    for (int t = 0; t < ntile; ++t, ++tctr) {
        if ((tctr % (int)gridDim.x) != lbid()) continue;
        const int n0 = (t / nkt) * 64, k0 = (t % nkt) * 64, c0 = colmap(n0, mapmode);
#pragma unroll
        for (int i = 0; i < 2; ++i) { const int e = tid + 512 * i, kr = e >> 4, c4 = (e & 15) * 4;
            const f32x4 v = *(const f32x4*)(src + (size_t)(k0 + kr) * ld + c0 + c4);
            tile[kr * 65 + c4] = v[0]; tile[kr * 65 + c4 + 1] = v[1]; tile[kr * 65 + c4 + 2] = v[2]; tile[kr * 65 + c4 + 3] = v[3]; }
        __syncthreads();
        { const int n = tid >> 3, k8 = (tid & 7) * 8; u32x4v w;
          w.x = pg8::cvt_pk_bf16(tile[(k8 + 0) * 65 + n], tile[(k8 + 1) * 65 + n]); w.y = pg8::cvt_pk_bf16(tile[(k8 + 2) * 65 + n], tile[(k8 + 3) * 65 + n]);
          w.z = pg8::cvt_pk_bf16(tile[(k8 + 4) * 65 + n], tile[(k8 + 5) * 65 + n]); w.w = pg8::cvt_pk_bf16(tile[(k8 + 6) * 65 + n], tile[(k8 + 7) * 65 + n]);
          *(u32x4v*)(dst + (size_t)(n0 + n) * K + k0 + k8) = w; }
        __syncthreads();
    }
}

__device__ __forceinline__ void norm_phase(KPC kp, int l, int sub) {
    const float* h = (const float*)(kp->ws + OFF_H); u16* uo = (u16*)(kp->ws + OFF_U);
    const float* g = kp->in[I_NORMG] + (size_t)(l * 3 + sub) * D; const float* modl = (const float*)(kp->ws + OFF_MOD) + (size_t)l * 5 * 9216;
    const int lane = ltid() & 63, wv = ltid() >> 6;
    for (int T = lbid() * 8 + wv; T < NTOK; T += gridDim.x * 8) {
        const float* hr = h + (size_t)T * D; f32x4 v[4]; float ss = 0.f;
#pragma unroll
        for (int i = 0; i < 4; ++i) { v[i] = *(const f32x4*)(hr + i * 256 + lane * 4); ss += v[i][0] * v[i][0] + v[i][1] * v[i][1] + v[i][2] * v[i][2] + v[i][3] * v[i][3]; }
        ss = wave_sum(ss); const float rs = rsqrtf(ss * (1.0f / D) + 1e-6f);
        const float* mp = modl + (size_t)modrow_of_token(T) * 9216 + sub * 3 * 1024;
#pragma unroll
        for (int i = 0; i < 4; ++i) { const int c = i * 256 + lane * 4; const f32x4 gg = *(const f32x4*)(g + c), sh = *(const f32x4*)(mp + c), sc = *(const f32x4*)(mp + 1024 + c);
            const f32x4 o = v[i] * rs * gg * (sc + 1.0f) + sh; u32x2 w; w.x = pg8::cvt_pk_bf16(o[0], o[1]); w.y = pg8::cvt_pk_bf16(o[2], o[3]);
            *(u32x2*)(uo + (size_t)T * D + c) = w; }
    }
}

__device__ __forceinline__ void final_phase(KPC kp) {
    const float* h = (const float*)(kp->ws + OFF_H); const float* g = kp->in[I_FINALG];
    const int lane = ltid() & 63, wv = ltid() >> 6;
    for (int r = lbid() * 8 + wv; r < NB * SEQ; r += gridDim.x * 8) {
        const int b = r / SEQ, s = r - b * SEQ; const float* hr = h + ((size_t)b * TPB + CTX + s) * D; f32x4 v[4]; float ss = 0.f;
#pragma unroll
        for (int i = 0; i < 4; ++i) { v[i] = *(const f32x4*)(hr + i * 256 + lane * 4); ss += v[i][0] * v[i][0] + v[i][1] * v[i][1] + v[i][2] * v[i][2] + v[i][3] * v[i][3]; }
        ss = wave_sum(ss); const float rs = rsqrtf(ss * (1.0f / D) + 1e-6f);
#pragma unroll
        for (int i = 0; i < 4; ++i) { const int c = i * 256 + lane * 4; *(f32x4*)(kp->out + (size_t)r * D + c) = v[i] * rs * *(const f32x4*)(g + c); }
    }
}

__device__ __forceinline__ void setup_phase(KPC kp, LAS float* ldsf) {
    float* h = (float*)(kp->ws + OFF_H); const int tid = ltid();
    for (size_t i = (size_t)lbid() * 512 + tid; i < (size_t)NTOK * 256; i += (size_t)gridDim.x * 512) {
        const int T = (int)(i >> 8), c = ((int)i & 255) * 4, b = T / TPB, t = T - b * TPB; f32x4 v;
        if (t < CTX) v = *(const f32x4*)(kp->in[I_CTX] + ((size_t)b * CTX + t) * D + c);
        else { const int s = t - CTX; v = *(const f32x4*)(kp->in[I_X] + ((size_t)b * SEQ + s) * D + c);
            const int half = c >> 9, cc = c & 511, isc = cc >> 8, i0 = cc & 255; const float pv = half ? (float)(s & 63) : (float)(s >> 6);
#pragma unroll
            for (int e = 0; e < 4; ++e) { const float om = exp2f(-13.287712379549449f * (float)(i0 + e) * (1.0f / 256.0f)); const float ang = pv * om; v[e] += isc ? cosf(ang) : sinf(ang); } }
        *(f32x4*)(h + (size_t)T * D + c) = v;
    }
    LAS float* sc = ldsf; LAS float* red = ldsf + 5 * 1024;
    for (int i = tid; i < 5 * 1024; i += 512) { const int r = i >> 10, k = i & 1023; const float cv = r < 4 ? kp->in[I_C][r * D + k] : kp->in[I_CCTX][k]; sc[i] = siluf(cv); }
    __syncthreads();
    float* mod = (float*)(kp->ws + OFF_MOD); const int lane = tid & 63, wv = tid >> 6;
    for (int task = lbid(); task < 288; task += gridDim.x) {
        const int l = task / 72, n0 = (task % 72) * 128 + lane * 2; const float* w = kp->in[I_ADAW] + (size_t)l * D * 9216 + n0;
        f32x2 a[5];
#pragma unroll
        for (int r = 0; r < 5; ++r) a[r] = (f32x2){0.f, 0.f};
        for (int k = wv * 128; k < wv * 128 + 128; ++k) { const f32x2 wv2 = *(const f32x2*)(w + (size_t)k * 9216);
#pragma unroll
            for (int r = 0; r < 5; ++r) a[r] += wv2 * sc[r * 1024 + k]; }
#pragma unroll
        for (int r = 0; r < 5; ++r) { red[(wv * 5 + r) * 128 + lane * 2] = a[r][0]; red[(wv * 5 + r) * 128 + lane * 2 + 1] = a[r][1]; }
        __syncthreads();
        for (int i = tid; i < 640; i += 512) { const int r = i >> 7, n = i & 127; float s = 0.f;
#pragma unroll
            for (int w8 = 0; w8 < 8; ++w8) s += red[(w8 * 5 + r) * 128 + n];
            const int nn = (task % 72) * 128 + n; mod[((size_t)l * 5 + r) * 9216 + nn] = s + kp->in[I_ADAB][(size_t)l * 9216 + nn]; }
        __syncthreads();
    }
}

__device__ __forceinline__ void convert_layer(KPC kp, int l, LAS float* tile) {
    unsigned char* wb = kp->ws + OFF_WB; int tctr = 0; const int j = l >> 1;
    for (int f = 0; f < 2; ++f) {
        convert_T(kp->in[I_FFNIN] + (size_t)(l * 2 + f) * D * 2 * FF, 2 * FF, D, 2 * FF, 1, (u16*)(wb + (f ? WB_FIN1 : WB_FIN0)), tile, tctr);
        convert_T(kp->in[I_FFNOUT] + (size_t)(l * 2 + f) * FF * D, D, FF, D, 0, (u16*)(wb + (f ? WB_FOUT1 : WB_FOUT0)), tile, tctr);
    }
    if ((l & 1) == 0) {
        convert_T(kp->in[I_HYWIN] + (size_t)j * D * 3 * D, 3 * D, D, 3 * D, 0, (u16*)(wb + WB_MIN), tile, tctr);
        convert_T(kp->in[I_HYWOUT] + (size_t)j * D * D, D, D, D, 0, (u16*)(wb + WB_MOUT), tile, tctr);
    } else {
        convert_T(kp->in[I_MLUP] + (size_t)j * D * 2 * INNER, 2 * INNER, D, 2 * INNER, 0, (u16*)(wb + WB_MIN), tile, tctr);
        convert_T(kp->in[I_MLDOWN] + (size_t)j * INNER * D, D, INNER, D, 0, (u16*)(wb + WB_MOUT), tile, tctr);
        u16* wg = (u16*)(wb + WB_WGT); const float* src = kp->in[I_MLWG] + (size_t)j * 3 * INNER * 16;
        for (int i = lbid() * 512 + ltid(); i < 16 * 3 * INNER; i += gridDim.x * 512) { const int o = i / (3 * INNER), k = i - o * 3 * INNER; wg[i] = f2bf(src[(size_t)k * 16 + o]); }
        float* gates = (float*)(kp->ws + OFF_GATES); const float* bg = kp->in[I_MLBG] + j * 16;
        for (int i = lbid() * 512 + ltid(); i < NTOK * 16; i += gridDim.x * 512) gates[i] = bg[i & 15];
    }
}

constexpr size_t HY_PL = 0, HY_PC = (size_t)NB * 3072 * SEQ * 2, HY_YL = HY_PC + (size_t)NB * 3072 * CTX * 2, HY_YC = HY_YL + (size_t)NB * D * SEQ * 2;
__device__ __forceinline__ int fphys(int i) { return i ^ ((((i >> 6) & 1) * 21) ^ (((i >> 5) & 1) * 10)); }
__device__ __forceinline__ f32x2 cmul(f32x2 a, f32x2 b) { return (f32x2){a.x * b.x - a.y * b.y, a.x * b.y + a.y * b.x}; }
__device__ __forceinline__ f32x2 cmulc(f32x2 a, f32x2 b) { return (f32x2){a.x * b.x + a.y * b.y, a.y * b.x - a.x * b.y}; }
__device__ __forceinline__ int drev(int x) { const unsigned r = __brev((unsigned)x) >> 18; return (int)(((r & 0x2AAAu) >> 1) | ((r & 0x1555u) << 1)); }

__device__ __forceinline__ void fft_fwd(LAS f32x2* buf) {
    const int tid = ltid();
    for (int lm = 12; lm >= 0; lm -= 2) {
        const int m = 1 << lm; const float inv = 1.0f / (float)(4 << lm);
#pragma unroll 2
        for (int i = 0; i < 8; ++i) {
            const int g = tid + 512 * i, p = g & (m - 1), base = ((g >> lm) << (lm + 2)) + p;
            const int i0 = fphys(base), i1 = fphys(base + m), i2 = fphys(base + 2 * m), i3 = fphys(base + 3 * m);
            const f32x2 a0 = buf[i0], a1 = buf[i1], a2 = buf[i2], a3 = buf[i3];
            const f32x2 t0 = a0 + a2, t1 = a0 - a2, t2 = a1 + a3, dd = a1 - a3, t3 = (f32x2){dd.y, -dd.x};
            const float rev = (float)p * inv;
            const f32x2 w1 = (f32x2){__builtin_amdgcn_cosf(rev), -__builtin_amdgcn_sinf(rev)}, w2 = cmul(w1, w1), w3 = cmul(w2, w1);
            buf[i0] = t0 + t2; buf[i1] = cmul(t1 + t3, w1); buf[i2] = cmul(t0 - t2, w2); buf[i3] = cmul(t1 - t3, w3);
        }
        __syncthreads();
    }
}
__device__ __forceinline__ void fft_inv(LAS f32x2* buf) {
    const int tid = ltid();
    for (int lm = 0; lm <= 12; lm += 2) {
        const int m = 1 << lm; const float inv = 1.0f / (float)(4 << lm);
#pragma unroll 2
        for (int i = 0; i < 8; ++i) {
            const int g = tid + 512 * i, p = g & (m - 1), base = ((g >> lm) << (lm + 2)) + p;
            const int i0 = fphys(base), i1 = fphys(base + m), i2 = fphys(base + 2 * m), i3 = fphys(base + 3 * m);
            const float rev = (float)p * inv;
            const f32x2 w1 = (f32x2){__builtin_amdgcn_cosf(rev), -__builtin_amdgcn_sinf(rev)}, w2 = cmul(w1, w1), w3 = cmul(w2, w1);
            const f32x2 b0 = buf[i0], b1 = cmulc(buf[i1], w1), b2 = cmulc(buf[i2], w2), b3 = cmulc(buf[i3], w3);
            const f32x2 s0 = b0 + b2, s1 = b0 - b2, s2 = b1 + b3, dd = b1 - b3, s3 = (f32x2){-dd.y, dd.x};
            buf[i0] = s0 + s2; buf[i1] = s1 + s3; buf[i2] = s0 - s2; buf[i3] = s1 - s3;
        }
        __syncthreads();
    }
}

__device__ __forceinline__ void hy_mlp_phase(KPC kp, int j) {
    float* h2 = (float*)(kp->ws + OFF_H2);
    const float* w1 = kp->in[I_HYW1] + j * 33 * 64; const float* b1 = kp->in[I_HYB1] + j * 64; const float* w2 = kp->in[I_HYW2] + j * 64 * 64; const float* b2 = kp->in[I_HYB2] + j * 64;
    const float* fr = kp->in[I_HYFREQ] + j * 128; const int lane = ltid() & 63, wv = ltid() >> 6;
    for (int pos = lbid() * 8 + wv; pos < SEQ + CTX; pos += gridDim.x * 8) {
        const int n = pos < SEQ ? SEQ : CTX, t = pos < SEQ ? pos : pos - SEQ; const float tn = (float)t / (float)(n - 1);
        float feat = 0.f;
        if (lane == 0) feat = tn;
        else if (lane < 33) { const int bi = (lane - 1) & 15; const float band = 1e-4f + (float)bi * ((15.0f - 1e-4f) / 15.0f); float rev = ((float)t / (float)n) * band; rev -= floorf(rev);
            const float ang = 6.283185307179586f * rev; feat = lane < 17 ? cosf(ang) : -sinf(ang); }
        float z = b1[lane];
        for (int i = 0; i < 33; ++i) z += lshfl(feat, i) * w1[i * 64 + lane];
        const float h1 = sinf(fr[lane] * z);
        float z2 = b2[lane];
        for (int v = 0; v < 64; ++v) z2 += lshfl(h1, v) * w2[v * 64 + lane];
        h2[(size_t)pos * 64 + lane] = sinf(fr[64 + lane] * z2);
    }
}

__device__ __forceinline__ void block_sum2(float& a, float& b, LAS float* red) {
    a = wave_sum(a); b = wave_sum(b); const int lane = ltid() & 63, wv = ltid() >> 6;
    __syncthreads(); if (lane == 0) { red[wv] = a; red[8 + wv] = b; } __syncthreads();
    float sa = 0.f, sb = 0.f;
#pragma unroll
    for (int i = 0; i < 8; ++i) { sa += red[i]; sb += red[8 + i]; }
    a = sa; b = sb;
}

__device__ __forceinline__ void hy_filter_task(KPC kp, int j, int task, LAS f32x2* buf, LAS float* aux) {
    const int tid = ltid(), d = task & 1023; const bool lat = task < 1024;
    const float* w3 = kp->in[I_HYW3] + (size_t)j * 64 * 4096; const float* b3 = kp->in[I_HYB3] + j * 4096; const float* ldc = kp->in[I_HYDECAY] + j * 4096;
    __syncthreads();
    if (tid < 256) aux[tid] = w3[(size_t)(tid & 63) * 4096 + (tid >> 6) * 1024 + d];
    if (tid < 4) { aux[256 + tid] = b3[tid * 1024 + d]; aux[260 + tid] = __expf(ldc[tid * 1024 + d]); }
    __syncthreads();
    const float* h2 = (const float*)(kp->ws + OFF_H2);
    float ss0 = 0.f, ss1 = 0.f;
    if (lat) {
        for (int r = 0; r < 16; ++r) { const int i = tid + 512 * r; float a0 = aux[256], a1 = aux[257], a2 = aux[258], a3 = aux[259];
#pragma unroll 4
            for (int u4 = 0; u4 < 16; ++u4) { const f32x4 hv = *(const f32x4*)(h2 + (size_t)i * 64 + u4 * 4);
#pragma unroll
                for (int e = 0; e < 4; ++e) { const int u = u4 * 4 + e; a0 += hv[e] * aux[u]; a1 += hv[e] * aux[64 + u]; a2 += hv[e] * aux[128 + u]; a3 += hv[e] * aux[192 + u]; } }
            const float tn = (float)i * (1.0f / 8191.0f);
            a0 *= __expf(-tn * aux[260]); a1 *= __expf(-tn * aux[261]); a2 *= __expf(-tn * aux[262]); a3 *= __expf(-tn * aux[263]);
            buf[fphys(i)] = (f32x2){a0, a2}; ss0 += a0 * a0; ss1 += a2 * a2;
            if (i >= 1) { buf[fphys(NFFT - i)] = (f32x2){a1, a3}; ss0 += a1 * a1; ss1 += a3 * a3; } }
        if (tid == 0) buf[fphys(SEQ)] = (f32x2){0.f, 0.f};
        block_sum2(ss0, ss1, aux + 272);
        const f32x2 scl = (f32x2){rsqrtf(ss0 + 1e-12f) * (1.0f / NFFT), rsqrtf(ss1 + 1e-12f) * (1.0f / NFFT)};
        for (int r = 0; r < 32; ++r) { const int q = fphys(tid + 512 * r); buf[q] = buf[q] * scl; }
        __syncthreads();
        fft_fwd(buf);
        f32x2* K0 = (f32x2*)(kp->ws + OFF_R2) + (size_t)d * NFFT; f32x2* K1 = (f32x2*)kp->out + (size_t)d * NFFT;
        for (int r = 0; r < 32; ++r) { const int pos = tid + 512 * r, k = drev(pos), pos2 = drev((NFFT - k) & (NFFT - 1)); const f32x2 Z = buf[fphys(pos)], Z2 = buf[fphys(pos2)];
            K0[pos] = (f32x2){0.5f * (Z.x + Z2.x), 0.5f * (Z.y - Z2.y)}; K1[pos] = (f32x2){0.5f * (Z.y + Z2.y), -0.5f * (Z.x - Z2.x)}; }
    } else {
        const int idx = tid; float a0 = 0.f, a1 = 0.f;
        if (idx != CTX) { const int t = idx < CTX ? idx : 2 * CTX - idx, dir = idx < CTX ? 0 : 1; a0 = aux[256 + dir]; a1 = aux[258 + dir];
            for (int u4 = 0; u4 < 16; ++u4) { const f32x4 hv = *(const f32x4*)(h2 + (size_t)(SEQ + t) * 64 + u4 * 4);
#pragma unroll
                for (int e = 0; e < 4; ++e) { const int u = u4 * 4 + e; a0 += hv[e] * aux[dir * 64 + u]; a1 += hv[e] * aux[128 + dir * 64 + u]; } }
            const float tn = (float)t * (1.0f / 255.0f); a0 *= __expf(-tn * aux[260 + dir]); a1 *= __expf(-tn * aux[262 + dir]); }
        ss0 = a0 * a0; ss1 = a1 * a1;
        block_sum2(ss0, ss1, aux + 272);
        float* kc = (float*)(kp->ws + OFF_KCTX);
        kc[(size_t)d * 512 + idx] = a0 * rsqrtf(ss0 + 1e-12f); kc[(size_t)(1024 + d) * 512 + idx] = a1 * rsqrtf(ss1 + 1e-12f);
    }
}

__device__ __forceinline__ float ld3(const u16* row, int t, int n, float wa, float wb, float wc, float bias) {
    const float xm = t > 0 ? bf2f(row[t - 1]) : 0.f, x0 = bf2f(row[t]), xp = t < n - 1 ? bf2f(row[t + 1]) : 0.f; return wa * xm + wb * x0 + wc * xp + bias; }

__device__ __forceinline__ void hy_conv_lat(KPC kp, int j, int task, LAS f32x2* buf) {
    const int tid = ltid(), bp = task >> 10, c = task & 1023, b0 = bp * 2;
    const u16* pl = (const u16*)(kp->ws + OFF_R1 + HY_PL); u16* yl = (u16*)(kp->ws + OFF_R1 + HY_YL);
    const float* cw = kp->in[I_HYCW] + (size_t)j * 3 * 3072; const float* cb = kp->in[I_HYCB] + j * 3072;
    const float w1a = cw[c], w1b = cw[3072 + c], w1c = cw[6144 + c], bb1 = cb[c];
    const float w2a = cw[1024 + c], w2b = cw[3072 + 1024 + c], w2c = cw[6144 + 1024 + c], bb2 = cb[1024 + c];
    const float w3a = cw[2048 + c], w3b = cw[3072 + 2048 + c], w3c = cw[6144 + 2048 + c], bb3 = cb[2048 + c];
    const float sk0 = kp->in[I_HYSKIP][j * 2048 + c], sk1 = kp->in[I_HYSKIP][j * 2048 + 1024 + c];
    const u16* x1r0 = pl + ((size_t)b0 * 3072 + c) * SEQ; const u16* x1r1 = x1r0 + (size_t)3072 * SEQ;
    const u16* x2r0 = x1r0 + (size_t)1024 * SEQ; const u16* x2r1 = x1r1 + (size_t)1024 * SEQ;
    const u16* vr0 = x1r0 + (size_t)2048 * SEQ; const u16* vr1 = x1r1 + (size_t)2048 * SEQ;
    const f32x2* K0 = (const f32x2*)(kp->ws + OFF_R2) + (size_t)c * NFFT; const f32x2* K1 = (const f32x2*)kp->out + (size_t)c * NFFT;
    __syncthreads();
    for (int r = 0; r < 32; ++r) { const int idx = tid + 512 * r;
        buf[fphys(idx)] = idx < SEQ ? (f32x2){ld3(vr0, idx, SEQ, w3a, w3b, w3c, bb3), ld3(vr1, idx, SEQ, w3a, w3b, w3c, bb3)} : (f32x2){0.f, 0.f}; }
    __syncthreads();
    fft_fwd(buf);
    for (int r = 0; r < 32; ++r) { const int pos = tid + 512 * r, q = fphys(pos); buf[q] = cmul(buf[q], K0[pos]); }
    __syncthreads();
    fft_inv(buf);
    float zr[32];
#pragma unroll
    for (int r = 0; r < 16; ++r) { const int t = tid + 512 * r; const f32x2 y = buf[fphys(t)];
        const float v0 = ld3(vr0, t, SEQ, w3a, w3b, w3c, bb3), v1 = ld3(vr1, t, SEQ, w3a, w3b, w3c, bb3);
        const float z0 = ld3(x1r0, t, SEQ, w1a, w1b, w1c, bb1) * (y.x + sk0 * v0), z1 = ld3(x1r1, t, SEQ, w1a, w1b, w1c, bb1) * (y.y + sk0 * v1);
        zr[2 * r] = z0; zr[2 * r + 1] = z1; buf[fphys(t)] = (f32x2){z0, z1}; buf[fphys(t + SEQ)] = (f32x2){0.f, 0.f}; }
    __syncthreads();
    fft_fwd(buf);
    for (int r = 0; r < 32; ++r) { const int pos = tid + 512 * r, q = fphys(pos); buf[q] = cmul(buf[q], K1[pos]); }
    __syncthreads();
    fft_inv(buf);
#pragma unroll
    for (int r = 0; r < 16; ++r) { const int t = tid + 512 * r; const f32x2 y = buf[fphys(t)];
        const float o0 = ld3(x2r0, t, SEQ, w2a, w2b, w2c, bb2) * (y.x + sk1 * zr[2 * r]), o1 = ld3(x2r1, t, SEQ, w2a, w2b, w2c, bb2) * (y.y + sk1 * zr[2 * r + 1]);
        yl[((size_t)b0 * D + c) * SEQ + t] = f2bf(o0); yl[((size_t)(b0 + 1) * D + c) * SEQ + t] = f2bf(o1); }
}

__device__ __forceinline__ void hy_conv_ctx(KPC kp, int j, int c, LAS float* ls) {
    const int tid = ltid();
    const u16* pc = (const u16*)(kp->ws + OFF_R1 + HY_PC); u16* yc = (u16*)(kp->ws + OFF_R1 + HY_YC); const float* kc = (const float*)(kp->ws + OFF_KCTX);
    const float* cw = kp->in[I_HYCW] + (size_t)j * 3 * 3072; const float* cb = kp->in[I_HYCB] + j * 3072;
    const float w1a = cw[c], w1b = cw[3072 + c], w1c = cw[6144 + c], bb1 = cb[c];
    const float w2a = cw[1024 + c], w2b = cw[3072 + 1024 + c], w2c = cw[6144 + 1024 + c], bb2 = cb[1024 + c];
    const float w3a = cw[2048 + c], w3b = cw[3072 + 2048 + c], w3c = cw[6144 + 2048 + c], bb3 = cb[2048 + c];
    const float sk0 = kp->in[I_HYSKIP][j * 2048 + c], sk1 = kp->in[I_HYSKIP][j * 2048 + 1024 + c];
    __syncthreads();
    ls[tid] = kc[(size_t)c * 512 + tid]; ls[512 + tid] = kc[(size_t)(1024 + c) * 512 + tid];
    for (int i = 0; i < 2; ++i) { const int e = tid + 512 * i, b = e >> 8, t = e & 255; ls[1024 + e] = ld3(pc + ((size_t)b * 3072 + 2048 + c) * CTX, t, CTX, w3a, w3b, w3c, bb3); }
    __syncthreads();
    float zr[2];
    for (int i = 0; i < 2; ++i) { const int e = tid + 512 * i, b = e >> 8, t = e & 255; float a = 0.f;
        for (int s = 0; s < CTX; ++s) a += ls[(t - s) & 511] * ls[1024 + b * 256 + s];
        zr[i] = ld3(pc + ((size_t)b * 3072 + c) * CTX, t, CTX, w1a, w1b, w1c, bb1) * (a + sk0 * ls[1024 + e]); ls[2048 + e] = zr[i]; }
    __syncthreads();
    for (int i = 0; i < 2; ++i) { const int e = tid + 512 * i, b = e >> 8, t = e & 255; float a = 0.f;
        for (int s = 0; s < CTX; ++s) a += ls[512 + ((t - s) & 511)] * ls[2048 + b * 256 + s];
        yc[((size_t)b * D + c) * CTX + t] = f2bf(ld3(pc + ((size_t)b * 3072 + 1024 + c) * CTX, t, CTX, w2a, w2b, w2c, bb2) * (a + sk1 * zr[i])); }
}

__device__ __forceinline__ void hy_transpose(KPC kp, LAS u16* tl) {
    const u16* yl = (const u16*)(kp->ws + OFF_R1 + HY_YL); const u16* yc = (const u16*)(kp->ws + OFF_R1 + HY_YC); u16* y = (u16*)(kp->ws + OFF_U); const int tid = ltid();
    for (int tile = lbid(); tile < NB * 16 * NCH; tile += gridDim.x) {
        const int b = tile / (16 * NCH), rem = tile - b * 16 * NCH, ct = rem / NCH, tt = rem - ct * NCH;
        const u16* src = tt < 4 ? yc + ((size_t)b * D + ct * 64) * CTX + tt * 64 : yl + ((size_t)b * D + ct * 64) * SEQ + (tt - 4) * 64; const int ld = tt < 4 ? CTX : SEQ;
        { const int cr = tid >> 3, t8 = (tid & 7) * 8; *(LAS u32x4v*)(tl + cr * 72 + t8) = *(const u32x4v*)(src + (size_t)cr * ld + t8); }
        __syncthreads();
        { const int tr = tid >> 3, c8 = (tid & 7) * 8; u32x4v w;
          w.x = (unsigned)tl[(c8 + 0) * 72 + tr] | ((unsigned)tl[(c8 + 1) * 72 + tr] << 16); w.y = (unsigned)tl[(c8 + 2) * 72 + tr] | ((unsigned)tl[(c8 + 3) * 72 + tr] << 16);
          w.z = (unsigned)tl[(c8 + 4) * 72 + tr] | ((unsigned)tl[(c8 + 5) * 72 + tr] << 16); w.w = (unsigned)tl[(c8 + 6) * 72 + tr] | ((unsigned)tl[(c8 + 7) * 72 + tr] << 16);
          *(u32x4v*)(y + ((size_t)b * TPB + tt * 64 + tr) * D + ct * 64 + c8) = w; }
        __syncthreads();
    }
}

constexpr size_t OFF_XM = OFF_R1, OFF_XC = OFF_R1 + 132 * MiB, OFF_S = WS_NEED, OFF_MLM = OFF_S + 34 * MiB, WS_NEED2 = OFF_MLM + 1 * MiB;
__device__ __forceinline__ u16* hb_ptr(KPC kp, int T) { const int b = T / TPB, t = T - b * TPB;
    return t < CTX ? (u16*)(kp->ws + OFF_HBC) + ((size_t)b * CTX + t) * INNER : (u16*)kp->out + ((size_t)b * SEQ + (t - CTX)) * INNER; }
__device__ __forceinline__ void unpack8(u32x4v w, float (&f)[8]) { f[0] = bflo(w.x); f[1] = bfhi(w.x); f[2] = bflo(w.y); f[3] = bfhi(w.y); f[4] = bflo(w.z); f[5] = bfhi(w.z); f[6] = bflo(w.w); f[7] = bfhi(w.w); }
__device__ __forceinline__ u32x4v pack8(const float (&f)[8]) { u32x4v w; w.x = pg8::cvt_pk_bf16(f[0], f[1]); w.y = pg8::cvt_pk_bf16(f[2], f[3]); w.z = pg8::cvt_pk_bf16(f[4], f[5]); w.w = pg8::cvt_pk_bf16(f[6], f[7]); return w; }
__device__ __forceinline__ void bd8(const float (&x)[8], const float (&w)[32], float (&y)[8]) {
#pragma unroll
    for (int bl = 0; bl < 2; ++bl)
#pragma unroll
        for (int e = 0; e < 4; ++e) { float s = 0.f;
#pragma unroll
            for (int d = 0; d < 4; ++d) s += x[bl * 4 + d] * w[bl * 16 + d * 4 + e];
            y[bl * 4 + e] = s; }
}
__device__ __forceinline__ void ldw32(const float* p, float (&w)[32]) {
#pragma unroll
    for (int i = 0; i < 8; ++i) { const f32x4 v = *(const f32x4*)(p + i * 4); w[i * 4] = v[0]; w[i * 4 + 1] = v[1]; w[i * 4 + 2] = v[2]; w[i * 4 + 3] = v[3]; } }

__device__ __forceinline__ void ml_m_phase(KPC kp, int j) {
    float* M = (float*)(kp->ws + OFF_MLM); const float* wq = kp->in[I_MLWQ] + (size_t)j * 512 * 16; const float* wk = kp->in[I_MLWK] + (size_t)j * 512 * 16;
    for (int i = lbid() * 512 + ltid(); i < 512 * 16; i += gridDim.x * 512) { const int blk = i >> 4, d = (i >> 2) & 3, d2 = i & 3; float s = 0.f;
#pragma unroll
        for (int e = 0; e < 4; ++e) s += wq[blk * 16 + d * 4 + e] * wk[blk * 16 + d2 * 4 + e];
        M[i] = s * 0.04419417382415922f; }
}

__device__ __forceinline__ void ml_prep_task(KPC kp, int j, int task, LAS unsigned char* lds) {
    const int tid = ltid(), lane = tid & 63, wv = tid >> 6, fr = lane & 15, fq = lane >> 4;
    const int hd = task & 3, bc = task >> 2, b = bc / NCH, ci = bc - b * NCH;
    const u16* xm = (const u16*)(kp->ws + OFF_XM); u16* xc = (u16*)(kp->ws + OFF_XC);
    const int T0 = b * TPB + ci * 64, tlo = b * TPB + (ci < 4 ? 0 : CTX), thi = b * TPB + (ci < 4 ? CTX - 1 : TPB - 1);
    const int ch0 = hd * DH + lane * 8;
    LAS u16* QS = (LAS u16*)lds; LAS u16* KS = (LAS u16*)(lds + 66560);
    const float* cw = kp->in[I_MLCW] + (size_t)j * 3 * INNER; const float* cb = kp->in[I_MLCB] + (size_t)j * INNER;
    __syncthreads();
    {
        float cwa[8], cwb[8], cwc[8], cbb[8], wq[32], wk[32];
#pragma unroll
        for (int e = 0; e < 8; ++e) { cwa[e] = cw[ch0 + e]; cwb[e] = cw[INNER + ch0 + e]; cwc[e] = cw[2 * INNER + ch0 + e]; cbb[e] = cb[ch0 + e]; }
        ldw32(kp->in[I_MLWQ] + ((size_t)j * 512 + (ch0 >> 2)) * 16, wq); ldw32(kp->in[I_MLWK] + ((size_t)j * 512 + (ch0 >> 2)) * 16, wk);
        for (int r = 0; r < 8; ++r) { const int jj = wv + 8 * r, T = T0 + jj; const u16* p = xm + (size_t)T * INNER + ch0;
            float x0[8], xa[8], xb[8], xcv[8], q[8], k[8];
            unpack8(*(const u32x4v*)p, x0);
            if (T > tlo) unpack8(*(const u32x4v*)(p - INNER), xa); else {
#pragma unroll
                for (int e = 0; e < 8; ++e) xa[e] = 0.f; }
            if (T < thi) unpack8(*(const u32x4v*)(p + INNER), xb); else {
#pragma unroll
                for (int e = 0; e < 8; ++e) xb[e] = 0.f; }
#pragma unroll
            for (int e = 0; e < 8; ++e) xcv[e] = siluf(cwa[e] * xa[e] + cwb[e] * x0[e] + cwc[e] * xb[e] + cbb[e]);
            const u32x4v xw = pack8(xcv); *(u32x4v*)(xc + (size_t)T * INNER + ch0) = xw; unpack8(xw, xcv);
            bd8(xcv, wq, q); bd8(xcv, wk, k);
            *(LAS u32x4v*)(QS + jj * 520 + lane * 8) = pack8(q); *(LAS u32x4v*)(KS + jj * 520 + lane * 8) = pack8(k); }
    }
    __syncthreads();
    const u16* wg = (const u16*)(kp->ws + OFF_WB + WB_WGT);
    const int mt = wv & 3, kh = wv >> 2;
    { f32x4 s0 = {0.f, 0.f, 0.f, 0.f}, s1 = {0.f, 0.f, 0.f, 0.f}; const int nt0 = kh * 2;
      for (int ks = 0; ks < 16; ++ks) { const bf16x8 a = *(const LAS bf16x8*)(QS + (16 * mt + fr) * 520 + 32 * ks + 8 * fq);
          const bf16x8 b0 = *(const LAS bf16x8*)(KS + (16 * nt0 + fr) * 520 + 32 * ks + 8 * fq), b1 = *(const LAS bf16x8*)(KS + (16 * (nt0 + 1) + fr) * 520 + 32 * ks + 8 * fq);
          s0 = __builtin_amdgcn_mfma_f32_16x16x32_bf16(a, b0, s0, 0, 0, 0); s1 = __builtin_amdgcn_mfma_f32_16x16x32_bf16(a, b1, s1, 0, 0, 0); }
      float* S = (float*)(kp->ws + OFF_S) + ((size_t)(b * 4 + hd) * NCH + ci) * 4096;
#pragma unroll
      for (int r = 0; r < 4; ++r) { S[(16 * mt + 4 * fq + r) * 64 + 16 * nt0 + fr] = s0[r]; S[(16 * mt + 4 * fq + r) * 64 + 16 * (nt0 + 1) + fr] = s1[r]; } }
    f32x4 ga = {0.f, 0.f, 0.f, 0.f};
    for (int ks = kh * 8; ks < kh * 8 + 8; ++ks) { const int kk = hd * DH + 32 * ks + 8 * fq;
        const bf16x8 a = *(const LAS bf16x8*)(QS + (16 * mt + fr) * 520 + 32 * ks + 8 * fq), a2 = *(const LAS bf16x8*)(KS + (16 * mt + fr) * 520 + 32 * ks + 8 * fq);
        const bf16x8 bq = *(const bf16x8*)(wg + (size_t)fr * 6144 + kk), bk = *(const bf16x8*)(wg + (size_t)fr * 6144 + INNER + kk);
        ga = __builtin_amdgcn_mfma_f32_16x16x32_bf16(a, bq, ga, 0, 0, 0); ga = __builtin_amdgcn_mfma_f32_16x16x32_bf16(a2, bk, ga, 0, 0, 0); }
    __syncthreads();
    {
        float wvv[32]; ldw32(kp->in[I_MLWV] + ((size_t)j * 512 + (ch0 >> 2)) * 16, wvv);
        for (int r = 0; r < 8; ++r) { const int jj = wv + 8 * r, T = T0 + jj; float x0[8], v[8]; unpack8(*(const u32x4v*)(xm + (size_t)T * INNER + ch0), x0); bd8(x0, wvv, v);
            *(LAS u32x4v*)(QS + jj * 520 + lane * 8) = pack8(v); }
    }
    __syncthreads();
    for (int ks = kh * 8; ks < kh * 8 + 8; ++ks) { const int kk = hd * DH + 32 * ks + 8 * fq;
        const bf16x8 a = *(const LAS bf16x8*)(QS + (16 * mt + fr) * 520 + 32 * ks + 8 * fq); const bf16x8 bv = *(const bf16x8*)(wg + (size_t)fr * 6144 + 2 * INNER + kk);
        ga = __builtin_amdgcn_mfma_f32_16x16x32_bf16(a, bv, ga, 0, 0, 0); }
    float* gates = (float*)(kp->ws + OFF_GATES);
#pragma unroll
    for (int r = 0; r < 4; ++r) atomicAdd(gates + (size_t)(T0 + 16 * mt + 4 * fq + r) * 16 + fr, ga[r]);
}

constexpr int SC_QS = 0, SC_KT = 66560, SC_VT = 132096, SC_ST = 148480, SC_VEC = 156672;
__device__ __forceinline__ void ml_scan_task(KPC kp, int j, int task, LAS unsigned char* lds) {
    const int tid = ltid(), lane = tid & 63, wv = tid >> 6, fr = lane & 15, fq = lane >> 4;
    const int es = task & 3, dir = (task >> 2) & 1, hd = (task >> 3) & 3, b = task >> 5;
    const u16* xm = (const u16*)(kp->ws + OFF_XM); const u16* xc = (const u16*)(kp->ws + OFF_XC); const float* gates = (const float*)(kp->ws + OFF_GATES);
    const float* Sg = (const float*)(kp->ws + OFF_S) + (size_t)(b * 4 + hd) * NCH * 4096;
    u16* hf = (u16*)(kp->ws + OFF_R2);
    LAS unsigned char* QS = lds + SC_QS; LAS unsigned char* KT = lds + SC_KT; LAS unsigned char* VT = lds + SC_VT; LAS unsigned char* ST = lds + SC_ST;
    LAS float* rowterm = (LAS float*)(lds + SC_VEC); LAS float* colterm = rowterm + 64; LAS float* winter = rowterm + 128; LAS float* einv = rowterm + 192;
    LAS float* kws = rowterm + 256; LAS float* dinv = rowterm + 320; LAS float* nst = rowterm + 384; LAS float* scal = rowterm + 896;
    f32x4 C[32];
#pragma unroll
    for (int i = 0; i < 32; ++i) C[i] = (f32x4){0.f, 0.f, 0.f, 0.f};
    float m_st = 0.f;
    __syncthreads();
    nst[tid] = 0.f;
    for (int ci = 0; ci < NCH; ++ci) {
        __syncthreads();
        const int p0 = ci * 64;
        const int tid = ltid(), lane = tid & 63, wv = tid >> 6, fr = lane & 15, fq = lane >> 4;
        asm volatile("" ::: "memory");
        float Mw[32]; ldw32((const float*)(kp->ws + OFF_MLM) + (size_t)(hd * 128 + lane * 2) * 16, Mw);
        auto tok = [&](int jj) -> int { const int p = p0 + jj; const int t = dir == 0 ? p : (p < CTX ? CTX - 1 - p : TPB + CTX - 1 - p); return b * TPB + t; };
        for (int r = 0; r < 8; ++r) { const int jj = wv + 8 * r, T = tok(jj); float x[8], q[8];
            const u32x4v xw = *(const u32x4v*)(xc + (size_t)T * INNER + hd * DH + lane * 8); unpack8(xw, x); bd8(x, Mw, q);
            *(LAS u32x4v*)(QS + jj * 1040 + lane * 16) = pack8(q);
            const unsigned wd[4] = {xw.x, xw.y, xw.z, xw.w};
#pragma unroll
            for (int e = 0; e < 8; ++e) { const int d = lane * 8 + e; *(LAS u16*)(KT + d * 128 + ((((jj >> 3) ^ (d & 7)) << 4) | ((jj & 7) << 1))) = (u16)((e & 1) ? (wd[e >> 1] >> 16) : (wd[e >> 1] & 0xffffu)); } }
        for (int r = 0; r < 2; ++r) { const int i = tid + 512 * r, jj = i >> 4, g = i & 15, T = tok(jj); const int chv = hd * DH + es * 128 + g * 8; float x[8], v[8], wvv[32];
            unpack8(*(const u32x4v*)(xm + (size_t)T * INNER + chv), x); ldw32(kp->in[I_MLWV] + ((size_t)j * 512 + (chv >> 2)) * 16, wvv); bd8(x, wvv, v);
#pragma unroll
            for (int e = 0; e < 8; ++e) { const int ee = g * 8 + e; *(LAS u16*)(VT + ee * 128 + ((((jj >> 3) ^ (ee & 7)) << 4) | ((jj & 7) << 1))) = f2bf(v[e]); } }
        if (wv == 0) {
            const int T = tok(lane); const float ic = gates[(size_t)T * 16 + dir * 8 + hd], fp = gates[(size_t)T * 16 + dir * 8 + 4 + hd];
            const float lf = fminf(fp, 0.f) - log1pf(__expf(-fabsf(fp)));
            float bb = lf;
#pragma unroll
            for (int o = 1; o < 64; o <<= 1) { const float t = lshfl(bb, lane - o); if (lane >= o) bb += t; }
            const float uu = ic - bb; float pm = uu;
#pragma unroll
            for (int o = 1; o < 64; o <<= 1) { const float t = lshfl(pm, lane - o); if (lane >= o) pm = fmaxf(pm, t); }
            const float a = bb + m_st, mj = fmaxf(a, bb + pm);
            rowterm[lane] = bb - mj; colterm[lane] = uu; winter[lane] = __expf(a - mj); einv[lane] = __expf(-mj);
            const float blast = lshfl(bb, 63), gs = blast - bb + ic, gmax = wave_max(gs), mnew = fmaxf(blast + m_st, gmax);
            kws[lane] = __expf(gs - mnew);
            if (lane == 0) { scal[0] = __expf(blast + m_st - mnew); scal[1] = mnew; }
        }
        __syncthreads();
        {
            const int jj = tid >> 3, sub = tid & 7, s8 = sub * 8; float sv[8];
            if (dir == 0) { const float* sp = Sg + (size_t)ci * 4096 + jj * 64 + s8; const f32x4 v0 = *(const f32x4*)sp, v1 = *(const f32x4*)(sp + 4);
                sv[0] = v0[0]; sv[1] = v0[1]; sv[2] = v0[2]; sv[3] = v0[3]; sv[4] = v1[0]; sv[5] = v1[1]; sv[6] = v1[2]; sv[7] = v1[3]; }
            else { const int oc = ci < 4 ? 3 - ci : 135 - ci; const float* sp = Sg + (size_t)oc * 4096 + (63 - jj) * 64 + (56 - s8); const f32x4 v0 = *(const f32x4*)sp, v1 = *(const f32x4*)(sp + 4);
                sv[7] = v0[0]; sv[6] = v0[1]; sv[5] = v0[2]; sv[4] = v0[3]; sv[3] = v1[0]; sv[2] = v1[1]; sv[1] = v1[2]; sv[0] = v1[3]; }
            const float rt = rowterm[jj]; float rsum = 0.f;
#pragma unroll
            for (int e = 0; e < 8; ++e) { const int s = s8 + e; const float w = s <= jj ? sv[e] * 0.04419417382415922f * __expf(rt + colterm[s]) : 0.f; sv[e] = w; rsum += w; }
            *(LAS u32x4v*)(ST + jj * 128 + ((sub ^ (jj & 7)) << 4)) = pack8(sv);
            float qd = 0.f;
#pragma unroll
            for (int c8 = 0; c8 < 8; ++c8) { float qv[8]; unpack8(*(const LAS u32x4v*)(QS + jj * 1040 + (sub * 8 + c8) * 16), qv);
#pragma unroll
                for (int e = 0; e < 8; ++e) qd += qv[e] * nst[sub * 64 + c8 * 8 + e]; }
            rsum += lshfl(rsum, lane ^ 1); rsum += lshfl(rsum, lane ^ 2); rsum += lshfl(rsum, lane ^ 4);
            qd += lshfl(qd, lane ^ 1); qd += lshfl(qd, lane ^ 2); qd += lshfl(qd, lane ^ 4);
            if (sub == 0) { const float qn = winter[jj] * qd + rsum; dinv[jj] = 1.0f / fmaxf(fabsf(qn), einv[jj]); }
        }
        __syncthreads();
        {
            f32x4 o[4];
#pragma unroll
            for (int mt = 0; mt < 4; ++mt) o[mt] = (f32x4){0.f, 0.f, 0.f, 0.f};
#pragma unroll
            for (int ks = 0; ks < 16; ++ks) {
                u32x4v bw; bw.x = pg8::cvt_pk_bf16(C[2 * ks][0], C[2 * ks][1]); bw.y = pg8::cvt_pk_bf16(C[2 * ks][2], C[2 * ks][3]);
                bw.z = pg8::cvt_pk_bf16(C[2 * ks + 1][0], C[2 * ks + 1][1]); bw.w = pg8::cvt_pk_bf16(C[2 * ks + 1][2], C[2 * ks + 1][3]);
                const bf16x8 bfr = __builtin_bit_cast(bf16x8, bw);
#pragma unroll
                for (int mt = 0; mt < 4; ++mt) { const int off = (16 * mt + fr) * 1040 + 8 * fq;
                    const u32x2 lo = *(const LAS u32x2*)(QS + off + 64 * ks), hi = *(const LAS u32x2*)(QS + off + 64 * ks + 32);
                    u32x4v aw; aw.x = lo.x; aw.y = lo.y; aw.z = hi.x; aw.w = hi.y;
                    o[mt] = __builtin_amdgcn_mfma_f32_16x16x32_bf16(__builtin_bit_cast(bf16x8, aw), bfr, o[mt], 0, 0, 0); }
                if ((ks & 1) == 1) __builtin_amdgcn_sched_barrier(0); }
#pragma unroll
            for (int mt = 0; mt < 4; ++mt)
#pragma unroll
                for (int r = 0; r < 4; ++r) o[mt][r] *= winter[16 * mt + 4 * fq + r];
            const int el = 16 * wv + fr;
            bf16x8 vfr[2];
#pragma unroll
            for (int k2 = 0; k2 < 2; ++k2) { vfr[k2] = *(const LAS bf16x8*)(VT + el * 128 + (((4 * k2 + fq) ^ (el & 7)) << 4));
#pragma unroll
                for (int mt = 0; mt < 4; ++mt) { const int jr = 16 * mt + fr; const bf16x8 a = *(const LAS bf16x8*)(ST + jr * 128 + (((4 * k2 + fq) ^ (jr & 7)) << 4));
                    o[mt] = __builtin_amdgcn_mfma_f32_16x16x32_bf16(a, vfr[k2], o[mt], 0, 0, 0); } }
#pragma unroll
            for (int mt = 0; mt < 4; ++mt)
#pragma unroll
                for (int r = 0; r < 4; ++r) { const int jr = 16 * mt + 4 * fq + r, T = tok(jr); const float hv = o[mt][r] * dinv[jr];
                    u16* dst = dir == 0 ? hf + (size_t)T * INNER : hb_ptr(kp, T); dst[hd * DH + es * 128 + el] = f2bf(hv); }
            const float decay = scal[0];
#pragma unroll
            for (int i = 0; i < 32; ++i) C[i] = C[i] * decay;
#pragma unroll
            for (int k2 = 0; k2 < 2; ++k2) { float vv[8]; unpack8(__builtin_bit_cast(u32x4v, vfr[k2]), vv);
#pragma unroll
                for (int e = 0; e < 8; ++e) vv[e] *= kws[32 * k2 + 8 * fq + e];
                const bf16x8 bsc = __builtin_bit_cast(bf16x8, pack8(vv));
#pragma unroll
                for (int dt = 0; dt < 32; ++dt) { const int dr = 16 * dt + fr; const bf16x8 a = *(const LAS bf16x8*)(KT + dr * 128 + (((4 * k2 + fq) ^ (dr & 7)) << 4));
                    C[dt] = __builtin_amdgcn_mfma_f32_16x16x32_bf16(a, bsc, C[dt], 0, 0, 0);
                    if ((dt & 7) == 7) __builtin_amdgcn_sched_barrier(0); } }
            { float nn = decay * nst[tid];
#pragma unroll
              for (int g = 0; g < 8; ++g) { float kv[8]; unpack8(*(const LAS u32x4v*)(KT + tid * 128 + ((g ^ (tid & 7)) << 4)), kv);
#pragma unroll
                  for (int e = 0; e < 8; ++e) nn += kv[e] * kws[8 * g + e]; }
              nst[tid] = nn; }
            m_st = scal[1];
        }
    }
}

__device__ __forceinline__ void ml_gate_phase(KPC kp, int j) {
    u16* hf = (u16*)(kp->ws + OFF_R2); const u16* xc = (const u16*)(kp->ws + OFF_XC); const u16* z = (const u16*)(kp->ws + OFF_XM);
    const float* ng = kp->in[I_MLNG] + (size_t)j * INNER; const float* sk = kp->in[I_MLSKIP] + (size_t)j * INNER;
    const int lane = ltid() & 63, wv = ltid() >> 6;
    for (int T = lbid() * 8 + wv; T < NTOK; T += gridDim.x * 8) {
        const u16* hbp = hb_ptr(kp, T);
#pragma unroll
        for (int hd = 0; hd < 4; ++hd) { const int c0 = hd * DH + lane * 8; float a[8], bq[8], xv[8], zv[8], o[8];
            unpack8(*(const u32x4v*)(hf + (size_t)T * INNER + c0), a); unpack8(*(const u32x4v*)(hbp + c0), bq);
            float s = 0.f;
#pragma unroll
            for (int e = 0; e < 8; ++e) { a[e] += bq[e]; s += a[e]; }
            const float mu = wave_sum(s) * (1.0f / DH); float vs = 0.f;
#pragma unroll
            for (int e = 0; e < 8; ++e) { a[e] -= mu; vs += a[e] * a[e]; }
            const float rs = rsqrtf(wave_sum(vs) * (1.0f / DH) + 1e-5f);
            unpack8(*(const u32x4v*)(xc + (size_t)T * INNER + c0), xv); unpack8(*(const u32x4v*)(z + (size_t)T * INNER + c0), zv);
#pragma unroll
            for (int e = 0; e < 8; ++e) o[e] = (a[e] * rs * ng[c0 + e] + sk[c0 + e] * xv[e]) * siluf(zv[e]);
            *(u32x4v*)(hf + (size_t)T * INNER + c0) = pack8(o); }
    }
}

enum { K_SETUP = 0, K_CN, K_G1, K_G2R, K_HYIN, K_HYCONV, K_HYTR, K_MLUPX, K_MLPREP, K_MLSCAN, K_MLUPZ, K_MLGATE, K_FINAL };
constexpr int NPHASE = 1 + 11 + 13 + 11 + 13 + 1;
__device__ __forceinline__ void decode_phase(int ph, int& kind, int& l, int& arg) {
    kind = K_SETUP; l = 0; arg = 0; if (ph == 0) return;
    ph -= 1;
    for (l = 0; l < 4; ++l) { const int n = (l & 1) ? 13 : 11; if (ph < n) break; ph -= n; }
    if (l == 4) { kind = K_FINAL; l = 0; return; }
    if (ph == 0) { kind = K_CN; arg = 0; return; } if (ph == 1) { kind = K_G1; arg = 0; return; } if (ph == 2) { kind = K_G2R; arg = 0; return; } if (ph == 3) { kind = K_CN; arg = 1; return; }
    const int nm = (l & 1) ? 6 : 4;
    if (ph < 4 + nm) { const int q = ph - 4;
        if (l & 1) { kind = q == 0 ? K_MLUPX : q == 1 ? K_MLPREP : q == 2 ? K_MLSCAN : q == 3 ? K_MLUPZ : q == 4 ? K_MLGATE : K_G2R; arg = 2; }
        else { kind = q == 0 ? K_HYIN : q == 1 ? K_HYCONV : q == 2 ? K_HYTR : K_G2R; arg = 2; }
        return; }
    ph -= 4 + nm;
    if (ph == 0) { kind = K_CN; arg = 2; return; } if (ph == 1) { kind = K_G1; arg = 1; return; } kind = K_G2R; arg = 1;
}

template <int MIX> __device__ __forceinline__ void run_phases(int lo, int hi, int ph_lo, int ph_hi, LAS unsigned char* lds, cg::grid_group& grid) {
    lo = lo > ph_lo ? lo : ph_lo; hi = hi < ph_hi ? hi : ph_hi;
    for (int ph = lo; ph < hi; ++ph) {
        KPC kp = (KPC)__builtin_amdgcn_kernarg_segment_ptr(); asm volatile("" : "+s"(kp) :: "memory");
        unsigned char* ws = kp->ws; unsigned char* wb = ws + OFF_WB;
        int kind, l, arg; decode_phase(ph, kind, l, arg); const int j = l >> 1;
        const float* modl = (const float*)(ws + OFF_MOD) + (size_t)l * 5 * 9216;
        if (kind == K_SETUP) { if constexpr (MIX == 0) setup_phase(kp, (LAS float*)lds); }
        else if (kind == K_CN) {
            if (arg == 0) { convert_layer(kp, l, (LAS float*)lds); if constexpr (MIX == 1) ml_m_phase(kp, j); }
            if constexpr (MIX == 0) { if (arg == 1) hy_mlp_phase(kp, j); }
            norm_phase(kp, l, arg);
        } else if (kind == K_G1) {
            pg8::Gemm g{(const u16*)(ws + OFF_U), (const u16*)(wb + (arg ? WB_FIN1 : WB_FIN0)), NTOK, 2 * FF, D};
            pg8::StaticOrder S; S.init(g.M, g.N, (int)gridDim.x, lbid()); EpiSwiglu E{(u16*)(ws + OFF_R1)};
            pg8::gemm_phase<EpiSwiglu, pg8::StaticOrder, false>(lds, g, S, E, nullptr);
        } else if (kind == K_G2R) {
            pg8::Gemm g; EpiResid E; E.h = (float*)(ws + OFF_H); E.modl = modl;
            if (arg < 2) { g = pg8::Gemm{(const u16*)(ws + OFF_R1), (const u16*)(wb + (arg ? WB_FOUT1 : WB_FOUT0)), NTOK, D, FF}; E.gidx = arg ? 8 : 2; E.scale = 0.5f; E.bias = nullptr; }
            else if (MIX == 1) { g = pg8::Gemm{(const u16*)(ws + OFF_R2), (const u16*)(wb + WB_MOUT), NTOK, D, INNER}; E.gidx = 5; E.scale = 1.0f; E.bias = nullptr; }
            else { g = pg8::Gemm{(const u16*)(ws + OFF_U), (const u16*)(wb + WB_MOUT), NTOK, D, D}; E.gidx = 5; E.scale = 1.0f; E.bias = kp->in[I_HYBOUT] + (size_t)j * D; }
            pg8::StaticOrder S; S.init(g.M, g.N, (int)gridDim.x, lbid());
            pg8::gemm_phase<EpiResid, pg8::StaticOrder, false>(lds, g, S, E, nullptr);
        } else if (kind == K_FINAL) { if constexpr (MIX == 1) final_phase(kp); }
        else if constexpr (MIX == 0) {
            if (kind == K_HYIN) {
                pg8::Gemm g{(const u16*)(wb + WB_MIN), (const u16*)(ws + OFF_U), 3 * D, NTOK, D};
                pg8::StaticOrder S; S.init(g.M, g.N, (int)gridDim.x, lbid());
                EpiProjT E{(u16*)(ws + OFF_R1 + HY_PL), (u16*)(ws + OFF_R1 + HY_PC), kp->in[I_HYBIN] + (size_t)j * 3 * D};
                pg8::gemm_phase<EpiProjT, pg8::StaticOrder, false>(lds, g, S, E, nullptr);
                __syncthreads();
                for (int t = lbid(); t < 2048; t += gridDim.x) hy_filter_task(kp, j, t, (LAS f32x2*)lds, (LAS float*)(lds + 131072));
            } else if (kind == K_HYCONV) {
                for (int t = lbid(); t < 2048; t += gridDim.x) hy_conv_lat(kp, j, t, (LAS f32x2*)lds);
                for (int t = lbid(); t < 1024; t += gridDim.x) hy_conv_ctx(kp, j, t, (LAS float*)lds);
            } else if (kind == K_HYTR) hy_transpose(kp, (LAS u16*)lds);
        } else {
            if (kind == K_MLUPX || kind == K_MLUPZ) {
                const bool zz = kind == K_MLUPZ;
                pg8::Gemm g{(const u16*)(ws + OFF_U), (const u16*)(wb + WB_MIN) + (zz ? (size_t)INNER * D : 0), NTOK, INNER, D};
                pg8::StaticOrder S; S.init(g.M, g.N, (int)gridDim.x, lbid()); EpiBf E{(u16*)(ws + OFF_XM), INNER};
                pg8::gemm_phase<EpiBf, pg8::StaticOrder, false>(lds, g, S, E, nullptr);
            } else if (kind == K_MLPREP) { for (int t = lbid(); t < NB * NCH * 4; t += gridDim.x) ml_prep_task(kp, j, t, lds); }
            else if (kind == K_MLSCAN) { for (int t = lbid(); t < 128; t += gridDim.x) ml_scan_task(kp, j, t, lds); }
            else if (kind == K_MLGATE) ml_gate_phase(kp, j);
        }
        if (ph + 1 < ph_hi) grid.sync();
    }
}

__global__ void __launch_bounds__(512) fwd_megakernel(KP kparg) {
    extern __shared__ __attribute__((aligned(16))) unsigned char shm[];
    LAS unsigned char* lds = (LAS unsigned char*)shm;
    cg::grid_group grid = cg::this_grid();
    const int ph_lo = kparg.ph_lo, ph_hi = kparg.ph_hi;
    run_phases<0>(0, 12, ph_lo, ph_hi, lds, grid);
    run_phases<1>(12, 25, ph_lo, ph_hi, lds, grid);
    run_phases<0>(25, 36, ph_lo, ph_hi, lds, grid);
    run_phases<1>(36, 50, ph_lo, ph_hi, lds, grid);
}

extern "C" void kernel_launch(void* const* d_in, const int* in_sizes, int n_in, void* d_out, int out_size, void* d_ws, size_t ws_size, hipStream_t stream) {
    static int grid_blocks = 0;
    if (!grid_blocks) {
        int dev = 0, cus = 0, per_cu = 0;
        hipGetDevice(&dev);
        hipDeviceGetAttribute(&cus, hipDeviceAttributeMultiprocessorCount, dev);
        hipFuncSetAttribute((const void*)fwd_megakernel, hipFuncAttributeMaxDynamicSharedMemorySize, LDS_BYTES);
        hipOccupancyMaxActiveBlocksPerMultiprocessor(&per_cu, fwd_megakernel, 512, LDS_BYTES);
        if (per_cu < 1) per_cu = 1;
        grid_blocks = cus * 1;
        if (ws_size < WS_NEED2) fprintf(stderr, "workspace too small: %zu < %zu\n", ws_size, (size_t)WS_NEED2);
    }
    KP hp{};
    for (int i = 0; i < 36; ++i) hp.in[i] = (const float*)d_in[i];
    hp.out = (float*)d_out; hp.ws = (unsigned char*)d_ws; hp.ph_lo = 0; hp.ph_hi = NPHASE;
    void* args[] = {&hp};
    hipError_t e = hipLaunchCooperativeKernel((void*)fwd_megakernel, dim3(grid_blocks), dim3(512), args, LDS_BYTES, stream);
    if (e != hipSuccess) fprintf(stderr, "cooperative launch failed: %s (grid %d)\n", hipGetErrorString(e), grid_blocks);
}
```

```cpp
#define REPMASK 0
#define REPN 1
#include <hip/hip_runtime.h>
#include <hip/hip_cooperative_groups.h>
#include <cstdio>
namespace cg = cooperative_groups;
#define WTAB_OFF 163584
__device__ __forceinline__ int llane() { int l = __builtin_amdgcn_mbcnt_hi(~0u, __builtin_amdgcn_mbcnt_lo(~0u, 0u)); asm volatile("" : "+v"(l) :: "memory"); return l; }
__device__ __forceinline__ int lwave() { extern __shared__ __attribute__((aligned(16))) unsigned char shm_w[];
    const int hw = __builtin_amdgcn_s_getreg(10244) & 63;
    return __builtin_amdgcn_readfirstlane(*(const __attribute__((address_space(3))) int*)((__attribute__((address_space(3))) unsigned char*)shm_w + WTAB_OFF + hw * 4)); }
__device__ __forceinline__ void wtab_init() { extern __shared__ __attribute__((aligned(16))) unsigned char shm_w[];
    const int hw = __builtin_amdgcn_s_getreg(10244) & 63;
    *(__attribute__((address_space(3))) int*)((__attribute__((address_space(3))) unsigned char*)shm_w + WTAB_OFF + hw * 4) = (int)(threadIdx.x >> 6); }
__device__ __forceinline__ int ltid() { return lwave() * 64 + llane(); }
__device__ __forceinline__ int lbid() { int t = blockIdx.x; asm volatile("" : "+s"(t) :: "memory"); return t; }
namespace pg8 {
#define PG8_LAS __attribute__((address_space(3)))
typedef unsigned short bf16_t;
typedef short bf16x8 __attribute__((ext_vector_type(8)));
typedef float f32x4 __attribute__((ext_vector_type(4)));
typedef unsigned u32x4 __attribute__((ext_vector_type(4)));
constexpr int BM = 256, BK = 64, HALF = 128, HTB = HALF * BK * 2  , STAGE_BYTES = 8 * HTB, NXCD = 8, WGM = 8;

__host__ __device__ __forceinline__ int lds_byte(int r, int c) { const int st = (r >> 4) * 2 + (c >> 5), rr = r & 15, cc = c & 31, ob = rr * 64 + cc * 2; return st * 1024 + (ob ^ (((ob >> 9) & 1) << 5)); }
__host__ __device__ __forceinline__ void stage_rc(int b, int& R, int& C) { const int st = b / 1024, sb = b % 1024, swz = sb ^ (((sb >> 9) & 1) << 5); R = (st >> 1) * 16 + swz / 64; C = (st & 1) * 32 + (swz % 64) / 2; }
__host__ __device__ __forceinline__ int perm32(int rho) { const int n = rho >> 4, i = rho & 15; return 8 * (i >> 2) + 4 * n + (i & 3); }

struct Unit { int pm, pn; };
struct Gemm { const bf16_t* A; const bf16_t* Bt; int M, N, K; };

struct StaticOrder {
    int nM, nN, nwg, G, c;
    __host__ __device__ void init(int M, int N, int G_, int c_) { nM = M / BM; nN = N / BM; nwg = nM * nN; G = G_; c = c_; }
    __host__ __device__ bool next(int i, Unit& u) const {
        const long L = (long)i * G + c; if (L >= nwg) return false;
        int wgid = (int)L; { const int q = nwg / NXCD, r = nwg % NXCD, xcd = wgid % NXCD, off = wgid / NXCD; wgid = (xcd < r ? xcd * (q + 1) : r * (q + 1) + (xcd - r) * q) + off; }
        const int nig = WGM * nN, gid = wgid / nig, fm = gid * WGM, gsz = (nM - fm) < WGM ? (nM - fm) : WGM;
        u.pm = fm + ((wgid % nig) % gsz); u.pn = (wgid % nig) / gsz; return true;
    }
    __device__ __forceinline__ void a_ready(const Unit&) const {}
    __device__ __forceinline__ void done(const Unit&) const {}
};
__device__ __forceinline__ unsigned cvt_pk_bf16(float lo, float hi) { unsigned r; asm volatile("v_cvt_pk_bf16_f32 %0, %1, %2" : "=v"(r) : "v"(lo), "v"(hi)); return r; }
template <class Epi, class Sched, bool STAMP = false>
__device__ __forceinline__ void gemm_phase(PG8_LAS unsigned char* lds, const Gemm g, const Sched& S, const Epi& E, unsigned long long* stamps) {
    const int tid = ltid(), wid = __builtin_amdgcn_readfirstlane(tid >> 6), lane = tid & 63, wr = wid >> 2, wc = wid & 3, fr = lane & 15, fq = lane >> 4;
    const int K = g.K, nt = K / BK;
    int ts_lo = 0, ts_hi = 0, nts = 0; const unsigned long long rt_entry = STAMP ? (unsigned long long)wall_clock64() : 0ull;
#define PG8_STAMP() do { if (STAMP && wid == 0 && nts < 64) { const unsigned long long _c = (unsigned long long)clock64(); \
        ts_lo = (lane == nts) ? (int)(unsigned)_c : ts_lo; ts_hi = (lane == nts) ? (int)(unsigned)(_c >> 32) : ts_hi; ++nts; } } while (0)
    PG8_STAMP();
    unsigned voffA[2], voffB[2];
#pragma unroll
    for (int i = 0; i < 2; ++i) { int R, C; stage_rc(tid * 16 + i * 8192, R, C); const int Rb = Epi::PERM ? ((R & ~31) + perm32(R & 31)) : R;
        voffA[i] = (unsigned)(R * K + C) * 2u; voffB[i] = (unsigned)(Rb * K + C) * 2u; }
    const size_t kstep = (size_t)(BK * 2);
    const size_t hstep = (size_t)HALF * K * 2;
    const size_t tstep = 2 * hstep;
    const unsigned ldsw = (unsigned)wid * 1024u;
    const int aoff = lds_byte(wr * 64 + fr, fq * 8), boff = lds_byte(wc * 32 + fr, fq * 8);
#define PG8_SA(b, h) (((b) * 2 + (h)) * HTB)
#define PG8_SB(b, h) ((4 + (b) * 2 + (h)) * HTB)
#define PG8_STAGE(bufoff, gbase, voff) do { _Pragma("unroll") for (int _i = 0; _i < 2; ++_i) \
        __builtin_amdgcn_global_load_lds((const unsigned*)((const char*)(gbase) + (voff)[_i]), (PG8_LAS unsigned*)(lds + (bufoff) + ldsw + _i * 8192), 16, 0, 0); } while (0)
#define PG8_LDA(dst, b, h) do { _Pragma("unroll") for (int m = 0; m < 4; ++m) _Pragma("unroll") for (int k = 0; k < 2; ++k) dst[m][k] = *(const PG8_LAS bf16x8*)(lds + PG8_SA(b, h) + aoff + m * 2048 + k * 1024); } while (0)
#define PG8_LDB(dst, b, h) do { _Pragma("unroll") for (int n = 0; n < 2; ++n) _Pragma("unroll") for (int k = 0; k < 2; ++k) dst[n][k] = *(const PG8_LAS bf16x8*)(lds + PG8_SB(b, h) + boff + n * 2048 + k * 1024); } while (0)
#define PG8_MMA(ai, bj, At, Bt) do { __builtin_amdgcn_s_setprio(1); _Pragma("unroll") for (int m = 0; m < 4; ++m) _Pragma("unroll") for (int n = 0; n < 2; ++n) _Pragma("unroll") for (int k = 0; k < 2; ++k) \
        acc[ai][bj][m][n] = __builtin_amdgcn_mfma_f32_16x16x32_bf16(Bt[n][k], At[m][k], acc[ai][bj][m][n], 0, 0, 0); __builtin_amdgcn_s_setprio(0); } while (0)
#define PG8_WAIT_V(n) asm volatile("s_waitcnt vmcnt(" #n ")" ::: "memory")
#define PG8_WAIT_L(n) asm volatile("s_waitcnt lgkmcnt(" #n ")" ::: "memory")
#define PG8_BAR __builtin_amdgcn_s_barrier()
#define PG8_SCHED __builtin_amdgcn_sched_barrier(0)
    Unit cur, nxt; int ui = 0;
    if (!S.next(0, cur)) return;
    f32x4 acc[2][2][4][2];
#pragma unroll
    for (int a = 0; a < 2; ++a)
#pragma unroll
        for (int b = 0; b < 2; ++b)
#pragma unroll
            for (int m = 0; m < 4; ++m)
#pragma unroll
                for (int n = 0; n < 2; ++n) acc[a][b][m][n] = (f32x4){0.f, 0.f, 0.f, 0.f};
    bf16x8 At[4][2], B0[2][2], B1[2][2];
    const char* cA = (const char*)g.A + (size_t)cur.pm * tstep; const char* cB = (const char*)g.Bt + (size_t)cur.pn * tstep;
    S.a_ready(cur);
    PG8_STAGE(PG8_SB(0, 0), cB, voffB); PG8_STAGE(PG8_SA(0, 0), cA, voffA); PG8_STAGE(PG8_SB(0, 1), cB + hstep, voffB); PG8_STAGE(PG8_SA(0, 1), cA + hstep, voffA);
    if (wr == 1) PG8_BAR;
    PG8_WAIT_V(4); PG8_BAR;
    PG8_STAGE(PG8_SB(1, 0), cB + kstep, voffB); PG8_STAGE(PG8_SA(1, 0), cA + kstep, voffA); PG8_STAGE(PG8_SB(1, 1), cB + hstep + kstep, voffB);
    PG8_WAIT_V(6); PG8_BAR;
    PG8_STAMP();
    for (;;) {
        const bool has_next = S.next(ui + 1, nxt);
        const char* nA = has_next ? (const char*)g.A + (size_t)nxt.pm * tstep : cA; const char* nB = has_next ? (const char*)g.Bt + (size_t)nxt.pn * tstep : cB;
        for (int t = 0; t < nt; t += 2) {
            const bool last = (t == nt - 2);
            const char* a1 = cA + (size_t)(t + 1) * kstep;
            const char* a2 = last ? nA : cA + (size_t)(t + 2) * kstep; const char* b2 = last ? nB : cB + (size_t)(t + 2) * kstep;
            const char* a3 = a2 + kstep; const char* b3 = b2 + kstep;
            if (last && has_next) S.a_ready(nxt);
            PG8_LDB(B0, 0, 0); PG8_SCHED; PG8_LDA(At, 0, 0); PG8_STAGE(PG8_SA(1, 1), a1 + hstep, voffA);
            PG8_WAIT_L(8); PG8_BAR; PG8_WAIT_L(0); PG8_MMA(0, 0, At, B0); PG8_BAR; PG8_SCHED;
            PG8_LDB(B1, 0, 1); PG8_STAGE(PG8_SB(0, 0), b2, voffB);
            PG8_BAR; PG8_WAIT_L(0); PG8_MMA(0, 1, At, B1); PG8_BAR;
            PG8_LDA(At, 0, 1); PG8_STAGE(PG8_SA(0, 0), a2, voffA);
            PG8_BAR; PG8_WAIT_L(0); PG8_MMA(1, 0, At, B0); PG8_BAR; PG8_SCHED;
            PG8_STAGE(PG8_SB(0, 1), b2 + hstep, voffB);
            PG8_WAIT_V(6); PG8_BAR; PG8_MMA(1, 1, At, B1); PG8_BAR;
            PG8_LDB(B0, 1, 0); PG8_SCHED; PG8_LDA(At, 1, 0); PG8_STAGE(PG8_SA(0, 1), a2 + hstep, voffA);
            PG8_WAIT_L(8); PG8_BAR; PG8_WAIT_L(0); PG8_MMA(0, 0, At, B0); PG8_BAR; PG8_SCHED;
            PG8_LDB(B1, 1, 1); PG8_STAGE(PG8_SB(1, 0), b3, voffB);
            PG8_BAR; PG8_WAIT_L(0); PG8_MMA(0, 1, At, B1); PG8_BAR;
            PG8_LDA(At, 1, 1); PG8_STAGE(PG8_SA(1, 0), a3, voffA);
            PG8_BAR; PG8_WAIT_L(0); PG8_MMA(1, 0, At, B0); PG8_BAR; PG8_SCHED;
            PG8_STAGE(PG8_SB(1, 1), b3 + hstep, voffB);
            PG8_WAIT_V(6); PG8_BAR; PG8_MMA(1, 1, At, B1); PG8_BAR;
        }
        PG8_STAMP();
        if constexpr (!Epi::AFTER_DRAIN) { E(acc, cur, wr, wc, fr, fq); S.done(cur); }
        PG8_STAMP();
        if (!has_next) break;
#pragma unroll
        for (int a = 0; a < 2; ++a)
#pragma unroll
            for (int b = 0; b < 2; ++b)
#pragma unroll
                for (int m = 0; m < 4; ++m)
#pragma unroll
                    for (int n = 0; n < 2; ++n) acc[a][b][m][n] = (f32x4){0.f, 0.f, 0.f, 0.f};
        cur = nxt; cA = nA; cB = nB; ++ui;
    }
    PG8_WAIT_V(0);
    if (wr == 0) PG8_BAR;
    PG8_BAR;
    if constexpr (Epi::AFTER_DRAIN) { E.fused(acc, cur, wr, wc, fr, fq, lds, wid, lane); S.done(cur); }
    PG8_STAMP();
    if (STAMP && wid == 0) { stamps[lane] = lane < nts ? (((unsigned long long)(unsigned)ts_hi << 32) | (unsigned)ts_lo) : 0ull;
        if (lane == 62) stamps[62] = rt_entry; if (lane == 63) stamps[63] = (unsigned long long)wall_clock64(); }
#undef PG8_STAMP
#undef PG8_SA
#undef PG8_SB
#undef PG8_STAGE
#undef PG8_LDA
#undef PG8_LDB
#undef PG8_MMA
#undef PG8_WAIT_V
#undef PG8_WAIT_L
#undef PG8_BAR
#undef PG8_SCHED
}
}

typedef unsigned short u16;
using pg8::f32x4; using pg8::bf16x8;
typedef float f32x2 __attribute__((ext_vector_type(2)));
typedef unsigned u32x2 __attribute__((ext_vector_type(2)));
typedef unsigned u32x4v __attribute__((ext_vector_type(4)));
typedef short s16x4 __attribute__((ext_vector_type(4)));
#define LAS __attribute__((address_space(3)))
constexpr int D = 1024, NB = 4, SEQ = 8192, CTX = 256, TPB = 8448, NTOK = 33792, FF = 2816, NCH = 132, INNER = 2048, DH = 512, NFFT = 16384;
constexpr size_t MiB = 1u << 20;
constexpr size_t OFF_WB = 0, OFF_MOD = 48 * MiB, OFF_H = 49 * MiB, OFF_U = OFF_H + 132 * MiB, OFF_R1 = OFF_U + 66 * MiB, OFF_R2 = OFF_R1 + 264 * MiB,
                 OFF_HBC = OFF_R2 + 132 * MiB, OFF_GATES = OFF_HBC + 4 * MiB, OFF_H2 = OFF_GATES + 3 * MiB, OFF_KCTX = OFF_H2 + 3 * MiB, WS_NEED = OFF_KCTX + 4 * MiB;
constexpr size_t WB_FIN0 = 0, WB_FIN1 = 11 * MiB, WB_FOUT0 = 22 * MiB, WB_FOUT1 = 22 * MiB + 5632 * 1024, WB_MIN = 33 * MiB, WB_MOUT = 41 * MiB, WB_WGT = 45 * MiB;
constexpr int LDS_BYTES = 163840;
struct KP { const float* in[36]; float* out; unsigned char* ws; int ph_lo, ph_hi; };
typedef const KP __attribute__((address_space(4))) * KPC;
enum { I_X = 0, I_C, I_CTX, I_CCTX, I_ADAW, I_ADAB, I_NORMG, I_FINALG, I_FFNIN, I_FFNOUT, I_HYWIN, I_HYBIN, I_HYCW, I_HYCB, I_HYW1, I_HYB1, I_HYW2, I_HYB2, I_HYW3, I_HYB3,
       I_HYFREQ, I_HYDECAY, I_HYSKIP, I_HYWOUT, I_HYBOUT, I_MLUP, I_MLCW, I_MLCB, I_MLWQ, I_MLWK, I_MLWV, I_MLWG, I_MLBG, I_MLNG, I_MLSKIP, I_MLDOWN };

__device__ __forceinline__ float bf2f(u16 b) { return __uint_as_float(((unsigned)b) << 16); }
__device__ __forceinline__ float bflo(unsigned w) { return __uint_as_float(w << 16); }
__device__ __forceinline__ float bfhi(unsigned w) { return __uint_as_float(w & 0xffff0000u); }
__device__ __forceinline__ u16 f2bf(float f) { return (u16)(pg8::cvt_pk_bf16(f, 0.f) & 0xffffu); }
__device__ __forceinline__ float siluf(float x) { return x / (1.0f + __expf(-x)); }
__device__ __forceinline__ int modrow_of_token(int T) { const int b = T / TPB, t = T - b * TPB; return t < CTX ? 4 : b; }
__device__ __forceinline__ float lshfl(float v, int srclane) { return __int_as_float(__builtin_amdgcn_ds_bpermute(srclane << 2, __float_as_int(v))); }
__device__ __forceinline__ float wave_sum(float v) { const int lane = llane();
#pragma unroll
    for (int o = 32; o > 0; o >>= 1) v += lshfl(v, lane ^ o);
    return v; }
__device__ __forceinline__ float wave_max(float v) { const int lane = llane();
#pragma unroll
    for (int o = 32; o > 0; o >>= 1) v = fmaxf(v, lshfl(v, lane ^ o));
    return v; }

struct EpiSwiglu {
    static constexpr bool PERM = true, AFTER_DRAIN = false;
    u16* act;
    __device__ __forceinline__ void operator()(const f32x4 (&acc)[2][2][4][2], const pg8::Unit& u, int wr, int wc, int fr, int fq) const {
        const int row0 = u.pm * 256 + wr * 64 + fr, col0 = u.pn * 128 + wc * 32 + 8 * fq;
#pragma unroll
        for (int ai = 0; ai < 2; ++ai)
#pragma unroll
            for (int m = 0; m < 4; ++m) {
                const f32x4 g0 = acc[ai][0][m][0], g1 = acc[ai][0][m][1], v0 = acc[ai][1][m][0], v1 = acc[ai][1][m][1];
                u32x4v w;
                w.x = pg8::cvt_pk_bf16(siluf(g0[0]) * v0[0], siluf(g0[1]) * v0[1]); w.y = pg8::cvt_pk_bf16(siluf(g0[2]) * v0[2], siluf(g0[3]) * v0[3]);
                w.z = pg8::cvt_pk_bf16(siluf(g1[0]) * v1[0], siluf(g1[1]) * v1[1]); w.w = pg8::cvt_pk_bf16(siluf(g1[2]) * v1[2], siluf(g1[3]) * v1[3]);
                *(u32x4v*)(act + (size_t)(row0 + ai * 128 + m * 16) * FF + col0) = w; }
    }
};
struct EpiResid {
    static constexpr bool PERM = false, AFTER_DRAIN = false;
    float* h; const float* modl; int gidx; float scale; const float* bias;
    __device__ __forceinline__ void operator()(const f32x4 (&acc)[2][2][4][2], const pg8::Unit& u, int wr, int wc, int fr, int fq) const {
        const int row0 = u.pm * 256 + wr * 64 + fr, col0 = u.pn * 256 + wc * 32 + 4 * fq;
        const int mr = modrow_of_token(u.pm * 256);
        const float* gp = modl + (size_t)mr * 9216 + gidx * 1024;
        f32x4 gv[2][2], bv[2][2];
#pragma unroll
        for (int bj = 0; bj < 2; ++bj)
#pragma unroll
            for (int n = 0; n < 2; ++n) { gv[bj][n] = *(const f32x4*)(gp + col0 + bj * 128 + n * 16) * scale;
                bv[bj][n] = bias ? *(const f32x4*)(bias + col0 + bj * 128 + n * 16) : (f32x4){0.f, 0.f, 0.f, 0.f}; }
#pragma unroll
        for (int ai = 0; ai < 2; ++ai)
#pragma unroll
            for (int m = 0; m < 4; ++m) { float* rowp = h + (size_t)(row0 + ai * 128 + m * 16) * D + col0;
#pragma unroll
                for (int bj = 0; bj < 2; ++bj)
#pragma unroll
                    for (int n = 0; n < 2; ++n) { f32x4* q = (f32x4*)(rowp + bj * 128 + n * 16); *q = *q + gv[bj][n] * (acc[ai][bj][m][n] + bv[bj][n]); } }
    }
};
struct EpiBf {
    static constexpr bool PERM = true, AFTER_DRAIN = false;
    u16* O; int ldc;
    __device__ __forceinline__ void operator()(const f32x4 (&acc)[2][2][4][2], const pg8::Unit& u, int wr, int wc, int fr, int fq) const {
        const int row0 = u.pm * 256 + wr * 64 + fr, col0 = u.pn * 256 + wc * 32 + 8 * fq;
#pragma unroll
        for (int ai = 0; ai < 2; ++ai)
#pragma unroll
            for (int m = 0; m < 4; ++m)
#pragma unroll
                for (int bj = 0; bj < 2; ++bj) { const f32x4 a = acc[ai][bj][m][0], b = acc[ai][bj][m][1]; u32x4v w;
                    w.x = pg8::cvt_pk_bf16(a[0], a[1]); w.y = pg8::cvt_pk_bf16(a[2], a[3]); w.z = pg8::cvt_pk_bf16(b[0], b[1]); w.w = pg8::cvt_pk_bf16(b[2], b[3]);
                    *(u32x4v*)(O + (size_t)(row0 + ai * 128 + m * 16) * ldc + col0 + bj * 128) = w; }
    }
};
struct EpiProjT {
    static constexpr bool PERM = true, AFTER_DRAIN = false;
    u16* lat; u16* ctx; const float* bias;
    __device__ __forceinline__ void operator()(const f32x4 (&acc)[2][2][4][2], const pg8::Unit& u, int wr, int wc, int fr, int fq) const {
        const int row0 = u.pm * 256 + wr * 64 + fr, tc0 = wc * 32 + 8 * fq;
        const int b = u.pn / 33, tile = u.pn - b * 33;
#pragma unroll
        for (int ai = 0; ai < 2; ++ai)
#pragma unroll
            for (int m = 0; m < 4; ++m) { const int ch = row0 + ai * 128 + m * 16; const float bs = bias[ch];
                u16* dst = tile == 0 ? ctx + ((size_t)b * 3072 + ch) * CTX + tc0 : lat + ((size_t)b * 3072 + ch) * SEQ + (tile - 1) * 256 + tc0;
#pragma unroll
                for (int bj = 0; bj < 2; ++bj) { const f32x4 a = acc[ai][bj][m][0] + bs, c = acc[ai][bj][m][1] + bs; u32x4v w;
                    w.x = pg8::cvt_pk_bf16(a[0], a[1]); w.y = pg8::cvt_pk_bf16(a[2], a[3]); w.z = pg8::cvt_pk_bf16(c[0], c[1]); w.w = pg8::cvt_pk_bf16(c[2], c[3]);
                    *(u32x4v*)(dst + bj * 128) = w; } }
    }
};

__device__ __forceinline__ int colmap(int n, int mapmode) { return mapmode ? (((n >> 8) << 7) + (n & 127) + ((n >> 7) & 1) * FF) : n; }
__device__ __forceinline__ void convert_T(const float* __restrict__ src, int ld, int K, int Nd, int mapmode, u16* __restrict__ dst, LAS float* tile, int& tctr) {
    const int tid = ltid(), nkt = K / 64, ntile = (Nd / 64) * nkt;
    const int G = (int)gridDim.x; const int first = (((lbid() - tctr) % G) + G) % G; tctr += ntile;
    for (int t = first; t < ntile; t += G) {
        const int n0 = (t / nkt) * 64, k0 = (t % nkt) * 64, c0 = colmap(n0, mapmode);
#pragma unroll
        for (int i = 0; i < 2; ++i) { const int e = tid + 512 * i, kr = e >> 4, c4 = (e & 15) * 4;
            const f32x4 v = *(const f32x4*)(src + (size_t)(k0 + kr) * ld + c0 + c4);
            tile[kr * 65 + c4] = v[0]; tile[kr * 65 + c4 + 1] = v[1]; tile[kr * 65 + c4 + 2] = v[2]; tile[kr * 65 + c4 + 3] = v[3]; }
        __syncthreads();
        { const int n = tid >> 3, k8 = (tid & 7) * 8; u32x4v w;
          w.x = pg8::cvt_pk_bf16(tile[(k8 + 0) * 65 + n], tile[(k8 + 1) * 65 + n]); w.y = pg8::cvt_pk_bf16(tile[(k8 + 2) * 65 + n], tile[(k8 + 3) * 65 + n]);
          w.z = pg8::cvt_pk_bf16(tile[(k8 + 4) * 65 + n], tile[(k8 + 5) * 65 + n]); w.w = pg8::cvt_pk_bf16(tile[(k8 + 6) * 65 + n], tile[(k8 + 7) * 65 + n]);
          *(u32x4v*)(dst + (size_t)(n0 + n) * K + k0 + k8) = w; }
        __syncthreads();
    }
}

__device__ __forceinline__ void norm_phase(KPC kp, int l, int sub) {
    const float* h = (const float*)(kp->ws + OFF_H); u16* uo = (u16*)(kp->ws + OFF_U);
    const float* g = kp->in[I_NORMG] + (size_t)(l * 3 + sub) * D; const float* modl = (const float*)(kp->ws + OFF_MOD) + (size_t)l * 5 * 9216;
    const int lane = ltid() & 63, wv = ltid() >> 6;
    for (int T = lbid() * 8 + wv; T < NTOK; T += gridDim.x * 8) {
        const float* hr = h + (size_t)T * D; f32x4 v[4]; float ss = 0.f;
#pragma unroll
        for (int i = 0; i < 4; ++i) { v[i] = *(const f32x4*)(hr + i * 256 + lane * 4); ss += v[i][0] * v[i][0] + v[i][1] * v[i][1] + v[i][2] * v[i][2] + v[i][3] * v[i][3]; }
        ss = wave_sum(ss); const float rs = rsqrtf(ss * (1.0f / D) + 1e-6f);
        const float* mp = modl + (size_t)modrow_of_token(T) * 9216 + sub * 3 * 1024;
#pragma unroll
        for (int i = 0; i < 4; ++i) { const int c = i * 256 + lane * 4; const f32x4 gg = *(const f32x4*)(g + c), sh = *(const f32x4*)(mp + c), sc = *(const f32x4*)(mp + 1024 + c);
            const f32x4 o = v[i] * rs * gg * (sc + 1.0f) + sh; u32x2 w; w.x = pg8::cvt_pk_bf16(o[0], o[1]); w.y = pg8::cvt_pk_bf16(o[2], o[3]);
            *(u32x2*)(uo + (size_t)T * D + c) = w; }
    }
}

__device__ __forceinline__ void final_phase(KPC kp) {
    const float* h = (const float*)(kp->ws + OFF_H); const float* g = kp->in[I_FINALG];
    const int lane = ltid() & 63, wv = ltid() >> 6;
    for (int r = lbid() * 8 + wv; r < NB * SEQ; r += gridDim.x * 8) {
        const int b = r / SEQ, s = r - b * SEQ; const float* hr = h + ((size_t)b * TPB + CTX + s) * D; f32x4 v[4]; float ss = 0.f;
#pragma unroll
        for (int i = 0; i < 4; ++i) { v[i] = *(const f32x4*)(hr + i * 256 + lane * 4); ss += v[i][0] * v[i][0] + v[i][1] * v[i][1] + v[i][2] * v[i][2] + v[i][3] * v[i][3]; }
        ss = wave_sum(ss); const float rs = rsqrtf(ss * (1.0f / D) + 1e-6f);
#pragma unroll
        for (int i = 0; i < 4; ++i) { const int c = i * 256 + lane * 4; *(f32x4*)(kp->out + (size_t)r * D + c) = v[i] * rs * *(const f32x4*)(g + c); }
    }
}

__device__ __forceinline__ void setup_phase(KPC kp, LAS float* ldsf) {
    float* h = (float*)(kp->ws + OFF_H); const int tid = ltid();
    for (size_t i = (size_t)lbid() * 512 + tid; i < (size_t)NTOK * 256; i += (size_t)gridDim.x * 512) {
        const int T = (int)(i >> 8), c = ((int)i & 255) * 4, b = T / TPB, t = T - b * TPB; f32x4 v;
        if (t < CTX) v = *(const f32x4*)(kp->in[I_CTX] + ((size_t)b * CTX + t) * D + c);
        else { const int s = t - CTX; v = *(const f32x4*)(kp->in[I_X] + ((size_t)b * SEQ + s) * D + c);
            const int half = c >> 9, cc = c & 511, isc = cc >> 8, i0 = cc & 255; const float pv = half ? (float)(s & 63) : (float)(s >> 6);
#pragma unroll
            for (int e = 0; e < 4; ++e) { const float om = exp2f(-13.287712379549449f * (float)(i0 + e) * (1.0f / 256.0f)); const float ang = pv * om; v[e] += isc ? cosf(ang) : sinf(ang); } }
        *(f32x4*)(h + (size_t)T * D + c) = v;
    }
    LAS float* sc = ldsf; LAS float* red = ldsf + 5 * 1024;
    for (int i = tid; i < 5 * 1024; i += 512) { const int r = i >> 10, k = i & 1023; const float cv = r < 4 ? kp->in[I_C][r * D + k] : kp->in[I_CCTX][k]; sc[i] = siluf(cv); }
    __syncthreads();
    float* mod = (float*)(kp->ws + OFF_MOD); const int lane = tid & 63, wv = tid >> 6;
    for (int task = lbid(); task < 288; task += gridDim.x) {
        const int l = task / 72, n0 = (task % 72) * 128 + lane * 2; const float* w = kp->in[I_ADAW] + (size_t)l * D * 9216 + n0;
        f32x2 a[5];
#pragma unroll
        for (int r = 0; r < 5; ++r) a[r] = (f32x2){0.f, 0.f};
#pragma unroll 16
        for (int k = wv * 128; k < wv * 128 + 128; ++k) { const f32x2 wv2 = *(const f32x2*)(w + (size_t)k * 9216);
#pragma unroll
            for (int r = 0; r < 5; ++r) a[r] += wv2 * sc[r * 1024 + k]; }
#pragma unroll
        for (int r = 0; r < 5; ++r) { red[(wv * 5 + r) * 128 + lane * 2] = a[r][0]; red[(wv * 5 + r) * 128 + lane * 2 + 1] = a[r][1]; }
        __syncthreads();
        for (int i = tid; i < 640; i += 512) { const int r = i >> 7, n = i & 127; float s = 0.f;
#pragma unroll
            for (int w8 = 0; w8 < 8; ++w8) s += red[(w8 * 5 + r) * 128 + n];
            const int nn = (task % 72) * 128 + n; mod[((size_t)l * 5 + r) * 9216 + nn] = s + kp->in[I_ADAB][(size_t)l * 9216 + nn]; }
        __syncthreads();
    }
}

__device__ __forceinline__ void convert_layer(KPC kp, int l, LAS float* tile) {
    unsigned char* wb = kp->ws + OFF_WB; int tctr = 0; const int j = l >> 1;
    for (int f = 0; f < 2; ++f) {
        convert_T(kp->in[I_FFNIN] + (size_t)(l * 2 + f) * D * 2 * FF, 2 * FF, D, 2 * FF, 1, (u16*)(wb + (f ? WB_FIN1 : WB_FIN0)), tile, tctr);
        convert_T(kp->in[I_FFNOUT] + (size_t)(l * 2 + f) * FF * D, D, FF, D, 0, (u16*)(wb + (f ? WB_FOUT1 : WB_FOUT0)), tile, tctr);
    }
    if ((l & 1) == 0) {
        convert_T(kp->in[I_HYWIN] + (size_t)j * D * 3 * D, 3 * D, D, 3 * D, 0, (u16*)(wb + WB_MIN), tile, tctr);
        convert_T(kp->in[I_HYWOUT] + (size_t)j * D * D, D, D, D, 0, (u16*)(wb + WB_MOUT), tile, tctr);
    } else {
        convert_T(kp->in[I_MLUP] + (size_t)j * D * 2 * INNER, 2 * INNER, D, 2 * INNER, 0, (u16*)(wb + WB_MIN), tile, tctr);
        convert_T(kp->in[I_MLDOWN] + (size_t)j * INNER * D, D, INNER, D, 0, (u16*)(wb + WB_MOUT), tile, tctr);
        u16* wg = (u16*)(wb + WB_WGT); const float* src = kp->in[I_MLWG] + (size_t)j * 3 * INNER * 16;
        for (int i = lbid() * 512 + ltid(); i < 16 * 3 * INNER; i += gridDim.x * 512) { const int o = i / (3 * INNER), k = i - o * 3 * INNER; wg[i] = f2bf(src[(size_t)k * 16 + o]); }
        float* gates = (float*)(kp->ws + OFF_GATES); const float* bg = kp->in[I_MLBG] + j * 16;
        for (int i = lbid() * 512 + ltid(); i < NTOK * 16; i += gridDim.x * 512) gates[i] = bg[i & 15];
    }
}

constexpr size_t HY_PL = 0, HY_PC = (size_t)NB * 3072 * SEQ * 2, HY_YL = HY_PC + (size_t)NB * 3072 * CTX * 2, HY_YC = HY_YL + (size_t)NB * D * SEQ * 2;
__device__ __forceinline__ int fphys(int i) { return i ^ ((((i >> 6) & 1) * 21) ^ (((i >> 5) & 1) * 10)); }
__device__ __forceinline__ f32x2 cmul(f32x2 a, f32x2 b) { return (f32x2){a.x * b.x - a.y * b.y, a.x * b.y + a.y * b.x}; }
__device__ __forceinline__ f32x2 cmulc(f32x2 a, f32x2 b) { return (f32x2){a.x * b.x + a.y * b.y, a.y * b.x - a.x * b.y}; }
__device__ __forceinline__ int drev(int x) { const unsigned r = __brev((unsigned)x) >> 18; return (int)(((r & 0x2AAAu) >> 1) | ((r & 0x1555u) << 1)); }

__device__ __forceinline__ void fft_fwd(LAS f32x2* buf) {
    const int tid = ltid();
    for (int lm = 12; lm >= 0; lm -= 2) {
        const int m = 1 << lm; const float inv = 1.0f / (float)(4 << lm);
#pragma unroll 4
        for (int i = 0; i < 8; ++i) {
            const int g = tid + 512 * i, p = g & (m - 1), base = ((g >> lm) << (lm + 2)) + p;
            const int i0 = fphys(base), i1 = fphys(base + m), i2 = fphys(base + 2 * m), i3 = fphys(base + 3 * m);
            const f32x2 a0 = buf[i0], a1 = buf[i1], a2 = buf[i2], a3 = buf[i3];
            const f32x2 t0 = a0 + a2, t1 = a0 - a2, t2 = a1 + a3, dd = a1 - a3, t3 = (f32x2){dd.y, -dd.x};
            const float rev = (float)p * inv;
            const f32x2 w1 = (f32x2){__builtin_amdgcn_cosf(rev), -__builtin_amdgcn_sinf(rev)}, w2 = cmul(w1, w1), w3 = cmul(w2, w1);
            buf[i0] = t0 + t2; buf[i1] = cmul(t1 + t3, w1); buf[i2] = cmul(t0 - t2, w2); buf[i3] = cmul(t1 - t3, w3);
        }
        __syncthreads();
    }
}
__device__ __forceinline__ void fft_inv(LAS f32x2* buf) {
    const int tid = ltid();
    for (int lm = 0; lm <= 12; lm += 2) {
        const int m = 1 << lm; const float inv = 1.0f / (float)(4 << lm);
#pragma unroll 4
        for (int i = 0; i < 8; ++i) {
            const int g = tid + 512 * i, p = g & (m - 1), base = ((g >> lm) << (lm + 2)) + p;
            const int i0 = fphys(base), i1 = fphys(base + m), i2 = fphys(base + 2 * m), i3 = fphys(base + 3 * m);
            const float rev = (float)p * inv;
            const f32x2 w1 = (f32x2){__builtin_amdgcn_cosf(rev), -__builtin_amdgcn_sinf(rev)}, w2 = cmul(w1, w1), w3 = cmul(w2, w1);
            const f32x2 b0 = buf[i0], b1 = cmulc(buf[i1], w1), b2 = cmulc(buf[i2], w2), b3 = cmulc(buf[i3], w3);
            const f32x2 s0 = b0 + b2, s1 = b0 - b2, s2 = b1 + b3, dd = b1 - b3, s3 = (f32x2){-dd.y, dd.x};
            buf[i0] = s0 + s2; buf[i1] = s1 + s3; buf[i2] = s0 - s2; buf[i3] = s1 - s3;
        }
        __syncthreads();
    }
}

__device__ __forceinline__ void hy_mlp_phase(KPC kp, int j) {
    float* h2 = (float*)(kp->ws + OFF_H2);
    const float* w1 = kp->in[I_HYW1] + j * 33 * 64; const float* b1 = kp->in[I_HYB1] + j * 64; const float* w2 = kp->in[I_HYW2] + j * 64 * 64; const float* b2 = kp->in[I_HYB2] + j * 64;
    const float* fr = kp->in[I_HYFREQ] + j * 128; const int lane = ltid() & 63, wv = ltid() >> 6;
    for (int pos = lbid() * 8 + wv; pos < SEQ + CTX; pos += gridDim.x * 8) {
        const int n = pos < SEQ ? SEQ : CTX, t = pos < SEQ ? pos : pos - SEQ; const float tn = (float)t / (float)(n - 1);
        float feat = 0.f;
        if (lane == 0) feat = tn;
        else if (lane < 33) { const int bi = (lane - 1) & 15; const float band = 1e-4f + (float)bi * ((15.0f - 1e-4f) / 15.0f); float rev = ((float)t / (float)n) * band; rev -= floorf(rev);
            const float ang = 6.283185307179586f * rev; feat = lane < 17 ? cosf(ang) : -sinf(ang); }
        float z = b1[lane];
        for (int i = 0; i < 33; ++i) z += lshfl(feat, i) * w1[i * 64 + lane];
        const float h1 = sinf(fr[lane] * z);
        float z2 = b2[lane];
        for (int v = 0; v < 64; ++v) z2 += lshfl(h1, v) * w2[v * 64 + lane];
        h2[(size_t)pos * 64 + lane] = sinf(fr[64 + lane] * z2);
    }
}

__device__ __forceinline__ void block_sum2(float& a, float& b, LAS float* red) {
    a = wave_sum(a); b = wave_sum(b); const int lane = ltid() & 63, wv = ltid() >> 6;
    __syncthreads(); if (lane == 0) { red[wv] = a; red[8 + wv] = b; } __syncthreads();
    float sa = 0.f, sb = 0.f;
#pragma unroll
    for (int i = 0; i < 8; ++i) { sa += red[i]; sb += red[8 + i]; }
    a = sa; b = sb;
}

__device__ __forceinline__ void hy_filter_task(KPC kp, int j, int task, LAS f32x2* buf, LAS float* aux) {
    const int tid = ltid(), d = task & 1023; const bool lat = task < 1024;
    const float* w3 = kp->in[I_HYW3] + (size_t)j * 64 * 4096; const float* b3 = kp->in[I_HYB3] + j * 4096; const float* ldc = kp->in[I_HYDECAY] + j * 4096;
    __syncthreads();
    if (tid < 256) aux[tid] = w3[(size_t)(tid & 63) * 4096 + (tid >> 6) * 1024 + d];
    if (tid < 4) { aux[256 + tid] = b3[tid * 1024 + d]; aux[260 + tid] = __expf(ldc[tid * 1024 + d]); }
    __syncthreads();
    const float* h2 = (const float*)(kp->ws + OFF_H2);
    float ss0 = 0.f, ss1 = 0.f;
    if (lat) {
        for (int r = 0; r < 16; ++r) { const int i = tid + 512 * r; float a0 = aux[256], a1 = aux[257], a2 = aux[258], a3 = aux[259];
#pragma unroll 4
            for (int u4 = 0; u4 < 16; ++u4) { const f32x4 hv = *(const f32x4*)(h2 + (size_t)i * 64 + u4 * 4);
#pragma unroll
                for (int e = 0; e < 4; ++e) { const int u = u4 * 4 + e; a0 += hv[e] * aux[u]; a1 += hv[e] * aux[64 + u]; a2 += hv[e] * aux[128 + u]; a3 += hv[e] * aux[192 + u]; } }
            const float tn = (float)i * (1.0f / 8191.0f);
            a0 *= __expf(-tn * aux[260]); a1 *= __expf(-tn * aux[261]); a2 *= __expf(-tn * aux[262]); a3 *= __expf(-tn * aux[263]);
            buf[fphys(i)] = (f32x2){a0, a2}; ss0 += a0 * a0; ss1 += a2 * a2;
            if (i >= 1) { buf[fphys(NFFT - i)] = (f32x2){a1, a3}; ss0 += a1 * a1; ss1 += a3 * a3; } }
        if (tid == 0) buf[fphys(SEQ)] = (f32x2){0.f, 0.f};
        block_sum2(ss0, ss1, aux + 272);
        const f32x2 scl = (f32x2){rsqrtf(ss0 + 1e-12f) * (1.0f / NFFT), rsqrtf(ss1 + 1e-12f) * (1.0f / NFFT)};
        for (int r = 0; r < 32; ++r) { const int q = fphys(tid + 512 * r); buf[q] = buf[q] * scl; }
        __syncthreads();
        fft_fwd(buf);
        f32x2* K0 = (f32x2*)(kp->ws + OFF_R2) + (size_t)d * NFFT; f32x2* K1 = (f32x2*)kp->out + (size_t)d * NFFT;
        for (int r = 0; r < 32; ++r) { const int pos = tid + 512 * r, k = drev(pos), pos2 = drev((NFFT - k) & (NFFT - 1)); const f32x2 Z = buf[fphys(pos)], Z2 = buf[fphys(pos2)];
            K0[pos] = (f32x2){0.5f * (Z.x + Z2.x), 0.5f * (Z.y - Z2.y)}; K1[pos] = (f32x2){0.5f * (Z.y + Z2.y), -0.5f * (Z.x - Z2.x)}; }
    } else {
        const int idx = tid; float a0 = 0.f, a1 = 0.f;
        if (idx != CTX) { const int t = idx < CTX ? idx : 2 * CTX - idx, dir = idx < CTX ? 0 : 1; a0 = aux[256 + dir]; a1 = aux[258 + dir];
            for (int u4 = 0; u4 < 16; ++u4) { const f32x4 hv = *(const f32x4*)(h2 + (size_t)(SEQ + t) * 64 + u4 * 4);
#pragma unroll
                for (int e = 0; e < 4; ++e) { const int u = u4 * 4 + e; a0 += hv[e] * aux[dir * 64 + u]; a1 += hv[e] * aux[128 + dir * 64 + u]; } }
            const float tn = (float)t * (1.0f / 255.0f); a0 *= __expf(-tn * aux[260 + dir]); a1 *= __expf(-tn * aux[262 + dir]); }
        ss0 = a0 * a0; ss1 = a1 * a1;
        block_sum2(ss0, ss1, aux + 272);
        float* kc = (float*)(kp->ws + OFF_KCTX);
        kc[(size_t)d * 512 + idx] = a0 * rsqrtf(ss0 + 1e-12f); kc[(size_t)(1024 + d) * 512 + idx] = a1 * rsqrtf(ss1 + 1e-12f);
    }
}

__device__ __forceinline__ float ld3(const u16* row, int t, int n, float wa, float wb, float wc, float bias) {
    const float xm = t > 0 ? bf2f(row[t - 1]) : 0.f, x0 = bf2f(row[t]), xp = t < n - 1 ? bf2f(row[t + 1]) : 0.f; return wa * xm + wb * x0 + wc * xp + bias; }

__device__ __forceinline__ void hy_conv_lat(KPC kp, int j, int task, LAS f32x2* buf) {
    const int tid = ltid(), bp = task >> 10, c = task & 1023, b0 = bp * 2;
    const u16* pl = (const u16*)(kp->ws + OFF_R1 + HY_PL); u16* yl = (u16*)(kp->ws + OFF_R1 + HY_YL);
    const float* cw = kp->in[I_HYCW] + (size_t)j * 3 * 3072; const float* cb = kp->in[I_HYCB] + j * 3072;
    const float w1a = cw[c], w1b = cw[3072 + c], w1c = cw[6144 + c], bb1 = cb[c];
    const float w2a = cw[1024 + c], w2b = cw[3072 + 1024 + c], w2c = cw[6144 + 1024 + c], bb2 = cb[1024 + c];
    const float w3a = cw[2048 + c], w3b = cw[3072 + 2048 + c], w3c = cw[6144 + 2048 + c], bb3 = cb[2048 + c];
    const float sk0 = kp->in[I_HYSKIP][j * 2048 + c], sk1 = kp->in[I_HYSKIP][j * 2048 + 1024 + c];
    const u16* x1r0 = pl + ((size_t)b0 * 3072 + c) * SEQ; const u16* x1r1 = x1r0 + (size_t)3072 * SEQ;
    const u16* x2r0 = x1r0 + (size_t)1024 * SEQ; const u16* x2r1 = x1r1 + (size_t)1024 * SEQ;
    const u16* vr0 = x1r0 + (size_t)2048 * SEQ; const u16* vr1 = x1r1 + (size_t)2048 * SEQ;
    const f32x2* K0 = (const f32x2*)(kp->ws + OFF_R2) + (size_t)c * NFFT; const f32x2* K1 = (const f32x2*)kp->out + (size_t)c * NFFT;
    __syncthreads();
#pragma unroll 8
    for (int r = 0; r < 32; ++r) { const int idx = tid + 512 * r;
        buf[fphys(idx)] = idx < SEQ ? (f32x2){ld3(vr0, idx, SEQ, w3a, w3b, w3c, bb3), ld3(vr1, idx, SEQ, w3a, w3b, w3c, bb3)} : (f32x2){0.f, 0.f}; }
    __syncthreads();
    fft_fwd(buf);
#pragma unroll 8
    for (int r = 0; r < 32; ++r) { const int pos = tid + 512 * r, q = fphys(pos); buf[q] = cmul(buf[q], K0[pos]); }
    __syncthreads();
    fft_inv(buf);
    float zr[32];
#pragma unroll
    for (int r = 0; r < 16; ++r) { const int t = tid + 512 * r; const f32x2 y = buf[fphys(t)];
        const float v0 = ld3(vr0, t, SEQ, w3a, w3b, w3c, bb3), v1 = ld3(vr1, t, SEQ, w3a, w3b, w3c, bb3);
        const float z0 = ld3(x1r0, t, SEQ, w1a, w1b, w1c, bb1) * (y.x + sk0 * v0), z1 = ld3(x1r1, t, SEQ, w1a, w1b, w1c, bb1) * (y.y + sk0 * v1);
        zr[2 * r] = z0; zr[2 * r + 1] = z1; buf[fphys(t)] = (f32x2){z0, z1}; buf[fphys(t + SEQ)] = (f32x2){0.f, 0.f}; }
    __syncthreads();
    fft_fwd(buf);
#pragma unroll 8
    for (int r = 0; r < 32; ++r) { const int pos = tid + 512 * r, q = fphys(pos); buf[q] = cmul(buf[q], K1[pos]); }
    __syncthreads();
    fft_inv(buf);
#pragma unroll
    for (int r = 0; r < 16; ++r) { const int t = tid + 512 * r; const f32x2 y = buf[fphys(t)];
        const float o0 = ld3(x2r0, t, SEQ, w2a, w2b, w2c, bb2) * (y.x + sk1 * zr[2 * r]), o1 = ld3(x2r1, t, SEQ, w2a, w2b, w2c, bb2) * (y.y + sk1 * zr[2 * r + 1]);
        yl[((size_t)b0 * D + c) * SEQ + t] = f2bf(o0); yl[((size_t)(b0 + 1) * D + c) * SEQ + t] = f2bf(o1); }
}

__device__ __forceinline__ void hy_conv_ctx(KPC kp, int j, int c, LAS float* ls) {
    const int tid = ltid();
    const u16* pc = (const u16*)(kp->ws + OFF_R1 + HY_PC); u16* yc = (u16*)(kp->ws + OFF_R1 + HY_YC); const float* kc = (const float*)(kp->ws + OFF_KCTX);
    const float* cw = kp->in[I_HYCW] + (size_t)j * 3 * 3072; const float* cb = kp->in[I_HYCB] + j * 3072;
    const float w1a = cw[c], w1b = cw[3072 + c], w1c = cw[6144 + c], bb1 = cb[c];
    const float w2a = cw[1024 + c], w2b = cw[3072 + 1024 + c], w2c = cw[6144 + 1024 + c], bb2 = cb[1024 + c];
    const float w3a = cw[2048 + c], w3b = cw[3072 + 2048 + c], w3c = cw[6144 + 2048 + c], bb3 = cb[2048 + c];
    const float sk0 = kp->in[I_HYSKIP][j * 2048 + c], sk1 = kp->in[I_HYSKIP][j * 2048 + 1024 + c];
    __syncthreads();
    ls[tid] = kc[(size_t)c * 512 + tid]; ls[512 + tid] = kc[(size_t)(1024 + c) * 512 + tid];
    for (int i = 0; i < 2; ++i) { const int e = tid + 512 * i, b = e >> 8, t = e & 255; ls[1024 + e] = ld3(pc + ((size_t)b * 3072 + 2048 + c) * CTX, t, CTX, w3a, w3b, w3c, bb3); }
    __syncthreads();
    float zr[2];
    for (int i = 0; i < 2; ++i) { const int e = tid + 512 * i, b = e >> 8, t = e & 255; float a = 0.f;
        for (int s = 0; s < CTX; ++s) a += ls[(t - s) & 511] * ls[1024 + b * 256 + s];
        zr[i] = ld3(pc + ((size_t)b * 3072 + c) * CTX, t, CTX, w1a, w1b, w1c, bb1) * (a + sk0 * ls[1024 + e]); ls[2048 + e] = zr[i]; }
    __syncthreads();
    for (int i = 0; i < 2; ++i) { const int e = tid + 512 * i, b = e >> 8, t = e & 255; float a = 0.f;
        for (int s = 0; s < CTX; ++s) a += ls[512 + ((t - s) & 511)] * ls[2048 + b * 256 + s];
        yc[((size_t)b * D + c) * CTX + t] = f2bf(ld3(pc + ((size_t)b * 3072 + 1024 + c) * CTX, t, CTX, w2a, w2b, w2c, bb2) * (a + sk1 * zr[i])); }
}

__device__ __forceinline__ void hy_transpose(KPC kp, LAS u16* tl) {
    const u16* yl = (const u16*)(kp->ws + OFF_R1 + HY_YL); const u16* yc = (const u16*)(kp->ws + OFF_R1 + HY_YC); u16* y = (u16*)(kp->ws + OFF_U); const int tid = ltid();
    for (int tile = lbid(); tile < NB * 16 * NCH; tile += gridDim.x) {
        const int b = tile / (16 * NCH), rem = tile - b * 16 * NCH, ct = rem / NCH, tt = rem - ct * NCH;
        const u16* src = tt < 4 ? yc + ((size_t)b * D + ct * 64) * CTX + tt * 64 : yl + ((size_t)b * D + ct * 64) * SEQ + (tt - 4) * 64; const int ld = tt < 4 ? CTX : SEQ;
        { const int cr = tid >> 3, t8 = (tid & 7) * 8; *(LAS u32x4v*)(tl + cr * 72 + t8) = *(const u32x4v*)(src + (size_t)cr * ld + t8); }
        __syncthreads();
        { const int tr = tid >> 3, c8 = (tid & 7) * 8; u32x4v w;
          w.x = (unsigned)tl[(c8 + 0) * 72 + tr] | ((unsigned)tl[(c8 + 1) * 72 + tr] << 16); w.y = (unsigned)tl[(c8 + 2) * 72 + tr] | ((unsigned)tl[(c8 + 3) * 72 + tr] << 16);
          w.z = (unsigned)tl[(c8 + 4) * 72 + tr] | ((unsigned)tl[(c8 + 5) * 72 + tr] << 16); w.w = (unsigned)tl[(c8 + 6) * 72 + tr] | ((unsigned)tl[(c8 + 7) * 72 + tr] << 16);
          *(u32x4v*)(y + ((size_t)b * TPB + tt * 64 + tr) * D + ct * 64 + c8) = w; }
        __syncthreads();
    }
}

constexpr size_t OFF_XM = OFF_R1, OFF_XC = OFF_R1 + 132 * MiB, OFF_S = WS_NEED, OFF_MLM = OFF_S + 34 * MiB, WS_NEED2 = OFF_MLM + 1 * MiB;
__device__ __forceinline__ u16* hb_ptr(KPC kp, int T) { const int b = T / TPB, t = T - b * TPB;
    return t < CTX ? (u16*)(kp->ws + OFF_HBC) + ((size_t)b * CTX + t) * INNER : (u16*)kp->out + ((size_t)b * SEQ + (t - CTX)) * INNER; }
__device__ __forceinline__ void unpack8(u32x4v w, float (&f)[8]) { f[0] = bflo(w.x); f[1] = bfhi(w.x); f[2] = bflo(w.y); f[3] = bfhi(w.y); f[4] = bflo(w.z); f[5] = bfhi(w.z); f[6] = bflo(w.w); f[7] = bfhi(w.w); }
__device__ __forceinline__ u32x4v pack8(const float (&f)[8]) { u32x4v w; w.x = pg8::cvt_pk_bf16(f[0], f[1]); w.y = pg8::cvt_pk_bf16(f[2], f[3]); w.z = pg8::cvt_pk_bf16(f[4], f[5]); w.w = pg8::cvt_pk_bf16(f[6], f[7]); return w; }
__device__ __forceinline__ void bd8(const float (&x)[8], const float (&w)[32], float (&y)[8]) {
#pragma unroll
    for (int bl = 0; bl < 2; ++bl)
#pragma unroll
        for (int e = 0; e < 4; ++e) { float s = 0.f;
#pragma unroll
            for (int d = 0; d < 4; ++d) s += x[bl * 4 + d] * w[bl * 16 + d * 4 + e];
            y[bl * 4 + e] = s; }
}
__device__ __forceinline__ void ldw32(const float* p, float (&w)[32]) {
#pragma unroll
    for (int i = 0; i < 8; ++i) { const f32x4 v = *(const f32x4*)(p + i * 4); w[i * 4] = v[0]; w[i * 4 + 1] = v[1]; w[i * 4 + 2] = v[2]; w[i * 4 + 3] = v[3]; } }

__device__ __forceinline__ void ml_m_phase(KPC kp, int j) {
    float* M = (float*)(kp->ws + OFF_MLM); const float* wq = kp->in[I_MLWQ] + (size_t)j * 512 * 16; const float* wk = kp->in[I_MLWK] + (size_t)j * 512 * 16;
    for (int i = lbid() * 512 + ltid(); i < 512 * 16; i += gridDim.x * 512) { const int blk = i >> 4, d = (i >> 2) & 3, d2 = i & 3; float s = 0.f;
#pragma unroll
        for (int e = 0; e < 4; ++e) s += wq[blk * 16 + d * 4 + e] * wk[blk * 16 + d2 * 4 + e];
        M[i] = s * 0.04419417382415922f; }
}

__device__ __forceinline__ void ml_prep_task(KPC kp, int j, int task, LAS unsigned char* lds) {
    const int tid = ltid(), lane = tid & 63, wv = tid >> 6, fr = lane & 15, fq = lane >> 4;
    const int hd = task & 3, bc = task >> 2, b = bc / NCH, ci = bc - b * NCH;
    const u16* xm = (const u16*)(kp->ws + OFF_XM); u16* xc = (u16*)(kp->ws + OFF_XC);
    const int T0 = b * TPB + ci * 64, tlo = b * TPB + (ci < 4 ? 0 : CTX), thi = b * TPB + (ci < 4 ? CTX - 1 : TPB - 1);
    const int ch0 = hd * DH + lane * 8;
    LAS u16* QS = (LAS u16*)lds; LAS u16* KS = (LAS u16*)(lds + 66560);
    const float* cw = kp->in[I_MLCW] + (size_t)j * 3 * INNER; const float* cb = kp->in[I_MLCB] + (size_t)j * INNER;
    __syncthreads();
    {
        float cwa[8], cwb[8], cwc[8], cbb[8], wq[32], wk[32];
#pragma unroll
        for (int e = 0; e < 8; ++e) { cwa[e] = cw[ch0 + e]; cwb[e] = cw[INNER + ch0 + e]; cwc[e] = cw[2 * INNER + ch0 + e]; cbb[e] = cb[ch0 + e]; }
        ldw32(kp->in[I_MLWQ] + ((size_t)j * 512 + (ch0 >> 2)) * 16, wq); ldw32(kp->in[I_MLWK] + ((size_t)j * 512 + (ch0 >> 2)) * 16, wk);
        for (int r = 0; r < 8; ++r) { const int jj = wv + 8 * r, T = T0 + jj; const u16* p = xm + (size_t)T * INNER + ch0;
            float x0[8], xa[8], xb[8], xcv[8], q[8], k[8];
            unpack8(*(const u32x4v*)p, x0);
            if (T > tlo) unpack8(*(const u32x4v*)(p - INNER), xa); else {
#pragma unroll
                for (int e = 0; e < 8; ++e) xa[e] = 0.f; }
            if (T < thi) unpack8(*(const u32x4v*)(p + INNER), xb); else {
#pragma unroll
                for (int e = 0; e < 8; ++e) xb[e] = 0.f; }
#pragma unroll
            for (int e = 0; e < 8; ++e) xcv[e] = siluf(cwa[e] * xa[e] + cwb[e] * x0[e] + cwc[e] * xb[e] + cbb[e]);
            const u32x4v xw = pack8(xcv); *(u32x4v*)(xc + (size_t)T * INNER + ch0) = xw; unpack8(xw, xcv);
            bd8(xcv, wq, q); bd8(xcv, wk, k);
            *(LAS u32x4v*)(QS + jj * 520 + lane * 8) = pack8(q); *(LAS u32x4v*)(KS + jj * 520 + lane * 8) = pack8(k); }
    }
    __syncthreads();
    const u16* wg = (const u16*)(kp->ws + OFF_WB + WB_WGT);
    const int mt = wv & 3, kh = wv >> 2;
    { f32x4 s0 = {0.f, 0.f, 0.f, 0.f}, s1 = {0.f, 0.f, 0.f, 0.f}; const int nt0 = kh * 2;
      for (int ks = 0; ks < 16; ++ks) { const bf16x8 a = *(const LAS bf16x8*)(QS + (16 * mt + fr) * 520 + 32 * ks + 8 * fq);
          const bf16x8 b0 = *(const LAS bf16x8*)(KS + (16 * nt0 + fr) * 520 + 32 * ks + 8 * fq), b1 = *(const LAS bf16x8*)(KS + (16 * (nt0 + 1) + fr) * 520 + 32 * ks + 8 * fq);
          s0 = __builtin_amdgcn_mfma_f32_16x16x32_bf16(a, b0, s0, 0, 0, 0); s1 = __builtin_amdgcn_mfma_f32_16x16x32_bf16(a, b1, s1, 0, 0, 0); }
      float* S = (float*)(kp->ws + OFF_S) + ((size_t)(b * 4 + hd) * NCH + ci) * 4096;
#pragma unroll
      for (int r = 0; r < 4; ++r) { S[(16 * mt + 4 * fq + r) * 64 + 16 * nt0 + fr] = s0[r]; S[(16 * mt + 4 * fq + r) * 64 + 16 * (nt0 + 1) + fr] = s1[r]; } }
    f32x4 ga = {0.f, 0.f, 0.f, 0.f};
    for (int ks = kh * 8; ks < kh * 8 + 8; ++ks) { const int kk = hd * DH + 32 * ks + 8 * fq;
        const bf16x8 a = *(const LAS bf16x8*)(QS + (16 * mt + fr) * 520 + 32 * ks + 8 * fq), a2 = *(const LAS bf16x8*)(KS + (16 * mt + fr) * 520 + 32 * ks + 8 * fq);
        const bf16x8 bq = *(const bf16x8*)(wg + (size_t)fr * 6144 + kk), bk = *(const bf16x8*)(wg + (size_t)fr * 6144 + INNER + kk);
        ga = __builtin_amdgcn_mfma_f32_16x16x32_bf16(a, bq, ga, 0, 0, 0); ga = __builtin_amdgcn_mfma_f32_16x16x32_bf16(a2, bk, ga, 0, 0, 0); }
    __syncthreads();
    {
        float wvv[32]; ldw32(kp->in[I_MLWV] + ((size_t)j * 512 + (ch0 >> 2)) * 16, wvv);
        for (int r = 0; r < 8; ++r) { const int jj = wv + 8 * r, T = T0 + jj; float x0[8], v[8]; unpack8(*(const u32x4v*)(xm + (size_t)T * INNER + ch0), x0); bd8(x0, wvv, v);
            *(LAS u32x4v*)(QS + jj * 520 + lane * 8) = pack8(v); }
    }
    __syncthreads();
    for (int ks = kh * 8; ks < kh * 8 + 8; ++ks) { const int kk = hd * DH + 32 * ks + 8 * fq;
        const bf16x8 a = *(const LAS bf16x8*)(QS + (16 * mt + fr) * 520 + 32 * ks + 8 * fq); const bf16x8 bv = *(const bf16x8*)(wg + (size_t)fr * 6144 + 2 * INNER + kk);
        ga = __builtin_amdgcn_mfma_f32_16x16x32_bf16(a, bv, ga, 0, 0, 0); }
    float* gates = (float*)(kp->ws + OFF_GATES);
#pragma unroll
    for (int r = 0; r < 4; ++r) atomicAdd(gates + (size_t)(T0 + 16 * mt + 4 * fq + r) * 16 + fr, ga[r]);
}

#ifndef REP_STAGE
#define REP_STAGE 1
#define REP_STILDE 1
#define REP_MFMA 1
#endif
constexpr int SC_QS = 0, SC_KT = 66560, SC_VT = 132096, SC_ST = 148480, SC_VEC = 156672;
__device__ __forceinline__ void ml_scan_task(KPC kp, int j, int task, LAS unsigned char* lds) {
    const int tid = ltid(), lane = tid & 63, wv = tid >> 6, fr = lane & 15, fq = lane >> 4;
    const int es = task & 3, dir = (task >> 2) & 1, hd = (task >> 3) & 3, b = task >> 5;
    const u16* xm = (const u16*)(kp->ws + OFF_XM); const u16* xc = (const u16*)(kp->ws + OFF_XC); const float* gates = (const float*)(kp->ws + OFF_GATES);
    const float* Sg = (const float*)(kp->ws + OFF_S) + (size_t)(b * 4 + hd) * NCH * 4096;
    u16* hf = (u16*)(kp->ws + OFF_R2);
    LAS unsigned char* QS = lds + SC_QS; LAS unsigned char* KT = lds + SC_KT; LAS unsigned char* VT = lds + SC_VT; LAS unsigned char* ST = lds + SC_ST;
    LAS float* rowterm = (LAS float*)(lds + SC_VEC); LAS float* colterm = rowterm + 64; LAS float* winter = rowterm + 128; LAS float* einv = rowterm + 192;
    LAS float* kws = rowterm + 256; LAS float* dinv = rowterm + 320; LAS float* nst = rowterm + 384; LAS float* scal = rowterm + 896;
    f32x4 C[32];
#pragma unroll
    for (int i = 0; i < 32; ++i) C[i] = (f32x4){0.f, 0.f, 0.f, 0.f};
    float m_st = 0.f;
    __syncthreads();
    nst[tid] = 0.f;
    for (int ci = 0; ci < NCH; ++ci) {
        __syncthreads();
        const int p0 = ci * 64;
        const int tid = ltid(), lane = tid & 63, wv = tid >> 6, fr = lane & 15, fq = lane >> 4;
        asm volatile("" ::: "memory");
        auto tok = [&](int jj) -> int { const int p = p0 + jj; const int t = dir == 0 ? p : (p < CTX ? CTX - 1 - p : TPB + CTX - 1 - p); return b * TPB + t; };
        float sv[8];
        { const int jj = tid >> 3, s8 = (tid & 7) * 8;
            if (dir == 0) { const float* sp = Sg + (size_t)ci * 4096 + jj * 64 + s8; const f32x4 v0 = *(const f32x4*)sp, v1 = *(const f32x4*)(sp + 4);
                sv[0] = v0[0]; sv[1] = v0[1]; sv[2] = v0[2]; sv[3] = v0[3]; sv[4] = v1[0]; sv[5] = v1[1]; sv[6] = v1[2]; sv[7] = v1[3]; }
            else { const int oc = ci < 4 ? 3 - ci : 135 - ci; const float* sp = Sg + (size_t)oc * 4096 + (63 - jj) * 64 + (56 - s8); const f32x4 v0 = *(const f32x4*)sp, v1 = *(const f32x4*)(sp + 4);
                sv[7] = v0[0]; sv[6] = v0[1]; sv[5] = v0[2]; sv[4] = v0[3]; sv[3] = v1[0]; sv[2] = v1[1]; sv[1] = v1[2]; sv[0] = v1[3]; }
        }
        float g_ic = 0.f, g_fp = 0.f;
        if (wv == 0) { const int Tg = tok(lane); g_ic = gates[(size_t)Tg * 16 + dir * 8 + hd]; g_fp = gates[(size_t)Tg * 16 + dir * 8 + 4 + hd]; }
        for (int rpS = 0; rpS < REP_STAGE; ++rpS) {
        const int wvu = __builtin_amdgcn_readfirstlane(wv); const int Tl = tok(lane);
        for (int r = 0; r < 8; ++r) { const int g8 = wvu + 8 * r; float x[8], q[8], Mw[32];
            const u32x4v xw = *(const u32x4v*)(xc + (size_t)Tl * INNER + hd * DH + g8 * 8); unpack8(xw, x);
            ldw32((const float*)(kp->ws + OFF_MLM) + (size_t)(hd * 128 + g8 * 2) * 16, Mw); bd8(x, Mw, q);
            *(LAS u32x4v*)(QS + lane * 1040 + g8 * 16) = pack8(q);
            const unsigned wd[4] = {xw.x, xw.y, xw.z, xw.w};
#pragma unroll
            for (int e = 0; e < 8; ++e) { const int d = g8 * 8 + e; *(LAS u16*)(KT + d * 128 + ((((lane >> 3) ^ (d & 7)) << 4) | ((lane & 7) << 1))) = (u16)((e & 1) ? (wd[e >> 1] >> 16) : (wd[e >> 1] & 0xffffu)); } }
        for (int r = 0; r < 2; ++r) { const int g = wvu + 8 * r; const int chv = hd * DH + es * 128 + g * 8; float x[8], v[8], wvv[32];
            unpack8(*(const u32x4v*)(xm + (size_t)Tl * INNER + chv), x); ldw32(kp->in[I_MLWV] + ((size_t)j * 512 + (chv >> 2)) * 16, wvv); bd8(x, wvv, v);
#pragma unroll
            for (int e = 0; e < 8; ++e) { const int ee = g * 8 + e; *(LAS u16*)(VT + ee * 128 + ((((lane >> 3) ^ (ee & 7)) << 4) | ((lane & 7) << 1))) = f2bf(v[e]); } }
        }
        if (wv == 0) {
            const float ic = g_ic, fp = g_fp;
            const float lf = fminf(fp, 0.f) - log1pf(__expf(-fabsf(fp)));
            float bb = lf;
#pragma unroll
            for (int o = 1; o < 64; o <<= 1) { const float t = lshfl(bb, lane - o); if (lane >= o) bb += t; }
            const float uu = ic - bb; float pm = uu;
#pragma unroll
            for (int o = 1; o < 64; o <<= 1) { const float t = lshfl(pm, lane - o); if (lane >= o) pm = fmaxf(pm, t); }
            const float a = bb + m_st, mj = fmaxf(a, bb + pm);
            rowterm[lane] = bb - mj; colterm[lane] = uu; winter[lane] = __expf(a - mj); einv[lane] = __expf(-mj);
            const float blast = lshfl(bb, 63), gs = blast - bb + ic, gmax = wave_max(gs), mnew = fmaxf(blast + m_st, gmax);
            kws[lane] = __expf(gs - mnew);
            if (lane == 0) { scal[0] = __expf(blast + m_st - mnew); scal[1] = mnew; }
        }
        __syncthreads();
        for (int rpT = 0; rpT < REP_STILDE; ++rpT) {
            const int jj = tid >> 3, sub = tid & 7, s8 = sub * 8;
            const float rt = rowterm[jj]; float rsum = 0.f;
#pragma unroll
            for (int e = 0; e < 8; ++e) { const int s = s8 + e; const float w = s <= jj ? sv[e] * 0.04419417382415922f * __expf(rt + colterm[s]) : 0.f; sv[e] = w; rsum += w; }
            *(LAS u32x4v*)(ST + jj * 128 + ((sub ^ (jj & 7)) << 4)) = pack8(sv);
            float qd = 0.f;
#pragma unroll
            for (int c8 = 0; c8 < 8; ++c8) { float qv[8]; unpack8(*(const LAS u32x4v*)(QS + jj * 1040 + (sub * 8 + c8) * 16), qv);
#pragma unroll
                for (int e = 0; e < 8; ++e) qd += qv[e] * nst[sub * 64 + c8 * 8 + e]; }
            rsum += lshfl(rsum, lane ^ 1); rsum += lshfl(rsum, lane ^ 2); rsum += lshfl(rsum, lane ^ 4);
            qd += lshfl(qd, lane ^ 1); qd += lshfl(qd, lane ^ 2); qd += lshfl(qd, lane ^ 4);
            if (sub == 0) { const float qn = winter[jj] * qd + rsum; dinv[jj] = 1.0f / fmaxf(fabsf(qn), einv[jj]); }
        }
        __syncthreads();
        {
            f32x4 o[4];
            const int el = 16 * wv + fr;
            bf16x8 vfr[2];
            for (int rpM = 0; rpM < REP_MFMA; ++rpM) {
#pragma unroll
            for (int mt = 0; mt < 4; ++mt) o[mt] = (f32x4){0.f, 0.f, 0.f, 0.f};
#pragma unroll
            for (int ks = 0; ks < 16; ++ks) {
                u32x4v bw; bw.x = pg8::cvt_pk_bf16(C[2 * ks][0], C[2 * ks][1]); bw.y = pg8::cvt_pk_bf16(C[2 * ks][2], C[2 * ks][3]);
                bw.z = pg8::cvt_pk_bf16(C[2 * ks + 1][0], C[2 * ks + 1][1]); bw.w = pg8::cvt_pk_bf16(C[2 * ks + 1][2], C[2 * ks + 1][3]);
                const bf16x8 bfr = __builtin_bit_cast(bf16x8, bw);
#pragma unroll
                for (int mt = 0; mt < 4; ++mt) { const int off = (16 * mt + fr) * 1040 + 8 * fq;
                    const u32x2 lo = *(const LAS u32x2*)(QS + off + 64 * ks), hi = *(const LAS u32x2*)(QS + off + 64 * ks + 32);
                    u32x4v aw; aw.x = lo.x; aw.y = lo.y; aw.z = hi.x; aw.w = hi.y;
                    o[mt] = __builtin_amdgcn_mfma_f32_16x16x32_bf16(__builtin_bit_cast(bf16x8, aw), bfr, o[mt], 0, 0, 0); }
                if ((ks & 1) == 1) __builtin_amdgcn_sched_barrier(0); }
#pragma unroll
            for (int mt = 0; mt < 4; ++mt)
#pragma unroll
                for (int r = 0; r < 4; ++r) o[mt][r] *= winter[16 * mt + 4 * fq + r];
#pragma unroll
            for (int k2 = 0; k2 < 2; ++k2) { vfr[k2] = *(const LAS bf16x8*)(VT + el * 128 + (((4 * k2 + fq) ^ (el & 7)) << 4));
#pragma unroll
                for (int mt = 0; mt < 4; ++mt) { const int jr = 16 * mt + fr; const bf16x8 a = *(const LAS bf16x8*)(ST + jr * 128 + (((4 * k2 + fq) ^ (jr & 7)) << 4));
                    o[mt] = __builtin_amdgcn_mfma_f32_16x16x32_bf16(a, vfr[k2], o[mt], 0, 0, 0); } }
            }
#pragma unroll
            for (int mt = 0; mt < 4; ++mt)
#pragma unroll
                for (int r = 0; r < 4; ++r) { const int jr = 16 * mt + 4 * fq + r, T = tok(jr); const float hv = o[mt][r] * dinv[jr];
                    u16* dst = dir == 0 ? hf + (size_t)T * INNER : hb_ptr(kp, T); dst[hd * DH + es * 128 + el] = f2bf(hv); }
            const float decay = scal[0];
#pragma unroll
            for (int i = 0; i < 32; ++i) C[i] = C[i] * decay;
#pragma unroll
            for (int k2 = 0; k2 < 2; ++k2) { float vv[8]; unpack8(__builtin_bit_cast(u32x4v, vfr[k2]), vv);
#pragma unroll
                for (int e = 0; e < 8; ++e) vv[e] *= kws[32 * k2 + 8 * fq + e];
                const bf16x8 bsc = __builtin_bit_cast(bf16x8, pack8(vv));
#pragma unroll
                for (int dt = 0; dt < 32; ++dt) { const int dr = 16 * dt + fr; const bf16x8 a = *(const LAS bf16x8*)(KT + dr * 128 + (((4 * k2 + fq) ^ (dr & 7)) << 4));
                    C[dt] = __builtin_amdgcn_mfma_f32_16x16x32_bf16(a, bsc, C[dt], 0, 0, 0);
                    if ((dt & 7) == 7) __builtin_amdgcn_sched_barrier(0); } }
            { float nn = decay * nst[tid];
#pragma unroll
              for (int g = 0; g < 8; ++g) { float kv[8]; unpack8(*(const LAS u32x4v*)(KT + tid * 128 + ((g ^ (tid & 7)) << 4)), kv);
#pragma unroll
                  for (int e = 0; e < 8; ++e) nn += kv[e] * kws[8 * g + e]; }
              nst[tid] = nn; }
            m_st = scal[1];
        }
    }
}

__device__ __forceinline__ void ml_gate_phase(KPC kp, int j) {
    u16* hf = (u16*)(kp->ws + OFF_R2); const u16* xc = (const u16*)(kp->ws + OFF_XC); const u16* z = (const u16*)(kp->ws + OFF_XM);
    const float* ng = kp->in[I_MLNG] + (size_t)j * INNER; const float* sk = kp->in[I_MLSKIP] + (size_t)j * INNER;
    const int lane = ltid() & 63, wv = ltid() >> 6;
    for (int T = lbid() * 8 + wv; T < NTOK; T += gridDim.x * 8) {
        const u16* hbp = hb_ptr(kp, T);
#pragma unroll
        for (int hd = 0; hd < 4; ++hd) { const int c0 = hd * DH + lane * 8; float a[8], bq[8], xv[8], zv[8], o[8];
            unpack8(*(const u32x4v*)(hf + (size_t)T * INNER + c0), a); unpack8(*(const u32x4v*)(hbp + c0), bq);
            float s = 0.f;
#pragma unroll
            for (int e = 0; e < 8; ++e) { a[e] += bq[e]; s += a[e]; }
            const float mu = wave_sum(s) * (1.0f / DH); float vs = 0.f;
#pragma unroll
            for (int e = 0; e < 8; ++e) { a[e] -= mu; vs += a[e] * a[e]; }
            const float rs = rsqrtf(wave_sum(vs) * (1.0f / DH) + 1e-5f);
            unpack8(*(const u32x4v*)(xc + (size_t)T * INNER + c0), xv); unpack8(*(const u32x4v*)(z + (size_t)T * INNER + c0), zv);
#pragma unroll
            for (int e = 0; e < 8; ++e) o[e] = (a[e] * rs * ng[c0 + e] + sk[c0 + e] * xv[e]) * siluf(zv[e]);
            *(u32x4v*)(hf + (size_t)T * INNER + c0) = pack8(o); }
    }
}


enum { K_SETUP = 0, K_CN, K_G1, K_G2R, K_HYIN, K_HYCONV, K_HYTR, K_MLUPX, K_MLPREP, K_MLSCAN, K_MLUPZ, K_MLGATE, K_FINAL };
constexpr int NPHASE = 1 + 11 + 13 + 11 + 13 + 1;
__device__ __forceinline__ void decode_phase(int ph, int& kind, int& l, int& arg) {
    kind = K_SETUP; l = 0; arg = 0; if (ph == 0) return;
    ph -= 1;
    for (l = 0; l < 4; ++l) { const int n = (l & 1) ? 13 : 11; if (ph < n) break; ph -= n; }
    if (l == 4) { kind = K_FINAL; l = 0; return; }
    if (ph == 0) { kind = K_CN; arg = 0; return; } if (ph == 1) { kind = K_G1; arg = 0; return; } if (ph == 2) { kind = K_G2R; arg = 0; return; } if (ph == 3) { kind = K_CN; arg = 1; return; }
    const int nm = (l & 1) ? 6 : 4;
    if (ph < 4 + nm) { const int q = ph - 4;
        if (l & 1) { kind = q == 0 ? K_MLUPX : q == 1 ? K_MLPREP : q == 2 ? K_MLSCAN : q == 3 ? K_MLUPZ : q == 4 ? K_MLGATE : K_G2R; arg = 2; }
        else { kind = q == 0 ? K_HYIN : q == 1 ? K_HYCONV : q == 2 ? K_HYTR : K_G2R; arg = 2; }
        return; }
    ph -= 4 + nm;
    if (ph == 0) { kind = K_CN; arg = 2; return; } if (ph == 1) { kind = K_G1; arg = 1; return; } kind = K_G2R; arg = 1;
}

#ifndef REPMASK
#define REPMASK 0
#define REPN 1
#endif
template <int MIX> __device__ __forceinline__ void run_phases(int lo, int hi, int ph_lo, int ph_hi, LAS unsigned char* lds0, cg::grid_group& grid) {
    lo = lo > ph_lo ? lo : ph_lo; hi = hi < ph_hi ? hi : ph_hi;
    for (int ph = lo; ph < hi; ++ph) {
        KPC kp = (KPC)__builtin_amdgcn_kernarg_segment_ptr(); asm volatile("" : "+s"(kp) :: "memory");
        LAS unsigned char* lds = lds0; asm volatile("" : "+s"(lds) :: "memory");
        unsigned char* ws = kp->ws; unsigned char* wb = ws + OFF_WB;
        int kind, l, arg; decode_phase(ph, kind, l, arg); const int j = l >> 1;
        const float* modl = (const float*)(ws + OFF_MOD) + (size_t)l * 5 * 9216;
        const int nrep = ((REPMASK >> kind) & 1) ? REPN : 1;
        for (int rep = 0; rep < nrep; ++rep) {
        if (kind == K_SETUP) { if constexpr (MIX == 0) setup_phase(kp, (LAS float*)lds); }
        else if (kind == K_CN) {
            if (arg == 0) { convert_layer(kp, l, (LAS float*)lds); if constexpr (MIX == 1) ml_m_phase(kp, j); }
            if constexpr (MIX == 0) { if (arg == 1) hy_mlp_phase(kp, j); }
            norm_phase(kp, l, arg);
        } else if (kind == K_G1) {
            pg8::Gemm g{(const u16*)(ws + OFF_U), (const u16*)(wb + (arg ? WB_FIN1 : WB_FIN0)), NTOK, 2 * FF, D};
            pg8::StaticOrder S; S.init(g.M, g.N, (int)gridDim.x, lbid()); EpiSwiglu E{(u16*)(ws + OFF_R1)};
            pg8::gemm_phase<EpiSwiglu, pg8::StaticOrder, false>(lds, g, S, E, nullptr);
        } else if (kind == K_G2R) {
            pg8::Gemm g; EpiResid E; E.h = (float*)(ws + OFF_H); E.modl = modl;
            if (arg < 2) { g = pg8::Gemm{(const u16*)(ws + OFF_R1), (const u16*)(wb + (arg ? WB_FOUT1 : WB_FOUT0)), NTOK, D, FF}; E.gidx = arg ? 8 : 2; E.scale = 0.5f; E.bias = nullptr; }
            else if (MIX == 1) { g = pg8::Gemm{(const u16*)(ws + OFF_R2), (const u16*)(wb + WB_MOUT), NTOK, D, INNER}; E.gidx = 5; E.scale = 1.0f; E.bias = nullptr; }
            else { g = pg8::Gemm{(const u16*)(ws + OFF_U), (const u16*)(wb + WB_MOUT), NTOK, D, D}; E.gidx = 5; E.scale = 1.0f; E.bias = kp->in[I_HYBOUT] + (size_t)j * D; }
            pg8::StaticOrder S; S.init(g.M, g.N, (int)gridDim.x, lbid());
            pg8::gemm_phase<EpiResid, pg8::StaticOrder, false>(lds, g, S, E, nullptr);
        } else if (kind == K_FINAL) { if constexpr (MIX == 1) final_phase(kp); }
        else if constexpr (MIX == 0) {
            if (kind == K_HYIN) {
                pg8::Gemm g{(const u16*)(wb + WB_MIN), (const u16*)(ws + OFF_U), 3 * D, NTOK, D};
                pg8::StaticOrder S; S.init(g.M, g.N, (int)gridDim.x, lbid());
                EpiProjT E{(u16*)(ws + OFF_R1 + HY_PL), (u16*)(ws + OFF_R1 + HY_PC), kp->in[I_HYBIN] + (size_t)j * 3 * D};
                pg8::gemm_phase<EpiProjT, pg8::StaticOrder, false>(lds, g, S, E, nullptr);
                __syncthreads();
                for (int t = lbid(); t < 2048; t += gridDim.x) hy_filter_task(kp, j, t, (LAS f32x2*)lds, (LAS float*)(lds + 131072));
            } else if (kind == K_HYCONV) {
                for (int t = lbid(); t < 2048; t += gridDim.x) hy_conv_lat(kp, j, t, (LAS f32x2*)lds);
                for (int t = lbid(); t < 1024; t += gridDim.x) hy_conv_ctx(kp, j, t, (LAS float*)lds);
            } else if (kind == K_HYTR) hy_transpose(kp, (LAS u16*)lds);
        } else {
            if (kind == K_MLUPX || kind == K_MLUPZ) {
                const bool zz = kind == K_MLUPZ;
                pg8::Gemm g{(const u16*)(ws + OFF_U), (const u16*)(wb + WB_MIN) + (zz ? (size_t)INNER * D : 0), NTOK, INNER, D};
                pg8::StaticOrder S; S.init(g.M, g.N, (int)gridDim.x, lbid()); EpiBf E{(u16*)(ws + OFF_XM), INNER};
                pg8::gemm_phase<EpiBf, pg8::StaticOrder, false>(lds, g, S, E, nullptr);
            } else if (kind == K_MLPREP) { for (int t = lbid(); t < NB * NCH * 4; t += gridDim.x) ml_prep_task(kp, j, t, lds); }
            else if (kind == K_MLSCAN) { for (int t = lbid(); t < 128; t += gridDim.x) ml_scan_task(kp, j, t, lds); }
            else if (kind == K_MLGATE) ml_gate_phase(kp, j);
        }
        }
        if (ph + 1 < ph_hi) grid.sync();
    }
}

__global__ void __launch_bounds__(512) fwd_megakernel(KP kparg) {
    extern __shared__ __attribute__((aligned(16))) unsigned char shm[];
    LAS unsigned char* lds = (LAS unsigned char*)shm;
    cg::grid_group grid = cg::this_grid();
    wtab_init();
    const int ph_lo = kparg.ph_lo, ph_hi = kparg.ph_hi;
    run_phases<0>(0, 12, ph_lo, ph_hi, lds, grid);
    run_phases<1>(12, 25, ph_lo, ph_hi, lds, grid);
    run_phases<0>(25, 36, ph_lo, ph_hi, lds, grid);
    run_phases<1>(36, 50, ph_lo, ph_hi, lds, grid);
}

extern "C" void kernel_launch(void* const* d_in, const int* in_sizes, int n_in, void* d_out, int out_size, void* d_ws, size_t ws_size, hipStream_t stream) {
    static int grid_blocks = 0;
    if (!grid_blocks) {
        int dev = 0, cus = 0, per_cu = 0;
        hipGetDevice(&dev);
        hipDeviceGetAttribute(&cus, hipDeviceAttributeMultiprocessorCount, dev);
        hipFuncSetAttribute((const void*)fwd_megakernel, hipFuncAttributeMaxDynamicSharedMemorySize, LDS_BYTES);
        hipOccupancyMaxActiveBlocksPerMultiprocessor(&per_cu, fwd_megakernel, 512, LDS_BYTES);
        if (per_cu < 1) per_cu = 1;
        grid_blocks = cus * 1;
        if (ws_size < WS_NEED2) fprintf(stderr, "workspace too small: %zu < %zu\n", ws_size, (size_t)WS_NEED2);
    }
    KP hp{};
    for (int i = 0; i < 36; ++i) hp.in[i] = (const float*)d_in[i];
    hp.out = (float*)d_out; hp.ws = (unsigned char*)d_ws; hp.ph_lo = 0; hp.ph_hi = NPHASE;
    void* args[] = {&hp};
    hipError_t e = hipLaunchCooperativeKernel((void*)fwd_megakernel, dim3(grid_blocks), dim3(512), args, LDS_BYTES, stream);
    if (e != hipSuccess) fprintf(stderr, "cooperative launch failed: %s (grid %d)\n", hipGetErrorString(e), grid_blocks);
}
```

```cpp
#define REPMASK 0
#define REPN 1
#include <hip/hip_runtime.h>
#include <hip/hip_cooperative_groups.h>
#include <cstdio>
namespace cg = cooperative_groups;
#define WTAB_OFF 163584
__device__ __forceinline__ int llane() { int l; asm volatile("v_mbcnt_lo_u32_b32 %0, -1, 0\n\tv_mbcnt_hi_u32_b32 %0, -1, %0" : "=v"(l) :: "memory"); return l; }
__device__ __forceinline__ int lwave() { extern __shared__ __attribute__((aligned(16))) unsigned char shm_w[];
    const int hw = __builtin_amdgcn_s_getreg(10244) & 63;
    return __builtin_amdgcn_readfirstlane(*(const __attribute__((address_space(3))) int*)((__attribute__((address_space(3))) unsigned char*)shm_w + WTAB_OFF + hw * 4)); }
__device__ __forceinline__ void wtab_init() { extern __shared__ __attribute__((aligned(16))) unsigned char shm_w[];
    const int hw = __builtin_amdgcn_s_getreg(10244) & 63;
    *(__attribute__((address_space(3))) int*)((__attribute__((address_space(3))) unsigned char*)shm_w + WTAB_OFF + hw * 4) = (int)(threadIdx.x >> 6); }
__device__ __forceinline__ int ltid() { return lwave() * 64 + llane(); }
__device__ __forceinline__ int lbid() { int t = blockIdx.x; asm volatile("" : "+s"(t) :: "memory"); return t; }
namespace pg8 {
#define PG8_LAS __attribute__((address_space(3)))
typedef unsigned short bf16_t;
typedef short bf16x8 __attribute__((ext_vector_type(8)));
typedef float f32x4 __attribute__((ext_vector_type(4)));
typedef unsigned u32x4 __attribute__((ext_vector_type(4)));
constexpr int BM = 256, BK = 64, HALF = 128, HTB = HALF * BK * 2  , STAGE_BYTES = 8 * HTB, NXCD = 8, WGM = 8;

__host__ __device__ __forceinline__ int lds_byte(int r, int c) { const int st = (r >> 4) * 2 + (c >> 5), rr = r & 15, cc = c & 31, ob = rr * 64 + cc * 2; return st * 1024 + (ob ^ (((ob >> 9) & 1) << 5)); }
__host__ __device__ __forceinline__ void stage_rc(int b, int& R, int& C) { const int st = b / 1024, sb = b % 1024, swz = sb ^ (((sb >> 9) & 1) << 5); R = (st >> 1) * 16 + swz / 64; C = (st & 1) * 32 + (swz % 64) / 2; }
__host__ __device__ __forceinline__ int perm32(int rho) { const int n = rho >> 4, i = rho & 15; return 8 * (i >> 2) + 4 * n + (i & 3); }

struct Unit { int pm, pn, kofs; };
struct Gemm { const bf16_t* A; const bf16_t* Bt; int M, N, K, ldk; };

struct StaticOrder {
    int nM, nN, nwg, G, c;
    __host__ __device__ void init(int M, int N, int G_, int c_) { nM = M / BM; nN = N / BM; nwg = nM * nN; G = G_; c = c_; }
    __host__ __device__ bool next(int i, Unit& u) const {
        const long L = (long)i * G + c; if (L >= nwg) return false;
        int wgid = (int)L; { const int q = nwg / NXCD, r = nwg % NXCD, xcd = wgid % NXCD, off = wgid / NXCD; wgid = (xcd < r ? xcd * (q + 1) : r * (q + 1) + (xcd - r) * q) + off; }
        const int nig = WGM * nN, gid = wgid / nig, fm = gid * WGM, gsz = (nM - fm) < WGM ? (nM - fm) : WGM;
        u.pm = fm + ((wgid % nig) % gsz); u.pn = (wgid % nig) / gsz; u.kofs = 0; return true;
    }
    __device__ __forceinline__ void a_ready(const Unit&) const {}
    __device__ __forceinline__ void done(const Unit&) const {}
};
__device__ __forceinline__ unsigned cvt_pk_bf16(float lo, float hi) { unsigned r; asm volatile("v_cvt_pk_bf16_f32 %0, %1, %2" : "=v"(r) : "v"(lo), "v"(hi)); return r; }
template <class Epi, class Sched, bool STAMP = false>
__device__ __forceinline__ void gemm_phase(PG8_LAS unsigned char* lds, const Gemm g, const Sched& S, const Epi& E, unsigned long long* stamps) {
    const int tid = ltid(), wid = __builtin_amdgcn_readfirstlane(tid >> 6), lane = tid & 63, wr = wid >> 2, wc = wid & 3, fr = lane & 15, fq = lane >> 4;
    const int K = g.K, nt = K / BK, ldk = g.ldk ? g.ldk : g.K;
    int ts_lo = 0, ts_hi = 0, nts = 0; const unsigned long long rt_entry = STAMP ? (unsigned long long)wall_clock64() : 0ull;
#define PG8_STAMP() do { if (STAMP && wid == 0 && nts < 64) { const unsigned long long _c = (unsigned long long)clock64(); \
        ts_lo = (lane == nts) ? (int)(unsigned)_c : ts_lo; ts_hi = (lane == nts) ? (int)(unsigned)(_c >> 32) : ts_hi; ++nts; } } while (0)
    PG8_STAMP();
    unsigned voffA[2], voffB[2];
#pragma unroll
    for (int i = 0; i < 2; ++i) { int R, C; stage_rc(tid * 16 + i * 8192, R, C); const int Rb = Epi::PERM ? ((R & ~31) + perm32(R & 31)) : R;
        voffA[i] = (unsigned)(R * ldk + C) * 2u; voffB[i] = (unsigned)(Rb * ldk + C) * 2u; }
    const size_t kstep = (size_t)(BK * 2);
    const size_t hstep = (size_t)HALF * ldk * 2;
    const size_t tstep = 2 * hstep;
    const unsigned ldsw = (unsigned)wid * 1024u;
    const int aoff = lds_byte(wr * 64 + fr, fq * 8), boff = lds_byte(wc * 32 + fr, fq * 8);
#define PG8_SA(b, h) (((b) * 2 + (h)) * HTB)
#define PG8_SB(b, h) ((4 + (b) * 2 + (h)) * HTB)
#define PG8_STAGE(bufoff, gbase, voff) do { _Pragma("unroll") for (int _i = 0; _i < 2; ++_i) \
        __builtin_amdgcn_global_load_lds((const unsigned*)((const char*)(gbase) + (voff)[_i]), (PG8_LAS unsigned*)(lds + (bufoff) + ldsw + _i * 8192), 16, 0, 0); } while (0)
#define PG8_LDA(dst, b, h) do { _Pragma("unroll") for (int m = 0; m < 4; ++m) _Pragma("unroll") for (int k = 0; k < 2; ++k) dst[m][k] = *(const PG8_LAS bf16x8*)(lds + PG8_SA(b, h) + aoff + m * 2048 + k * 1024); } while (0)
#define PG8_LDB(dst, b, h) do { _Pragma("unroll") for (int n = 0; n < 2; ++n) _Pragma("unroll") for (int k = 0; k < 2; ++k) dst[n][k] = *(const PG8_LAS bf16x8*)(lds + PG8_SB(b, h) + boff + n * 2048 + k * 1024); } while (0)
#define PG8_MMA(ai, bj, At, Bt) do { __builtin_amdgcn_s_setprio(1); _Pragma("unroll") for (int m = 0; m < 4; ++m) _Pragma("unroll") for (int n = 0; n < 2; ++n) _Pragma("unroll") for (int k = 0; k < 2; ++k) \
        acc[ai][bj][m][n] = __builtin_amdgcn_mfma_f32_16x16x32_bf16(Bt[n][k], At[m][k], acc[ai][bj][m][n], 0, 0, 0); __builtin_amdgcn_s_setprio(0); } while (0)
#define PG8_WAIT_V(n) asm volatile("s_waitcnt vmcnt(" #n ")" ::: "memory")
#define PG8_WAIT_L(n) asm volatile("s_waitcnt lgkmcnt(" #n ")" ::: "memory")
#define PG8_BAR __builtin_amdgcn_s_barrier()
#define PG8_SCHED __builtin_amdgcn_sched_barrier(0)
    Unit cur, nxt; int ui = 0;
    if (!S.next(0, cur)) return;
    f32x4 acc[2][2][4][2];
#pragma unroll
    for (int a = 0; a < 2; ++a)
#pragma unroll
        for (int b = 0; b < 2; ++b)
#pragma unroll
            for (int m = 0; m < 4; ++m)
#pragma unroll
                for (int n = 0; n < 2; ++n) acc[a][b][m][n] = (f32x4){0.f, 0.f, 0.f, 0.f};
    bf16x8 At[4][2], B0[2][2], B1[2][2];
    const char* cA = (const char*)g.A + (size_t)cur.pm * tstep + (size_t)cur.kofs * 2; const char* cB = (const char*)g.Bt + (size_t)cur.pn * tstep + (size_t)cur.kofs * 2;
    S.a_ready(cur);
    PG8_STAGE(PG8_SB(0, 0), cB, voffB); PG8_STAGE(PG8_SA(0, 0), cA, voffA); PG8_STAGE(PG8_SB(0, 1), cB + hstep, voffB); PG8_STAGE(PG8_SA(0, 1), cA + hstep, voffA);
    if (wr == 1) PG8_BAR;
    PG8_WAIT_V(4); PG8_BAR;
    PG8_STAGE(PG8_SB(1, 0), cB + kstep, voffB); PG8_STAGE(PG8_SA(1, 0), cA + kstep, voffA); PG8_STAGE(PG8_SB(1, 1), cB + hstep + kstep, voffB);
    PG8_WAIT_V(6); PG8_BAR;
    PG8_STAMP();
    for (;;) {
        const bool has_next = S.next(ui + 1, nxt);
        const char* nA = has_next ? (const char*)g.A + (size_t)nxt.pm * tstep + (size_t)nxt.kofs * 2 : cA; const char* nB = has_next ? (const char*)g.Bt + (size_t)nxt.pn * tstep + (size_t)nxt.kofs * 2 : cB;
        for (int t = 0; t < nt; t += 2) {
            const bool last = (t == nt - 2);
            const char* a1 = cA + (size_t)(t + 1) * kstep;
            const char* a2 = last ? nA : cA + (size_t)(t + 2) * kstep; const char* b2 = last ? nB : cB + (size_t)(t + 2) * kstep;
            const char* a3 = a2 + kstep; const char* b3 = b2 + kstep;
            if (last && has_next) S.a_ready(nxt);
            PG8_LDB(B0, 0, 0); PG8_SCHED; PG8_LDA(At, 0, 0); PG8_STAGE(PG8_SA(1, 1), a1 + hstep, voffA);
            PG8_WAIT_L(8); PG8_BAR; PG8_WAIT_L(0); PG8_MMA(0, 0, At, B0); PG8_BAR; PG8_SCHED;
            PG8_LDB(B1, 0, 1); PG8_STAGE(PG8_SB(0, 0), b2, voffB);
            PG8_BAR; PG8_WAIT_L(0); PG8_MMA(0, 1, At, B1); PG8_BAR;
            PG8_LDA(At, 0, 1); PG8_STAGE(PG8_SA(0, 0), a2, voffA);
            PG8_BAR; PG8_WAIT_L(0); PG8_MMA(1, 0, At, B0); PG8_BAR; PG8_SCHED;
            PG8_STAGE(PG8_SB(0, 1), b2 + hstep, voffB);
            PG8_WAIT_V(6); PG8_BAR; PG8_MMA(1, 1, At, B1); PG8_BAR;
            PG8_LDB(B0, 1, 0); PG8_SCHED; PG8_LDA(At, 1, 0); PG8_STAGE(PG8_SA(0, 1), a2 + hstep, voffA);
            PG8_WAIT_L(8); PG8_BAR; PG8_WAIT_L(0); PG8_MMA(0, 0, At, B0); PG8_BAR; PG8_SCHED;
            PG8_LDB(B1, 1, 1); PG8_STAGE(PG8_SB(1, 0), b3, voffB);
            PG8_BAR; PG8_WAIT_L(0); PG8_MMA(0, 1, At, B1); PG8_BAR;
            PG8_LDA(At, 1, 1); PG8_STAGE(PG8_SA(1, 0), a3, voffA);
            PG8_BAR; PG8_WAIT_L(0); PG8_MMA(1, 0, At, B0); PG8_BAR; PG8_SCHED;
            PG8_STAGE(PG8_SB(1, 1), b3 + hstep, voffB);
            PG8_WAIT_V(6); PG8_BAR; PG8_MMA(1, 1, At, B1); PG8_BAR;
        }
        PG8_STAMP();
        if constexpr (!Epi::AFTER_DRAIN) { E(acc, cur, wr, wc, fr, fq); S.done(cur); }
        PG8_STAMP();
        if (!has_next) break;
#pragma unroll
        for (int a = 0; a < 2; ++a)
#pragma unroll
            for (int b = 0; b < 2; ++b)
#pragma unroll
                for (int m = 0; m < 4; ++m)
#pragma unroll
                    for (int n = 0; n < 2; ++n) acc[a][b][m][n] = (f32x4){0.f, 0.f, 0.f, 0.f};
        cur = nxt; cA = nA; cB = nB; ++ui;
    }
    PG8_WAIT_V(0);
    if (wr == 0) PG8_BAR;
    PG8_BAR;
    if constexpr (Epi::AFTER_DRAIN) { E.fused(acc, cur, wr, wc, fr, fq, lds, wid, lane); S.done(cur); }
    PG8_STAMP();
    if (STAMP && wid == 0) { stamps[lane] = lane < nts ? (((unsigned long long)(unsigned)ts_hi << 32) | (unsigned)ts_lo) : 0ull;
        if (lane == 62) stamps[62] = rt_entry; if (lane == 63) stamps[63] = (unsigned long long)wall_clock64(); }
#undef PG8_STAMP
#undef PG8_SA
#undef PG8_SB
#undef PG8_STAGE
#undef PG8_LDA
#undef PG8_LDB
#undef PG8_MMA
#undef PG8_WAIT_V
#undef PG8_WAIT_L
#undef PG8_BAR
#undef PG8_SCHED
}
}

typedef unsigned short u16;
using pg8::f32x4; using pg8::bf16x8;
typedef float f32x2 __attribute__((ext_vector_type(2)));
typedef unsigned u32x2 __attribute__((ext_vector_type(2)));
typedef unsigned u32x4v __attribute__((ext_vector_type(4)));
typedef short s16x4 __attribute__((ext_vector_type(4)));
#define LAS __attribute__((address_space(3)))
constexpr int D = 1024, NB = 4, SEQ = 8192, CTX = 256, TPB = 8448, NTOK = 33792, FF = 2816, NCH = 132, INNER = 2048, DH = 512, NFFT = 16384;
constexpr size_t MiB = 1u << 20;
constexpr size_t OFF_WB = 0, OFF_MOD = 48 * MiB, OFF_H = 49 * MiB, OFF_U = OFF_H + 132 * MiB, OFF_R1 = OFF_U + 66 * MiB, OFF_R2 = OFF_R1 + 264 * MiB,
                 OFF_HBC = OFF_R2 + 132 * MiB, OFF_GATES = OFF_HBC + 4 * MiB, OFF_H2 = OFF_GATES + 3 * MiB, OFF_KCTX = OFF_H2 + 3 * MiB, WS_NEED = OFF_KCTX + 4 * MiB;
constexpr size_t WB_FIN0 = 0, WB_FIN1 = 11 * MiB, WB_FOUT0 = 22 * MiB, WB_FOUT1 = 22 * MiB + 5632 * 1024, WB_MIN = 33 * MiB, WB_MOUT = 41 * MiB, WB_WGT = 45 * MiB;
constexpr int LDS_BYTES = 163840;
struct KP { const float* in[36]; float* out; unsigned char* ws; int ph_lo, ph_hi; };
typedef const KP __attribute__((address_space(4))) * KPC;
enum { I_X = 0, I_C, I_CTX, I_CCTX, I_ADAW, I_ADAB, I_NORMG, I_FINALG, I_FFNIN, I_FFNOUT, I_HYWIN, I_HYBIN, I_HYCW, I_HYCB, I_HYW1, I_HYB1, I_HYW2, I_HYB2, I_HYW3, I_HYB3,
       I_HYFREQ, I_HYDECAY, I_HYSKIP, I_HYWOUT, I_HYBOUT, I_MLUP, I_MLCW, I_MLCB, I_MLWQ, I_MLWK, I_MLWV, I_MLWG, I_MLBG, I_MLNG, I_MLSKIP, I_MLDOWN };

__device__ __forceinline__ float bf2f(u16 b) { return __uint_as_float(((unsigned)b) << 16); }
__device__ __forceinline__ float bflo(unsigned w) { return __uint_as_float(w << 16); }
__device__ __forceinline__ float bfhi(unsigned w) { return __uint_as_float(w & 0xffff0000u); }
__device__ __forceinline__ u16 f2bf(float f) { return (u16)(pg8::cvt_pk_bf16(f, 0.f) & 0xffffu); }
__device__ __forceinline__ float siluf(float x) { return x / (1.0f + __expf(-x)); }
__device__ __forceinline__ int modrow_of_token(int T) { const int b = T / TPB, t = T - b * TPB; return t < CTX ? 4 : b; }
__device__ __forceinline__ float lshfl(float v, int srclane) { return __int_as_float(__builtin_amdgcn_ds_bpermute(srclane << 2, __float_as_int(v))); }
__device__ __forceinline__ float wave_sum(float v) { const int lane = llane();
#pragma unroll
    for (int o = 32; o > 0; o >>= 1) v += lshfl(v, lane ^ o);
    return v; }
__device__ __forceinline__ float wave_max(float v) { const int lane = llane();
#pragma unroll
    for (int o = 32; o > 0; o >>= 1) v = fmaxf(v, lshfl(v, lane ^ o));
    return v; }

struct EpiSwiglu {
    static constexpr bool PERM = true, AFTER_DRAIN = false;
    u16* act;
    __device__ __forceinline__ void operator()(const f32x4 (&acc)[2][2][4][2], const pg8::Unit& u, int wr, int wc, int fr, int fq) const {
        const int row0 = u.pm * 256 + wr * 64 + fr, col0 = u.pn * 128 + wc * 32 + 8 * fq;
#pragma unroll
        for (int ai = 0; ai < 2; ++ai)
#pragma unroll
            for (int m = 0; m < 4; ++m) {
                const f32x4 g0 = acc[ai][0][m][0], g1 = acc[ai][0][m][1], v0 = acc[ai][1][m][0], v1 = acc[ai][1][m][1];
                u32x4v w;
                w.x = pg8::cvt_pk_bf16(siluf(g0[0]) * v0[0], siluf(g0[1]) * v0[1]); w.y = pg8::cvt_pk_bf16(siluf(g0[2]) * v0[2], siluf(g0[3]) * v0[3]);
                w.z = pg8::cvt_pk_bf16(siluf(g1[0]) * v1[0], siluf(g1[1]) * v1[1]); w.w = pg8::cvt_pk_bf16(siluf(g1[2]) * v1[2], siluf(g1[3]) * v1[3]);
                *(u32x4v*)(act + (size_t)(row0 + ai * 128 + m * 16) * FF + col0) = w; }
    }
};
struct EpiResid {
    static constexpr bool PERM = false, AFTER_DRAIN = false;
    float* h; const float* modl; int gidx; float scale; const float* bias;
    __device__ __forceinline__ void operator()(const f32x4 (&acc)[2][2][4][2], const pg8::Unit& u, int wr, int wc, int fr, int fq) const {
        const int row0 = u.pm * 256 + wr * 64 + fr, col0 = u.pn * 256 + wc * 32 + 4 * fq;
        const int mr = modrow_of_token(u.pm * 256);
        const float* gp = modl + (size_t)mr * 9216 + gidx * 1024;
        f32x4 gv[2][2], bv[2][2];
#pragma unroll
        for (int bj = 0; bj < 2; ++bj)
#pragma unroll
            for (int n = 0; n < 2; ++n) { gv[bj][n] = *(const f32x4*)(gp + col0 + bj * 128 + n * 16) * scale;
                bv[bj][n] = bias ? *(const f32x4*)(bias + col0 + bj * 128 + n * 16) : (f32x4){0.f, 0.f, 0.f, 0.f}; }
#pragma unroll
        for (int ai = 0; ai < 2; ++ai)
#pragma unroll
            for (int m = 0; m < 4; ++m) { float* rowp = h + (size_t)(row0 + ai * 128 + m * 16) * D + col0;
#pragma unroll
                for (int bj = 0; bj < 2; ++bj)
#pragma unroll
                    for (int n = 0; n < 2; ++n) { f32x4* q = (f32x4*)(rowp + bj * 128 + n * 16); *q = *q + gv[bj][n] * (acc[ai][bj][m][n] + bv[bj][n]); } }
    }
};
struct EpiBf {
    static constexpr bool PERM = true, AFTER_DRAIN = false;
    u16* O; int ldc;
    __device__ __forceinline__ void operator()(const f32x4 (&acc)[2][2][4][2], const pg8::Unit& u, int wr, int wc, int fr, int fq) const {
        const int row0 = u.pm * 256 + wr * 64 + fr, col0 = u.pn * 256 + wc * 32 + 8 * fq;
#pragma unroll
        for (int ai = 0; ai < 2; ++ai)
#pragma unroll
            for (int m = 0; m < 4; ++m)
#pragma unroll
                for (int bj = 0; bj < 2; ++bj) { const f32x4 a = acc[ai][bj][m][0], b = acc[ai][bj][m][1]; u32x4v w;
                    w.x = pg8::cvt_pk_bf16(a[0], a[1]); w.y = pg8::cvt_pk_bf16(a[2], a[3]); w.z = pg8::cvt_pk_bf16(b[0], b[1]); w.w = pg8::cvt_pk_bf16(b[2], b[3]);
                    *(u32x4v*)(O + (size_t)(row0 + ai * 128 + m * 16) * ldc + col0 + bj * 128) = w; }
    }
};
struct EpiProjT {
    static constexpr bool PERM = true, AFTER_DRAIN = false;
    u16* lat; u16* ctx; const float* bias;
    __device__ __forceinline__ void operator()(const f32x4 (&acc)[2][2][4][2], const pg8::Unit& u, int wr, int wc, int fr, int fq) const {
        const int row0 = u.pm * 256 + wr * 64 + fr, tc0 = wc * 32 + 8 * fq;
        const int b = u.pn / 33, tile = u.pn - b * 33;
#pragma unroll
        for (int ai = 0; ai < 2; ++ai)
#pragma unroll
            for (int m = 0; m < 4; ++m) { const int ch = row0 + ai * 128 + m * 16; const float bs = bias[ch];
                u16* dst = tile == 0 ? ctx + ((size_t)b * 3072 + ch) * CTX + tc0 : lat + ((size_t)b * 3072 + ch) * SEQ + (tile - 1) * 256 + tc0;
#pragma unroll
                for (int bj = 0; bj < 2; ++bj) { const f32x4 a = acc[ai][bj][m][0] + bs, c = acc[ai][bj][m][1] + bs; u32x4v w;
                    w.x = pg8::cvt_pk_bf16(a[0], a[1]); w.y = pg8::cvt_pk_bf16(a[2], a[3]); w.z = pg8::cvt_pk_bf16(c[0], c[1]); w.w = pg8::cvt_pk_bf16(c[2], c[3]);
                    *(u32x4v*)(dst + bj * 128) = w; } }
    }
};


struct LatOrder : pg8::StaticOrder {
    __device__ bool next(int i, pg8::Unit& u) const { if (!pg8::StaticOrder::next(i, u)) return false; u.pm = (u.pm >> 5) * 33 + 1 + (u.pm & 31); return true; }
};
struct CtxSplitOrder {
    int nk, G, c;
    __device__ bool next(int i, pg8::Unit& u) const { const int L = i * G + c; if (L >= 16 * nk) return false; const int un = L & 15, kc = L >> 4; u.pm = (un >> 2) * 33; u.pn = un & 3; u.kofs = kc * 256; return true; }
    __device__ __forceinline__ void a_ready(const pg8::Unit&) const {}
    __device__ __forceinline__ void done(const pg8::Unit&) const {}
};
struct EpiResidAtomic {
    static constexpr bool PERM = false, AFTER_DRAIN = false;
    float* h; const float* gp; float scale;
    __device__ __forceinline__ void operator()(const f32x4 (&acc)[2][2][4][2], const pg8::Unit& u, int wr, int wc, int fr, int fq) const {
        const int row0 = u.pm * 256 + wr * 64 + fr, col0 = u.pn * 256 + wc * 32 + 4 * fq;
#pragma unroll
        for (int bj = 0; bj < 2; ++bj)
#pragma unroll
            for (int n = 0; n < 2; ++n) { const f32x4 gv = *(const f32x4*)(gp + col0 + bj * 128 + n * 16) * scale;
#pragma unroll
                for (int ai = 0; ai < 2; ++ai)
#pragma unroll
                    for (int m = 0; m < 4; ++m) { float* q = h + (size_t)(row0 + ai * 128 + m * 16) * D + col0 + bj * 128 + n * 16; const f32x4 v = gv * acc[ai][bj][m][n];
                        atomicAdd(q, v[0]); atomicAdd(q + 1, v[1]); atomicAdd(q + 2, v[2]); atomicAdd(q + 3, v[3]); } }
    }
};

__device__ __forceinline__ void ctx_bias_phase(KPC kp, const float* gp, const float* bias) {
    float* h = (float*)(kp->ws + OFF_H);
    for (int i = lbid() * 512 + ltid(); i < NB * CTX * 256; i += gridDim.x * 512) { const int r = i >> 8, c = (i & 255) * 4, b = r >> 8, t = r & 255;
        f32x4* q = (f32x4*)(h + ((size_t)b * TPB + t) * D + c); *q = *q + *(const f32x4*)(gp + c) * *(const f32x4*)(bias + c); }
}
__device__ __forceinline__ int colmap(int n, int mapmode) { return mapmode ? (((n >> 8) << 7) + (n & 127) + ((n >> 7) & 1) * FF) : n; }
__device__ __forceinline__ void convert_T(const float* __restrict__ src, int ld, int K, int Nd, int mapmode, u16* __restrict__ dst, LAS float* tile, int& tctr) {
    const int tid = ltid(), nkt = K / 64, ntile = (Nd / 64) * nkt;
    const int G = (int)gridDim.x; const int first = (((lbid() - tctr) % G) + G) % G; tctr += ntile;
    for (int t = first; t < ntile; t += G) {
        const int n0 = (t / nkt) * 64, k0 = (t % nkt) * 64, c0 = colmap(n0, mapmode);
#pragma unroll
        for (int i = 0; i < 2; ++i) { const int e = tid + 512 * i, kr = e >> 4, c4 = (e & 15) * 4;
            const f32x4 v = *(const f32x4*)(src + (size_t)(k0 + kr) * ld + c0 + c4);
            tile[kr * 65 + c4] = v[0]; tile[kr * 65 + c4 + 1] = v[1]; tile[kr * 65 + c4 + 2] = v[2]; tile[kr * 65 + c4 + 3] = v[3]; }
        __syncthreads();
        { const int n = tid >> 3, k8 = (tid & 7) * 8; u32x4v w;
          w.x = pg8::cvt_pk_bf16(tile[(k8 + 0) * 65 + n], tile[(k8 + 1) * 65 + n]); w.y = pg8::cvt_pk_bf16(tile[(k8 + 2) * 65 + n], tile[(k8 + 3) * 65 + n]);
          w.z = pg8::cvt_pk_bf16(tile[(k8 + 4) * 65 + n], tile[(k8 + 5) * 65 + n]); w.w = pg8::cvt_pk_bf16(tile[(k8 + 6) * 65 + n], tile[(k8 + 7) * 65 + n]);
          *(u32x4v*)(dst + (size_t)(n0 + n) * K + k0 + k8) = w; }
        __syncthreads();
    }
}

__device__ __forceinline__ void norm_phase(KPC kp, int l, int sub) {
    const float* h = (const float*)(kp->ws + OFF_H); u16* uo = (u16*)(kp->ws + OFF_U);
    const float* g = kp->in[I_NORMG] + (size_t)(l * 3 + sub) * D; const float* modl = (const float*)(kp->ws + OFF_MOD) + (size_t)l * 5 * 9216;
    const int lane = ltid() & 63, wv = ltid() >> 6;
    for (int T = lbid() * 8 + wv; T < NTOK; T += gridDim.x * 8) {
        const float* hr = h + (size_t)T * D; f32x4 v[4]; float ss = 0.f;
#pragma unroll
        for (int i = 0; i < 4; ++i) { v[i] = *(const f32x4*)(hr + i * 256 + lane * 4); ss += v[i][0] * v[i][0] + v[i][1] * v[i][1] + v[i][2] * v[i][2] + v[i][3] * v[i][3]; }
        ss = wave_sum(ss); const float rs = rsqrtf(ss * (1.0f / D) + 1e-6f);
        const float* mp = modl + (size_t)modrow_of_token(T) * 9216 + sub * 3 * 1024;
#pragma unroll
        for (int i = 0; i < 4; ++i) { const int c = i * 256 + lane * 4; const f32x4 gg = *(const f32x4*)(g + c), sh = *(const f32x4*)(mp + c), sc = *(const f32x4*)(mp + 1024 + c);
            const f32x4 o = v[i] * rs * gg * (sc + 1.0f) + sh; u32x2 w; w.x = pg8::cvt_pk_bf16(o[0], o[1]); w.y = pg8::cvt_pk_bf16(o[2], o[3]);
            *(u32x2*)(uo + (size_t)T * D + c) = w; }
    }
}

__device__ __forceinline__ void final_phase(KPC kp) {
    const float* h = (const float*)(kp->ws + OFF_H); const float* g = kp->in[I_FINALG];
    const int lane = ltid() & 63, wv = ltid() >> 6;
    for (int r = lbid() * 8 + wv; r < NB * SEQ; r += gridDim.x * 8) {
        const int b = r / SEQ, s = r - b * SEQ; const float* hr = h + ((size_t)b * TPB + CTX + s) * D; f32x4 v[4]; float ss = 0.f;
#pragma unroll
        for (int i = 0; i < 4; ++i) { v[i] = *(const f32x4*)(hr + i * 256 + lane * 4); ss += v[i][0] * v[i][0] + v[i][1] * v[i][1] + v[i][2] * v[i][2] + v[i][3] * v[i][3]; }
        ss = wave_sum(ss); const float rs = rsqrtf(ss * (1.0f / D) + 1e-6f);
#pragma unroll
        for (int i = 0; i < 4; ++i) { const int c = i * 256 + lane * 4; *(f32x4*)(kp->out + (size_t)r * D + c) = v[i] * rs * *(const f32x4*)(g + c); }
    }
}

__device__ __forceinline__ void setup_phase(KPC kp, LAS float* ldsf) {
    float* h = (float*)(kp->ws + OFF_H); const int tid = ltid();
    for (size_t i = (size_t)lbid() * 512 + tid; i < (size_t)NTOK * 256; i += (size_t)gridDim.x * 512) {
        const int T = (int)(i >> 8), c = ((int)i & 255) * 4, b = T / TPB, t = T - b * TPB; f32x4 v;
        if (t < CTX) v = *(const f32x4*)(kp->in[I_CTX] + ((size_t)b * CTX + t) * D + c);
        else { const int s = t - CTX; v = *(const f32x4*)(kp->in[I_X] + ((size_t)b * SEQ + s) * D + c);
            const int half = c >> 9, cc = c & 511, isc = cc >> 8, i0 = cc & 255; const float pv = half ? (float)(s & 63) : (float)(s >> 6);
#pragma unroll
            for (int e = 0; e < 4; ++e) { const float om = exp2f(-13.287712379549449f * (float)(i0 + e) * (1.0f / 256.0f)); const float ang = pv * om; v[e] += isc ? cosf(ang) : sinf(ang); } }
        *(f32x4*)(h + (size_t)T * D + c) = v;
    }
    LAS float* sc = ldsf; LAS float* red = ldsf + 5 * 1024;
    for (int i = tid; i < 5 * 1024; i += 512) { const int r = i >> 10, k = i & 1023; const float cv = r < 4 ? kp->in[I_C][r * D + k] : kp->in[I_CCTX][k]; sc[i] = siluf(cv); }
    __syncthreads();
    float* mod = (float*)(kp->ws + OFF_MOD); const int lane = tid & 63, wv = tid >> 6;
    for (int task = lbid(); task < 288; task += gridDim.x) {
        const int l = task / 72, n0 = (task % 72) * 128 + lane * 2; const float* w = kp->in[I_ADAW] + (size_t)l * D * 9216 + n0;
        f32x2 a[5];
#pragma unroll
        for (int r = 0; r < 5; ++r) a[r] = (f32x2){0.f, 0.f};
#pragma unroll 16
        for (int k = wv * 128; k < wv * 128 + 128; ++k) { const f32x2 wv2 = *(const f32x2*)(w + (size_t)k * 9216);
#pragma unroll
            for (int r = 0; r < 5; ++r) a[r] += wv2 * sc[r * 1024 + k]; }
#pragma unroll
        for (int r = 0; r < 5; ++r) { red[(wv * 5 + r) * 128 + lane * 2] = a[r][0]; red[(wv * 5 + r) * 128 + lane * 2 + 1] = a[r][1]; }
        __syncthreads();
        for (int i = tid; i < 640; i += 512) { const int r = i >> 7, n = i & 127; float s = 0.f;
#pragma unroll
            for (int w8 = 0; w8 < 8; ++w8) s += red[(w8 * 5 + r) * 128 + n];
            const int nn = (task % 72) * 128 + n; mod[((size_t)l * 5 + r) * 9216 + nn] = s + kp->in[I_ADAB][(size_t)l * 9216 + nn]; }
        __syncthreads();
    }
}

__device__ __forceinline__ void convert_layer(KPC kp, int l, LAS float* tile) {
    unsigned char* wb = kp->ws + OFF_WB; int tctr = 0; const int j = l >> 1;
    for (int f = 0; f < 2; ++f) {
        convert_T(kp->in[I_FFNIN] + (size_t)(l * 2 + f) * D * 2 * FF, 2 * FF, D, 2 * FF, 1, (u16*)(wb + (f ? WB_FIN1 : WB_FIN0)), tile, tctr);
        convert_T(kp->in[I_FFNOUT] + (size_t)(l * 2 + f) * FF * D, D, FF, D, 0, (u16*)(wb + (f ? WB_FOUT1 : WB_FOUT0)), tile, tctr);
    }
    if ((l & 1) == 0) {
        convert_T(kp->in[I_HYWIN] + (size_t)j * D * 3 * D, 3 * D, D, 3 * D, 0, (u16*)(wb + WB_MIN), tile, tctr);
        convert_T(kp->in[I_HYWOUT] + (size_t)j * D * D, D, D, D, 0, (u16*)(wb + WB_MOUT), tile, tctr);
    } else {
        convert_T(kp->in[I_MLUP] + (size_t)j * D * 2 * INNER, 2 * INNER, D, 2 * INNER, 0, (u16*)(wb + WB_MIN), tile, tctr);
        convert_T(kp->in[I_MLDOWN] + (size_t)j * INNER * D, D, INNER, D, 0, (u16*)(wb + WB_MOUT), tile, tctr);
        u16* wg = (u16*)(wb + WB_WGT); const float* src = kp->in[I_MLWG] + (size_t)j * 3 * INNER * 16;
        for (int i = lbid() * 512 + ltid(); i < 16 * 3 * INNER; i += gridDim.x * 512) { const int o = i / (3 * INNER), k = i - o * 3 * INNER; wg[i] = f2bf(src[(size_t)k * 16 + o]); }
        float* gates = (float*)(kp->ws + OFF_GATES); const float* bg = kp->in[I_MLBG] + j * 16;
        for (int i = lbid() * 512 + ltid(); i < NTOK * 16; i += gridDim.x * 512) gates[i] = bg[i & 15];
    }
}

constexpr size_t HY_PL = 0, HY_PC = (size_t)NB * 3072 * SEQ * 2, HY_YL = HY_PC + (size_t)NB * 3072 * CTX * 2, HY_YC = HY_YL + (size_t)NB * D * SEQ * 2;
__device__ __forceinline__ int fphys(int i) { return i ^ ((((i >> 6) & 1) * 21) ^ (((i >> 5) & 1) * 10)); }
__device__ __forceinline__ f32x2 cmul(f32x2 a, f32x2 b) { return (f32x2){a.x * b.x - a.y * b.y, a.x * b.y + a.y * b.x}; }
__device__ __forceinline__ f32x2 cmulc(f32x2 a, f32x2 b) { return (f32x2){a.x * b.x + a.y * b.y, a.y * b.x - a.x * b.y}; }
__device__ __forceinline__ int drev(int x) { const unsigned r = __brev((unsigned)x) >> 18; return (int)(((r & 0x2AAAu) >> 1) | ((r & 0x1555u) << 1)); }

__device__ __forceinline__ void fft_fwd(LAS f32x2* buf) {
    const int tid = ltid();
    for (int lm = 12; lm >= 0; lm -= 2) {
        const int m = 1 << lm; const float inv = 1.0f / (float)(4 << lm);
#pragma unroll 4
        for (int i = 0; i < 8; ++i) {
            const int g = tid + 512 * i, p = g & (m - 1), base = ((g >> lm) << (lm + 2)) + p;
            const int i0 = fphys(base), i1 = fphys(base + m), i2 = fphys(base + 2 * m), i3 = fphys(base + 3 * m);
            const f32x2 a0 = buf[i0], a1 = buf[i1], a2 = buf[i2], a3 = buf[i3];
            const f32x2 t0 = a0 + a2, t1 = a0 - a2, t2 = a1 + a3, dd = a1 - a3, t3 = (f32x2){dd.y, -dd.x};
            const float rev = (float)p * inv;
            const f32x2 w1 = (f32x2){__builtin_amdgcn_cosf(rev), -__builtin_amdgcn_sinf(rev)}, w2 = cmul(w1, w1), w3 = cmul(w2, w1);
            buf[i0] = t0 + t2; buf[i1] = cmul(t1 + t3, w1); buf[i2] = cmul(t0 - t2, w2); buf[i3] = cmul(t1 - t3, w3);
        }
        __syncthreads();
    }
}
__device__ __forceinline__ void fft_inv(LAS f32x2* buf) {
    const int tid = ltid();
    for (int lm = 0; lm <= 12; lm += 2) {
        const int m = 1 << lm; const float inv = 1.0f / (float)(4 << lm);
#pragma unroll 4
        for (int i = 0; i < 8; ++i) {
            const int g = tid + 512 * i, p = g & (m - 1), base = ((g >> lm) << (lm + 2)) + p;
            const int i0 = fphys(base), i1 = fphys(base + m), i2 = fphys(base + 2 * m), i3 = fphys(base + 3 * m);
            const float rev = (float)p * inv;
            const f32x2 w1 = (f32x2){__builtin_amdgcn_cosf(rev), -__builtin_amdgcn_sinf(rev)}, w2 = cmul(w1, w1), w3 = cmul(w2, w1);
            const f32x2 b0 = buf[i0], b1 = cmulc(buf[i1], w1), b2 = cmulc(buf[i2], w2), b3 = cmulc(buf[i3], w3);
            const f32x2 s0 = b0 + b2, s1 = b0 - b2, s2 = b1 + b3, dd = b1 - b3, s3 = (f32x2){-dd.y, dd.x};
            buf[i0] = s0 + s2; buf[i1] = s1 + s3; buf[i2] = s0 - s2; buf[i3] = s1 - s3;
        }
        __syncthreads();
    }
}

__device__ __forceinline__ void hy_mlp_phase(KPC kp, int j) {
    float* h2 = (float*)(kp->ws + OFF_H2);
    const float* w1 = kp->in[I_HYW1] + j * 33 * 64; const float* b1 = kp->in[I_HYB1] + j * 64; const float* w2 = kp->in[I_HYW2] + j * 64 * 64; const float* b2 = kp->in[I_HYB2] + j * 64;
    const float* fr = kp->in[I_HYFREQ] + j * 128; const int lane = ltid() & 63, wv = ltid() >> 6;
    for (int pos = lbid() * 8 + wv; pos < SEQ + CTX; pos += gridDim.x * 8) {
        const int n = pos < SEQ ? SEQ : CTX, t = pos < SEQ ? pos : pos - SEQ; const float tn = (float)t / (float)(n - 1);
        float feat = 0.f;
        if (lane == 0) feat = tn;
        else if (lane < 33) { const int bi = (lane - 1) & 15; const float band = 1e-4f + (float)bi * ((15.0f - 1e-4f) / 15.0f); float rev = ((float)t / (float)n) * band; rev -= floorf(rev);
            const float ang = 6.283185307179586f * rev; feat = lane < 17 ? cosf(ang) : -sinf(ang); }
        float z = b1[lane];
        for (int i = 0; i < 33; ++i) z += lshfl(feat, i) * w1[i * 64 + lane];
        const float h1 = sinf(fr[lane] * z);
        float z2 = b2[lane];
        for (int v = 0; v < 64; ++v) z2 += lshfl(h1, v) * w2[v * 64 + lane];
        h2[(size_t)pos * 64 + lane] = sinf(fr[64 + lane] * z2);
    }
}

__device__ __forceinline__ void block_sum2(float& a, float& b, LAS float* red) {
    a = wave_sum(a); b = wave_sum(b); const int lane = ltid() & 63, wv = ltid() >> 6;
    __syncthreads(); if (lane == 0) { red[wv] = a; red[8 + wv] = b; } __syncthreads();
    float sa = 0.f, sb = 0.f;
#pragma unroll
    for (int i = 0; i < 8; ++i) { sa += red[i]; sb += red[8 + i]; }
    a = sa; b = sb;
}

__device__ __forceinline__ void hy_filter_task(KPC kp, int j, int task, LAS f32x2* buf, LAS float* aux) {
    const int tid = ltid(), d = task & 1023; const bool lat = task < 1024;
    const float* w3 = kp->in[I_HYW3] + (size_t)j * 64 * 4096; const float* b3 = kp->in[I_HYB3] + j * 4096; const float* ldc = kp->in[I_HYDECAY] + j * 4096;
    __syncthreads();
    if (tid < 256) aux[tid] = w3[(size_t)(tid & 63) * 4096 + (tid >> 6) * 1024 + d];
    if (tid < 4) { aux[256 + tid] = b3[tid * 1024 + d]; aux[260 + tid] = __expf(ldc[tid * 1024 + d]); }
    __syncthreads();
    const float* h2 = (const float*)(kp->ws + OFF_H2);
    float ss0 = 0.f, ss1 = 0.f;
    if (lat) {
        for (int r = 0; r < 16; ++r) { const int i = tid + 512 * r; float a0 = aux[256], a1 = aux[257], a2 = aux[258], a3 = aux[259];
#pragma unroll 4
            for (int u4 = 0; u4 < 16; ++u4) { const f32x4 hv = *(const f32x4*)(h2 + (size_t)i * 64 + u4 * 4);
#pragma unroll
                for (int e = 0; e < 4; ++e) { const int u = u4 * 4 + e; a0 += hv[e] * aux[u]; a1 += hv[e] * aux[64 + u]; a2 += hv[e] * aux[128 + u]; a3 += hv[e] * aux[192 + u]; } }
            const float tn = (float)i * (1.0f / 8191.0f);
            a0 *= __expf(-tn * aux[260]); a1 *= __expf(-tn * aux[261]); a2 *= __expf(-tn * aux[262]); a3 *= __expf(-tn * aux[263]);
            buf[fphys(i)] = (f32x2){a0, a2}; ss0 += a0 * a0; ss1 += a2 * a2;
            if (i >= 1) { buf[fphys(NFFT - i)] = (f32x2){a1, a3}; ss0 += a1 * a1; ss1 += a3 * a3; } }
        if (tid == 0) buf[fphys(SEQ)] = (f32x2){0.f, 0.f};
        block_sum2(ss0, ss1, aux + 272);
        const f32x2 scl = (f32x2){rsqrtf(ss0 + 1e-12f) * (1.0f / NFFT), rsqrtf(ss1 + 1e-12f) * (1.0f / NFFT)};
        for (int r = 0; r < 32; ++r) { const int q = fphys(tid + 512 * r); buf[q] = buf[q] * scl; }
        __syncthreads();
        fft_fwd(buf);
        f32x2* K0 = (f32x2*)(kp->ws + OFF_R2) + (size_t)d * NFFT; f32x2* K1 = (f32x2*)kp->out + (size_t)d * NFFT;
        for (int r = 0; r < 32; ++r) { const int pos = tid + 512 * r, k = drev(pos), pos2 = drev((NFFT - k) & (NFFT - 1)); const f32x2 Z = buf[fphys(pos)], Z2 = buf[fphys(pos2)];
            K0[pos] = (f32x2){0.5f * (Z.x + Z2.x), 0.5f * (Z.y - Z2.y)}; K1[pos] = (f32x2){0.5f * (Z.y + Z2.y), -0.5f * (Z.x - Z2.x)}; }
    } else {
        const int idx = tid; float a0 = 0.f, a1 = 0.f;
        if (idx != CTX) { const int t = idx < CTX ? idx : 2 * CTX - idx, dir = idx < CTX ? 0 : 1; a0 = aux[256 + dir]; a1 = aux[258 + dir];
            for (int u4 = 0; u4 < 16; ++u4) { const f32x4 hv = *(const f32x4*)(h2 + (size_t)(SEQ + t) * 64 + u4 * 4);
#pragma unroll
                for (int e = 0; e < 4; ++e) { const int u = u4 * 4 + e; a0 += hv[e] * aux[dir * 64 + u]; a1 += hv[e] * aux[128 + dir * 64 + u]; } }
            const float tn = (float)t * (1.0f / 255.0f); a0 *= __expf(-tn * aux[260 + dir]); a1 *= __expf(-tn * aux[262 + dir]); }
        ss0 = a0 * a0; ss1 = a1 * a1;
        block_sum2(ss0, ss1, aux + 272);
        float* kc = (float*)(kp->ws + OFF_KCTX);
        kc[(size_t)d * 512 + idx] = a0 * rsqrtf(ss0 + 1e-12f); kc[(size_t)(1024 + d) * 512 + idx] = a1 * rsqrtf(ss1 + 1e-12f);
    }
}

__device__ __forceinline__ float ld3(const u16* row, int t, int n, float wa, float wb, float wc, float bias) {
    const float xm = t > 0 ? bf2f(row[t - 1]) : 0.f, x0 = bf2f(row[t]), xp = t < n - 1 ? bf2f(row[t + 1]) : 0.f; return wa * xm + wb * x0 + wc * xp + bias; }

__device__ __forceinline__ void hy_conv_lat(KPC kp, int j, int task, LAS f32x2* buf) {
    const int tid = ltid(), bp = task >> 10, c = task & 1023, b0 = bp * 2;
    const u16* pl = (const u16*)(kp->ws + OFF_R1 + HY_PL); u16* yl = (u16*)(kp->ws + OFF_R1 + HY_YL);
    const float* cw = kp->in[I_HYCW] + (size_t)j * 3 * 3072; const float* cb = kp->in[I_HYCB] + j * 3072;
    const float w1a = cw[c], w1b = cw[3072 + c], w1c = cw[6144 + c], bb1 = cb[c];
    const float w2a = cw[1024 + c], w2b = cw[3072 + 1024 + c], w2c = cw[6144 + 1024 + c], bb2 = cb[1024 + c];
    const float w3a = cw[2048 + c], w3b = cw[3072 + 2048 + c], w3c = cw[6144 + 2048 + c], bb3 = cb[2048 + c];
    const float sk0 = kp->in[I_HYSKIP][j * 2048 + c], sk1 = kp->in[I_HYSKIP][j * 2048 + 1024 + c];
    const u16* x1r0 = pl + ((size_t)b0 * 3072 + c) * SEQ; const u16* x1r1 = x1r0 + (size_t)3072 * SEQ;
    const u16* x2r0 = x1r0 + (size_t)1024 * SEQ; const u16* x2r1 = x1r1 + (size_t)1024 * SEQ;
    const u16* vr0 = x1r0 + (size_t)2048 * SEQ; const u16* vr1 = x1r1 + (size_t)2048 * SEQ;
    const f32x2* K0 = (const f32x2*)(kp->ws + OFF_R2) + (size_t)c * NFFT; const f32x2* K1 = (const f32x2*)kp->out + (size_t)c * NFFT;
    __syncthreads();
#pragma unroll 8
    for (int r = 0; r < 32; ++r) { const int idx = tid + 512 * r;
        buf[fphys(idx)] = idx < SEQ ? (f32x2){ld3(vr0, idx, SEQ, w3a, w3b, w3c, bb3), ld3(vr1, idx, SEQ, w3a, w3b, w3c, bb3)} : (f32x2){0.f, 0.f}; }
    __syncthreads();
    fft_fwd(buf);
#pragma unroll 8
    for (int r = 0; r < 32; ++r) { const int pos = tid + 512 * r, q = fphys(pos); buf[q] = cmul(buf[q], K0[pos]); }
    __syncthreads();
    fft_inv(buf);
    float zr[32];
#pragma unroll
    for (int r = 0; r < 16; ++r) { const int t = tid + 512 * r; const f32x2 y = buf[fphys(t)];
        const float v0 = ld3(vr0, t, SEQ, w3a, w3b, w3c, bb3), v1 = ld3(vr1, t, SEQ, w3a, w3b, w3c, bb3);
        const float z0 = ld3(x1r0, t, SEQ, w1a, w1b, w1c, bb1) * (y.x + sk0 * v0), z1 = ld3(x1r1, t, SEQ, w1a, w1b, w1c, bb1) * (y.y + sk0 * v1);
        zr[2 * r] = z0; zr[2 * r + 1] = z1; buf[fphys(t)] = (f32x2){z0, z1}; buf[fphys(t + SEQ)] = (f32x2){0.f, 0.f}; }
    __syncthreads();
    fft_fwd(buf);
#pragma unroll 8
    for (int r = 0; r < 32; ++r) { const int pos = tid + 512 * r, q = fphys(pos); buf[q] = cmul(buf[q], K1[pos]); }
    __syncthreads();
    fft_inv(buf);
#pragma unroll
    for (int r = 0; r < 16; ++r) { const int t = tid + 512 * r; const f32x2 y = buf[fphys(t)];
        const float o0 = ld3(x2r0, t, SEQ, w2a, w2b, w2c, bb2) * (y.x + sk1 * zr[2 * r]), o1 = ld3(x2r1, t, SEQ, w2a, w2b, w2c, bb2) * (y.y + sk1 * zr[2 * r + 1]);
        yl[((size_t)b0 * D + c) * SEQ + t] = f2bf(o0); yl[((size_t)(b0 + 1) * D + c) * SEQ + t] = f2bf(o1); }
}

__device__ __forceinline__ void hy_conv_ctx(KPC kp, int j, int c, LAS float* ls) {
    const int tid = ltid();
    const u16* pc = (const u16*)(kp->ws + OFF_R1 + HY_PC); u16* yc = (u16*)(kp->ws + OFF_R1 + HY_YC); const float* kc = (const float*)(kp->ws + OFF_KCTX);
    const float* cw = kp->in[I_HYCW] + (size_t)j * 3 * 3072; const float* cb = kp->in[I_HYCB] + j * 3072;
    const float w1a = cw[c], w1b = cw[3072 + c], w1c = cw[6144 + c], bb1 = cb[c];
    const float w2a = cw[1024 + c], w2b = cw[3072 + 1024 + c], w2c = cw[6144 + 1024 + c], bb2 = cb[1024 + c];
    const float w3a = cw[2048 + c], w3b = cw[3072 + 2048 + c], w3c = cw[6144 + 2048 + c], bb3 = cb[2048 + c];
    const float sk0 = kp->in[I_HYSKIP][j * 2048 + c], sk1 = kp->in[I_HYSKIP][j * 2048 + 1024 + c];
    __syncthreads();
    ls[tid] = kc[(size_t)c * 512 + tid]; ls[512 + tid] = kc[(size_t)(1024 + c) * 512 + tid];
    for (int i = 0; i < 2; ++i) { const int e = tid + 512 * i, b = e >> 8, t = e & 255; ls[1024 + e] = ld3(pc + ((size_t)b * 3072 + 2048 + c) * CTX, t, CTX, w3a, w3b, w3c, bb3); }
    __syncthreads();
    float zr[2];
    for (int i = 0; i < 2; ++i) { const int e = tid + 512 * i, b = e >> 8, t = e & 255; float a = 0.f;
        for (int s = 0; s < CTX; ++s) a += ls[(t - s) & 511] * ls[1024 + b * 256 + s];
        zr[i] = ld3(pc + ((size_t)b * 3072 + c) * CTX, t, CTX, w1a, w1b, w1c, bb1) * (a + sk0 * ls[1024 + e]); ls[2048 + e] = zr[i]; }
    __syncthreads();
    for (int i = 0; i < 2; ++i) { const int e = tid + 512 * i, b = e >> 8, t = e & 255; float a = 0.f;
        for (int s = 0; s < CTX; ++s) a += ls[512 + ((t - s) & 511)] * ls[2048 + b * 256 + s];
        yc[((size_t)b * D + c) * CTX + t] = f2bf(ld3(pc + ((size_t)b * 3072 + 1024 + c) * CTX, t, CTX, w2a, w2b, w2c, bb2) * (a + sk1 * zr[i])); }
}

__device__ __forceinline__ void hy_transpose(KPC kp, LAS u16* tl) {
    const u16* yl = (const u16*)(kp->ws + OFF_R1 + HY_YL); const u16* yc = (const u16*)(kp->ws + OFF_R1 + HY_YC); u16* y = (u16*)(kp->ws + OFF_U); const int tid = ltid();
    for (int tile = lbid(); tile < NB * 16 * NCH; tile += gridDim.x) {
        const int b = tile / (16 * NCH), rem = tile - b * 16 * NCH, ct = rem / NCH, tt = rem - ct * NCH;
        const u16* src = tt < 4 ? yc + ((size_t)b * D + ct * 64) * CTX + tt * 64 : yl + ((size_t)b * D + ct * 64) * SEQ + (tt - 4) * 64; const int ld = tt < 4 ? CTX : SEQ;
        { const int cr = tid >> 3, t8 = (tid & 7) * 8; *(LAS u32x4v*)(tl + cr * 72 + t8) = *(const u32x4v*)(src + (size_t)cr * ld + t8); }
        __syncthreads();
        { const int tr = tid >> 3, c8 = (tid & 7) * 8; u32x4v w;
          w.x = (unsigned)tl[(c8 + 0) * 72 + tr] | ((unsigned)tl[(c8 + 1) * 72 + tr] << 16); w.y = (unsigned)tl[(c8 + 2) * 72 + tr] | ((unsigned)tl[(c8 + 3) * 72 + tr] << 16);
          w.z = (unsigned)tl[(c8 + 4) * 72 + tr] | ((unsigned)tl[(c8 + 5) * 72 + tr] << 16); w.w = (unsigned)tl[(c8 + 6) * 72 + tr] | ((unsigned)tl[(c8 + 7) * 72 + tr] << 16);
          *(u32x4v*)(y + ((size_t)b * TPB + tt * 64 + tr) * D + ct * 64 + c8) = w; }
        __syncthreads();
    }
}

constexpr size_t OFF_XM = OFF_R1, OFF_XC = OFF_R1 + 132 * MiB, OFF_S = WS_NEED, OFF_MLM = OFF_S + 34 * MiB, WS_NEED2 = OFF_MLM + 1 * MiB;
__device__ __forceinline__ u16* hb_ptr(KPC kp, int T) { const int b = T / TPB, t = T - b * TPB;
    return t < CTX ? (u16*)(kp->ws + OFF_HBC) + ((size_t)b * CTX + t) * INNER : (u16*)kp->out + ((size_t)b * SEQ + (t - CTX)) * INNER; }
__device__ __forceinline__ void unpack8(u32x4v w, float (&f)[8]) { f[0] = bflo(w.x); f[1] = bfhi(w.x); f[2] = bflo(w.y); f[3] = bfhi(w.y); f[4] = bflo(w.z); f[5] = bfhi(w.z); f[6] = bflo(w.w); f[7] = bfhi(w.w); }
__device__ __forceinline__ u32x4v pack8(const float (&f)[8]) { u32x4v w; w.x = pg8::cvt_pk_bf16(f[0], f[1]); w.y = pg8::cvt_pk_bf16(f[2], f[3]); w.z = pg8::cvt_pk_bf16(f[4], f[5]); w.w = pg8::cvt_pk_bf16(f[6], f[7]); return w; }
__device__ __forceinline__ void bd8(const float (&x)[8], const float (&w)[32], float (&y)[8]) {
#pragma unroll
    for (int bl = 0; bl < 2; ++bl)
#pragma unroll
        for (int e = 0; e < 4; ++e) { float s = 0.f;
#pragma unroll
            for (int d = 0; d < 4; ++d) s += x[bl * 4 + d] * w[bl * 16 + d * 4 + e];
            y[bl * 4 + e] = s; }
}
__device__ __forceinline__ void ldw32(const float* p, float (&w)[32]) {
#pragma unroll
    for (int i = 0; i < 8; ++i) { const f32x4 v = *(const f32x4*)(p + i * 4); w[i * 4] = v[0]; w[i * 4 + 1] = v[1]; w[i * 4 + 2] = v[2]; w[i * 4 + 3] = v[3]; } }

__device__ __forceinline__ void ml_m_phase(KPC kp, int j) {
    float* M = (float*)(kp->ws + OFF_MLM); const float* wq = kp->in[I_MLWQ] + (size_t)j * 512 * 16; const float* wk = kp->in[I_MLWK] + (size_t)j * 512 * 16;
    for (int i = lbid() * 512 + ltid(); i < 512 * 16; i += gridDim.x * 512) { const int blk = i >> 4, d = (i >> 2) & 3, d2 = i & 3; float s = 0.f;
#pragma unroll
        for (int e = 0; e < 4; ++e) s += wq[blk * 16 + d * 4 + e] * wk[blk * 16 + d2 * 4 + e];
        M[i] = s * 0.04419417382415922f; }
}

__device__ __forceinline__ void ml_prep_task(KPC kp, int j, int task, LAS unsigned char* lds) {
    const int tid = ltid(), lane = tid & 63, wv = tid >> 6, fr = lane & 15, fq = lane >> 4;
    const int hd = task & 3, bc = task >> 2, b = bc / NCH, ci = bc - b * NCH;
    const u16* xm = (const u16*)(kp->ws + OFF_XM); u16* xc = (u16*)(kp->ws + OFF_XC);
    const int T0 = b * TPB + ci * 64, tlo = b * TPB + (ci < 4 ? 0 : CTX), thi = b * TPB + (ci < 4 ? CTX - 1 : TPB - 1);
    const int ch0 = hd * DH + lane * 8;
    LAS u16* QS = (LAS u16*)lds; LAS u16* KS = (LAS u16*)(lds + 66560);
    const float* cw = kp->in[I_MLCW] + (size_t)j * 3 * INNER; const float* cb = kp->in[I_MLCB] + (size_t)j * INNER;
    __syncthreads();
    {
        float cwa[8], cwb[8], cwc[8], cbb[8], wq[32], wk[32];
#pragma unroll
        for (int e = 0; e < 8; ++e) { cwa[e] = cw[ch0 + e]; cwb[e] = cw[INNER + ch0 + e]; cwc[e] = cw[2 * INNER + ch0 + e]; cbb[e] = cb[ch0 + e]; }
        ldw32(kp->in[I_MLWQ] + ((size_t)j * 512 + (ch0 >> 2)) * 16, wq); ldw32(kp->in[I_MLWK] + ((size_t)j * 512 + (ch0 >> 2)) * 16, wk);
        for (int r = 0; r < 8; ++r) { const int jj = wv + 8 * r, T = T0 + jj; const u16* p = xm + (size_t)T * INNER + ch0;
            float x0[8], xa[8], xb[8], xcv[8], q[8], k[8];
            unpack8(*(const u32x4v*)p, x0);
            if (T > tlo) unpack8(*(const u32x4v*)(p - INNER), xa); else {
#pragma unroll
                for (int e = 0; e < 8; ++e) xa[e] = 0.f; }
            if (T < thi) unpack8(*(const u32x4v*)(p + INNER), xb); else {
#pragma unroll
                for (int e = 0; e < 8; ++e) xb[e] = 0.f; }
#pragma unroll
            for (int e = 0; e < 8; ++e) xcv[e] = siluf(cwa[e] * xa[e] + cwb[e] * x0[e] + cwc[e] * xb[e] + cbb[e]);
            const u32x4v xw = pack8(xcv); *(u32x4v*)(xc + (size_t)T * INNER + ch0) = xw; unpack8(xw, xcv);
            bd8(xcv, wq, q); bd8(xcv, wk, k);
            *(LAS u32x4v*)(QS + jj * 520 + lane * 8) = pack8(q); *(LAS u32x4v*)(KS + jj * 520 + lane * 8) = pack8(k); }
    }
    __syncthreads();
    const u16* wg = (const u16*)(kp->ws + OFF_WB + WB_WGT);
    const int mt = wv & 3, kh = wv >> 2;
    { f32x4 s0 = {0.f, 0.f, 0.f, 0.f}, s1 = {0.f, 0.f, 0.f, 0.f}; const int nt0 = kh * 2;
      for (int ks = 0; ks < 16; ++ks) { const bf16x8 a = *(const LAS bf16x8*)(QS + (16 * mt + fr) * 520 + 32 * ks + 8 * fq);
          const bf16x8 b0 = *(const LAS bf16x8*)(KS + (16 * nt0 + fr) * 520 + 32 * ks + 8 * fq), b1 = *(const LAS bf16x8*)(KS + (16 * (nt0 + 1) + fr) * 520 + 32 * ks + 8 * fq);
          s0 = __builtin_amdgcn_mfma_f32_16x16x32_bf16(a, b0, s0, 0, 0, 0); s1 = __builtin_amdgcn_mfma_f32_16x16x32_bf16(a, b1, s1, 0, 0, 0); }
      float* S = (float*)(kp->ws + OFF_S) + ((size_t)(b * 4 + hd) * NCH + ci) * 4096;
#pragma unroll
      for (int r = 0; r < 4; ++r) { S[(16 * mt + 4 * fq + r) * 64 + 16 * nt0 + fr] = s0[r]; S[(16 * mt + 4 * fq + r) * 64 + 16 * (nt0 + 1) + fr] = s1[r]; } }
    f32x4 ga = {0.f, 0.f, 0.f, 0.f};
    for (int ks = kh * 8; ks < kh * 8 + 8; ++ks) { const int kk = hd * DH + 32 * ks + 8 * fq;
        const bf16x8 a = *(const LAS bf16x8*)(QS + (16 * mt + fr) * 520 + 32 * ks + 8 * fq), a2 = *(const LAS bf16x8*)(KS + (16 * mt + fr) * 520 + 32 * ks + 8 * fq);
        const bf16x8 bq = *(const bf16x8*)(wg + (size_t)fr * 6144 + kk), bk = *(const bf16x8*)(wg + (size_t)fr * 6144 + INNER + kk);
        ga = __builtin_amdgcn_mfma_f32_16x16x32_bf16(a, bq, ga, 0, 0, 0); ga = __builtin_amdgcn_mfma_f32_16x16x32_bf16(a2, bk, ga, 0, 0, 0); }
    __syncthreads();
    {
        float wvv[32]; ldw32(kp->in[I_MLWV] + ((size_t)j * 512 + (ch0 >> 2)) * 16, wvv);
        for (int r = 0; r < 8; ++r) { const int jj = wv + 8 * r, T = T0 + jj; float x0[8], v[8]; unpack8(*(const u32x4v*)(xm + (size_t)T * INNER + ch0), x0); bd8(x0, wvv, v);
            *(LAS u32x4v*)(QS + jj * 520 + lane * 8) = pack8(v); }
    }
    __syncthreads();
    for (int ks = kh * 8; ks < kh * 8 + 8; ++ks) { const int kk = hd * DH + 32 * ks + 8 * fq;
        const bf16x8 a = *(const LAS bf16x8*)(QS + (16 * mt + fr) * 520 + 32 * ks + 8 * fq); const bf16x8 bv = *(const bf16x8*)(wg + (size_t)fr * 6144 + 2 * INNER + kk);
        ga = __builtin_amdgcn_mfma_f32_16x16x32_bf16(a, bv, ga, 0, 0, 0); }
    float* gates = (float*)(kp->ws + OFF_GATES);
#pragma unroll
    for (int r = 0; r < 4; ++r) atomicAdd(gates + (size_t)(T0 + 16 * mt + 4 * fq + r) * 16 + fr, ga[r]);
}

#ifndef REP_STAGE
#define REP_STAGE 1
#define REP_STILDE 1
#define REP_MFMA 1
#endif
constexpr int SC_QS = 0, SC_KT = 66560, SC_VT = 132096, SC_ST = 148480, SC_VEC = 156672;
__device__ __forceinline__ void ml_scan_task(KPC kp, int j, int task, LAS unsigned char* lds) {
    const int tid = ltid(), lane = tid & 63, wv = tid >> 6, fr = lane & 15, fq = lane >> 4;
    const int es = task & 3, dir = (task >> 2) & 1, hd = (task >> 3) & 3, b = task >> 5;
    const u16* xm = (const u16*)(kp->ws + OFF_XM); const u16* xc = (const u16*)(kp->ws + OFF_XC); const float* gates = (const float*)(kp->ws + OFF_GATES);
    const float* Sg = (const float*)(kp->ws + OFF_S) + (size_t)(b * 4 + hd) * NCH * 4096;
    u16* hf = (u16*)(kp->ws + OFF_R2);
    LAS unsigned char* QS = lds + SC_QS; LAS unsigned char* KT = lds + SC_KT; LAS unsigned char* VT = lds + SC_VT; LAS unsigned char* ST = lds + SC_ST;
    LAS float* rowterm = (LAS float*)(lds + SC_VEC); LAS float* colterm = rowterm + 64; LAS float* winter = rowterm + 128; LAS float* einv = rowterm + 192;
    LAS float* kws = rowterm + 256; LAS float* dinv = rowterm + 320; LAS float* nst = rowterm + 384; LAS float* scal = rowterm + 896;
    f32x4 C[32];
#pragma unroll
    for (int i = 0; i < 32; ++i) C[i] = (f32x4){0.f, 0.f, 0.f, 0.f};
    float m_st = 0.f;
    __syncthreads();
    nst[tid] = 0.f;
    for (int ci = 0; ci < NCH; ++ci) {
        __syncthreads();
        const int p0 = ci * 64;
        const int tid = ltid(), lane = tid & 63, wv = tid >> 6, fr = lane & 15, fq = lane >> 4;
        asm volatile("" ::: "memory");
        auto tok = [&](int jj) -> int { const int p = p0 + jj; const int t = dir == 0 ? p : (p < CTX ? CTX - 1 - p : TPB + CTX - 1 - p); return b * TPB + t; };
        float sv[8];
        { const int jj = tid >> 3, s8 = (tid & 7) * 8;
            if (dir == 0) { const float* sp = Sg + (size_t)ci * 4096 + jj * 64 + s8; const f32x4 v0 = *(const f32x4*)sp, v1 = *(const f32x4*)(sp + 4);
                sv[0] = v0[0]; sv[1] = v0[1]; sv[2] = v0[2]; sv[3] = v0[3]; sv[4] = v1[0]; sv[5] = v1[1]; sv[6] = v1[2]; sv[7] = v1[3]; }
            else { const int oc = ci < 4 ? 3 - ci : 135 - ci; const float* sp = Sg + (size_t)oc * 4096 + (63 - jj) * 64 + (56 - s8); const f32x4 v0 = *(const f32x4*)sp, v1 = *(const f32x4*)(sp + 4);
                sv[7] = v0[0]; sv[6] = v0[1]; sv[5] = v0[2]; sv[4] = v0[3]; sv[3] = v1[0]; sv[2] = v1[1]; sv[1] = v1[2]; sv[0] = v1[3]; }
        }
        float g_ic = 0.f, g_fp = 0.f;
        if (wv == 0) { const int Tg = tok(lane); g_ic = gates[(size_t)Tg * 16 + dir * 8 + hd]; g_fp = gates[(size_t)Tg * 16 + dir * 8 + 4 + hd]; }
        for (int rpS = 0; rpS < REP_STAGE; ++rpS) {
        const int wvu = __builtin_amdgcn_readfirstlane(wv); const int Tl = tok(lane);
        for (int r = 0; r < 8; ++r) { const int g8 = wvu * 8 + r; float x[8], q[8], Mw[32];
            const u32x4v xw = *(const u32x4v*)(xc + (size_t)Tl * INNER + hd * DH + g8 * 8); unpack8(xw, x);
            ldw32((const float*)(kp->ws + OFF_MLM) + (size_t)(hd * 128 + g8 * 2) * 16, Mw); bd8(x, Mw, q);
            *(LAS u32x4v*)(QS + lane * 1040 + g8 * 16) = pack8(q);
            const unsigned wd[4] = {xw.x, xw.y, xw.z, xw.w};
#pragma unroll
            for (int e = 0; e < 8; ++e) { const int d = g8 * 8 + e; *(LAS u16*)(KT + d * 128 + ((((lane >> 3) ^ (d & 7)) << 4) | ((lane & 7) << 1))) = (u16)((e & 1) ? (wd[e >> 1] >> 16) : (wd[e >> 1] & 0xffffu)); } }
        for (int r = 0; r < 2; ++r) { const int g = wvu * 2 + r; const int chv = hd * DH + es * 128 + g * 8; float x[8], v[8], wvv[32];
            unpack8(*(const u32x4v*)(xm + (size_t)Tl * INNER + chv), x); ldw32(kp->in[I_MLWV] + ((size_t)j * 512 + (chv >> 2)) * 16, wvv); bd8(x, wvv, v);
#pragma unroll
            for (int e = 0; e < 8; ++e) { const int ee = g * 8 + e; *(LAS u16*)(VT + ee * 128 + ((((lane >> 3) ^ (ee & 7)) << 4) | ((lane & 7) << 1))) = f2bf(v[e]); } }
        }
        if (wv == 0) {
            const float ic = g_ic, fp = g_fp;
            const float lf = fminf(fp, 0.f) - log1pf(__expf(-fabsf(fp)));
            float bb = lf;
#pragma unroll
            for (int o = 1; o < 64; o <<= 1) { const float t = lshfl(bb, lane - o); if (lane >= o) bb += t; }
            const float uu = ic - bb; float pm = uu;
#pragma unroll
            for (int o = 1; o < 64; o <<= 1) { const float t = lshfl(pm, lane - o); if (lane >= o) pm = fmaxf(pm, t); }
            const float a = bb + m_st, mj = fmaxf(a, bb + pm);
            rowterm[lane] = bb - mj; colterm[lane] = uu; winter[lane] = __expf(a - mj); einv[lane] = __expf(-mj);
            const float blast = lshfl(bb, 63), gs = blast - bb + ic, gmax = wave_max(gs), mnew = fmaxf(blast + m_st, gmax);
            kws[lane] = __expf(gs - mnew);
            if (lane == 0) { scal[0] = __expf(blast + m_st - mnew); scal[1] = mnew; }
        }
        __syncthreads();
        for (int rpT = 0; rpT < REP_STILDE; ++rpT) {
            const int jj = tid >> 3, sub = tid & 7, s8 = sub * 8;
            const float rt = rowterm[jj]; float rsum = 0.f;
#pragma unroll
            for (int e = 0; e < 8; ++e) { const int s = s8 + e; const float w = s <= jj ? sv[e] * 0.04419417382415922f * __expf(rt + colterm[s]) : 0.f; sv[e] = w; rsum += w; }
            *(LAS u32x4v*)(ST + jj * 128 + ((sub ^ (jj & 7)) << 4)) = pack8(sv);
            float qd = 0.f;
#pragma unroll
            for (int c8 = 0; c8 < 8; ++c8) { float qv[8]; unpack8(*(const LAS u32x4v*)(QS + jj * 1040 + (sub * 8 + c8) * 16), qv);
                { const f32x4 n0 = *(const LAS f32x4*)(nst + sub * 64 + c8 * 8), n1 = *(const LAS f32x4*)(nst + sub * 64 + c8 * 8 + 4);
                  qd += qv[0] * n0[0] + qv[1] * n0[1] + qv[2] * n0[2] + qv[3] * n0[3] + qv[4] * n1[0] + qv[5] * n1[1] + qv[6] * n1[2] + qv[7] * n1[3]; } }
            rsum += lshfl(rsum, lane ^ 1); rsum += lshfl(rsum, lane ^ 2); rsum += lshfl(rsum, lane ^ 4);
            qd += lshfl(qd, lane ^ 1); qd += lshfl(qd, lane ^ 2); qd += lshfl(qd, lane ^ 4);
            if (sub == 0) { const float qn = winter[jj] * qd + rsum; dinv[jj] = 1.0f / fmaxf(fabsf(qn), einv[jj]); }
        }
        __syncthreads();
        {
            f32x4 o[4];
            const int el = 16 * wv + fr;
            bf16x8 vfr[2];
            for (int rpM = 0; rpM < REP_MFMA; ++rpM) {
#pragma unroll
            for (int mt = 0; mt < 4; ++mt) o[mt] = (f32x4){0.f, 0.f, 0.f, 0.f};
#pragma unroll
            for (int ks = 0; ks < 16; ++ks) {
                u32x4v bw; bw.x = pg8::cvt_pk_bf16(C[2 * ks][0], C[2 * ks][1]); bw.y = pg8::cvt_pk_bf16(C[2 * ks][2], C[2 * ks][3]);
                bw.z = pg8::cvt_pk_bf16(C[2 * ks + 1][0], C[2 * ks + 1][1]); bw.w = pg8::cvt_pk_bf16(C[2 * ks + 1][2], C[2 * ks + 1][3]);
                const bf16x8 bfr = __builtin_bit_cast(bf16x8, bw);
#pragma unroll
                for (int mt = 0; mt < 4; ++mt) { const int off = (16 * mt + fr) * 1040 + 8 * fq;
                    const u32x2 lo = *(const LAS u32x2*)(QS + off + 64 * ks), hi = *(const LAS u32x2*)(QS + off + 64 * ks + 32);
                    u32x4v aw; aw.x = lo.x; aw.y = lo.y; aw.z = hi.x; aw.w = hi.y;
                    o[mt] = __builtin_amdgcn_mfma_f32_16x16x32_bf16(__builtin_bit_cast(bf16x8, aw), bfr, o[mt], 0, 0, 0); }
                if ((ks & 1) == 1) __builtin_amdgcn_sched_barrier(0); }
#pragma unroll
            for (int mt = 0; mt < 4; ++mt)
#pragma unroll
                for (int r = 0; r < 4; ++r) o[mt][r] *= winter[16 * mt + 4 * fq + r];
#pragma unroll
            for (int k2 = 0; k2 < 2; ++k2) { vfr[k2] = *(const LAS bf16x8*)(VT + el * 128 + (((4 * k2 + fq) ^ (el & 7)) << 4));
#pragma unroll
                for (int mt = 0; mt < 4; ++mt) { const int jr = 16 * mt + fr; const bf16x8 a = *(const LAS bf16x8*)(ST + jr * 128 + (((4 * k2 + fq) ^ (jr & 7)) << 4));
                    o[mt] = __builtin_amdgcn_mfma_f32_16x16x32_bf16(a, vfr[k2], o[mt], 0, 0, 0); } }
            }
#pragma unroll
            for (int mt = 0; mt < 4; ++mt)
#pragma unroll
                for (int r = 0; r < 4; ++r) { const int jr = 16 * mt + 4 * fq + r, T = tok(jr); const float hv = o[mt][r] * dinv[jr];
                    u16* dst = dir == 0 ? hf + (size_t)T * INNER : hb_ptr(kp, T); dst[hd * DH + es * 128 + el] = f2bf(hv); }
            const float decay = scal[0];
#pragma unroll
            for (int i = 0; i < 32; ++i) C[i] = C[i] * decay;
#pragma unroll
            for (int k2 = 0; k2 < 2; ++k2) { float vv[8]; unpack8(__builtin_bit_cast(u32x4v, vfr[k2]), vv);
#pragma unroll
                for (int e = 0; e < 8; ++e) vv[e] *= kws[32 * k2 + 8 * fq + e];
                const bf16x8 bsc = __builtin_bit_cast(bf16x8, pack8(vv));
#pragma unroll
                for (int dt = 0; dt < 32; ++dt) { const int dr = 16 * dt + fr; const bf16x8 a = *(const LAS bf16x8*)(KT + dr * 128 + (((4 * k2 + fq) ^ (dr & 7)) << 4));
                    C[dt] = __builtin_amdgcn_mfma_f32_16x16x32_bf16(a, bsc, C[dt], 0, 0, 0);
                    if ((dt & 7) == 7) __builtin_amdgcn_sched_barrier(0); } }
            { float nn = decay * nst[tid];
#pragma unroll
              for (int g = 0; g < 8; ++g) { float kv[8]; unpack8(*(const LAS u32x4v*)(KT + tid * 128 + ((g ^ (tid & 7)) << 4)), kv);
#pragma unroll
                  for (int e = 0; e < 8; ++e) nn += kv[e] * kws[8 * g + e]; }
              nst[tid] = nn; }
            m_st = scal[1];
        }
    }
}

__device__ __forceinline__ void ml_gate_phase(KPC kp, int j) {
    u16* hf = (u16*)(kp->ws + OFF_R2); const u16* xc = (const u16*)(kp->ws + OFF_XC); const u16* z = (const u16*)(kp->ws + OFF_XM);
    const float* ng = kp->in[I_MLNG] + (size_t)j * INNER; const float* sk = kp->in[I_MLSKIP] + (size_t)j * INNER;
    const int lane = ltid() & 63, wv = ltid() >> 6;
    for (int T = lbid() * 8 + wv; T < NTOK; T += gridDim.x * 8) {
        const u16* hbp = hb_ptr(kp, T);
#pragma unroll
        for (int hd = 0; hd < 4; ++hd) { const int c0 = hd * DH + lane * 8; float a[8], bq[8], xv[8], zv[8], o[8];
            unpack8(*(const u32x4v*)(hf + (size_t)T * INNER + c0), a); unpack8(*(const u32x4v*)(hbp + c0), bq);
            float s = 0.f;
#pragma unroll
            for (int e = 0; e < 8; ++e) { a[e] += bq[e]; s += a[e]; }
            const float mu = wave_sum(s) * (1.0f / DH); float vs = 0.f;
#pragma unroll
            for (int e = 0; e < 8; ++e) { a[e] -= mu; vs += a[e] * a[e]; }
            const float rs = rsqrtf(wave_sum(vs) * (1.0f / DH) + 1e-5f);
            unpack8(*(const u32x4v*)(xc + (size_t)T * INNER + c0), xv); unpack8(*(const u32x4v*)(z + (size_t)T * INNER + c0), zv);
#pragma unroll
            for (int e = 0; e < 8; ++e) o[e] = (a[e] * rs * ng[c0 + e] + sk[c0 + e] * xv[e]) * siluf(zv[e]);
            *(u32x4v*)(hf + (size_t)T * INNER + c0) = pack8(o); }
    }
}


enum { K_SETUP = 0, K_CN, K_G1, K_G2R, K_HYIN, K_HYCONV, K_HYTR, K_MLUPX, K_MLPREP, K_MLSCAN, K_MLUPZ, K_MLGATE, K_FINAL };
constexpr int NPHASE = 1 + 11 + 13 + 11 + 13 + 1;
__device__ __forceinline__ void decode_phase(int ph, int& kind, int& l, int& arg) {
    kind = K_SETUP; l = 0; arg = 0; if (ph == 0) return;
    ph -= 1;
    for (l = 0; l < 4; ++l) { const int n = (l & 1) ? 13 : 11; if (ph < n) break; ph -= n; }
    if (l == 4) { kind = K_FINAL; l = 0; return; }
    if (ph == 0) { kind = K_CN; arg = 0; return; } if (ph == 1) { kind = K_G1; arg = 0; return; } if (ph == 2) { kind = K_G2R; arg = 0; return; } if (ph == 3) { kind = K_CN; arg = 1; return; }
    const int nm = (l & 1) ? 6 : 4;
    if (ph < 4 + nm) { const int q = ph - 4;
        if (l & 1) { kind = q == 0 ? K_MLUPX : q == 1 ? K_MLPREP : q == 2 ? K_MLSCAN : q == 3 ? K_MLUPZ : q == 4 ? K_MLGATE : K_G2R; arg = 2; }
        else { kind = q == 0 ? K_HYIN : q == 1 ? K_HYCONV : q == 2 ? K_HYTR : K_G2R; arg = 2; }
        return; }
    ph -= 4 + nm;
    if (ph == 0) { kind = K_CN; arg = 2; return; } if (ph == 1) { kind = K_G1; arg = 1; return; } kind = K_G2R; arg = 1;
}

__device__ __forceinline__ void gbar(unsigned* ctr, unsigned target) {
    __syncthreads();
    if (ltid() == 0) {
        __builtin_amdgcn_fence(__ATOMIC_RELEASE, "agent");
        __hip_atomic_fetch_add(ctr, 1u, __ATOMIC_RELAXED, __HIP_MEMORY_SCOPE_AGENT);
        while (__hip_atomic_load(ctr, __ATOMIC_RELAXED, __HIP_MEMORY_SCOPE_AGENT) < target) __builtin_amdgcn_s_sleep(2);
        __builtin_amdgcn_fence(__ATOMIC_ACQUIRE, "agent");
    }
    __syncthreads();
}
#ifndef REPMASK
#define REPMASK 0
#define REPN 1
#endif
template <int MIX> __device__ __forceinline__ void run_phases(int lo, int hi, int ph_lo, int ph_hi, LAS unsigned char* lds0, cg::grid_group& grid) {
    lo = lo > ph_lo ? lo : ph_lo; hi = hi < ph_hi ? hi : ph_hi;
    for (int ph = lo; ph < hi; ++ph) {
        KPC kp = (KPC)__builtin_amdgcn_kernarg_segment_ptr(); asm volatile("" : "+s"(kp) :: "memory");
        LAS unsigned char* lds = lds0; asm volatile("" : "+s"(lds) :: "memory");
        unsigned char* ws = kp->ws; unsigned char* wb = ws + OFF_WB;
        int kind, l, arg; decode_phase(ph, kind, l, arg); const int j = l >> 1;
        const float* modl = (const float*)(ws + OFF_MOD) + (size_t)l * 5 * 9216;
        const int nrep = ((REPMASK >> kind) & 1) ? REPN : 1;
        for (int rep = 0; rep < nrep; ++rep) {
        if (kind == K_SETUP) { if constexpr (MIX == 0) setup_phase(kp, (LAS float*)lds); }
        else if (kind == K_CN) {
            if (arg == 0) { convert_layer(kp, l, (LAS float*)lds); if constexpr (MIX == 1) ml_m_phase(kp, j); }
            if constexpr (MIX == 0) { if (arg == 1) hy_mlp_phase(kp, j); }
            norm_phase(kp, l, arg);
        } else if (kind == K_G1) {
            pg8::Gemm g{(const u16*)(ws + OFF_U), (const u16*)(wb + (arg ? WB_FIN1 : WB_FIN0)), NTOK, 2 * FF, D};
            pg8::StaticOrder S; S.init(g.M, g.N, (int)gridDim.x, lbid()); EpiSwiglu E{(u16*)(ws + OFF_R1)};
            pg8::gemm_phase<EpiSwiglu, pg8::StaticOrder, false>(lds, g, S, E, nullptr);
        } else if (kind == K_G2R) {
            pg8::Gemm g; EpiResid E; E.h = (float*)(ws + OFF_H); E.modl = modl;
            if (arg < 2) { g = pg8::Gemm{(const u16*)(ws + OFF_R1), (const u16*)(wb + (arg ? WB_FOUT1 : WB_FOUT0)), NTOK, D, FF}; E.gidx = arg ? 8 : 2; E.scale = 0.5f; E.bias = nullptr; }
            else if (MIX == 1) { g = pg8::Gemm{(const u16*)(ws + OFF_R2), (const u16*)(wb + WB_MOUT), NTOK, D, INNER}; E.gidx = 5; E.scale = 1.0f; E.bias = nullptr; }
            else { g = pg8::Gemm{(const u16*)(ws + OFF_U), (const u16*)(wb + WB_MOUT), NTOK, D, D}; E.gidx = 5; E.scale = 1.0f; E.bias = kp->in[I_HYBOUT] + (size_t)j * D; }
            pg8::StaticOrder S; S.init(g.M, g.N, (int)gridDim.x, lbid());
            pg8::gemm_phase<EpiResid, pg8::StaticOrder, false>(lds, g, S, E, nullptr);
        } else if (kind == K_FINAL) { if constexpr (MIX == 1) final_phase(kp); }
        else if constexpr (MIX == 0) {
            if (kind == K_HYIN) {
                pg8::Gemm g{(const u16*)(wb + WB_MIN), (const u16*)(ws + OFF_U), 3 * D, NTOK, D};
                pg8::StaticOrder S; S.init(g.M, g.N, (int)gridDim.x, lbid());
                EpiProjT E{(u16*)(ws + OFF_R1 + HY_PL), (u16*)(ws + OFF_R1 + HY_PC), kp->in[I_HYBIN] + (size_t)j * 3 * D};
                pg8::gemm_phase<EpiProjT, pg8::StaticOrder, false>(lds, g, S, E, nullptr);
                __syncthreads();
                for (int t = lbid(); t < 2048; t += gridDim.x) hy_filter_task(kp, j, t, (LAS f32x2*)lds, (LAS float*)(lds + 131072));
            } else if (kind == K_HYCONV) {
                for (int t = lbid(); t < 2048; t += gridDim.x) hy_conv_lat(kp, j, t, (LAS f32x2*)lds);
                for (int t = lbid(); t < 1024; t += gridDim.x) hy_conv_ctx(kp, j, t, (LAS float*)lds);
            } else if (kind == K_HYTR) hy_transpose(kp, (LAS u16*)lds);
        } else {
            if (kind == K_MLUPX || kind == K_MLUPZ) {
                const bool zz = kind == K_MLUPZ;
                pg8::Gemm g{(const u16*)(ws + OFF_U), (const u16*)(wb + WB_MIN) + (zz ? (size_t)INNER * D : 0), NTOK, INNER, D};
                pg8::StaticOrder S; S.init(g.M, g.N, (int)gridDim.x, lbid()); EpiBf E{(u16*)(ws + OFF_XM), INNER};
                pg8::gemm_phase<EpiBf, pg8::StaticOrder, false>(lds, g, S, E, nullptr);
            } else if (kind == K_MLPREP) { for (int t = lbid(); t < NB * NCH * 4; t += gridDim.x) ml_prep_task(kp, j, t, lds); }
            else if (kind == K_MLSCAN) { for (int t = lbid(); t < 128; t += gridDim.x) ml_scan_task(kp, j, t, lds); }
            else if (kind == K_MLGATE) ml_gate_phase(kp, j);
        }
        }
        if (ph + 1 < ph_hi) gbar((unsigned*)(kp->ws + OFF_MLM + 65536), (unsigned)(ph + 1 - ph_lo) * gridDim.x);
    }
}

__global__ void __launch_bounds__(512) fwd_megakernel(KP kparg) {
    extern __shared__ __attribute__((aligned(16))) unsigned char shm[];
    LAS unsigned char* lds = (LAS unsigned char*)shm;
    cg::grid_group grid = cg::this_grid();
    grid.sync();
    wtab_init();
    const int ph_lo = kparg.ph_lo, ph_hi = kparg.ph_hi;
    run_phases<0>(0, 12, ph_lo, ph_hi, lds, grid);
    run_phases<1>(12, 25, ph_lo, ph_hi, lds, grid);
    run_phases<0>(25, 36, ph_lo, ph_hi, lds, grid);
    run_phases<1>(36, 50, ph_lo, ph_hi, lds, grid);
}

extern "C" void kernel_launch(void* const* d_in, const int* in_sizes, int n_in, void* d_out, int out_size, void* d_ws, size_t ws_size, hipStream_t stream) {
    static int grid_blocks = 0;
    if (!grid_blocks) {
        int dev = 0, cus = 0, per_cu = 0;
        hipGetDevice(&dev);
        hipDeviceGetAttribute(&cus, hipDeviceAttributeMultiprocessorCount, dev);
        hipFuncSetAttribute((const void*)fwd_megakernel, hipFuncAttributeMaxDynamicSharedMemorySize, LDS_BYTES);
        hipOccupancyMaxActiveBlocksPerMultiprocessor(&per_cu, fwd_megakernel, 512, LDS_BYTES);
        if (per_cu < 1) per_cu = 1;
        grid_blocks = cus * 1;
        if (ws_size < WS_NEED2) fprintf(stderr, "workspace too small: %zu < %zu\n", ws_size, (size_t)WS_NEED2);
    }
    KP hp{};
    for (int i = 0; i < 36; ++i) hp.in[i] = (const float*)d_in[i];
    hp.out = (float*)d_out; hp.ws = (unsigned char*)d_ws; hp.ph_lo = 0; hp.ph_hi = NPHASE;
    void* args[] = {&hp};
    hipMemsetAsync((unsigned char*)d_ws + OFF_MLM + 65536, 0, 256, stream);
    hipError_t e = hipLaunchCooperativeKernel((void*)fwd_megakernel, dim3(grid_blocks), dim3(512), args, LDS_BYTES, stream);
    if (e != hipSuccess) fprintf(stderr, "cooperative launch failed: %s (grid %d)\n", hipGetErrorString(e), grid_blocks);
}
```

```cpp
#define REPMASK 0
#define REPN 1
#include <hip/hip_runtime.h>
#include <hip/hip_cooperative_groups.h>
#include <cstdio>
namespace cg = cooperative_groups;
#define WTAB_OFF 163584
__device__ __forceinline__ int llane() { int l; asm volatile("v_mbcnt_lo_u32_b32 %0, -1, 0\n\tv_mbcnt_hi_u32_b32 %0, -1, %0" : "=v"(l) :: "memory"); return l; }
__device__ __forceinline__ int lwave() { extern __shared__ __attribute__((aligned(16))) unsigned char shm_w[];
    const int hw = __builtin_amdgcn_s_getreg(10244) & 63;
    return __builtin_amdgcn_readfirstlane(*(const __attribute__((address_space(3))) int*)((__attribute__((address_space(3))) unsigned char*)shm_w + WTAB_OFF + hw * 4)); }
__device__ __forceinline__ void wtab_init() { extern __shared__ __attribute__((aligned(16))) unsigned char shm_w[];
    const int hw = __builtin_amdgcn_s_getreg(10244) & 63;
    *(__attribute__((address_space(3))) int*)((__attribute__((address_space(3))) unsigned char*)shm_w + WTAB_OFF + hw * 4) = (int)(threadIdx.x >> 6); }
__device__ __forceinline__ int ltid() { return lwave() * 64 + llane(); }
__device__ __forceinline__ int lbid() { int t = blockIdx.x; asm volatile("" : "+s"(t) :: "memory"); return t; }
namespace pg8 {
#define PG8_LAS __attribute__((address_space(3)))
typedef unsigned short bf16_t;
typedef short bf16x8 __attribute__((ext_vector_type(8)));
typedef float f32x4 __attribute__((ext_vector_type(4)));
typedef unsigned u32x4 __attribute__((ext_vector_type(4)));
constexpr int BM = 256, BK = 64, HALF = 128, HTB = HALF * BK * 2  , STAGE_BYTES = 8 * HTB, NXCD = 8, WGM = 8;

__host__ __device__ __forceinline__ int lds_byte(int r, int c) { const int st = (r >> 4) * 2 + (c >> 5), rr = r & 15, cc = c & 31, ob = rr * 64 + cc * 2; return st * 1024 + (ob ^ (((ob >> 9) & 1) << 5)); }
__host__ __device__ __forceinline__ void stage_rc(int b, int& R, int& C) { const int st = b / 1024, sb = b % 1024, swz = sb ^ (((sb >> 9) & 1) << 5); R = (st >> 1) * 16 + swz / 64; C = (st & 1) * 32 + (swz % 64) / 2; }
__host__ __device__ __forceinline__ int perm32(int rho) { const int n = rho >> 4, i = rho & 15; return 8 * (i >> 2) + 4 * n + (i & 3); }

struct Unit { int pm, pn, kofs; };
struct Gemm { const bf16_t* A; const bf16_t* Bt; int M, N, K, ldk; };

struct StaticOrder {
    int nM, nN, nwg, G, c;
    __host__ __device__ void init(int M, int N, int G_, int c_) { nM = M / BM; nN = N / BM; nwg = nM * nN; G = G_; c = c_; }
    __host__ __device__ bool next(int i, Unit& u) const {
        const long L = (long)i * G + c; if (L >= nwg) return false;
        int wgid = (int)L; { const int q = nwg / NXCD, r = nwg % NXCD, xcd = wgid % NXCD, off = wgid / NXCD; wgid = (xcd < r ? xcd * (q + 1) : r * (q + 1) + (xcd - r) * q) + off; }
        const int nig = WGM * nN, gid = wgid / nig, fm = gid * WGM, gsz = (nM - fm) < WGM ? (nM - fm) : WGM;
        u.pm = fm + ((wgid % nig) % gsz); u.pn = (wgid % nig) / gsz; u.kofs = 0; return true;
    }
    __device__ __forceinline__ void a_ready(const Unit&) const {}
    __device__ __forceinline__ void done(const Unit&) const {}
};
__device__ __forceinline__ unsigned cvt_pk_bf16(float lo, float hi) { unsigned r; asm volatile("v_cvt_pk_bf16_f32 %0, %1, %2" : "=v"(r) : "v"(lo), "v"(hi)); return r; }
template <class Epi, class Sched, bool STAMP = false>
__device__ __forceinline__ void gemm_phase(PG8_LAS unsigned char* lds, const Gemm g, const Sched& S, const Epi& E, unsigned long long* stamps) {
    const int tid = ltid(), wid = __builtin_amdgcn_readfirstlane(tid >> 6), lane = tid & 63, wr = wid >> 2, wc = wid & 3, fr = lane & 15, fq = lane >> 4;
    const int K = g.K, nt = K / BK, ldk = g.ldk ? g.ldk : g.K;
    int ts_lo = 0, ts_hi = 0, nts = 0; const unsigned long long rt_entry = STAMP ? (unsigned long long)wall_clock64() : 0ull;
#define PG8_STAMP() do { if (STAMP && wid == 0 && nts < 64) { const unsigned long long _c = (unsigned long long)clock64(); \
        ts_lo = (lane == nts) ? (int)(unsigned)_c : ts_lo; ts_hi = (lane == nts) ? (int)(unsigned)(_c >> 32) : ts_hi; ++nts; } } while (0)
    PG8_STAMP();
    unsigned voffA[2], voffB[2];
#pragma unroll
    for (int i = 0; i < 2; ++i) { int R, C; stage_rc(tid * 16 + i * 8192, R, C); const int Rb = Epi::PERM ? ((R & ~31) + perm32(R & 31)) : R;
        voffA[i] = (unsigned)(R * ldk + C) * 2u; voffB[i] = (unsigned)(Rb * ldk + C) * 2u; }
    const size_t kstep = (size_t)(BK * 2);
    const size_t hstep = (size_t)HALF * ldk * 2;
    const size_t tstep = 2 * hstep;
    const unsigned ldsw = (unsigned)wid * 1024u;
    const int aoff = lds_byte(wr * 64 + fr, fq * 8), boff = lds_byte(wc * 32 + fr, fq * 8);
#define PG8_SA(b, h) (((b) * 2 + (h)) * HTB)
#define PG8_SB(b, h) ((4 + (b) * 2 + (h)) * HTB)
#define PG8_STAGE(bufoff, gbase, voff) do { _Pragma("unroll") for (int _i = 0; _i < 2; ++_i) \
        __builtin_amdgcn_global_load_lds((const unsigned*)((const char*)(gbase) + (voff)[_i]), (PG8_LAS unsigned*)(lds + (bufoff) + ldsw + _i * 8192), 16, 0, 0); } while (0)
#define PG8_LDA(dst, b, h) do { _Pragma("unroll") for (int m = 0; m < 4; ++m) _Pragma("unroll") for (int k = 0; k < 2; ++k) dst[m][k] = *(const PG8_LAS bf16x8*)(lds + PG8_SA(b, h) + aoff + m * 2048 + k * 1024); } while (0)
#define PG8_LDB(dst, b, h) do { _Pragma("unroll") for (int n = 0; n < 2; ++n) _Pragma("unroll") for (int k = 0; k < 2; ++k) dst[n][k] = *(const PG8_LAS bf16x8*)(lds + PG8_SB(b, h) + boff + n * 2048 + k * 1024); } while (0)
#define PG8_MMA(ai, bj, At, Bt) do { __builtin_amdgcn_s_setprio(1); _Pragma("unroll") for (int m = 0; m < 4; ++m) _Pragma("unroll") for (int n = 0; n < 2; ++n) _Pragma("unroll") for (int k = 0; k < 2; ++k) \
        acc[ai][bj][m][n] = __builtin_amdgcn_mfma_f32_16x16x32_bf16(Bt[n][k], At[m][k], acc[ai][bj][m][n], 0, 0, 0); __builtin_amdgcn_s_setprio(0); } while (0)
#define PG8_WAIT_V(n) asm volatile("s_waitcnt vmcnt(" #n ")" ::: "memory")
#define PG8_WAIT_L(n) asm volatile("s_waitcnt lgkmcnt(" #n ")" ::: "memory")
#define PG8_BAR __builtin_amdgcn_s_barrier()
#define PG8_SCHED __builtin_amdgcn_sched_barrier(0)
    Unit cur, nxt; int ui = 0;
    if (!S.next(0, cur)) return;
    f32x4 acc[2][2][4][2];
#pragma unroll
    for (int a = 0; a < 2; ++a)
#pragma unroll
        for (int b = 0; b < 2; ++b)
#pragma unroll
            for (int m = 0; m < 4; ++m)
#pragma unroll
                for (int n = 0; n < 2; ++n) acc[a][b][m][n] = (f32x4){0.f, 0.f, 0.f, 0.f};
    bf16x8 At[4][2], B0[2][2], B1[2][2];
    const char* cA = (const char*)g.A + (size_t)cur.pm * tstep + (size_t)cur.kofs * 2; const char* cB = (const char*)g.Bt + (size_t)cur.pn * tstep + (size_t)cur.kofs * 2;
    S.a_ready(cur);
    PG8_STAGE(PG8_SB(0, 0), cB, voffB); PG8_STAGE(PG8_SA(0, 0), cA, voffA); PG8_STAGE(PG8_SB(0, 1), cB + hstep, voffB); PG8_STAGE(PG8_SA(0, 1), cA + hstep, voffA);
    if (wr == 1) PG8_BAR;
    PG8_WAIT_V(4); PG8_BAR;
    PG8_STAGE(PG8_SB(1, 0), cB + kstep, voffB); PG8_STAGE(PG8_SA(1, 0), cA + kstep, voffA); PG8_STAGE(PG8_SB(1, 1), cB + hstep + kstep, voffB);
    PG8_WAIT_V(6); PG8_BAR;
    PG8_STAMP();
    for (;;) {
        const bool has_next = S.next(ui + 1, nxt);
        const char* nA = has_next ? (const char*)g.A + (size_t)nxt.pm * tstep + (size_t)nxt.kofs * 2 : cA; const char* nB = has_next ? (const char*)g.Bt + (size_t)nxt.pn * tstep + (size_t)nxt.kofs * 2 : cB;
        for (int t = 0; t < nt; t += 2) {
            const bool last = (t == nt - 2);
            const char* a1 = cA + (size_t)(t + 1) * kstep;
            const char* a2 = last ? nA : cA + (size_t)(t + 2) * kstep; const char* b2 = last ? nB : cB + (size_t)(t + 2) * kstep;
            const char* a3 = a2 + kstep; const char* b3 = b2 + kstep;
            if (last && has_next) S.a_ready(nxt);
            PG8_LDB(B0, 0, 0); PG8_SCHED; PG8_LDA(At, 0, 0); PG8_STAGE(PG8_SA(1, 1), a1 + hstep, voffA);
            PG8_WAIT_L(8); PG8_BAR; PG8_WAIT_L(0); PG8_MMA(0, 0, At, B0); PG8_BAR; PG8_SCHED;
            PG8_LDB(B1, 0, 1); PG8_STAGE(PG8_SB(0, 0), b2, voffB);
            PG8_BAR; PG8_WAIT_L(0); PG8_MMA(0, 1, At, B1); PG8_BAR;
            PG8_LDA(At, 0, 1); PG8_STAGE(PG8_SA(0, 0), a2, voffA);
            PG8_BAR; PG8_WAIT_L(0); PG8_MMA(1, 0, At, B0); PG8_BAR; PG8_SCHED;
            PG8_STAGE(PG8_SB(0, 1), b2 + hstep, voffB);
            PG8_WAIT_V(6); PG8_BAR; PG8_MMA(1, 1, At, B1); PG8_BAR;
            PG8_LDB(B0, 1, 0); PG8_SCHED; PG8_LDA(At, 1, 0); PG8_STAGE(PG8_SA(0, 1), a2 + hstep, voffA);
            PG8_WAIT_L(8); PG8_BAR; PG8_WAIT_L(0); PG8_MMA(0, 0, At, B0); PG8_BAR; PG8_SCHED;
            PG8_LDB(B1, 1, 1); PG8_STAGE(PG8_SB(1, 0), b3, voffB);
            PG8_BAR; PG8_WAIT_L(0); PG8_MMA(0, 1, At, B1); PG8_BAR;
            PG8_LDA(At, 1, 1); PG8_STAGE(PG8_SA(1, 0), a3, voffA);
            PG8_BAR; PG8_WAIT_L(0); PG8_MMA(1, 0, At, B0); PG8_BAR; PG8_SCHED;
            PG8_STAGE(PG8_SB(1, 1), b3 + hstep, voffB);
            PG8_WAIT_V(6); PG8_BAR; PG8_MMA(1, 1, At, B1); PG8_BAR;
        }
        PG8_STAMP();
        if constexpr (!Epi::AFTER_DRAIN) { E(acc, cur, wr, wc, fr, fq); S.done(cur); }
        PG8_STAMP();
        if (!has_next) break;
#pragma unroll
        for (int a = 0; a < 2; ++a)
#pragma unroll
            for (int b = 0; b < 2; ++b)
#pragma unroll
                for (int m = 0; m < 4; ++m)
#pragma unroll
                    for (int n = 0; n < 2; ++n) acc[a][b][m][n] = (f32x4){0.f, 0.f, 0.f, 0.f};
        cur = nxt; cA = nA; cB = nB; ++ui;
    }
    PG8_WAIT_V(0);
    if (wr == 0) PG8_BAR;
    PG8_BAR;
    if constexpr (Epi::AFTER_DRAIN) { E.fused(acc, cur, wr, wc, fr, fq, lds, wid, lane); S.done(cur); }
    PG8_STAMP();
    if (STAMP && wid == 0) { stamps[lane] = lane < nts ? (((unsigned long long)(unsigned)ts_hi << 32) | (unsigned)ts_lo) : 0ull;
        if (lane == 62) stamps[62] = rt_entry; if (lane == 63) stamps[63] = (unsigned long long)wall_clock64(); }
#undef PG8_STAMP
#undef PG8_SA
#undef PG8_SB
#undef PG8_STAGE
#undef PG8_LDA
#undef PG8_LDB
#undef PG8_MMA
#undef PG8_WAIT_V
#undef PG8_WAIT_L
#undef PG8_BAR
#undef PG8_SCHED
}
}

typedef unsigned short u16;
using pg8::f32x4; using pg8::bf16x8;
typedef float f32x2 __attribute__((ext_vector_type(2)));
typedef unsigned u32x2 __attribute__((ext_vector_type(2)));
typedef unsigned u32x4v __attribute__((ext_vector_type(4)));
typedef short s16x4 __attribute__((ext_vector_type(4)));
#define LAS __attribute__((address_space(3)))
constexpr int D = 1024, NB = 4, SEQ = 8192, CTX = 256, TPB = 8448, NTOK = 33792, FF = 2816, NCH = 132, INNER = 2048, DH = 512, NFFT = 16384;
constexpr size_t MiB = 1u << 20;
constexpr size_t OFF_WB = 0, OFF_MOD = 48 * MiB, OFF_H = 49 * MiB, OFF_U = OFF_H + 132 * MiB, OFF_R1 = OFF_U + 66 * MiB, OFF_R2 = OFF_R1 + 264 * MiB,
                 OFF_HBC = OFF_R2 + 132 * MiB, OFF_GATES = OFF_HBC + 4 * MiB, OFF_H2 = OFF_GATES + 3 * MiB, OFF_KCTX = OFF_H2 + 3 * MiB, WS_NEED = OFF_KCTX + 4 * MiB;
constexpr size_t WB_FIN0 = 0, WB_FIN1 = 11 * MiB, WB_FOUT0 = 22 * MiB, WB_FOUT1 = 22 * MiB + 5632 * 1024, WB_MIN = 33 * MiB, WB_MOUT = 41 * MiB, WB_WGT = 45 * MiB;
constexpr int LDS_BYTES = 163840;
struct KP { const float* in[36]; float* out; unsigned char* ws; int ph_lo, ph_hi; };
typedef const KP __attribute__((address_space(4))) * KPC;
enum { I_X = 0, I_C, I_CTX, I_CCTX, I_ADAW, I_ADAB, I_NORMG, I_FINALG, I_FFNIN, I_FFNOUT, I_HYWIN, I_HYBIN, I_HYCW, I_HYCB, I_HYW1, I_HYB1, I_HYW2, I_HYB2, I_HYW3, I_HYB3,
       I_HYFREQ, I_HYDECAY, I_HYSKIP, I_HYWOUT, I_HYBOUT, I_MLUP, I_MLCW, I_MLCB, I_MLWQ, I_MLWK, I_MLWV, I_MLWG, I_MLBG, I_MLNG, I_MLSKIP, I_MLDOWN };

__device__ __forceinline__ float bf2f(u16 b) { return __uint_as_float(((unsigned)b) << 16); }
__device__ __forceinline__ float bflo(unsigned w) { return __uint_as_float(w << 16); }
__device__ __forceinline__ float bfhi(unsigned w) { return __uint_as_float(w & 0xffff0000u); }
__device__ __forceinline__ u16 f2bf(float f) { return (u16)(pg8::cvt_pk_bf16(f, 0.f) & 0xffffu); }
__device__ __forceinline__ float siluf(float x) { return x / (1.0f + __expf(-x)); }
__device__ __forceinline__ int modrow_of_token(int T) { const int b = T / TPB, t = T - b * TPB; return t < CTX ? 4 : b; }
__device__ __forceinline__ float lshfl(float v, int srclane) { return __int_as_float(__builtin_amdgcn_ds_bpermute(srclane << 2, __float_as_int(v))); }
__device__ __forceinline__ float wave_sum(float v) { const int lane = llane();
#pragma unroll
    for (int o = 32; o > 0; o >>= 1) v += lshfl(v, lane ^ o);
    return v; }
__device__ __forceinline__ float wave_max(float v) { const int lane = llane();
#pragma unroll
    for (int o = 32; o > 0; o >>= 1) v = fmaxf(v, lshfl(v, lane ^ o));
    return v; }

__device__ __forceinline__ void unpack8(u32x4v w, float (&f)[8]) { f[0] = bflo(w.x); f[1] = bfhi(w.x); f[2] = bflo(w.y); f[3] = bfhi(w.y); f[4] = bflo(w.z); f[5] = bfhi(w.z); f[6] = bflo(w.w); f[7] = bfhi(w.w); }
__device__ __forceinline__ u32x4v pack8(const float (&f)[8]) { u32x4v w; w.x = pg8::cvt_pk_bf16(f[0], f[1]); w.y = pg8::cvt_pk_bf16(f[2], f[3]); w.z = pg8::cvt_pk_bf16(f[4], f[5]); w.w = pg8::cvt_pk_bf16(f[6], f[7]); return w; }

struct EpiSwiglu {
    static constexpr bool PERM = true, AFTER_DRAIN = false;
    u16* act;
    __device__ __forceinline__ void operator()(const f32x4 (&acc)[2][2][4][2], const pg8::Unit& u, int wr, int wc, int fr, int fq) const {
        const int row0 = u.pm * 256 + wr * 64 + fr, col0 = u.pn * 128 + wc * 32 + 8 * fq;
#pragma unroll
        for (int ai = 0; ai < 2; ++ai)
#pragma unroll
            for (int m = 0; m < 4; ++m) {
                const f32x4 g0 = acc[ai][0][m][0], g1 = acc[ai][0][m][1], v0 = acc[ai][1][m][0], v1 = acc[ai][1][m][1];
                u32x4v w;
                w.x = pg8::cvt_pk_bf16(siluf(g0[0]) * v0[0], siluf(g0[1]) * v0[1]); w.y = pg8::cvt_pk_bf16(siluf(g0[2]) * v0[2], siluf(g0[3]) * v0[3]);
                w.z = pg8::cvt_pk_bf16(siluf(g1[0]) * v1[0], siluf(g1[1]) * v1[1]); w.w = pg8::cvt_pk_bf16(siluf(g1[2]) * v1[2], siluf(g1[3]) * v1[3]);
                *(u32x4v*)(act + (size_t)(row0 + ai * 128 + m * 16) * FF + col0) = w; }
    }
};
struct EpiResid {
    static constexpr bool PERM = false, AFTER_DRAIN = false;
    float* h; const float* modl; int gidx; float scale; const float* bias;
    __device__ __forceinline__ void operator()(const f32x4 (&acc)[2][2][4][2], const pg8::Unit& u, int wr, int wc, int fr, int fq) const {
        const int row0 = u.pm * 256 + wr * 64 + fr, col0 = u.pn * 256 + wc * 32 + 4 * fq;
        const int mr = modrow_of_token(u.pm * 256);
        const float* gp = modl + (size_t)mr * 9216 + gidx * 1024;
        f32x4 gv[2][2], bv[2][2];
#pragma unroll
        for (int bj = 0; bj < 2; ++bj)
#pragma unroll
            for (int n = 0; n < 2; ++n) { gv[bj][n] = *(const f32x4*)(gp + col0 + bj * 128 + n * 16) * scale;
                bv[bj][n] = bias ? *(const f32x4*)(bias + col0 + bj * 128 + n * 16) : (f32x4){0.f, 0.f, 0.f, 0.f}; }
#pragma unroll
        for (int ai = 0; ai < 2; ++ai)
#pragma unroll
            for (int m = 0; m < 4; ++m) { float* rowp = h + (size_t)(row0 + ai * 128 + m * 16) * D + col0;
#pragma unroll
                for (int bj = 0; bj < 2; ++bj)
#pragma unroll
                    for (int n = 0; n < 2; ++n) { f32x4* q = (f32x4*)(rowp + bj * 128 + n * 16); *q = *q + gv[bj][n] * (acc[ai][bj][m][n] + bv[bj][n]); } }
    }
};
struct EpiBf {
    static constexpr bool PERM = true, AFTER_DRAIN = false;
    u16* O; int ldc;
    __device__ __forceinline__ void operator()(const f32x4 (&acc)[2][2][4][2], const pg8::Unit& u, int wr, int wc, int fr, int fq) const {
        const int row0 = u.pm * 256 + wr * 64 + fr, col0 = u.pn * 256 + wc * 32 + 8 * fq;
#pragma unroll
        for (int ai = 0; ai < 2; ++ai)
#pragma unroll
            for (int m = 0; m < 4; ++m)
#pragma unroll
                for (int bj = 0; bj < 2; ++bj) { const f32x4 a = acc[ai][bj][m][0], b = acc[ai][bj][m][1]; u32x4v w;
                    w.x = pg8::cvt_pk_bf16(a[0], a[1]); w.y = pg8::cvt_pk_bf16(a[2], a[3]); w.z = pg8::cvt_pk_bf16(b[0], b[1]); w.w = pg8::cvt_pk_bf16(b[2], b[3]);
                    *(u32x4v*)(O + (size_t)(row0 + ai * 128 + m * 16) * ldc + col0 + bj * 128) = w; }
    }
};
struct EpiProjT {
    static constexpr bool PERM = true, AFTER_DRAIN = false;
    u16* lat; u16* ctx; const float* bias;
    __device__ __forceinline__ void operator()(const f32x4 (&acc)[2][2][4][2], const pg8::Unit& u, int wr, int wc, int fr, int fq) const {
        const int row0 = u.pm * 256 + wr * 64 + fr, tc0 = wc * 32 + 8 * fq;
        const int b = u.pn / 33, tile = u.pn - b * 33;
#pragma unroll
        for (int ai = 0; ai < 2; ++ai)
#pragma unroll
            for (int m = 0; m < 4; ++m) { const int ch = row0 + ai * 128 + m * 16; const float bs = bias[ch];
                u16* dst = tile == 0 ? ctx + ((size_t)b * 3072 + ch) * CTX + tc0 : lat + ((size_t)b * 3072 + ch) * SEQ + (tile - 1) * 256 + tc0;
#pragma unroll
                for (int bj = 0; bj < 2; ++bj) { const f32x4 a = acc[ai][bj][m][0] + bs, c = acc[ai][bj][m][1] + bs; u32x4v w;
                    w.x = pg8::cvt_pk_bf16(a[0], a[1]); w.y = pg8::cvt_pk_bf16(a[2], a[3]); w.z = pg8::cvt_pk_bf16(c[0], c[1]); w.w = pg8::cvt_pk_bf16(c[2], c[3]);
                    *(u32x4v*)(dst + bj * 128) = w; } }
    }
};


struct LatOrder : pg8::StaticOrder {
    __device__ bool next(int i, pg8::Unit& u) const { if (!pg8::StaticOrder::next(i, u)) return false; u.pm = (u.pm >> 5) * 33 + 1 + (u.pm & 31); return true; }
};
struct CtxSplitOrder {
    int nk, G, c;
    __device__ bool next(int i, pg8::Unit& u) const { const int L = i * G + c; if (L >= 16 * nk) return false; const int un = L & 15, kc = L >> 4; u.pm = (un >> 2) * 33; u.pn = un & 3; u.kofs = kc * 256; return true; }
    __device__ __forceinline__ void a_ready(const pg8::Unit&) const {}
    __device__ __forceinline__ void done(const pg8::Unit&) const {}
};
struct EpiResidAtomic {
    static constexpr bool PERM = false, AFTER_DRAIN = false;
    float* h; const float* gp; float scale;
    __device__ __forceinline__ void operator()(const f32x4 (&acc)[2][2][4][2], const pg8::Unit& u, int wr, int wc, int fr, int fq) const {
        const int row0 = u.pm * 256 + wr * 64 + fr, col0 = u.pn * 256 + wc * 32 + 4 * fq;
#pragma unroll
        for (int bj = 0; bj < 2; ++bj)
#pragma unroll
            for (int n = 0; n < 2; ++n) { const f32x4 gv = *(const f32x4*)(gp + col0 + bj * 128 + n * 16) * scale;
#pragma unroll
                for (int ai = 0; ai < 2; ++ai)
#pragma unroll
                    for (int m = 0; m < 4; ++m) { float* q = h + (size_t)(row0 + ai * 128 + m * 16) * D + col0 + bj * 128 + n * 16; const f32x4 v = gv * acc[ai][bj][m][n];
                        atomicAdd(q, v[0]); atomicAdd(q + 1, v[1]); atomicAdd(q + 2, v[2]); atomicAdd(q + 3, v[3]); } }
    }
};

__device__ __forceinline__ void ctx_bias_phase(KPC kp, const float* gp, const float* bias) {
    float* h = (float*)(kp->ws + OFF_H);
    for (int i = lbid() * 512 + ltid(); i < NB * CTX * 256; i += gridDim.x * 512) { const int r = i >> 8, c = (i & 255) * 4, b = r >> 8, t = r & 255;
        f32x4* q = (f32x4*)(h + ((size_t)b * TPB + t) * D + c); *q = *q + *(const f32x4*)(gp + c) * *(const f32x4*)(bias + c); }
}
__device__ __forceinline__ int colmap(int n, int mapmode) { return mapmode ? (((n >> 8) << 7) + (n & 127) + ((n >> 7) & 1) * FF) : n; }
__device__ __forceinline__ void convert_T(const float* __restrict__ src, int ld, int K, int Nd, int mapmode, u16* __restrict__ dst, LAS float* tile, int& tctr) {
    const int tid = ltid(), nkt = K / 64, ntile = (Nd / 64) * nkt;
    const int G = (int)gridDim.x; const int first = (((lbid() - tctr) % G) + G) % G; tctr += ntile;
    for (int t = first; t < ntile; t += G) {
        const int n0 = (t / nkt) * 64, k0 = (t % nkt) * 64, c0 = colmap(n0, mapmode);
#pragma unroll
        for (int i = 0; i < 2; ++i) { const int e = tid + 512 * i, kr = e >> 4, c4 = (e & 15) * 4;
            const f32x4 v = *(const f32x4*)(src + (size_t)(k0 + kr) * ld + c0 + c4);
            tile[kr * 65 + c4] = v[0]; tile[kr * 65 + c4 + 1] = v[1]; tile[kr * 65 + c4 + 2] = v[2]; tile[kr * 65 + c4 + 3] = v[3]; }
        __syncthreads();
        { const int n = tid >> 3, k8 = (tid & 7) * 8; u32x4v w;
          w.x = pg8::cvt_pk_bf16(tile[(k8 + 0) * 65 + n], tile[(k8 + 1) * 65 + n]); w.y = pg8::cvt_pk_bf16(tile[(k8 + 2) * 65 + n], tile[(k8 + 3) * 65 + n]);
          w.z = pg8::cvt_pk_bf16(tile[(k8 + 4) * 65 + n], tile[(k8 + 5) * 65 + n]); w.w = pg8::cvt_pk_bf16(tile[(k8 + 6) * 65 + n], tile[(k8 + 7) * 65 + n]);
          *(u32x4v*)(dst + (size_t)(n0 + n) * K + k0 + k8) = w; }
        __syncthreads();
    }
}

__device__ __forceinline__ void norm_phase(KPC kp, int l, int sub) {
    const float* h = (const float*)(kp->ws + OFF_H); u16* uo = (u16*)(kp->ws + OFF_U);
    const float* g = kp->in[I_NORMG] + (size_t)(l * 3 + sub) * D; const float* modl = (const float*)(kp->ws + OFF_MOD) + (size_t)l * 5 * 9216;
    const int lane = ltid() & 63, wv = ltid() >> 6;
    for (int T = lbid() * 8 + wv; T < NTOK; T += gridDim.x * 8) {
        const float* hr = h + (size_t)T * D; f32x4 v[4]; float ss = 0.f;
#pragma unroll
        for (int i = 0; i < 4; ++i) { v[i] = *(const f32x4*)(hr + i * 256 + lane * 4); ss += v[i][0] * v[i][0] + v[i][1] * v[i][1] + v[i][2] * v[i][2] + v[i][3] * v[i][3]; }
        ss = wave_sum(ss); const float rs = rsqrtf(ss * (1.0f / D) + 1e-6f);
        const float* mp = modl + (size_t)modrow_of_token(T) * 9216 + sub * 3 * 1024;
#pragma unroll
        for (int i = 0; i < 4; ++i) { const int c = i * 256 + lane * 4; const f32x4 gg = *(const f32x4*)(g + c), sh = *(const f32x4*)(mp + c), sc = *(const f32x4*)(mp + 1024 + c);
            const f32x4 o = v[i] * rs * gg * (sc + 1.0f) + sh; u32x2 w; w.x = pg8::cvt_pk_bf16(o[0], o[1]); w.y = pg8::cvt_pk_bf16(o[2], o[3]);
            *(u32x2*)(uo + (size_t)T * D + c) = w; }
    }
}

__device__ __forceinline__ void final_phase(KPC kp) {
    const float* h = (const float*)(kp->ws + OFF_H); const float* g = kp->in[I_FINALG];
    const int lane = ltid() & 63, wv = ltid() >> 6;
    for (int r = lbid() * 8 + wv; r < NB * SEQ; r += gridDim.x * 8) {
        const int b = r / SEQ, s = r - b * SEQ; const float* hr = h + ((size_t)b * TPB + CTX + s) * D; f32x4 v[4]; float ss = 0.f;
#pragma unroll
        for (int i = 0; i < 4; ++i) { v[i] = *(const f32x4*)(hr + i * 256 + lane * 4); ss += v[i][0] * v[i][0] + v[i][1] * v[i][1] + v[i][2] * v[i][2] + v[i][3] * v[i][3]; }
        ss = wave_sum(ss); const float rs = rsqrtf(ss * (1.0f / D) + 1e-6f);
#pragma unroll
        for (int i = 0; i < 4; ++i) { const int c = i * 256 + lane * 4; *(f32x4*)(kp->out + (size_t)r * D + c) = v[i] * rs * *(const f32x4*)(g + c); }
    }
}

__device__ __forceinline__ void setup_phase(KPC kp, LAS float* ldsf) {
    float* h = (float*)(kp->ws + OFF_H); const int tid = ltid();
    for (size_t i = (size_t)lbid() * 512 + tid; i < (size_t)NTOK * 256; i += (size_t)gridDim.x * 512) {
        const int T = (int)(i >> 8), c = ((int)i & 255) * 4, b = T / TPB, t = T - b * TPB; f32x4 v;
        if (t < CTX) v = *(const f32x4*)(kp->in[I_CTX] + ((size_t)b * CTX + t) * D + c);
        else { const int s = t - CTX; v = *(const f32x4*)(kp->in[I_X] + ((size_t)b * SEQ + s) * D + c);
            const int half = c >> 9, cc = c & 511, isc = cc >> 8, i0 = cc & 255; const float pv = half ? (float)(s & 63) : (float)(s >> 6);
#pragma unroll
            for (int e = 0; e < 4; ++e) { const float om = exp2f(-13.287712379549449f * (float)(i0 + e) * (1.0f / 256.0f)); const float ang = pv * om; v[e] += isc ? cosf(ang) : sinf(ang); } }
        *(f32x4*)(h + (size_t)T * D + c) = v;
    }
    LAS float* sc = ldsf; LAS float* red = ldsf + 5 * 1024;
    for (int i = tid; i < 5 * 1024; i += 512) { const int r = i >> 10, k = i & 1023; const float cv = r < 4 ? kp->in[I_C][r * D + k] : kp->in[I_CCTX][k]; sc[i] = siluf(cv); }
    __syncthreads();
    float* mod = (float*)(kp->ws + OFF_MOD); const int lane = tid & 63, wv = tid >> 6;
    for (int task = lbid(); task < 288; task += gridDim.x) {
        const int l = task / 72, n0 = (task % 72) * 128 + lane * 2; const float* w = kp->in[I_ADAW] + (size_t)l * D * 9216 + n0;
        f32x2 a[5];
#pragma unroll
        for (int r = 0; r < 5; ++r) a[r] = (f32x2){0.f, 0.f};
#pragma unroll 16
        for (int k = wv * 128; k < wv * 128 + 128; ++k) { const f32x2 wv2 = *(const f32x2*)(w + (size_t)k * 9216);
#pragma unroll
            for (int r = 0; r < 5; ++r) a[r] += wv2 * sc[r * 1024 + k]; }
#pragma unroll
        for (int r = 0; r < 5; ++r) { red[(wv * 5 + r) * 128 + lane * 2] = a[r][0]; red[(wv * 5 + r) * 128 + lane * 2 + 1] = a[r][1]; }
        __syncthreads();
        for (int i = tid; i < 640; i += 512) { const int r = i >> 7, n = i & 127; float s = 0.f;
#pragma unroll
            for (int w8 = 0; w8 < 8; ++w8) s += red[(w8 * 5 + r) * 128 + n];
            const int nn = (task % 72) * 128 + n; mod[((size_t)l * 5 + r) * 9216 + nn] = s + kp->in[I_ADAB][(size_t)l * 9216 + nn]; }
        __syncthreads();
    }
}

__device__ __forceinline__ void convert_layer(KPC kp, int l, LAS float* tile) {
    unsigned char* wb = kp->ws + OFF_WB; int tctr = 0; const int j = l >> 1;
    for (int f = 0; f < 2; ++f) {
        convert_T(kp->in[I_FFNIN] + (size_t)(l * 2 + f) * D * 2 * FF, 2 * FF, D, 2 * FF, 1, (u16*)(wb + (f ? WB_FIN1 : WB_FIN0)), tile, tctr);
        convert_T(kp->in[I_FFNOUT] + (size_t)(l * 2 + f) * FF * D, D, FF, D, 0, (u16*)(wb + (f ? WB_FOUT1 : WB_FOUT0)), tile, tctr);
    }
    if ((l & 1) == 0) {
        convert_T(kp->in[I_HYWIN] + (size_t)j * D * 3 * D, 3 * D, D, 3 * D, 0, (u16*)(wb + WB_MIN), tile, tctr);
        convert_T(kp->in[I_HYWOUT] + (size_t)j * D * D, D, D, D, 0, (u16*)(wb + WB_MOUT), tile, tctr);
    } else {
        convert_T(kp->in[I_MLUP] + (size_t)j * D * 2 * INNER, 2 * INNER, D, 2 * INNER, 0, (u16*)(wb + WB_MIN), tile, tctr);
        convert_T(kp->in[I_MLDOWN] + (size_t)j * INNER * D, D, INNER, D, 0, (u16*)(wb + WB_MOUT), tile, tctr);
        u16* wg = (u16*)(wb + WB_WGT); const float* src = kp->in[I_MLWG] + (size_t)j * 3 * INNER * 16;
        for (int i = lbid() * 512 + ltid(); i < 16 * 3 * INNER; i += gridDim.x * 512) { const int o = i / (3 * INNER), k = i - o * 3 * INNER; wg[i] = f2bf(src[(size_t)k * 16 + o]); }
        float* gates = (float*)(kp->ws + OFF_GATES); const float* bg = kp->in[I_MLBG] + j * 16;
        for (int i = lbid() * 512 + ltid(); i < NTOK * 16; i += gridDim.x * 512) gates[i] = bg[i & 15];
    }
}

constexpr size_t HY_PL = 0, HY_PC = (size_t)NB * 3072 * SEQ * 2, HY_YL = HY_PC + (size_t)NB * 3072 * CTX * 2, HY_YC = HY_YL + (size_t)NB * D * SEQ * 2;
__device__ __forceinline__ int fphys(int i) { return i ^ ((((i >> 6) & 1) * 21) ^ (((i >> 5) & 1) * 10)); }
__device__ __forceinline__ f32x2 cmul(f32x2 a, f32x2 b) { return (f32x2){a.x * b.x - a.y * b.y, a.x * b.y + a.y * b.x}; }
__device__ __forceinline__ f32x2 cmulc(f32x2 a, f32x2 b) { return (f32x2){a.x * b.x + a.y * b.y, a.y * b.x - a.x * b.y}; }
__device__ __forceinline__ int drev(int x) { const unsigned r = __brev((unsigned)x) >> 18; return (int)(((r & 0x2AAAu) >> 1) | ((r & 0x1555u) << 1)); }

__device__ __forceinline__ void fidx4(int base, int lm, int (&ix)[4]) {
    const int m = 1 << lm;
    if (lm == 6) { const int i0 = fphys(base); ix[0] = i0; ix[1] = (i0 + 64) ^ 21; ix[2] = i0 + 128; ix[3] = (i0 + 192) ^ 21; }
    else if (lm == 4) { const int c6 = ((base >> 6) & 1) * 21; ix[0] = base ^ c6; ix[1] = (base + 16) ^ c6; ix[2] = (base + 32) ^ c6 ^ 10; ix[3] = (base + 48) ^ c6 ^ 10; }
    else { const int c = (((base >> 6) & 1) * 21) ^ (((base >> 5) & 1) * 10); ix[0] = base ^ c; ix[1] = (base + m) ^ c; ix[2] = (base + 2 * m) ^ c; ix[3] = (base + 3 * m) ^ c; }
}
__device__ __forceinline__ void fft_fwd(LAS f32x2* buf) {
    const int tid = ltid();
    for (int lm = 12; lm >= 0; lm -= 2) {
        const int m = 1 << lm; const float inv = 1.0f / (float)(4 << lm);
        f32x2 a[8][4]; int ix[8][4];
#pragma unroll
        for (int i = 0; i < 8; ++i) { const int g = tid + 512 * i, p = g & (m - 1), base = ((g >> lm) << (lm + 2)) + p; fidx4(base, lm, ix[i]);
#pragma unroll
            for (int r = 0; r < 4; ++r) a[i][r] = buf[ix[i][r]]; }
#pragma unroll
        for (int i = 0; i < 8; ++i) { const int p = (tid + 512 * i) & (m - 1);
            const f32x2 t0 = a[i][0] + a[i][2], t1 = a[i][0] - a[i][2], t2 = a[i][1] + a[i][3], dd = a[i][1] - a[i][3], t3 = (f32x2){dd.y, -dd.x};
            const float rev = (float)p * inv;
            const f32x2 w1 = (f32x2){__builtin_amdgcn_cosf(rev), -__builtin_amdgcn_sinf(rev)}, w2 = cmul(w1, w1), w3 = cmul(w2, w1);
            buf[ix[i][0]] = t0 + t2; buf[ix[i][1]] = cmul(t1 + t3, w1); buf[ix[i][2]] = cmul(t0 - t2, w2); buf[ix[i][3]] = cmul(t1 - t3, w3); }
        __syncthreads();
    }
}
__device__ __forceinline__ void fft_inv(LAS f32x2* buf) {
    const int tid = ltid();
    for (int lm = 0; lm <= 12; lm += 2) {
        const int m = 1 << lm; const float inv = 1.0f / (float)(4 << lm);
        f32x2 a[8][4]; int ix[8][4];
#pragma unroll
        for (int i = 0; i < 8; ++i) { const int g = tid + 512 * i, p = g & (m - 1), base = ((g >> lm) << (lm + 2)) + p; fidx4(base, lm, ix[i]);
#pragma unroll
            for (int r = 0; r < 4; ++r) a[i][r] = buf[ix[i][r]]; }
#pragma unroll
        for (int i = 0; i < 8; ++i) { const int p = (tid + 512 * i) & (m - 1);
            const float rev = (float)p * inv;
            const f32x2 w1 = (f32x2){__builtin_amdgcn_cosf(rev), -__builtin_amdgcn_sinf(rev)}, w2 = cmul(w1, w1), w3 = cmul(w2, w1);
            const f32x2 b0 = a[i][0], b1 = cmulc(a[i][1], w1), b2 = cmulc(a[i][2], w2), b3 = cmulc(a[i][3], w3);
            const f32x2 s0 = b0 + b2, s1 = b0 - b2, s2 = b1 + b3, dd = b1 - b3, s3 = (f32x2){-dd.y, dd.x};
            buf[ix[i][0]] = s0 + s2; buf[ix[i][1]] = s1 + s3; buf[ix[i][2]] = s0 - s2; buf[ix[i][3]] = s1 - s3; }
        __syncthreads();
    }
}

__device__ __forceinline__ void hy_mlp_phase(KPC kp, int j) {
    float* h2 = (float*)(kp->ws + OFF_H2);
    const float* w1 = kp->in[I_HYW1] + j * 33 * 64; const float* b1 = kp->in[I_HYB1] + j * 64; const float* w2 = kp->in[I_HYW2] + j * 64 * 64; const float* b2 = kp->in[I_HYB2] + j * 64;
    const float* fr = kp->in[I_HYFREQ] + j * 128; const int lane = ltid() & 63, wv = ltid() >> 6;
    for (int pos = lbid() * 8 + wv; pos < SEQ + CTX; pos += gridDim.x * 8) {
        const int n = pos < SEQ ? SEQ : CTX, t = pos < SEQ ? pos : pos - SEQ; const float tn = (float)t / (float)(n - 1);
        float feat = 0.f;
        if (lane == 0) feat = tn;
        else if (lane < 33) { const int bi = (lane - 1) & 15; const float band = 1e-4f + (float)bi * ((15.0f - 1e-4f) / 15.0f); float rev = ((float)t / (float)n) * band; rev -= floorf(rev);
            const float ang = 6.283185307179586f * rev; feat = lane < 17 ? cosf(ang) : -sinf(ang); }
        float z = b1[lane];
        for (int i = 0; i < 33; ++i) z += lshfl(feat, i) * w1[i * 64 + lane];
        const float h1 = sinf(fr[lane] * z);
        float z2 = b2[lane];
        for (int v = 0; v < 64; ++v) z2 += lshfl(h1, v) * w2[v * 64 + lane];
        h2[(size_t)pos * 64 + lane] = sinf(fr[64 + lane] * z2);
    }
}

__device__ __forceinline__ void block_sum2(float& a, float& b, LAS float* red) {
    a = wave_sum(a); b = wave_sum(b); const int lane = ltid() & 63, wv = ltid() >> 6;
    __syncthreads(); if (lane == 0) { red[wv] = a; red[8 + wv] = b; } __syncthreads();
    float sa = 0.f, sb = 0.f;
#pragma unroll
    for (int i = 0; i < 8; ++i) { sa += red[i]; sb += red[8 + i]; }
    a = sa; b = sb;
}

__device__ __forceinline__ void hy_filter_task(KPC kp, int j, int task, LAS f32x2* buf, LAS float* aux) {
    const int tid = ltid(), d = task & 1023; const bool lat = task < 1024;
    const float* w3 = kp->in[I_HYW3] + (size_t)j * 64 * 4096; const float* b3 = kp->in[I_HYB3] + j * 4096; const float* ldc = kp->in[I_HYDECAY] + j * 4096;
    __syncthreads();
    if (tid < 256) aux[tid] = w3[(size_t)(tid & 63) * 4096 + (tid >> 6) * 1024 + d];
    if (tid < 4) { aux[256 + tid] = b3[tid * 1024 + d]; aux[260 + tid] = __expf(ldc[tid * 1024 + d]); }
    __syncthreads();
    const float* h2 = (const float*)(kp->ws + OFF_H2);
    float ss0 = 0.f, ss1 = 0.f;
    if (lat) {
        for (int r = 0; r < 16; ++r) { const int i = tid + 512 * r; float a0 = aux[256], a1 = aux[257], a2 = aux[258], a3 = aux[259];
#pragma unroll 4
            for (int u4 = 0; u4 < 16; ++u4) { const f32x4 hv = *(const f32x4*)(h2 + (size_t)i * 64 + u4 * 4);
#pragma unroll
                for (int e = 0; e < 4; ++e) { const int u = u4 * 4 + e; a0 += hv[e] * aux[u]; a1 += hv[e] * aux[64 + u]; a2 += hv[e] * aux[128 + u]; a3 += hv[e] * aux[192 + u]; } }
            const float tn = (float)i * (1.0f / 8191.0f);
            a0 *= __expf(-tn * aux[260]); a1 *= __expf(-tn * aux[261]); a2 *= __expf(-tn * aux[262]); a3 *= __expf(-tn * aux[263]);
            buf[fphys(i)] = (f32x2){a0, a2}; ss0 += a0 * a0; ss1 += a2 * a2;
            if (i >= 1) { buf[fphys(NFFT - i)] = (f32x2){a1, a3}; ss0 += a1 * a1; ss1 += a3 * a3; } }
        if (tid == 0) buf[fphys(SEQ)] = (f32x2){0.f, 0.f};
        block_sum2(ss0, ss1, aux + 272);
        const f32x2 scl = (f32x2){rsqrtf(ss0 + 1e-12f) * (1.0f / NFFT), rsqrtf(ss1 + 1e-12f) * (1.0f / NFFT)};
        for (int r = 0; r < 32; ++r) { const int q = fphys(tid + 512 * r); buf[q] = buf[q] * scl; }
        __syncthreads();
        fft_fwd(buf);
        f32x2* K0 = (f32x2*)(kp->ws + OFF_R2) + (size_t)d * NFFT; f32x2* K1 = (f32x2*)kp->out + (size_t)d * NFFT;
        for (int r = 0; r < 32; ++r) { const int pos = tid + 512 * r, k = drev(pos), pos2 = drev((NFFT - k) & (NFFT - 1)); const f32x2 Z = buf[fphys(pos)], Z2 = buf[fphys(pos2)];
            K0[pos] = (f32x2){0.5f * (Z.x + Z2.x), 0.5f * (Z.y - Z2.y)}; K1[pos] = (f32x2){0.5f * (Z.y + Z2.y), -0.5f * (Z.x - Z2.x)}; }
    } else {
        const int idx = tid; float a0 = 0.f, a1 = 0.f;
        if (idx != CTX) { const int t = idx < CTX ? idx : 2 * CTX - idx, dir = idx < CTX ? 0 : 1; a0 = aux[256 + dir]; a1 = aux[258 + dir];
            for (int u4 = 0; u4 < 16; ++u4) { const f32x4 hv = *(const f32x4*)(h2 + (size_t)(SEQ + t) * 64 + u4 * 4);
#pragma unroll
                for (int e = 0; e < 4; ++e) { const int u = u4 * 4 + e; a0 += hv[e] * aux[dir * 64 + u]; a1 += hv[e] * aux[128 + dir * 64 + u]; } }
            const float tn = (float)t * (1.0f / 255.0f); a0 *= __expf(-tn * aux[260 + dir]); a1 *= __expf(-tn * aux[262 + dir]); }
        ss0 = a0 * a0; ss1 = a1 * a1;
        block_sum2(ss0, ss1, aux + 272);
        float* kc = (float*)(kp->ws + OFF_KCTX);
        kc[(size_t)d * 512 + idx] = a0 * rsqrtf(ss0 + 1e-12f); kc[(size_t)(1024 + d) * 512 + idx] = a1 * rsqrtf(ss1 + 1e-12f);
    }
}

__device__ __forceinline__ float ld3(const u16* row, int t, int n, float wa, float wb, float wc, float bias) {
    const float xm = t > 0 ? bf2f(row[t - 1]) : 0.f, x0 = bf2f(row[t]), xp = t < n - 1 ? bf2f(row[t + 1]) : 0.f; return wa * xm + wb * x0 + wc * xp + bias; }

__device__ __forceinline__ void ld3x8(const u16* row, int t0, float wa, float wb, float wc, float bias, float (&o)[8]) {
    const u32x4v w = *(const u32x4v*)(row + t0);
    const float x0 = bflo(w.x), x1 = bfhi(w.x), x2 = bflo(w.y), x3 = bfhi(w.y), x4 = bflo(w.z), x5 = bfhi(w.z), x6 = bflo(w.w), x7 = bfhi(w.w);
    const float xl = t0 > 0 ? bf2f(row[t0 - 1]) : 0.f, xr = t0 + 8 < SEQ ? bf2f(row[t0 + 8]) : 0.f;
    o[0] = wa * xl + wb * x0 + wc * x1 + bias; o[1] = wa * x0 + wb * x1 + wc * x2 + bias; o[2] = wa * x1 + wb * x2 + wc * x3 + bias; o[3] = wa * x2 + wb * x3 + wc * x4 + bias;
    o[4] = wa * x3 + wb * x4 + wc * x5 + bias; o[5] = wa * x4 + wb * x5 + wc * x6 + bias; o[6] = wa * x5 + wb * x6 + wc * x7 + bias; o[7] = wa * x6 + wb * x7 + wc * xr + bias;
}
__device__ __forceinline__ void hy_conv_lat(KPC kp, int j, int task, LAS f32x2* buf) {
    const int tid = ltid(), bp = task >> 10, c = task & 1023, b0 = bp * 2;
    const u16* pl = (const u16*)(kp->ws + OFF_R1 + HY_PL); u16* yl = (u16*)(kp->ws + OFF_R1 + HY_YL);
    const float* cw = kp->in[I_HYCW] + (size_t)j * 3 * 3072; const float* cb = kp->in[I_HYCB] + j * 3072;
    const float w1a = cw[c], w1b = cw[3072 + c], w1c = cw[6144 + c], bb1 = cb[c];
    const float w2a = cw[1024 + c], w2b = cw[3072 + 1024 + c], w2c = cw[6144 + 1024 + c], bb2 = cb[1024 + c];
    const float w3a = cw[2048 + c], w3b = cw[3072 + 2048 + c], w3c = cw[6144 + 2048 + c], bb3 = cb[2048 + c];
    const float sk0 = kp->in[I_HYSKIP][j * 2048 + c], sk1 = kp->in[I_HYSKIP][j * 2048 + 1024 + c];
    const u16* x1r0 = pl + ((size_t)b0 * 3072 + c) * SEQ; const u16* x1r1 = x1r0 + (size_t)3072 * SEQ;
    const u16* x2r0 = x1r0 + (size_t)1024 * SEQ; const u16* x2r1 = x1r1 + (size_t)1024 * SEQ;
    const u16* vr0 = x1r0 + (size_t)2048 * SEQ; const u16* vr1 = x1r1 + (size_t)2048 * SEQ;
    const f32x2* K0 = (const f32x2*)(kp->ws + OFF_R2) + (size_t)c * NFFT; const f32x2* K1 = (const f32x2*)kp->out + (size_t)c * NFFT;
    __syncthreads();
#pragma unroll
    for (int g = 0; g < 2; ++g) { const int t0 = 8 * (tid + 512 * g); float v0[8], v1[8];
        ld3x8(vr0, t0, w3a, w3b, w3c, bb3, v0); ld3x8(vr1, t0, w3a, w3b, w3c, bb3, v1);
#pragma unroll
        for (int e = 0; e < 8; ++e) { buf[fphys(t0 + e)] = (f32x2){v0[e], v1[e]}; buf[fphys(SEQ + t0 + e)] = (f32x2){0.f, 0.f}; } }
    __syncthreads();
#ifdef PROBE_FFT
    for (int rp = 0; rp < PROBE_FFT; ++rp) { fft_fwd(buf); fft_inv(buf); for (int r = 0; r < 32; ++r) { const int q = fphys(tid + 512 * r); buf[q] = buf[q] * (1.0f / NFFT); } __syncthreads(); }
#endif
    fft_fwd(buf);
#pragma unroll 8
    for (int r = 0; r < 32; ++r) { const int pos = tid + 512 * r, q = fphys(pos); buf[q] = cmul(buf[q], K0[pos]); }
    __syncthreads();
    fft_inv(buf);
    float zr[32];
#pragma unroll
    for (int g = 0; g < 2; ++g) { const int t0 = 8 * (tid + 512 * g); float v0[8], v1[8], xa[8], xb[8];
        ld3x8(vr0, t0, w3a, w3b, w3c, bb3, v0); ld3x8(vr1, t0, w3a, w3b, w3c, bb3, v1); ld3x8(x1r0, t0, w1a, w1b, w1c, bb1, xa); ld3x8(x1r1, t0, w1a, w1b, w1c, bb1, xb);
#pragma unroll
        for (int e = 0; e < 8; ++e) { const f32x2 y = buf[fphys(t0 + e)]; const float z0 = xa[e] * (y.x + sk0 * v0[e]), z1 = xb[e] * (y.y + sk0 * v1[e]);
            zr[g * 16 + 2 * e] = z0; zr[g * 16 + 2 * e + 1] = z1; buf[fphys(t0 + e)] = (f32x2){z0, z1}; buf[fphys(SEQ + t0 + e)] = (f32x2){0.f, 0.f}; } }
    __syncthreads();
    fft_fwd(buf);
#pragma unroll 8
    for (int r = 0; r < 32; ++r) { const int pos = tid + 512 * r, q = fphys(pos); buf[q] = cmul(buf[q], K1[pos]); }
    __syncthreads();
    fft_inv(buf);
#pragma unroll
    for (int g = 0; g < 2; ++g) { const int t0 = 8 * (tid + 512 * g); float xa[8], xb[8], o0[8], o1[8];
        ld3x8(x2r0, t0, w2a, w2b, w2c, bb2, xa); ld3x8(x2r1, t0, w2a, w2b, w2c, bb2, xb);
#pragma unroll
        for (int e = 0; e < 8; ++e) { const f32x2 y = buf[fphys(t0 + e)]; o0[e] = xa[e] * (y.x + sk1 * zr[g * 16 + 2 * e]); o1[e] = xb[e] * (y.y + sk1 * zr[g * 16 + 2 * e + 1]); }
        *(u32x4v*)(yl + ((size_t)b0 * D + c) * SEQ + t0) = pack8(o0); *(u32x4v*)(yl + ((size_t)(b0 + 1) * D + c) * SEQ + t0) = pack8(o1); }
}

__device__ __forceinline__ void hy_conv_ctx(KPC kp, int j, int c, LAS float* ls) {
    const int tid = ltid();
    const u16* pc = (const u16*)(kp->ws + OFF_R1 + HY_PC); u16* yc = (u16*)(kp->ws + OFF_R1 + HY_YC); const float* kc = (const float*)(kp->ws + OFF_KCTX);
    const float* cw = kp->in[I_HYCW] + (size_t)j * 3 * 3072; const float* cb = kp->in[I_HYCB] + j * 3072;
    const float w1a = cw[c], w1b = cw[3072 + c], w1c = cw[6144 + c], bb1 = cb[c];
    const float w2a = cw[1024 + c], w2b = cw[3072 + 1024 + c], w2c = cw[6144 + 1024 + c], bb2 = cb[1024 + c];
    const float w3a = cw[2048 + c], w3b = cw[3072 + 2048 + c], w3c = cw[6144 + 2048 + c], bb3 = cb[2048 + c];
    const float sk0 = kp->in[I_HYSKIP][j * 2048 + c], sk1 = kp->in[I_HYSKIP][j * 2048 + 1024 + c];
    __syncthreads();
    ls[tid] = kc[(size_t)c * 512 + tid]; ls[512 + tid] = kc[(size_t)(1024 + c) * 512 + tid];
    for (int i = 0; i < 2; ++i) { const int e = tid + 512 * i, b = e >> 8, t = e & 255; ls[1024 + e] = ld3(pc + ((size_t)b * 3072 + 2048 + c) * CTX, t, CTX, w3a, w3b, w3c, bb3); }
    __syncthreads();
    float zr[2];
    for (int i = 0; i < 2; ++i) { const int e = tid + 512 * i, b = e >> 8, t = e & 255; float a = 0.f;
        for (int s = 0; s < CTX; ++s) a += ls[(t - s) & 511] * ls[1024 + b * 256 + s];
        zr[i] = ld3(pc + ((size_t)b * 3072 + c) * CTX, t, CTX, w1a, w1b, w1c, bb1) * (a + sk0 * ls[1024 + e]); ls[2048 + e] = zr[i]; }
    __syncthreads();
    for (int i = 0; i < 2; ++i) { const int e = tid + 512 * i, b = e >> 8, t = e & 255; float a = 0.f;
        for (int s = 0; s < CTX; ++s) a += ls[512 + ((t - s) & 511)] * ls[2048 + b * 256 + s];
        yc[((size_t)b * D + c) * CTX + t] = f2bf(ld3(pc + ((size_t)b * 3072 + 1024 + c) * CTX, t, CTX, w2a, w2b, w2c, bb2) * (a + sk1 * zr[i])); }
}

__device__ __forceinline__ void hy_transpose(KPC kp, LAS u16* tl) {
    const u16* yl = (const u16*)(kp->ws + OFF_R1 + HY_YL); const u16* yc = (const u16*)(kp->ws + OFF_R1 + HY_YC); u16* y = (u16*)(kp->ws + OFF_U); const int tid = ltid();
    for (int tile = lbid(); tile < NB * 16 * NCH; tile += gridDim.x) {
        const int b = tile / (16 * NCH), rem = tile - b * 16 * NCH, ct = rem / NCH, tt = rem - ct * NCH;
        const u16* src = tt < 4 ? yc + ((size_t)b * D + ct * 64) * CTX + tt * 64 : yl + ((size_t)b * D + ct * 64) * SEQ + (tt - 4) * 64; const int ld = tt < 4 ? CTX : SEQ;
        { const int cr = tid >> 3, t8 = (tid & 7) * 8; *(LAS u32x4v*)(tl + cr * 72 + t8) = *(const u32x4v*)(src + (size_t)cr * ld + t8); }
        __syncthreads();
        { const int tr = tid >> 3, c8 = (tid & 7) * 8; u32x4v w;
          w.x = (unsigned)tl[(c8 + 0) * 72 + tr] | ((unsigned)tl[(c8 + 1) * 72 + tr] << 16); w.y = (unsigned)tl[(c8 + 2) * 72 + tr] | ((unsigned)tl[(c8 + 3) * 72 + tr] << 16);
          w.z = (unsigned)tl[(c8 + 4) * 72 + tr] | ((unsigned)tl[(c8 + 5) * 72 + tr] << 16); w.w = (unsigned)tl[(c8 + 6) * 72 + tr] | ((unsigned)tl[(c8 + 7) * 72 + tr] << 16);
          *(u32x4v*)(y + ((size_t)b * TPB + tt * 64 + tr) * D + ct * 64 + c8) = w; }
        __syncthreads();
    }
}

constexpr size_t OFF_XM = OFF_R1, OFF_XC = OFF_R1 + 132 * MiB, OFF_S = WS_NEED, OFF_MLM = OFF_S + 34 * MiB, WS_NEED2 = OFF_MLM + 1 * MiB;
__device__ __forceinline__ u16* hb_ptr(KPC kp, int T) { const int b = T / TPB, t = T - b * TPB;
    return t < CTX ? (u16*)(kp->ws + OFF_HBC) + ((size_t)b * CTX + t) * INNER : (u16*)kp->out + ((size_t)b * SEQ + (t - CTX)) * INNER; }
__device__ __forceinline__ void bd8(const float (&x)[8], const float (&w)[32], float (&y)[8]) {
#pragma unroll
    for (int bl = 0; bl < 2; ++bl)
#pragma unroll
        for (int e = 0; e < 4; ++e) { float s = 0.f;
#pragma unroll
            for (int d = 0; d < 4; ++d) s += x[bl * 4 + d] * w[bl * 16 + d * 4 + e];
            y[bl * 4 + e] = s; }
}
__device__ __forceinline__ void ldw32(const float* p, float (&w)[32]) {
#pragma unroll
    for (int i = 0; i < 8; ++i) { const f32x4 v = *(const f32x4*)(p + i * 4); w[i * 4] = v[0]; w[i * 4 + 1] = v[1]; w[i * 4 + 2] = v[2]; w[i * 4 + 3] = v[3]; } }

__device__ __forceinline__ void ml_m_phase(KPC kp, int j) {
    float* M = (float*)(kp->ws + OFF_MLM); const float* wq = kp->in[I_MLWQ] + (size_t)j * 512 * 16; const float* wk = kp->in[I_MLWK] + (size_t)j * 512 * 16;
    for (int i = lbid() * 512 + ltid(); i < 512 * 16; i += gridDim.x * 512) { const int blk = i >> 4, d = (i >> 2) & 3, d2 = i & 3; float s = 0.f;
#pragma unroll
        for (int e = 0; e < 4; ++e) s += wq[blk * 16 + d * 4 + e] * wk[blk * 16 + d2 * 4 + e];
        M[i] = s * 0.04419417382415922f; }
}

__device__ __forceinline__ void ml_prep_task(KPC kp, int j, int task, LAS unsigned char* lds) {
    const int tid = ltid(), lane = tid & 63, wv = tid >> 6, fr = lane & 15, fq = lane >> 4;
    const int hd = task & 3, bc = task >> 2, b = bc / NCH, ci = bc - b * NCH;
    const u16* xm = (const u16*)(kp->ws + OFF_XM); u16* xc = (u16*)(kp->ws + OFF_XC);
    const int T0 = b * TPB + ci * 64, tlo = b * TPB + (ci < 4 ? 0 : CTX), thi = b * TPB + (ci < 4 ? CTX - 1 : TPB - 1);
    const int ch0 = hd * DH + lane * 8;
    LAS u16* QS = (LAS u16*)lds; LAS u16* KS = (LAS u16*)(lds + 66560);
    const float* cw = kp->in[I_MLCW] + (size_t)j * 3 * INNER; const float* cb = kp->in[I_MLCB] + (size_t)j * INNER;
    __syncthreads();
    {
        float cwa[8], cwb[8], cwc[8], cbb[8], wq[32], wk[32];
#pragma unroll
        for (int e = 0; e < 8; ++e) { cwa[e] = cw[ch0 + e]; cwb[e] = cw[INNER + ch0 + e]; cwc[e] = cw[2 * INNER + ch0 + e]; cbb[e] = cb[ch0 + e]; }
        ldw32(kp->in[I_MLWQ] + ((size_t)j * 512 + (ch0 >> 2)) * 16, wq); ldw32(kp->in[I_MLWK] + ((size_t)j * 512 + (ch0 >> 2)) * 16, wk);
        for (int r = 0; r < 8; ++r) { const int jj = wv + 8 * r, T = T0 + jj; const u16* p = xm + (size_t)T * INNER + ch0;
            float x0[8], xa[8], xb[8], xcv[8], q[8], k[8];
            unpack8(*(const u32x4v*)p, x0);
            if (T > tlo) unpack8(*(const u32x4v*)(p - INNER), xa); else {
#pragma unroll
                for (int e = 0; e < 8; ++e) xa[e] = 0.f; }
            if (T < thi) unpack8(*(const u32x4v*)(p + INNER), xb); else {
#pragma unroll
                for (int e = 0; e < 8; ++e) xb[e] = 0.f; }
#pragma unroll
            for (int e = 0; e < 8; ++e) xcv[e] = siluf(cwa[e] * xa[e] + cwb[e] * x0[e] + cwc[e] * xb[e] + cbb[e]);
            const u32x4v xw = pack8(xcv); *(u32x4v*)(xc + (size_t)T * INNER + ch0) = xw; unpack8(xw, xcv);
            bd8(xcv, wq, q); bd8(xcv, wk, k);
            *(LAS u32x4v*)(QS + jj * 520 + lane * 8) = pack8(q); *(LAS u32x4v*)(KS + jj * 520 + lane * 8) = pack8(k); }
    }
    __syncthreads();
    const u16* wg = (const u16*)(kp->ws + OFF_WB + WB_WGT);
    const int mt = wv & 3, kh = wv >> 2;
    { f32x4 s0 = {0.f, 0.f, 0.f, 0.f}, s1 = {0.f, 0.f, 0.f, 0.f}; const int nt0 = kh * 2;
      for (int ks = 0; ks < 16; ++ks) { const bf16x8 a = *(const LAS bf16x8*)(QS + (16 * mt + fr) * 520 + 32 * ks + 8 * fq);
          const bf16x8 b0 = *(const LAS bf16x8*)(KS + (16 * nt0 + fr) * 520 + 32 * ks + 8 * fq), b1 = *(const LAS bf16x8*)(KS + (16 * (nt0 + 1) + fr) * 520 + 32 * ks + 8 * fq);
          s0 = __builtin_amdgcn_mfma_f32_16x16x32_bf16(a, b0, s0, 0, 0, 0); s1 = __builtin_amdgcn_mfma_f32_16x16x32_bf16(a, b1, s1, 0, 0, 0); }
      float* S = (float*)(kp->ws + OFF_S) + ((size_t)(b * 4 + hd) * NCH + ci) * 4096;
#pragma unroll
      for (int r = 0; r < 4; ++r) { S[(16 * mt + 4 * fq + r) * 64 + 16 * nt0 + fr] = s0[r]; S[(16 * mt + 4 * fq + r) * 64 + 16 * (nt0 + 1) + fr] = s1[r]; } }
    f32x4 ga = {0.f, 0.f, 0.f, 0.f};
    for (int ks = kh * 8; ks < kh * 8 + 8; ++ks) { const int kk = hd * DH + 32 * ks + 8 * fq;
        const bf16x8 a = *(const LAS bf16x8*)(QS + (16 * mt + fr) * 520 + 32 * ks + 8 * fq), a2 = *(const LAS bf16x8*)(KS + (16 * mt + fr) * 520 + 32 * ks + 8 * fq);
        const bf16x8 bq = *(const bf16x8*)(wg + (size_t)fr * 6144 + kk), bk = *(const bf16x8*)(wg + (size_t)fr * 6144 + INNER + kk);
        ga = __builtin_amdgcn_mfma_f32_16x16x32_bf16(a, bq, ga, 0, 0, 0); ga = __builtin_amdgcn_mfma_f32_16x16x32_bf16(a2, bk, ga, 0, 0, 0); }
    __syncthreads();
    {
        float wvv[32]; ldw32(kp->in[I_MLWV] + ((size_t)j * 512 + (ch0 >> 2)) * 16, wvv);
        for (int r = 0; r < 8; ++r) { const int jj = wv + 8 * r, T = T0 + jj; float x0[8], v[8]; unpack8(*(const u32x4v*)(xm + (size_t)T * INNER + ch0), x0); bd8(x0, wvv, v);
            *(LAS u32x4v*)(QS + jj * 520 + lane * 8) = pack8(v); }
    }
    __syncthreads();
    for (int ks = kh * 8; ks < kh * 8 + 8; ++ks) { const int kk = hd * DH + 32 * ks + 8 * fq;
        const bf16x8 a = *(const LAS bf16x8*)(QS + (16 * mt + fr) * 520 + 32 * ks + 8 * fq); const bf16x8 bv = *(const bf16x8*)(wg + (size_t)fr * 6144 + 2 * INNER + kk);
        ga = __builtin_amdgcn_mfma_f32_16x16x32_bf16(a, bv, ga, 0, 0, 0); }
    float* gates = (float*)(kp->ws + OFF_GATES);
#pragma unroll
    for (int r = 0; r < 4; ++r) atomicAdd(gates + (size_t)(T0 + 16 * mt + 4 * fq + r) * 16 + fr, ga[r]);
}

#ifndef REP_STAGE
#define REP_STAGE 1
#define REP_STILDE 1
#define REP_MFMA 1
#endif
constexpr int SC_QS = 0, SC_KT = 66560, SC_VT = 132096, SC_ST = 148480, SC_VEC = 156672;
__device__ __forceinline__ void ml_scan_task(KPC kp, int j, int task, LAS unsigned char* lds) {
    const int tid = ltid(), lane = tid & 63, wv = tid >> 6, fr = lane & 15, fq = lane >> 4;
    const int es = task & 3, dir = (task >> 2) & 1, hd = (task >> 3) & 3, b = task >> 5;
    const u16* xm = (const u16*)(kp->ws + OFF_XM); const u16* xc = (const u16*)(kp->ws + OFF_XC); const float* gates = (const float*)(kp->ws + OFF_GATES);
    const float* Sg = (const float*)(kp->ws + OFF_S) + (size_t)(b * 4 + hd) * NCH * 4096;
    u16* hf = (u16*)(kp->ws + OFF_R2);
    LAS unsigned char* QS = lds + SC_QS; LAS unsigned char* KT = lds + SC_KT; LAS unsigned char* VT = lds + SC_VT; LAS unsigned char* ST = lds + SC_ST;
    LAS float* rowterm = (LAS float*)(lds + SC_VEC); LAS float* colterm = rowterm + 64; LAS float* winter = rowterm + 128; LAS float* einv = rowterm + 192;
    LAS float* kws = rowterm + 256; LAS float* dinv = rowterm + 320; LAS float* nst = rowterm + 384; LAS float* scal = rowterm + 896;
    f32x4 C[32];
#pragma unroll
    for (int i = 0; i < 32; ++i) C[i] = (f32x4){0.f, 0.f, 0.f, 0.f};
    float m_st = 0.f;
    __syncthreads();
    nst[tid] = 0.f;
    for (int ci = 0; ci < NCH; ++ci) {
        __syncthreads();
        const int p0 = ci * 64;
        const int tid = ltid(), lane = tid & 63, wv = tid >> 6, fr = lane & 15, fq = lane >> 4;
        asm volatile("" ::: "memory");
        auto tok = [&](int jj) -> int { const int p = p0 + jj; const int t = dir == 0 ? p : (p < CTX ? CTX - 1 - p : TPB + CTX - 1 - p); return b * TPB + t; };
        float sv[8];
        { const int jj = tid >> 3, s8 = (tid & 7) * 8;
            if (dir == 0) { const float* sp = Sg + (size_t)ci * 4096 + jj * 64 + s8; const f32x4 v0 = *(const f32x4*)sp, v1 = *(const f32x4*)(sp + 4);
                sv[0] = v0[0]; sv[1] = v0[1]; sv[2] = v0[2]; sv[3] = v0[3]; sv[4] = v1[0]; sv[5] = v1[1]; sv[6] = v1[2]; sv[7] = v1[3]; }
            else { const int oc = ci < 4 ? 3 - ci : 135 - ci; const float* sp = Sg + (size_t)oc * 4096 + (63 - jj) * 64 + (56 - s8); const f32x4 v0 = *(const f32x4*)sp, v1 = *(const f32x4*)(sp + 4);
                sv[7] = v0[0]; sv[6] = v0[1]; sv[5] = v0[2]; sv[4] = v0[3]; sv[3] = v1[0]; sv[2] = v1[1]; sv[1] = v1[2]; sv[0] = v1[3]; }
        }
        float g_ic = 0.f, g_fp = 0.f;
        if (wv == 0) { const int Tg = tok(lane); g_ic = gates[(size_t)Tg * 16 + dir * 8 + hd]; g_fp = gates[(size_t)Tg * 16 + dir * 8 + 4 + hd]; }
        for (int rpS = 0; rpS < REP_STAGE; ++rpS) {
        const int wvu = __builtin_amdgcn_readfirstlane(wv); const int Tl = tok(lane);
        for (int r = 0; r < 8; ++r) { const int g8 = wvu * 8 + r; float x[8], q[8], Mw[32];
            const u32x4v xw = *(const u32x4v*)(xc + (size_t)Tl * INNER + hd * DH + g8 * 8); unpack8(xw, x);
            ldw32((const float*)(kp->ws + OFF_MLM) + (size_t)(hd * 128 + g8 * 2) * 16, Mw); bd8(x, Mw, q);
            *(LAS u32x4v*)(QS + lane * 1040 + g8 * 16) = pack8(q);
            const unsigned wd[4] = {xw.x, xw.y, xw.z, xw.w};
#pragma unroll
            for (int e = 0; e < 8; ++e) { const int d = g8 * 8 + e; *(LAS u16*)(KT + d * 128 + ((((lane >> 3) ^ (d & 7)) << 4) | ((lane & 7) << 1))) = (u16)((e & 1) ? (wd[e >> 1] >> 16) : (wd[e >> 1] & 0xffffu)); } }
        for (int r = 0; r < 2; ++r) { const int g = wvu * 2 + r; const int chv = hd * DH + es * 128 + g * 8; float x[8], v[8], wvv[32];
            unpack8(*(const u32x4v*)(xm + (size_t)Tl * INNER + chv), x); ldw32(kp->in[I_MLWV] + ((size_t)j * 512 + (chv >> 2)) * 16, wvv); bd8(x, wvv, v);
#pragma unroll
            for (int e = 0; e < 8; ++e) { const int ee = g * 8 + e; *(LAS u16*)(VT + ee * 128 + ((((lane >> 3) ^ (ee & 7)) << 4) | ((lane & 7) << 1))) = f2bf(v[e]); } }
        }
        if (wv == 0) {
            const float ic = g_ic, fp = g_fp;
            const float lf = fminf(fp, 0.f) - log1pf(__expf(-fabsf(fp)));
            float bb = lf;
#pragma unroll
            for (int o = 1; o < 64; o <<= 1) { const float t = lshfl(bb, lane - o); if (lane >= o) bb += t; }
            const float uu = ic - bb; float pm = uu;
#pragma unroll
            for (int o = 1; o < 64; o <<= 1) { const float t = lshfl(pm, lane - o); if (lane >= o) pm = fmaxf(pm, t); }
            const float a = bb + m_st, mj = fmaxf(a, bb + pm);
            rowterm[lane] = bb - mj; colterm[lane] = uu; winter[lane] = __expf(a - mj); einv[lane] = __expf(-mj);
            const float blast = lshfl(bb, 63), gs = blast - bb + ic, gmax = wave_max(gs), mnew = fmaxf(blast + m_st, gmax);
            kws[lane] = __expf(gs - mnew);
            if (lane == 0) { scal[0] = __expf(blast + m_st - mnew); scal[1] = mnew; }
        }
        __syncthreads();
        for (int rpT = 0; rpT < REP_STILDE; ++rpT) {
            const int jj = tid >> 3, sub = tid & 7, s8 = sub * 8;
            const float rt = rowterm[jj]; float rsum = 0.f;
#pragma unroll
            for (int e = 0; e < 8; ++e) { const int s = s8 + e; const float w = s <= jj ? sv[e] * 0.04419417382415922f * __expf(rt + colterm[s]) : 0.f; sv[e] = w; rsum += w; }
            *(LAS u32x4v*)(ST + jj * 128 + ((sub ^ (jj & 7)) << 4)) = pack8(sv);
            float qd = 0.f;
#pragma unroll
            for (int c8 = 0; c8 < 8; ++c8) { float qv[8]; unpack8(*(const LAS u32x4v*)(QS + jj * 1040 + (sub * 8 + c8) * 16), qv);
                { const f32x4 n0 = *(const LAS f32x4*)(nst + sub * 64 + c8 * 8), n1 = *(const LAS f32x4*)(nst + sub * 64 + c8 * 8 + 4);
                  qd += qv[0] * n0[0] + qv[1] * n0[1] + qv[2] * n0[2] + qv[3] * n0[3] + qv[4] * n1[0] + qv[5] * n1[1] + qv[6] * n1[2] + qv[7] * n1[3]; } }
            rsum += lshfl(rsum, lane ^ 1); rsum += lshfl(rsum, lane ^ 2); rsum += lshfl(rsum, lane ^ 4);
            qd += lshfl(qd, lane ^ 1); qd += lshfl(qd, lane ^ 2); qd += lshfl(qd, lane ^ 4);
            if (sub == 0) { const float qn = winter[jj] * qd + rsum; dinv[jj] = 1.0f / fmaxf(fabsf(qn), einv[jj]); }
        }
        __syncthreads();
        {
            f32x4 o[4];
            const int el = 16 * wv + fr;
            bf16x8 vfr[2];
            for (int rpM = 0; rpM < REP_MFMA; ++rpM) {
#pragma unroll
            for (int mt = 0; mt < 4; ++mt) o[mt] = (f32x4){0.f, 0.f, 0.f, 0.f};
#pragma unroll
            for (int ks = 0; ks < 16; ++ks) {
                u32x4v bw; bw.x = pg8::cvt_pk_bf16(C[2 * ks][0], C[2 * ks][1]); bw.y = pg8::cvt_pk_bf16(C[2 * ks][2], C[2 * ks][3]);
                bw.z = pg8::cvt_pk_bf16(C[2 * ks + 1][0], C[2 * ks + 1][1]); bw.w = pg8::cvt_pk_bf16(C[2 * ks + 1][2], C[2 * ks + 1][3]);
                const bf16x8 bfr = __builtin_bit_cast(bf16x8, bw);
#pragma unroll
                for (int mt = 0; mt < 4; ++mt) { const int off = (16 * mt + fr) * 1040 + 8 * fq;
                    const u32x2 lo = *(const LAS u32x2*)(QS + off + 64 * ks), hi = *(const LAS u32x2*)(QS + off + 64 * ks + 32);
                    u32x4v aw; aw.x = lo.x; aw.y = lo.y; aw.z = hi.x; aw.w = hi.y;
                    o[mt] = __builtin_amdgcn_mfma_f32_16x16x32_bf16(__builtin_bit_cast(bf16x8, aw), bfr, o[mt], 0, 0, 0); }
                if ((ks & 1) == 1) __builtin_amdgcn_sched_barrier(0); }
#pragma unroll
            for (int mt = 0; mt < 4; ++mt)
#pragma unroll
                for (int r = 0; r < 4; ++r) o[mt][r] *= winter[16 * mt + 4 * fq + r];
#pragma unroll
            for (int k2 = 0; k2 < 2; ++k2) { vfr[k2] = *(const LAS bf16x8*)(VT + el * 128 + (((4 * k2 + fq) ^ (el & 7)) << 4));
#pragma unroll
                for (int mt = 0; mt < 4; ++mt) { const int jr = 16 * mt + fr; const bf16x8 a = *(const LAS bf16x8*)(ST + jr * 128 + (((4 * k2 + fq) ^ (jr & 7)) << 4));
                    o[mt] = __builtin_amdgcn_mfma_f32_16x16x32_bf16(a, vfr[k2], o[mt], 0, 0, 0); } }
            }
#pragma unroll
            for (int mt = 0; mt < 4; ++mt)
#pragma unroll
                for (int r = 0; r < 4; ++r) { const int jr = 16 * mt + 4 * fq + r, T = tok(jr); const float hv = o[mt][r] * dinv[jr];
                    u16* dst = dir == 0 ? hf + (size_t)T * INNER : hb_ptr(kp, T); dst[hd * DH + es * 128 + el] = f2bf(hv); }
            const float decay = scal[0];
#pragma unroll
            for (int i = 0; i < 32; ++i) C[i] = C[i] * decay;
#pragma unroll
            for (int k2 = 0; k2 < 2; ++k2) { float vv[8]; unpack8(__builtin_bit_cast(u32x4v, vfr[k2]), vv);
#pragma unroll
                for (int e = 0; e < 8; ++e) vv[e] *= kws[32 * k2 + 8 * fq + e];
                const bf16x8 bsc = __builtin_bit_cast(bf16x8, pack8(vv));
#pragma unroll
                for (int dt = 0; dt < 32; ++dt) { const int dr = 16 * dt + fr; const bf16x8 a = *(const LAS bf16x8*)(KT + dr * 128 + (((4 * k2 + fq) ^ (dr & 7)) << 4));
                    C[dt] = __builtin_amdgcn_mfma_f32_16x16x32_bf16(a, bsc, C[dt], 0, 0, 0);
                    if ((dt & 7) == 7) __builtin_amdgcn_sched_barrier(0); } }
            { float nn = decay * nst[tid];
#pragma unroll
              for (int g = 0; g < 8; ++g) { float kv[8]; unpack8(*(const LAS u32x4v*)(KT + tid * 128 + ((g ^ (tid & 7)) << 4)), kv);
#pragma unroll
                  for (int e = 0; e < 8; ++e) nn += kv[e] * kws[8 * g + e]; }
              nst[tid] = nn; }
            m_st = scal[1];
        }
    }
}

__device__ __forceinline__ void ml_gate_phase(KPC kp, int j) {
    u16* hf = (u16*)(kp->ws + OFF_R2); const u16* xc = (const u16*)(kp->ws + OFF_XC); const u16* z = (const u16*)(kp->ws + OFF_XM);
    const float* ng = kp->in[I_MLNG] + (size_t)j * INNER; const float* sk = kp->in[I_MLSKIP] + (size_t)j * INNER;
    const int lane = ltid() & 63, wv = ltid() >> 6;
    for (int T = lbid() * 8 + wv; T < NTOK; T += gridDim.x * 8) {
        const u16* hbp = hb_ptr(kp, T);
#pragma unroll
        for (int hd = 0; hd < 4; ++hd) { const int c0 = hd * DH + lane * 8; float a[8], bq[8], xv[8], zv[8], o[8];
            unpack8(*(const u32x4v*)(hf + (size_t)T * INNER + c0), a); unpack8(*(const u32x4v*)(hbp + c0), bq);
            float s = 0.f;
#pragma unroll
            for (int e = 0; e < 8; ++e) { a[e] += bq[e]; s += a[e]; }
            const float mu = wave_sum(s) * (1.0f / DH); float vs = 0.f;
#pragma unroll
            for (int e = 0; e < 8; ++e) { a[e] -= mu; vs += a[e] * a[e]; }
            const float rs = rsqrtf(wave_sum(vs) * (1.0f / DH) + 1e-5f);
            unpack8(*(const u32x4v*)(xc + (size_t)T * INNER + c0), xv); unpack8(*(const u32x4v*)(z + (size_t)T * INNER + c0), zv);
#pragma unroll
            for (int e = 0; e < 8; ++e) o[e] = (a[e] * rs * ng[c0 + e] + sk[c0 + e] * xv[e]) * siluf(zv[e]);
            *(u32x4v*)(hf + (size_t)T * INNER + c0) = pack8(o); }
    }
}


enum { K_SETUP = 0, K_CN, K_G1, K_G2R, K_HYIN, K_HYCONV, K_HYTR, K_MLUPX, K_MLPREP, K_MLSCAN, K_MLUPZ, K_MLGATE, K_FINAL };
constexpr int NPHASE = 1 + 11 + 13 + 11 + 13 + 1;
__device__ __forceinline__ void decode_phase(int ph, int& kind, int& l, int& arg) {
    kind = K_SETUP; l = 0; arg = 0; if (ph == 0) return;
    ph -= 1;
    for (l = 0; l < 4; ++l) { const int n = (l & 1) ? 13 : 11; if (ph < n) break; ph -= n; }
    if (l == 4) { kind = K_FINAL; l = 0; return; }
    if (ph == 0) { kind = K_CN; arg = 0; return; } if (ph == 1) { kind = K_G1; arg = 0; return; } if (ph == 2) { kind = K_G2R; arg = 0; return; } if (ph == 3) { kind = K_CN; arg = 1; return; }
    const int nm = (l & 1) ? 6 : 4;
    if (ph < 4 + nm) { const int q = ph - 4;
        if (l & 1) { kind = q == 0 ? K_MLUPX : q == 1 ? K_MLPREP : q == 2 ? K_MLSCAN : q == 3 ? K_MLUPZ : q == 4 ? K_MLGATE : K_G2R; arg = 2; }
        else { kind = q == 0 ? K_HYIN : q == 1 ? K_HYCONV : q == 2 ? K_HYTR : K_G2R; arg = 2; }
        return; }
    ph -= 4 + nm;
    if (ph == 0) { kind = K_CN; arg = 2; return; } if (ph == 1) { kind = K_G1; arg = 1; return; } kind = K_G2R; arg = 1;
}

__device__ __forceinline__ void gbar(unsigned* ctr, unsigned target) {
    __syncthreads();
    if (ltid() == 0) {
        __builtin_amdgcn_fence(__ATOMIC_RELEASE, "agent");
        __hip_atomic_fetch_add(ctr, 1u, __ATOMIC_RELAXED, __HIP_MEMORY_SCOPE_AGENT);
        while (__hip_atomic_load(ctr, __ATOMIC_RELAXED, __HIP_MEMORY_SCOPE_AGENT) < target) __builtin_amdgcn_s_sleep(2);
        __builtin_amdgcn_fence(__ATOMIC_ACQUIRE, "agent");
    }
    __syncthreads();
}
#ifndef REPMASK
#define REPMASK 0
#define REPN 1
#endif
template <int MIX> __device__ __forceinline__ void run_phases(int lo, int hi, int ph_lo, int ph_hi, LAS unsigned char* lds0, cg::grid_group& grid) {
    lo = lo > ph_lo ? lo : ph_lo; hi = hi < ph_hi ? hi : ph_hi;
    for (int ph = lo; ph < hi; ++ph) {
        KPC kp = (KPC)__builtin_amdgcn_kernarg_segment_ptr(); asm volatile("" : "+s"(kp) :: "memory");
        LAS unsigned char* lds = lds0; asm volatile("" : "+s"(lds) :: "memory");
        unsigned char* ws = kp->ws; unsigned char* wb = ws + OFF_WB;
        int kind, l, arg; decode_phase(ph, kind, l, arg); const int j = l >> 1;
        const float* modl = (const float*)(ws + OFF_MOD) + (size_t)l * 5 * 9216;
        const int nrep = ((REPMASK >> kind) & 1) ? REPN : 1;
        for (int rep = 0; rep < nrep; ++rep) {
        if (kind == K_SETUP) { if constexpr (MIX == 0) setup_phase(kp, (LAS float*)lds); }
        else if (kind == K_CN) {
            if (arg == 0) { convert_layer(kp, l, (LAS float*)lds); if constexpr (MIX == 1) ml_m_phase(kp, j); }
            if constexpr (MIX == 0) { if (arg == 1) hy_mlp_phase(kp, j); }
            norm_phase(kp, l, arg);
        } else if (kind == K_G1) {
            pg8::Gemm g{(const u16*)(ws + OFF_U), (const u16*)(wb + (arg ? WB_FIN1 : WB_FIN0)), NTOK, 2 * FF, D};
            pg8::StaticOrder S; S.init(g.M, g.N, (int)gridDim.x, lbid()); EpiSwiglu E{(u16*)(ws + OFF_R1)};
            pg8::gemm_phase<EpiSwiglu, pg8::StaticOrder, false>(lds, g, S, E, nullptr);
        } else if (kind == K_G2R) {
            pg8::Gemm g; EpiResid E; E.h = (float*)(ws + OFF_H); E.modl = modl;
            if (arg < 2) { g = pg8::Gemm{(const u16*)(ws + OFF_R1), (const u16*)(wb + (arg ? WB_FOUT1 : WB_FOUT0)), NTOK, D, FF}; E.gidx = arg ? 8 : 2; E.scale = 0.5f; E.bias = nullptr; }
            else if (MIX == 1) { g = pg8::Gemm{(const u16*)(ws + OFF_R2), (const u16*)(wb + WB_MOUT), NTOK, D, INNER}; E.gidx = 5; E.scale = 1.0f; E.bias = nullptr; }
            else { g = pg8::Gemm{(const u16*)(ws + OFF_U), (const u16*)(wb + WB_MOUT), NTOK, D, D}; E.gidx = 5; E.scale = 1.0f; E.bias = kp->in[I_HYBOUT] + (size_t)j * D; }
            pg8::StaticOrder S; S.init(g.M, g.N, (int)gridDim.x, lbid());
            pg8::gemm_phase<EpiResid, pg8::StaticOrder, false>(lds, g, S, E, nullptr);
        } else if (kind == K_FINAL) { if constexpr (MIX == 1) final_phase(kp); }
        else if constexpr (MIX == 0) {
            if (kind == K_HYIN) {
                pg8::Gemm g{(const u16*)(wb + WB_MIN), (const u16*)(ws + OFF_U), 3 * D, NTOK, D};
                pg8::StaticOrder S; S.init(g.M, g.N, (int)gridDim.x, lbid());
                EpiProjT E{(u16*)(ws + OFF_R1 + HY_PL), (u16*)(ws + OFF_R1 + HY_PC), kp->in[I_HYBIN] + (size_t)j * 3 * D};
                pg8::gemm_phase<EpiProjT, pg8::StaticOrder, false>(lds, g, S, E, nullptr);
                __syncthreads();
                for (int t = lbid(); t < 2048; t += gridDim.x) hy_filter_task(kp, j, t, (LAS f32x2*)lds, (LAS float*)(lds + 131072));
            } else if (kind == K_HYCONV) {
                for (int t = lbid(); t < 2048; t += gridDim.x) hy_conv_lat(kp, j, t, (LAS f32x2*)lds);
                for (int t = lbid(); t < 1024; t += gridDim.x) hy_conv_ctx(kp, j, t, (LAS float*)lds);
            } else if (kind == K_HYTR) hy_transpose(kp, (LAS u16*)lds);
        } else {
            if (kind == K_MLUPX || kind == K_MLUPZ) {
                const bool zz = kind == K_MLUPZ;
                pg8::Gemm g{(const u16*)(ws + OFF_U), (const u16*)(wb + WB_MIN) + (zz ? (size_t)INNER * D : 0), NTOK, INNER, D};
                pg8::StaticOrder S; S.init(g.M, g.N, (int)gridDim.x, lbid()); EpiBf E{(u16*)(ws + OFF_XM), INNER};
                pg8::gemm_phase<EpiBf, pg8::StaticOrder, false>(lds, g, S, E, nullptr);
            } else if (kind == K_MLPREP) { for (int t = lbid(); t < NB * NCH * 4; t += gridDim.x) ml_prep_task(kp, j, t, lds); }
            else if (kind == K_MLSCAN) { for (int t = lbid(); t < 128; t += gridDim.x) ml_scan_task(kp, j, t, lds); }
            else if (kind == K_MLGATE) ml_gate_phase(kp, j);
        }
        }
        if (ph + 1 < ph_hi) gbar((unsigned*)(kp->ws + OFF_MLM + 65536), (unsigned)(ph + 1 - ph_lo) * gridDim.x);
    }
}

__global__ void __launch_bounds__(512) fwd_megakernel(KP kparg) {
    extern __shared__ __attribute__((aligned(16))) unsigned char shm[];
    LAS unsigned char* lds = (LAS unsigned char*)shm;
    cg::grid_group grid = cg::this_grid();
    grid.sync();
    wtab_init();
    const int ph_lo = kparg.ph_lo, ph_hi = kparg.ph_hi;
    run_phases<0>(0, 12, ph_lo, ph_hi, lds, grid);
    run_phases<1>(12, 25, ph_lo, ph_hi, lds, grid);
    run_phases<0>(25, 36, ph_lo, ph_hi, lds, grid);
    run_phases<1>(36, 50, ph_lo, ph_hi, lds, grid);
}

extern "C" void kernel_launch(void* const* d_in, const int* in_sizes, int n_in, void* d_out, int out_size, void* d_ws, size_t ws_size, hipStream_t stream) {
    static int grid_blocks = 0;
    if (!grid_blocks) {
        int dev = 0, cus = 0, per_cu = 0;
        hipGetDevice(&dev);
        hipDeviceGetAttribute(&cus, hipDeviceAttributeMultiprocessorCount, dev);
        hipFuncSetAttribute((const void*)fwd_megakernel, hipFuncAttributeMaxDynamicSharedMemorySize, LDS_BYTES);
        hipOccupancyMaxActiveBlocksPerMultiprocessor(&per_cu, fwd_megakernel, 512, LDS_BYTES);
        if (per_cu < 1) per_cu = 1;
        grid_blocks = cus * 1;
        if (ws_size < WS_NEED2) fprintf(stderr, "workspace too small: %zu < %zu\n", ws_size, (size_t)WS_NEED2);
    }
    KP hp{};
    for (int i = 0; i < 36; ++i) hp.in[i] = (const float*)d_in[i];
    hp.out = (float*)d_out; hp.ws = (unsigned char*)d_ws; hp.ph_lo = 0; hp.ph_hi = NPHASE;
    void* args[] = {&hp};
    hipMemsetAsync((unsigned char*)d_ws + OFF_MLM + 65536, 0, 256, stream);
    hipError_t e = hipLaunchCooperativeKernel((void*)fwd_megakernel, dim3(grid_blocks), dim3(512), args, LDS_BYTES, stream);
    if (e != hipSuccess) fprintf(stderr, "cooperative launch failed: %s (grid %d)\n", hipGetErrorString(e), grid_blocks);
}
```

```cpp
#define REPMASK 0
#define REPN 1
#include <hip/hip_runtime.h>
#include <hip/hip_cooperative_groups.h>
#include <cstdio>
namespace cg = cooperative_groups;
#define WTAB_OFF 163584
__device__ __forceinline__ int llane() { int l; asm volatile("v_mbcnt_lo_u32_b32 %0, -1, 0\n\tv_mbcnt_hi_u32_b32 %0, -1, %0" : "=v"(l) :: "memory"); return l; }
__device__ __forceinline__ int lwave() { extern __shared__ __attribute__((aligned(16))) unsigned char shm_w[];
    const int hw = __builtin_amdgcn_s_getreg(10244) & 63;
    return __builtin_amdgcn_readfirstlane(*(const __attribute__((address_space(3))) int*)((__attribute__((address_space(3))) unsigned char*)shm_w + WTAB_OFF + hw * 4)); }
__device__ __forceinline__ void wtab_init() { extern __shared__ __attribute__((aligned(16))) unsigned char shm_w[];
    const int hw = __builtin_amdgcn_s_getreg(10244) & 63;
    *(__attribute__((address_space(3))) int*)((__attribute__((address_space(3))) unsigned char*)shm_w + WTAB_OFF + hw * 4) = (int)(threadIdx.x >> 6); }
__device__ __forceinline__ int ltid() { return lwave() * 64 + llane(); }
__device__ __forceinline__ int lbid() { int t = blockIdx.x; asm volatile("" : "+s"(t) :: "memory"); return t; }
namespace pg8 {
#define PG8_LAS __attribute__((address_space(3)))
typedef unsigned short bf16_t;
typedef short bf16x8 __attribute__((ext_vector_type(8)));
typedef float f32x4 __attribute__((ext_vector_type(4)));
typedef unsigned u32x4 __attribute__((ext_vector_type(4)));
constexpr int BM = 256, BK = 64, HALF = 128, HTB = HALF * BK * 2  , STAGE_BYTES = 8 * HTB, NXCD = 8, WGM = 8;

__host__ __device__ __forceinline__ int lds_byte(int r, int c) { const int st = (r >> 4) * 2 + (c >> 5), rr = r & 15, cc = c & 31, ob = rr * 64 + cc * 2; return st * 1024 + (ob ^ (((ob >> 9) & 1) << 5)); }
__host__ __device__ __forceinline__ void stage_rc(int b, int& R, int& C) { const int st = b / 1024, sb = b % 1024, swz = sb ^ (((sb >> 9) & 1) << 5); R = (st >> 1) * 16 + swz / 64; C = (st & 1) * 32 + (swz % 64) / 2; }
__host__ __device__ __forceinline__ int perm32(int rho) { const int n = rho >> 4, i = rho & 15; return 8 * (i >> 2) + 4 * n + (i & 3); }

struct Unit { int pm, pn, kofs; };
struct Gemm { const bf16_t* A; const bf16_t* Bt; int M, N, K, ldk; };

struct StaticOrder {
    int nM, nN, nwg, G, c, lat;
    __host__ __device__ void init(int M, int N, int G_, int c_, int lat_ = 0) { lat = lat_; nM = lat ? 128 : M / BM; nN = N / BM; nwg = nM * nN; G = G_; c = c_; }
    __host__ __device__ bool next(int i, Unit& u) const {
        const long L = (long)i * G + c; if (L >= nwg) return false;
        int wgid = (int)L; { const int q = nwg / NXCD, r = nwg % NXCD, xcd = wgid % NXCD, off = wgid / NXCD; wgid = (xcd < r ? xcd * (q + 1) : r * (q + 1) + (xcd - r) * q) + off; }
        const int nig = WGM * nN, gid = wgid / nig, fm = gid * WGM, gsz = (nM - fm) < WGM ? (nM - fm) : WGM;
        u.pm = fm + ((wgid % nig) % gsz); u.pn = (wgid % nig) / gsz; u.kofs = 0; if (lat) u.pm = (u.pm >> 5) * 33 + 1 + (u.pm & 31); return true;
    }
    __device__ __forceinline__ void a_ready(const Unit&) const {}
    __device__ __forceinline__ void done(const Unit&) const {}
};
__device__ __forceinline__ unsigned cvt_pk_bf16(float lo, float hi) { unsigned r; asm volatile("v_cvt_pk_bf16_f32 %0, %1, %2" : "=v"(r) : "v"(lo), "v"(hi)); return r; }
template <class Epi, class Sched, bool STAMP = false>
__device__ __forceinline__ void gemm_phase(PG8_LAS unsigned char* lds, const Gemm g, const Sched& S, const Epi& E, unsigned long long* stamps) {
    const int tid = ltid(), wid = __builtin_amdgcn_readfirstlane(tid >> 6), lane = tid & 63, wr = wid >> 2, wc = wid & 3, fr = lane & 15, fq = lane >> 4;
    const int K = g.K, nt = K / BK, ldk = g.ldk ? g.ldk : g.K;
    int ts_lo = 0, ts_hi = 0, nts = 0; const unsigned long long rt_entry = STAMP ? (unsigned long long)wall_clock64() : 0ull;
#define PG8_STAMP() do { if (STAMP && wid == 0 && nts < 64) { const unsigned long long _c = (unsigned long long)clock64(); \
        ts_lo = (lane == nts) ? (int)(unsigned)_c : ts_lo; ts_hi = (lane == nts) ? (int)(unsigned)(_c >> 32) : ts_hi; ++nts; } } while (0)
    PG8_STAMP();
    unsigned voffA[2], voffB[2];
#pragma unroll
    for (int i = 0; i < 2; ++i) { int R, C; stage_rc(tid * 16 + i * 8192, R, C); const int Rb = Epi::PERM ? ((R & ~31) + perm32(R & 31)) : R;
        voffA[i] = (unsigned)(R * ldk + C) * 2u; voffB[i] = (unsigned)(Rb * ldk + C) * 2u; }
    const size_t kstep = (size_t)(BK * 2);
    const size_t hstep = (size_t)HALF * ldk * 2;
    const size_t tstep = 2 * hstep;
    const unsigned ldsw = (unsigned)wid * 1024u;
    const int aoff = lds_byte(wr * 64 + fr, fq * 8), boff = lds_byte(wc * 32 + fr, fq * 8);
#define PG8_SA(b, h) (((b) * 2 + (h)) * HTB)
#define PG8_SB(b, h) ((4 + (b) * 2 + (h)) * HTB)
#define PG8_STAGE(bufoff, gbase, voff) do { _Pragma("unroll") for (int _i = 0; _i < 2; ++_i) \
        __builtin_amdgcn_global_load_lds((const unsigned*)((const char*)(gbase) + (voff)[_i]), (PG8_LAS unsigned*)(lds + (bufoff) + ldsw + _i * 8192), 16, 0, 0); } while (0)
#define PG8_LDA(dst, b, h) do { _Pragma("unroll") for (int m = 0; m < 4; ++m) _Pragma("unroll") for (int k = 0; k < 2; ++k) dst[m][k] = *(const PG8_LAS bf16x8*)(lds + PG8_SA(b, h) + aoff + m * 2048 + k * 1024); } while (0)
#define PG8_LDB(dst, b, h) do { _Pragma("unroll") for (int n = 0; n < 2; ++n) _Pragma("unroll") for (int k = 0; k < 2; ++k) dst[n][k] = *(const PG8_LAS bf16x8*)(lds + PG8_SB(b, h) + boff + n * 2048 + k * 1024); } while (0)
#define PG8_MMA(ai, bj, At, Bt) do { __builtin_amdgcn_s_setprio(1); _Pragma("unroll") for (int m = 0; m < 4; ++m) _Pragma("unroll") for (int n = 0; n < 2; ++n) _Pragma("unroll") for (int k = 0; k < 2; ++k) \
        acc[ai][bj][m][n] = __builtin_amdgcn_mfma_f32_16x16x32_bf16(Bt[n][k], At[m][k], acc[ai][bj][m][n], 0, 0, 0); __builtin_amdgcn_s_setprio(0); } while (0)
#define PG8_WAIT_V(n) asm volatile("s_waitcnt vmcnt(" #n ")" ::: "memory")
#define PG8_WAIT_L(n) asm volatile("s_waitcnt lgkmcnt(" #n ")" ::: "memory")
#define PG8_BAR __builtin_amdgcn_s_barrier()
#define PG8_SCHED __builtin_amdgcn_sched_barrier(0)
    Unit cur, nxt; int ui = 0;
    if (!S.next(0, cur)) return;
    f32x4 acc[2][2][4][2];
#pragma unroll
    for (int a = 0; a < 2; ++a)
#pragma unroll
        for (int b = 0; b < 2; ++b)
#pragma unroll
            for (int m = 0; m < 4; ++m)
#pragma unroll
                for (int n = 0; n < 2; ++n) acc[a][b][m][n] = (f32x4){0.f, 0.f, 0.f, 0.f};
    bf16x8 At[4][2], B0[2][2], B1[2][2];
    const char* cA = (const char*)g.A + (size_t)cur.pm * tstep + (size_t)cur.kofs * 2; const char* cB = (const char*)g.Bt + (size_t)cur.pn * tstep + (size_t)cur.kofs * 2;
    S.a_ready(cur);
    PG8_STAGE(PG8_SB(0, 0), cB, voffB); PG8_STAGE(PG8_SA(0, 0), cA, voffA); PG8_STAGE(PG8_SB(0, 1), cB + hstep, voffB); PG8_STAGE(PG8_SA(0, 1), cA + hstep, voffA);
    if (wr == 1) PG8_BAR;
    PG8_WAIT_V(4); PG8_BAR;
    PG8_STAGE(PG8_SB(1, 0), cB + kstep, voffB); PG8_STAGE(PG8_SA(1, 0), cA + kstep, voffA); PG8_STAGE(PG8_SB(1, 1), cB + hstep + kstep, voffB);
    PG8_WAIT_V(6); PG8_BAR;
    PG8_STAMP();
    for (;;) {
        const bool has_next = S.next(ui + 1, nxt);
        const char* nA = has_next ? (const char*)g.A + (size_t)nxt.pm * tstep + (size_t)nxt.kofs * 2 : cA; const char* nB = has_next ? (const char*)g.Bt + (size_t)nxt.pn * tstep + (size_t)nxt.kofs * 2 : cB;
        for (int t = 0; t < nt; t += 2) {
            const bool last = (t == nt - 2);
            const char* a1 = cA + (size_t)(t + 1) * kstep;
            const char* a2 = last ? nA : cA + (size_t)(t + 2) * kstep; const char* b2 = last ? nB : cB + (size_t)(t + 2) * kstep;
            const char* a3 = a2 + kstep; const char* b3 = b2 + kstep;
            if (last && has_next) S.a_ready(nxt);
            PG8_LDB(B0, 0, 0); PG8_SCHED; PG8_LDA(At, 0, 0); PG8_STAGE(PG8_SA(1, 1), a1 + hstep, voffA);
            PG8_WAIT_L(8); PG8_BAR; PG8_WAIT_L(0); PG8_MMA(0, 0, At, B0); PG8_BAR; PG8_SCHED;
            PG8_LDB(B1, 0, 1); PG8_STAGE(PG8_SB(0, 0), b2, voffB);
            PG8_BAR; PG8_WAIT_L(0); PG8_MMA(0, 1, At, B1); PG8_BAR;
            PG8_LDA(At, 0, 1); PG8_STAGE(PG8_SA(0, 0), a2, voffA);
            PG8_BAR; PG8_WAIT_L(0); PG8_MMA(1, 0, At, B0); PG8_BAR; PG8_SCHED;
            PG8_STAGE(PG8_SB(0, 1), b2 + hstep, voffB);
            PG8_WAIT_V(6); PG8_BAR; PG8_MMA(1, 1, At, B1); PG8_BAR;
            PG8_LDB(B0, 1, 0); PG8_SCHED; PG8_LDA(At, 1, 0); PG8_STAGE(PG8_SA(0, 1), a2 + hstep, voffA);
            PG8_WAIT_L(8); PG8_BAR; PG8_WAIT_L(0); PG8_MMA(0, 0, At, B0); PG8_BAR; PG8_SCHED;
            PG8_LDB(B1, 1, 1); PG8_STAGE(PG8_SB(1, 0), b3, voffB);
            PG8_BAR; PG8_WAIT_L(0); PG8_MMA(0, 1, At, B1); PG8_BAR;
            PG8_LDA(At, 1, 1); PG8_STAGE(PG8_SA(1, 0), a3, voffA);
            PG8_BAR; PG8_WAIT_L(0); PG8_MMA(1, 0, At, B0); PG8_BAR; PG8_SCHED;
            PG8_STAGE(PG8_SB(1, 1), b3 + hstep, voffB);
            PG8_WAIT_V(6); PG8_BAR; PG8_MMA(1, 1, At, B1); PG8_BAR;
        }
        PG8_STAMP();
        if constexpr (!Epi::AFTER_DRAIN) { E(acc, cur, wr, wc, fr, fq); S.done(cur); }
        PG8_STAMP();
        if (!has_next) break;
#pragma unroll
        for (int a = 0; a < 2; ++a)
#pragma unroll
            for (int b = 0; b < 2; ++b)
#pragma unroll
                for (int m = 0; m < 4; ++m)
#pragma unroll
                    for (int n = 0; n < 2; ++n) acc[a][b][m][n] = (f32x4){0.f, 0.f, 0.f, 0.f};
        cur = nxt; cA = nA; cB = nB; ++ui;
    }
    PG8_WAIT_V(0);
    if (wr == 0) PG8_BAR;
    PG8_BAR;
    if constexpr (Epi::AFTER_DRAIN) { E.fused(acc, cur, wr, wc, fr, fq, lds, wid, lane); S.done(cur); }
    PG8_STAMP();
    if (STAMP && wid == 0) { stamps[lane] = lane < nts ? (((unsigned long long)(unsigned)ts_hi << 32) | (unsigned)ts_lo) : 0ull;
        if (lane == 62) stamps[62] = rt_entry; if (lane == 63) stamps[63] = (unsigned long long)wall_clock64(); }
#undef PG8_STAMP
#undef PG8_SA
#undef PG8_SB
#undef PG8_STAGE
#undef PG8_LDA
#undef PG8_LDB
#undef PG8_MMA
#undef PG8_WAIT_V
#undef PG8_WAIT_L
#undef PG8_BAR
#undef PG8_SCHED
}
}

typedef unsigned short u16;
using pg8::f32x4; using pg8::bf16x8;
typedef float f32x2 __attribute__((ext_vector_type(2)));
typedef unsigned u32x2 __attribute__((ext_vector_type(2)));
typedef unsigned u32x4v __attribute__((ext_vector_type(4)));
typedef short s16x4 __attribute__((ext_vector_type(4)));
#define LAS __attribute__((address_space(3)))
constexpr int D = 1024, NB = 4, SEQ = 8192, CTX = 256, TPB = 8448, NTOK = 33792, FF = 2816, NCH = 132, INNER = 2048, DH = 512, NFFT = 16384;
constexpr size_t MiB = 1u << 20;
constexpr size_t OFF_WB = 0, OFF_MOD = 48 * MiB, OFF_H = 49 * MiB, OFF_U = OFF_H + 132 * MiB, OFF_R1 = OFF_U + 66 * MiB, OFF_R2 = OFF_R1 + 264 * MiB,
                 OFF_HBC = OFF_R2 + 132 * MiB, OFF_GATES = OFF_HBC + 4 * MiB, OFF_H2 = OFF_GATES + 3 * MiB, OFF_KCTX = OFF_H2 + 3 * MiB, WS_NEED = OFF_KCTX + 4 * MiB;
constexpr size_t WB_FIN0 = 0, WB_FIN1 = 11 * MiB, WB_FOUT0 = 22 * MiB, WB_FOUT1 = 22 * MiB + 5632 * 1024, WB_MIN = 33 * MiB, WB_MOUT = 41 * MiB, WB_WGT = 45 * MiB;
constexpr int LDS_BYTES = 163840;
struct KP { const float* in[36]; float* out; unsigned char* ws; int ph_lo, ph_hi; };
typedef const KP __attribute__((address_space(4))) * KPC;
enum { I_X = 0, I_C, I_CTX, I_CCTX, I_ADAW, I_ADAB, I_NORMG, I_FINALG, I_FFNIN, I_FFNOUT, I_HYWIN, I_HYBIN, I_HYCW, I_HYCB, I_HYW1, I_HYB1, I_HYW2, I_HYB2, I_HYW3, I_HYB3,
       I_HYFREQ, I_HYDECAY, I_HYSKIP, I_HYWOUT, I_HYBOUT, I_MLUP, I_MLCW, I_MLCB, I_MLWQ, I_MLWK, I_MLWV, I_MLWG, I_MLBG, I_MLNG, I_MLSKIP, I_MLDOWN };

__device__ __forceinline__ float bf2f(u16 b) { return __uint_as_float(((unsigned)b) << 16); }
__device__ __forceinline__ float bflo(unsigned w) { return __uint_as_float(w << 16); }
__device__ __forceinline__ float bfhi(unsigned w) { return __uint_as_float(w & 0xffff0000u); }
__device__ __forceinline__ u16 f2bf(float f) { return (u16)(pg8::cvt_pk_bf16(f, 0.f) & 0xffffu); }
__device__ __forceinline__ float siluf(float x) { return x / (1.0f + __expf(-x)); }
__device__ __forceinline__ int modrow_of_token(int T) { const int b = T / TPB, t = T - b * TPB; return t < CTX ? 4 : b; }
__device__ __forceinline__ float lshfl(float v, int srclane) { return __int_as_float(__builtin_amdgcn_ds_bpermute(srclane << 2, __float_as_int(v))); }
__device__ __forceinline__ float wave_sum(float v) { const int lane = llane();
#pragma unroll
    for (int o = 32; o > 0; o >>= 1) v += lshfl(v, lane ^ o);
    return v; }
__device__ __forceinline__ float wave_max(float v) { const int lane = llane();
#pragma unroll
    for (int o = 32; o > 0; o >>= 1) v = fmaxf(v, lshfl(v, lane ^ o));
    return v; }

__device__ __forceinline__ void unpack8(u32x4v w, float (&f)[8]) { f[0] = bflo(w.x); f[1] = bfhi(w.x); f[2] = bflo(w.y); f[3] = bfhi(w.y); f[4] = bflo(w.z); f[5] = bfhi(w.z); f[6] = bflo(w.w); f[7] = bfhi(w.w); }
__device__ __forceinline__ u32x4v pack8(const float (&f)[8]) { u32x4v w; w.x = pg8::cvt_pk_bf16(f[0], f[1]); w.y = pg8::cvt_pk_bf16(f[2], f[3]); w.z = pg8::cvt_pk_bf16(f[4], f[5]); w.w = pg8::cvt_pk_bf16(f[6], f[7]); return w; }

struct EpiSwiglu {
    static constexpr bool PERM = true, AFTER_DRAIN = false;
    u16* act;
    __device__ __forceinline__ void operator()(const f32x4 (&acc)[2][2][4][2], const pg8::Unit& u, int wr, int wc, int fr, int fq) const {
        const int row0 = u.pm * 256 + wr * 64 + fr, col0 = u.pn * 128 + wc * 32 + 8 * fq;
#pragma unroll
        for (int ai = 0; ai < 2; ++ai)
#pragma unroll
            for (int m = 0; m < 4; ++m) {
                const f32x4 g0 = acc[ai][0][m][0], g1 = acc[ai][0][m][1], v0 = acc[ai][1][m][0], v1 = acc[ai][1][m][1];
                u32x4v w;
                w.x = pg8::cvt_pk_bf16(siluf(g0[0]) * v0[0], siluf(g0[1]) * v0[1]); w.y = pg8::cvt_pk_bf16(siluf(g0[2]) * v0[2], siluf(g0[3]) * v0[3]);
                w.z = pg8::cvt_pk_bf16(siluf(g1[0]) * v1[0], siluf(g1[1]) * v1[1]); w.w = pg8::cvt_pk_bf16(siluf(g1[2]) * v1[2], siluf(g1[3]) * v1[3]);
                *(u32x4v*)(act + (size_t)(row0 + ai * 128 + m * 16) * FF + col0) = w; }
    }
};
struct EpiResid {
    static constexpr bool PERM = false, AFTER_DRAIN = false;
    float* h; const float* modl; int gidx; float scale; const float* bias;
    __device__ __forceinline__ void operator()(const f32x4 (&acc)[2][2][4][2], const pg8::Unit& u, int wr, int wc, int fr, int fq) const {
        const int row0 = u.pm * 256 + wr * 64 + fr, col0 = u.pn * 256 + wc * 32 + 4 * fq;
        const int mr = modrow_of_token(u.pm * 256);
        const float* gp = modl + (size_t)mr * 9216 + gidx * 1024;
        f32x4 gv[2][2], bv[2][2];
#pragma unroll
        for (int bj = 0; bj < 2; ++bj)
#pragma unroll
            for (int n = 0; n < 2; ++n) { gv[bj][n] = *(const f32x4*)(gp + col0 + bj * 128 + n * 16) * scale;
                bv[bj][n] = bias ? *(const f32x4*)(bias + col0 + bj * 128 + n * 16) : (f32x4){0.f, 0.f, 0.f, 0.f}; }
#pragma unroll
        for (int ai = 0; ai < 2; ++ai)
#pragma unroll
            for (int m = 0; m < 4; ++m) { float* rowp = h + (size_t)(row0 + ai * 128 + m * 16) * D + col0;
#pragma unroll
                for (int bj = 0; bj < 2; ++bj)
#pragma unroll
                    for (int n = 0; n < 2; ++n) { f32x4* q = (f32x4*)(rowp + bj * 128 + n * 16); *q = *q + gv[bj][n] * (acc[ai][bj][m][n] + bv[bj][n]); } }
    }
};
struct EpiBf {
    static constexpr bool PERM = true, AFTER_DRAIN = false;
    u16* O; int ldc;
    __device__ __forceinline__ void operator()(const f32x4 (&acc)[2][2][4][2], const pg8::Unit& u, int wr, int wc, int fr, int fq) const {
        const int row0 = u.pm * 256 + wr * 64 + fr, col0 = u.pn * 256 + wc * 32 + 8 * fq;
#pragma unroll
        for (int ai = 0; ai < 2; ++ai)
#pragma unroll
            for (int m = 0; m < 4; ++m)
#pragma unroll
                for (int bj = 0; bj < 2; ++bj) { const f32x4 a = acc[ai][bj][m][0], b = acc[ai][bj][m][1]; u32x4v w;
                    w.x = pg8::cvt_pk_bf16(a[0], a[1]); w.y = pg8::cvt_pk_bf16(a[2], a[3]); w.z = pg8::cvt_pk_bf16(b[0], b[1]); w.w = pg8::cvt_pk_bf16(b[2], b[3]);
                    *(u32x4v*)(O + (size_t)(row0 + ai * 128 + m * 16) * ldc + col0 + bj * 128) = w; }
    }
};
struct EpiProjT {
    static constexpr bool PERM = true, AFTER_DRAIN = false;
    u16* lat; u16* ctx; const float* bias;
    __device__ __forceinline__ void operator()(const f32x4 (&acc)[2][2][4][2], const pg8::Unit& u, int wr, int wc, int fr, int fq) const {
        const int row0 = u.pm * 256 + wr * 64 + fr, tc0 = wc * 32 + 8 * fq;
        const int b = u.pn / 33, tile = u.pn - b * 33;
#pragma unroll
        for (int ai = 0; ai < 2; ++ai)
#pragma unroll
            for (int m = 0; m < 4; ++m) { const int ch = row0 + ai * 128 + m * 16; const float bs = bias[ch];
                u16* dst = tile == 0 ? ctx + ((size_t)b * 3072 + ch) * CTX + tc0 : lat + ((size_t)b * 3072 + ch) * SEQ + (tile - 1) * 256 + tc0;
#pragma unroll
                for (int bj = 0; bj < 2; ++bj) { const f32x4 a = acc[ai][bj][m][0] + bs, c = acc[ai][bj][m][1] + bs; u32x4v w;
                    w.x = pg8::cvt_pk_bf16(a[0], a[1]); w.y = pg8::cvt_pk_bf16(a[2], a[3]); w.z = pg8::cvt_pk_bf16(c[0], c[1]); w.w = pg8::cvt_pk_bf16(c[2], c[3]);
                    *(u32x4v*)(dst + bj * 128) = w; } }
    }
};


struct LatOrder : pg8::StaticOrder {
    __device__ bool next(int i, pg8::Unit& u) const { if (!pg8::StaticOrder::next(i, u)) return false; u.pm = (u.pm >> 5) * 33 + 1 + (u.pm & 31); return true; }
};
struct CtxSplitOrder {
    int nk, G, c;
    __device__ bool next(int i, pg8::Unit& u) const { const int L = i * G + c; if (L >= 16 * nk) return false; const int un = L & 15, kc = L >> 4; u.pm = (un >> 2) * 33; u.pn = un & 3; u.kofs = kc * 256; return true; }
    __device__ __forceinline__ void a_ready(const pg8::Unit&) const {}
    __device__ __forceinline__ void done(const pg8::Unit&) const {}
};
struct EpiResidAtomic {
    static constexpr bool PERM = false, AFTER_DRAIN = false;
    float* h; const float* gp; float scale;
    __device__ __forceinline__ void operator()(const f32x4 (&acc)[2][2][4][2], const pg8::Unit& u, int wr, int wc, int fr, int fq) const {
        const int row0 = u.pm * 256 + wr * 64 + fr, col0 = u.pn * 256 + wc * 32 + 4 * fq;
#pragma unroll
        for (int bj = 0; bj < 2; ++bj)
#pragma unroll
            for (int n = 0; n < 2; ++n) { const f32x4 gv = *(const f32x4*)(gp + col0 + bj * 128 + n * 16) * scale;
#pragma unroll
                for (int ai = 0; ai < 2; ++ai)
#pragma unroll
                    for (int m = 0; m < 4; ++m) { float* q = h + (size_t)(row0 + ai * 128 + m * 16) * D + col0 + bj * 128 + n * 16; const f32x4 v = gv * acc[ai][bj][m][n];
                        atomicAdd(q, v[0]); atomicAdd(q + 1, v[1]); atomicAdd(q + 2, v[2]); atomicAdd(q + 3, v[3]); } }
    }
};

__device__ __forceinline__ void ctx_bias_phase(KPC kp, const float* gp, const float* bias) {
    float* h = (float*)(kp->ws + OFF_H);
    for (int i = lbid() * 512 + ltid(); i < NB * CTX * 256; i += gridDim.x * 512) { const int r = i >> 8, c = (i & 255) * 4, b = r >> 8, t = r & 255;
        f32x4* q = (f32x4*)(h + ((size_t)b * TPB + t) * D + c); *q = *q + *(const f32x4*)(gp + c) * *(const f32x4*)(bias + c); }
}
__device__ __forceinline__ int colmap(int n, int mapmode) { return mapmode ? (((n >> 8) << 7) + (n & 127) + ((n >> 7) & 1) * FF) : n; }
__device__ __forceinline__ void convert_T(const float* __restrict__ src, int ld, int K, int Nd, int mapmode, u16* __restrict__ dst, LAS float* tile, int& tctr) {
    const int tid = ltid(), nkt = K / 64, ntile = (Nd / 64) * nkt;
    const int G = (int)gridDim.x; const int first = (((lbid() - tctr) % G) + G) % G; tctr += ntile;
    for (int t = first; t < ntile; t += G) {
        const int n0 = (t / nkt) * 64, k0 = (t % nkt) * 64, c0 = colmap(n0, mapmode);
#pragma unroll
        for (int i = 0; i < 2; ++i) { const int e = tid + 512 * i, kr = e >> 4, c4 = (e & 15) * 4;
            const f32x4 v = *(const f32x4*)(src + (size_t)(k0 + kr) * ld + c0 + c4);
            tile[kr * 65 + c4] = v[0]; tile[kr * 65 + c4 + 1] = v[1]; tile[kr * 65 + c4 + 2] = v[2]; tile[kr * 65 + c4 + 3] = v[3]; }
        __syncthreads();
        { const int n = tid >> 3, k8 = (tid & 7) * 8; u32x4v w;
          w.x = pg8::cvt_pk_bf16(tile[(k8 + 0) * 65 + n], tile[(k8 + 1) * 65 + n]); w.y = pg8::cvt_pk_bf16(tile[(k8 + 2) * 65 + n], tile[(k8 + 3) * 65 + n]);
          w.z = pg8::cvt_pk_bf16(tile[(k8 + 4) * 65 + n], tile[(k8 + 5) * 65 + n]); w.w = pg8::cvt_pk_bf16(tile[(k8 + 6) * 65 + n], tile[(k8 + 7) * 65 + n]);
          *(u32x4v*)(dst + (size_t)(n0 + n) * K + k0 + k8) = w; }
        __syncthreads();
    }
}

__device__ __forceinline__ void norm_phase(KPC kp, int l, int sub) {
    const float* h = (const float*)(kp->ws + OFF_H); u16* uo = (u16*)(kp->ws + OFF_U);
    const float* g = kp->in[I_NORMG] + (size_t)(l * 3 + sub) * D; const float* modl = (const float*)(kp->ws + OFF_MOD) + (size_t)l * 5 * 9216;
    const int lane = ltid() & 63, wv = ltid() >> 6;
    for (int T = lbid() * 8 + wv; T < NTOK; T += gridDim.x * 8) {
        const float* hr = h + (size_t)T * D; f32x4 v[4]; float ss = 0.f;
#pragma unroll
        for (int i = 0; i < 4; ++i) { v[i] = *(const f32x4*)(hr + i * 256 + lane * 4); ss += v[i][0] * v[i][0] + v[i][1] * v[i][1] + v[i][2] * v[i][2] + v[i][3] * v[i][3]; }
        ss = wave_sum(ss); const float rs = rsqrtf(ss * (1.0f / D) + 1e-6f);
        const float* mp = modl + (size_t)modrow_of_token(T) * 9216 + sub * 3 * 1024;
#pragma unroll
        for (int i = 0; i < 4; ++i) { const int c = i * 256 + lane * 4; const f32x4 gg = *(const f32x4*)(g + c), sh = *(const f32x4*)(mp + c), sc = *(const f32x4*)(mp + 1024 + c);
            const f32x4 o = v[i] * rs * gg * (sc + 1.0f) + sh; u32x2 w; w.x = pg8::cvt_pk_bf16(o[0], o[1]); w.y = pg8::cvt_pk_bf16(o[2], o[3]);
            *(u32x2*)(uo + (size_t)T * D + c) = w; }
    }
}

__device__ __forceinline__ void final_phase(KPC kp) {
    const float* h = (const float*)(kp->ws + OFF_H); const float* g = kp->in[I_FINALG];
    const int lane = ltid() & 63, wv = ltid() >> 6;
    for (int r = lbid() * 8 + wv; r < NB * SEQ; r += gridDim.x * 8) {
        const int b = r / SEQ, s = r - b * SEQ; const float* hr = h + ((size_t)b * TPB + CTX + s) * D; f32x4 v[4]; float ss = 0.f;
#pragma unroll
        for (int i = 0; i < 4; ++i) { v[i] = *(const f32x4*)(hr + i * 256 + lane * 4); ss += v[i][0] * v[i][0] + v[i][1] * v[i][1] + v[i][2] * v[i][2] + v[i][3] * v[i][3]; }
        ss = wave_sum(ss); const float rs = rsqrtf(ss * (1.0f / D) + 1e-6f);
#pragma unroll
        for (int i = 0; i < 4; ++i) { const int c = i * 256 + lane * 4; *(f32x4*)(kp->out + (size_t)r * D + c) = v[i] * rs * *(const f32x4*)(g + c); }
    }
}

__device__ __forceinline__ void setup_phase(KPC kp, LAS float* ldsf) {
    float* h = (float*)(kp->ws + OFF_H); const int tid = ltid();
    for (size_t i = (size_t)lbid() * 512 + tid; i < (size_t)NTOK * 256; i += (size_t)gridDim.x * 512) {
        const int T = (int)(i >> 8), c = ((int)i & 255) * 4, b = T / TPB, t = T - b * TPB; f32x4 v;
        if (t < CTX) v = *(const f32x4*)(kp->in[I_CTX] + ((size_t)b * CTX + t) * D + c);
        else { const int s = t - CTX; v = *(const f32x4*)(kp->in[I_X] + ((size_t)b * SEQ + s) * D + c);
            const int half = c >> 9, cc = c & 511, isc = cc >> 8, i0 = cc & 255; const float pv = half ? (float)(s & 63) : (float)(s >> 6);
#pragma unroll
            for (int e = 0; e < 4; ++e) { const float om = exp2f(-13.287712379549449f * (float)(i0 + e) * (1.0f / 256.0f)); const float ang = pv * om; v[e] += isc ? __cosf(ang) : __sinf(ang); } }
        *(f32x4*)(h + (size_t)T * D + c) = v;
    }
    LAS float* sc = ldsf; LAS float* red = ldsf + 5 * 1024;
    for (int i = tid; i < 5 * 1024; i += 512) { const int r = i >> 10, k = i & 1023; const float cv = r < 4 ? kp->in[I_C][r * D + k] : kp->in[I_CCTX][k]; sc[i] = siluf(cv); }
    __syncthreads();
    float* mod = (float*)(kp->ws + OFF_MOD); const int lane = tid & 63, wv = tid >> 6;
    for (int task = lbid(); task < 288; task += gridDim.x) {
        const int l = task / 72, n0 = (task % 72) * 128 + lane * 2; const float* w = kp->in[I_ADAW] + (size_t)l * D * 9216 + n0;
        f32x2 a[5];
#pragma unroll
        for (int r = 0; r < 5; ++r) a[r] = (f32x2){0.f, 0.f};
#pragma unroll 16
        for (int k = wv * 128; k < wv * 128 + 128; ++k) { const f32x2 wv2 = *(const f32x2*)(w + (size_t)k * 9216);
#pragma unroll
            for (int r = 0; r < 5; ++r) a[r] += wv2 * sc[r * 1024 + k]; }
#pragma unroll
        for (int r = 0; r < 5; ++r) { red[(wv * 5 + r) * 128 + lane * 2] = a[r][0]; red[(wv * 5 + r) * 128 + lane * 2 + 1] = a[r][1]; }
        __syncthreads();
        for (int i = tid; i < 640; i += 512) { const int r = i >> 7, n = i & 127; float s = 0.f;
#pragma unroll
            for (int w8 = 0; w8 < 8; ++w8) s += red[(w8 * 5 + r) * 128 + n];
            const int nn = (task % 72) * 128 + n; mod[((size_t)l * 5 + r) * 9216 + nn] = s + kp->in[I_ADAB][(size_t)l * 9216 + nn]; }
        __syncthreads();
    }
}

__device__ __forceinline__ void convert_layer(KPC kp, int l, LAS float* tile) {
    unsigned char* wb = kp->ws + OFF_WB; int tctr = 0; const int j = l >> 1;
    for (int f = 0; f < 2; ++f) {
        convert_T(kp->in[I_FFNIN] + (size_t)(l * 2 + f) * D * 2 * FF, 2 * FF, D, 2 * FF, 1, (u16*)(wb + (f ? WB_FIN1 : WB_FIN0)), tile, tctr);
        convert_T(kp->in[I_FFNOUT] + (size_t)(l * 2 + f) * FF * D, D, FF, D, 0, (u16*)(wb + (f ? WB_FOUT1 : WB_FOUT0)), tile, tctr);
    }
    if ((l & 1) == 0) {
        convert_T(kp->in[I_HYWIN] + (size_t)j * D * 3 * D, 3 * D, D, 3 * D, 0, (u16*)(wb + WB_MIN), tile, tctr);
        convert_T(kp->in[I_HYWOUT] + (size_t)j * D * D, D, D, D, 0, (u16*)(wb + WB_MOUT), tile, tctr);
    } else {
        convert_T(kp->in[I_MLUP] + (size_t)j * D * 2 * INNER, 2 * INNER, D, 2 * INNER, 0, (u16*)(wb + WB_MIN), tile, tctr);
        convert_T(kp->in[I_MLDOWN] + (size_t)j * INNER * D, D, INNER, D, 0, (u16*)(wb + WB_MOUT), tile, tctr);
        u16* wg = (u16*)(wb + WB_WGT); const float* src = kp->in[I_MLWG] + (size_t)j * 3 * INNER * 16;
        for (int i = lbid() * 512 + ltid(); i < 16 * 3 * INNER; i += gridDim.x * 512) { const int o = i / (3 * INNER), k = i - o * 3 * INNER; wg[i] = f2bf(src[(size_t)k * 16 + o]); }
        float* gates = (float*)(kp->ws + OFF_GATES); const float* bg = kp->in[I_MLBG] + j * 16;
        for (int i = lbid() * 512 + ltid(); i < NTOK * 16; i += gridDim.x * 512) gates[i] = bg[i & 15];
    }
}

constexpr size_t HY_PL = 0, HY_PC = (size_t)NB * 3072 * SEQ * 2, HY_YL = HY_PC + (size_t)NB * 3072 * CTX * 2, HY_YC = HY_YL + (size_t)NB * D * SEQ * 2;
__device__ __forceinline__ int fphys(int i) { return i ^ ((((i >> 6) & 1) * 21) ^ (((i >> 5) & 1) * 10)); }
__device__ __forceinline__ f32x2 cmul(f32x2 a, f32x2 b) { return (f32x2){a.x * b.x - a.y * b.y, a.x * b.y + a.y * b.x}; }
__device__ __forceinline__ f32x2 cmulc(f32x2 a, f32x2 b) { return (f32x2){a.x * b.x + a.y * b.y, a.y * b.x - a.x * b.y}; }
__device__ __forceinline__ int drev(int x) { const unsigned r = __brev((unsigned)x) >> 18; return (int)(((r & 0x2AAAu) >> 1) | ((r & 0x1555u) << 1)); }

__device__ __forceinline__ void fidx4(int base, int lm, int (&ix)[4]) {
    const int m = 1 << lm;
    if (lm == 6) { const int i0 = fphys(base); ix[0] = i0; ix[1] = (i0 + 64) ^ 21; ix[2] = i0 + 128; ix[3] = (i0 + 192) ^ 21; }
    else if (lm == 4) { const int c6 = ((base >> 6) & 1) * 21; ix[0] = base ^ c6; ix[1] = (base + 16) ^ c6; ix[2] = (base + 32) ^ c6 ^ 10; ix[3] = (base + 48) ^ c6 ^ 10; }
    else { const int c = (((base >> 6) & 1) * 21) ^ (((base >> 5) & 1) * 10); ix[0] = base ^ c; ix[1] = (base + m) ^ c; ix[2] = (base + 2 * m) ^ c; ix[3] = (base + 3 * m) ^ c; }
}
__device__ __forceinline__ void fft_fwd(LAS f32x2* buf) {
    const int tid = ltid();
    for (int lm = 12; lm >= 0; lm -= 2) {
        const int m = 1 << lm; const float inv = 1.0f / (float)(4 << lm);
        f32x2 a[8][4]; int ix[8][4];
#pragma unroll
        for (int i = 0; i < 8; ++i) { const int g = tid + 512 * i, p = g & (m - 1), base = ((g >> lm) << (lm + 2)) + p; fidx4(base, lm, ix[i]);
#pragma unroll
            for (int r = 0; r < 4; ++r) a[i][r] = buf[ix[i][r]]; }
#pragma unroll
        for (int i = 0; i < 8; ++i) { const int p = (tid + 512 * i) & (m - 1);
            const f32x2 t0 = a[i][0] + a[i][2], t1 = a[i][0] - a[i][2], t2 = a[i][1] + a[i][3], dd = a[i][1] - a[i][3], t3 = (f32x2){dd.y, -dd.x};
            const float rev = (float)p * inv;
            const f32x2 w1 = (f32x2){__builtin_amdgcn_cosf(rev), -__builtin_amdgcn_sinf(rev)}, w2 = cmul(w1, w1), w3 = cmul(w2, w1);
            buf[ix[i][0]] = t0 + t2; buf[ix[i][1]] = cmul(t1 + t3, w1); buf[ix[i][2]] = cmul(t0 - t2, w2); buf[ix[i][3]] = cmul(t1 - t3, w3); }
        __syncthreads();
    }
}
__device__ __forceinline__ void fft_inv(LAS f32x2* buf) {
    const int tid = ltid();
    for (int lm = 0; lm <= 12; lm += 2) {
        const int m = 1 << lm; const float inv = 1.0f / (float)(4 << lm);
        f32x2 a[8][4]; int ix[8][4];
#pragma unroll
        for (int i = 0; i < 8; ++i) { const int g = tid + 512 * i, p = g & (m - 1), base = ((g >> lm) << (lm + 2)) + p; fidx4(base, lm, ix[i]);
#pragma unroll
            for (int r = 0; r < 4; ++r) a[i][r] = buf[ix[i][r]]; }
#pragma unroll
        for (int i = 0; i < 8; ++i) { const int p = (tid + 512 * i) & (m - 1);
            const float rev = (float)p * inv;
            const f32x2 w1 = (f32x2){__builtin_amdgcn_cosf(rev), -__builtin_amdgcn_sinf(rev)}, w2 = cmul(w1, w1), w3 = cmul(w2, w1);
            const f32x2 b0 = a[i][0], b1 = cmulc(a[i][1], w1), b2 = cmulc(a[i][2], w2), b3 = cmulc(a[i][3], w3);
            const f32x2 s0 = b0 + b2, s1 = b0 - b2, s2 = b1 + b3, dd = b1 - b3, s3 = (f32x2){-dd.y, dd.x};
            buf[ix[i][0]] = s0 + s2; buf[ix[i][1]] = s1 + s3; buf[ix[i][2]] = s0 - s2; buf[ix[i][3]] = s1 - s3; }
        __syncthreads();
    }
}

__device__ __forceinline__ void hy_mlp_phase(KPC kp, int j) {
    float* h2 = (float*)(kp->ws + OFF_H2);
    const float* w1 = kp->in[I_HYW1] + j * 33 * 64; const float* b1 = kp->in[I_HYB1] + j * 64; const float* w2 = kp->in[I_HYW2] + j * 64 * 64; const float* b2 = kp->in[I_HYB2] + j * 64;
    const float* fr = kp->in[I_HYFREQ] + j * 128; const int lane = ltid() & 63, wv = ltid() >> 6;
    for (int pos = lbid() * 8 + wv; pos < SEQ + CTX; pos += gridDim.x * 8) {
        const int n = pos < SEQ ? SEQ : CTX, t = pos < SEQ ? pos : pos - SEQ; const float tn = (float)t / (float)(n - 1);
        float feat = 0.f;
        if (lane == 0) feat = tn;
        else if (lane < 33) { const int bi = (lane - 1) & 15; const float band = 1e-4f + (float)bi * ((15.0f - 1e-4f) / 15.0f); float rev = ((float)t / (float)n) * band; rev -= floorf(rev);
            const float ang = 6.283185307179586f * rev; feat = lane < 17 ? cosf(ang) : -sinf(ang); }
        float z = b1[lane];
        for (int i = 0; i < 33; ++i) z += lshfl(feat, i) * w1[i * 64 + lane];
        const float h1 = sinf(fr[lane] * z);
        float z2 = b2[lane];
        for (int v = 0; v < 64; ++v) z2 += lshfl(h1, v) * w2[v * 64 + lane];
        h2[(size_t)pos * 64 + lane] = sinf(fr[64 + lane] * z2);
    }
}

__device__ __forceinline__ void block_sum2(float& a, float& b, LAS float* red) {
    a = wave_sum(a); b = wave_sum(b); const int lane = ltid() & 63, wv = ltid() >> 6;
    __syncthreads(); if (lane == 0) { red[wv] = a; red[8 + wv] = b; } __syncthreads();
    float sa = 0.f, sb = 0.f;
#pragma unroll
    for (int i = 0; i < 8; ++i) { sa += red[i]; sb += red[8 + i]; }
    a = sa; b = sb;
}

__device__ __forceinline__ void hy_filter_task(KPC kp, int j, int task, LAS f32x2* buf, LAS float* aux) {
    const int tid = ltid(), d = task & 1023; const bool lat = task < 1024;
    const float* w3 = kp->in[I_HYW3] + (size_t)j * 64 * 4096; const float* b3 = kp->in[I_HYB3] + j * 4096; const float* ldc = kp->in[I_HYDECAY] + j * 4096;
    __syncthreads();
    if (tid < 256) aux[tid] = w3[(size_t)(tid & 63) * 4096 + (tid >> 6) * 1024 + d];
    if (tid < 4) { aux[256 + tid] = b3[tid * 1024 + d]; aux[260 + tid] = __expf(ldc[tid * 1024 + d]); }
    __syncthreads();
    const float* h2 = (const float*)(kp->ws + OFF_H2);
    float ss0 = 0.f, ss1 = 0.f;
    if (lat) {
        for (int r = 0; r < 16; ++r) { const int i = tid + 512 * r; float a0 = aux[256], a1 = aux[257], a2 = aux[258], a3 = aux[259];
#pragma unroll 4
            for (int u4 = 0; u4 < 16; ++u4) { const f32x4 hv = *(const f32x4*)(h2 + (size_t)i * 64 + u4 * 4);
                const f32x4 q0 = *(const LAS f32x4*)(aux + u4 * 4), q1 = *(const LAS f32x4*)(aux + 64 + u4 * 4), q2 = *(const LAS f32x4*)(aux + 128 + u4 * 4), q3 = *(const LAS f32x4*)(aux + 192 + u4 * 4);
#pragma unroll
                for (int e = 0; e < 4; ++e) { a0 += hv[e] * q0[e]; a1 += hv[e] * q1[e]; a2 += hv[e] * q2[e]; a3 += hv[e] * q3[e]; } }
            const float tn = (float)i * (1.0f / 8191.0f);
            a0 *= __expf(-tn * aux[260]); a1 *= __expf(-tn * aux[261]); a2 *= __expf(-tn * aux[262]); a3 *= __expf(-tn * aux[263]);
            buf[fphys(i)] = (f32x2){a0, a2}; ss0 += a0 * a0; ss1 += a2 * a2;
            if (i >= 1) { buf[fphys(NFFT - i)] = (f32x2){a1, a3}; ss0 += a1 * a1; ss1 += a3 * a3; } }
        if (tid == 0) buf[fphys(SEQ)] = (f32x2){0.f, 0.f};
        block_sum2(ss0, ss1, aux + 272);
        const f32x2 scl = (f32x2){rsqrtf(ss0 + 1e-12f) * (1.0f / NFFT), rsqrtf(ss1 + 1e-12f) * (1.0f / NFFT)};
        for (int r = 0; r < 32; ++r) { const int q = fphys(tid + 512 * r); buf[q] = buf[q] * scl; }
        __syncthreads();
        fft_fwd(buf);
        f32x2* K0 = (f32x2*)(kp->ws + OFF_R2) + (size_t)d * NFFT; f32x2* K1 = (f32x2*)kp->out + (size_t)d * NFFT;
        for (int r = 0; r < 32; ++r) { const int pos = tid + 512 * r, k = drev(pos), pos2 = drev((NFFT - k) & (NFFT - 1)); const f32x2 Z = buf[fphys(pos)], Z2 = buf[fphys(pos2)];
            K0[pos] = (f32x2){0.5f * (Z.x + Z2.x), 0.5f * (Z.y - Z2.y)}; K1[pos] = (f32x2){0.5f * (Z.y + Z2.y), -0.5f * (Z.x - Z2.x)}; }
    } else {
        const int idx = tid; float a0 = 0.f, a1 = 0.f;
        if (idx != CTX) { const int t = idx < CTX ? idx : 2 * CTX - idx, dir = idx < CTX ? 0 : 1; a0 = aux[256 + dir]; a1 = aux[258 + dir];
            for (int u4 = 0; u4 < 16; ++u4) { const f32x4 hv = *(const f32x4*)(h2 + (size_t)(SEQ + t) * 64 + u4 * 4);
#pragma unroll
                for (int e = 0; e < 4; ++e) { const int u = u4 * 4 + e; a0 += hv[e] * aux[dir * 64 + u]; a1 += hv[e] * aux[128 + dir * 64 + u]; } }
            const float tn = (float)t * (1.0f / 255.0f); a0 *= __expf(-tn * aux[260 + dir]); a1 *= __expf(-tn * aux[262 + dir]); }
        ss0 = a0 * a0; ss1 = a1 * a1;
        block_sum2(ss0, ss1, aux + 272);
        float* kc = (float*)(kp->ws + OFF_KCTX);
        kc[(size_t)d * 512 + idx] = a0 * rsqrtf(ss0 + 1e-12f); kc[(size_t)(1024 + d) * 512 + idx] = a1 * rsqrtf(ss1 + 1e-12f);
    }
}

__device__ __forceinline__ float ld3(const u16* row, int t, int n, float wa, float wb, float wc, float bias) {
    const float xm = t > 0 ? bf2f(row[t - 1]) : 0.f, x0 = bf2f(row[t]), xp = t < n - 1 ? bf2f(row[t + 1]) : 0.f; return wa * xm + wb * x0 + wc * xp + bias; }

__device__ __forceinline__ void ld3x8(const u16* row, int t0, float wa, float wb, float wc, float bias, float (&o)[8]) {
    const u32x4v w = *(const u32x4v*)(row + t0);
    const float x0 = bflo(w.x), x1 = bfhi(w.x), x2 = bflo(w.y), x3 = bfhi(w.y), x4 = bflo(w.z), x5 = bfhi(w.z), x6 = bflo(w.w), x7 = bfhi(w.w);
    const float xl = t0 > 0 ? bf2f(row[t0 - 1]) : 0.f, xr = t0 + 8 < SEQ ? bf2f(row[t0 + 8]) : 0.f;
    o[0] = wa * xl + wb * x0 + wc * x1 + bias; o[1] = wa * x0 + wb * x1 + wc * x2 + bias; o[2] = wa * x1 + wb * x2 + wc * x3 + bias; o[3] = wa * x2 + wb * x3 + wc * x4 + bias;
    o[4] = wa * x3 + wb * x4 + wc * x5 + bias; o[5] = wa * x4 + wb * x5 + wc * x6 + bias; o[6] = wa * x5 + wb * x6 + wc * x7 + bias; o[7] = wa * x6 + wb * x7 + wc * xr + bias;
}
__device__ __forceinline__ void hy_conv_lat(KPC kp, int j, int task, LAS f32x2* buf) {
    const int tid = ltid(), bp = task >> 10, c = task & 1023, b0 = bp * 2;
    const u16* pl = (const u16*)(kp->ws + OFF_R1 + HY_PL); u16* yl = (u16*)(kp->ws + OFF_R1 + HY_YL);
    const float* cw = kp->in[I_HYCW] + (size_t)j * 3 * 3072; const float* cb = kp->in[I_HYCB] + j * 3072;
    const float w1a = cw[c], w1b = cw[3072 + c], w1c = cw[6144 + c], bb1 = cb[c];
    const float w2a = cw[1024 + c], w2b = cw[3072 + 1024 + c], w2c = cw[6144 + 1024 + c], bb2 = cb[1024 + c];
    const float w3a = cw[2048 + c], w3b = cw[3072 + 2048 + c], w3c = cw[6144 + 2048 + c], bb3 = cb[2048 + c];
    const float sk0 = kp->in[I_HYSKIP][j * 2048 + c], sk1 = kp->in[I_HYSKIP][j * 2048 + 1024 + c];
    const u16* x1r0 = pl + ((size_t)b0 * 3072 + c) * SEQ; const u16* x1r1 = x1r0 + (size_t)3072 * SEQ;
    const u16* x2r0 = x1r0 + (size_t)1024 * SEQ; const u16* x2r1 = x1r1 + (size_t)1024 * SEQ;
    const u16* vr0 = x1r0 + (size_t)2048 * SEQ; const u16* vr1 = x1r1 + (size_t)2048 * SEQ;
    const f32x2* K0 = (const f32x2*)(kp->ws + OFF_R2) + (size_t)c * NFFT; const f32x2* K1 = (const f32x2*)kp->out + (size_t)c * NFFT;
    __syncthreads();
#pragma unroll
    for (int g = 0; g < 2; ++g) { const int t0 = 8 * (tid + 512 * g); float v0[8], v1[8];
        ld3x8(vr0, t0, w3a, w3b, w3c, bb3, v0); ld3x8(vr1, t0, w3a, w3b, w3c, bb3, v1);
#pragma unroll
        for (int e = 0; e < 8; ++e) { buf[fphys(t0 + e)] = (f32x2){v0[e], v1[e]}; buf[fphys(SEQ + t0 + e)] = (f32x2){0.f, 0.f}; } }
    __syncthreads();
#ifdef PROBE_FFT
    for (int rp = 0; rp < PROBE_FFT; ++rp) { fft_fwd(buf); fft_inv(buf); for (int r = 0; r < 32; ++r) { const int q = fphys(tid + 512 * r); buf[q] = buf[q] * (1.0f / NFFT); } __syncthreads(); }
#endif
    fft_fwd(buf);
#pragma unroll 8
    for (int r = 0; r < 32; ++r) { const int pos = tid + 512 * r, q = fphys(pos); buf[q] = cmul(buf[q], K0[pos]); }
    __syncthreads();
    fft_inv(buf);
    float zr[32];
#pragma unroll
    for (int g = 0; g < 2; ++g) { const int t0 = 8 * (tid + 512 * g); float v0[8], v1[8], xa[8], xb[8];
        ld3x8(vr0, t0, w3a, w3b, w3c, bb3, v0); ld3x8(vr1, t0, w3a, w3b, w3c, bb3, v1); ld3x8(x1r0, t0, w1a, w1b, w1c, bb1, xa); ld3x8(x1r1, t0, w1a, w1b, w1c, bb1, xb);
#pragma unroll
        for (int e = 0; e < 8; ++e) { const f32x2 y = buf[fphys(t0 + e)]; const float z0 = xa[e] * (y.x + sk0 * v0[e]), z1 = xb[e] * (y.y + sk0 * v1[e]);
            zr[g * 16 + 2 * e] = z0; zr[g * 16 + 2 * e + 1] = z1; buf[fphys(t0 + e)] = (f32x2){z0, z1}; buf[fphys(SEQ + t0 + e)] = (f32x2){0.f, 0.f}; } }
    __syncthreads();
    fft_fwd(buf);
#pragma unroll 8
    for (int r = 0; r < 32; ++r) { const int pos = tid + 512 * r, q = fphys(pos); buf[q] = cmul(buf[q], K1[pos]); }
    __syncthreads();
    fft_inv(buf);
#pragma unroll
    for (int g = 0; g < 2; ++g) { const int t0 = 8 * (tid + 512 * g); float xa[8], xb[8], o0[8], o1[8];
        ld3x8(x2r0, t0, w2a, w2b, w2c, bb2, xa); ld3x8(x2r1, t0, w2a, w2b, w2c, bb2, xb);
#pragma unroll
        for (int e = 0; e < 8; ++e) { const f32x2 y = buf[fphys(t0 + e)]; o0[e] = xa[e] * (y.x + sk1 * zr[g * 16 + 2 * e]); o1[e] = xb[e] * (y.y + sk1 * zr[g * 16 + 2 * e + 1]); }
        *(u32x4v*)(yl + ((size_t)b0 * D + c) * SEQ + t0) = pack8(o0); *(u32x4v*)(yl + ((size_t)(b0 + 1) * D + c) * SEQ + t0) = pack8(o1); }
}

__device__ __forceinline__ void hy_conv_ctx(KPC kp, int j, int c, LAS float* ls) {
    const int tid = ltid();
    const u16* pc = (const u16*)(kp->ws + OFF_R1 + HY_PC); u16* yc = (u16*)(kp->ws + OFF_R1 + HY_YC); const float* kc = (const float*)(kp->ws + OFF_KCTX);
    const float* cw = kp->in[I_HYCW] + (size_t)j * 3 * 3072; const float* cb = kp->in[I_HYCB] + j * 3072;
    const float w1a = cw[c], w1b = cw[3072 + c], w1c = cw[6144 + c], bb1 = cb[c];
    const float w2a = cw[1024 + c], w2b = cw[3072 + 1024 + c], w2c = cw[6144 + 1024 + c], bb2 = cb[1024 + c];
    const float w3a = cw[2048 + c], w3b = cw[3072 + 2048 + c], w3c = cw[6144 + 2048 + c], bb3 = cb[2048 + c];
    const float sk0 = kp->in[I_HYSKIP][j * 2048 + c], sk1 = kp->in[I_HYSKIP][j * 2048 + 1024 + c];
    __syncthreads();
    ls[tid] = kc[(size_t)c * 512 + tid]; ls[512 + tid] = kc[(size_t)(1024 + c) * 512 + tid];
    for (int i = 0; i < 2; ++i) { const int e = tid + 512 * i, b = e >> 8, t = e & 255; ls[1024 + e] = ld3(pc + ((size_t)b * 3072 + 2048 + c) * CTX, t, CTX, w3a, w3b, w3c, bb3); }
    __syncthreads();
    float zr[2];
    for (int i = 0; i < 2; ++i) { const int e = tid + 512 * i, b = e >> 8, t = e & 255; float a = 0.f;
        for (int s = 0; s < CTX; ++s) a += ls[(t - s) & 511] * ls[1024 + b * 256 + s];
        zr[i] = ld3(pc + ((size_t)b * 3072 + c) * CTX, t, CTX, w1a, w1b, w1c, bb1) * (a + sk0 * ls[1024 + e]); ls[2048 + e] = zr[i]; }
    __syncthreads();
    for (int i = 0; i < 2; ++i) { const int e = tid + 512 * i, b = e >> 8, t = e & 255; float a = 0.f;
        for (int s = 0; s < CTX; ++s) a += ls[512 + ((t - s) & 511)] * ls[2048 + b * 256 + s];
        yc[((size_t)b * D + c) * CTX + t] = f2bf(ld3(pc + ((size_t)b * 3072 + 1024 + c) * CTX, t, CTX, w2a, w2b, w2c, bb2) * (a + sk1 * zr[i])); }
}

__device__ __forceinline__ void hy_transpose(KPC kp, LAS u16* tl) {
    const u16* yl = (const u16*)(kp->ws + OFF_R1 + HY_YL); const u16* yc = (const u16*)(kp->ws + OFF_R1 + HY_YC); u16* y = (u16*)(kp->ws + OFF_U); const int tid = ltid();
    for (int tile = lbid(); tile < NB * 16 * NCH; tile += gridDim.x) {
        const int b = tile / (16 * NCH), rem = tile - b * 16 * NCH, ct = rem / NCH, tt = rem - ct * NCH;
        const u16* src = tt < 4 ? yc + ((size_t)b * D + ct * 64) * CTX + tt * 64 : yl + ((size_t)b * D + ct * 64) * SEQ + (tt - 4) * 64; const int ld = tt < 4 ? CTX : SEQ;
        { const int cr = tid >> 3, t8 = (tid & 7) * 8; *(LAS u32x4v*)(tl + cr * 72 + t8) = *(const u32x4v*)(src + (size_t)cr * ld + t8); }
        __syncthreads();
        { const int tr = tid >> 3, c8 = (tid & 7) * 8; u32x4v w;
          w.x = (unsigned)tl[(c8 + 0) * 72 + tr] | ((unsigned)tl[(c8 + 1) * 72 + tr] << 16); w.y = (unsigned)tl[(c8 + 2) * 72 + tr] | ((unsigned)tl[(c8 + 3) * 72 + tr] << 16);
          w.z = (unsigned)tl[(c8 + 4) * 72 + tr] | ((unsigned)tl[(c8 + 5) * 72 + tr] << 16); w.w = (unsigned)tl[(c8 + 6) * 72 + tr] | ((unsigned)tl[(c8 + 7) * 72 + tr] << 16);
          *(u32x4v*)(y + ((size_t)b * TPB + tt * 64 + tr) * D + ct * 64 + c8) = w; }
        __syncthreads();
    }
}

constexpr size_t OFF_XM = OFF_R1, OFF_XC = OFF_R1 + 132 * MiB, OFF_S = WS_NEED, OFF_MLM = OFF_S + 34 * MiB, WS_NEED2 = OFF_MLM + 1 * MiB;
__device__ __forceinline__ u16* hb_ptr(KPC kp, int T) { const int b = T / TPB, t = T - b * TPB;
    return t < CTX ? (u16*)(kp->ws + OFF_HBC) + ((size_t)b * CTX + t) * INNER : (u16*)kp->out + ((size_t)b * SEQ + (t - CTX)) * INNER; }
__device__ __forceinline__ void bd8(const float (&x)[8], const float (&w)[32], float (&y)[8]) {
#pragma unroll
    for (int bl = 0; bl < 2; ++bl)
#pragma unroll
        for (int e = 0; e < 4; ++e) { float s = 0.f;
#pragma unroll
            for (int d = 0; d < 4; ++d) s += x[bl * 4 + d] * w[bl * 16 + d * 4 + e];
            y[bl * 4 + e] = s; }
}
__device__ __forceinline__ void ldw32(const float* p, float (&w)[32]) {
#pragma unroll
    for (int i = 0; i < 8; ++i) { const f32x4 v = *(const f32x4*)(p + i * 4); w[i * 4] = v[0]; w[i * 4 + 1] = v[1]; w[i * 4 + 2] = v[2]; w[i * 4 + 3] = v[3]; } }

__device__ __forceinline__ void ml_m_phase(KPC kp, int j) {
    float* M = (float*)(kp->ws + OFF_MLM); const float* wq = kp->in[I_MLWQ] + (size_t)j * 512 * 16; const float* wk = kp->in[I_MLWK] + (size_t)j * 512 * 16;
    for (int i = lbid() * 512 + ltid(); i < 512 * 16; i += gridDim.x * 512) { const int blk = i >> 4, d = (i >> 2) & 3, d2 = i & 3; float s = 0.f;
#pragma unroll
        for (int e = 0; e < 4; ++e) s += wq[blk * 16 + d * 4 + e] * wk[blk * 16 + d2 * 4 + e];
        M[i] = s * 0.04419417382415922f; }
}

__device__ __forceinline__ void ml_prep_task(KPC kp, int j, int task, LAS unsigned char* lds) {
    const int tid = ltid(), lane = tid & 63, wv = tid >> 6, fr = lane & 15, fq = lane >> 4;
    const int hd = task & 3, bc = task >> 2, b = bc / NCH, ci = bc - b * NCH;
    const u16* xm = (const u16*)(kp->ws + OFF_XM); u16* xc = (u16*)(kp->ws + OFF_XC);
    const int T0 = b * TPB + ci * 64, tlo = b * TPB + (ci < 4 ? 0 : CTX), thi = b * TPB + (ci < 4 ? CTX - 1 : TPB - 1);
    const int ch0 = hd * DH + lane * 8;
    LAS u16* QS = (LAS u16*)lds; LAS u16* KS = (LAS u16*)(lds + 66560);
    const float* cw = kp->in[I_MLCW] + (size_t)j * 3 * INNER; const float* cb = kp->in[I_MLCB] + (size_t)j * INNER;
    __syncthreads();
    {
        float cwa[8], cwb[8], cwc[8], cbb[8], wq[32], wk[32];
#pragma unroll
        for (int e = 0; e < 8; ++e) { cwa[e] = cw[ch0 + e]; cwb[e] = cw[INNER + ch0 + e]; cwc[e] = cw[2 * INNER + ch0 + e]; cbb[e] = cb[ch0 + e]; }
        ldw32(kp->in[I_MLWQ] + ((size_t)j * 512 + (ch0 >> 2)) * 16, wq); ldw32(kp->in[I_MLWK] + ((size_t)j * 512 + (ch0 >> 2)) * 16, wk);
        for (int r = 0; r < 8; ++r) { const int jj = wv + 8 * r, T = T0 + jj; const u16* p = xm + (size_t)T * INNER + ch0;
            float x0[8], xa[8], xb[8], xcv[8], q[8], k[8];
            unpack8(*(const u32x4v*)p, x0);
            if (T > tlo) unpack8(*(const u32x4v*)(p - INNER), xa); else {
#pragma unroll
                for (int e = 0; e < 8; ++e) xa[e] = 0.f; }
            if (T < thi) unpack8(*(const u32x4v*)(p + INNER), xb); else {
#pragma unroll
                for (int e = 0; e < 8; ++e) xb[e] = 0.f; }
#pragma unroll
            for (int e = 0; e < 8; ++e) xcv[e] = siluf(cwa[e] * xa[e] + cwb[e] * x0[e] + cwc[e] * xb[e] + cbb[e]);
            const u32x4v xw = pack8(xcv); *(u32x4v*)(xc + (size_t)T * INNER + ch0) = xw; unpack8(xw, xcv);
            bd8(xcv, wq, q); bd8(xcv, wk, k);
            *(LAS u32x4v*)(QS + jj * 520 + lane * 8) = pack8(q); *(LAS u32x4v*)(KS + jj * 520 + lane * 8) = pack8(k); }
    }
    __syncthreads();
    const u16* wg = (const u16*)(kp->ws + OFF_WB + WB_WGT);
    const int mt = wv & 3, kh = wv >> 2;
    { f32x4 s0 = {0.f, 0.f, 0.f, 0.f}, s1 = {0.f, 0.f, 0.f, 0.f}; const int nt0 = kh * 2;
      for (int ks = 0; ks < 16; ++ks) { const bf16x8 a = *(const LAS bf16x8*)(QS + (16 * mt + fr) * 520 + 32 * ks + 8 * fq);
          const bf16x8 b0 = *(const LAS bf16x8*)(KS + (16 * nt0 + fr) * 520 + 32 * ks + 8 * fq), b1 = *(const LAS bf16x8*)(KS + (16 * (nt0 + 1) + fr) * 520 + 32 * ks + 8 * fq);
          s0 = __builtin_amdgcn_mfma_f32_16x16x32_bf16(a, b0, s0, 0, 0, 0); s1 = __builtin_amdgcn_mfma_f32_16x16x32_bf16(a, b1, s1, 0, 0, 0); }
      float* S = (float*)(kp->ws + OFF_S) + ((size_t)(b * 4 + hd) * NCH + ci) * 4096;
#pragma unroll
      for (int r = 0; r < 4; ++r) { S[(16 * mt + 4 * fq + r) * 64 + 16 * nt0 + fr] = s0[r]; S[(16 * mt + 4 * fq + r) * 64 + 16 * (nt0 + 1) + fr] = s1[r]; } }
    f32x4 ga = {0.f, 0.f, 0.f, 0.f};
    for (int ks = kh * 8; ks < kh * 8 + 8; ++ks) { const int kk = hd * DH + 32 * ks + 8 * fq;
        const bf16x8 a = *(const LAS bf16x8*)(QS + (16 * mt + fr) * 520 + 32 * ks + 8 * fq), a2 = *(const LAS bf16x8*)(KS + (16 * mt + fr) * 520 + 32 * ks + 8 * fq);
        const bf16x8 bq = *(const bf16x8*)(wg + (size_t)fr * 6144 + kk), bk = *(const bf16x8*)(wg + (size_t)fr * 6144 + INNER + kk);
        ga = __builtin_amdgcn_mfma_f32_16x16x32_bf16(a, bq, ga, 0, 0, 0); ga = __builtin_amdgcn_mfma_f32_16x16x32_bf16(a2, bk, ga, 0, 0, 0); }
    __syncthreads();
    {
        float wvv[32]; ldw32(kp->in[I_MLWV] + ((size_t)j * 512 + (ch0 >> 2)) * 16, wvv);
        for (int r = 0; r < 8; ++r) { const int jj = wv + 8 * r, T = T0 + jj; float x0[8], v[8]; unpack8(*(const u32x4v*)(xm + (size_t)T * INNER + ch0), x0); bd8(x0, wvv, v);
            *(LAS u32x4v*)(QS + jj * 520 + lane * 8) = pack8(v); }
    }
    __syncthreads();
    for (int ks = kh * 8; ks < kh * 8 + 8; ++ks) { const int kk = hd * DH + 32 * ks + 8 * fq;
        const bf16x8 a = *(const LAS bf16x8*)(QS + (16 * mt + fr) * 520 + 32 * ks + 8 * fq); const bf16x8 bv = *(const bf16x8*)(wg + (size_t)fr * 6144 + 2 * INNER + kk);
        ga = __builtin_amdgcn_mfma_f32_16x16x32_bf16(a, bv, ga, 0, 0, 0); }
    float* gates = (float*)(kp->ws + OFF_GATES);
#pragma unroll
    for (int r = 0; r < 4; ++r) atomicAdd(gates + (size_t)(T0 + 16 * mt + 4 * fq + r) * 16 + fr, ga[r]);
}

__device__ __forceinline__ void tr_store8(LAS unsigned char* base, int d0, const unsigned (&w)[4], int lane) {
    const int odd = lane & 1, sp = lane & ~1;
#pragma unroll
    for (int i = 0; i < 4; ++i) { const unsigned pw = (unsigned)__builtin_amdgcn_update_dpp(0, (int)w[i], 0xB1, 0xF, 0xF, false);
        const unsigned ow = odd ? ((pw >> 16) | (w[i] & 0xffff0000u)) : ((w[i] & 0xffffu) | (pw << 16)); const int d = d0 + 2 * i + odd;
        *(LAS unsigned*)(base + d * 128 + ((((sp >> 3) ^ (d & 7)) << 4) | ((sp & 7) << 1))) = ow; }
}
#ifndef REP_STAGE
#define REP_STAGE 1
#define REP_STILDE 1
#define REP_MFMA 1
#endif
constexpr int SC_QS = 0, SC_KT = 66560, SC_VT = 132096, SC_ST = 148480, SC_VEC = 156672;
__device__ __forceinline__ void ml_scan_task(KPC kp, int j, int task, LAS unsigned char* lds) {
    const int tid = ltid(), lane = tid & 63, wv = tid >> 6, fr = lane & 15, fq = lane >> 4;
    const int es = task & 3, dir = (task >> 2) & 1, hd = (task >> 3) & 3, b = task >> 5;
    const u16* xm = (const u16*)(kp->ws + OFF_XM); const u16* xc = (const u16*)(kp->ws + OFF_XC); const float* gates = (const float*)(kp->ws + OFF_GATES);
    const float* Sg = (const float*)(kp->ws + OFF_S) + (size_t)(b * 4 + hd) * NCH * 4096;
    u16* hf = (u16*)(kp->ws + OFF_R2);
    LAS unsigned char* QS = lds + SC_QS; LAS unsigned char* KT = lds + SC_KT; LAS unsigned char* VT = lds + SC_VT; LAS unsigned char* ST = lds + SC_ST;
    LAS float* rowterm = (LAS float*)(lds + SC_VEC); LAS float* colterm = rowterm + 64; LAS float* winter = rowterm + 128; LAS float* einv = rowterm + 192;
    LAS float* kws = rowterm + 256; LAS float* dinv = rowterm + 320; LAS float* nst = rowterm + 384; LAS float* scal = rowterm + 896;
    f32x4 C[32];
#pragma unroll
    for (int i = 0; i < 32; ++i) C[i] = (f32x4){0.f, 0.f, 0.f, 0.f};
    float m_st = 0.f;
    __syncthreads();
    nst[tid] = 0.f;
    for (int ci = 0; ci < NCH; ++ci) {
        __syncthreads();
        const int p0 = ci * 64;
        const int tid = ltid(), lane = tid & 63, wv = tid >> 6, fr = lane & 15, fq = lane >> 4;
        asm volatile("" ::: "memory");
        auto tok = [&](int jj) -> int { const int p = p0 + jj; const int t = dir == 0 ? p : (p < CTX ? CTX - 1 - p : TPB + CTX - 1 - p); return b * TPB + t; };
        float sv[8];
        { const int jj = tid >> 3, s8 = (tid & 7) * 8;
            if (dir == 0) { const float* sp = Sg + (size_t)ci * 4096 + jj * 64 + s8; const f32x4 v0 = *(const f32x4*)sp, v1 = *(const f32x4*)(sp + 4);
                sv[0] = v0[0]; sv[1] = v0[1]; sv[2] = v0[2]; sv[3] = v0[3]; sv[4] = v1[0]; sv[5] = v1[1]; sv[6] = v1[2]; sv[7] = v1[3]; }
            else { const int oc = ci < 4 ? 3 - ci : 135 - ci; const float* sp = Sg + (size_t)oc * 4096 + (63 - jj) * 64 + (56 - s8); const f32x4 v0 = *(const f32x4*)sp, v1 = *(const f32x4*)(sp + 4);
                sv[7] = v0[0]; sv[6] = v0[1]; sv[5] = v0[2]; sv[4] = v0[3]; sv[3] = v1[0]; sv[2] = v1[1]; sv[1] = v1[2]; sv[0] = v1[3]; }
        }
        float g_ic = 0.f, g_fp = 0.f;
        if (wv == 0) { const int Tg = tok(lane); g_ic = gates[(size_t)Tg * 16 + dir * 8 + hd]; g_fp = gates[(size_t)Tg * 16 + dir * 8 + 4 + hd]; }
        for (int rpS = 0; rpS < REP_STAGE; ++rpS) {
        const int wvu = __builtin_amdgcn_readfirstlane(wv); const int Tl = tok(lane);
        for (int r = 0; r < 8; ++r) { const int g8 = wvu * 8 + r; float x[8], q[8], Mw[32];
            const u32x4v xw = *(const u32x4v*)(xc + (size_t)Tl * INNER + hd * DH + g8 * 8); unpack8(xw, x);
            ldw32((const float*)(kp->ws + OFF_MLM) + (size_t)(hd * 128 + g8 * 2) * 16, Mw); bd8(x, Mw, q);
            *(LAS u32x4v*)(QS + lane * 1040 + g8 * 16) = pack8(q);
            const unsigned wd[4] = {xw.x, xw.y, xw.z, xw.w}; tr_store8(KT, g8 * 8, wd, lane); }
        for (int r = 0; r < 2; ++r) { const int g = wvu * 2 + r; const int chv = hd * DH + es * 128 + g * 8; float x[8], v[8], wvv[32];
            unpack8(*(const u32x4v*)(xm + (size_t)Tl * INNER + chv), x); ldw32(kp->in[I_MLWV] + ((size_t)j * 512 + (chv >> 2)) * 16, wvv); bd8(x, wvv, v);
            { const u32x4v vw = pack8(v); const unsigned wd[4] = {vw.x, vw.y, vw.z, vw.w}; tr_store8(VT, g * 8, wd, lane); } }
        }
        if (wv == 0) {
            const float ic = g_ic, fp = g_fp;
            const float lf = fminf(fp, 0.f) - log1pf(__expf(-fabsf(fp)));
            float bb = lf;
#pragma unroll
            for (int o = 1; o < 64; o <<= 1) { const float t = lshfl(bb, lane - o); if (lane >= o) bb += t; }
            const float uu = ic - bb; float pm = uu;
#pragma unroll
            for (int o = 1; o < 64; o <<= 1) { const float t = lshfl(pm, lane - o); if (lane >= o) pm = fmaxf(pm, t); }
            const float a = bb + m_st, mj = fmaxf(a, bb + pm);
            rowterm[lane] = bb - mj; colterm[lane] = uu; winter[lane] = __expf(a - mj); einv[lane] = __expf(-mj);
            const float blast = lshfl(bb, 63), gs = blast - bb + ic, gmax = wave_max(gs), mnew = fmaxf(blast + m_st, gmax);
            kws[lane] = __expf(gs - mnew);
            if (lane == 0) { scal[0] = __expf(blast + m_st - mnew); scal[1] = mnew; }
        }
        __syncthreads();
        for (int rpT = 0; rpT < REP_STILDE; ++rpT) {
            const int jj = tid >> 3, sub = tid & 7, s8 = sub * 8;
            const float rt = rowterm[jj]; float rsum = 0.f;
#pragma unroll
            for (int e = 0; e < 8; ++e) { const int s = s8 + e; const float w = s <= jj ? sv[e] * 0.04419417382415922f * __expf(rt + colterm[s]) : 0.f; sv[e] = w; rsum += w; }
            *(LAS u32x4v*)(ST + jj * 128 + ((sub ^ (jj & 7)) << 4)) = pack8(sv);
            float qd = 0.f;
#pragma unroll
            for (int c8 = 0; c8 < 8; ++c8) { float qv[8]; unpack8(*(const LAS u32x4v*)(QS + jj * 1040 + (sub * 8 + c8) * 16), qv);
                { const f32x4 n0 = *(const LAS f32x4*)(nst + sub * 64 + c8 * 8), n1 = *(const LAS f32x4*)(nst + sub * 64 + c8 * 8 + 4);
                  qd += qv[0] * n0[0] + qv[1] * n0[1] + qv[2] * n0[2] + qv[3] * n0[3] + qv[4] * n1[0] + qv[5] * n1[1] + qv[6] * n1[2] + qv[7] * n1[3]; } }
            rsum += lshfl(rsum, lane ^ 1); rsum += lshfl(rsum, lane ^ 2); rsum += lshfl(rsum, lane ^ 4);
            qd += lshfl(qd, lane ^ 1); qd += lshfl(qd, lane ^ 2); qd += lshfl(qd, lane ^ 4);
            if (sub == 0) { const float qn = winter[jj] * qd + rsum; dinv[jj] = 1.0f / fmaxf(fabsf(qn), einv[jj]); }
        }
        __syncthreads();
        {
            f32x4 o[4];
            const int el = 16 * wv + fr;
            bf16x8 vfr[2];
            for (int rpM = 0; rpM < REP_MFMA; ++rpM) {
#pragma unroll
            for (int mt = 0; mt < 4; ++mt) o[mt] = (f32x4){0.f, 0.f, 0.f, 0.f};
#pragma unroll
            for (int ks = 0; ks < 16; ++ks) {
                u32x4v bw; bw.x = pg8::cvt_pk_bf16(C[2 * ks][0], C[2 * ks][1]); bw.y = pg8::cvt_pk_bf16(C[2 * ks][2], C[2 * ks][3]);
                bw.z = pg8::cvt_pk_bf16(C[2 * ks + 1][0], C[2 * ks + 1][1]); bw.w = pg8::cvt_pk_bf16(C[2 * ks + 1][2], C[2 * ks + 1][3]);
                const bf16x8 bfr = __builtin_bit_cast(bf16x8, bw);
#pragma unroll
                for (int mt = 0; mt < 4; ++mt) { const int off = (16 * mt + fr) * 1040 + 8 * fq;
                    const u32x2 lo = *(const LAS u32x2*)(QS + off + 64 * ks), hi = *(const LAS u32x2*)(QS + off + 64 * ks + 32);
                    u32x4v aw; aw.x = lo.x; aw.y = lo.y; aw.z = hi.x; aw.w = hi.y;
                    o[mt] = __builtin_amdgcn_mfma_f32_16x16x32_bf16(bfr, __builtin_bit_cast(bf16x8, aw), o[mt], 0, 0, 0); }
                if ((ks & 1) == 1) __builtin_amdgcn_sched_barrier(0); }
#pragma unroll
            for (int mt = 0; mt < 4; ++mt)
#pragma unroll
                for (int r = 0; r < 4; ++r) o[mt][r] *= winter[16 * mt + fr];
#pragma unroll
            for (int k2 = 0; k2 < 2; ++k2) { vfr[k2] = *(const LAS bf16x8*)(VT + el * 128 + (((4 * k2 + fq) ^ (el & 7)) << 4));
#pragma unroll
                for (int mt = 0; mt < 4; ++mt) { const int jr = 16 * mt + fr; const bf16x8 a = *(const LAS bf16x8*)(ST + jr * 128 + (((4 * k2 + fq) ^ (jr & 7)) << 4));
                    o[mt] = __builtin_amdgcn_mfma_f32_16x16x32_bf16(vfr[k2], a, o[mt], 0, 0, 0); } }
            }
#pragma unroll
            for (int mt = 0; mt < 4; ++mt)
                { const int jr = 16 * mt + fr, T = tok(jr); const float di = dinv[jr];
                    u16* dst = dir == 0 ? hf + (size_t)T * INNER : hb_ptr(kp, T); u32x2 w; w.x = pg8::cvt_pk_bf16(o[mt][0] * di, o[mt][1] * di); w.y = pg8::cvt_pk_bf16(o[mt][2] * di, o[mt][3] * di);
                    *(u32x2*)(dst + hd * DH + es * 128 + 16 * wv + 4 * fq) = w; }
            const float decay = scal[0];
#pragma unroll
            for (int i = 0; i < 32; ++i) C[i] = C[i] * decay;
#pragma unroll
            for (int k2 = 0; k2 < 2; ++k2) { float vv[8]; unpack8(__builtin_bit_cast(u32x4v, vfr[k2]), vv);
#pragma unroll
                for (int e = 0; e < 8; ++e) vv[e] *= kws[32 * k2 + 8 * fq + e];
                const bf16x8 bsc = __builtin_bit_cast(bf16x8, pack8(vv));
#pragma unroll
                for (int dt = 0; dt < 32; ++dt) { const int dr = 16 * dt + fr; const bf16x8 a = *(const LAS bf16x8*)(KT + dr * 128 + (((4 * k2 + fq) ^ (dr & 7)) << 4));
                    C[dt] = __builtin_amdgcn_mfma_f32_16x16x32_bf16(a, bsc, C[dt], 0, 0, 0);
                    if ((dt & 7) == 7) __builtin_amdgcn_sched_barrier(0); } }
            { float nn = decay * nst[tid];
#pragma unroll
              for (int g = 0; g < 8; ++g) { float kv[8]; unpack8(*(const LAS u32x4v*)(KT + tid * 128 + ((g ^ (tid & 7)) << 4)), kv);
#pragma unroll
                  for (int e = 0; e < 8; ++e) nn += kv[e] * kws[8 * g + e]; }
              nst[tid] = nn; }
            m_st = scal[1];
        }
    }
}

__device__ __forceinline__ void ml_gate_phase(KPC kp, int j) {
    u16* hf = (u16*)(kp->ws + OFF_R2); const u16* xc = (const u16*)(kp->ws + OFF_XC); const u16* z = (const u16*)(kp->ws + OFF_XM);
    const float* ng = kp->in[I_MLNG] + (size_t)j * INNER; const float* sk = kp->in[I_MLSKIP] + (size_t)j * INNER;
    const int lane = ltid() & 63, wv = ltid() >> 6;
    for (int T = lbid() * 8 + wv; T < NTOK; T += gridDim.x * 8) {
        const u16* hbp = hb_ptr(kp, T);
#pragma unroll
        for (int hd = 0; hd < 4; ++hd) { const int c0 = hd * DH + lane * 8; float a[8], bq[8], xv[8], zv[8], o[8];
            unpack8(*(const u32x4v*)(hf + (size_t)T * INNER + c0), a); unpack8(*(const u32x4v*)(hbp + c0), bq);
            float s = 0.f;
#pragma unroll
            for (int e = 0; e < 8; ++e) { a[e] += bq[e]; s += a[e]; }
            const float mu = wave_sum(s) * (1.0f / DH); float vs = 0.f;
#pragma unroll
            for (int e = 0; e < 8; ++e) { a[e] -= mu; vs += a[e] * a[e]; }
            const float rs = rsqrtf(wave_sum(vs) * (1.0f / DH) + 1e-5f);
            unpack8(*(const u32x4v*)(xc + (size_t)T * INNER + c0), xv); unpack8(*(const u32x4v*)(z + (size_t)T * INNER + c0), zv);
#pragma unroll
            for (int e = 0; e < 8; ++e) o[e] = (a[e] * rs * ng[c0 + e] + sk[c0 + e] * xv[e]) * siluf(zv[e]);
            *(u32x4v*)(hf + (size_t)T * INNER + c0) = pack8(o); }
    }
}


enum { K_SETUP = 0, K_CN, K_G1, K_G2R, K_HYIN, K_HYCONV, K_HYTR, K_MLUPX, K_MLPREP, K_MLSCAN, K_MLUPZ, K_MLGATE, K_FINAL };
constexpr int NPHASE = 1 + 11 + 13 + 11 + 13 + 1;
__device__ __forceinline__ void decode_phase(int ph, int& kind, int& l, int& arg) {
    kind = K_SETUP; l = 0; arg = 0; if (ph == 0) return;
    ph -= 1;
    for (l = 0; l < 4; ++l) { const int n = (l & 1) ? 13 : 11; if (ph < n) break; ph -= n; }
    if (l == 4) { kind = K_FINAL; l = 0; return; }
    if (ph == 0) { kind = K_CN; arg = 0; return; } if (ph == 1) { kind = K_G1; arg = 0; return; } if (ph == 2) { kind = K_G2R; arg = 0; return; } if (ph == 3) { kind = K_CN; arg = 1; return; }
    const int nm = (l & 1) ? 6 : 4;
    if (ph < 4 + nm) { const int q = ph - 4;
        if (l & 1) { kind = q == 0 ? K_MLUPX : q == 1 ? K_MLPREP : q == 2 ? K_MLSCAN : q == 3 ? K_MLUPZ : q == 4 ? K_MLGATE : K_G2R; arg = 2; }
        else { kind = q == 0 ? K_HYIN : q == 1 ? K_HYCONV : q == 2 ? K_HYTR : K_G2R; arg = 2; }
        return; }
    ph -= 4 + nm;
    if (ph == 0) { kind = K_CN; arg = 2; return; } if (ph == 1) { kind = K_G1; arg = 1; return; } kind = K_G2R; arg = 1;
}

__device__ __forceinline__ void gbar(unsigned* ctr, unsigned target) {
    __syncthreads();
    if (ltid() == 0) {
        __builtin_amdgcn_fence(__ATOMIC_RELEASE, "agent");
        __hip_atomic_fetch_add(ctr, 1u, __ATOMIC_RELAXED, __HIP_MEMORY_SCOPE_AGENT);
        while (__hip_atomic_load(ctr, __ATOMIC_RELAXED, __HIP_MEMORY_SCOPE_AGENT) < target) __builtin_amdgcn_s_sleep(2);
        __builtin_amdgcn_fence(__ATOMIC_ACQUIRE, "agent");
    }
    __syncthreads();
}
#ifndef REPMASK
#define REPMASK 0
#define REPN 1
#endif
template <int MIX> __device__ __forceinline__ void run_phases(int lo, int hi, int ph_lo, int ph_hi, LAS unsigned char* lds0, cg::grid_group& grid) {
    lo = lo > ph_lo ? lo : ph_lo; hi = hi < ph_hi ? hi : ph_hi;
    for (int ph = lo; ph < hi; ++ph) {
        KPC kp = (KPC)__builtin_amdgcn_kernarg_segment_ptr(); asm volatile("" : "+s"(kp) :: "memory");
        LAS unsigned char* lds = lds0; asm volatile("" : "+s"(lds) :: "memory");
        unsigned char* ws = kp->ws; unsigned char* wb = ws + OFF_WB;
        int kind, l, arg; decode_phase(ph, kind, l, arg); const int j = l >> 1;
        const float* modl = (const float*)(ws + OFF_MOD) + (size_t)l * 5 * 9216;
        const int nrep = ((REPMASK >> kind) & 1) ? REPN : 1;
        for (int rep = 0; rep < nrep; ++rep) {
        if (kind == K_SETUP) { if constexpr (MIX == 0) setup_phase(kp, (LAS float*)lds); }
        else if (kind == K_CN) {
            if (arg == 0) { convert_layer(kp, l, (LAS float*)lds); if constexpr (MIX == 1) ml_m_phase(kp, j); }
            if constexpr (MIX == 0) { if (arg == 1) hy_mlp_phase(kp, j); }
            norm_phase(kp, l, arg);
        } else if (kind == K_G1) {
            pg8::Gemm g{(const u16*)(ws + OFF_U), (const u16*)(wb + (arg ? WB_FIN1 : WB_FIN0)), NTOK, 2 * FF, D};
            pg8::StaticOrder S; S.init(g.M, g.N, (int)gridDim.x, lbid(), (l == 3 && arg == 1) ? 1 : 0); EpiSwiglu E{(u16*)(ws + OFF_R1)};
            pg8::gemm_phase<EpiSwiglu, pg8::StaticOrder, false>(lds, g, S, E, nullptr);
        } else if (kind == K_G2R) {
            pg8::Gemm g; EpiResid E; E.h = (float*)(ws + OFF_H); E.modl = modl;
            if (arg < 2) { g = pg8::Gemm{(const u16*)(ws + OFF_R1), (const u16*)(wb + (arg ? WB_FOUT1 : WB_FOUT0)), NTOK, D, FF}; E.gidx = arg ? 8 : 2; E.scale = 0.5f; E.bias = nullptr; }
            else if (MIX == 1) { g = pg8::Gemm{(const u16*)(ws + OFF_R2), (const u16*)(wb + WB_MOUT), NTOK, D, INNER}; E.gidx = 5; E.scale = 1.0f; E.bias = nullptr; }
            else { g = pg8::Gemm{(const u16*)(ws + OFF_U), (const u16*)(wb + WB_MOUT), NTOK, D, D}; E.gidx = 5; E.scale = 1.0f; E.bias = kp->in[I_HYBOUT] + (size_t)j * D; }
            pg8::StaticOrder S; S.init(g.M, g.N, (int)gridDim.x, lbid(), (l == 3 && arg >= 1) ? 1 : 0);
            pg8::gemm_phase<EpiResid, pg8::StaticOrder, false>(lds, g, S, E, nullptr);
        } else if (kind == K_FINAL) { if constexpr (MIX == 1) final_phase(kp); }
        else if constexpr (MIX == 0) {
            if (kind == K_HYIN) {
                pg8::Gemm g{(const u16*)(wb + WB_MIN), (const u16*)(ws + OFF_U), 3 * D, NTOK, D};
                pg8::StaticOrder S; S.init(g.M, g.N, (int)gridDim.x, lbid());
                EpiProjT E{(u16*)(ws + OFF_R1 + HY_PL), (u16*)(ws + OFF_R1 + HY_PC), kp->in[I_HYBIN] + (size_t)j * 3 * D};
                pg8::gemm_phase<EpiProjT, pg8::StaticOrder, false>(lds, g, S, E, nullptr);
                __syncthreads();
                for (int t = lbid(); t < 2048; t += gridDim.x) hy_filter_task(kp, j, t, (LAS f32x2*)lds, (LAS float*)(lds + 131072));
            } else if (kind == K_HYCONV) {
                for (int t = lbid(); t < 2048; t += gridDim.x) hy_conv_lat(kp, j, t, (LAS f32x2*)lds);
                for (int t = lbid(); t < 1024; t += gridDim.x) hy_conv_ctx(kp, j, t, (LAS float*)lds);
            } else if (kind == K_HYTR) hy_transpose(kp, (LAS u16*)lds);
        } else {
            if (kind == K_MLUPX || kind == K_MLUPZ) {
                const bool zz = kind == K_MLUPZ;
                pg8::Gemm g{(const u16*)(ws + OFF_U), (const u16*)(wb + WB_MIN) + (zz ? (size_t)INNER * D : 0), NTOK, INNER, D};
                pg8::StaticOrder S; S.init(g.M, g.N, (int)gridDim.x, lbid()); EpiBf E{(u16*)(ws + OFF_XM), INNER};
                pg8::gemm_phase<EpiBf, pg8::StaticOrder, false>(lds, g, S, E, nullptr);
            } else if (kind == K_MLPREP) { for (int t = lbid(); t < NB * NCH * 4; t += gridDim.x) ml_prep_task(kp, j, t, lds); }
            else if (kind == K_MLSCAN) { for (int t = lbid(); t < 128; t += gridDim.x) ml_scan_task(kp, j, t, lds); }
            else if (kind == K_MLGATE) ml_gate_phase(kp, j);
        }
        }
        if (ph + 1 < ph_hi) gbar((unsigned*)(kp->ws + OFF_MLM + 65536), (unsigned)(ph + 1 - ph_lo) * gridDim.x);
    }
}

__global__ void __launch_bounds__(512) fwd_megakernel(KP kparg) {
    extern __shared__ __attribute__((aligned(16))) unsigned char shm[];
    LAS unsigned char* lds = (LAS unsigned char*)shm;
    cg::grid_group grid = cg::this_grid();
    grid.sync();
    wtab_init();
    const int ph_lo = kparg.ph_lo, ph_hi = kparg.ph_hi;
    run_phases<0>(0, 12, ph_lo, ph_hi, lds, grid);
    run_phases<1>(12, 25, ph_lo, ph_hi, lds, grid);
    run_phases<0>(25, 36, ph_lo, ph_hi, lds, grid);
    run_phases<1>(36, 50, ph_lo, ph_hi, lds, grid);
}

extern "C" void kernel_launch(void* const* d_in, const int* in_sizes, int n_in, void* d_out, int out_size, void* d_ws, size_t ws_size, hipStream_t stream) {
    static int grid_blocks = 0;
    if (!grid_blocks) {
        int dev = 0, cus = 0, per_cu = 0;
        hipGetDevice(&dev);
        hipDeviceGetAttribute(&cus, hipDeviceAttributeMultiprocessorCount, dev);
        hipFuncSetAttribute((const void*)fwd_megakernel, hipFuncAttributeMaxDynamicSharedMemorySize, LDS_BYTES);
        hipOccupancyMaxActiveBlocksPerMultiprocessor(&per_cu, fwd_megakernel, 512, LDS_BYTES);
        if (per_cu < 1) per_cu = 1;
        grid_blocks = cus * 1;
        if (ws_size < WS_NEED2) fprintf(stderr, "workspace too small: %zu < %zu\n", ws_size, (size_t)WS_NEED2);
    }
    KP hp{};
    for (int i = 0; i < 36; ++i) hp.in[i] = (const float*)d_in[i];
    hp.out = (float*)d_out; hp.ws = (unsigned char*)d_ws; hp.ph_lo = 0; hp.ph_hi = NPHASE;
    void* args[] = {&hp};
    hipMemsetAsync((unsigned char*)d_ws + OFF_MLM + 65536, 0, 256, stream);
    hipError_t e = hipLaunchCooperativeKernel((void*)fwd_megakernel, dim3(grid_blocks), dim3(512), args, LDS_BYTES, stream);
    if (e != hipSuccess) fprintf(stderr, "cooperative launch failed: %s (grid %d)\n", hipGetErrorString(e), grid_blocks);
}
```

```cpp
#define REPMASK 0
#define REPN 1
#include <hip/hip_runtime.h>
#include <hip/hip_cooperative_groups.h>
#include <cstdio>
namespace cg = cooperative_groups;
#define WTAB_OFF 163584
__device__ __forceinline__ int llane() { int l; asm volatile("v_mbcnt_lo_u32_b32 %0, -1, 0\n\tv_mbcnt_hi_u32_b32 %0, -1, %0" : "=v"(l) :: "memory"); return l; }
__device__ __forceinline__ int lwave() { extern __shared__ __attribute__((aligned(16))) unsigned char shm_w[];
    const int hw = __builtin_amdgcn_s_getreg(10244) & 63;
    return __builtin_amdgcn_readfirstlane(*(const __attribute__((address_space(3))) int*)((__attribute__((address_space(3))) unsigned char*)shm_w + WTAB_OFF + hw * 4)); }
__device__ __forceinline__ void wtab_init() { extern __shared__ __attribute__((aligned(16))) unsigned char shm_w[];
    const int hw = __builtin_amdgcn_s_getreg(10244) & 63;
    *(__attribute__((address_space(3))) int*)((__attribute__((address_space(3))) unsigned char*)shm_w + WTAB_OFF + hw * 4) = (int)(threadIdx.x >> 6); }
__device__ __forceinline__ int ltid() { return lwave() * 64 + llane(); }
__device__ __forceinline__ int lbid() { int t = blockIdx.x; asm volatile("" : "+s"(t) :: "memory"); return t; }
namespace pg8 {
#define PG8_LAS __attribute__((address_space(3)))
typedef unsigned short bf16_t;
typedef short bf16x8 __attribute__((ext_vector_type(8)));
typedef float f32x4 __attribute__((ext_vector_type(4)));
typedef unsigned u32x4 __attribute__((ext_vector_type(4)));
constexpr int BM = 256, BK = 64, HALF = 128, HTB = HALF * BK * 2  , STAGE_BYTES = 8 * HTB, NXCD = 8, WGM = 8;

__host__ __device__ __forceinline__ int lds_byte(int r, int c) { const int st = (r >> 4) * 2 + (c >> 5), rr = r & 15, cc = c & 31, ob = rr * 64 + cc * 2; return st * 1024 + (ob ^ (((ob >> 9) & 1) << 5)); }
__host__ __device__ __forceinline__ void stage_rc(int b, int& R, int& C) { const int st = b / 1024, sb = b % 1024, swz = sb ^ (((sb >> 9) & 1) << 5); R = (st >> 1) * 16 + swz / 64; C = (st & 1) * 32 + (swz % 64) / 2; }
__host__ __device__ __forceinline__ int perm32(int rho) { const int n = rho >> 4, i = rho & 15; return 8 * (i >> 2) + 4 * n + (i & 3); }

struct Unit { int pm, pn, kofs; };
struct Gemm { const bf16_t* A; const bf16_t* Bt; int M, N, K, ldk; };

struct StaticOrder {
    int nM, nN, nwg, G, c, lat;
    __host__ __device__ void init(int M, int N, int G_, int c_, int lat_ = 0) { lat = lat_; nM = lat ? 128 : M / BM; nN = N / BM; nwg = nM * nN; G = G_; c = c_; }
    __host__ __device__ bool next(int i, Unit& u) const {
        const long L = (long)i * G + c; if (L >= nwg) return false;
        int wgid = (int)L; { const int q = nwg / NXCD, r = nwg % NXCD, xcd = wgid % NXCD, off = wgid / NXCD; wgid = (xcd < r ? xcd * (q + 1) : r * (q + 1) + (xcd - r) * q) + off; }
        const int nig = WGM * nN, gid = wgid / nig, fm = gid * WGM, gsz = (nM - fm) < WGM ? (nM - fm) : WGM;
        u.pm = fm + ((wgid % nig) % gsz); u.pn = (wgid % nig) / gsz; u.kofs = 0; if (lat) u.pm = (u.pm >> 5) * 33 + 1 + (u.pm & 31); return true;
    }
    __device__ __forceinline__ void a_ready(const Unit&) const {}
    __device__ __forceinline__ void done(const Unit&) const {}
};
__device__ __forceinline__ unsigned cvt_pk_bf16(float lo, float hi) { unsigned r; asm volatile("v_cvt_pk_bf16_f32 %0, %1, %2" : "=v"(r) : "v"(lo), "v"(hi)); return r; }
template <class Epi, class Sched, bool STAMP = false>
__device__ __forceinline__ void gemm_phase(PG8_LAS unsigned char* lds, const Gemm g, const Sched& S, const Epi& E, unsigned long long* stamps) {
    const int tid = ltid(), wid = __builtin_amdgcn_readfirstlane(tid >> 6), lane = tid & 63, wr = wid >> 2, wc = wid & 3, fr = lane & 15, fq = lane >> 4;
    const int K = g.K, nt = K / BK, ldk = g.ldk ? g.ldk : g.K;
    int ts_lo = 0, ts_hi = 0, nts = 0; const unsigned long long rt_entry = STAMP ? (unsigned long long)wall_clock64() : 0ull;
#define PG8_STAMP() do { if (STAMP && wid == 0 && nts < 64) { const unsigned long long _c = (unsigned long long)clock64(); \
        ts_lo = (lane == nts) ? (int)(unsigned)_c : ts_lo; ts_hi = (lane == nts) ? (int)(unsigned)(_c >> 32) : ts_hi; ++nts; } } while (0)
    PG8_STAMP();
    unsigned voffA[2], voffB[2];
#pragma unroll
    for (int i = 0; i < 2; ++i) { int R, C; stage_rc(tid * 16 + i * 8192, R, C); const int Rb = Epi::PERM ? ((R & ~31) + perm32(R & 31)) : R;
        voffA[i] = (unsigned)(R * ldk + C) * 2u; voffB[i] = (unsigned)(Rb * ldk + C) * 2u; }
    const size_t kstep = (size_t)(BK * 2);
    const size_t hstep = (size_t)HALF * ldk * 2;
    const size_t tstep = 2 * hstep;
    const unsigned ldsw = (unsigned)wid * 1024u;
    const int aoff = lds_byte(wr * 64 + fr, fq * 8), boff = lds_byte(wc * 32 + fr, fq * 8);
#define PG8_SA(b, h) (((b) * 2 + (h)) * HTB)
#define PG8_SB(b, h) ((4 + (b) * 2 + (h)) * HTB)
#define PG8_STAGE(bufoff, gbase, voff) do { _Pragma("unroll") for (int _i = 0; _i < 2; ++_i) \
        __builtin_amdgcn_global_load_lds((const unsigned*)((const char*)(gbase) + (voff)[_i]), (PG8_LAS unsigned*)(lds + (bufoff) + ldsw + _i * 8192), 16, 0, 0); } while (0)
#define PG8_LDA(dst, b, h) do { _Pragma("unroll") for (int m = 0; m < 4; ++m) _Pragma("unroll") for (int k = 0; k < 2; ++k) dst[m][k] = *(const PG8_LAS bf16x8*)(lds + PG8_SA(b, h) + aoff + m * 2048 + k * 1024); } while (0)
#define PG8_LDB(dst, b, h) do { _Pragma("unroll") for (int n = 0; n < 2; ++n) _Pragma("unroll") for (int k = 0; k < 2; ++k) dst[n][k] = *(const PG8_LAS bf16x8*)(lds + PG8_SB(b, h) + boff + n * 2048 + k * 1024); } while (0)
#define PG8_MMA(ai, bj, At, Bt) do { __builtin_amdgcn_s_setprio(1); _Pragma("unroll") for (int m = 0; m < 4; ++m) _Pragma("unroll") for (int n = 0; n < 2; ++n) _Pragma("unroll") for (int k = 0; k < 2; ++k) \
        acc[ai][bj][m][n] = __builtin_amdgcn_mfma_f32_16x16x32_bf16(Bt[n][k], At[m][k], acc[ai][bj][m][n], 0, 0, 0); __builtin_amdgcn_s_setprio(0); } while (0)
#define PG8_WAIT_V(n) asm volatile("s_waitcnt vmcnt(" #n ")" ::: "memory")
#define PG8_WAIT_L(n) asm volatile("s_waitcnt lgkmcnt(" #n ")" ::: "memory")
#define PG8_BAR __builtin_amdgcn_s_barrier()
#define PG8_SCHED __builtin_amdgcn_sched_barrier(0)
    Unit cur, nxt; int ui = 0;
    if (!S.next(0, cur)) return;
    f32x4 acc[2][2][4][2];
#pragma unroll
    for (int a = 0; a < 2; ++a)
#pragma unroll
        for (int b = 0; b < 2; ++b)
#pragma unroll
            for (int m = 0; m < 4; ++m)
#pragma unroll
                for (int n = 0; n < 2; ++n) acc[a][b][m][n] = (f32x4){0.f, 0.f, 0.f, 0.f};
    bf16x8 At[4][2], B0[2][2], B1[2][2];
    const char* cA = (const char*)g.A + (size_t)cur.pm * tstep + (size_t)cur.kofs * 2; const char* cB = (const char*)g.Bt + (size_t)cur.pn * tstep + (size_t)cur.kofs * 2;
    S.a_ready(cur);
    PG8_STAGE(PG8_SB(0, 0), cB, voffB); PG8_STAGE(PG8_SA(0, 0), cA, voffA); PG8_STAGE(PG8_SB(0, 1), cB + hstep, voffB); PG8_STAGE(PG8_SA(0, 1), cA + hstep, voffA);
    if (wr == 1) PG8_BAR;
    PG8_WAIT_V(4); PG8_BAR;
    PG8_STAGE(PG8_SB(1, 0), cB + kstep, voffB); PG8_STAGE(PG8_SA(1, 0), cA + kstep, voffA); PG8_STAGE(PG8_SB(1, 1), cB + hstep + kstep, voffB);
    PG8_WAIT_V(6); PG8_BAR;
    PG8_STAMP();
    for (;;) {
        const bool has_next = S.next(ui + 1, nxt);
        const char* nA = has_next ? (const char*)g.A + (size_t)nxt.pm * tstep + (size_t)nxt.kofs * 2 : cA; const char* nB = has_next ? (const char*)g.Bt + (size_t)nxt.pn * tstep + (size_t)nxt.kofs * 2 : cB;
        for (int t = 0; t < nt; t += 2) {
            const bool last = (t == nt - 2);
            const char* a1 = cA + (size_t)(t + 1) * kstep;
            const char* a2 = last ? nA : cA + (size_t)(t + 2) * kstep; const char* b2 = last ? nB : cB + (size_t)(t + 2) * kstep;
            const char* a3 = a2 + kstep; const char* b3 = b2 + kstep;
            if (last && has_next) S.a_ready(nxt);
            PG8_LDB(B0, 0, 0); PG8_SCHED; PG8_LDA(At, 0, 0); PG8_STAGE(PG8_SA(1, 1), a1 + hstep, voffA);
            PG8_WAIT_L(8); PG8_BAR; PG8_WAIT_L(0); PG8_MMA(0, 0, At, B0); PG8_BAR; PG8_SCHED;
            PG8_LDB(B1, 0, 1); PG8_STAGE(PG8_SB(0, 0), b2, voffB);
            PG8_BAR; PG8_WAIT_L(0); PG8_MMA(0, 1, At, B1); PG8_BAR;
            PG8_LDA(At, 0, 1); PG8_STAGE(PG8_SA(0, 0), a2, voffA);
            PG8_BAR; PG8_WAIT_L(0); PG8_MMA(1, 0, At, B0); PG8_BAR; PG8_SCHED;
            PG8_STAGE(PG8_SB(0, 1), b2 + hstep, voffB);
            PG8_WAIT_V(6); PG8_BAR; PG8_MMA(1, 1, At, B1); PG8_BAR;
            PG8_LDB(B0, 1, 0); PG8_SCHED; PG8_LDA(At, 1, 0); PG8_STAGE(PG8_SA(0, 1), a2 + hstep, voffA);
            PG8_WAIT_L(8); PG8_BAR; PG8_WAIT_L(0); PG8_MMA(0, 0, At, B0); PG8_BAR; PG8_SCHED;
            PG8_LDB(B1, 1, 1); PG8_STAGE(PG8_SB(1, 0), b3, voffB);
            PG8_BAR; PG8_WAIT_L(0); PG8_MMA(0, 1, At, B1); PG8_BAR;
            PG8_LDA(At, 1, 1); PG8_STAGE(PG8_SA(1, 0), a3, voffA);
            PG8_BAR; PG8_WAIT_L(0); PG8_MMA(1, 0, At, B0); PG8_BAR; PG8_SCHED;
            PG8_STAGE(PG8_SB(1, 1), b3 + hstep, voffB);
            PG8_WAIT_V(6); PG8_BAR; PG8_MMA(1, 1, At, B1); PG8_BAR;
        }
        PG8_STAMP();
        if constexpr (!Epi::AFTER_DRAIN) { E(acc, cur, wr, wc, fr, fq); S.done(cur); }
        PG8_STAMP();
        if (!has_next) break;
#pragma unroll
        for (int a = 0; a < 2; ++a)
#pragma unroll
            for (int b = 0; b < 2; ++b)
#pragma unroll
                for (int m = 0; m < 4; ++m)
#pragma unroll
                    for (int n = 0; n < 2; ++n) acc[a][b][m][n] = (f32x4){0.f, 0.f, 0.f, 0.f};
        cur = nxt; cA = nA; cB = nB; ++ui;
    }
    PG8_WAIT_V(0);
    if (wr == 0) PG8_BAR;
    PG8_BAR;
    if constexpr (Epi::AFTER_DRAIN) { E.fused(acc, cur, wr, wc, fr, fq, lds, wid, lane); S.done(cur); }
    PG8_STAMP();
    if (STAMP && wid == 0) { stamps[lane] = lane < nts ? (((unsigned long long)(unsigned)ts_hi << 32) | (unsigned)ts_lo) : 0ull;
        if (lane == 62) stamps[62] = rt_entry; if (lane == 63) stamps[63] = (unsigned long long)wall_clock64(); }
#undef PG8_STAMP
#undef PG8_SA
#undef PG8_SB
#undef PG8_STAGE
#undef PG8_LDA
#undef PG8_LDB
#undef PG8_MMA
#undef PG8_WAIT_V
#undef PG8_WAIT_L
#undef PG8_BAR
#undef PG8_SCHED
}
}

typedef unsigned short u16;
using pg8::f32x4; using pg8::bf16x8;
typedef float f32x2 __attribute__((ext_vector_type(2)));
typedef unsigned u32x2 __attribute__((ext_vector_type(2)));
typedef unsigned u32x4v __attribute__((ext_vector_type(4)));
typedef short s16x4 __attribute__((ext_vector_type(4)));
#define LAS __attribute__((address_space(3)))
constexpr int D = 1024, NB = 4, SEQ = 8192, CTX = 256, TPB = 8448, NTOK = 33792, FF = 2816, NCH = 132, INNER = 2048, DH = 512, NFFT = 16384;
constexpr size_t MiB = 1u << 20;
constexpr size_t OFF_WB = 0, OFF_MOD = 48 * MiB, OFF_H = 49 * MiB, OFF_U = OFF_H + 132 * MiB, OFF_R1 = OFF_U + 66 * MiB, OFF_R2 = OFF_R1 + 264 * MiB,
                 OFF_HBC = OFF_R2 + 132 * MiB, OFF_GATES = OFF_HBC + 4 * MiB, OFF_H2 = OFF_GATES + 3 * MiB, OFF_KCTX = OFF_H2 + 3 * MiB, WS_NEED = OFF_KCTX + 4 * MiB;
constexpr size_t WB_FIN0 = 0, WB_FIN1 = 11 * MiB, WB_FOUT0 = 22 * MiB, WB_FOUT1 = 22 * MiB + 5632 * 1024, WB_MIN = 33 * MiB, WB_MOUT = 41 * MiB, WB_WGT = 45 * MiB;
constexpr int LDS_BYTES = 163840;
struct KP { const float* in[36]; float* out; unsigned char* ws; int ph_lo, ph_hi; };
typedef const KP __attribute__((address_space(4))) * KPC;
enum { I_X = 0, I_C, I_CTX, I_CCTX, I_ADAW, I_ADAB, I_NORMG, I_FINALG, I_FFNIN, I_FFNOUT, I_HYWIN, I_HYBIN, I_HYCW, I_HYCB, I_HYW1, I_HYB1, I_HYW2, I_HYB2, I_HYW3, I_HYB3,
       I_HYFREQ, I_HYDECAY, I_HYSKIP, I_HYWOUT, I_HYBOUT, I_MLUP, I_MLCW, I_MLCB, I_MLWQ, I_MLWK, I_MLWV, I_MLWG, I_MLBG, I_MLNG, I_MLSKIP, I_MLDOWN };

__device__ __forceinline__ float bf2f(u16 b) { return __uint_as_float(((unsigned)b) << 16); }
__device__ __forceinline__ float bflo(unsigned w) { return __uint_as_float(w << 16); }
__device__ __forceinline__ float bfhi(unsigned w) { return __uint_as_float(w & 0xffff0000u); }
__device__ __forceinline__ u16 f2bf(float f) { return (u16)(pg8::cvt_pk_bf16(f, 0.f) & 0xffffu); }
__device__ __forceinline__ float siluf(float x) { return x / (1.0f + __expf(-x)); }
__device__ __forceinline__ int modrow_of_token(int T) { const int b = T / TPB, t = T - b * TPB; return t < CTX ? 4 : b; }
__device__ __forceinline__ float lshfl(float v, int srclane) { return __int_as_float(__builtin_amdgcn_ds_bpermute(srclane << 2, __float_as_int(v))); }
__device__ __forceinline__ float wave_sum(float v) { const int lane = llane();
#pragma unroll
    for (int o = 32; o > 0; o >>= 1) v += lshfl(v, lane ^ o);
    return v; }
__device__ __forceinline__ float wave_max(float v) { const int lane = llane();
#pragma unroll
    for (int o = 32; o > 0; o >>= 1) v = fmaxf(v, lshfl(v, lane ^ o));
    return v; }

__device__ __forceinline__ void unpack8(u32x4v w, float (&f)[8]) { f[0] = bflo(w.x); f[1] = bfhi(w.x); f[2] = bflo(w.y); f[3] = bfhi(w.y); f[4] = bflo(w.z); f[5] = bfhi(w.z); f[6] = bflo(w.w); f[7] = bfhi(w.w); }
__device__ __forceinline__ u32x4v pack8(const float (&f)[8]) { u32x4v w; w.x = pg8::cvt_pk_bf16(f[0], f[1]); w.y = pg8::cvt_pk_bf16(f[2], f[3]); w.z = pg8::cvt_pk_bf16(f[4], f[5]); w.w = pg8::cvt_pk_bf16(f[6], f[7]); return w; }

struct EpiSwiglu {
    static constexpr bool PERM = true, AFTER_DRAIN = false;
    u16* act;
    __device__ __forceinline__ void operator()(const f32x4 (&acc)[2][2][4][2], const pg8::Unit& u, int wr, int wc, int fr, int fq) const {
        const int row0 = u.pm * 256 + wr * 64 + fr, col0 = u.pn * 128 + wc * 32 + 8 * fq;
#pragma unroll
        for (int ai = 0; ai < 2; ++ai)
#pragma unroll
            for (int m = 0; m < 4; ++m) {
                const f32x4 g0 = acc[ai][0][m][0], g1 = acc[ai][0][m][1], v0 = acc[ai][1][m][0], v1 = acc[ai][1][m][1];
                u32x4v w;
                w.x = pg8::cvt_pk_bf16(siluf(g0[0]) * v0[0], siluf(g0[1]) * v0[1]); w.y = pg8::cvt_pk_bf16(siluf(g0[2]) * v0[2], siluf(g0[3]) * v0[3]);
                w.z = pg8::cvt_pk_bf16(siluf(g1[0]) * v1[0], siluf(g1[1]) * v1[1]); w.w = pg8::cvt_pk_bf16(siluf(g1[2]) * v1[2], siluf(g1[3]) * v1[3]);
                *(u32x4v*)(act + (size_t)(row0 + ai * 128 + m * 16) * FF + col0) = w; }
    }
};
struct EpiResid {
    static constexpr bool PERM = false, AFTER_DRAIN = false;
    float* h; const float* modl; int gidx; float scale; const float* bias;
    __device__ __forceinline__ void operator()(const f32x4 (&acc)[2][2][4][2], const pg8::Unit& u, int wr, int wc, int fr, int fq) const {
        const int row0 = u.pm * 256 + wr * 64 + fr, col0 = u.pn * 256 + wc * 32 + 4 * fq;
        const int mr = modrow_of_token(u.pm * 256);
        const float* gp = modl + (size_t)mr * 9216 + gidx * 1024;
        f32x4 gv[2][2], bv[2][2];
#pragma unroll
        for (int bj = 0; bj < 2; ++bj)
#pragma unroll
            for (int n = 0; n < 2; ++n) { gv[bj][n] = *(const f32x4*)(gp + col0 + bj * 128 + n * 16) * scale;
                bv[bj][n] = bias ? *(const f32x4*)(bias + col0 + bj * 128 + n * 16) : (f32x4){0.f, 0.f, 0.f, 0.f}; }
#pragma unroll
        for (int ai = 0; ai < 2; ++ai)
#pragma unroll
            for (int m = 0; m < 4; ++m) { float* rowp = h + (size_t)(row0 + ai * 128 + m * 16) * D + col0;
#pragma unroll
                for (int bj = 0; bj < 2; ++bj)
#pragma unroll
                    for (int n = 0; n < 2; ++n) { f32x4* q = (f32x4*)(rowp + bj * 128 + n * 16); *q = *q + gv[bj][n] * (acc[ai][bj][m][n] + bv[bj][n]); } }
    }
};
struct EpiBf {
    static constexpr bool PERM = true, AFTER_DRAIN = false;
    u16* O; int ldc;
    __device__ __forceinline__ void operator()(const f32x4 (&acc)[2][2][4][2], const pg8::Unit& u, int wr, int wc, int fr, int fq) const {
        const int row0 = u.pm * 256 + wr * 64 + fr, col0 = u.pn * 256 + wc * 32 + 8 * fq;
#pragma unroll
        for (int ai = 0; ai < 2; ++ai)
#pragma unroll
            for (int m = 0; m < 4; ++m)
#pragma unroll
                for (int bj = 0; bj < 2; ++bj) { const f32x4 a = acc[ai][bj][m][0], b = acc[ai][bj][m][1]; u32x4v w;
                    w.x = pg8::cvt_pk_bf16(a[0], a[1]); w.y = pg8::cvt_pk_bf16(a[2], a[3]); w.z = pg8::cvt_pk_bf16(b[0], b[1]); w.w = pg8::cvt_pk_bf16(b[2], b[3]);
                    *(u32x4v*)(O + (size_t)(row0 + ai * 128 + m * 16) * ldc + col0 + bj * 128) = w; }
    }
};
struct EpiProjT {
    static constexpr bool PERM = true, AFTER_DRAIN = false;
    u16* lat; u16* ctx; const float* bias;
    __device__ __forceinline__ void operator()(const f32x4 (&acc)[2][2][4][2], const pg8::Unit& u, int wr, int wc, int fr, int fq) const {
        const int row0 = u.pm * 256 + wr * 64 + fr, tc0 = wc * 32 + 8 * fq;
        const int b = u.pn / 33, tile = u.pn - b * 33;
#pragma unroll
        for (int ai = 0; ai < 2; ++ai)
#pragma unroll
            for (int m = 0; m < 4; ++m) { const int ch = row0 + ai * 128 + m * 16; const float bs = bias[ch];
                u16* dst = tile == 0 ? ctx + ((size_t)b * 3072 + ch) * CTX + tc0 : lat + ((size_t)b * 3072 + ch) * SEQ + (tile - 1) * 256 + tc0;
#pragma unroll
                for (int bj = 0; bj < 2; ++bj) { const f32x4 a = acc[ai][bj][m][0] + bs, c = acc[ai][bj][m][1] + bs; u32x4v w;
                    w.x = pg8::cvt_pk_bf16(a[0], a[1]); w.y = pg8::cvt_pk_bf16(a[2], a[3]); w.z = pg8::cvt_pk_bf16(c[0], c[1]); w.w = pg8::cvt_pk_bf16(c[2], c[3]);
                    *(u32x4v*)(dst + bj * 128) = w; } }
    }
};


struct LatOrder : pg8::StaticOrder {
    __device__ bool next(int i, pg8::Unit& u) const { if (!pg8::StaticOrder::next(i, u)) return false; u.pm = (u.pm >> 5) * 33 + 1 + (u.pm & 31); return true; }
};
struct CtxSplitOrder {
    int nk, G, c;
    __device__ bool next(int i, pg8::Unit& u) const { const int L = i * G + c; if (L >= 16 * nk) return false; const int un = L & 15, kc = L >> 4; u.pm = (un >> 2) * 33; u.pn = un & 3; u.kofs = kc * 256; return true; }
    __device__ __forceinline__ void a_ready(const pg8::Unit&) const {}
    __device__ __forceinline__ void done(const pg8::Unit&) const {}
};
struct EpiResidAtomic {
    static constexpr bool PERM = false, AFTER_DRAIN = false;
    float* h; const float* gp; float scale;
    __device__ __forceinline__ void operator()(const f32x4 (&acc)[2][2][4][2], const pg8::Unit& u, int wr, int wc, int fr, int fq) const {
        const int row0 = u.pm * 256 + wr * 64 + fr, col0 = u.pn * 256 + wc * 32 + 4 * fq;
#pragma unroll
        for (int bj = 0; bj < 2; ++bj)
#pragma unroll
            for (int n = 0; n < 2; ++n) { const f32x4 gv = *(const f32x4*)(gp + col0 + bj * 128 + n * 16) * scale;
#pragma unroll
                for (int ai = 0; ai < 2; ++ai)
#pragma unroll
                    for (int m = 0; m < 4; ++m) { float* q = h + (size_t)(row0 + ai * 128 + m * 16) * D + col0 + bj * 128 + n * 16; const f32x4 v = gv * acc[ai][bj][m][n];
                        atomicAdd(q, v[0]); atomicAdd(q + 1, v[1]); atomicAdd(q + 2, v[2]); atomicAdd(q + 3, v[3]); } }
    }
};

__device__ __forceinline__ void ctx_bias_phase(KPC kp, const float* gp, const float* bias) {
    float* h = (float*)(kp->ws + OFF_H);
    for (int i = lbid() * 512 + ltid(); i < NB * CTX * 256; i += gridDim.x * 512) { const int r = i >> 8, c = (i & 255) * 4, b = r >> 8, t = r & 255;
        f32x4* q = (f32x4*)(h + ((size_t)b * TPB + t) * D + c); *q = *q + *(const f32x4*)(gp + c) * *(const f32x4*)(bias + c); }
}
__device__ __forceinline__ int colmap(int n, int mapmode) { return mapmode ? (((n >> 8) << 7) + (n & 127) + ((n >> 7) & 1) * FF) : n; }
__device__ __forceinline__ void convert_T(const float* __restrict__ src, int ld, int K, int Nd, int mapmode, u16* __restrict__ dst, LAS float* tile, int& tctr) {
    const int tid = ltid(), nkt = K / 64, ntile = (Nd / 64) * nkt;
    const int G = (int)gridDim.x; const int first = (((lbid() - tctr) % G) + G) % G; tctr += ntile;
    for (int t = first; t < ntile; t += G) {
        const int n0 = (t / nkt) * 64, k0 = (t % nkt) * 64, c0 = colmap(n0, mapmode);
#pragma unroll
        for (int i = 0; i < 2; ++i) { const int e = tid + 512 * i, kr = e >> 4, c4 = (e & 15) * 4;
            const f32x4 v = *(const f32x4*)(src + (size_t)(k0 + kr) * ld + c0 + c4);
            tile[kr * 65 + c4] = v[0]; tile[kr * 65 + c4 + 1] = v[1]; tile[kr * 65 + c4 + 2] = v[2]; tile[kr * 65 + c4 + 3] = v[3]; }
        __syncthreads();
        { const int n = tid >> 3, k8 = (tid & 7) * 8; u32x4v w;
          w.x = pg8::cvt_pk_bf16(tile[(k8 + 0) * 65 + n], tile[(k8 + 1) * 65 + n]); w.y = pg8::cvt_pk_bf16(tile[(k8 + 2) * 65 + n], tile[(k8 + 3) * 65 + n]);
          w.z = pg8::cvt_pk_bf16(tile[(k8 + 4) * 65 + n], tile[(k8 + 5) * 65 + n]); w.w = pg8::cvt_pk_bf16(tile[(k8 + 6) * 65 + n], tile[(k8 + 7) * 65 + n]);
          *(u32x4v*)(dst + (size_t)(n0 + n) * K + k0 + k8) = w; }
        __syncthreads();
    }
}

__device__ __forceinline__ void norm_phase(KPC kp, int l, int sub) {
    const float* h = (const float*)(kp->ws + OFF_H); u16* uo = (u16*)(kp->ws + OFF_U);
    const float* g = kp->in[I_NORMG] + (size_t)(l * 3 + sub) * D; const float* modl = (const float*)(kp->ws + OFF_MOD) + (size_t)l * 5 * 9216;
    const int lane = ltid() & 63, wv = ltid() >> 6;
    for (int T = lbid() * 8 + wv; T < NTOK; T += gridDim.x * 8) {
        const float* hr = h + (size_t)T * D; f32x4 v[4]; float ss = 0.f;
#pragma unroll
        for (int i = 0; i < 4; ++i) { v[i] = *(const f32x4*)(hr + i * 256 + lane * 4); ss += v[i][0] * v[i][0] + v[i][1] * v[i][1] + v[i][2] * v[i][2] + v[i][3] * v[i][3]; }
        ss = wave_sum(ss); const float rs = rsqrtf(ss * (1.0f / D) + 1e-6f);
        const float* mp = modl + (size_t)modrow_of_token(T) * 9216 + sub * 3 * 1024;
#pragma unroll
        for (int i = 0; i < 4; ++i) { const int c = i * 256 + lane * 4; const f32x4 gg = *(const f32x4*)(g + c), sh = *(const f32x4*)(mp + c), sc = *(const f32x4*)(mp + 1024 + c);
            const f32x4 o = v[i] * rs * gg * (sc + 1.0f) + sh; u32x2 w; w.x = pg8::cvt_pk_bf16(o[0], o[1]); w.y = pg8::cvt_pk_bf16(o[2], o[3]);
            *(u32x2*)(uo + (size_t)T * D + c) = w; }
    }
}

__device__ __forceinline__ void final_phase(KPC kp) {
    const float* h = (const float*)(kp->ws + OFF_H); const float* g = kp->in[I_FINALG];
    const int lane = ltid() & 63, wv = ltid() >> 6;
    for (int r = lbid() * 8 + wv; r < NB * SEQ; r += gridDim.x * 8) {
        const int b = r / SEQ, s = r - b * SEQ; const float* hr = h + ((size_t)b * TPB + CTX + s) * D; f32x4 v[4]; float ss = 0.f;
#pragma unroll
        for (int i = 0; i < 4; ++i) { v[i] = *(const f32x4*)(hr + i * 256 + lane * 4); ss += v[i][0] * v[i][0] + v[i][1] * v[i][1] + v[i][2] * v[i][2] + v[i][3] * v[i][3]; }
        ss = wave_sum(ss); const float rs = rsqrtf(ss * (1.0f / D) + 1e-6f);
#pragma unroll
        for (int i = 0; i < 4; ++i) { const int c = i * 256 + lane * 4; *(f32x4*)(kp->out + (size_t)r * D + c) = v[i] * rs * *(const f32x4*)(g + c); }
    }
}

__device__ __forceinline__ void setup_phase(KPC kp, LAS float* ldsf) {
    float* h = (float*)(kp->ws + OFF_H); const int tid = ltid();
    for (size_t i = (size_t)lbid() * 512 + tid; i < (size_t)NTOK * 256; i += (size_t)gridDim.x * 512) {
        const int T = (int)(i >> 8), c = ((int)i & 255) * 4, b = T / TPB, t = T - b * TPB; f32x4 v;
        if (t < CTX) v = *(const f32x4*)(kp->in[I_CTX] + ((size_t)b * CTX + t) * D + c);
        else { const int s = t - CTX; v = *(const f32x4*)(kp->in[I_X] + ((size_t)b * SEQ + s) * D + c);
            const int half = c >> 9, cc = c & 511, isc = cc >> 8, i0 = cc & 255; const float pv = half ? (float)(s & 63) : (float)(s >> 6);
#pragma unroll
            for (int e = 0; e < 4; ++e) { const float om = exp2f(-13.287712379549449f * (float)(i0 + e) * (1.0f / 256.0f)); const float ang = pv * om; v[e] += isc ? __cosf(ang) : __sinf(ang); } }
        *(f32x4*)(h + (size_t)T * D + c) = v;
    }
    LAS float* sc = ldsf; LAS float* red = ldsf + 5 * 1024;
    for (int i = tid; i < 5 * 1024; i += 512) { const int r = i >> 10, k = i & 1023; const float cv = r < 4 ? kp->in[I_C][r * D + k] : kp->in[I_CCTX][k]; sc[i] = siluf(cv); }
    __syncthreads();
    float* mod = (float*)(kp->ws + OFF_MOD); const int lane = tid & 63, wv = tid >> 6;
    for (int task = lbid(); task < 288; task += gridDim.x) {
        const int l = task / 72, n0 = (task % 72) * 128 + lane * 2; const float* w = kp->in[I_ADAW] + (size_t)l * D * 9216 + n0;
        f32x2 a[5];
#pragma unroll
        for (int r = 0; r < 5; ++r) a[r] = (f32x2){0.f, 0.f};
#pragma unroll 16
        for (int k = wv * 128; k < wv * 128 + 128; ++k) { const f32x2 wv2 = *(const f32x2*)(w + (size_t)k * 9216);
#pragma unroll
            for (int r = 0; r < 5; ++r) a[r] += wv2 * sc[r * 1024 + k]; }
#pragma unroll
        for (int r = 0; r < 5; ++r) { red[(wv * 5 + r) * 128 + lane * 2] = a[r][0]; red[(wv * 5 + r) * 128 + lane * 2 + 1] = a[r][1]; }
        __syncthreads();
        for (int i = tid; i < 640; i += 512) { const int r = i >> 7, n = i & 127; float s = 0.f;
#pragma unroll
            for (int w8 = 0; w8 < 8; ++w8) s += red[(w8 * 5 + r) * 128 + n];
            const int nn = (task % 72) * 128 + n; mod[((size_t)l * 5 + r) * 9216 + nn] = s + kp->in[I_ADAB][(size_t)l * 9216 + nn]; }
        __syncthreads();
    }
}

__device__ __forceinline__ void convert_layer(KPC kp, int l, LAS float* tile) {
    unsigned char* wb = kp->ws + OFF_WB; int tctr = 0; const int j = l >> 1;
    for (int f = 0; f < 2; ++f) {
        convert_T(kp->in[I_FFNIN] + (size_t)(l * 2 + f) * D * 2 * FF, 2 * FF, D, 2 * FF, 1, (u16*)(wb + (f ? WB_FIN1 : WB_FIN0)), tile, tctr);
        convert_T(kp->in[I_FFNOUT] + (size_t)(l * 2 + f) * FF * D, D, FF, D, 0, (u16*)(wb + (f ? WB_FOUT1 : WB_FOUT0)), tile, tctr);
    }
    if ((l & 1) == 0) {
        convert_T(kp->in[I_HYWIN] + (size_t)j * D * 3 * D, 3 * D, D, 3 * D, 0, (u16*)(wb + WB_MIN), tile, tctr);
        convert_T(kp->in[I_HYWOUT] + (size_t)j * D * D, D, D, D, 0, (u16*)(wb + WB_MOUT), tile, tctr);
    } else {
        convert_T(kp->in[I_MLUP] + (size_t)j * D * 2 * INNER, 2 * INNER, D, 2 * INNER, 0, (u16*)(wb + WB_MIN), tile, tctr);
        convert_T(kp->in[I_MLDOWN] + (size_t)j * INNER * D, D, INNER, D, 0, (u16*)(wb + WB_MOUT), tile, tctr);
        u16* wg = (u16*)(wb + WB_WGT); const float* src = kp->in[I_MLWG] + (size_t)j * 3 * INNER * 16;
        for (int i = lbid() * 512 + ltid(); i < 16 * 3 * INNER; i += gridDim.x * 512) { const int o = i / (3 * INNER), k = i - o * 3 * INNER; wg[i] = f2bf(src[(size_t)k * 16 + o]); }
        float* gates = (float*)(kp->ws + OFF_GATES); const float* bg = kp->in[I_MLBG] + j * 16;
        for (int i = lbid() * 512 + ltid(); i < NTOK * 16; i += gridDim.x * 512) gates[i] = bg[i & 15];
    }
}

constexpr size_t HY_PL = 0, HY_PC = (size_t)NB * 3072 * SEQ * 2, HY_YL = HY_PC + (size_t)NB * 3072 * CTX * 2, HY_YC = HY_YL + (size_t)NB * D * SEQ * 2;
__device__ __forceinline__ int fphys(int i) { return i ^ ((((i >> 6) & 1) * 21) ^ (((i >> 5) & 1) * 10)); }
__device__ __forceinline__ f32x2 cmul(f32x2 a, f32x2 b) { return (f32x2){a.x * b.x - a.y * b.y, a.x * b.y + a.y * b.x}; }
__device__ __forceinline__ f32x2 cmulc(f32x2 a, f32x2 b) { return (f32x2){a.x * b.x + a.y * b.y, a.y * b.x - a.x * b.y}; }
__device__ __forceinline__ int drev(int x) { const unsigned r = __brev((unsigned)x) >> 18; return (int)(((r & 0x2AAAu) >> 1) | ((r & 0x1555u) << 1)); }

__device__ __forceinline__ void fidx4(int base, int lm, int (&ix)[4]) {
    const int m = 1 << lm;
    if (lm == 6) { const int i0 = fphys(base); ix[0] = i0; ix[1] = (i0 + 64) ^ 21; ix[2] = i0 + 128; ix[3] = (i0 + 192) ^ 21; }
    else if (lm == 4) { const int c6 = ((base >> 6) & 1) * 21; ix[0] = base ^ c6; ix[1] = (base + 16) ^ c6; ix[2] = (base + 32) ^ c6 ^ 10; ix[3] = (base + 48) ^ c6 ^ 10; }
    else { const int c = (((base >> 6) & 1) * 21) ^ (((base >> 5) & 1) * 10); ix[0] = base ^ c; ix[1] = (base + m) ^ c; ix[2] = (base + 2 * m) ^ c; ix[3] = (base + 3 * m) ^ c; }
}
__device__ __forceinline__ void fft_fwd(LAS f32x2* buf) {
    const int tid = ltid();
    for (int lm = 12; lm >= 0; lm -= 2) {
        const int m = 1 << lm; const float inv = 1.0f / (float)(4 << lm);
        f32x2 a[8][4]; int ix[8][4];
#pragma unroll
        for (int i = 0; i < 8; ++i) { const int g = tid + 512 * i, p = g & (m - 1), base = ((g >> lm) << (lm + 2)) + p; fidx4(base, lm, ix[i]);
#pragma unroll
            for (int r = 0; r < 4; ++r) a[i][r] = buf[ix[i][r]]; }
#pragma unroll
        for (int i = 0; i < 8; ++i) { const int p = (tid + 512 * i) & (m - 1);
            const f32x2 t0 = a[i][0] + a[i][2], t1 = a[i][0] - a[i][2], t2 = a[i][1] + a[i][3], dd = a[i][1] - a[i][3], t3 = (f32x2){dd.y, -dd.x};
            const float rev = (float)p * inv;
            const f32x2 w1 = (f32x2){__builtin_amdgcn_cosf(rev), -__builtin_amdgcn_sinf(rev)}, w2 = cmul(w1, w1), w3 = cmul(w2, w1);
            buf[ix[i][0]] = t0 + t2; buf[ix[i][1]] = cmul(t1 + t3, w1); buf[ix[i][2]] = cmul(t0 - t2, w2); buf[ix[i][3]] = cmul(t1 - t3, w3); }
        __syncthreads();
    }
}
__device__ __forceinline__ void fft_inv(LAS f32x2* buf) {
    const int tid = ltid();
    for (int lm = 0; lm <= 12; lm += 2) {
        const int m = 1 << lm; const float inv = 1.0f / (float)(4 << lm);
        f32x2 a[8][4]; int ix[8][4];
#pragma unroll
        for (int i = 0; i < 8; ++i) { const int g = tid + 512 * i, p = g & (m - 1), base = ((g >> lm) << (lm + 2)) + p; fidx4(base, lm, ix[i]);
#pragma unroll
            for (int r = 0; r < 4; ++r) a[i][r] = buf[ix[i][r]]; }
#pragma unroll
        for (int i = 0; i < 8; ++i) { const int p = (tid + 512 * i) & (m - 1);
            const float rev = (float)p * inv;
            const f32x2 w1 = (f32x2){__builtin_amdgcn_cosf(rev), -__builtin_amdgcn_sinf(rev)}, w2 = cmul(w1, w1), w3 = cmul(w2, w1);
            const f32x2 b0 = a[i][0], b1 = cmulc(a[i][1], w1), b2 = cmulc(a[i][2], w2), b3 = cmulc(a[i][3], w3);
            const f32x2 s0 = b0 + b2, s1 = b0 - b2, s2 = b1 + b3, dd = b1 - b3, s3 = (f32x2){-dd.y, dd.x};
            buf[ix[i][0]] = s0 + s2; buf[ix[i][1]] = s1 + s3; buf[ix[i][2]] = s0 - s2; buf[ix[i][3]] = s1 - s3; }
        __syncthreads();
    }
}

__device__ __forceinline__ void hy_mlp_phase(KPC kp, int j) {
    float* h2 = (float*)(kp->ws + OFF_H2);
    const float* w1 = kp->in[I_HYW1] + j * 33 * 64; const float* b1 = kp->in[I_HYB1] + j * 64; const float* w2 = kp->in[I_HYW2] + j * 64 * 64; const float* b2 = kp->in[I_HYB2] + j * 64;
    const float* fr = kp->in[I_HYFREQ] + j * 128; const int lane = ltid() & 63, wv = ltid() >> 6;
    for (int pos = lbid() * 8 + wv; pos < SEQ + CTX; pos += gridDim.x * 8) {
        const int n = pos < SEQ ? SEQ : CTX, t = pos < SEQ ? pos : pos - SEQ; const float tn = (float)t / (float)(n - 1);
        float feat = 0.f;
        if (lane == 0) feat = tn;
        else if (lane < 33) { const int bi = (lane - 1) & 15; const float band = 1e-4f + (float)bi * ((15.0f - 1e-4f) / 15.0f); float rev = ((float)t / (float)n) * band; rev -= floorf(rev);
            const float ang = 6.283185307179586f * rev; feat = lane < 17 ? cosf(ang) : -sinf(ang); }
        float z = b1[lane];
        for (int i = 0; i < 33; ++i) z += lshfl(feat, i) * w1[i * 64 + lane];
        const float h1 = sinf(fr[lane] * z);
        float z2 = b2[lane];
        for (int v = 0; v < 64; ++v) z2 += lshfl(h1, v) * w2[v * 64 + lane];
        h2[(size_t)pos * 64 + lane] = sinf(fr[64 + lane] * z2);
    }
}

__device__ __forceinline__ void block_sum2(float& a, float& b, LAS float* red) {
    a = wave_sum(a); b = wave_sum(b); const int lane = ltid() & 63, wv = ltid() >> 6;
    __syncthreads(); if (lane == 0) { red[wv] = a; red[8 + wv] = b; } __syncthreads();
    float sa = 0.f, sb = 0.f;
#pragma unroll
    for (int i = 0; i < 8; ++i) { sa += red[i]; sb += red[8 + i]; }
    a = sa; b = sb;
}

__device__ __forceinline__ void hy_filter_task(KPC kp, int j, int task, LAS f32x2* buf, LAS float* aux) {
    const int tid = ltid(), d = task & 1023; const bool lat = task < 1024;
    const float* w3 = kp->in[I_HYW3] + (size_t)j * 64 * 4096; const float* b3 = kp->in[I_HYB3] + j * 4096; const float* ldc = kp->in[I_HYDECAY] + j * 4096;
    __syncthreads();
    if (tid < 256) aux[tid] = w3[(size_t)(tid & 63) * 4096 + (tid >> 6) * 1024 + d];
    if (tid < 4) { aux[256 + tid] = b3[tid * 1024 + d]; aux[260 + tid] = __expf(ldc[tid * 1024 + d]); }
    __syncthreads();
    const float* h2 = (const float*)(kp->ws + OFF_H2);
    float ss0 = 0.f, ss1 = 0.f;
    if (lat) {
        for (int r = 0; r < 16; ++r) { const int i = tid + 512 * r; float a0 = aux[256], a1 = aux[257], a2 = aux[258], a3 = aux[259];
#pragma unroll 4
            for (int u4 = 0; u4 < 16; ++u4) { const f32x4 hv = *(const f32x4*)(h2 + (size_t)i * 64 + u4 * 4);
                const f32x4 q0 = *(const LAS f32x4*)(aux + u4 * 4), q1 = *(const LAS f32x4*)(aux + 64 + u4 * 4), q2 = *(const LAS f32x4*)(aux + 128 + u4 * 4), q3 = *(const LAS f32x4*)(aux + 192 + u4 * 4);
#pragma unroll
                for (int e = 0; e < 4; ++e) { a0 += hv[e] * q0[e]; a1 += hv[e] * q1[e]; a2 += hv[e] * q2[e]; a3 += hv[e] * q3[e]; } }
            const float tn = (float)i * (1.0f / 8191.0f);
            a0 *= __expf(-tn * aux[260]); a1 *= __expf(-tn * aux[261]); a2 *= __expf(-tn * aux[262]); a3 *= __expf(-tn * aux[263]);
            buf[fphys(i)] = (f32x2){a0, a2}; ss0 += a0 * a0; ss1 += a2 * a2;
            if (i >= 1) { buf[fphys(NFFT - i)] = (f32x2){a1, a3}; ss0 += a1 * a1; ss1 += a3 * a3; } }
        if (tid == 0) buf[fphys(SEQ)] = (f32x2){0.f, 0.f};
        block_sum2(ss0, ss1, aux + 272);
        const f32x2 scl = (f32x2){rsqrtf(ss0 + 1e-12f) * (1.0f / NFFT), rsqrtf(ss1 + 1e-12f) * (1.0f / NFFT)};
        for (int r = 0; r < 32; ++r) { const int q = fphys(tid + 512 * r); buf[q] = buf[q] * scl; }
        __syncthreads();
        fft_fwd(buf);
        f32x2* K0 = (f32x2*)(kp->ws + OFF_R2) + (size_t)d * NFFT; f32x2* K1 = (f32x2*)kp->out + (size_t)d * NFFT;
        for (int r = 0; r < 32; ++r) { const int pos = tid + 512 * r, k = drev(pos), pos2 = drev((NFFT - k) & (NFFT - 1)); const f32x2 Z = buf[fphys(pos)], Z2 = buf[fphys(pos2)];
            K0[pos] = (f32x2){0.5f * (Z.x + Z2.x), 0.5f * (Z.y - Z2.y)}; K1[pos] = (f32x2){0.5f * (Z.y + Z2.y), -0.5f * (Z.x - Z2.x)}; }
    } else {
        const int idx = tid; float a0 = 0.f, a1 = 0.f;
        if (idx != CTX) { const int t = idx < CTX ? idx : 2 * CTX - idx, dir = idx < CTX ? 0 : 1; a0 = aux[256 + dir]; a1 = aux[258 + dir];
            for (int u4 = 0; u4 < 16; ++u4) { const f32x4 hv = *(const f32x4*)(h2 + (size_t)(SEQ + t) * 64 + u4 * 4);
#pragma unroll
                for (int e = 0; e < 4; ++e) { const int u = u4 * 4 + e; a0 += hv[e] * aux[dir * 64 + u]; a1 += hv[e] * aux[128 + dir * 64 + u]; } }
            const float tn = (float)t * (1.0f / 255.0f); a0 *= __expf(-tn * aux[260 + dir]); a1 *= __expf(-tn * aux[262 + dir]); }
        ss0 = a0 * a0; ss1 = a1 * a1;
        block_sum2(ss0, ss1, aux + 272);
        float* kc = (float*)(kp->ws + OFF_KCTX);
        kc[(size_t)d * 512 + idx] = a0 * rsqrtf(ss0 + 1e-12f); kc[(size_t)(1024 + d) * 512 + idx] = a1 * rsqrtf(ss1 + 1e-12f);
    }
}

__device__ __forceinline__ float ld3(const u16* row, int t, int n, float wa, float wb, float wc, float bias) {
    const float xm = t > 0 ? bf2f(row[t - 1]) : 0.f, x0 = bf2f(row[t]), xp = t < n - 1 ? bf2f(row[t + 1]) : 0.f; return wa * xm + wb * x0 + wc * xp + bias; }

__device__ __forceinline__ void ld3x8(const u16* row, int t0, float wa, float wb, float wc, float bias, float (&o)[8]) {
    const u32x4v w = *(const u32x4v*)(row + t0);
    const float x0 = bflo(w.x), x1 = bfhi(w.x), x2 = bflo(w.y), x3 = bfhi(w.y), x4 = bflo(w.z), x5 = bfhi(w.z), x6 = bflo(w.w), x7 = bfhi(w.w);
    const float xl = t0 > 0 ? bf2f(row[t0 - 1]) : 0.f, xr = t0 + 8 < SEQ ? bf2f(row[t0 + 8]) : 0.f;
    o[0] = wa * xl + wb * x0 + wc * x1 + bias; o[1] = wa * x0 + wb * x1 + wc * x2 + bias; o[2] = wa * x1 + wb * x2 + wc * x3 + bias; o[3] = wa * x2 + wb * x3 + wc * x4 + bias;
    o[4] = wa * x3 + wb * x4 + wc * x5 + bias; o[5] = wa * x4 + wb * x5 + wc * x6 + bias; o[6] = wa * x5 + wb * x6 + wc * x7 + bias; o[7] = wa * x6 + wb * x7 + wc * xr + bias;
}
__device__ __forceinline__ void hy_conv_lat(KPC kp, int j, int task, LAS f32x2* buf) {
    const int tid = ltid(), bp = task >> 10, c = task & 1023, b0 = bp * 2;
    const u16* pl = (const u16*)(kp->ws + OFF_R1 + HY_PL); u16* yl = (u16*)(kp->ws + OFF_R1 + HY_YL);
    const float* cw = kp->in[I_HYCW] + (size_t)j * 3 * 3072; const float* cb = kp->in[I_HYCB] + j * 3072;
    const float w1a = cw[c], w1b = cw[3072 + c], w1c = cw[6144 + c], bb1 = cb[c];
    const float w2a = cw[1024 + c], w2b = cw[3072 + 1024 + c], w2c = cw[6144 + 1024 + c], bb2 = cb[1024 + c];
    const float w3a = cw[2048 + c], w3b = cw[3072 + 2048 + c], w3c = cw[6144 + 2048 + c], bb3 = cb[2048 + c];
    const float sk0 = kp->in[I_HYSKIP][j * 2048 + c], sk1 = kp->in[I_HYSKIP][j * 2048 + 1024 + c];
    const u16* x1r0 = pl + ((size_t)b0 * 3072 + c) * SEQ; const u16* x1r1 = x1r0 + (size_t)3072 * SEQ;
    const u16* x2r0 = x1r0 + (size_t)1024 * SEQ; const u16* x2r1 = x1r1 + (size_t)1024 * SEQ;
    const u16* vr0 = x1r0 + (size_t)2048 * SEQ; const u16* vr1 = x1r1 + (size_t)2048 * SEQ;
    const f32x2* K0 = (const f32x2*)(kp->ws + OFF_R2) + (size_t)c * NFFT; const f32x2* K1 = (const f32x2*)kp->out + (size_t)c * NFFT;
    __syncthreads();
#pragma unroll
    for (int g = 0; g < 2; ++g) { const int t0 = 8 * (tid + 512 * g); float v0[8], v1[8];
        ld3x8(vr0, t0, w3a, w3b, w3c, bb3, v0); ld3x8(vr1, t0, w3a, w3b, w3c, bb3, v1);
#pragma unroll
        for (int e = 0; e < 8; ++e) { buf[fphys(t0 + e)] = (f32x2){v0[e], v1[e]}; buf[fphys(SEQ + t0 + e)] = (f32x2){0.f, 0.f}; } }
    __syncthreads();
#ifdef PROBE_FFT
    for (int rp = 0; rp < PROBE_FFT; ++rp) { fft_fwd(buf); fft_inv(buf); for (int r = 0; r < 32; ++r) { const int q = fphys(tid + 512 * r); buf[q] = buf[q] * (1.0f / NFFT); } __syncthreads(); }
#endif
    fft_fwd(buf);
#pragma unroll 8
    for (int r = 0; r < 32; ++r) { const int pos = tid + 512 * r, q = fphys(pos); buf[q] = cmul(buf[q], K0[pos]); }
    __syncthreads();
    fft_inv(buf);
    float zr[32];
#pragma unroll
    for (int g = 0; g < 2; ++g) { const int t0 = 8 * (tid + 512 * g); float v0[8], v1[8], xa[8], xb[8];
        ld3x8(vr0, t0, w3a, w3b, w3c, bb3, v0); ld3x8(vr1, t0, w3a, w3b, w3c, bb3, v1); ld3x8(x1r0, t0, w1a, w1b, w1c, bb1, xa); ld3x8(x1r1, t0, w1a, w1b, w1c, bb1, xb);
#pragma unroll
        for (int e = 0; e < 8; ++e) { const f32x2 y = buf[fphys(t0 + e)]; const float z0 = xa[e] * (y.x + sk0 * v0[e]), z1 = xb[e] * (y.y + sk0 * v1[e]);
            zr[g * 16 + 2 * e] = z0; zr[g * 16 + 2 * e + 1] = z1; buf[fphys(t0 + e)] = (f32x2){z0, z1}; buf[fphys(SEQ + t0 + e)] = (f32x2){0.f, 0.f}; } }
    __syncthreads();
    fft_fwd(buf);
#pragma unroll 8
    for (int r = 0; r < 32; ++r) { const int pos = tid + 512 * r, q = fphys(pos); buf[q] = cmul(buf[q], K1[pos]); }
    __syncthreads();
    fft_inv(buf);
#pragma unroll
    for (int g = 0; g < 2; ++g) { const int t0 = 8 * (tid + 512 * g); float xa[8], xb[8], o0[8], o1[8];
        ld3x8(x2r0, t0, w2a, w2b, w2c, bb2, xa); ld3x8(x2r1, t0, w2a, w2b, w2c, bb2, xb);
#pragma unroll
        for (int e = 0; e < 8; ++e) { const f32x2 y = buf[fphys(t0 + e)]; o0[e] = xa[e] * (y.x + sk1 * zr[g * 16 + 2 * e]); o1[e] = xb[e] * (y.y + sk1 * zr[g * 16 + 2 * e + 1]); }
        *(u32x4v*)(yl + ((size_t)b0 * D + c) * SEQ + t0) = pack8(o0); *(u32x4v*)(yl + ((size_t)(b0 + 1) * D + c) * SEQ + t0) = pack8(o1); }
}

__device__ __forceinline__ void hy_conv_ctx(KPC kp, int j, int c, LAS float* ls) {
    const int tid = ltid();
    const u16* pc = (const u16*)(kp->ws + OFF_R1 + HY_PC); u16* yc = (u16*)(kp->ws + OFF_R1 + HY_YC); const float* kc = (const float*)(kp->ws + OFF_KCTX);
    const float* cw = kp->in[I_HYCW] + (size_t)j * 3 * 3072; const float* cb = kp->in[I_HYCB] + j * 3072;
    const float w1a = cw[c], w1b = cw[3072 + c], w1c = cw[6144 + c], bb1 = cb[c];
    const float w2a = cw[1024 + c], w2b = cw[3072 + 1024 + c], w2c = cw[6144 + 1024 + c], bb2 = cb[1024 + c];
    const float w3a = cw[2048 + c], w3b = cw[3072 + 2048 + c], w3c = cw[6144 + 2048 + c], bb3 = cb[2048 + c];
    const float sk0 = kp->in[I_HYSKIP][j * 2048 + c], sk1 = kp->in[I_HYSKIP][j * 2048 + 1024 + c];
    __syncthreads();
    ls[tid] = kc[(size_t)c * 512 + tid]; ls[512 + tid] = kc[(size_t)(1024 + c) * 512 + tid];
    for (int i = 0; i < 2; ++i) { const int e = tid + 512 * i, b = e >> 8, t = e & 255; ls[1024 + e] = ld3(pc + ((size_t)b * 3072 + 2048 + c) * CTX, t, CTX, w3a, w3b, w3c, bb3); }
    __syncthreads();
    float zr[2];
    for (int i = 0; i < 2; ++i) { const int e = tid + 512 * i, b = e >> 8, t = e & 255; float a = 0.f;
        for (int s = 0; s < CTX; ++s) a += ls[(t - s) & 511] * ls[1024 + b * 256 + s];
        zr[i] = ld3(pc + ((size_t)b * 3072 + c) * CTX, t, CTX, w1a, w1b, w1c, bb1) * (a + sk0 * ls[1024 + e]); ls[2048 + e] = zr[i]; }
    __syncthreads();
    for (int i = 0; i < 2; ++i) { const int e = tid + 512 * i, b = e >> 8, t = e & 255; float a = 0.f;
        for (int s = 0; s < CTX; ++s) a += ls[512 + ((t - s) & 511)] * ls[2048 + b * 256 + s];
        yc[((size_t)b * D + c) * CTX + t] = f2bf(ld3(pc + ((size_t)b * 3072 + 1024 + c) * CTX, t, CTX, w2a, w2b, w2c, bb2) * (a + sk1 * zr[i])); }
}

__device__ __forceinline__ void hy_transpose(KPC kp, LAS u16* tl) {
    const u16* yl = (const u16*)(kp->ws + OFF_R1 + HY_YL); const u16* yc = (const u16*)(kp->ws + OFF_R1 + HY_YC); u16* y = (u16*)(kp->ws + OFF_U); const int tid = ltid();
    for (int tile = lbid(); tile < NB * 16 * NCH; tile += gridDim.x) {
        const int b = tile / (16 * NCH), rem = tile - b * 16 * NCH, ct = rem / NCH, tt = rem - ct * NCH;
        const u16* src = tt < 4 ? yc + ((size_t)b * D + ct * 64) * CTX + tt * 64 : yl + ((size_t)b * D + ct * 64) * SEQ + (tt - 4) * 64; const int ld = tt < 4 ? CTX : SEQ;
        { const int cr = tid >> 3, t8 = (tid & 7) * 8; *(LAS u32x4v*)(tl + cr * 72 + t8) = *(const u32x4v*)(src + (size_t)cr * ld + t8); }
        __syncthreads();
        { const int tr = tid >> 3, c8 = (tid & 7) * 8; u32x4v w;
          w.x = (unsigned)tl[(c8 + 0) * 72 + tr] | ((unsigned)tl[(c8 + 1) * 72 + tr] << 16); w.y = (unsigned)tl[(c8 + 2) * 72 + tr] | ((unsigned)tl[(c8 + 3) * 72 + tr] << 16);
          w.z = (unsigned)tl[(c8 + 4) * 72 + tr] | ((unsigned)tl[(c8 + 5) * 72 + tr] << 16); w.w = (unsigned)tl[(c8 + 6) * 72 + tr] | ((unsigned)tl[(c8 + 7) * 72 + tr] << 16);
          *(u32x4v*)(y + ((size_t)b * TPB + tt * 64 + tr) * D + ct * 64 + c8) = w; }
        __syncthreads();
    }
}

constexpr size_t OFF_XM = OFF_R1, OFF_XC = OFF_R1 + 132 * MiB, OFF_S = WS_NEED, OFF_MLM = OFF_S + 34 * MiB, WS_NEED2 = OFF_MLM + 1 * MiB;
__device__ __forceinline__ u16* hb_ptr(KPC kp, int T) { const int b = T / TPB, t = T - b * TPB;
    return t < CTX ? (u16*)(kp->ws + OFF_HBC) + ((size_t)b * CTX + t) * INNER : (u16*)kp->out + ((size_t)b * SEQ + (t - CTX)) * INNER; }
__device__ __forceinline__ void bd8(const float (&x)[8], const float (&w)[32], float (&y)[8]) {
#pragma unroll
    for (int bl = 0; bl < 2; ++bl)
#pragma unroll
        for (int e = 0; e < 4; ++e) { float s = 0.f;
#pragma unroll
            for (int d = 0; d < 4; ++d) s += x[bl * 4 + d] * w[bl * 16 + d * 4 + e];
            y[bl * 4 + e] = s; }
}
__device__ __forceinline__ void ldw32(const float* p, float (&w)[32]) {
#pragma unroll
    for (int i = 0; i < 8; ++i) { const f32x4 v = *(const f32x4*)(p + i * 4); w[i * 4] = v[0]; w[i * 4 + 1] = v[1]; w[i * 4 + 2] = v[2]; w[i * 4 + 3] = v[3]; } }

__device__ __forceinline__ void ml_m_phase(KPC kp, int j) {
    float* M = (float*)(kp->ws + OFF_MLM); const float* wq = kp->in[I_MLWQ] + (size_t)j * 512 * 16; const float* wk = kp->in[I_MLWK] + (size_t)j * 512 * 16;
    for (int i = lbid() * 512 + ltid(); i < 512 * 16; i += gridDim.x * 512) { const int blk = i >> 4, d = (i >> 2) & 3, d2 = i & 3; float s = 0.f;
#pragma unroll
        for (int e = 0; e < 4; ++e) s += wq[blk * 16 + d * 4 + e] * wk[blk * 16 + d2 * 4 + e];
        M[i] = s * 0.04419417382415922f; }
}

__device__ __forceinline__ void ml_prep_task(KPC kp, int j, int task, LAS unsigned char* lds) {
    const int tid = ltid(), lane = tid & 63, wv = tid >> 6, fr = lane & 15, fq = lane >> 4;
    const int hd = task & 3, bc = task >> 2, b = bc / NCH, ci = bc - b * NCH;
    const u16* xm = (const u16*)(kp->ws + OFF_XM); u16* xc = (u16*)(kp->ws + OFF_XC);
    const int T0 = b * TPB + ci * 64, tlo = b * TPB + (ci < 4 ? 0 : CTX), thi = b * TPB + (ci < 4 ? CTX - 1 : TPB - 1);
    const int ch0 = hd * DH + lane * 8;
    LAS u16* QS = (LAS u16*)lds; LAS u16* KS = (LAS u16*)(lds + 66560);
    const float* cw = kp->in[I_MLCW] + (size_t)j * 3 * INNER; const float* cb = kp->in[I_MLCB] + (size_t)j * INNER;
    __syncthreads();
    {
        float cwa[8], cwb[8], cwc[8], cbb[8], wq[32], wk[32];
#pragma unroll
        for (int e = 0; e < 8; ++e) { cwa[e] = cw[ch0 + e]; cwb[e] = cw[INNER + ch0 + e]; cwc[e] = cw[2 * INNER + ch0 + e]; cbb[e] = cb[ch0 + e]; }
        ldw32(kp->in[I_MLWQ] + ((size_t)j * 512 + (ch0 >> 2)) * 16, wq); ldw32(kp->in[I_MLWK] + ((size_t)j * 512 + (ch0 >> 2)) * 16, wk);
        for (int r = 0; r < 8; ++r) { const int jj = wv + 8 * r, T = T0 + jj; const u16* p = xm + (size_t)T * INNER + ch0;
            float x0[8], xa[8], xb[8], xcv[8], q[8], k[8];
            unpack8(*(const u32x4v*)p, x0);
            if (T > tlo) unpack8(*(const u32x4v*)(p - INNER), xa); else {
#pragma unroll
                for (int e = 0; e < 8; ++e) xa[e] = 0.f; }
            if (T < thi) unpack8(*(const u32x4v*)(p + INNER), xb); else {
#pragma unroll
                for (int e = 0; e < 8; ++e) xb[e] = 0.f; }
#pragma unroll
            for (int e = 0; e < 8; ++e) xcv[e] = siluf(cwa[e] * xa[e] + cwb[e] * x0[e] + cwc[e] * xb[e] + cbb[e]);
            const u32x4v xw = pack8(xcv); *(u32x4v*)(xc + (size_t)T * INNER + ch0) = xw; unpack8(xw, xcv);
            bd8(xcv, wq, q); bd8(xcv, wk, k);
            *(LAS u32x4v*)(QS + jj * 520 + lane * 8) = pack8(q); *(LAS u32x4v*)(KS + jj * 520 + lane * 8) = pack8(k); }
    }
    __syncthreads();
    const u16* wg = (const u16*)(kp->ws + OFF_WB + WB_WGT);
    const int mt = wv & 3, kh = wv >> 2;
    { f32x4 s0 = {0.f, 0.f, 0.f, 0.f}, s1 = {0.f, 0.f, 0.f, 0.f}; const int nt0 = kh * 2;
      for (int ks = 0; ks < 16; ++ks) { const bf16x8 a = *(const LAS bf16x8*)(QS + (16 * mt + fr) * 520 + 32 * ks + 8 * fq);
          const bf16x8 b0 = *(const LAS bf16x8*)(KS + (16 * nt0 + fr) * 520 + 32 * ks + 8 * fq), b1 = *(const LAS bf16x8*)(KS + (16 * (nt0 + 1) + fr) * 520 + 32 * ks + 8 * fq);
          s0 = __builtin_amdgcn_mfma_f32_16x16x32_bf16(a, b0, s0, 0, 0, 0); s1 = __builtin_amdgcn_mfma_f32_16x16x32_bf16(a, b1, s1, 0, 0, 0); }
      float* S = (float*)(kp->ws + OFF_S) + ((size_t)(b * 4 + hd) * NCH + ci) * 4096;
#pragma unroll
      for (int r = 0; r < 4; ++r) { S[(16 * mt + 4 * fq + r) * 64 + 16 * nt0 + fr] = s0[r]; S[(16 * mt + 4 * fq + r) * 64 + 16 * (nt0 + 1) + fr] = s1[r]; } }
    f32x4 ga = {0.f, 0.f, 0.f, 0.f};
    for (int ks = kh * 8; ks < kh * 8 + 8; ++ks) { const int kk = hd * DH + 32 * ks + 8 * fq;
        const bf16x8 a = *(const LAS bf16x8*)(QS + (16 * mt + fr) * 520 + 32 * ks + 8 * fq), a2 = *(const LAS bf16x8*)(KS + (16 * mt + fr) * 520 + 32 * ks + 8 * fq);
        const bf16x8 bq = *(const bf16x8*)(wg + (size_t)fr * 6144 + kk), bk = *(const bf16x8*)(wg + (size_t)fr * 6144 + INNER + kk);
        ga = __builtin_amdgcn_mfma_f32_16x16x32_bf16(a, bq, ga, 0, 0, 0); ga = __builtin_amdgcn_mfma_f32_16x16x32_bf16(a2, bk, ga, 0, 0, 0); }
    __syncthreads();
    {
        float wvv[32]; ldw32(kp->in[I_MLWV] + ((size_t)j * 512 + (ch0 >> 2)) * 16, wvv);
        for (int r = 0; r < 8; ++r) { const int jj = wv + 8 * r, T = T0 + jj; float x0[8], v[8]; unpack8(*(const u32x4v*)(xm + (size_t)T * INNER + ch0), x0); bd8(x0, wvv, v);
            *(LAS u32x4v*)(QS + jj * 520 + lane * 8) = pack8(v); }
    }
    __syncthreads();
    for (int ks = kh * 8; ks < kh * 8 + 8; ++ks) { const int kk = hd * DH + 32 * ks + 8 * fq;
        const bf16x8 a = *(const LAS bf16x8*)(QS + (16 * mt + fr) * 520 + 32 * ks + 8 * fq); const bf16x8 bv = *(const bf16x8*)(wg + (size_t)fr * 6144 + 2 * INNER + kk);
        ga = __builtin_amdgcn_mfma_f32_16x16x32_bf16(a, bv, ga, 0, 0, 0); }
    float* gates = (float*)(kp->ws + OFF_GATES);
#pragma unroll
    for (int r = 0; r < 4; ++r) atomicAdd(gates + (size_t)(T0 + 16 * mt + 4 * fq + r) * 16 + fr, ga[r]);
}

__device__ __forceinline__ void tr_store8(LAS unsigned char* base, int d0, const unsigned (&w)[4], int lane) {
    const int odd = lane & 1, sp = lane & ~1;
#pragma unroll
    for (int i = 0; i < 4; ++i) { const unsigned pw = (unsigned)__builtin_amdgcn_update_dpp(0, (int)w[i], 0xB1, 0xF, 0xF, false);
        const unsigned ow = odd ? ((pw >> 16) | (w[i] & 0xffff0000u)) : ((w[i] & 0xffffu) | (pw << 16)); const int d = d0 + 2 * i + odd;
        *(LAS unsigned*)(base + d * 128 + ((((sp >> 3) ^ (d & 7)) << 4) | ((sp & 7) << 1))) = ow; }
}
#ifndef REP_STAGE
#define REP_STAGE 1
#define REP_STILDE 1
#define REP_MFMA 1
#endif
constexpr int SC_QS = 0, SC_KT = 66560, SC_VT = 132096, SC_ST = 148480, SC_VEC = 156672;
__device__ __forceinline__ void ml_scan_task(KPC kp, int j, int task, LAS unsigned char* lds) {
    const int tid = ltid(), lane = tid & 63, wv = tid >> 6, fr = lane & 15, fq = lane >> 4;
    const int es = task & 3, dir = (task >> 2) & 1, hd = (task >> 3) & 3, b = task >> 5;
    const u16* xm = (const u16*)(kp->ws + OFF_XM); const u16* xc = (const u16*)(kp->ws + OFF_XC); const float* gates = (const float*)(kp->ws + OFF_GATES);
    const float* Sg = (const float*)(kp->ws + OFF_S) + (size_t)(b * 4 + hd) * NCH * 4096;
    u16* hf = (u16*)(kp->ws + OFF_R2);
    LAS unsigned char* QS = lds + SC_QS; LAS unsigned char* KT = lds + SC_KT; LAS unsigned char* VT = lds + SC_VT; LAS unsigned char* ST = lds + SC_ST;
    LAS float* rowterm = (LAS float*)(lds + SC_VEC); LAS float* colterm = rowterm + 64; LAS float* winter = rowterm + 128; LAS float* einv = rowterm + 192;
    LAS float* kws = rowterm + 256; LAS float* dinv = rowterm + 320; LAS float* nst = rowterm + 384; LAS float* scal = rowterm + 896;
    f32x4 C[32];
#pragma unroll
    for (int i = 0; i < 32; ++i) C[i] = (f32x4){0.f, 0.f, 0.f, 0.f};
    float m_st = 0.f;
    __syncthreads();
    nst[tid] = 0.f;
    for (int ci = 0; ci < NCH; ++ci) {
        __syncthreads();
        const int p0 = ci * 64;
        const int tid = ltid(), lane = tid & 63, wv = tid >> 6, fr = lane & 15, fq = lane >> 4;
        asm volatile("" ::: "memory");
        auto tok = [&](int jj) -> int { const int p = p0 + jj; const int t = dir == 0 ? p : (p < CTX ? CTX - 1 - p : TPB + CTX - 1 - p); return b * TPB + t; };
        float sv[8];
        { const int jj = tid >> 3, s8 = (tid & 7) * 8;
            if (dir == 0) { const float* sp = Sg + (size_t)ci * 4096 + jj * 64 + s8; const f32x4 v0 = *(const f32x4*)sp, v1 = *(const f32x4*)(sp + 4);
                sv[0] = v0[0]; sv[1] = v0[1]; sv[2] = v0[2]; sv[3] = v0[3]; sv[4] = v1[0]; sv[5] = v1[1]; sv[6] = v1[2]; sv[7] = v1[3]; }
            else { const int oc = ci < 4 ? 3 - ci : 135 - ci; const float* sp = Sg + (size_t)oc * 4096 + (63 - jj) * 64 + (56 - s8); const f32x4 v0 = *(const f32x4*)sp, v1 = *(const f32x4*)(sp + 4);
                sv[7] = v0[0]; sv[6] = v0[1]; sv[5] = v0[2]; sv[4] = v0[3]; sv[3] = v1[0]; sv[2] = v1[1]; sv[1] = v1[2]; sv[0] = v1[3]; }
        }
        float g_ic = 0.f, g_fp = 0.f;
        if (wv == 0) { const int Tg = tok(lane); g_ic = gates[(size_t)Tg * 16 + dir * 8 + hd]; g_fp = gates[(size_t)Tg * 16 + dir * 8 + 4 + hd]; }
        for (int rpS = 0; rpS < REP_STAGE; ++rpS) {
        const int wvu = __builtin_amdgcn_readfirstlane(wv); const int Tl = tok(lane);
        for (int r = 0; r < 8; ++r) { const int g8 = wvu * 8 + r; float x[8], q[8], Mw[32];
            const u32x4v xw = *(const u32x4v*)(xc + (size_t)Tl * INNER + hd * DH + g8 * 8); unpack8(xw, x);
            ldw32((const float*)(kp->ws + OFF_MLM) + (size_t)(hd * 128 + g8 * 2) * 16, Mw); bd8(x, Mw, q);
            *(LAS u32x4v*)(QS + lane * 1040 + g8 * 16) = pack8(q);
            const unsigned wd[4] = {xw.x, xw.y, xw.z, xw.w}; tr_store8(KT, g8 * 8, wd, lane); }
        for (int r = 0; r < 2; ++r) { const int g = wvu * 2 + r; const int chv = hd * DH + es * 128 + g * 8; float x[8], v[8], wvv[32];
            unpack8(*(const u32x4v*)(xm + (size_t)Tl * INNER + chv), x); ldw32(kp->in[I_MLWV] + ((size_t)j * 512 + (chv >> 2)) * 16, wvv); bd8(x, wvv, v);
            { const u32x4v vw = pack8(v); const unsigned wd[4] = {vw.x, vw.y, vw.z, vw.w}; tr_store8(VT, g * 8, wd, lane); } }
        }
        if (wv == 0) {
            const float ic = g_ic, fp = g_fp;
            const float lf = fminf(fp, 0.f) - log1pf(__expf(-fabsf(fp)));
            float bb = lf;
#pragma unroll
            for (int o = 1; o < 64; o <<= 1) { const float t = lshfl(bb, lane - o); if (lane >= o) bb += t; }
            const float uu = ic - bb; float pm = uu;
#pragma unroll
            for (int o = 1; o < 64; o <<= 1) { const float t = lshfl(pm, lane - o); if (lane >= o) pm = fmaxf(pm, t); }
            const float a = bb + m_st, mj = fmaxf(a, bb + pm);
            rowterm[lane] = bb - mj; colterm[lane] = uu; winter[lane] = __expf(a - mj); einv[lane] = __expf(-mj);
            const float blast = lshfl(bb, 63), gs = blast - bb + ic, gmax = wave_max(gs), mnew = fmaxf(blast + m_st, gmax);
            kws[lane] = __expf(gs - mnew);
            if (lane == 0) { scal[0] = __expf(blast + m_st - mnew); scal[1] = mnew; }
        }
        __syncthreads();
        for (int rpT = 0; rpT < REP_STILDE; ++rpT) {
            const int jj = tid >> 3, sub = tid & 7, s8 = sub * 8;
            const float rt = rowterm[jj]; float rsum = 0.f;
            const f32x4 ct0 = *(const LAS f32x4*)(colterm + s8), ct1 = *(const LAS f32x4*)(colterm + s8 + 4); const float ctv[8] = {ct0[0], ct0[1], ct0[2], ct0[3], ct1[0], ct1[1], ct1[2], ct1[3]};
#pragma unroll
            for (int e = 0; e < 8; ++e) { const int s = s8 + e; const float w = s <= jj ? sv[e] * 0.04419417382415922f * __expf(rt + ctv[e]) : 0.f; sv[e] = w; rsum += w; }
            *(LAS u32x4v*)(ST + jj * 128 + ((sub ^ (jj & 7)) << 4)) = pack8(sv);
            float qd = 0.f;
#pragma unroll
            for (int c8 = 0; c8 < 8; ++c8) { float qv[8]; unpack8(*(const LAS u32x4v*)(QS + jj * 1040 + (sub * 8 + c8) * 16), qv);
                { const f32x4 n0 = *(const LAS f32x4*)(nst + sub * 64 + c8 * 8), n1 = *(const LAS f32x4*)(nst + sub * 64 + c8 * 8 + 4);
                  qd += qv[0] * n0[0] + qv[1] * n0[1] + qv[2] * n0[2] + qv[3] * n0[3] + qv[4] * n1[0] + qv[5] * n1[1] + qv[6] * n1[2] + qv[7] * n1[3]; } }
            rsum += lshfl(rsum, lane ^ 1); rsum += lshfl(rsum, lane ^ 2); rsum += lshfl(rsum, lane ^ 4);
            qd += lshfl(qd, lane ^ 1); qd += lshfl(qd, lane ^ 2); qd += lshfl(qd, lane ^ 4);
            if (sub == 0) { const float qn = winter[jj] * qd + rsum; dinv[jj] = 1.0f / fmaxf(fabsf(qn), einv[jj]); }
        }
        __syncthreads();
        {
            f32x4 o[4];
            const int el = 16 * wv + fr;
            bf16x8 vfr[2];
            for (int rpM = 0; rpM < REP_MFMA; ++rpM) {
#pragma unroll
            for (int mt = 0; mt < 4; ++mt) o[mt] = (f32x4){0.f, 0.f, 0.f, 0.f};
#pragma unroll
            for (int ks = 0; ks < 16; ++ks) {
                u32x4v bw; bw.x = pg8::cvt_pk_bf16(C[2 * ks][0], C[2 * ks][1]); bw.y = pg8::cvt_pk_bf16(C[2 * ks][2], C[2 * ks][3]);
                bw.z = pg8::cvt_pk_bf16(C[2 * ks + 1][0], C[2 * ks + 1][1]); bw.w = pg8::cvt_pk_bf16(C[2 * ks + 1][2], C[2 * ks + 1][3]);
                const bf16x8 bfr = __builtin_bit_cast(bf16x8, bw);
#pragma unroll
                for (int mt = 0; mt < 4; ++mt) { const int off = (16 * mt + fr) * 1040 + 8 * fq;
                    const u32x2 lo = *(const LAS u32x2*)(QS + off + 64 * ks), hi = *(const LAS u32x2*)(QS + off + 64 * ks + 32);
                    u32x4v aw; aw.x = lo.x; aw.y = lo.y; aw.z = hi.x; aw.w = hi.y;
                    o[mt] = __builtin_amdgcn_mfma_f32_16x16x32_bf16(bfr, __builtin_bit_cast(bf16x8, aw), o[mt], 0, 0, 0); }
                if ((ks & 1) == 1) __builtin_amdgcn_sched_barrier(0); }
#pragma unroll
            for (int mt = 0; mt < 4; ++mt)
#pragma unroll
                for (int r = 0; r < 4; ++r) o[mt][r] *= winter[16 * mt + fr];
#pragma unroll
            for (int k2 = 0; k2 < 2; ++k2) { vfr[k2] = *(const LAS bf16x8*)(VT + el * 128 + (((4 * k2 + fq) ^ (el & 7)) << 4));
#pragma unroll
                for (int mt = 0; mt < 4; ++mt) { const int jr = 16 * mt + fr; const bf16x8 a = *(const LAS bf16x8*)(ST + jr * 128 + (((4 * k2 + fq) ^ (jr & 7)) << 4));
                    o[mt] = __builtin_amdgcn_mfma_f32_16x16x32_bf16(vfr[k2], a, o[mt], 0, 0, 0); } }
            }
#pragma unroll
            for (int mt = 0; mt < 4; ++mt)
                { const int jr = 16 * mt + fr, T = tok(jr); const float di = dinv[jr];
                    u16* dst = dir == 0 ? hf + (size_t)T * INNER : hb_ptr(kp, T); u32x2 w; w.x = pg8::cvt_pk_bf16(o[mt][0] * di, o[mt][1] * di); w.y = pg8::cvt_pk_bf16(o[mt][2] * di, o[mt][3] * di);
                    *(u32x2*)(dst + hd * DH + es * 128 + 16 * wv + 4 * fq) = w; }
            const float decay = scal[0];
#pragma unroll
            for (int i = 0; i < 32; ++i) C[i] = C[i] * decay;
            float kwv[2][8];
#pragma unroll
            for (int k2 = 0; k2 < 2; ++k2) { const f32x4 k0 = *(const LAS f32x4*)(kws + 32 * k2 + 8 * fq), k1 = *(const LAS f32x4*)(kws + 32 * k2 + 8 * fq + 4);
                kwv[k2][0] = k0[0]; kwv[k2][1] = k0[1]; kwv[k2][2] = k0[2]; kwv[k2][3] = k0[3]; kwv[k2][4] = k1[0]; kwv[k2][5] = k1[1]; kwv[k2][6] = k1[2]; kwv[k2][7] = k1[3]; }
#pragma unroll
            for (int k2 = 0; k2 < 2; ++k2) { float vv[8]; unpack8(__builtin_bit_cast(u32x4v, vfr[k2]), vv);
#pragma unroll
                for (int e = 0; e < 8; ++e) vv[e] *= kwv[k2][e];
                const bf16x8 bsc = __builtin_bit_cast(bf16x8, pack8(vv));
#pragma unroll
                for (int dt = 0; dt < 32; ++dt) { const int dr = 16 * dt + fr; const bf16x8 a = *(const LAS bf16x8*)(KT + dr * 128 + (((4 * k2 + fq) ^ (dr & 7)) << 4));
                    C[dt] = __builtin_amdgcn_mfma_f32_16x16x32_bf16(a, bsc, C[dt], 0, 0, 0);
                    if ((dt & 7) == 7) __builtin_amdgcn_sched_barrier(0); } }
            { float nn = decay * nst[tid];
#pragma unroll
              for (int g = 0; g < 8; ++g) { float kv[8]; unpack8(*(const LAS u32x4v*)(KT + tid * 128 + ((g ^ (tid & 7)) << 4)), kv);
                  { const f32x4 k0 = *(const LAS f32x4*)(kws + 8 * g), k1 = *(const LAS f32x4*)(kws + 8 * g + 4); nn += kv[0] * k0[0] + kv[1] * k0[1] + kv[2] * k0[2] + kv[3] * k0[3] + kv[4] * k1[0] + kv[5] * k1[1] + kv[6] * k1[2] + kv[7] * k1[3]; } }
              nst[tid] = nn; }
            m_st = scal[1];
        }
    }
}

__device__ __forceinline__ void ml_gate_phase(KPC kp, int j) {
    u16* hf = (u16*)(kp->ws + OFF_R2); const u16* xc = (const u16*)(kp->ws + OFF_XC); const u16* z = (const u16*)(kp->ws + OFF_XM);
    const float* ng = kp->in[I_MLNG] + (size_t)j * INNER; const float* sk = kp->in[I_MLSKIP] + (size_t)j * INNER;
    const int lane = ltid() & 63, wv = ltid() >> 6;
    for (int T = lbid() * 8 + wv; T < NTOK; T += gridDim.x * 8) {
        const u16* hbp = hb_ptr(kp, T);
#pragma unroll
        for (int hd = 0; hd < 4; ++hd) { const int c0 = hd * DH + lane * 8; float a[8], bq[8], xv[8], zv[8], o[8];
            unpack8(*(const u32x4v*)(hf + (size_t)T * INNER + c0), a); unpack8(*(const u32x4v*)(hbp + c0), bq);
            float s = 0.f;
#pragma unroll
            for (int e = 0; e < 8; ++e) { a[e] += bq[e]; s += a[e]; }
            const float mu = wave_sum(s) * (1.0f / DH); float vs = 0.f;
#pragma unroll
            for (int e = 0; e < 8; ++e) { a[e] -= mu; vs += a[e] * a[e]; }
            const float rs = rsqrtf(wave_sum(vs) * (1.0f / DH) + 1e-5f);
            unpack8(*(const u32x4v*)(xc + (size_t)T * INNER + c0), xv); unpack8(*(const u32x4v*)(z + (size_t)T * INNER + c0), zv);
            const f32x4 n0 = *(const f32x4*)(ng + c0), n1 = *(const f32x4*)(ng + c0 + 4), s0 = *(const f32x4*)(sk + c0), s1 = *(const f32x4*)(sk + c0 + 4);
            const float ngv[8] = {n0[0], n0[1], n0[2], n0[3], n1[0], n1[1], n1[2], n1[3]}, skv[8] = {s0[0], s0[1], s0[2], s0[3], s1[0], s1[1], s1[2], s1[3]};
#pragma unroll
            for (int e = 0; e < 8; ++e) o[e] = (a[e] * rs * ngv[e] + skv[e] * xv[e]) * siluf(zv[e]);
            *(u32x4v*)(hf + (size_t)T * INNER + c0) = pack8(o); }
    }
}


enum { K_SETUP = 0, K_CN, K_G1, K_G2R, K_HYIN, K_HYCONV, K_HYTR, K_MLUPX, K_MLPREP, K_MLSCAN, K_MLUPZ, K_MLGATE, K_FINAL };
constexpr int NPHASE = 1 + 11 + 13 + 11 + 13 + 1;
__device__ __forceinline__ void decode_phase(int ph, int& kind, int& l, int& arg) {
    kind = K_SETUP; l = 0; arg = 0; if (ph == 0) return;
    ph -= 1;
    for (l = 0; l < 4; ++l) { const int n = (l & 1) ? 13 : 11; if (ph < n) break; ph -= n; }
    if (l == 4) { kind = K_FINAL; l = 0; return; }
    if (ph == 0) { kind = K_CN; arg = 0; return; } if (ph == 1) { kind = K_G1; arg = 0; return; } if (ph == 2) { kind = K_G2R; arg = 0; return; } if (ph == 3) { kind = K_CN; arg = 1; return; }
    const int nm = (l & 1) ? 6 : 4;
    if (ph < 4 + nm) { const int q = ph - 4;
        if (l & 1) { kind = q == 0 ? K_MLUPX : q == 1 ? K_MLPREP : q == 2 ? K_MLSCAN : q == 3 ? K_MLUPZ : q == 4 ? K_MLGATE : K_G2R; arg = 2; }
        else { kind = q == 0 ? K_HYIN : q == 1 ? K_HYCONV : q == 2 ? K_HYTR : K_G2R; arg = 2; }
        return; }
    ph -= 4 + nm;
    if (ph == 0) { kind = K_CN; arg = 2; return; } if (ph == 1) { kind = K_G1; arg = 1; return; } kind = K_G2R; arg = 1;
}

__device__ __forceinline__ void gbar(unsigned* ctr, unsigned target) {
    __syncthreads();
    if (ltid() == 0) {
        __builtin_amdgcn_fence(__ATOMIC_RELEASE, "agent");
        __hip_atomic_fetch_add(ctr, 1u, __ATOMIC_RELAXED, __HIP_MEMORY_SCOPE_AGENT);
        while (__hip_atomic_load(ctr, __ATOMIC_RELAXED, __HIP_MEMORY_SCOPE_AGENT) < target) __builtin_amdgcn_s_sleep(2);
        __builtin_amdgcn_fence(__ATOMIC_ACQUIRE, "agent");
    }
    __syncthreads();
}
#ifndef REPMASK
#define REPMASK 0
#define REPN 1
#endif
template <int MIX> __device__ __forceinline__ void run_phases(int lo, int hi, int ph_lo, int ph_hi, LAS unsigned char* lds0, cg::grid_group& grid) {
    lo = lo > ph_lo ? lo : ph_lo; hi = hi < ph_hi ? hi : ph_hi;
    for (int ph = lo; ph < hi; ++ph) {
        KPC kp = (KPC)__builtin_amdgcn_kernarg_segment_ptr(); asm volatile("" : "+s"(kp) :: "memory");
        LAS unsigned char* lds = lds0; asm volatile("" : "+s"(lds) :: "memory");
        unsigned char* ws = kp->ws; unsigned char* wb = ws + OFF_WB;
        int kind, l, arg; decode_phase(ph, kind, l, arg); const int j = l >> 1;
        const float* modl = (const float*)(ws + OFF_MOD) + (size_t)l * 5 * 9216;
        const int nrep = ((REPMASK >> kind) & 1) ? REPN : 1;
        for (int rep = 0; rep < nrep; ++rep) {
        if (kind == K_SETUP) { if constexpr (MIX == 0) setup_phase(kp, (LAS float*)lds); }
        else if (kind == K_CN) {
            if (arg == 0) { convert_layer(kp, l, (LAS float*)lds); if constexpr (MIX == 1) ml_m_phase(kp, j); }
            if constexpr (MIX == 0) { if (arg == 1) hy_mlp_phase(kp, j); }
            norm_phase(kp, l, arg);
        } else if (kind == K_G1) {
            pg8::Gemm g{(const u16*)(ws + OFF_U), (const u16*)(wb + (arg ? WB_FIN1 : WB_FIN0)), NTOK, 2 * FF, D};
            pg8::StaticOrder S; S.init(g.M, g.N, (int)gridDim.x, lbid(), (l == 3 && arg == 1) ? 1 : 0); EpiSwiglu E{(u16*)(ws + OFF_R1)};
            pg8::gemm_phase<EpiSwiglu, pg8::StaticOrder, false>(lds, g, S, E, nullptr);
        } else if (kind == K_G2R) {
            pg8::Gemm g; EpiResid E; E.h = (float*)(ws + OFF_H); E.modl = modl;
            if (arg < 2) { g = pg8::Gemm{(const u16*)(ws + OFF_R1), (const u16*)(wb + (arg ? WB_FOUT1 : WB_FOUT0)), NTOK, D, FF}; E.gidx = arg ? 8 : 2; E.scale = 0.5f; E.bias = nullptr; }
            else if (MIX == 1) { g = pg8::Gemm{(const u16*)(ws + OFF_R2), (const u16*)(wb + WB_MOUT), NTOK, D, INNER}; E.gidx = 5; E.scale = 1.0f; E.bias = nullptr; }
            else { g = pg8::Gemm{(const u16*)(ws + OFF_U), (const u16*)(wb + WB_MOUT), NTOK, D, D}; E.gidx = 5; E.scale = 1.0f; E.bias = kp->in[I_HYBOUT] + (size_t)j * D; }
            pg8::StaticOrder S; S.init(g.M, g.N, (int)gridDim.x, lbid(), (l == 3 && arg >= 1) ? 1 : 0);
            pg8::gemm_phase<EpiResid, pg8::StaticOrder, false>(lds, g, S, E, nullptr);
        } else if (kind == K_FINAL) { if constexpr (MIX == 1) final_phase(kp); }
        else if constexpr (MIX == 0) {
            if (kind == K_HYIN) {
                pg8::Gemm g{(const u16*)(wb + WB_MIN), (const u16*)(ws + OFF_U), 3 * D, NTOK, D};
                pg8::StaticOrder S; S.init(g.M, g.N, (int)gridDim.x, lbid());
                EpiProjT E{(u16*)(ws + OFF_R1 + HY_PL), (u16*)(ws + OFF_R1 + HY_PC), kp->in[I_HYBIN] + (size_t)j * 3 * D};
                pg8::gemm_phase<EpiProjT, pg8::StaticOrder, false>(lds, g, S, E, nullptr);
                __syncthreads();
                for (int t = lbid(); t < 2048; t += gridDim.x) hy_filter_task(kp, j, t, (LAS f32x2*)lds, (LAS float*)(lds + 131072));
            } else if (kind == K_HYCONV) {
                for (int t = lbid(); t < 2048; t += gridDim.x) hy_conv_lat(kp, j, t, (LAS f32x2*)lds);
                for (int t = lbid(); t < 1024; t += gridDim.x) hy_conv_ctx(kp, j, t, (LAS float*)lds);
            } else if (kind == K_HYTR) hy_transpose(kp, (LAS u16*)lds);
        } else {
            if (kind == K_MLUPX || kind == K_MLUPZ) {
                const bool zz = kind == K_MLUPZ;
                pg8::Gemm g{(const u16*)(ws + OFF_U), (const u16*)(wb + WB_MIN) + (zz ? (size_t)INNER * D : 0), NTOK, INNER, D};
                pg8::StaticOrder S; S.init(g.M, g.N, (int)gridDim.x, lbid(), (zz && l == 3) ? 1 : 0); EpiBf E{(u16*)(ws + OFF_XM), INNER};
                pg8::gemm_phase<EpiBf, pg8::StaticOrder, false>(lds, g, S, E, nullptr);
            } else if (kind == K_MLPREP) { for (int t = lbid(); t < NB * NCH * 4; t += gridDim.x) ml_prep_task(kp, j, t, lds); }
            else if (kind == K_MLSCAN) { for (int t = lbid(); t < 128; t += gridDim.x) ml_scan_task(kp, j, t, lds); }
            else if (kind == K_MLGATE) ml_gate_phase(kp, j);
        }
        }
        if (ph + 1 < ph_hi) gbar((unsigned*)(kp->ws + OFF_MLM + 65536), (unsigned)(ph + 1 - ph_lo) * gridDim.x);
    }
}

__global__ void __launch_bounds__(512) fwd_megakernel(KP kparg) {
    extern __shared__ __attribute__((aligned(16))) unsigned char shm[];
    LAS unsigned char* lds = (LAS unsigned char*)shm;
    cg::grid_group grid = cg::this_grid();
    grid.sync();
    wtab_init();
    const int ph_lo = kparg.ph_lo, ph_hi = kparg.ph_hi;
    run_phases<0>(0, 12, ph_lo, ph_hi, lds, grid);
    run_phases<1>(12, 25, ph_lo, ph_hi, lds, grid);
    run_phases<0>(25, 36, ph_lo, ph_hi, lds, grid);
    run_phases<1>(36, 50, ph_lo, ph_hi, lds, grid);
}

extern "C" void kernel_launch(void* const* d_in, const int* in_sizes, int n_in, void* d_out, int out_size, void* d_ws, size_t ws_size, hipStream_t stream) {
    static int grid_blocks = 0;
    if (!grid_blocks) {
        int dev = 0, cus = 0, per_cu = 0;
        hipGetDevice(&dev);
        hipDeviceGetAttribute(&cus, hipDeviceAttributeMultiprocessorCount, dev);
        hipFuncSetAttribute((const void*)fwd_megakernel, hipFuncAttributeMaxDynamicSharedMemorySize, LDS_BYTES);
        hipOccupancyMaxActiveBlocksPerMultiprocessor(&per_cu, fwd_megakernel, 512, LDS_BYTES);
        if (per_cu < 1) per_cu = 1;
        grid_blocks = cus * 1;
        if (ws_size < WS_NEED2) fprintf(stderr, "workspace too small: %zu < %zu\n", ws_size, (size_t)WS_NEED2);
    }
    KP hp{};
    for (int i = 0; i < 36; ++i) hp.in[i] = (const float*)d_in[i];
    hp.out = (float*)d_out; hp.ws = (unsigned char*)d_ws; hp.ph_lo = 0; hp.ph_hi = NPHASE;
    void* args[] = {&hp};
    hipMemsetAsync((unsigned char*)d_ws + OFF_MLM + 65536, 0, 256, stream);
    hipError_t e = hipLaunchCooperativeKernel((void*)fwd_megakernel, dim3(grid_blocks), dim3(512), args, LDS_BYTES, stream);
    if (e != hipSuccess) fprintf(stderr, "cooperative launch failed: %s (grid %d)\n", hipGetErrorString(e), grid_blocks);
}
```

```cpp
#define REPMASK 0
#define REPN 1
#include <hip/hip_runtime.h>
#include <hip/hip_cooperative_groups.h>
#include <cstdio>
namespace cg = cooperative_groups;
#define WTAB_OFF 163584
__device__ __forceinline__ int llane() { int l; asm volatile("v_mbcnt_lo_u32_b32 %0, -1, 0\n\tv_mbcnt_hi_u32_b32 %0, -1, %0" : "=v"(l) :: "memory"); return l; }
__device__ __forceinline__ int lwave() { extern __shared__ __attribute__((aligned(16))) unsigned char shm_w[];
    const int hw = __builtin_amdgcn_s_getreg(10244) & 63;
    return __builtin_amdgcn_readfirstlane(*(const __attribute__((address_space(3))) int*)((__attribute__((address_space(3))) unsigned char*)shm_w + WTAB_OFF + hw * 4)); }
__device__ __forceinline__ void wtab_init() { extern __shared__ __attribute__((aligned(16))) unsigned char shm_w[];
    const int hw = __builtin_amdgcn_s_getreg(10244) & 63;
    *(__attribute__((address_space(3))) int*)((__attribute__((address_space(3))) unsigned char*)shm_w + WTAB_OFF + hw * 4) = (int)(threadIdx.x >> 6); }
__device__ __forceinline__ int ltid() { return lwave() * 64 + llane(); }
__device__ __forceinline__ int lbid() { int t = blockIdx.x; asm volatile("" : "+s"(t) :: "memory"); return t; }
namespace pg8 {
#define PG8_LAS __attribute__((address_space(3)))
typedef unsigned short bf16_t;
typedef short bf16x8 __attribute__((ext_vector_type(8)));
typedef float f32x4 __attribute__((ext_vector_type(4)));
typedef unsigned u32x4 __attribute__((ext_vector_type(4)));
constexpr int BM = 256, BK = 64, HALF = 128, HTB = HALF * BK * 2  , STAGE_BYTES = 8 * HTB, NXCD = 8, WGM = 8;

__host__ __device__ __forceinline__ int lds_byte(int r, int c) { const int st = (r >> 4) * 2 + (c >> 5), rr = r & 15, cc = c & 31, ob = rr * 64 + cc * 2; return st * 1024 + (ob ^ (((ob >> 9) & 1) << 5)); }
__host__ __device__ __forceinline__ void stage_rc(int b, int& R, int& C) { const int st = b / 1024, sb = b % 1024, swz = sb ^ (((sb >> 9) & 1) << 5); R = (st >> 1) * 16 + swz / 64; C = (st & 1) * 32 + (swz % 64) / 2; }
__host__ __device__ __forceinline__ int perm32(int rho) { const int n = rho >> 4, i = rho & 15; return 8 * (i >> 2) + 4 * n + (i & 3); }

struct Unit { int pm, pn, kofs; };
struct Gemm { const bf16_t* A; const bf16_t* Bt; int M, N, K, ldk; };

struct StaticOrder {
    int nM, nN, nwg, G, c, lat;
    __host__ __device__ void init(int M, int N, int G_, int c_, int lat_ = 0) { lat = lat_; nM = lat ? 128 : M / BM; nN = N / BM; nwg = nM * nN; G = G_; c = c_; }
    __host__ __device__ bool next(int i, Unit& u) const {
        const long L = (long)i * G + c; if (L >= nwg) return false;
        int wgid = (int)L; { const int q = nwg / NXCD, r = nwg % NXCD, xcd = wgid % NXCD, off = wgid / NXCD; wgid = (xcd < r ? xcd * (q + 1) : r * (q + 1) + (xcd - r) * q) + off; }
        const int nig = WGM * nN, gid = wgid / nig, fm = gid * WGM, gsz = (nM - fm) < WGM ? (nM - fm) : WGM;
        u.pm = fm + ((wgid % nig) % gsz); u.pn = (wgid % nig) / gsz; u.kofs = 0; if (lat) u.pm = (u.pm >> 5) * 33 + 1 + (u.pm & 31); return true;
    }
    __device__ __forceinline__ void a_ready(const Unit&) const {}
    __device__ __forceinline__ void done(const Unit&) const {}
};
__device__ __forceinline__ unsigned cvt_pk_bf16(float lo, float hi) { unsigned r; asm volatile("v_cvt_pk_bf16_f32 %0, %1, %2" : "=v"(r) : "v"(lo), "v"(hi)); return r; }
template <class Epi, class Sched, bool STAMP = false>
__device__ __forceinline__ void gemm_phase(PG8_LAS unsigned char* lds, const Gemm g, const Sched& S, const Epi& E, unsigned long long* stamps) {
    const int tid = ltid(), wid = __builtin_amdgcn_readfirstlane(tid >> 6), lane = tid & 63, wr = wid >> 2, wc = wid & 3, fr = lane & 15, fq = lane >> 4;
    const int K = g.K, nt = K / BK, ldk = g.ldk ? g.ldk : g.K;
    int ts_lo = 0, ts_hi = 0, nts = 0; const unsigned long long rt_entry = STAMP ? (unsigned long long)wall_clock64() : 0ull;
#define PG8_STAMP() do { if (STAMP && wid == 0 && nts < 64) { const unsigned long long _c = (unsigned long long)clock64(); \
        ts_lo = (lane == nts) ? (int)(unsigned)_c : ts_lo; ts_hi = (lane == nts) ? (int)(unsigned)(_c >> 32) : ts_hi; ++nts; } } while (0)
    PG8_STAMP();
    unsigned voffA[2], voffB[2];
#pragma unroll
    for (int i = 0; i < 2; ++i) { int R, C; stage_rc(tid * 16 + i * 8192, R, C); const int Rb = Epi::PERM ? ((R & ~31) + perm32(R & 31)) : R;
        voffA[i] = (unsigned)(R * ldk + C) * 2u; voffB[i] = (unsigned)(Rb * ldk + C) * 2u; }
    const size_t kstep = (size_t)(BK * 2);
    const size_t hstep = (size_t)HALF * ldk * 2;
    const size_t tstep = 2 * hstep;
    const unsigned ldsw = (unsigned)wid * 1024u;
    const int aoff = lds_byte(wr * 64 + fr, fq * 8), boff = lds_byte(wc * 32 + fr, fq * 8);
#define PG8_SA(b, h) (((b) * 2 + (h)) * HTB)
#define PG8_SB(b, h) ((4 + (b) * 2 + (h)) * HTB)
#define PG8_STAGE(bufoff, gbase, voff) do { _Pragma("unroll") for (int _i = 0; _i < 2; ++_i) \
        __builtin_amdgcn_global_load_lds((const unsigned*)((const char*)(gbase) + (voff)[_i]), (PG8_LAS unsigned*)(lds + (bufoff) + ldsw + _i * 8192), 16, 0, 0); } while (0)
#define PG8_LDA(dst, b, h) do { _Pragma("unroll") for (int m = 0; m < 4; ++m) _Pragma("unroll") for (int k = 0; k < 2; ++k) dst[m][k] = *(const PG8_LAS bf16x8*)(lds + PG8_SA(b, h) + aoff + m * 2048 + k * 1024); } while (0)
#define PG8_LDB(dst, b, h) do { _Pragma("unroll") for (int n = 0; n < 2; ++n) _Pragma("unroll") for (int k = 0; k < 2; ++k) dst[n][k] = *(const PG8_LAS bf16x8*)(lds + PG8_SB(b, h) + boff + n * 2048 + k * 1024); } while (0)
#define PG8_MMA(ai, bj, At, Bt) do { __builtin_amdgcn_s_setprio(1); _Pragma("unroll") for (int m = 0; m < 4; ++m) _Pragma("unroll") for (int n = 0; n < 2; ++n) _Pragma("unroll") for (int k = 0; k < 2; ++k) \
        acc[ai][bj][m][n] = __builtin_amdgcn_mfma_f32_16x16x32_bf16(Bt[n][k], At[m][k], acc[ai][bj][m][n], 0, 0, 0); __builtin_amdgcn_s_setprio(0); } while (0)
#define PG8_WAIT_V(n) asm volatile("s_waitcnt vmcnt(" #n ")" ::: "memory")
#define PG8_WAIT_L(n) asm volatile("s_waitcnt lgkmcnt(" #n ")" ::: "memory")
#define PG8_BAR __builtin_amdgcn_s_barrier()
#define PG8_SCHED __builtin_amdgcn_sched_barrier(0)
    Unit cur, nxt; int ui = 0;
    if (!S.next(0, cur)) return;
    f32x4 acc[2][2][4][2];
#pragma unroll
    for (int a = 0; a < 2; ++a)
#pragma unroll
        for (int b = 0; b < 2; ++b)
#pragma unroll
            for (int m = 0; m < 4; ++m)
#pragma unroll
                for (int n = 0; n < 2; ++n) acc[a][b][m][n] = (f32x4){0.f, 0.f, 0.f, 0.f};
    bf16x8 At[4][2], B0[2][2], B1[2][2];
    const char* cA = (const char*)g.A + (size_t)cur.pm * tstep + (size_t)cur.kofs * 2; const char* cB = (const char*)g.Bt + (size_t)cur.pn * tstep + (size_t)cur.kofs * 2;
    S.a_ready(cur);
    PG8_STAGE(PG8_SB(0, 0), cB, voffB); PG8_STAGE(PG8_SA(0, 0), cA, voffA); PG8_STAGE(PG8_SB(0, 1), cB + hstep, voffB); PG8_STAGE(PG8_SA(0, 1), cA + hstep, voffA);
    if (wr == 1) PG8_BAR;
    PG8_WAIT_V(4); PG8_BAR;
    PG8_STAGE(PG8_SB(1, 0), cB + kstep, voffB); PG8_STAGE(PG8_SA(1, 0), cA + kstep, voffA); PG8_STAGE(PG8_SB(1, 1), cB + hstep + kstep, voffB);
    PG8_WAIT_V(6); PG8_BAR;
    PG8_STAMP();
    for (;;) {
        const bool has_next = S.next(ui + 1, nxt);
        const char* nA = has_next ? (const char*)g.A + (size_t)nxt.pm * tstep + (size_t)nxt.kofs * 2 : cA; const char* nB = has_next ? (const char*)g.Bt + (size_t)nxt.pn * tstep + (size_t)nxt.kofs * 2 : cB;
        for (int t = 0; t < nt; t += 2) {
            const bool last = (t == nt - 2);
            const char* a1 = cA + (size_t)(t + 1) * kstep;
            const char* a2 = last ? nA : cA + (size_t)(t + 2) * kstep; const char* b2 = last ? nB : cB + (size_t)(t + 2) * kstep;
            const char* a3 = a2 + kstep; const char* b3 = b2 + kstep;
            if (last && has_next) S.a_ready(nxt);
            PG8_LDB(B0, 0, 0); PG8_SCHED; PG8_LDA(At, 0, 0); PG8_STAGE(PG8_SA(1, 1), a1 + hstep, voffA);
            PG8_WAIT_L(8); PG8_BAR; PG8_WAIT_L(0); PG8_MMA(0, 0, At, B0); PG8_BAR; PG8_SCHED;
            PG8_LDB(B1, 0, 1); PG8_STAGE(PG8_SB(0, 0), b2, voffB);
            PG8_BAR; PG8_WAIT_L(0); PG8_MMA(0, 1, At, B1); PG8_BAR;
            PG8_LDA(At, 0, 1); PG8_STAGE(PG8_SA(0, 0), a2, voffA);
            PG8_BAR; PG8_WAIT_L(0); PG8_MMA(1, 0, At, B0); PG8_BAR; PG8_SCHED;
            PG8_STAGE(PG8_SB(0, 1), b2 + hstep, voffB);
            PG8_WAIT_V(6); PG8_BAR; PG8_MMA(1, 1, At, B1); PG8_BAR;
            PG8_LDB(B0, 1, 0); PG8_SCHED; PG8_LDA(At, 1, 0); PG8_STAGE(PG8_SA(0, 1), a2 + hstep, voffA);
            PG8_WAIT_L(8); PG8_BAR; PG8_WAIT_L(0); PG8_MMA(0, 0, At, B0); PG8_BAR; PG8_SCHED;
            PG8_LDB(B1, 1, 1); PG8_STAGE(PG8_SB(1, 0), b3, voffB);
            PG8_BAR; PG8_WAIT_L(0); PG8_MMA(0, 1, At, B1); PG8_BAR;
            PG8_LDA(At, 1, 1); PG8_STAGE(PG8_SA(1, 0), a3, voffA);
            PG8_BAR; PG8_WAIT_L(0); PG8_MMA(1, 0, At, B0); PG8_BAR; PG8_SCHED;
            PG8_STAGE(PG8_SB(1, 1), b3 + hstep, voffB);
            PG8_WAIT_V(6); PG8_BAR; PG8_MMA(1, 1, At, B1); PG8_BAR;
        }
        PG8_STAMP();
        if constexpr (!Epi::AFTER_DRAIN) { E(acc, cur, wr, wc, fr, fq); S.done(cur); }
        PG8_STAMP();
        if (!has_next) break;
#pragma unroll
        for (int a = 0; a < 2; ++a)
#pragma unroll
            for (int b = 0; b < 2; ++b)
#pragma unroll
                for (int m = 0; m < 4; ++m)
#pragma unroll
                    for (int n = 0; n < 2; ++n) acc[a][b][m][n] = (f32x4){0.f, 0.f, 0.f, 0.f};
        cur = nxt; cA = nA; cB = nB; ++ui;
    }
    PG8_WAIT_V(0);
    if (wr == 0) PG8_BAR;
    PG8_BAR;
    if constexpr (Epi::AFTER_DRAIN) { E.fused(acc, cur, wr, wc, fr, fq, lds, wid, lane); S.done(cur); }
    PG8_STAMP();
    if (STAMP && wid == 0) { stamps[lane] = lane < nts ? (((unsigned long long)(unsigned)ts_hi << 32) | (unsigned)ts_lo) : 0ull;
        if (lane == 62) stamps[62] = rt_entry; if (lane == 63) stamps[63] = (unsigned long long)wall_clock64(); }
#undef PG8_STAMP
#undef PG8_SA
#undef PG8_SB
#undef PG8_STAGE
#undef PG8_LDA
#undef PG8_LDB
#undef PG8_MMA
#undef PG8_WAIT_V
#undef PG8_WAIT_L
#undef PG8_BAR
#undef PG8_SCHED
}
}

typedef unsigned short u16;
using pg8::f32x4; using pg8::bf16x8;
typedef float f32x2 __attribute__((ext_vector_type(2)));
typedef unsigned u32x2 __attribute__((ext_vector_type(2)));
typedef unsigned u32x4v __attribute__((ext_vector_type(4)));
typedef short s16x4 __attribute__((ext_vector_type(4)));
#define LAS __attribute__((address_space(3)))
constexpr int D = 1024, NB = 4, SEQ = 8192, CTX = 256, TPB = 8448, NTOK = 33792, FF = 2816, NCH = 132, INNER = 2048, DH = 512, NFFT = 16384;
constexpr size_t MiB = 1u << 20;
constexpr size_t OFF_WB = 0, OFF_MOD = 48 * MiB, OFF_H = 49 * MiB, OFF_U = OFF_H + 132 * MiB, OFF_R1 = OFF_U + 66 * MiB, OFF_R2 = OFF_R1 + 264 * MiB,
                 OFF_HBC = OFF_R2 + 132 * MiB, OFF_GATES = OFF_HBC + 4 * MiB, OFF_H2 = OFF_GATES + 3 * MiB, OFF_KCTX = OFF_H2 + 3 * MiB, WS_NEED = OFF_KCTX + 4 * MiB;
constexpr size_t WB_FIN0 = 0, WB_FIN1 = 11 * MiB, WB_FOUT0 = 22 * MiB, WB_FOUT1 = 22 * MiB + 5632 * 1024, WB_MIN = 33 * MiB, WB_MOUT = 41 * MiB, WB_WGT = 45 * MiB;
constexpr int LDS_BYTES = 163840;
struct KP { const float* in[36]; float* out; unsigned char* ws; int ph_lo, ph_hi; };
typedef const KP __attribute__((address_space(4))) * KPC;
enum { I_X = 0, I_C, I_CTX, I_CCTX, I_ADAW, I_ADAB, I_NORMG, I_FINALG, I_FFNIN, I_FFNOUT, I_HYWIN, I_HYBIN, I_HYCW, I_HYCB, I_HYW1, I_HYB1, I_HYW2, I_HYB2, I_HYW3, I_HYB3,
       I_HYFREQ, I_HYDECAY, I_HYSKIP, I_HYWOUT, I_HYBOUT, I_MLUP, I_MLCW, I_MLCB, I_MLWQ, I_MLWK, I_MLWV, I_MLWG, I_MLBG, I_MLNG, I_MLSKIP, I_MLDOWN };

__device__ __forceinline__ float bf2f(u16 b) { return __uint_as_float(((unsigned)b) << 16); }
__device__ __forceinline__ float bflo(unsigned w) { return __uint_as_float(w << 16); }
__device__ __forceinline__ float bfhi(unsigned w) { return __uint_as_float(w & 0xffff0000u); }
__device__ __forceinline__ u16 f2bf(float f) { return (u16)(pg8::cvt_pk_bf16(f, 0.f) & 0xffffu); }
__device__ __forceinline__ float siluf(float x) { return x / (1.0f + __expf(-x)); }
__device__ __forceinline__ int modrow_of_token(int T) { const int b = T / TPB, t = T - b * TPB; return t < CTX ? 4 : b; }
__device__ __forceinline__ float lshfl(float v, int srclane) { return __int_as_float(__builtin_amdgcn_ds_bpermute(srclane << 2, __float_as_int(v))); }
__device__ __forceinline__ float wave_sum(float v) { const int lane = llane();
#pragma unroll
    for (int o = 32; o > 0; o >>= 1) v += lshfl(v, lane ^ o);
    return v; }
__device__ __forceinline__ float wave_max(float v) { const int lane = llane();
#pragma unroll
    for (int o = 32; o > 0; o >>= 1) v = fmaxf(v, lshfl(v, lane ^ o));
    return v; }

__device__ __forceinline__ void unpack8(u32x4v w, float (&f)[8]) { f[0] = bflo(w.x); f[1] = bfhi(w.x); f[2] = bflo(w.y); f[3] = bfhi(w.y); f[4] = bflo(w.z); f[5] = bfhi(w.z); f[6] = bflo(w.w); f[7] = bfhi(w.w); }
__device__ __forceinline__ u32x4v pack8(const float (&f)[8]) { u32x4v w; w.x = pg8::cvt_pk_bf16(f[0], f[1]); w.y = pg8::cvt_pk_bf16(f[2], f[3]); w.z = pg8::cvt_pk_bf16(f[4], f[5]); w.w = pg8::cvt_pk_bf16(f[6], f[7]); return w; }

struct EpiSwiglu {
    static constexpr bool PERM = true, AFTER_DRAIN = false;
    u16* act;
    __device__ __forceinline__ void operator()(const f32x4 (&acc)[2][2][4][2], const pg8::Unit& u, int wr, int wc, int fr, int fq) const {
        const int row0 = u.pm * 256 + wr * 64 + fr, col0 = u.pn * 128 + wc * 32 + 8 * fq;
#pragma unroll
        for (int ai = 0; ai < 2; ++ai)
#pragma unroll
            for (int m = 0; m < 4; ++m) {
                const f32x4 g0 = acc[ai][0][m][0], g1 = acc[ai][0][m][1], v0 = acc[ai][1][m][0], v1 = acc[ai][1][m][1];
                u32x4v w;
                w.x = pg8::cvt_pk_bf16(siluf(g0[0]) * v0[0], siluf(g0[1]) * v0[1]); w.y = pg8::cvt_pk_bf16(siluf(g0[2]) * v0[2], siluf(g0[3]) * v0[3]);
                w.z = pg8::cvt_pk_bf16(siluf(g1[0]) * v1[0], siluf(g1[1]) * v1[1]); w.w = pg8::cvt_pk_bf16(siluf(g1[2]) * v1[2], siluf(g1[3]) * v1[3]);
                *(u32x4v*)(act + (size_t)(row0 + ai * 128 + m * 16) * FF + col0) = w; }
    }
};
struct EpiResid {
    static constexpr bool PERM = false, AFTER_DRAIN = false;
    float* h; const float* modl; int gidx; float scale; const float* bias;
    __device__ __forceinline__ void operator()(const f32x4 (&acc)[2][2][4][2], const pg8::Unit& u, int wr, int wc, int fr, int fq) const {
        const int row0 = u.pm * 256 + wr * 64 + fr, col0 = u.pn * 256 + wc * 32 + 4 * fq;
        const int mr = modrow_of_token(u.pm * 256);
        const float* gp = modl + (size_t)mr * 9216 + gidx * 1024;
        f32x4 gv[2][2], bv[2][2];
#pragma unroll
        for (int bj = 0; bj < 2; ++bj)
#pragma unroll
            for (int n = 0; n < 2; ++n) { gv[bj][n] = *(const f32x4*)(gp + col0 + bj * 128 + n * 16) * scale;
                bv[bj][n] = bias ? *(const f32x4*)(bias + col0 + bj * 128 + n * 16) : (f32x4){0.f, 0.f, 0.f, 0.f}; }
#pragma unroll
        for (int ai = 0; ai < 2; ++ai)
#pragma unroll
            for (int m = 0; m < 4; ++m) { float* rowp = h + (size_t)(row0 + ai * 128 + m * 16) * D + col0;
#pragma unroll
                for (int bj = 0; bj < 2; ++bj)
#pragma unroll
                    for (int n = 0; n < 2; ++n) { f32x4* q = (f32x4*)(rowp + bj * 128 + n * 16); *q = *q + gv[bj][n] * (acc[ai][bj][m][n] + bv[bj][n]); } }
    }
};
struct EpiBf {
    static constexpr bool PERM = true, AFTER_DRAIN = false;
    u16* O; int ldc;
    __device__ __forceinline__ void operator()(const f32x4 (&acc)[2][2][4][2], const pg8::Unit& u, int wr, int wc, int fr, int fq) const {
        const int row0 = u.pm * 256 + wr * 64 + fr, col0 = u.pn * 256 + wc * 32 + 8 * fq;
#pragma unroll
        for (int ai = 0; ai < 2; ++ai)
#pragma unroll
            for (int m = 0; m < 4; ++m)
#pragma unroll
                for (int bj = 0; bj < 2; ++bj) { const f32x4 a = acc[ai][bj][m][0], b = acc[ai][bj][m][1]; u32x4v w;
                    w.x = pg8::cvt_pk_bf16(a[0], a[1]); w.y = pg8::cvt_pk_bf16(a[2], a[3]); w.z = pg8::cvt_pk_bf16(b[0], b[1]); w.w = pg8::cvt_pk_bf16(b[2], b[3]);
                    *(u32x4v*)(O + (size_t)(row0 + ai * 128 + m * 16) * ldc + col0 + bj * 128) = w; }
    }
};
struct EpiProjT {
    static constexpr bool PERM = true, AFTER_DRAIN = false;
    u16* lat; u16* ctx; const float* bias;
    __device__ __forceinline__ void operator()(const f32x4 (&acc)[2][2][4][2], const pg8::Unit& u, int wr, int wc, int fr, int fq) const {
        const int row0 = u.pm * 256 + wr * 64 + fr, tc0 = wc * 32 + 8 * fq;
        const int b = u.pn / 33, tile = u.pn - b * 33;
#pragma unroll
        for (int ai = 0; ai < 2; ++ai)
#pragma unroll
            for (int m = 0; m < 4; ++m) { const int ch = row0 + ai * 128 + m * 16; const float bs = bias[ch];
                u16* dst = tile == 0 ? ctx + ((size_t)b * 3072 + ch) * CTX + tc0 : lat + ((size_t)b * 3072 + ch) * SEQ + (tile - 1) * 256 + tc0;
#pragma unroll
                for (int bj = 0; bj < 2; ++bj) { const f32x4 a = acc[ai][bj][m][0] + bs, c = acc[ai][bj][m][1] + bs; u32x4v w;
                    w.x = pg8::cvt_pk_bf16(a[0], a[1]); w.y = pg8::cvt_pk_bf16(a[2], a[3]); w.z = pg8::cvt_pk_bf16(c[0], c[1]); w.w = pg8::cvt_pk_bf16(c[2], c[3]);
                    *(u32x4v*)(dst + bj * 128) = w; } }
    }
};


struct LatOrder : pg8::StaticOrder {
    __device__ bool next(int i, pg8::Unit& u) const { if (!pg8::StaticOrder::next(i, u)) return false; u.pm = (u.pm >> 5) * 33 + 1 + (u.pm & 31); return true; }
};
struct CtxSplitOrder {
    int nk, G, c;
    __device__ bool next(int i, pg8::Unit& u) const { const int L = i * G + c; if (L >= 16 * nk) return false; const int un = L & 15, kc = L >> 4; u.pm = (un >> 2) * 33; u.pn = un & 3; u.kofs = kc * 256; return true; }
    __device__ __forceinline__ void a_ready(const pg8::Unit&) const {}
    __device__ __forceinline__ void done(const pg8::Unit&) const {}
};
struct EpiResidAtomic {
    static constexpr bool PERM = false, AFTER_DRAIN = false;
    float* h; const float* gp; float scale;
    __device__ __forceinline__ void operator()(const f32x4 (&acc)[2][2][4][2], const pg8::Unit& u, int wr, int wc, int fr, int fq) const {
        const int row0 = u.pm * 256 + wr * 64 + fr, col0 = u.pn * 256 + wc * 32 + 4 * fq;
#pragma unroll
        for (int bj = 0; bj < 2; ++bj)
#pragma unroll
            for (int n = 0; n < 2; ++n) { const f32x4 gv = *(const f32x4*)(gp + col0 + bj * 128 + n * 16) * scale;
#pragma unroll
                for (int ai = 0; ai < 2; ++ai)
#pragma unroll
                    for (int m = 0; m < 4; ++m) { float* q = h + (size_t)(row0 + ai * 128 + m * 16) * D + col0 + bj * 128 + n * 16; const f32x4 v = gv * acc[ai][bj][m][n];
                        atomicAdd(q, v[0]); atomicAdd(q + 1, v[1]); atomicAdd(q + 2, v[2]); atomicAdd(q + 3, v[3]); } }
    }
};

__device__ __forceinline__ void ctx_bias_phase(KPC kp, const float* gp, const float* bias) {
    float* h = (float*)(kp->ws + OFF_H);
    for (int i = lbid() * 512 + ltid(); i < NB * CTX * 256; i += gridDim.x * 512) { const int r = i >> 8, c = (i & 255) * 4, b = r >> 8, t = r & 255;
        f32x4* q = (f32x4*)(h + ((size_t)b * TPB + t) * D + c); *q = *q + *(const f32x4*)(gp + c) * *(const f32x4*)(bias + c); }
}
__device__ __forceinline__ int colmap(int n, int mapmode) { return mapmode ? (((n >> 8) << 7) + (n & 127) + ((n >> 7) & 1) * FF) : n; }
__device__ __forceinline__ void convert_T(const float* __restrict__ src, int ld, int K, int Nd, int mapmode, u16* __restrict__ dst, LAS float* tile, int& tctr) {
    const int tid = ltid(), nkt = K / 64, ntile = (Nd / 64) * nkt;
    const int G = (int)gridDim.x; const int first = (((lbid() - tctr) % G) + G) % G; tctr += ntile;
    for (int t = first; t < ntile; t += G) {
        const int n0 = (t / nkt) * 64, k0 = (t % nkt) * 64, c0 = colmap(n0, mapmode);
#pragma unroll
        for (int i = 0; i < 2; ++i) { const int e = tid + 512 * i, kr = e >> 4, c4 = (e & 15) * 4;
            const f32x4 v = *(const f32x4*)(src + (size_t)(k0 + kr) * ld + c0 + c4);
            tile[kr * 65 + c4] = v[0]; tile[kr * 65 + c4 + 1] = v[1]; tile[kr * 65 + c4 + 2] = v[2]; tile[kr * 65 + c4 + 3] = v[3]; }
        __syncthreads();
        { const int n = tid >> 3, k8 = (tid & 7) * 8; u32x4v w;
          w.x = pg8::cvt_pk_bf16(tile[(k8 + 0) * 65 + n], tile[(k8 + 1) * 65 + n]); w.y = pg8::cvt_pk_bf16(tile[(k8 + 2) * 65 + n], tile[(k8 + 3) * 65 + n]);
          w.z = pg8::cvt_pk_bf16(tile[(k8 + 4) * 65 + n], tile[(k8 + 5) * 65 + n]); w.w = pg8::cvt_pk_bf16(tile[(k8 + 6) * 65 + n], tile[(k8 + 7) * 65 + n]);
          *(u32x4v*)(dst + (size_t)(n0 + n) * K + k0 + k8) = w; }
        __syncthreads();
    }
}

__device__ __forceinline__ void norm_phase(KPC kp, int l, int sub) {
    const float* h = (const float*)(kp->ws + OFF_H); u16* uo = (u16*)(kp->ws + OFF_U);
    const float* g = kp->in[I_NORMG] + (size_t)(l * 3 + sub) * D; const float* modl = (const float*)(kp->ws + OFF_MOD) + (size_t)l * 5 * 9216;
    const int lane = ltid() & 63, wv = ltid() >> 6;
    for (int T = lbid() * 8 + wv; T < NTOK; T += gridDim.x * 8) {
        const float* hr = h + (size_t)T * D; f32x4 v[4]; float ss = 0.f;
#pragma unroll
        for (int i = 0; i < 4; ++i) { v[i] = *(const f32x4*)(hr + i * 256 + lane * 4); ss += v[i][0] * v[i][0] + v[i][1] * v[i][1] + v[i][2] * v[i][2] + v[i][3] * v[i][3]; }
        ss = wave_sum(ss); const float rs = rsqrtf(ss * (1.0f / D) + 1e-6f);
        const float* mp = modl + (size_t)modrow_of_token(T) * 9216 + sub * 3 * 1024;
#pragma unroll
        for (int i = 0; i < 4; ++i) { const int c = i * 256 + lane * 4; const f32x4 gg = *(const f32x4*)(g + c), sh = *(const f32x4*)(mp + c), sc = *(const f32x4*)(mp + 1024 + c);
            const f32x4 o = v[i] * rs * gg * (sc + 1.0f) + sh; u32x2 w; w.x = pg8::cvt_pk_bf16(o[0], o[1]); w.y = pg8::cvt_pk_bf16(o[2], o[3]);
            *(u32x2*)(uo + (size_t)T * D + c) = w; }
    }
}

__device__ __forceinline__ void final_phase(KPC kp) {
    const float* h = (const float*)(kp->ws + OFF_H); const float* g = kp->in[I_FINALG];
    const int lane = ltid() & 63, wv = ltid() >> 6;
    for (int r = lbid() * 8 + wv; r < NB * SEQ; r += gridDim.x * 8) {
        const int b = r / SEQ, s = r - b * SEQ; const float* hr = h + ((size_t)b * TPB + CTX + s) * D; f32x4 v[4]; float ss = 0.f;
#pragma unroll
        for (int i = 0; i < 4; ++i) { v[i] = *(const f32x4*)(hr + i * 256 + lane * 4); ss += v[i][0] * v[i][0] + v[i][1] * v[i][1] + v[i][2] * v[i][2] + v[i][3] * v[i][3]; }
        ss = wave_sum(ss); const float rs = rsqrtf(ss * (1.0f / D) + 1e-6f);
#pragma unroll
        for (int i = 0; i < 4; ++i) { const int c = i * 256 + lane * 4; *(f32x4*)(kp->out + (size_t)r * D + c) = v[i] * rs * *(const f32x4*)(g + c); }
    }
}

__device__ __forceinline__ void setup_phase(KPC kp, LAS float* ldsf) {
    float* h = (float*)(kp->ws + OFF_H); const int tid = ltid();
    const int hb0 = gridDim.x > 64 ? 32 : 0;
    for (size_t i = (size_t)(lbid() - hb0) * 512 + tid; lbid() >= hb0 && i < (size_t)NTOK * 256; i += (size_t)(gridDim.x - hb0) * 512) {
        const int T = (int)(i >> 8), c = ((int)i & 255) * 4, b = T / TPB, t = T - b * TPB; f32x4 v;
        if (t < CTX) v = *(const f32x4*)(kp->in[I_CTX] + ((size_t)b * CTX + t) * D + c);
        else { const int s = t - CTX; v = *(const f32x4*)(kp->in[I_X] + ((size_t)b * SEQ + s) * D + c);
            const int half = c >> 9, cc = c & 511, isc = cc >> 8, i0 = cc & 255; const float pv = half ? (float)(s & 63) : (float)(s >> 6);
#pragma unroll
            for (int e = 0; e < 4; ++e) { const float om = exp2f(-13.287712379549449f * (float)(i0 + e) * (1.0f / 256.0f)); const float ang = pv * om; v[e] += isc ? __cosf(ang) : __sinf(ang); } }
        *(f32x4*)(h + (size_t)T * D + c) = v;
    }
    LAS float* sc = ldsf; LAS float* red = ldsf + 5 * 1024;
    for (int i = tid; i < 5 * 1024; i += 512) { const int r = i >> 10, k = i & 1023; const float cv = r < 4 ? kp->in[I_C][r * D + k] : kp->in[I_CCTX][k]; sc[i] = siluf(cv); }
    __syncthreads();
    float* mod = (float*)(kp->ws + OFF_MOD); const int lane = tid & 63, wv = tid >> 6;
    for (int task = lbid(); task < 288; task += gridDim.x) {
        const int l = task / 72, n0 = (task % 72) * 128 + lane * 2; const float* w = kp->in[I_ADAW] + (size_t)l * D * 9216 + n0;
        f32x2 a[5];
#pragma unroll
        for (int r = 0; r < 5; ++r) a[r] = (f32x2){0.f, 0.f};
#pragma unroll 16
        for (int k = wv * 128; k < wv * 128 + 128; ++k) { const f32x2 wv2 = *(const f32x2*)(w + (size_t)k * 9216);
#pragma unroll
            for (int r = 0; r < 5; ++r) a[r] += wv2 * sc[r * 1024 + k]; }
#pragma unroll
        for (int r = 0; r < 5; ++r) { red[(wv * 5 + r) * 128 + lane * 2] = a[r][0]; red[(wv * 5 + r) * 128 + lane * 2 + 1] = a[r][1]; }
        __syncthreads();
        for (int i = tid; i < 640; i += 512) { const int r = i >> 7, n = i & 127; float s = 0.f;
#pragma unroll
            for (int w8 = 0; w8 < 8; ++w8) s += red[(w8 * 5 + r) * 128 + n];
            const int nn = (task % 72) * 128 + n; mod[((size_t)l * 5 + r) * 9216 + nn] = s + kp->in[I_ADAB][(size_t)l * 9216 + nn]; }
        __syncthreads();
    }
}

__device__ __forceinline__ void convert_layer(KPC kp, int l, LAS float* tile) {
    unsigned char* wb = kp->ws + OFF_WB; int tctr = 0; const int j = l >> 1;
    for (int f = 0; f < 2; ++f) {
        convert_T(kp->in[I_FFNIN] + (size_t)(l * 2 + f) * D * 2 * FF, 2 * FF, D, 2 * FF, 1, (u16*)(wb + (f ? WB_FIN1 : WB_FIN0)), tile, tctr);
        convert_T(kp->in[I_FFNOUT] + (size_t)(l * 2 + f) * FF * D, D, FF, D, 0, (u16*)(wb + (f ? WB_FOUT1 : WB_FOUT0)), tile, tctr);
    }
    if ((l & 1) == 0) {
        convert_T(kp->in[I_HYWIN] + (size_t)j * D * 3 * D, 3 * D, D, 3 * D, 0, (u16*)(wb + WB_MIN), tile, tctr);
        convert_T(kp->in[I_HYWOUT] + (size_t)j * D * D, D, D, D, 0, (u16*)(wb + WB_MOUT), tile, tctr);
    } else {
        convert_T(kp->in[I_MLUP] + (size_t)j * D * 2 * INNER, 2 * INNER, D, 2 * INNER, 0, (u16*)(wb + WB_MIN), tile, tctr);
        convert_T(kp->in[I_MLDOWN] + (size_t)j * INNER * D, D, INNER, D, 0, (u16*)(wb + WB_MOUT), tile, tctr);
        u16* wg = (u16*)(wb + WB_WGT); const float* src = kp->in[I_MLWG] + (size_t)j * 3 * INNER * 16;
        for (int i = lbid() * 512 + ltid(); i < 16 * 3 * INNER; i += gridDim.x * 512) { const int o = i / (3 * INNER), k = i - o * 3 * INNER; wg[i] = f2bf(src[(size_t)k * 16 + o]); }
        float* gates = (float*)(kp->ws + OFF_GATES); const float* bg = kp->in[I_MLBG] + j * 16;
        for (int i = lbid() * 512 + ltid(); i < NTOK * 16; i += gridDim.x * 512) gates[i] = bg[i & 15];
    }
}

constexpr size_t HY_PL = 0, HY_PC = (size_t)NB * 3072 * SEQ * 2, HY_YL = HY_PC + (size_t)NB * 3072 * CTX * 2, HY_YC = HY_YL + (size_t)NB * D * SEQ * 2;
__device__ __forceinline__ int fphys(int i) { return i ^ ((((i >> 6) & 1) * 21) ^ (((i >> 5) & 1) * 10)); }
__device__ __forceinline__ f32x2 cmul(f32x2 a, f32x2 b) { return (f32x2){a.x * b.x - a.y * b.y, a.x * b.y + a.y * b.x}; }
__device__ __forceinline__ f32x2 cmulc(f32x2 a, f32x2 b) { return (f32x2){a.x * b.x + a.y * b.y, a.y * b.x - a.x * b.y}; }
__device__ __forceinline__ int drev(int x) { const unsigned r = __brev((unsigned)x) >> 18; return (int)(((r & 0x2AAAu) >> 1) | ((r & 0x1555u) << 1)); }

__device__ __forceinline__ void fidx4(int base, int lm, int (&ix)[4]) {
    const int m = 1 << lm;
    if (lm == 6) { const int i0 = fphys(base); ix[0] = i0; ix[1] = (i0 + 64) ^ 21; ix[2] = i0 + 128; ix[3] = (i0 + 192) ^ 21; }
    else if (lm == 4) { const int c6 = ((base >> 6) & 1) * 21; ix[0] = base ^ c6; ix[1] = (base + 16) ^ c6; ix[2] = (base + 32) ^ c6 ^ 10; ix[3] = (base + 48) ^ c6 ^ 10; }
    else { const int c = (((base >> 6) & 1) * 21) ^ (((base >> 5) & 1) * 10); ix[0] = base ^ c; ix[1] = (base + m) ^ c; ix[2] = (base + 2 * m) ^ c; ix[3] = (base + 3 * m) ^ c; }
}
__device__ __forceinline__ void fft_fwd(LAS f32x2* buf) {
    const int tid = ltid();
    for (int lm = 12; lm >= 0; lm -= 2) {
        const int m = 1 << lm; const float inv = 1.0f / (float)(4 << lm);
        f32x2 a[8][4]; int ix[8][4];
#pragma unroll
        for (int i = 0; i < 8; ++i) { const int g = tid + 512 * i, p = g & (m - 1), base = ((g >> lm) << (lm + 2)) + p; fidx4(base, lm, ix[i]);
#pragma unroll
            for (int r = 0; r < 4; ++r) a[i][r] = buf[ix[i][r]]; }
#pragma unroll
        for (int i = 0; i < 8; ++i) { const int p = (tid + 512 * i) & (m - 1);
            const f32x2 t0 = a[i][0] + a[i][2], t1 = a[i][0] - a[i][2], t2 = a[i][1] + a[i][3], dd = a[i][1] - a[i][3], t3 = (f32x2){dd.y, -dd.x};
            const float rev = (float)p * inv;
            const f32x2 w1 = (f32x2){__builtin_amdgcn_cosf(rev), -__builtin_amdgcn_sinf(rev)}, w2 = cmul(w1, w1), w3 = cmul(w2, w1);
            buf[ix[i][0]] = t0 + t2; buf[ix[i][1]] = cmul(t1 + t3, w1); buf[ix[i][2]] = cmul(t0 - t2, w2); buf[ix[i][3]] = cmul(t1 - t3, w3); }
        __syncthreads();
    }
}
__device__ __forceinline__ void fft_inv(LAS f32x2* buf) {
    const int tid = ltid();
    for (int lm = 0; lm <= 12; lm += 2) {
        const int m = 1 << lm; const float inv = 1.0f / (float)(4 << lm);
        f32x2 a[8][4]; int ix[8][4];
#pragma unroll
        for (int i = 0; i < 8; ++i) { const int g = tid + 512 * i, p = g & (m - 1), base = ((g >> lm) << (lm + 2)) + p; fidx4(base, lm, ix[i]);
#pragma unroll
            for (int r = 0; r < 4; ++r) a[i][r] = buf[ix[i][r]]; }
#pragma unroll
        for (int i = 0; i < 8; ++i) { const int p = (tid + 512 * i) & (m - 1);
            const float rev = (float)p * inv;
            const f32x2 w1 = (f32x2){__builtin_amdgcn_cosf(rev), -__builtin_amdgcn_sinf(rev)}, w2 = cmul(w1, w1), w3 = cmul(w2, w1);
            const f32x2 b0 = a[i][0], b1 = cmulc(a[i][1], w1), b2 = cmulc(a[i][2], w2), b3 = cmulc(a[i][3], w3);
            const f32x2 s0 = b0 + b2, s1 = b0 - b2, s2 = b1 + b3, dd = b1 - b3, s3 = (f32x2){-dd.y, dd.x};
            buf[ix[i][0]] = s0 + s2; buf[ix[i][1]] = s1 + s3; buf[ix[i][2]] = s0 - s2; buf[ix[i][3]] = s1 - s3; }
        __syncthreads();
    }
}

__device__ __forceinline__ void hy_mlp_phase(KPC kp, int j) {
    float* h2 = (float*)(kp->ws + OFF_H2);
    const float* w1 = kp->in[I_HYW1] + j * 33 * 64; const float* b1 = kp->in[I_HYB1] + j * 64; const float* w2 = kp->in[I_HYW2] + j * 64 * 64; const float* b2 = kp->in[I_HYB2] + j * 64;
    const float* fr = kp->in[I_HYFREQ] + j * 128; const int lane = ltid() & 63, wv = ltid() >> 6;
    for (int pos = lbid() * 8 + wv; pos < SEQ + CTX; pos += gridDim.x * 8) {
        const int n = pos < SEQ ? SEQ : CTX, t = pos < SEQ ? pos : pos - SEQ; const float tn = (float)t / (float)(n - 1);
        float feat = 0.f;
        if (lane == 0) feat = tn;
        else if (lane < 33) { const int bi = (lane - 1) & 15; const float band = 1e-4f + (float)bi * ((15.0f - 1e-4f) / 15.0f); float rev = ((float)t / (float)n) * band; rev -= floorf(rev);
            const float ang = 6.283185307179586f * rev; feat = lane < 17 ? cosf(ang) : -sinf(ang); }
        float z = b1[lane];
        for (int i = 0; i < 33; ++i) z += lshfl(feat, i) * w1[i * 64 + lane];
        const float h1 = sinf(fr[lane] * z);
        float z2 = b2[lane];
        for (int v = 0; v < 64; ++v) z2 += lshfl(h1, v) * w2[v * 64 + lane];
        h2[(size_t)pos * 64 + lane] = sinf(fr[64 + lane] * z2);
    }
}

__device__ __forceinline__ void block_sum2(float& a, float& b, LAS float* red) {
    a = wave_sum(a); b = wave_sum(b); const int lane = ltid() & 63, wv = ltid() >> 6;
    __syncthreads(); if (lane == 0) { red[wv] = a; red[8 + wv] = b; } __syncthreads();
    float sa = 0.f, sb = 0.f;
#pragma unroll
    for (int i = 0; i < 8; ++i) { sa += red[i]; sb += red[8 + i]; }
    a = sa; b = sb;
}

__device__ __forceinline__ void hy_filter_task(KPC kp, int j, int task, LAS f32x2* buf, LAS float* aux) {
    const int tid = ltid(), d = task & 1023; const bool lat = task < 1024;
    const float* w3 = kp->in[I_HYW3] + (size_t)j * 64 * 4096; const float* b3 = kp->in[I_HYB3] + j * 4096; const float* ldc = kp->in[I_HYDECAY] + j * 4096;
    __syncthreads();
    if (tid < 256) aux[tid] = w3[(size_t)(tid & 63) * 4096 + (tid >> 6) * 1024 + d];
    if (tid < 4) { aux[256 + tid] = b3[tid * 1024 + d]; aux[260 + tid] = __expf(ldc[tid * 1024 + d]); }
    __syncthreads();
    const float* h2 = (const float*)(kp->ws + OFF_H2);
    float ss0 = 0.f, ss1 = 0.f;
    if (lat) {
        for (int r = 0; r < 16; ++r) { const int i = tid + 512 * r; float a0 = aux[256], a1 = aux[257], a2 = aux[258], a3 = aux[259];
#pragma unroll 4
            for (int u4 = 0; u4 < 16; ++u4) { const f32x4 hv = *(const f32x4*)(h2 + (size_t)i * 64 + u4 * 4);
                const f32x4 q0 = *(const LAS f32x4*)(aux + u4 * 4), q1 = *(const LAS f32x4*)(aux + 64 + u4 * 4), q2 = *(const LAS f32x4*)(aux + 128 + u4 * 4), q3 = *(const LAS f32x4*)(aux + 192 + u4 * 4);
#pragma unroll
                for (int e = 0; e < 4; ++e) { a0 += hv[e] * q0[e]; a1 += hv[e] * q1[e]; a2 += hv[e] * q2[e]; a3 += hv[e] * q3[e]; } }
            const float tn = (float)i * (1.0f / 8191.0f);
            a0 *= __expf(-tn * aux[260]); a1 *= __expf(-tn * aux[261]); a2 *= __expf(-tn * aux[262]); a3 *= __expf(-tn * aux[263]);
            buf[fphys(i)] = (f32x2){a0, a2}; ss0 += a0 * a0; ss1 += a2 * a2;
            if (i >= 1) { buf[fphys(NFFT - i)] = (f32x2){a1, a3}; ss0 += a1 * a1; ss1 += a3 * a3; } }
        if (tid == 0) buf[fphys(SEQ)] = (f32x2){0.f, 0.f};
        block_sum2(ss0, ss1, aux + 272);
        const f32x2 scl = (f32x2){rsqrtf(ss0 + 1e-12f) * (1.0f / NFFT), rsqrtf(ss1 + 1e-12f) * (1.0f / NFFT)};
        for (int r = 0; r < 32; ++r) { const int q = fphys(tid + 512 * r); buf[q] = buf[q] * scl; }
        __syncthreads();
        fft_fwd(buf);
        f32x2* K0 = (f32x2*)(kp->ws + OFF_R2) + (size_t)d * NFFT; f32x2* K1 = (f32x2*)kp->out + (size_t)d * NFFT;
        for (int r = 0; r < 32; ++r) { const int pos = tid + 512 * r, k = drev(pos), pos2 = drev((NFFT - k) & (NFFT - 1)); const f32x2 Z = buf[fphys(pos)], Z2 = buf[fphys(pos2)];
            K0[pos] = (f32x2){0.5f * (Z.x + Z2.x), 0.5f * (Z.y - Z2.y)}; K1[pos] = (f32x2){0.5f * (Z.y + Z2.y), -0.5f * (Z.x - Z2.x)}; }
    } else {
        const int idx = tid; float a0 = 0.f, a1 = 0.f;
        if (idx != CTX) { const int t = idx < CTX ? idx : 2 * CTX - idx, dir = idx < CTX ? 0 : 1; a0 = aux[256 + dir]; a1 = aux[258 + dir];
            for (int u4 = 0; u4 < 16; ++u4) { const f32x4 hv = *(const f32x4*)(h2 + (size_t)(SEQ + t) * 64 + u4 * 4);
#pragma unroll
                for (int e = 0; e < 4; ++e) { const int u = u4 * 4 + e; a0 += hv[e] * aux[dir * 64 + u]; a1 += hv[e] * aux[128 + dir * 64 + u]; } }
            const float tn = (float)t * (1.0f / 255.0f); a0 *= __expf(-tn * aux[260 + dir]); a1 *= __expf(-tn * aux[262 + dir]); }
        ss0 = a0 * a0; ss1 = a1 * a1;
        block_sum2(ss0, ss1, aux + 272);
        float* kc = (float*)(kp->ws + OFF_KCTX);
        kc[(size_t)d * 512 + idx] = a0 * rsqrtf(ss0 + 1e-12f); kc[(size_t)(1024 + d) * 512 + idx] = a1 * rsqrtf(ss1 + 1e-12f);
    }
}

__device__ __forceinline__ float ld3(const u16* row, int t, int n, float wa, float wb, float wc, float bias) {
    const float xm = t > 0 ? bf2f(row[t - 1]) : 0.f, x0 = bf2f(row[t]), xp = t < n - 1 ? bf2f(row[t + 1]) : 0.f; return wa * xm + wb * x0 + wc * xp + bias; }

__device__ __forceinline__ void ld3x8(const u16* row, int t0, float wa, float wb, float wc, float bias, float (&o)[8]) {
    const u32x4v w = *(const u32x4v*)(row + t0);
    const float x0 = bflo(w.x), x1 = bfhi(w.x), x2 = bflo(w.y), x3 = bfhi(w.y), x4 = bflo(w.z), x5 = bfhi(w.z), x6 = bflo(w.w), x7 = bfhi(w.w);
    const float xl = t0 > 0 ? bf2f(row[t0 - 1]) : 0.f, xr = t0 + 8 < SEQ ? bf2f(row[t0 + 8]) : 0.f;
    o[0] = wa * xl + wb * x0 + wc * x1 + bias; o[1] = wa * x0 + wb * x1 + wc * x2 + bias; o[2] = wa * x1 + wb * x2 + wc * x3 + bias; o[3] = wa * x2 + wb * x3 + wc * x4 + bias;
    o[4] = wa * x3 + wb * x4 + wc * x5 + bias; o[5] = wa * x4 + wb * x5 + wc * x6 + bias; o[6] = wa * x5 + wb * x6 + wc * x7 + bias; o[7] = wa * x6 + wb * x7 + wc * xr + bias;
}
__device__ __forceinline__ void hy_conv_lat(KPC kp, int j, int task, LAS f32x2* buf) {
    const int tid = ltid(), bp = task >> 10, c = task & 1023, b0 = bp * 2;
    const u16* pl = (const u16*)(kp->ws + OFF_R1 + HY_PL); u16* yl = (u16*)(kp->ws + OFF_R1 + HY_YL);
    const float* cw = kp->in[I_HYCW] + (size_t)j * 3 * 3072; const float* cb = kp->in[I_HYCB] + j * 3072;
    const float w1a = cw[c], w1b = cw[3072 + c], w1c = cw[6144 + c], bb1 = cb[c];
    const float w2a = cw[1024 + c], w2b = cw[3072 + 1024 + c], w2c = cw[6144 + 1024 + c], bb2 = cb[1024 + c];
    const float w3a = cw[2048 + c], w3b = cw[3072 + 2048 + c], w3c = cw[6144 + 2048 + c], bb3 = cb[2048 + c];
    const float sk0 = kp->in[I_HYSKIP][j * 2048 + c], sk1 = kp->in[I_HYSKIP][j * 2048 + 1024 + c];
    const u16* x1r0 = pl + ((size_t)b0 * 3072 + c) * SEQ; const u16* x1r1 = x1r0 + (size_t)3072 * SEQ;
    const u16* x2r0 = x1r0 + (size_t)1024 * SEQ; const u16* x2r1 = x1r1 + (size_t)1024 * SEQ;
    const u16* vr0 = x1r0 + (size_t)2048 * SEQ; const u16* vr1 = x1r1 + (size_t)2048 * SEQ;
    const f32x2* K0 = (const f32x2*)(kp->ws + OFF_R2) + (size_t)c * NFFT; const f32x2* K1 = (const f32x2*)kp->out + (size_t)c * NFFT;
    __syncthreads();
#pragma unroll
    for (int g = 0; g < 2; ++g) { const int t0 = 8 * (tid + 512 * g); float v0[8], v1[8];
        ld3x8(vr0, t0, w3a, w3b, w3c, bb3, v0); ld3x8(vr1, t0, w3a, w3b, w3c, bb3, v1);
#pragma unroll
        for (int e = 0; e < 8; ++e) { buf[fphys(t0 + e)] = (f32x2){v0[e], v1[e]}; buf[fphys(SEQ + t0 + e)] = (f32x2){0.f, 0.f}; } }
    __syncthreads();
#ifdef PROBE_FFT
    for (int rp = 0; rp < PROBE_FFT; ++rp) { fft_fwd(buf); fft_inv(buf); for (int r = 0; r < 32; ++r) { const int q = fphys(tid + 512 * r); buf[q] = buf[q] * (1.0f / NFFT); } __syncthreads(); }
#endif
    fft_fwd(buf);
#pragma unroll 8
    for (int r = 0; r < 32; ++r) { const int pos = tid + 512 * r, q = fphys(pos); buf[q] = cmul(buf[q], K0[pos]); }
    __syncthreads();
    fft_inv(buf);
    float zr[32];
#pragma unroll
    for (int g = 0; g < 2; ++g) { const int t0 = 8 * (tid + 512 * g); float v0[8], v1[8], xa[8], xb[8];
        ld3x8(vr0, t0, w3a, w3b, w3c, bb3, v0); ld3x8(vr1, t0, w3a, w3b, w3c, bb3, v1); ld3x8(x1r0, t0, w1a, w1b, w1c, bb1, xa); ld3x8(x1r1, t0, w1a, w1b, w1c, bb1, xb);
#pragma unroll
        for (int e = 0; e < 8; ++e) { const f32x2 y = buf[fphys(t0 + e)]; const float z0 = xa[e] * (y.x + sk0 * v0[e]), z1 = xb[e] * (y.y + sk0 * v1[e]);
            zr[g * 16 + 2 * e] = z0; zr[g * 16 + 2 * e + 1] = z1; buf[fphys(t0 + e)] = (f32x2){z0, z1}; buf[fphys(SEQ + t0 + e)] = (f32x2){0.f, 0.f}; } }
    __syncthreads();
    fft_fwd(buf);
#pragma unroll 8
    for (int r = 0; r < 32; ++r) { const int pos = tid + 512 * r, q = fphys(pos); buf[q] = cmul(buf[q], K1[pos]); }
    __syncthreads();
    fft_inv(buf);
#pragma unroll
    for (int g = 0; g < 2; ++g) { const int t0 = 8 * (tid + 512 * g); float xa[8], xb[8], o0[8], o1[8];
        ld3x8(x2r0, t0, w2a, w2b, w2c, bb2, xa); ld3x8(x2r1, t0, w2a, w2b, w2c, bb2, xb);
#pragma unroll
        for (int e = 0; e < 8; ++e) { const f32x2 y = buf[fphys(t0 + e)]; o0[e] = xa[e] * (y.x + sk1 * zr[g * 16 + 2 * e]); o1[e] = xb[e] * (y.y + sk1 * zr[g * 16 + 2 * e + 1]); }
        *(u32x4v*)(yl + ((size_t)b0 * D + c) * SEQ + t0) = pack8(o0); *(u32x4v*)(yl + ((size_t)(b0 + 1) * D + c) * SEQ + t0) = pack8(o1); }
}

__device__ __forceinline__ void hy_conv_ctx(KPC kp, int j, int c, LAS float* ls) {
    const int tid = ltid();
    const u16* pc = (const u16*)(kp->ws + OFF_R1 + HY_PC); u16* yc = (u16*)(kp->ws + OFF_R1 + HY_YC); const float* kc = (const float*)(kp->ws + OFF_KCTX);
    const float* cw = kp->in[I_HYCW] + (size_t)j * 3 * 3072; const float* cb = kp->in[I_HYCB] + j * 3072;
    const float w1a = cw[c], w1b = cw[3072 + c], w1c = cw[6144 + c], bb1 = cb[c];
    const float w2a = cw[1024 + c], w2b = cw[3072 + 1024 + c], w2c = cw[6144 + 1024 + c], bb2 = cb[1024 + c];
    const float w3a = cw[2048 + c], w3b = cw[3072 + 2048 + c], w3c = cw[6144 + 2048 + c], bb3 = cb[2048 + c];
    const float sk0 = kp->in[I_HYSKIP][j * 2048 + c], sk1 = kp->in[I_HYSKIP][j * 2048 + 1024 + c];
    __syncthreads();
    ls[tid] = kc[(size_t)c * 512 + tid]; ls[512 + tid] = kc[(size_t)(1024 + c) * 512 + tid];
    for (int i = 0; i < 2; ++i) { const int e = tid + 512 * i, b = e >> 8, t = e & 255; ls[1024 + e] = ld3(pc + ((size_t)b * 3072 + 2048 + c) * CTX, t, CTX, w3a, w3b, w3c, bb3); }
    __syncthreads();
    float zr[2];
    for (int i = 0; i < 2; ++i) { const int e = tid + 512 * i, b = e >> 8, t = e & 255; float a = 0.f;
        for (int s = 0; s < CTX; ++s) a += ls[(t - s) & 511] * ls[1024 + b * 256 + s];
        zr[i] = ld3(pc + ((size_t)b * 3072 + c) * CTX, t, CTX, w1a, w1b, w1c, bb1) * (a + sk0 * ls[1024 + e]); ls[2048 + e] = zr[i]; }
    __syncthreads();
    for (int i = 0; i < 2; ++i) { const int e = tid + 512 * i, b = e >> 8, t = e & 255; float a = 0.f;
        for (int s = 0; s < CTX; ++s) a += ls[512 + ((t - s) & 511)] * ls[2048 + b * 256 + s];
        yc[((size_t)b * D + c) * CTX + t] = f2bf(ld3(pc + ((size_t)b * 3072 + 1024 + c) * CTX, t, CTX, w2a, w2b, w2c, bb2) * (a + sk1 * zr[i])); }
}

__device__ __forceinline__ void hy_transpose(KPC kp, LAS u16* tl) {
    const u16* yl = (const u16*)(kp->ws + OFF_R1 + HY_YL); const u16* yc = (const u16*)(kp->ws + OFF_R1 + HY_YC); u16* y = (u16*)(kp->ws + OFF_U); const int tid = ltid();
    for (int tile = lbid(); tile < NB * 16 * NCH; tile += gridDim.x) {
        const int b = tile / (16 * NCH), rem = tile - b * 16 * NCH, ct = rem / NCH, tt = rem - ct * NCH;
        const u16* src = tt < 4 ? yc + ((size_t)b * D + ct * 64) * CTX + tt * 64 : yl + ((size_t)b * D + ct * 64) * SEQ + (tt - 4) * 64; const int ld = tt < 4 ? CTX : SEQ;
        { const int cr = tid >> 3, t8 = (tid & 7) * 8; *(LAS u32x4v*)(tl + cr * 72 + t8) = *(const u32x4v*)(src + (size_t)cr * ld + t8); }
        __syncthreads();
        { const int tr = tid >> 3, c8 = (tid & 7) * 8; u32x4v w;
          w.x = (unsigned)tl[(c8 + 0) * 72 + tr] | ((unsigned)tl[(c8 + 1) * 72 + tr] << 16); w.y = (unsigned)tl[(c8 + 2) * 72 + tr] | ((unsigned)tl[(c8 + 3) * 72 + tr] << 16);
          w.z = (unsigned)tl[(c8 + 4) * 72 + tr] | ((unsigned)tl[(c8 + 5) * 72 + tr] << 16); w.w = (unsigned)tl[(c8 + 6) * 72 + tr] | ((unsigned)tl[(c8 + 7) * 72 + tr] << 16);
          *(u32x4v*)(y + ((size_t)b * TPB + tt * 64 + tr) * D + ct * 64 + c8) = w; }
        __syncthreads();
    }
}

constexpr size_t OFF_XM = OFF_R1, OFF_XC = OFF_R1 + 132 * MiB, OFF_S = WS_NEED, OFF_MLM = OFF_S + 34 * MiB, WS_NEED2 = OFF_MLM + 1 * MiB;
__device__ __forceinline__ u16* hb_ptr(KPC kp, int T) { const int b = T / TPB, t = T - b * TPB;
    return t < CTX ? (u16*)(kp->ws + OFF_HBC) + ((size_t)b * CTX + t) * INNER : (u16*)kp->out + ((size_t)b * SEQ + (t - CTX)) * INNER; }
__device__ __forceinline__ void bd8(const float (&x)[8], const float (&w)[32], float (&y)[8]) {
#pragma unroll
    for (int bl = 0; bl < 2; ++bl)
#pragma unroll
        for (int e = 0; e < 4; ++e) { float s = 0.f;
#pragma unroll
            for (int d = 0; d < 4; ++d) s += x[bl * 4 + d] * w[bl * 16 + d * 4 + e];
            y[bl * 4 + e] = s; }
}
__device__ __forceinline__ void ldw32(const float* p, float (&w)[32]) {
#pragma unroll
    for (int i = 0; i < 8; ++i) { const f32x4 v = *(const f32x4*)(p + i * 4); w[i * 4] = v[0]; w[i * 4 + 1] = v[1]; w[i * 4 + 2] = v[2]; w[i * 4 + 3] = v[3]; } }

__device__ __forceinline__ void ml_m_phase(KPC kp, int j) {
    float* M = (float*)(kp->ws + OFF_MLM); const float* wq = kp->in[I_MLWQ] + (size_t)j * 512 * 16; const float* wk = kp->in[I_MLWK] + (size_t)j * 512 * 16;
    for (int i = lbid() * 512 + ltid(); i < 512 * 16; i += gridDim.x * 512) { const int blk = i >> 4, d = (i >> 2) & 3, d2 = i & 3; float s = 0.f;
#pragma unroll
        for (int e = 0; e < 4; ++e) s += wq[blk * 16 + d * 4 + e] * wk[blk * 16 + d2 * 4 + e];
        M[i] = s * 0.04419417382415922f; }
}

__device__ __forceinline__ void ml_prep_task(KPC kp, int j, int task, LAS unsigned char* lds) {
    const int tid = ltid(), lane = tid & 63, wv = tid >> 6, fr = lane & 15, fq = lane >> 4;
    const int hd = task & 3, bc = task >> 2, b = bc / NCH, ci = bc - b * NCH;
    const u16* xm = (const u16*)(kp->ws + OFF_XM); u16* xc = (u16*)(kp->ws + OFF_XC);
    const int T0 = b * TPB + ci * 64, tlo = b * TPB + (ci < 4 ? 0 : CTX), thi = b * TPB + (ci < 4 ? CTX - 1 : TPB - 1);
    const int ch0 = hd * DH + lane * 8;
    LAS u16* QS = (LAS u16*)lds; LAS u16* KS = (LAS u16*)(lds + 66560);
    const float* cw = kp->in[I_MLCW] + (size_t)j * 3 * INNER; const float* cb = kp->in[I_MLCB] + (size_t)j * INNER;
    __syncthreads();
    {
        float cwa[8], cwb[8], cwc[8], cbb[8], wq[32], wk[32];
#pragma unroll
        for (int e = 0; e < 8; ++e) { cwa[e] = cw[ch0 + e]; cwb[e] = cw[INNER + ch0 + e]; cwc[e] = cw[2 * INNER + ch0 + e]; cbb[e] = cb[ch0 + e]; }
        ldw32(kp->in[I_MLWQ] + ((size_t)j * 512 + (ch0 >> 2)) * 16, wq); ldw32(kp->in[I_MLWK] + ((size_t)j * 512 + (ch0 >> 2)) * 16, wk);
        for (int r = 0; r < 8; ++r) { const int jj = wv + 8 * r, T = T0 + jj; const u16* p = xm + (size_t)T * INNER + ch0;
            float x0[8], xa[8], xb[8], xcv[8], q[8], k[8];
            unpack8(*(const u32x4v*)p, x0);
            if (T > tlo) unpack8(*(const u32x4v*)(p - INNER), xa); else {
#pragma unroll
                for (int e = 0; e < 8; ++e) xa[e] = 0.f; }
            if (T < thi) unpack8(*(const u32x4v*)(p + INNER), xb); else {
#pragma unroll
                for (int e = 0; e < 8; ++e) xb[e] = 0.f; }
#pragma unroll
            for (int e = 0; e < 8; ++e) xcv[e] = siluf(cwa[e] * xa[e] + cwb[e] * x0[e] + cwc[e] * xb[e] + cbb[e]);
            const u32x4v xw = pack8(xcv); *(u32x4v*)(xc + (size_t)T * INNER + ch0) = xw; unpack8(xw, xcv);
            bd8(xcv, wq, q); bd8(xcv, wk, k);
            *(LAS u32x4v*)(QS + jj * 520 + lane * 8) = pack8(q); *(LAS u32x4v*)(KS + jj * 520 + lane * 8) = pack8(k); }
    }
    __syncthreads();
    const u16* wg = (const u16*)(kp->ws + OFF_WB + WB_WGT);
    const int mt = wv & 3, kh = wv >> 2;
    { f32x4 s0 = {0.f, 0.f, 0.f, 0.f}, s1 = {0.f, 0.f, 0.f, 0.f}; const int nt0 = kh * 2;
      for (int ks = 0; ks < 16; ++ks) { const bf16x8 a = *(const LAS bf16x8*)(QS + (16 * mt + fr) * 520 + 32 * ks + 8 * fq);
          const bf16x8 b0 = *(const LAS bf16x8*)(KS + (16 * nt0 + fr) * 520 + 32 * ks + 8 * fq), b1 = *(const LAS bf16x8*)(KS + (16 * (nt0 + 1) + fr) * 520 + 32 * ks + 8 * fq);
          s0 = __builtin_amdgcn_mfma_f32_16x16x32_bf16(a, b0, s0, 0, 0, 0); s1 = __builtin_amdgcn_mfma_f32_16x16x32_bf16(a, b1, s1, 0, 0, 0); }
      float* S = (float*)(kp->ws + OFF_S) + ((size_t)(b * 4 + hd) * NCH + ci) * 4096;
#pragma unroll
      for (int r = 0; r < 4; ++r) { S[(16 * mt + 4 * fq + r) * 64 + 16 * nt0 + fr] = s0[r]; S[(16 * mt + 4 * fq + r) * 64 + 16 * (nt0 + 1) + fr] = s1[r]; } }
    f32x4 ga = {0.f, 0.f, 0.f, 0.f};
    for (int ks = kh * 8; ks < kh * 8 + 8; ++ks) { const int kk = hd * DH + 32 * ks + 8 * fq;
        const bf16x8 a = *(const LAS bf16x8*)(QS + (16 * mt + fr) * 520 + 32 * ks + 8 * fq), a2 = *(const LAS bf16x8*)(KS + (16 * mt + fr) * 520 + 32 * ks + 8 * fq);
        const bf16x8 bq = *(const bf16x8*)(wg + (size_t)fr * 6144 + kk), bk = *(const bf16x8*)(wg + (size_t)fr * 6144 + INNER + kk);
        ga = __builtin_amdgcn_mfma_f32_16x16x32_bf16(a, bq, ga, 0, 0, 0); ga = __builtin_amdgcn_mfma_f32_16x16x32_bf16(a2, bk, ga, 0, 0, 0); }
    __syncthreads();
    {
        float wvv[32]; ldw32(kp->in[I_MLWV] + ((size_t)j * 512 + (ch0 >> 2)) * 16, wvv);
        for (int r = 0; r < 8; ++r) { const int jj = wv + 8 * r, T = T0 + jj; float x0[8], v[8]; unpack8(*(const u32x4v*)(xm + (size_t)T * INNER + ch0), x0); bd8(x0, wvv, v);
            *(LAS u32x4v*)(QS + jj * 520 + lane * 8) = pack8(v); }
    }
    __syncthreads();
    for (int ks = kh * 8; ks < kh * 8 + 8; ++ks) { const int kk = hd * DH + 32 * ks + 8 * fq;
        const bf16x8 a = *(const LAS bf16x8*)(QS + (16 * mt + fr) * 520 + 32 * ks + 8 * fq); const bf16x8 bv = *(const bf16x8*)(wg + (size_t)fr * 6144 + 2 * INNER + kk);
        ga = __builtin_amdgcn_mfma_f32_16x16x32_bf16(a, bv, ga, 0, 0, 0); }
    float* gates = (float*)(kp->ws + OFF_GATES);
#pragma unroll
    for (int r = 0; r < 4; ++r) atomicAdd(gates + (size_t)(T0 + 16 * mt + 4 * fq + r) * 16 + fr, ga[r]);
}

__device__ __forceinline__ void tr_store8(LAS unsigned char* base, int d0, const unsigned (&w)[4], int lane) {
    const int odd = lane & 1, sp = lane & ~1;
#pragma unroll
    for (int i = 0; i < 4; ++i) { const unsigned pw = (unsigned)__builtin_amdgcn_update_dpp(0, (int)w[i], 0xB1, 0xF, 0xF, false);
        const unsigned ow = odd ? ((pw >> 16) | (w[i] & 0xffff0000u)) : ((w[i] & 0xffffu) | (pw << 16)); const int d = d0 + 2 * i + odd;
        *(LAS unsigned*)(base + d * 128 + ((((sp >> 3) ^ (d & 7)) << 4) | ((sp & 7) << 1))) = ow; }
}
#ifndef REP_STAGE
#define REP_STAGE 1
#define REP_STILDE 1
#define REP_MFMA 1
#endif
constexpr int SC_QS = 0, SC_KT = 66560, SC_VT = 132096, SC_ST = 148480, SC_VEC = 156672;
__device__ __forceinline__ void ml_scan_task(KPC kp, int j, int task, LAS unsigned char* lds) {
    const int tid = ltid(), lane = tid & 63, wv = tid >> 6, fr = lane & 15, fq = lane >> 4;
    const int es = task & 3, dir = (task >> 2) & 1, hd = (task >> 3) & 3, b = task >> 5;
    const u16* xm = (const u16*)(kp->ws + OFF_XM); const u16* xc = (const u16*)(kp->ws + OFF_XC); const float* gates = (const float*)(kp->ws + OFF_GATES);
    const float* Sg = (const float*)(kp->ws + OFF_S) + (size_t)(b * 4 + hd) * NCH * 4096;
    u16* hf = (u16*)(kp->ws + OFF_R2);
    LAS unsigned char* QS = lds + SC_QS; LAS unsigned char* KT = lds + SC_KT; LAS unsigned char* VT = lds + SC_VT; LAS unsigned char* ST = lds + SC_ST;
    LAS float* rowterm = (LAS float*)(lds + SC_VEC); LAS float* colterm = rowterm + 64; LAS float* winter = rowterm + 128; LAS float* einv = rowterm + 192;
    LAS float* kws = rowterm + 256; LAS float* dinv = rowterm + 320; LAS float* nst = rowterm + 384; LAS float* scal = rowterm + 896;
    f32x4 C[32];
#pragma unroll
    for (int i = 0; i < 32; ++i) C[i] = (f32x4){0.f, 0.f, 0.f, 0.f};
    float m_st = 0.f;
    __syncthreads();
    nst[tid] = 0.f;
    float pg_ic = 0.f, pg_fp = 0.f;
    if (wv == 0) { const int tn = dir == 0 ? lane : CTX - 1 - lane; const int Tg = b * TPB + tn; pg_ic = gates[(size_t)Tg * 16 + dir * 8 + hd]; pg_fp = gates[(size_t)Tg * 16 + dir * 8 + 4 + hd]; }
    for (int ci = 0; ci < NCH; ++ci) {
        __syncthreads();
        const int p0 = ci * 64;
        const int tid = ltid(), lane = tid & 63, wv = tid >> 6, fr = lane & 15, fq = lane >> 4;
        asm volatile("" ::: "memory");
        auto tok = [&](int jj) -> int { const int p = p0 + jj; const int t = dir == 0 ? p : (p < CTX ? CTX - 1 - p : TPB + CTX - 1 - p); return b * TPB + t; };
        float sv[8];
        { const int jj = tid >> 3, s8 = (tid & 7) * 8;
            if (dir == 0) { const float* sp = Sg + (size_t)ci * 4096 + jj * 64 + s8; const f32x4 v0 = *(const f32x4*)sp, v1 = *(const f32x4*)(sp + 4);
                sv[0] = v0[0]; sv[1] = v0[1]; sv[2] = v0[2]; sv[3] = v0[3]; sv[4] = v1[0]; sv[5] = v1[1]; sv[6] = v1[2]; sv[7] = v1[3]; }
            else { const int oc = ci < 4 ? 3 - ci : 135 - ci; const float* sp = Sg + (size_t)oc * 4096 + (63 - jj) * 64 + (56 - s8); const f32x4 v0 = *(const f32x4*)sp, v1 = *(const f32x4*)(sp + 4);
                sv[7] = v0[0]; sv[6] = v0[1]; sv[5] = v0[2]; sv[4] = v0[3]; sv[3] = v1[0]; sv[2] = v1[1]; sv[1] = v1[2]; sv[0] = v1[3]; }
        }
        const float g_ic = pg_ic, g_fp = pg_fp;
        if (wv == 0 && ci + 1 < NCH) { const int pn = p0 + 64 + lane; const int tn = dir == 0 ? pn : (pn < CTX ? CTX - 1 - pn : TPB + CTX - 1 - pn); const int Tg = b * TPB + tn;
            pg_ic = gates[(size_t)Tg * 16 + dir * 8 + hd]; pg_fp = gates[(size_t)Tg * 16 + dir * 8 + 4 + hd]; }
        for (int rpS = 0; rpS < REP_STAGE; ++rpS) {
        const int wvu = __builtin_amdgcn_readfirstlane(wv); const int Tl = tok(lane);
        for (int r = 0; r < 8; ++r) { const int g8 = wvu * 8 + r; float x[8], q[8], Mw[32];
            const u32x4v xw = *(const u32x4v*)(xc + (size_t)Tl * INNER + hd * DH + g8 * 8); unpack8(xw, x);
            ldw32((const float*)(kp->ws + OFF_MLM) + (size_t)(hd * 128 + g8 * 2) * 16, Mw); bd8(x, Mw, q);
            *(LAS u32x4v*)(QS + lane * 1040 + g8 * 16) = pack8(q);
            const unsigned wd[4] = {xw.x, xw.y, xw.z, xw.w}; tr_store8(KT, g8 * 8, wd, lane); }
        for (int r = 0; r < 2; ++r) { const int g = wvu * 2 + r; const int chv = hd * DH + es * 128 + g * 8; float x[8], v[8], wvv[32];
            unpack8(*(const u32x4v*)(xm + (size_t)Tl * INNER + chv), x); ldw32(kp->in[I_MLWV] + ((size_t)j * 512 + (chv >> 2)) * 16, wvv); bd8(x, wvv, v);
            { const u32x4v vw = pack8(v); const unsigned wd[4] = {vw.x, vw.y, vw.z, vw.w}; tr_store8(VT, g * 8, wd, lane); } }
        }
        if (wv == 0) {
            const float ic = g_ic, fp = g_fp;
            const float lf = fminf(fp, 0.f) - log1pf(__expf(-fabsf(fp)));
            float bb = lf;
#pragma unroll
            for (int o = 1; o < 64; o <<= 1) { const float t = lshfl(bb, lane - o); if (lane >= o) bb += t; }
            const float uu = ic - bb; float pm = uu;
#pragma unroll
            for (int o = 1; o < 64; o <<= 1) { const float t = lshfl(pm, lane - o); if (lane >= o) pm = fmaxf(pm, t); }
            const float a = bb + m_st, mj = fmaxf(a, bb + pm);
            rowterm[lane] = bb - mj; colterm[lane] = uu; winter[lane] = __expf(a - mj); einv[lane] = __expf(-mj);
            const float blast = lshfl(bb, 63), gs = blast - bb + ic, gmax = wave_max(gs), mnew = fmaxf(blast + m_st, gmax);
            kws[lane] = __expf(gs - mnew);
            if (lane == 0) { scal[0] = __expf(blast + m_st - mnew); scal[1] = mnew; }
        }
        __syncthreads();
        for (int rpT = 0; rpT < REP_STILDE; ++rpT) {
            const int jj = tid >> 3, sub = tid & 7, s8 = sub * 8;
            const float rt = rowterm[jj]; float rsum = 0.f;
            const f32x4 ct0 = *(const LAS f32x4*)(colterm + s8), ct1 = *(const LAS f32x4*)(colterm + s8 + 4); const float ctv[8] = {ct0[0], ct0[1], ct0[2], ct0[3], ct1[0], ct1[1], ct1[2], ct1[3]};
#pragma unroll
            for (int e = 0; e < 8; ++e) { const int s = s8 + e; const float w = s <= jj ? sv[e] * 0.04419417382415922f * __expf(rt + ctv[e]) : 0.f; sv[e] = w; rsum += w; }
            *(LAS u32x4v*)(ST + jj * 128 + ((sub ^ (jj & 7)) << 4)) = pack8(sv);
            float qd = 0.f;
#pragma unroll
            for (int c8 = 0; c8 < 8; ++c8) { float qv[8]; unpack8(*(const LAS u32x4v*)(QS + jj * 1040 + (sub * 8 + c8) * 16), qv);
                { const f32x4 n0 = *(const LAS f32x4*)(nst + sub * 64 + c8 * 8), n1 = *(const LAS f32x4*)(nst + sub * 64 + c8 * 8 + 4);
                  qd += qv[0] * n0[0] + qv[1] * n0[1] + qv[2] * n0[2] + qv[3] * n0[3] + qv[4] * n1[0] + qv[5] * n1[1] + qv[6] * n1[2] + qv[7] * n1[3]; } }
            rsum += lshfl(rsum, lane ^ 1); rsum += lshfl(rsum, lane ^ 2); rsum += lshfl(rsum, lane ^ 4);
            qd += lshfl(qd, lane ^ 1); qd += lshfl(qd, lane ^ 2); qd += lshfl(qd, lane ^ 4);
            if (sub == 0) { const float qn = winter[jj] * qd + rsum; dinv[jj] = 1.0f / fmaxf(fabsf(qn), einv[jj]); }
        }
        __syncthreads();
        {
            f32x4 o[4];
            const int el = 16 * wv + fr;
            bf16x8 vfr[2];
            for (int rpM = 0; rpM < REP_MFMA; ++rpM) {
#pragma unroll
            for (int mt = 0; mt < 4; ++mt) o[mt] = (f32x4){0.f, 0.f, 0.f, 0.f};
#pragma unroll
            for (int ks = 0; ks < 16; ++ks) {
                u32x4v bw; bw.x = pg8::cvt_pk_bf16(C[2 * ks][0], C[2 * ks][1]); bw.y = pg8::cvt_pk_bf16(C[2 * ks][2], C[2 * ks][3]);
                bw.z = pg8::cvt_pk_bf16(C[2 * ks + 1][0], C[2 * ks + 1][1]); bw.w = pg8::cvt_pk_bf16(C[2 * ks + 1][2], C[2 * ks + 1][3]);
                const bf16x8 bfr = __builtin_bit_cast(bf16x8, bw);
#pragma unroll
                for (int mt = 0; mt < 4; ++mt) { const int off = (16 * mt + fr) * 1040 + 8 * fq;
                    const u32x2 lo = *(const LAS u32x2*)(QS + off + 64 * ks), hi = *(const LAS u32x2*)(QS + off + 64 * ks + 32);
                    u32x4v aw; aw.x = lo.x; aw.y = lo.y; aw.z = hi.x; aw.w = hi.y;
                    o[mt] = __builtin_amdgcn_mfma_f32_16x16x32_bf16(bfr, __builtin_bit_cast(bf16x8, aw), o[mt], 0, 0, 0); }
                if ((ks & 1) == 1) __builtin_amdgcn_sched_barrier(0); }
#pragma unroll
            for (int mt = 0; mt < 4; ++mt)
#pragma unroll
                for (int r = 0; r < 4; ++r) o[mt][r] *= winter[16 * mt + fr];
#pragma unroll
            for (int k2 = 0; k2 < 2; ++k2) { vfr[k2] = *(const LAS bf16x8*)(VT + el * 128 + (((4 * k2 + fq) ^ (el & 7)) << 4));
#pragma unroll
                for (int mt = 0; mt < 4; ++mt) { const int jr = 16 * mt + fr; const bf16x8 a = *(const LAS bf16x8*)(ST + jr * 128 + (((4 * k2 + fq) ^ (jr & 7)) << 4));
                    o[mt] = __builtin_amdgcn_mfma_f32_16x16x32_bf16(vfr[k2], a, o[mt], 0, 0, 0); } }
            }
#pragma unroll
            for (int mt = 0; mt < 4; ++mt)
                { const int jr = 16 * mt + fr, T = tok(jr); const float di = dinv[jr];
                    u16* dst = dir == 0 ? hf + (size_t)T * INNER : hb_ptr(kp, T); u32x2 w; w.x = pg8::cvt_pk_bf16(o[mt][0] * di, o[mt][1] * di); w.y = pg8::cvt_pk_bf16(o[mt][2] * di, o[mt][3] * di);
                    *(u32x2*)(dst + hd * DH + es * 128 + 16 * wv + 4 * fq) = w; }
            const float decay = scal[0];
#pragma unroll
            for (int i = 0; i < 32; ++i) C[i] = C[i] * decay;
            float kwv[2][8];
#pragma unroll
            for (int k2 = 0; k2 < 2; ++k2) { const f32x4 k0 = *(const LAS f32x4*)(kws + 32 * k2 + 8 * fq), k1 = *(const LAS f32x4*)(kws + 32 * k2 + 8 * fq + 4);
                kwv[k2][0] = k0[0]; kwv[k2][1] = k0[1]; kwv[k2][2] = k0[2]; kwv[k2][3] = k0[3]; kwv[k2][4] = k1[0]; kwv[k2][5] = k1[1]; kwv[k2][6] = k1[2]; kwv[k2][7] = k1[3]; }
#pragma unroll
            for (int k2 = 0; k2 < 2; ++k2) { float vv[8]; unpack8(__builtin_bit_cast(u32x4v, vfr[k2]), vv);
#pragma unroll
                for (int e = 0; e < 8; ++e) vv[e] *= kwv[k2][e];
                const bf16x8 bsc = __builtin_bit_cast(bf16x8, pack8(vv));
#pragma unroll
                for (int dt = 0; dt < 32; ++dt) { const int dr = 16 * dt + fr; const bf16x8 a = *(const LAS bf16x8*)(KT + dr * 128 + (((4 * k2 + fq) ^ (dr & 7)) << 4));
                    C[dt] = __builtin_amdgcn_mfma_f32_16x16x32_bf16(a, bsc, C[dt], 0, 0, 0);
                    if ((dt & 7) == 7) __builtin_amdgcn_sched_barrier(0); } }
            { float nn = decay * nst[tid];
#pragma unroll
              for (int g = 0; g < 8; ++g) { float kv[8]; unpack8(*(const LAS u32x4v*)(KT + tid * 128 + ((g ^ (tid & 7)) << 4)), kv);
                  { const f32x4 k0 = *(const LAS f32x4*)(kws + 8 * g), k1 = *(const LAS f32x4*)(kws + 8 * g + 4); nn += kv[0] * k0[0] + kv[1] * k0[1] + kv[2] * k0[2] + kv[3] * k0[3] + kv[4] * k1[0] + kv[5] * k1[1] + kv[6] * k1[2] + kv[7] * k1[3]; } }
              nst[tid] = nn; }
            m_st = scal[1];
        }
    }
}

__device__ __forceinline__ void ml_gate_phase(KPC kp, int j) {
    u16* hf = (u16*)(kp->ws + OFF_R2); const u16* xc = (const u16*)(kp->ws + OFF_XC); const u16* z = (const u16*)(kp->ws + OFF_XM);
    const float* ng = kp->in[I_MLNG] + (size_t)j * INNER; const float* sk = kp->in[I_MLSKIP] + (size_t)j * INNER;
    const int lane = ltid() & 63, wv = ltid() >> 6;
    for (int T = lbid() * 8 + wv; T < NTOK; T += gridDim.x * 8) {
        const u16* hbp = hb_ptr(kp, T);
#pragma unroll
        for (int hd = 0; hd < 4; ++hd) { const int c0 = hd * DH + lane * 8; float a[8], bq[8], xv[8], zv[8], o[8];
            unpack8(*(const u32x4v*)(hf + (size_t)T * INNER + c0), a); unpack8(*(const u32x4v*)(hbp + c0), bq);
            float s = 0.f;
#pragma unroll
            for (int e = 0; e < 8; ++e) { a[e] += bq[e]; s += a[e]; }
            const float mu = wave_sum(s) * (1.0f / DH); float vs = 0.f;
#pragma unroll
            for (int e = 0; e < 8; ++e) { a[e] -= mu; vs += a[e] * a[e]; }
            const float rs = rsqrtf(wave_sum(vs) * (1.0f / DH) + 1e-5f);
            unpack8(*(const u32x4v*)(xc + (size_t)T * INNER + c0), xv); unpack8(*(const u32x4v*)(z + (size_t)T * INNER + c0), zv);
            const f32x4 n0 = *(const f32x4*)(ng + c0), n1 = *(const f32x4*)(ng + c0 + 4), s0 = *(const f32x4*)(sk + c0), s1 = *(const f32x4*)(sk + c0 + 4);
            const float ngv[8] = {n0[0], n0[1], n0[2], n0[3], n1[0], n1[1], n1[2], n1[3]}, skv[8] = {s0[0], s0[1], s0[2], s0[3], s1[0], s1[1], s1[2], s1[3]};
#pragma unroll
            for (int e = 0; e < 8; ++e) o[e] = (a[e] * rs * ngv[e] + skv[e] * xv[e]) * siluf(zv[e]);
            *(u32x4v*)(hf + (size_t)T * INNER + c0) = pack8(o); }
    }
}


enum { K_SETUP = 0, K_CN, K_G1, K_G2R, K_HYIN, K_HYCONV, K_HYTR, K_MLUPX, K_MLPREP, K_MLSCAN, K_MLUPZ, K_MLGATE, K_FINAL };
constexpr int NPHASE = 1 + 11 + 13 + 11 + 13 + 1;
__device__ __forceinline__ void decode_phase(int ph, int& kind, int& l, int& arg) {
    kind = K_SETUP; l = 0; arg = 0; if (ph == 0) return;
    ph -= 1;
    for (l = 0; l < 4; ++l) { const int n = (l & 1) ? 13 : 11; if (ph < n) break; ph -= n; }
    if (l == 4) { kind = K_FINAL; l = 0; return; }
    if (ph == 0) { kind = K_CN; arg = 0; return; } if (ph == 1) { kind = K_G1; arg = 0; return; } if (ph == 2) { kind = K_G2R; arg = 0; return; } if (ph == 3) { kind = K_CN; arg = 1; return; }
    const int nm = (l & 1) ? 6 : 4;
    if (ph < 4 + nm) { const int q = ph - 4;
        if (l & 1) { kind = q == 0 ? K_MLUPX : q == 1 ? K_MLPREP : q == 2 ? K_MLSCAN : q == 3 ? K_MLUPZ : q == 4 ? K_MLGATE : K_G2R; arg = 2; }
        else { kind = q == 0 ? K_HYIN : q == 1 ? K_HYCONV : q == 2 ? K_HYTR : K_G2R; arg = 2; }
        return; }
    ph -= 4 + nm;
    if (ph == 0) { kind = K_CN; arg = 2; return; } if (ph == 1) { kind = K_G1; arg = 1; return; } kind = K_G2R; arg = 1;
}

__device__ __forceinline__ void gbar(unsigned* ctr, unsigned target) {
    __syncthreads();
    if (ltid() == 0) {
        __builtin_amdgcn_fence(__ATOMIC_RELEASE, "agent");
        __hip_atomic_fetch_add(ctr, 1u, __ATOMIC_RELAXED, __HIP_MEMORY_SCOPE_AGENT);
        while (__hip_atomic_load(ctr, __ATOMIC_RELAXED, __HIP_MEMORY_SCOPE_AGENT) < target) __builtin_amdgcn_s_sleep(2);
        __builtin_amdgcn_fence(__ATOMIC_ACQUIRE, "agent");
    }
    __syncthreads();
}
#ifndef REPMASK
#define REPMASK 0
#define REPN 1
#endif
template <int MIX> __device__ __forceinline__ void run_phases(int lo, int hi, int ph_lo, int ph_hi, LAS unsigned char* lds0, cg::grid_group& grid) {
    lo = lo > ph_lo ? lo : ph_lo; hi = hi < ph_hi ? hi : ph_hi;
    for (int ph = lo; ph < hi; ++ph) {
        KPC kp = (KPC)__builtin_amdgcn_kernarg_segment_ptr(); asm volatile("" : "+s"(kp) :: "memory");
        LAS unsigned char* lds = lds0; asm volatile("" : "+s"(lds) :: "memory");
        unsigned char* ws = kp->ws; unsigned char* wb = ws + OFF_WB;
        int kind, l, arg; decode_phase(ph, kind, l, arg); const int j = l >> 1;
        const float* modl = (const float*)(ws + OFF_MOD) + (size_t)l * 5 * 9216;
        const int nrep = ((REPMASK >> kind) & 1) ? REPN : 1;
        for (int rep = 0; rep < nrep; ++rep) {
        if (kind == K_SETUP) { if constexpr (MIX == 0) setup_phase(kp, (LAS float*)lds); }
        else if (kind == K_CN) {
            if (arg == 0) { convert_layer(kp, l, (LAS float*)lds); if constexpr (MIX == 1) ml_m_phase(kp, j); }
            if constexpr (MIX == 0) { if (arg == 1) hy_mlp_phase(kp, j); }
            norm_phase(kp, l, arg);
        } else if (kind == K_G1) {
            pg8::Gemm g{(const u16*)(ws + OFF_U), (const u16*)(wb + (arg ? WB_FIN1 : WB_FIN0)), NTOK, 2 * FF, D};
            pg8::StaticOrder S; S.init(g.M, g.N, (int)gridDim.x, lbid(), (l == 3 && arg == 1) ? 1 : 0); EpiSwiglu E{(u16*)(ws + OFF_R1)};
            pg8::gemm_phase<EpiSwiglu, pg8::StaticOrder, false>(lds, g, S, E, nullptr);
        } else if (kind == K_G2R) {
            pg8::Gemm g; EpiResid E; E.h = (float*)(ws + OFF_H); E.modl = modl;
            if (arg < 2) { g = pg8::Gemm{(const u16*)(ws + OFF_R1), (const u16*)(wb + (arg ? WB_FOUT1 : WB_FOUT0)), NTOK, D, FF}; E.gidx = arg ? 8 : 2; E.scale = 0.5f; E.bias = nullptr; }
            else if (MIX == 1) { g = pg8::Gemm{(const u16*)(ws + OFF_R2), (const u16*)(wb + WB_MOUT), NTOK, D, INNER}; E.gidx = 5; E.scale = 1.0f; E.bias = nullptr; }
            else { g = pg8::Gemm{(const u16*)(ws + OFF_U), (const u16*)(wb + WB_MOUT), NTOK, D, D}; E.gidx = 5; E.scale = 1.0f; E.bias = kp->in[I_HYBOUT] + (size_t)j * D; }
            pg8::StaticOrder S; S.init(g.M, g.N, (int)gridDim.x, lbid(), (l == 3 && arg >= 1) ? 1 : 0);
            pg8::gemm_phase<EpiResid, pg8::StaticOrder, false>(lds, g, S, E, nullptr);
        } else if (kind == K_FINAL) { if constexpr (MIX == 1) final_phase(kp); }
        else if constexpr (MIX == 0) {
            if (kind == K_HYIN) {
                pg8::Gemm g{(const u16*)(wb + WB_MIN), (const u16*)(ws + OFF_U), 3 * D, NTOK, D};
                pg8::StaticOrder S; S.init(g.M, g.N, (int)gridDim.x, lbid());
                EpiProjT E{(u16*)(ws + OFF_R1 + HY_PL), (u16*)(ws + OFF_R1 + HY_PC), kp->in[I_HYBIN] + (size_t)j * 3 * D};
                pg8::gemm_phase<EpiProjT, pg8::StaticOrder, false>(lds, g, S, E, nullptr);
                __syncthreads();
                for (int t = lbid(); t < 2048; t += gridDim.x) hy_filter_task(kp, j, t, (LAS f32x2*)lds, (LAS float*)(lds + 131072));
            } else if (kind == K_HYCONV) {
                for (int t = lbid(); t < 2048; t += gridDim.x) hy_conv_lat(kp, j, t, (LAS f32x2*)lds);
                for (int t = lbid(); t < 1024; t += gridDim.x) hy_conv_ctx(kp, j, t, (LAS float*)lds);
            } else if (kind == K_HYTR) hy_transpose(kp, (LAS u16*)lds);
        } else {
            if (kind == K_MLUPX || kind == K_MLUPZ) {
                const bool zz = kind == K_MLUPZ;
                pg8::Gemm g{(const u16*)(ws + OFF_U), (const u16*)(wb + WB_MIN) + (zz ? (size_t)INNER * D : 0), NTOK, INNER, D};
                pg8::StaticOrder S; S.init(g.M, g.N, (int)gridDim.x, lbid(), (zz && l == 3) ? 1 : 0); EpiBf E{(u16*)(ws + OFF_XM), INNER};
                pg8::gemm_phase<EpiBf, pg8::StaticOrder, false>(lds, g, S, E, nullptr);
            } else if (kind == K_MLPREP) { for (int t = lbid(); t < NB * NCH * 4; t += gridDim.x) ml_prep_task(kp, j, t, lds); }
            else if (kind == K_MLSCAN) { for (int t = lbid(); t < 128; t += gridDim.x) ml_scan_task(kp, j, t, lds); }
            else if (kind == K_MLGATE) ml_gate_phase(kp, j);
        }
        }
        if (ph + 1 < ph_hi) gbar((unsigned*)(kp->ws + OFF_MLM + 65536), (unsigned)(ph + 1 - ph_lo) * gridDim.x);
    }
}

__global__ void __launch_bounds__(512) fwd_megakernel(KP kparg) {
    extern __shared__ __attribute__((aligned(16))) unsigned char shm[];
    LAS unsigned char* lds = (LAS unsigned char*)shm;
    cg::grid_group grid = cg::this_grid();
    grid.sync();
    wtab_init();
    const int ph_lo = kparg.ph_lo, ph_hi = kparg.ph_hi;
    run_phases<0>(0, 12, ph_lo, ph_hi, lds, grid);
    run_phases<1>(12, 25, ph_lo, ph_hi, lds, grid);
    run_phases<0>(25, 36, ph_lo, ph_hi, lds, grid);
    run_phases<1>(36, 50, ph_lo, ph_hi, lds, grid);
}

extern "C" void kernel_launch(void* const* d_in, const int* in_sizes, int n_in, void* d_out, int out_size, void* d_ws, size_t ws_size, hipStream_t stream) {
    static int grid_blocks = 0;
    if (!grid_blocks) {
        int dev = 0, cus = 0, per_cu = 0;
        hipGetDevice(&dev);
        hipDeviceGetAttribute(&cus, hipDeviceAttributeMultiprocessorCount, dev);
        hipFuncSetAttribute((const void*)fwd_megakernel, hipFuncAttributeMaxDynamicSharedMemorySize, LDS_BYTES);
        hipOccupancyMaxActiveBlocksPerMultiprocessor(&per_cu, fwd_megakernel, 512, LDS_BYTES);
        if (per_cu < 1) per_cu = 1;
        grid_blocks = cus * 1;
        if (ws_size < WS_NEED2) fprintf(stderr, "workspace too small: %zu < %zu\n", ws_size, (size_t)WS_NEED2);
    }
    KP hp{};
    for (int i = 0; i < 36; ++i) hp.in[i] = (const float*)d_in[i];
    hp.out = (float*)d_out; hp.ws = (unsigned char*)d_ws; hp.ph_lo = 0; hp.ph_hi = NPHASE;
    void* args[] = {&hp};
    hipMemsetAsync((unsigned char*)d_ws + OFF_MLM + 65536, 0, 256, stream);
    hipError_t e = hipLaunchCooperativeKernel((void*)fwd_megakernel, dim3(grid_blocks), dim3(512), args, LDS_BYTES, stream);
    if (e != hipSuccess) fprintf(stderr, "cooperative launch failed: %s (grid %d)\n", hipGetErrorString(e), grid_blocks);
}
```

```cpp
#define REPMASK 0
#define REPN 1
#include <hip/hip_runtime.h>
#include <hip/hip_cooperative_groups.h>
#include <cstdio>
namespace cg = cooperative_groups;
#define WTAB_OFF 163584
__device__ __forceinline__ int llane() { int l; asm volatile("v_mbcnt_lo_u32_b32 %0, -1, 0\n\tv_mbcnt_hi_u32_b32 %0, -1, %0" : "=v"(l) :: "memory"); return l; }
__device__ __forceinline__ int lwave() { extern __shared__ __attribute__((aligned(16))) unsigned char shm_w[];
    const int hw = __builtin_amdgcn_s_getreg(10244) & 63;
    return __builtin_amdgcn_readfirstlane(*(const __attribute__((address_space(3))) int*)((__attribute__((address_space(3))) unsigned char*)shm_w + WTAB_OFF + hw * 4)); }
__device__ __forceinline__ void wtab_init() { extern __shared__ __attribute__((aligned(16))) unsigned char shm_w[];
    const int hw = __builtin_amdgcn_s_getreg(10244) & 63;
    *(__attribute__((address_space(3))) int*)((__attribute__((address_space(3))) unsigned char*)shm_w + WTAB_OFF + hw * 4) = (int)(threadIdx.x >> 6); }
__device__ __forceinline__ int ltid() { return lwave() * 64 + llane(); }
__device__ __forceinline__ int lbid() { int t = blockIdx.x; asm volatile("" : "+s"(t) :: "memory"); return t; }
namespace pg8 {
#define PG8_LAS __attribute__((address_space(3)))
typedef unsigned short bf16_t;
typedef short bf16x8 __attribute__((ext_vector_type(8)));
typedef float f32x4 __attribute__((ext_vector_type(4)));
typedef unsigned u32x4 __attribute__((ext_vector_type(4)));
constexpr int BM = 256, BK = 64, HALF = 128, HTB = HALF * BK * 2  , STAGE_BYTES = 8 * HTB, NXCD = 8, WGM = 8;

__host__ __device__ __forceinline__ int lds_byte(int r, int c) { const int st = (r >> 4) * 2 + (c >> 5), rr = r & 15, cc = c & 31, ob = rr * 64 + cc * 2; return st * 1024 + (ob ^ (((ob >> 9) & 1) << 5)); }
__host__ __device__ __forceinline__ void stage_rc(int b, int& R, int& C) { const int st = b / 1024, sb = b % 1024, swz = sb ^ (((sb >> 9) & 1) << 5); R = (st >> 1) * 16 + swz / 64; C = (st & 1) * 32 + (swz % 64) / 2; }
__host__ __device__ __forceinline__ int perm32(int rho) { const int n = rho >> 4, i = rho & 15; return 8 * (i >> 2) + 4 * n + (i & 3); }

struct Unit { int pm, pn, kofs; };
struct Gemm { const bf16_t* A; const bf16_t* Bt; int M, N, K, ldk; };

struct StaticOrder {
    int nM, nN, nwg, G, c, lat;
    __host__ __device__ void init(int M, int N, int G_, int c_, int lat_ = 0) { lat = lat_; nM = lat ? 128 : M / BM; nN = N / BM; nwg = nM * nN; G = G_; c = c_; }
    __host__ __device__ bool next(int i, Unit& u) const {
        const long L = (long)i * G + c; if (L >= nwg) return false;
        int wgid = (int)L; { const int q = nwg / NXCD, r = nwg % NXCD, xcd = wgid % NXCD, off = wgid / NXCD; wgid = (xcd < r ? xcd * (q + 1) : r * (q + 1) + (xcd - r) * q) + off; }
        const int nig = WGM * nN, gid = wgid / nig, fm = gid * WGM, gsz = (nM - fm) < WGM ? (nM - fm) : WGM;
        u.pm = fm + ((wgid % nig) % gsz); u.pn = (wgid % nig) / gsz; u.kofs = 0; if (lat) u.pm = (u.pm >> 5) * 33 + 1 + (u.pm & 31); return true;
    }
    __device__ __forceinline__ void a_ready(const Unit&) const {}
    __device__ __forceinline__ void done(const Unit&) const {}
};
__device__ __forceinline__ unsigned cvt_pk_bf16(float lo, float hi) { unsigned r; asm volatile("v_cvt_pk_bf16_f32 %0, %1, %2" : "=v"(r) : "v"(lo), "v"(hi)); return r; }
template <class Epi, class Sched, bool STAMP = false>
__device__ __forceinline__ void gemm_phase(PG8_LAS unsigned char* lds, const Gemm g, const Sched& S, const Epi& E, unsigned long long* stamps) {
    const int tid = ltid(), wid = __builtin_amdgcn_readfirstlane(tid >> 6), lane = tid & 63, wr = wid >> 2, wc = wid & 3, fr = lane & 15, fq = lane >> 4;
    const int K = g.K, nt = K / BK, ldk = g.ldk ? g.ldk : g.K;
    int ts_lo = 0, ts_hi = 0, nts = 0; const unsigned long long rt_entry = STAMP ? (unsigned long long)wall_clock64() : 0ull;
#define PG8_STAMP() do { if (STAMP && wid == 0 && nts < 64) { const unsigned long long _c = (unsigned long long)clock64(); \
        ts_lo = (lane == nts) ? (int)(unsigned)_c : ts_lo; ts_hi = (lane == nts) ? (int)(unsigned)(_c >> 32) : ts_hi; ++nts; } } while (0)
    PG8_STAMP();
    unsigned voffA[2], voffB[2];
#pragma unroll
    for (int i = 0; i < 2; ++i) { int R, C; stage_rc(tid * 16 + i * 8192, R, C); const int Rb = Epi::PERM ? ((R & ~31) + perm32(R & 31)) : R;
        voffA[i] = (unsigned)(R * ldk + C) * 2u; voffB[i] = (unsigned)(Rb * ldk + C) * 2u; }
    const size_t kstep = (size_t)(BK * 2);
    const size_t hstep = (size_t)HALF * ldk * 2;
    const size_t tstep = 2 * hstep;
    const unsigned ldsw = (unsigned)wid * 1024u;
    const int aoff = lds_byte(wr * 64 + fr, fq * 8), boff = lds_byte(wc * 32 + fr, fq * 8);
#define PG8_SA(b, h) (((b) * 2 + (h)) * HTB)
#define PG8_SB(b, h) ((4 + (b) * 2 + (h)) * HTB)
#define PG8_STAGE(bufoff, gbase, voff) do { _Pragma("unroll") for (int _i = 0; _i < 2; ++_i) \
        __builtin_amdgcn_global_load_lds((const unsigned*)((const char*)(gbase) + (voff)[_i]), (PG8_LAS unsigned*)(lds + (bufoff) + ldsw + _i * 8192), 16, 0, 0); } while (0)
#define PG8_LDA(dst, b, h) do { _Pragma("unroll") for (int m = 0; m < 4; ++m) _Pragma("unroll") for (int k = 0; k < 2; ++k) dst[m][k] = *(const PG8_LAS bf16x8*)(lds + PG8_SA(b, h) + aoff + m * 2048 + k * 1024); } while (0)
#define PG8_LDB(dst, b, h) do { _Pragma("unroll") for (int n = 0; n < 2; ++n) _Pragma("unroll") for (int k = 0; k < 2; ++k) dst[n][k] = *(const PG8_LAS bf16x8*)(lds + PG8_SB(b, h) + boff + n * 2048 + k * 1024); } while (0)
#define PG8_MMA(ai, bj, At, Bt) do { __builtin_amdgcn_s_setprio(1); _Pragma("unroll") for (int m = 0; m < 4; ++m) _Pragma("unroll") for (int n = 0; n < 2; ++n) _Pragma("unroll") for (int k = 0; k < 2; ++k) \
        acc[ai][bj][m][n] = __builtin_amdgcn_mfma_f32_16x16x32_bf16(Bt[n][k], At[m][k], acc[ai][bj][m][n], 0, 0, 0); __builtin_amdgcn_s_setprio(0); } while (0)
#define PG8_WAIT_V(n) asm volatile("s_waitcnt vmcnt(" #n ")" ::: "memory")
#define PG8_WAIT_L(n) asm volatile("s_waitcnt lgkmcnt(" #n ")" ::: "memory")
#define PG8_BAR __builtin_amdgcn_s_barrier()
#define PG8_SCHED __builtin_amdgcn_sched_barrier(0)
    Unit cur, nxt; int ui = 0;
    if (!S.next(0, cur)) return;
    f32x4 acc[2][2][4][2];
#pragma unroll
    for (int a = 0; a < 2; ++a)
#pragma unroll
        for (int b = 0; b < 2; ++b)
#pragma unroll
            for (int m = 0; m < 4; ++m)
#pragma unroll
                for (int n = 0; n < 2; ++n) acc[a][b][m][n] = (f32x4){0.f, 0.f, 0.f, 0.f};
    bf16x8 At[4][2], B0[2][2], B1[2][2];
    const char* cA = (const char*)g.A + (size_t)cur.pm * tstep + (size_t)cur.kofs * 2; const char* cB = (const char*)g.Bt + (size_t)cur.pn * tstep + (size_t)cur.kofs * 2;
    S.a_ready(cur);
    PG8_STAGE(PG8_SB(0, 0), cB, voffB); PG8_STAGE(PG8_SA(0, 0), cA, voffA); PG8_STAGE(PG8_SB(0, 1), cB + hstep, voffB); PG8_STAGE(PG8_SA(0, 1), cA + hstep, voffA);
    if (wr == 1) PG8_BAR;
    PG8_WAIT_V(4); PG8_BAR;
    PG8_STAGE(PG8_SB(1, 0), cB + kstep, voffB); PG8_STAGE(PG8_SA(1, 0), cA + kstep, voffA); PG8_STAGE(PG8_SB(1, 1), cB + hstep + kstep, voffB);
    PG8_WAIT_V(6); PG8_BAR;
    PG8_STAMP();
    for (;;) {
        const bool has_next = S.next(ui + 1, nxt);
        const char* nA = has_next ? (const char*)g.A + (size_t)nxt.pm * tstep + (size_t)nxt.kofs * 2 : cA; const char* nB = has_next ? (const char*)g.Bt + (size_t)nxt.pn * tstep + (size_t)nxt.kofs * 2 : cB;
        for (int t = 0; t < nt; t += 2) {
            const bool last = (t == nt - 2);
            const char* a1 = cA + (size_t)(t + 1) * kstep;
            const char* a2 = last ? nA : cA + (size_t)(t + 2) * kstep; const char* b2 = last ? nB : cB + (size_t)(t + 2) * kstep;
            const char* a3 = a2 + kstep; const char* b3 = b2 + kstep;
            if (last && has_next) S.a_ready(nxt);
            PG8_LDB(B0, 0, 0); PG8_SCHED; PG8_LDA(At, 0, 0); PG8_STAGE(PG8_SA(1, 1), a1 + hstep, voffA);
            PG8_WAIT_L(8); PG8_BAR; PG8_WAIT_L(0); PG8_MMA(0, 0, At, B0); PG8_BAR; PG8_SCHED;
            PG8_LDB(B1, 0, 1); PG8_STAGE(PG8_SB(0, 0), b2, voffB);
            PG8_BAR; PG8_WAIT_L(0); PG8_MMA(0, 1, At, B1); PG8_BAR;
            PG8_LDA(At, 0, 1); PG8_STAGE(PG8_SA(0, 0), a2, voffA);
            PG8_BAR; PG8_WAIT_L(0); PG8_MMA(1, 0, At, B0); PG8_BAR; PG8_SCHED;
            PG8_STAGE(PG8_SB(0, 1), b2 + hstep, voffB);
            PG8_WAIT_V(6); PG8_BAR; PG8_MMA(1, 1, At, B1); PG8_BAR;
            PG8_LDB(B0, 1, 0); PG8_SCHED; PG8_LDA(At, 1, 0); PG8_STAGE(PG8_SA(0, 1), a2 + hstep, voffA);
            PG8_WAIT_L(8); PG8_BAR; PG8_WAIT_L(0); PG8_MMA(0, 0, At, B0); PG8_BAR; PG8_SCHED;
            PG8_LDB(B1, 1, 1); PG8_STAGE(PG8_SB(1, 0), b3, voffB);
            PG8_BAR; PG8_WAIT_L(0); PG8_MMA(0, 1, At, B1); PG8_BAR;
            PG8_LDA(At, 1, 1); PG8_STAGE(PG8_SA(1, 0), a3, voffA);
            PG8_BAR; PG8_WAIT_L(0); PG8_MMA(1, 0, At, B0); PG8_BAR; PG8_SCHED;
            PG8_STAGE(PG8_SB(1, 1), b3 + hstep, voffB);
            PG8_WAIT_V(6); PG8_BAR; PG8_MMA(1, 1, At, B1); PG8_BAR;
        }
        PG8_STAMP();
        if constexpr (!Epi::AFTER_DRAIN) { E(acc, cur, wr, wc, fr, fq); S.done(cur); }
        PG8_STAMP();
        if (!has_next) break;
#pragma unroll
        for (int a = 0; a < 2; ++a)
#pragma unroll
            for (int b = 0; b < 2; ++b)
#pragma unroll
                for (int m = 0; m < 4; ++m)
#pragma unroll
                    for (int n = 0; n < 2; ++n) acc[a][b][m][n] = (f32x4){0.f, 0.f, 0.f, 0.f};
        cur = nxt; cA = nA; cB = nB; ++ui;
    }
    PG8_WAIT_V(0);
    if (wr == 0) PG8_BAR;
    PG8_BAR;
    if constexpr (Epi::AFTER_DRAIN) { E.fused(acc, cur, wr, wc, fr, fq, lds, wid, lane); S.done(cur); }
    PG8_STAMP();
    if (STAMP && wid == 0) { stamps[lane] = lane < nts ? (((unsigned long long)(unsigned)ts_hi << 32) | (unsigned)ts_lo) : 0ull;
        if (lane == 62) stamps[62] = rt_entry; if (lane == 63) stamps[63] = (unsigned long long)wall_clock64(); }
#undef PG8_STAMP
#undef PG8_SA
#undef PG8_SB
#undef PG8_STAGE
#undef PG8_LDA
#undef PG8_LDB
#undef PG8_MMA
#undef PG8_WAIT_V
#undef PG8_WAIT_L
#undef PG8_BAR
#undef PG8_SCHED
}
}

typedef unsigned short u16;
using pg8::f32x4; using pg8::bf16x8;
typedef float f32x2 __attribute__((ext_vector_type(2)));
typedef unsigned u32x2 __attribute__((ext_vector_type(2)));
typedef unsigned u32x4v __attribute__((ext_vector_type(4)));
typedef short s16x4 __attribute__((ext_vector_type(4)));
#define LAS __attribute__((address_space(3)))
constexpr int D = 1024, NB = 4, SEQ = 8192, CTX = 256, TPB = 8448, NTOK = 33792, FF = 2816, NCH = 132, INNER = 2048, DH = 512, NFFT = 16384;
constexpr size_t MiB = 1u << 20;
constexpr size_t OFF_WB = 0, OFF_MOD = 48 * MiB, OFF_H = 49 * MiB, OFF_U = OFF_H + 132 * MiB, OFF_R1 = OFF_U + 66 * MiB, OFF_R2 = OFF_R1 + 264 * MiB,
                 OFF_HBC = OFF_R2 + 132 * MiB, OFF_GATES = OFF_HBC + 4 * MiB, OFF_H2 = OFF_GATES + 3 * MiB, OFF_KCTX = OFF_H2 + 3 * MiB, WS_NEED = OFF_KCTX + 4 * MiB;
constexpr size_t WB_FIN0 = 0, WB_FIN1 = 11 * MiB, WB_FOUT0 = 22 * MiB, WB_FOUT1 = 22 * MiB + 5632 * 1024, WB_MIN = 33 * MiB, WB_MOUT = 41 * MiB, WB_WGT = 45 * MiB;
constexpr int LDS_BYTES = 163840;
struct KP { const float* in[36]; float* out; unsigned char* ws; int ph_lo, ph_hi; };
typedef const KP __attribute__((address_space(4))) * KPC;
enum { I_X = 0, I_C, I_CTX, I_CCTX, I_ADAW, I_ADAB, I_NORMG, I_FINALG, I_FFNIN, I_FFNOUT, I_HYWIN, I_HYBIN, I_HYCW, I_HYCB, I_HYW1, I_HYB1, I_HYW2, I_HYB2, I_HYW3, I_HYB3,
       I_HYFREQ, I_HYDECAY, I_HYSKIP, I_HYWOUT, I_HYBOUT, I_MLUP, I_MLCW, I_MLCB, I_MLWQ, I_MLWK, I_MLWV, I_MLWG, I_MLBG, I_MLNG, I_MLSKIP, I_MLDOWN };

__device__ __forceinline__ float bf2f(u16 b) { return __uint_as_float(((unsigned)b) << 16); }
__device__ __forceinline__ float bflo(unsigned w) { return __uint_as_float(w << 16); }
__device__ __forceinline__ float bfhi(unsigned w) { return __uint_as_float(w & 0xffff0000u); }
__device__ __forceinline__ u16 f2bf(float f) { return (u16)(pg8::cvt_pk_bf16(f, 0.f) & 0xffffu); }
__device__ __forceinline__ float siluf(float x) { return x / (1.0f + __expf(-x)); }
__device__ __forceinline__ int modrow_of_token(int T) { const int b = T / TPB, t = T - b * TPB; return t < CTX ? 4 : b; }
__device__ __forceinline__ float lshfl(float v, int srclane) { return __int_as_float(__builtin_amdgcn_ds_bpermute(srclane << 2, __float_as_int(v))); }
__device__ __forceinline__ float wave_sum(float v) { const int lane = llane();
#pragma unroll
    for (int o = 32; o > 0; o >>= 1) v += lshfl(v, lane ^ o);
    return v; }
__device__ __forceinline__ float wave_max(float v) { const int lane = llane();
#pragma unroll
    for (int o = 32; o > 0; o >>= 1) v = fmaxf(v, lshfl(v, lane ^ o));
    return v; }

__device__ __forceinline__ void unpack8(u32x4v w, float (&f)[8]) { f[0] = bflo(w.x); f[1] = bfhi(w.x); f[2] = bflo(w.y); f[3] = bfhi(w.y); f[4] = bflo(w.z); f[5] = bfhi(w.z); f[6] = bflo(w.w); f[7] = bfhi(w.w); }
__device__ __forceinline__ u32x4v pack8(const float (&f)[8]) { u32x4v w; w.x = pg8::cvt_pk_bf16(f[0], f[1]); w.y = pg8::cvt_pk_bf16(f[2], f[3]); w.z = pg8::cvt_pk_bf16(f[4], f[5]); w.w = pg8::cvt_pk_bf16(f[6], f[7]); return w; }

struct EpiSwiglu {
    static constexpr bool PERM = true, AFTER_DRAIN = false;
    u16* act;
    __device__ __forceinline__ void operator()(const f32x4 (&acc)[2][2][4][2], const pg8::Unit& u, int wr, int wc, int fr, int fq) const {
        const int row0 = u.pm * 256 + wr * 64 + fr, col0 = u.pn * 128 + wc * 32 + 8 * fq;
#pragma unroll
        for (int ai = 0; ai < 2; ++ai)
#pragma unroll
            for (int m = 0; m < 4; ++m) {
                const f32x4 g0 = acc[ai][0][m][0], g1 = acc[ai][0][m][1], v0 = acc[ai][1][m][0], v1 = acc[ai][1][m][1];
                u32x4v w;
                w.x = pg8::cvt_pk_bf16(siluf(g0[0]) * v0[0], siluf(g0[1]) * v0[1]); w.y = pg8::cvt_pk_bf16(siluf(g0[2]) * v0[2], siluf(g0[3]) * v0[3]);
                w.z = pg8::cvt_pk_bf16(siluf(g1[0]) * v1[0], siluf(g1[1]) * v1[1]); w.w = pg8::cvt_pk_bf16(siluf(g1[2]) * v1[2], siluf(g1[3]) * v1[3]);
                *(u32x4v*)(act + (size_t)(row0 + ai * 128 + m * 16) * FF + col0) = w; }
    }
};
struct EpiResid {
    static constexpr bool PERM = false, AFTER_DRAIN = false;
    float* h; const float* modl; int gidx; float scale; const float* bias;
    __device__ __forceinline__ void operator()(const f32x4 (&acc)[2][2][4][2], const pg8::Unit& u, int wr, int wc, int fr, int fq) const {
        const int row0 = u.pm * 256 + wr * 64 + fr, col0 = u.pn * 256 + wc * 32 + 4 * fq;
        const int mr = modrow_of_token(u.pm * 256);
        const float* gp = modl + (size_t)mr * 9216 + gidx * 1024;
        f32x4 gv[2][2], bv[2][2];
#pragma unroll
        for (int bj = 0; bj < 2; ++bj)
#pragma unroll
            for (int n = 0; n < 2; ++n) { gv[bj][n] = *(const f32x4*)(gp + col0 + bj * 128 + n * 16) * scale;
                bv[bj][n] = bias ? *(const f32x4*)(bias + col0 + bj * 128 + n * 16) : (f32x4){0.f, 0.f, 0.f, 0.f}; }
#pragma unroll
        for (int ai = 0; ai < 2; ++ai)
#pragma unroll
            for (int m = 0; m < 4; ++m) { float* rowp = h + (size_t)(row0 + ai * 128 + m * 16) * D + col0;
#pragma unroll
                for (int bj = 0; bj < 2; ++bj)
#pragma unroll
                    for (int n = 0; n < 2; ++n) { f32x4* q = (f32x4*)(rowp + bj * 128 + n * 16); *q = *q + gv[bj][n] * (acc[ai][bj][m][n] + bv[bj][n]); } }
    }
};
struct EpiBf {
    static constexpr bool PERM = true, AFTER_DRAIN = false;
    u16* O; int ldc;
    __device__ __forceinline__ void operator()(const f32x4 (&acc)[2][2][4][2], const pg8::Unit& u, int wr, int wc, int fr, int fq) const {
        const int row0 = u.pm * 256 + wr * 64 + fr, col0 = u.pn * 256 + wc * 32 + 8 * fq;
#pragma unroll
        for (int ai = 0; ai < 2; ++ai)
#pragma unroll
            for (int m = 0; m < 4; ++m)
#pragma unroll
                for (int bj = 0; bj < 2; ++bj) { const f32x4 a = acc[ai][bj][m][0], b = acc[ai][bj][m][1]; u32x4v w;
                    w.x = pg8::cvt_pk_bf16(a[0], a[1]); w.y = pg8::cvt_pk_bf16(a[2], a[3]); w.z = pg8::cvt_pk_bf16(b[0], b[1]); w.w = pg8::cvt_pk_bf16(b[2], b[3]);
                    *(u32x4v*)(O + (size_t)(row0 + ai * 128 + m * 16) * ldc + col0 + bj * 128) = w; }
    }
};
struct EpiProjT {
    static constexpr bool PERM = true, AFTER_DRAIN = false;
    u16* lat; u16* ctx; const float* bias;
    __device__ __forceinline__ void operator()(const f32x4 (&acc)[2][2][4][2], const pg8::Unit& u, int wr, int wc, int fr, int fq) const {
        const int row0 = u.pm * 256 + wr * 64 + fr, tc0 = wc * 32 + 8 * fq;
        const int b = u.pn / 33, tile = u.pn - b * 33;
#pragma unroll
        for (int ai = 0; ai < 2; ++ai)
#pragma unroll
            for (int m = 0; m < 4; ++m) { const int ch = row0 + ai * 128 + m * 16; const float bs = bias[ch];
                u16* dst = tile == 0 ? ctx + ((size_t)b * 3072 + ch) * CTX + tc0 : lat + ((size_t)b * 3072 + ch) * SEQ + (tile - 1) * 256 + tc0;
#pragma unroll
                for (int bj = 0; bj < 2; ++bj) { const f32x4 a = acc[ai][bj][m][0] + bs, c = acc[ai][bj][m][1] + bs; u32x4v w;
                    w.x = pg8::cvt_pk_bf16(a[0], a[1]); w.y = pg8::cvt_pk_bf16(a[2], a[3]); w.z = pg8::cvt_pk_bf16(c[0], c[1]); w.w = pg8::cvt_pk_bf16(c[2], c[3]);
                    *(u32x4v*)(dst + bj * 128) = w; } }
    }
};


struct LatOrder : pg8::StaticOrder {
    __device__ bool next(int i, pg8::Unit& u) const { if (!pg8::StaticOrder::next(i, u)) return false; u.pm = (u.pm >> 5) * 33 + 1 + (u.pm & 31); return true; }
};
struct CtxSplitOrder {
    int nk, G, c;
    __device__ bool next(int i, pg8::Unit& u) const { const int L = i * G + c; if (L >= 16 * nk) return false; const int un = L & 15, kc = L >> 4; u.pm = (un >> 2) * 33; u.pn = un & 3; u.kofs = kc * 256; return true; }
    __device__ __forceinline__ void a_ready(const pg8::Unit&) const {}
    __device__ __forceinline__ void done(const pg8::Unit&) const {}
};
struct EpiResidAtomic {
    static constexpr bool PERM = false, AFTER_DRAIN = false;
    float* h; const float* gp; float scale;
    __device__ __forceinline__ void operator()(const f32x4 (&acc)[2][2][4][2], const pg8::Unit& u, int wr, int wc, int fr, int fq) const {
        const int row0 = u.pm * 256 + wr * 64 + fr, col0 = u.pn * 256 + wc * 32 + 4 * fq;
#pragma unroll
        for (int bj = 0; bj < 2; ++bj)
#pragma unroll
            for (int n = 0; n < 2; ++n) { const f32x4 gv = *(const f32x4*)(gp + col0 + bj * 128 + n * 16) * scale;
#pragma unroll
                for (int ai = 0; ai < 2; ++ai)
#pragma unroll
                    for (int m = 0; m < 4; ++m) { float* q = h + (size_t)(row0 + ai * 128 + m * 16) * D + col0 + bj * 128 + n * 16; const f32x4 v = gv * acc[ai][bj][m][n];
                        atomicAdd(q, v[0]); atomicAdd(q + 1, v[1]); atomicAdd(q + 2, v[2]); atomicAdd(q + 3, v[3]); } }
    }
};

__device__ __forceinline__ void ctx_bias_phase(KPC kp, const float* gp, const float* bias) {
    float* h = (float*)(kp->ws + OFF_H);
    for (int i = lbid() * 512 + ltid(); i < NB * CTX * 256; i += gridDim.x * 512) { const int r = i >> 8, c = (i & 255) * 4, b = r >> 8, t = r & 255;
        f32x4* q = (f32x4*)(h + ((size_t)b * TPB + t) * D + c); *q = *q + *(const f32x4*)(gp + c) * *(const f32x4*)(bias + c); }
}
__device__ __forceinline__ int colmap(int n, int mapmode) { return mapmode ? (((n >> 8) << 7) + (n & 127) + ((n >> 7) & 1) * FF) : n; }
__device__ __forceinline__ void convert_T(const float* __restrict__ src, int ld, int K, int Nd, int mapmode, u16* __restrict__ dst, LAS float* tile, int& tctr) {
    const int tid = ltid(), nkt = K / 64, ntile = (Nd / 64) * nkt;
    const int G = (int)gridDim.x; const int first = (((lbid() - tctr) % G) + G) % G; tctr += ntile;
    for (int t = first; t < ntile; t += G) {
        const int n0 = (t / nkt) * 64, k0 = (t % nkt) * 64, c0 = colmap(n0, mapmode);
#pragma unroll
        for (int i = 0; i < 2; ++i) { const int e = tid + 512 * i, kr = e >> 4, c4 = (e & 15) * 4;
            const f32x4 v = *(const f32x4*)(src + (size_t)(k0 + kr) * ld + c0 + c4);
            tile[kr * 65 + c4] = v[0]; tile[kr * 65 + c4 + 1] = v[1]; tile[kr * 65 + c4 + 2] = v[2]; tile[kr * 65 + c4 + 3] = v[3]; }
        __syncthreads();
        { const int n = tid >> 3, k8 = (tid & 7) * 8; u32x4v w;
          w.x = pg8::cvt_pk_bf16(tile[(k8 + 0) * 65 + n], tile[(k8 + 1) * 65 + n]); w.y = pg8::cvt_pk_bf16(tile[(k8 + 2) * 65 + n], tile[(k8 + 3) * 65 + n]);
          w.z = pg8::cvt_pk_bf16(tile[(k8 + 4) * 65 + n], tile[(k8 + 5) * 65 + n]); w.w = pg8::cvt_pk_bf16(tile[(k8 + 6) * 65 + n], tile[(k8 + 7) * 65 + n]);
          *(u32x4v*)(dst + (size_t)(n0 + n) * K + k0 + k8) = w; }
        __syncthreads();
    }
}

__device__ __forceinline__ void norm_phase(KPC kp, int l, int sub) {
    const float* h = (const float*)(kp->ws + OFF_H); u16* uo = (u16*)(kp->ws + OFF_U);
    const float* g = kp->in[I_NORMG] + (size_t)(l * 3 + sub) * D; const float* modl = (const float*)(kp->ws + OFF_MOD) + (size_t)l * 5 * 9216;
    const int lane = ltid() & 63, wv = ltid() >> 6;
    for (int T = lbid() * 8 + wv; T < NTOK; T += gridDim.x * 8) {
        const float* hr = h + (size_t)T * D; f32x4 v[4]; float ss = 0.f;
#pragma unroll
        for (int i = 0; i < 4; ++i) { v[i] = *(const f32x4*)(hr + i * 256 + lane * 4); ss += v[i][0] * v[i][0] + v[i][1] * v[i][1] + v[i][2] * v[i][2] + v[i][3] * v[i][3]; }
        ss = wave_sum(ss); const float rs = rsqrtf(ss * (1.0f / D) + 1e-6f);
        const float* mp = modl + (size_t)modrow_of_token(T) * 9216 + sub * 3 * 1024;
#pragma unroll
        for (int i = 0; i < 4; ++i) { const int c = i * 256 + lane * 4; const f32x4 gg = *(const f32x4*)(g + c), sh = *(const f32x4*)(mp + c), sc = *(const f32x4*)(mp + 1024 + c);
            const f32x4 o = v[i] * rs * gg * (sc + 1.0f) + sh; u32x2 w; w.x = pg8::cvt_pk_bf16(o[0], o[1]); w.y = pg8::cvt_pk_bf16(o[2], o[3]);
            *(u32x2*)(uo + (size_t)T * D + c) = w; }
    }
}

__device__ __forceinline__ void final_phase(KPC kp) {
    const float* h = (const float*)(kp->ws + OFF_H); const float* g = kp->in[I_FINALG];
    const int lane = ltid() & 63, wv = ltid() >> 6;
    for (int r = lbid() * 8 + wv; r < NB * SEQ; r += gridDim.x * 8) {
        const int b = r / SEQ, s = r - b * SEQ; const float* hr = h + ((size_t)b * TPB + CTX + s) * D; f32x4 v[4]; float ss = 0.f;
#pragma unroll
        for (int i = 0; i < 4; ++i) { v[i] = *(const f32x4*)(hr + i * 256 + lane * 4); ss += v[i][0] * v[i][0] + v[i][1] * v[i][1] + v[i][2] * v[i][2] + v[i][3] * v[i][3]; }
        ss = wave_sum(ss); const float rs = rsqrtf(ss * (1.0f / D) + 1e-6f);
#pragma unroll
        for (int i = 0; i < 4; ++i) { const int c = i * 256 + lane * 4; *(f32x4*)(kp->out + (size_t)r * D + c) = v[i] * rs * *(const f32x4*)(g + c); }
    }
}

__device__ __forceinline__ void setup_phase(KPC kp, LAS float* ldsf) {
    float* h = (float*)(kp->ws + OFF_H); const int tid = ltid();
    const int hb0 = gridDim.x > 64 ? 32 : 0;
    for (size_t i = (size_t)(lbid() - hb0) * 512 + tid; lbid() >= hb0 && i < (size_t)NTOK * 256; i += (size_t)(gridDim.x - hb0) * 512) {
        const int T = (int)(i >> 8), c = ((int)i & 255) * 4, b = T / TPB, t = T - b * TPB; f32x4 v;
        if (t < CTX) v = *(const f32x4*)(kp->in[I_CTX] + ((size_t)b * CTX + t) * D + c);
        else { const int s = t - CTX; v = *(const f32x4*)(kp->in[I_X] + ((size_t)b * SEQ + s) * D + c);
            const int half = c >> 9, cc = c & 511, isc = cc >> 8, i0 = cc & 255; const float pv = half ? (float)(s & 63) : (float)(s >> 6);
#pragma unroll
            for (int e = 0; e < 4; ++e) { const float om = exp2f(-13.287712379549449f * (float)(i0 + e) * (1.0f / 256.0f)); const float ang = pv * om; v[e] += isc ? __cosf(ang) : __sinf(ang); } }
        *(f32x4*)(h + (size_t)T * D + c) = v;
    }
    LAS float* sc = ldsf; LAS float* red = ldsf + 5 * 1024;
    for (int i = tid; i < 5 * 1024; i += 512) { const int r = i >> 10, k = i & 1023; const float cv = r < 4 ? kp->in[I_C][r * D + k] : kp->in[I_CCTX][k]; sc[i] = siluf(cv); }
    __syncthreads();
    float* mod = (float*)(kp->ws + OFF_MOD); const int lane = tid & 63, wv = tid >> 6;
    for (int task = lbid(); task < 288; task += gridDim.x) {
        const int l = task / 72, n0 = (task % 72) * 128 + lane * 2; const float* w = kp->in[I_ADAW] + (size_t)l * D * 9216 + n0;
        f32x2 a[5];
#pragma unroll
        for (int r = 0; r < 5; ++r) a[r] = (f32x2){0.f, 0.f};
#pragma unroll 16
        for (int k = wv * 128; k < wv * 128 + 128; ++k) { const f32x2 wv2 = *(const f32x2*)(w + (size_t)k * 9216);
#pragma unroll
            for (int r = 0; r < 5; ++r) a[r] += wv2 * sc[r * 1024 + k]; }
#pragma unroll
        for (int r = 0; r < 5; ++r) { red[(wv * 5 + r) * 128 + lane * 2] = a[r][0]; red[(wv * 5 + r) * 128 + lane * 2 + 1] = a[r][1]; }
        __syncthreads();
        for (int i = tid; i < 640; i += 512) { const int r = i >> 7, n = i & 127; float s = 0.f;
#pragma unroll
            for (int w8 = 0; w8 < 8; ++w8) s += red[(w8 * 5 + r) * 128 + n];
            const int nn = (task % 72) * 128 + n; mod[((size_t)l * 5 + r) * 9216 + nn] = s + kp->in[I_ADAB][(size_t)l * 9216 + nn]; }
        __syncthreads();
    }
}

__device__ __forceinline__ void convert_layer(KPC kp, int l, LAS float* tile) {
    unsigned char* wb = kp->ws + OFF_WB; int tctr = 0; const int j = l >> 1;
    for (int f = 0; f < 2; ++f) {
        convert_T(kp->in[I_FFNIN] + (size_t)(l * 2 + f) * D * 2 * FF, 2 * FF, D, 2 * FF, 1, (u16*)(wb + (f ? WB_FIN1 : WB_FIN0)), tile, tctr);
        convert_T(kp->in[I_FFNOUT] + (size_t)(l * 2 + f) * FF * D, D, FF, D, 0, (u16*)(wb + (f ? WB_FOUT1 : WB_FOUT0)), tile, tctr);
    }
    if ((l & 1) == 0) {
        convert_T(kp->in[I_HYWIN] + (size_t)j * D * 3 * D, 3 * D, D, 3 * D, 0, (u16*)(wb + WB_MIN), tile, tctr);
        convert_T(kp->in[I_HYWOUT] + (size_t)j * D * D, D, D, D, 0, (u16*)(wb + WB_MOUT), tile, tctr);
    } else {
        convert_T(kp->in[I_MLUP] + (size_t)j * D * 2 * INNER, 2 * INNER, D, 2 * INNER, 0, (u16*)(wb + WB_MIN), tile, tctr);
        convert_T(kp->in[I_MLDOWN] + (size_t)j * INNER * D, D, INNER, D, 0, (u16*)(wb + WB_MOUT), tile, tctr);
        u16* wg = (u16*)(wb + WB_WGT); const float* src = kp->in[I_MLWG] + (size_t)j * 3 * INNER * 16;
        for (int i = lbid() * 512 + ltid(); i < 16 * 3 * INNER; i += gridDim.x * 512) { const int o = i / (3 * INNER), k = i - o * 3 * INNER; wg[i] = f2bf(src[(size_t)k * 16 + o]); }
        float* gates = (float*)(kp->ws + OFF_GATES); const float* bg = kp->in[I_MLBG] + j * 16;
        for (int i = lbid() * 512 + ltid(); i < NTOK * 16; i += gridDim.x * 512) gates[i] = bg[i & 15];
    }
}

constexpr size_t HY_PL = 0, HY_PC = (size_t)NB * 3072 * SEQ * 2, HY_YL = HY_PC + (size_t)NB * 3072 * CTX * 2, HY_YC = HY_YL + (size_t)NB * D * SEQ * 2;
__device__ __forceinline__ int fphys(int i) { return i ^ ((((i >> 6) & 1) * 21) ^ (((i >> 5) & 1) * 10)); }
__device__ __forceinline__ f32x2 cmul(f32x2 a, f32x2 b) { return (f32x2){a.x * b.x - a.y * b.y, a.x * b.y + a.y * b.x}; }
__device__ __forceinline__ f32x2 cmulc(f32x2 a, f32x2 b) { return (f32x2){a.x * b.x + a.y * b.y, a.y * b.x - a.x * b.y}; }
__device__ __forceinline__ int drev(int x) { const unsigned r = __brev((unsigned)x) >> 18; return (int)(((r & 0x2AAAu) >> 1) | ((r & 0x1555u) << 1)); }

__device__ __forceinline__ void fidx4(int base, int lm, int (&ix)[4]) {
    const int m = 1 << lm;
    if (lm == 6) { const int i0 = fphys(base); ix[0] = i0; ix[1] = (i0 + 64) ^ 21; ix[2] = i0 + 128; ix[3] = (i0 + 192) ^ 21; }
    else if (lm == 4) { const int c6 = ((base >> 6) & 1) * 21; ix[0] = base ^ c6; ix[1] = (base + 16) ^ c6; ix[2] = (base + 32) ^ c6 ^ 10; ix[3] = (base + 48) ^ c6 ^ 10; }
    else { const int c = (((base >> 6) & 1) * 21) ^ (((base >> 5) & 1) * 10); ix[0] = base ^ c; ix[1] = (base + m) ^ c; ix[2] = (base + 2 * m) ^ c; ix[3] = (base + 3 * m) ^ c; }
}
__device__ __forceinline__ void fft_fwd(LAS f32x2* buf) {
    const int tid = ltid();
    for (int lm = 12; lm >= 0; lm -= 2) {
        const int m = 1 << lm; const float inv = 1.0f / (float)(4 << lm);
        f32x2 a[8][4]; int ix[8][4];
#pragma unroll
        for (int i = 0; i < 8; ++i) { const int g = tid + 512 * i, p = g & (m - 1), base = ((g >> lm) << (lm + 2)) + p; fidx4(base, lm, ix[i]);
#pragma unroll
            for (int r = 0; r < 4; ++r) a[i][r] = buf[ix[i][r]]; }
#pragma unroll
        for (int i = 0; i < 8; ++i) { const int p = (tid + 512 * i) & (m - 1);
            const f32x2 t0 = a[i][0] + a[i][2], t1 = a[i][0] - a[i][2], t2 = a[i][1] + a[i][3], dd = a[i][1] - a[i][3], t3 = (f32x2){dd.y, -dd.x};
            const float rev = (float)p * inv;
            const f32x2 w1 = (f32x2){__builtin_amdgcn_cosf(rev), -__builtin_amdgcn_sinf(rev)}, w2 = cmul(w1, w1), w3 = cmul(w2, w1);
            buf[ix[i][0]] = t0 + t2; buf[ix[i][1]] = cmul(t1 + t3, w1); buf[ix[i][2]] = cmul(t0 - t2, w2); buf[ix[i][3]] = cmul(t1 - t3, w3); }
        __syncthreads();
    }
}
__device__ __forceinline__ void fft_inv(LAS f32x2* buf) {
    const int tid = ltid();
    for (int lm = 0; lm <= 12; lm += 2) {
        const int m = 1 << lm; const float inv = 1.0f / (float)(4 << lm);
        f32x2 a[8][4]; int ix[8][4];
#pragma unroll
        for (int i = 0; i < 8; ++i) { const int g = tid + 512 * i, p = g & (m - 1), base = ((g >> lm) << (lm + 2)) + p; fidx4(base, lm, ix[i]);
#pragma unroll
            for (int r = 0; r < 4; ++r) a[i][r] = buf[ix[i][r]]; }
#pragma unroll
        for (int i = 0; i < 8; ++i) { const int p = (tid + 512 * i) & (m - 1);
            const float rev = (float)p * inv;
            const f32x2 w1 = (f32x2){__builtin_amdgcn_cosf(rev), -__builtin_amdgcn_sinf(rev)}, w2 = cmul(w1, w1), w3 = cmul(w2, w1);
            const f32x2 b0 = a[i][0], b1 = cmulc(a[i][1], w1), b2 = cmulc(a[i][2], w2), b3 = cmulc(a[i][3], w3);
            const f32x2 s0 = b0 + b2, s1 = b0 - b2, s2 = b1 + b3, dd = b1 - b3, s3 = (f32x2){-dd.y, dd.x};
            buf[ix[i][0]] = s0 + s2; buf[ix[i][1]] = s1 + s3; buf[ix[i][2]] = s0 - s2; buf[ix[i][3]] = s1 - s3; }
        __syncthreads();
    }
}

__device__ __forceinline__ void hy_mlp_phase(KPC kp, int j) {
    float* h2 = (float*)(kp->ws + OFF_H2);
    const float* w1 = kp->in[I_HYW1] + j * 33 * 64; const float* b1 = kp->in[I_HYB1] + j * 64; const float* w2 = kp->in[I_HYW2] + j * 64 * 64; const float* b2 = kp->in[I_HYB2] + j * 64;
    const float* fr = kp->in[I_HYFREQ] + j * 128; const int lane = ltid() & 63, wv = ltid() >> 6;
    for (int pos = lbid() * 8 + wv; pos < SEQ + CTX; pos += gridDim.x * 8) {
        const int n = pos < SEQ ? SEQ : CTX, t = pos < SEQ ? pos : pos - SEQ; const float tn = (float)t / (float)(n - 1);
        float feat = 0.f;
        if (lane == 0) feat = tn;
        else if (lane < 33) { const int bi = (lane - 1) & 15; const float band = 1e-4f + (float)bi * ((15.0f - 1e-4f) / 15.0f); float rev = ((float)t / (float)n) * band; rev -= floorf(rev);
            const float ang = 6.283185307179586f * rev; feat = lane < 17 ? cosf(ang) : -sinf(ang); }
        float z = b1[lane];
        for (int i = 0; i < 33; ++i) z += lshfl(feat, i) * w1[i * 64 + lane];
        const float h1 = sinf(fr[lane] * z);
        float z2 = b2[lane];
        for (int v = 0; v < 64; ++v) z2 += lshfl(h1, v) * w2[v * 64 + lane];
        h2[(size_t)pos * 64 + lane] = sinf(fr[64 + lane] * z2);
    }
}

__device__ __forceinline__ void block_sum2(float& a, float& b, LAS float* red) {
    a = wave_sum(a); b = wave_sum(b); const int lane = ltid() & 63, wv = ltid() >> 6;
    __syncthreads(); if (lane == 0) { red[wv] = a; red[8 + wv] = b; } __syncthreads();
    float sa = 0.f, sb = 0.f;
#pragma unroll
    for (int i = 0; i < 8; ++i) { sa += red[i]; sb += red[8 + i]; }
    a = sa; b = sb;
}

__device__ __forceinline__ void hy_filter_task(KPC kp, int j, int task, LAS f32x2* buf, LAS float* aux) {
    const int tid = ltid(), d = task & 1023; const bool lat = task < 1024;
    const float* w3 = kp->in[I_HYW3] + (size_t)j * 64 * 4096; const float* b3 = kp->in[I_HYB3] + j * 4096; const float* ldc = kp->in[I_HYDECAY] + j * 4096;
    __syncthreads();
    if (tid < 256) aux[tid] = w3[(size_t)(tid & 63) * 4096 + (tid >> 6) * 1024 + d];
    if (tid < 4) { aux[256 + tid] = b3[tid * 1024 + d]; aux[260 + tid] = __expf(ldc[tid * 1024 + d]); }
    __syncthreads();
    const float* h2 = (const float*)(kp->ws + OFF_H2);
    float ss0 = 0.f, ss1 = 0.f;
    if (lat) {
        for (int r = 0; r < 16; ++r) { const int i = tid + 512 * r; float a0 = aux[256], a1 = aux[257], a2 = aux[258], a3 = aux[259];
#pragma unroll 4
            for (int u4 = 0; u4 < 16; ++u4) { const f32x4 hv = *(const f32x4*)(h2 + (size_t)i * 64 + u4 * 4);
                const f32x4 q0 = *(const LAS f32x4*)(aux + u4 * 4), q1 = *(const LAS f32x4*)(aux + 64 + u4 * 4), q2 = *(const LAS f32x4*)(aux + 128 + u4 * 4), q3 = *(const LAS f32x4*)(aux + 192 + u4 * 4);
#pragma unroll
                for (int e = 0; e < 4; ++e) { a0 += hv[e] * q0[e]; a1 += hv[e] * q1[e]; a2 += hv[e] * q2[e]; a3 += hv[e] * q3[e]; } }
            const float tn = (float)i * (1.0f / 8191.0f);
            a0 *= __expf(-tn * aux[260]); a1 *= __expf(-tn * aux[261]); a2 *= __expf(-tn * aux[262]); a3 *= __expf(-tn * aux[263]);
            buf[fphys(i)] = (f32x2){a0, a2}; ss0 += a0 * a0; ss1 += a2 * a2;
            if (i >= 1) { buf[fphys(NFFT - i)] = (f32x2){a1, a3}; ss0 += a1 * a1; ss1 += a3 * a3; } }
        if (tid == 0) buf[fphys(SEQ)] = (f32x2){0.f, 0.f};
        block_sum2(ss0, ss1, aux + 272);
        const f32x2 scl = (f32x2){rsqrtf(ss0 + 1e-12f) * (1.0f / NFFT), rsqrtf(ss1 + 1e-12f) * (1.0f / NFFT)};
        for (int r = 0; r < 32; ++r) { const int q = fphys(tid + 512 * r); buf[q] = buf[q] * scl; }
        __syncthreads();
        fft_fwd(buf);
        f32x2* K0 = (f32x2*)(kp->ws + OFF_R2) + (size_t)d * NFFT; f32x2* K1 = (f32x2*)kp->out + (size_t)d * NFFT;
        for (int r = 0; r < 32; ++r) { const int pos = tid + 512 * r, k = drev(pos), pos2 = drev((NFFT - k) & (NFFT - 1)); const f32x2 Z = buf[fphys(pos)], Z2 = buf[fphys(pos2)];
            K0[pos] = (f32x2){0.5f * (Z.x + Z2.x), 0.5f * (Z.y - Z2.y)}; K1[pos] = (f32x2){0.5f * (Z.y + Z2.y), -0.5f * (Z.x - Z2.x)}; }
    } else {
        const int idx = tid; float a0 = 0.f, a1 = 0.f;
        if (idx != CTX) { const int t = idx < CTX ? idx : 2 * CTX - idx, dir = idx < CTX ? 0 : 1; a0 = aux[256 + dir]; a1 = aux[258 + dir];
            for (int u4 = 0; u4 < 16; ++u4) { const f32x4 hv = *(const f32x4*)(h2 + (size_t)(SEQ + t) * 64 + u4 * 4);
#pragma unroll
                for (int e = 0; e < 4; ++e) { const int u = u4 * 4 + e; a0 += hv[e] * aux[dir * 64 + u]; a1 += hv[e] * aux[128 + dir * 64 + u]; } }
            const float tn = (float)t * (1.0f / 255.0f); a0 *= __expf(-tn * aux[260 + dir]); a1 *= __expf(-tn * aux[262 + dir]); }
        ss0 = a0 * a0; ss1 = a1 * a1;
        block_sum2(ss0, ss1, aux + 272);
        float* kc = (float*)(kp->ws + OFF_KCTX);
        kc[(size_t)d * 512 + idx] = a0 * rsqrtf(ss0 + 1e-12f); kc[(size_t)(1024 + d) * 512 + idx] = a1 * rsqrtf(ss1 + 1e-12f);
    }
}

__device__ __forceinline__ float ld3(const u16* row, int t, int n, float wa, float wb, float wc, float bias) {
    const float xm = t > 0 ? bf2f(row[t - 1]) : 0.f, x0 = bf2f(row[t]), xp = t < n - 1 ? bf2f(row[t + 1]) : 0.f; return wa * xm + wb * x0 + wc * xp + bias; }

__device__ __forceinline__ void ld3x8(const u16* row, int t0, float wa, float wb, float wc, float bias, float (&o)[8]) {
    const u32x4v w = *(const u32x4v*)(row + t0);
    const float x0 = bflo(w.x), x1 = bfhi(w.x), x2 = bflo(w.y), x3 = bfhi(w.y), x4 = bflo(w.z), x5 = bfhi(w.z), x6 = bflo(w.w), x7 = bfhi(w.w);
    const float xl = t0 > 0 ? bf2f(row[t0 - 1]) : 0.f, xr = t0 + 8 < SEQ ? bf2f(row[t0 + 8]) : 0.f;
    o[0] = wa * xl + wb * x0 + wc * x1 + bias; o[1] = wa * x0 + wb * x1 + wc * x2 + bias; o[2] = wa * x1 + wb * x2 + wc * x3 + bias; o[3] = wa * x2 + wb * x3 + wc * x4 + bias;
    o[4] = wa * x3 + wb * x4 + wc * x5 + bias; o[5] = wa * x4 + wb * x5 + wc * x6 + bias; o[6] = wa * x5 + wb * x6 + wc * x7 + bias; o[7] = wa * x6 + wb * x7 + wc * xr + bias;
}
__device__ __forceinline__ void hy_conv_lat(KPC kp, int j, int task, LAS f32x2* buf) {
    const int tid = ltid(), bp = task >> 10, c = task & 1023, b0 = bp * 2;
    const u16* pl = (const u16*)(kp->ws + OFF_R1 + HY_PL); u16* yl = (u16*)(kp->ws + OFF_R1 + HY_YL);
    const float* cw = kp->in[I_HYCW] + (size_t)j * 3 * 3072; const float* cb = kp->in[I_HYCB] + j * 3072;
    const float w1a = cw[c], w1b = cw[3072 + c], w1c = cw[6144 + c], bb1 = cb[c];
    const float w2a = cw[1024 + c], w2b = cw[3072 + 1024 + c], w2c = cw[6144 + 1024 + c], bb2 = cb[1024 + c];
    const float w3a = cw[2048 + c], w3b = cw[3072 + 2048 + c], w3c = cw[6144 + 2048 + c], bb3 = cb[2048 + c];
    const float sk0 = kp->in[I_HYSKIP][j * 2048 + c], sk1 = kp->in[I_HYSKIP][j * 2048 + 1024 + c];
    const u16* x1r0 = pl + ((size_t)b0 * 3072 + c) * SEQ; const u16* x1r1 = x1r0 + (size_t)3072 * SEQ;
    const u16* x2r0 = x1r0 + (size_t)1024 * SEQ; const u16* x2r1 = x1r1 + (size_t)1024 * SEQ;
    const u16* vr0 = x1r0 + (size_t)2048 * SEQ; const u16* vr1 = x1r1 + (size_t)2048 * SEQ;
    const f32x2* K0 = (const f32x2*)(kp->ws + OFF_R2) + (size_t)c * NFFT; const f32x2* K1 = (const f32x2*)kp->out + (size_t)c * NFFT;
    __syncthreads();
#pragma unroll
    for (int g = 0; g < 2; ++g) { const int t0 = 8 * (tid + 512 * g); float v0[8], v1[8];
        ld3x8(vr0, t0, w3a, w3b, w3c, bb3, v0); ld3x8(vr1, t0, w3a, w3b, w3c, bb3, v1);
#pragma unroll
        for (int e = 0; e < 8; ++e) { buf[fphys(t0 + e)] = (f32x2){v0[e], v1[e]}; buf[fphys(SEQ + t0 + e)] = (f32x2){0.f, 0.f}; } }
    __syncthreads();
#ifdef PROBE_FFT
    for (int rp = 0; rp < PROBE_FFT; ++rp) { fft_fwd(buf); fft_inv(buf); for (int r = 0; r < 32; ++r) { const int q = fphys(tid + 512 * r); buf[q] = buf[q] * (1.0f / NFFT); } __syncthreads(); }
#endif
    fft_fwd(buf);
#pragma unroll 8
    for (int r = 0; r < 32; ++r) { const int pos = tid + 512 * r, q = fphys(pos); buf[q] = cmul(buf[q], K0[pos]); }
    __syncthreads();
    fft_inv(buf);
    float zr[32];
#pragma unroll
    for (int g = 0; g < 2; ++g) { const int t0 = 8 * (tid + 512 * g); float v0[8], v1[8], xa[8], xb[8];
        ld3x8(vr0, t0, w3a, w3b, w3c, bb3, v0); ld3x8(vr1, t0, w3a, w3b, w3c, bb3, v1); ld3x8(x1r0, t0, w1a, w1b, w1c, bb1, xa); ld3x8(x1r1, t0, w1a, w1b, w1c, bb1, xb);
#pragma unroll
        for (int e = 0; e < 8; ++e) { const f32x2 y = buf[fphys(t0 + e)]; const float z0 = xa[e] * (y.x + sk0 * v0[e]), z1 = xb[e] * (y.y + sk0 * v1[e]);
            zr[g * 16 + 2 * e] = z0; zr[g * 16 + 2 * e + 1] = z1; buf[fphys(t0 + e)] = (f32x2){z0, z1}; buf[fphys(SEQ + t0 + e)] = (f32x2){0.f, 0.f}; } }
    __syncthreads();
    fft_fwd(buf);
#pragma unroll 8
    for (int r = 0; r < 32; ++r) { const int pos = tid + 512 * r, q = fphys(pos); buf[q] = cmul(buf[q], K1[pos]); }
    __syncthreads();
    fft_inv(buf);
#pragma unroll
    for (int g = 0; g < 2; ++g) { const int t0 = 8 * (tid + 512 * g); float xa[8], xb[8], o0[8], o1[8];
        ld3x8(x2r0, t0, w2a, w2b, w2c, bb2, xa); ld3x8(x2r1, t0, w2a, w2b, w2c, bb2, xb);
#pragma unroll
        for (int e = 0; e < 8; ++e) { const f32x2 y = buf[fphys(t0 + e)]; o0[e] = xa[e] * (y.x + sk1 * zr[g * 16 + 2 * e]); o1[e] = xb[e] * (y.y + sk1 * zr[g * 16 + 2 * e + 1]); }
        *(u32x4v*)(yl + ((size_t)b0 * D + c) * SEQ + t0) = pack8(o0); *(u32x4v*)(yl + ((size_t)(b0 + 1) * D + c) * SEQ + t0) = pack8(o1); }
}

__device__ __forceinline__ void hy_conv_ctx(KPC kp, int j, int c, LAS float* ls) {
    const int tid = ltid();
    const u16* pc = (const u16*)(kp->ws + OFF_R1 + HY_PC); u16* yc = (u16*)(kp->ws + OFF_R1 + HY_YC); const float* kc = (const float*)(kp->ws + OFF_KCTX);
    const float* cw = kp->in[I_HYCW] + (size_t)j * 3 * 3072; const float* cb = kp->in[I_HYCB] + j * 3072;
    const float w1a = cw[c], w1b = cw[3072 + c], w1c = cw[6144 + c], bb1 = cb[c];
    const float w2a = cw[1024 + c], w2b = cw[3072 + 1024 + c], w2c = cw[6144 + 1024 + c], bb2 = cb[1024 + c];
    const float w3a = cw[2048 + c], w3b = cw[3072 + 2048 + c], w3c = cw[6144 + 2048 + c], bb3 = cb[2048 + c];
    const float sk0 = kp->in[I_HYSKIP][j * 2048 + c], sk1 = kp->in[I_HYSKIP][j * 2048 + 1024 + c];
    __syncthreads();
    ls[tid] = kc[(size_t)c * 512 + tid]; ls[512 + tid] = kc[(size_t)(1024 + c) * 512 + tid];
    for (int i = 0; i < 2; ++i) { const int e = tid + 512 * i, b = e >> 8, t = e & 255; ls[1024 + e] = ld3(pc + ((size_t)b * 3072 + 2048 + c) * CTX, t, CTX, w3a, w3b, w3c, bb3); }
    __syncthreads();
    float zr[2];
    for (int i = 0; i < 2; ++i) { const int e = tid + 512 * i, b = e >> 8, t = e & 255; float a = 0.f;
        for (int s = 0; s < CTX; ++s) a += ls[(t - s) & 511] * ls[1024 + b * 256 + s];
        zr[i] = ld3(pc + ((size_t)b * 3072 + c) * CTX, t, CTX, w1a, w1b, w1c, bb1) * (a + sk0 * ls[1024 + e]); ls[2048 + e] = zr[i]; }
    __syncthreads();
    for (int i = 0; i < 2; ++i) { const int e = tid + 512 * i, b = e >> 8, t = e & 255; float a = 0.f;
        for (int s = 0; s < CTX; ++s) a += ls[512 + ((t - s) & 511)] * ls[2048 + b * 256 + s];
        yc[((size_t)b * D + c) * CTX + t] = f2bf(ld3(pc + ((size_t)b * 3072 + 1024 + c) * CTX, t, CTX, w2a, w2b, w2c, bb2) * (a + sk1 * zr[i])); }
}

__device__ __forceinline__ void hy_transpose(KPC kp, LAS u16* tl) {
    const u16* yl = (const u16*)(kp->ws + OFF_R1 + HY_YL); const u16* yc = (const u16*)(kp->ws + OFF_R1 + HY_YC); u16* y = (u16*)(kp->ws + OFF_U); const int tid = ltid();
    for (int tile = lbid(); tile < NB * 16 * NCH; tile += gridDim.x) {
        const int b = tile / (16 * NCH), rem = tile - b * 16 * NCH, ct = rem / NCH, tt = rem - ct * NCH;
        const u16* src = tt < 4 ? yc + ((size_t)b * D + ct * 64) * CTX + tt * 64 : yl + ((size_t)b * D + ct * 64) * SEQ + (tt - 4) * 64; const int ld = tt < 4 ? CTX : SEQ;
        { const int cr = tid >> 3, t8 = (tid & 7) * 8; *(LAS u32x4v*)(tl + cr * 72 + t8) = *(const u32x4v*)(src + (size_t)cr * ld + t8); }
        __syncthreads();
        { const int tr = tid >> 3, c8 = (tid & 7) * 8; u32x4v w;
          w.x = (unsigned)tl[(c8 + 0) * 72 + tr] | ((unsigned)tl[(c8 + 1) * 72 + tr] << 16); w.y = (unsigned)tl[(c8 + 2) * 72 + tr] | ((unsigned)tl[(c8 + 3) * 72 + tr] << 16);
          w.z = (unsigned)tl[(c8 + 4) * 72 + tr] | ((unsigned)tl[(c8 + 5) * 72 + tr] << 16); w.w = (unsigned)tl[(c8 + 6) * 72 + tr] | ((unsigned)tl[(c8 + 7) * 72 + tr] << 16);
          *(u32x4v*)(y + ((size_t)b * TPB + tt * 64 + tr) * D + ct * 64 + c8) = w; }
        __syncthreads();
    }
}

constexpr size_t OFF_XM = OFF_R1, OFF_XC = OFF_R1 + 132 * MiB, OFF_S = WS_NEED, OFF_MLM = OFF_S + 34 * MiB, WS_NEED2 = OFF_MLM + 1 * MiB;
__device__ __forceinline__ u16* hb_ptr(KPC kp, int T) { const int b = T / TPB, t = T - b * TPB;
    return t < CTX ? (u16*)(kp->ws + OFF_HBC) + ((size_t)b * CTX + t) * INNER : (u16*)kp->out + ((size_t)b * SEQ + (t - CTX)) * INNER; }
__device__ __forceinline__ void bd8(const float (&x)[8], const float (&w)[32], float (&y)[8]) {
#pragma unroll
    for (int bl = 0; bl < 2; ++bl)
#pragma unroll
        for (int e = 0; e < 4; ++e) { float s = 0.f;
#pragma unroll
            for (int d = 0; d < 4; ++d) s += x[bl * 4 + d] * w[bl * 16 + d * 4 + e];
            y[bl * 4 + e] = s; }
}
typedef float f32x8s __attribute__((ext_vector_type(8)));
__device__ __forceinline__ void sload32(const float* p, float (&w)[32]) {
    f32x8s a, b, c, d;
    asm volatile("s_load_dwordx8 %0, %4, 0x0\n\ts_load_dwordx8 %1, %4, 0x20\n\ts_load_dwordx8 %2, %4, 0x40\n\ts_load_dwordx8 %3, %4, 0x60\n\ts_waitcnt lgkmcnt(0)"
                 : "=&s"(a), "=&s"(b), "=&s"(c), "=&s"(d) : "s"(p) : "memory");
#pragma unroll
    for (int i = 0; i < 8; ++i) { w[i] = a[i]; w[8 + i] = b[i]; w[16 + i] = c[i]; w[24 + i] = d[i]; }
}
__device__ __forceinline__ void ldw32(const float* p, float (&w)[32]) {
#pragma unroll
    for (int i = 0; i < 8; ++i) { const f32x4 v = *(const f32x4*)(p + i * 4); w[i * 4] = v[0]; w[i * 4 + 1] = v[1]; w[i * 4 + 2] = v[2]; w[i * 4 + 3] = v[3]; } }

__device__ __forceinline__ void ml_m_phase(KPC kp, int j) {
    float* M = (float*)(kp->ws + OFF_MLM) + (size_t)j * 8192;
    const float* wq = kp->in[I_MLWQ] + (size_t)j * 512 * 16; const float* wk = kp->in[I_MLWK] + (size_t)j * 512 * 16;
    for (int i = lbid() * 512 + ltid(); i < 512 * 16; i += gridDim.x * 512) { const int blk = i >> 4, d = (i >> 2) & 3, d2 = i & 3; float s = 0.f;
#pragma unroll
        for (int e = 0; e < 4; ++e) s += wq[blk * 16 + d * 4 + e] * wk[blk * 16 + d2 * 4 + e];
        M[i] = s * 0.04419417382415922f; }
}

__device__ __forceinline__ void ml_prep_task(KPC kp, int j, int task, LAS unsigned char* lds) {
    const int tid = ltid(), lane = tid & 63, wv = tid >> 6, fr = lane & 15, fq = lane >> 4;
    const int hd = task & 3, bc = task >> 2, b = bc / NCH, ci = bc - b * NCH;
    const u16* xm = (const u16*)(kp->ws + OFF_XM); u16* xc = (u16*)(kp->ws + OFF_XC);
    const int T0 = b * TPB + ci * 64, tlo = b * TPB + (ci < 4 ? 0 : CTX), thi = b * TPB + (ci < 4 ? CTX - 1 : TPB - 1);
    const int ch0 = hd * DH + lane * 8;
    LAS u16* QS = (LAS u16*)lds; LAS u16* KS = (LAS u16*)(lds + 66560);
    const float* cw = kp->in[I_MLCW] + (size_t)j * 3 * INNER; const float* cb = kp->in[I_MLCB] + (size_t)j * INNER;
    __syncthreads();
    {
        float cwa[8], cwb[8], cwc[8], cbb[8], wq[32], wk[32];
#pragma unroll
        for (int e = 0; e < 8; ++e) { cwa[e] = cw[ch0 + e]; cwb[e] = cw[INNER + ch0 + e]; cwc[e] = cw[2 * INNER + ch0 + e]; cbb[e] = cb[ch0 + e]; }
        ldw32(kp->in[I_MLWQ] + ((size_t)j * 512 + (ch0 >> 2)) * 16, wq); ldw32(kp->in[I_MLWK] + ((size_t)j * 512 + (ch0 >> 2)) * 16, wk);
        for (int r = 0; r < 8; ++r) { const int jj = wv + 8 * r, T = T0 + jj; const u16* p = xm + (size_t)T * INNER + ch0;
            float x0[8], xa[8], xb[8], xcv[8], q[8], k[8];
            unpack8(*(const u32x4v*)p, x0);
            if (T > tlo) unpack8(*(const u32x4v*)(p - INNER), xa); else {
#pragma unroll
                for (int e = 0; e < 8; ++e) xa[e] = 0.f; }
            if (T < thi) unpack8(*(const u32x4v*)(p + INNER), xb); else {
#pragma unroll
                for (int e = 0; e < 8; ++e) xb[e] = 0.f; }
#pragma unroll
            for (int e = 0; e < 8; ++e) xcv[e] = siluf(cwa[e] * xa[e] + cwb[e] * x0[e] + cwc[e] * xb[e] + cbb[e]);
            const u32x4v xw = pack8(xcv); *(u32x4v*)(xc + (size_t)T * INNER + ch0) = xw; unpack8(xw, xcv);
            bd8(xcv, wq, q); bd8(xcv, wk, k);
            *(LAS u32x4v*)(QS + jj * 520 + lane * 8) = pack8(q); *(LAS u32x4v*)(KS + jj * 520 + lane * 8) = pack8(k); }
    }
    __syncthreads();
    const u16* wg = (const u16*)(kp->ws + OFF_WB + WB_WGT);
    const int mt = wv & 3, kh = wv >> 2;
    { f32x4 s0 = {0.f, 0.f, 0.f, 0.f}, s1 = {0.f, 0.f, 0.f, 0.f}; const int nt0 = kh * 2;
      for (int ks = 0; ks < 16; ++ks) { const bf16x8 a = *(const LAS bf16x8*)(QS + (16 * mt + fr) * 520 + 32 * ks + 8 * fq);
          const bf16x8 b0 = *(const LAS bf16x8*)(KS + (16 * nt0 + fr) * 520 + 32 * ks + 8 * fq), b1 = *(const LAS bf16x8*)(KS + (16 * (nt0 + 1) + fr) * 520 + 32 * ks + 8 * fq);
          s0 = __builtin_amdgcn_mfma_f32_16x16x32_bf16(a, b0, s0, 0, 0, 0); s1 = __builtin_amdgcn_mfma_f32_16x16x32_bf16(a, b1, s1, 0, 0, 0); }
      float* S = (float*)(kp->ws + OFF_S) + ((size_t)(b * 4 + hd) * NCH + ci) * 4096;
#pragma unroll
      for (int r = 0; r < 4; ++r) { S[(16 * mt + 4 * fq + r) * 64 + 16 * nt0 + fr] = s0[r]; S[(16 * mt + 4 * fq + r) * 64 + 16 * (nt0 + 1) + fr] = s1[r]; } }
    f32x4 ga = {0.f, 0.f, 0.f, 0.f};
    for (int ks = kh * 8; ks < kh * 8 + 8; ++ks) { const int kk = hd * DH + 32 * ks + 8 * fq;
        const bf16x8 a = *(const LAS bf16x8*)(QS + (16 * mt + fr) * 520 + 32 * ks + 8 * fq), a2 = *(const LAS bf16x8*)(KS + (16 * mt + fr) * 520 + 32 * ks + 8 * fq);
        const bf16x8 bq = *(const bf16x8*)(wg + (size_t)fr * 6144 + kk), bk = *(const bf16x8*)(wg + (size_t)fr * 6144 + INNER + kk);
        ga = __builtin_amdgcn_mfma_f32_16x16x32_bf16(a, bq, ga, 0, 0, 0); ga = __builtin_amdgcn_mfma_f32_16x16x32_bf16(a2, bk, ga, 0, 0, 0); }
    __syncthreads();
    {
        float wvv[32]; ldw32(kp->in[I_MLWV] + ((size_t)j * 512 + (ch0 >> 2)) * 16, wvv);
        for (int r = 0; r < 8; ++r) { const int jj = wv + 8 * r, T = T0 + jj; float x0[8], v[8]; unpack8(*(const u32x4v*)(xm + (size_t)T * INNER + ch0), x0); bd8(x0, wvv, v);
            *(LAS u32x4v*)(QS + jj * 520 + lane * 8) = pack8(v); }
    }
    __syncthreads();
    for (int ks = kh * 8; ks < kh * 8 + 8; ++ks) { const int kk = hd * DH + 32 * ks + 8 * fq;
        const bf16x8 a = *(const LAS bf16x8*)(QS + (16 * mt + fr) * 520 + 32 * ks + 8 * fq); const bf16x8 bv = *(const bf16x8*)(wg + (size_t)fr * 6144 + 2 * INNER + kk);
        ga = __builtin_amdgcn_mfma_f32_16x16x32_bf16(a, bv, ga, 0, 0, 0); }
    float* gates = (float*)(kp->ws + OFF_GATES);
#pragma unroll
    for (int r = 0; r < 4; ++r) atomicAdd(gates + (size_t)(T0 + 16 * mt + 4 * fq + r) * 16 + fr, ga[r]);
}

__device__ __forceinline__ void tr_store8(LAS unsigned char* base, int d0, const unsigned (&w)[4], int lane) {
    const int odd = lane & 1, sp = lane & ~1;
#pragma unroll
    for (int i = 0; i < 4; ++i) { const unsigned pw = (unsigned)__builtin_amdgcn_update_dpp(0, (int)w[i], 0xB1, 0xF, 0xF, false);
        const unsigned ow = odd ? ((pw >> 16) | (w[i] & 0xffff0000u)) : ((w[i] & 0xffffu) | (pw << 16)); const int d = d0 + 2 * i + odd;
        *(LAS unsigned*)(base + d * 128 + ((((sp >> 3) ^ (d & 7)) << 4) | ((sp & 7) << 1))) = ow; }
}
#ifndef REP_STAGE
#define REP_STAGE 1
#define REP_STILDE 1
#define REP_MFMA 1
#endif
constexpr int SC_QS = 0, SC_KT = 66560, SC_VT = 132096, SC_ST = 148480, SC_VEC = 156672;
__device__ __forceinline__ void ml_scan_task(KPC kp, int j, int task, LAS unsigned char* lds) {
    const int tid = ltid(), lane = tid & 63, wv = tid >> 6, fr = lane & 15, fq = lane >> 4;
    const int es = task & 3, dir = (task >> 2) & 1, hd = (task >> 3) & 3, b = task >> 5;
    const u16* xm = (const u16*)(kp->ws + OFF_XM); const u16* xc = (const u16*)(kp->ws + OFF_XC); const float* gates = (const float*)(kp->ws + OFF_GATES);
    const float* Sg = (const float*)(kp->ws + OFF_S) + (size_t)(b * 4 + hd) * NCH * 4096;
    u16* hf = (u16*)(kp->ws + OFF_R2);
    LAS unsigned char* QS = lds + SC_QS; LAS unsigned char* KT = lds + SC_KT; LAS unsigned char* VT = lds + SC_VT; LAS unsigned char* ST = lds + SC_ST;
    LAS float* rowterm = (LAS float*)(lds + SC_VEC); LAS float* colterm = rowterm + 64; LAS float* winter = rowterm + 128; LAS float* einv = rowterm + 192;
    LAS float* kws = rowterm + 256; LAS float* dinv = rowterm + 320; LAS float* nst = rowterm + 384; LAS float* scal = rowterm + 896;
    f32x4 C[32];
#pragma unroll
    for (int i = 0; i < 32; ++i) C[i] = (f32x4){0.f, 0.f, 0.f, 0.f};
    float m_st = 0.f;
    __syncthreads();
    nst[tid] = 0.f;
    float pg_ic = 0.f, pg_fp = 0.f;
    if (wv == 0) { const int tn = dir == 0 ? lane : CTX - 1 - lane; const int Tg = b * TPB + tn; pg_ic = gates[(size_t)Tg * 16 + dir * 8 + hd]; pg_fp = gates[(size_t)Tg * 16 + dir * 8 + 4 + hd]; }
    for (int ci = 0; ci < NCH; ++ci) {
        __syncthreads();
        const int p0 = ci * 64;
        const int tid = ltid(), lane = tid & 63, wv = tid >> 6, fr = lane & 15, fq = lane >> 4;
        asm volatile("" ::: "memory");
        auto tok = [&](int jj) -> int { const int p = p0 + jj; const int t = dir == 0 ? p : (p < CTX ? CTX - 1 - p : TPB + CTX - 1 - p); return b * TPB + t; };
        float sv[8];
        { const int jj = tid >> 3, s8 = (tid & 7) * 8;
            if (dir == 0) { const float* sp = Sg + (size_t)ci * 4096 + jj * 64 + s8; const f32x4 v0 = *(const f32x4*)sp, v1 = *(const f32x4*)(sp + 4);
                sv[0] = v0[0]; sv[1] = v0[1]; sv[2] = v0[2]; sv[3] = v0[3]; sv[4] = v1[0]; sv[5] = v1[1]; sv[6] = v1[2]; sv[7] = v1[3]; }
            else { const int oc = ci < 4 ? 3 - ci : 135 - ci; const float* sp = Sg + (size_t)oc * 4096 + (63 - jj) * 64 + (56 - s8); const f32x4 v0 = *(const f32x4*)sp, v1 = *(const f32x4*)(sp + 4);
                sv[7] = v0[0]; sv[6] = v0[1]; sv[5] = v0[2]; sv[4] = v0[3]; sv[3] = v1[0]; sv[2] = v1[1]; sv[1] = v1[2]; sv[0] = v1[3]; }
        }
        const float g_ic = pg_ic, g_fp = pg_fp;
        if (wv == 0 && ci + 1 < NCH) { const int pn = p0 + 64 + lane; const int tn = dir == 0 ? pn : (pn < CTX ? CTX - 1 - pn : TPB + CTX - 1 - pn); const int Tg = b * TPB + tn;
            pg_ic = gates[(size_t)Tg * 16 + dir * 8 + hd]; pg_fp = gates[(size_t)Tg * 16 + dir * 8 + 4 + hd]; }
        for (int rpS = 0; rpS < REP_STAGE; ++rpS) {
        const int wvu = __builtin_amdgcn_readfirstlane(wv); const int Tl = tok(lane);
        for (int r = 0; r < 8; ++r) { const int g8 = wvu * 8 + r; float x[8], q[8], Mw[32];
            const u32x4v xw = *(const u32x4v*)(xc + (size_t)Tl * INNER + hd * DH + g8 * 8); unpack8(xw, x);
            sload32((const float*)(kp->ws + OFF_MLM) + (size_t)j * 8192 + (size_t)(hd * 128 + g8 * 2) * 16, Mw); bd8(x, Mw, q);
            *(LAS u32x4v*)(QS + lane * 1040 + g8 * 16) = pack8(q);
            const unsigned wd[4] = {xw.x, xw.y, xw.z, xw.w}; tr_store8(KT, g8 * 8, wd, lane); }
        for (int r = 0; r < 2; ++r) { const int g = wvu * 2 + r; const int chv = hd * DH + es * 128 + g * 8; float x[8], v[8], wvv[32];
            unpack8(*(const u32x4v*)(xm + (size_t)Tl * INNER + chv), x); sload32(kp->in[I_MLWV] + ((size_t)j * 512 + (chv >> 2)) * 16, wvv); bd8(x, wvv, v);
            { const u32x4v vw = pack8(v); const unsigned wd[4] = {vw.x, vw.y, vw.z, vw.w}; tr_store8(VT, g * 8, wd, lane); } }
        }
        if (wv == 0) {
            const float ic = g_ic, fp = g_fp;
            const float lf = fminf(fp, 0.f) - log1pf(__expf(-fabsf(fp)));
            float bb = lf;
#pragma unroll
            for (int o = 1; o < 64; o <<= 1) { const float t = lshfl(bb, lane - o); if (lane >= o) bb += t; }
            const float uu = ic - bb; float pm = uu;
#pragma unroll
            for (int o = 1; o < 64; o <<= 1) { const float t = lshfl(pm, lane - o); if (lane >= o) pm = fmaxf(pm, t); }
            const float a = bb + m_st, mj = fmaxf(a, bb + pm);
            rowterm[lane] = bb - mj; colterm[lane] = uu; winter[lane] = __expf(a - mj); einv[lane] = __expf(-mj);
            const float blast = lshfl(bb, 63), gs = blast - bb + ic, gmax = wave_max(gs), mnew = fmaxf(blast + m_st, gmax);
            kws[lane] = __expf(gs - mnew);
            if (lane == 0) { scal[0] = __expf(blast + m_st - mnew); scal[1] = mnew; }
        }
        __syncthreads();
        for (int rpT = 0; rpT < REP_STILDE; ++rpT) {
            const int jj = tid >> 3, sub = tid & 7, s8 = sub * 8;
            const float rt = rowterm[jj]; float rsum = 0.f;
            const f32x4 ct0 = *(const LAS f32x4*)(colterm + s8), ct1 = *(const LAS f32x4*)(colterm + s8 + 4); const float ctv[8] = {ct0[0], ct0[1], ct0[2], ct0[3], ct1[0], ct1[1], ct1[2], ct1[3]};
#pragma unroll
            for (int e = 0; e < 8; ++e) { const int s = s8 + e; const float w = s <= jj ? sv[e] * 0.04419417382415922f * __expf(rt + ctv[e]) : 0.f; sv[e] = w; rsum += w; }
            *(LAS u32x4v*)(ST + jj * 128 + ((sub ^ (jj & 7)) << 4)) = pack8(sv);
            float qd = 0.f;
#pragma unroll
            for (int c8 = 0; c8 < 8; ++c8) { float qv[8]; unpack8(*(const LAS u32x4v*)(QS + jj * 1040 + (sub * 8 + c8) * 16), qv);
                { const f32x4 n0 = *(const LAS f32x4*)(nst + sub * 64 + c8 * 8), n1 = *(const LAS f32x4*)(nst + sub * 64 + c8 * 8 + 4);
                  qd += qv[0] * n0[0] + qv[1] * n0[1] + qv[2] * n0[2] + qv[3] * n0[3] + qv[4] * n1[0] + qv[5] * n1[1] + qv[6] * n1[2] + qv[7] * n1[3]; } }
            rsum += lshfl(rsum, lane ^ 1); rsum += lshfl(rsum, lane ^ 2); rsum += lshfl(rsum, lane ^ 4);
            qd += lshfl(qd, lane ^ 1); qd += lshfl(qd, lane ^ 2); qd += lshfl(qd, lane ^ 4);
            if (sub == 0) { const float qn = winter[jj] * qd + rsum; dinv[jj] = 1.0f / fmaxf(fabsf(qn), einv[jj]); }
        }
        __syncthreads();
        {
            f32x4 o[4];
            const int el = 16 * wv + fr;
            bf16x8 vfr[2];
            for (int rpM = 0; rpM < REP_MFMA; ++rpM) {
#pragma unroll
            for (int mt = 0; mt < 4; ++mt) o[mt] = (f32x4){0.f, 0.f, 0.f, 0.f};
#pragma unroll
            for (int ks = 0; ks < 16; ++ks) {
                u32x4v bw; bw.x = pg8::cvt_pk_bf16(C[2 * ks][0], C[2 * ks][1]); bw.y = pg8::cvt_pk_bf16(C[2 * ks][2], C[2 * ks][3]);
                bw.z = pg8::cvt_pk_bf16(C[2 * ks + 1][0], C[2 * ks + 1][1]); bw.w = pg8::cvt_pk_bf16(C[2 * ks + 1][2], C[2 * ks + 1][3]);
                const bf16x8 bfr = __builtin_bit_cast(bf16x8, bw);
#pragma unroll
                for (int mt = 0; mt < 4; ++mt) { const int off = (16 * mt + fr) * 1040 + 8 * fq;
                    const u32x2 lo = *(const LAS u32x2*)(QS + off + 64 * ks), hi = *(const LAS u32x2*)(QS + off + 64 * ks + 32);
                    u32x4v aw; aw.x = lo.x; aw.y = lo.y; aw.z = hi.x; aw.w = hi.y;
                    o[mt] = __builtin_amdgcn_mfma_f32_16x16x32_bf16(bfr, __builtin_bit_cast(bf16x8, aw), o[mt], 0, 0, 0); }
                if ((ks & 1) == 1) __builtin_amdgcn_sched_barrier(0); }
#pragma unroll
            for (int mt = 0; mt < 4; ++mt)
#pragma unroll
                for (int r = 0; r < 4; ++r) o[mt][r] *= winter[16 * mt + fr];
#pragma unroll
            for (int k2 = 0; k2 < 2; ++k2) { vfr[k2] = *(const LAS bf16x8*)(VT + el * 128 + (((4 * k2 + fq) ^ (el & 7)) << 4));
#pragma unroll
                for (int mt = 0; mt < 4; ++mt) { const int jr = 16 * mt + fr; const bf16x8 a = *(const LAS bf16x8*)(ST + jr * 128 + (((4 * k2 + fq) ^ (jr & 7)) << 4));
                    o[mt] = __builtin_amdgcn_mfma_f32_16x16x32_bf16(vfr[k2], a, o[mt], 0, 0, 0); } }
            }
#pragma unroll
            for (int mt = 0; mt < 4; ++mt)
                { const int jr = 16 * mt + fr, T = tok(jr); const float di = dinv[jr];
                    u16* dst = dir == 0 ? hf + (size_t)T * INNER : hb_ptr(kp, T); u32x2 w; w.x = pg8::cvt_pk_bf16(o[mt][0] * di, o[mt][1] * di); w.y = pg8::cvt_pk_bf16(o[mt][2] * di, o[mt][3] * di);
                    *(u32x2*)(dst + hd * DH + es * 128 + 16 * wv + 4 * fq) = w; }
            const float decay = scal[0];
#pragma unroll
            for (int i = 0; i < 32; ++i) C[i] = C[i] * decay;
            float kwv[2][8];
#pragma unroll
            for (int k2 = 0; k2 < 2; ++k2) { const f32x4 k0 = *(const LAS f32x4*)(kws + 32 * k2 + 8 * fq), k1 = *(const LAS f32x4*)(kws + 32 * k2 + 8 * fq + 4);
                kwv[k2][0] = k0[0]; kwv[k2][1] = k0[1]; kwv[k2][2] = k0[2]; kwv[k2][3] = k0[3]; kwv[k2][4] = k1[0]; kwv[k2][5] = k1[1]; kwv[k2][6] = k1[2]; kwv[k2][7] = k1[3]; }
#pragma unroll
            for (int k2 = 0; k2 < 2; ++k2) { float vv[8]; unpack8(__builtin_bit_cast(u32x4v, vfr[k2]), vv);
#pragma unroll
                for (int e = 0; e < 8; ++e) vv[e] *= kwv[k2][e];
                const bf16x8 bsc = __builtin_bit_cast(bf16x8, pack8(vv));
#pragma unroll
                for (int dt = 0; dt < 32; ++dt) { const int dr = 16 * dt + fr; const bf16x8 a = *(const LAS bf16x8*)(KT + dr * 128 + (((4 * k2 + fq) ^ (dr & 7)) << 4));
                    C[dt] = __builtin_amdgcn_mfma_f32_16x16x32_bf16(a, bsc, C[dt], 0, 0, 0);
                    if ((dt & 7) == 7) __builtin_amdgcn_sched_barrier(0); } }
            { float nn = decay * nst[tid];
#pragma unroll
              for (int g = 0; g < 8; ++g) { float kv[8]; unpack8(*(const LAS u32x4v*)(KT + tid * 128 + ((g ^ (tid & 7)) << 4)), kv);
                  { const f32x4 k0 = *(const LAS f32x4*)(kws + 8 * g), k1 = *(const LAS f32x4*)(kws + 8 * g + 4); nn += kv[0] * k0[0] + kv[1] * k0[1] + kv[2] * k0[2] + kv[3] * k0[3] + kv[4] * k1[0] + kv[5] * k1[1] + kv[6] * k1[2] + kv[7] * k1[3]; } }
              nst[tid] = nn; }
            m_st = scal[1];
        }
    }
}

__device__ __forceinline__ void ml_gate_phase(KPC kp, int j) {
    u16* hf = (u16*)(kp->ws + OFF_R2); const u16* xc = (const u16*)(kp->ws + OFF_XC); const u16* z = (const u16*)(kp->ws + OFF_XM);
    const float* ng = kp->in[I_MLNG] + (size_t)j * INNER; const float* sk = kp->in[I_MLSKIP] + (size_t)j * INNER;
    const int lane = ltid() & 63, wv = ltid() >> 6;
    for (int T = lbid() * 8 + wv; T < NTOK; T += gridDim.x * 8) {
        const u16* hbp = hb_ptr(kp, T);
#pragma unroll
        for (int hd = 0; hd < 4; ++hd) { const int c0 = hd * DH + lane * 8; float a[8], bq[8], xv[8], zv[8], o[8];
            unpack8(*(const u32x4v*)(hf + (size_t)T * INNER + c0), a); unpack8(*(const u32x4v*)(hbp + c0), bq);
            float s = 0.f;
#pragma unroll
            for (int e = 0; e < 8; ++e) { a[e] += bq[e]; s += a[e]; }
            const float mu = wave_sum(s) * (1.0f / DH); float vs = 0.f;
#pragma unroll
            for (int e = 0; e < 8; ++e) { a[e] -= mu; vs += a[e] * a[e]; }
            const float rs = rsqrtf(wave_sum(vs) * (1.0f / DH) + 1e-5f);
            unpack8(*(const u32x4v*)(xc + (size_t)T * INNER + c0), xv); unpack8(*(const u32x4v*)(z + (size_t)T * INNER + c0), zv);
            const f32x4 n0 = *(const f32x4*)(ng + c0), n1 = *(const f32x4*)(ng + c0 + 4), s0 = *(const f32x4*)(sk + c0), s1 = *(const f32x4*)(sk + c0 + 4);
            const float ngv[8] = {n0[0], n0[1], n0[2], n0[3], n1[0], n1[1], n1[2], n1[3]}, skv[8] = {s0[0], s0[1], s0[2], s0[3], s1[0], s1[1], s1[2], s1[3]};
#pragma unroll
            for (int e = 0; e < 8; ++e) o[e] = (a[e] * rs * ngv[e] + skv[e] * xv[e]) * siluf(zv[e]);
            *(u32x4v*)(hf + (size_t)T * INNER + c0) = pack8(o); }
    }
}


enum { K_SETUP = 0, K_CN, K_G1, K_G2R, K_HYIN, K_HYCONV, K_HYTR, K_MLUPX, K_MLPREP, K_MLSCAN, K_MLUPZ, K_MLGATE, K_FINAL };
constexpr int NPHASE = 1 + 11 + 13 + 11 + 13 + 1;
__device__ __forceinline__ void decode_phase(int ph, int& kind, int& l, int& arg) {
    kind = K_SETUP; l = 0; arg = 0; if (ph == 0) return;
    ph -= 1;
    for (l = 0; l < 4; ++l) { const int n = (l & 1) ? 13 : 11; if (ph < n) break; ph -= n; }
    if (l == 4) { kind = K_FINAL; l = 0; return; }
    if (ph == 0) { kind = K_CN; arg = 0; return; } if (ph == 1) { kind = K_G1; arg = 0; return; } if (ph == 2) { kind = K_G2R; arg = 0; return; } if (ph == 3) { kind = K_CN; arg = 1; return; }
    const int nm = (l & 1) ? 6 : 4;
    if (ph < 4 + nm) { const int q = ph - 4;
        if (l & 1) { kind = q == 0 ? K_MLUPX : q == 1 ? K_MLPREP : q == 2 ? K_MLSCAN : q == 3 ? K_MLUPZ : q == 4 ? K_MLGATE : K_G2R; arg = 2; }
        else { kind = q == 0 ? K_HYIN : q == 1 ? K_HYCONV : q == 2 ? K_HYTR : K_G2R; arg = 2; }
        return; }
    ph -= 4 + nm;
    if (ph == 0) { kind = K_CN; arg = 2; return; } if (ph == 1) { kind = K_G1; arg = 1; return; } kind = K_G2R; arg = 1;
}

__device__ __forceinline__ void gbar(unsigned* ctr, unsigned target) {
    __syncthreads();
    if (ltid() == 0) {
        __builtin_amdgcn_fence(__ATOMIC_RELEASE, "agent");
        __hip_atomic_fetch_add(ctr, 1u, __ATOMIC_RELAXED, __HIP_MEMORY_SCOPE_AGENT);
        while (__hip_atomic_load(ctr, __ATOMIC_RELAXED, __HIP_MEMORY_SCOPE_AGENT) < target) __builtin_amdgcn_s_sleep(2);
        __builtin_amdgcn_fence(__ATOMIC_ACQUIRE, "agent");
    }
    __syncthreads();
}
#ifndef REPMASK
#define REPMASK 0
#define REPN 1
#endif
template <int MIX> __device__ __forceinline__ void run_phases(int lo, int hi, int ph_lo, int ph_hi, LAS unsigned char* lds0, cg::grid_group& grid) {
    lo = lo > ph_lo ? lo : ph_lo; hi = hi < ph_hi ? hi : ph_hi;
    for (int ph = lo; ph < hi; ++ph) {
        KPC kp = (KPC)__builtin_amdgcn_kernarg_segment_ptr(); asm volatile("" : "+s"(kp) :: "memory");
        LAS unsigned char* lds = lds0; asm volatile("" : "+s"(lds) :: "memory");
        unsigned char* ws = kp->ws; unsigned char* wb = ws + OFF_WB;
        int kind, l, arg; decode_phase(ph, kind, l, arg); const int j = l >> 1;
        const float* modl = (const float*)(ws + OFF_MOD) + (size_t)l * 5 * 9216;
        const int nrep = ((REPMASK >> kind) & 1) ? REPN : 1;
        for (int rep = 0; rep < nrep; ++rep) {
        if (kind == K_SETUP) { if constexpr (MIX == 0) setup_phase(kp, (LAS float*)lds); }
        else if (kind == K_CN) {
            if (arg == 0) { convert_layer(kp, l, (LAS float*)lds); if constexpr (MIX == 1) ml_m_phase(kp, j); }
            if constexpr (MIX == 0) { if (arg == 1) hy_mlp_phase(kp, j); }
            norm_phase(kp, l, arg);
        } else if (kind == K_G1) {
            pg8::Gemm g{(const u16*)(ws + OFF_U), (const u16*)(wb + (arg ? WB_FIN1 : WB_FIN0)), NTOK, 2 * FF, D};
            pg8::StaticOrder S; S.init(g.M, g.N, (int)gridDim.x, lbid(), (l == 3 && arg == 1) ? 1 : 0); EpiSwiglu E{(u16*)(ws + OFF_R1)};
            pg8::gemm_phase<EpiSwiglu, pg8::StaticOrder, false>(lds, g, S, E, nullptr);
        } else if (kind == K_G2R) {
            pg8::Gemm g; EpiResid E; E.h = (float*)(ws + OFF_H); E.modl = modl;
            if (arg < 2) { g = pg8::Gemm{(const u16*)(ws + OFF_R1), (const u16*)(wb + (arg ? WB_FOUT1 : WB_FOUT0)), NTOK, D, FF}; E.gidx = arg ? 8 : 2; E.scale = 0.5f; E.bias = nullptr; }
            else if (MIX == 1) { g = pg8::Gemm{(const u16*)(ws + OFF_R2), (const u16*)(wb + WB_MOUT), NTOK, D, INNER}; E.gidx = 5; E.scale = 1.0f; E.bias = nullptr; }
            else { g = pg8::Gemm{(const u16*)(ws + OFF_U), (const u16*)(wb + WB_MOUT), NTOK, D, D}; E.gidx = 5; E.scale = 1.0f; E.bias = kp->in[I_HYBOUT] + (size_t)j * D; }
            pg8::StaticOrder S; S.init(g.M, g.N, (int)gridDim.x, lbid(), (l == 3 && arg >= 1) ? 1 : 0);
            pg8::gemm_phase<EpiResid, pg8::StaticOrder, false>(lds, g, S, E, nullptr);
        } else if (kind == K_FINAL) { if constexpr (MIX == 1) final_phase(kp); }
        else if constexpr (MIX == 0) {
            if (kind == K_HYIN) {
                pg8::Gemm g{(const u16*)(wb + WB_MIN), (const u16*)(ws + OFF_U), 3 * D, NTOK, D};
                pg8::StaticOrder S; S.init(g.M, g.N, (int)gridDim.x, lbid());
                EpiProjT E{(u16*)(ws + OFF_R1 + HY_PL), (u16*)(ws + OFF_R1 + HY_PC), kp->in[I_HYBIN] + (size_t)j * 3 * D};
                pg8::gemm_phase<EpiProjT, pg8::StaticOrder, false>(lds, g, S, E, nullptr);
                __syncthreads();
                for (int t = lbid(); t < 2048; t += gridDim.x) hy_filter_task(kp, j, t, (LAS f32x2*)lds, (LAS float*)(lds + 131072));
            } else if (kind == K_HYCONV) {
                for (int t = lbid(); t < 2048; t += gridDim.x) hy_conv_lat(kp, j, t, (LAS f32x2*)lds);
                for (int t = lbid(); t < 1024; t += gridDim.x) hy_conv_ctx(kp, j, t, (LAS float*)lds);
            } else if (kind == K_HYTR) hy_transpose(kp, (LAS u16*)lds);
        } else {
            if (kind == K_MLUPX || kind == K_MLUPZ) {
                const bool zz = kind == K_MLUPZ;
                pg8::Gemm g{(const u16*)(ws + OFF_U), (const u16*)(wb + WB_MIN) + (zz ? (size_t)INNER * D : 0), NTOK, INNER, D};
                pg8::StaticOrder S; S.init(g.M, g.N, (int)gridDim.x, lbid(), (zz && l == 3) ? 1 : 0); EpiBf E{(u16*)(ws + OFF_XM), INNER};
                pg8::gemm_phase<EpiBf, pg8::StaticOrder, false>(lds, g, S, E, nullptr);
            } else if (kind == K_MLPREP) { for (int t = lbid(); t < NB * NCH * 4; t += gridDim.x) ml_prep_task(kp, j, t, lds); }
            else if (kind == K_MLSCAN) { for (int t = lbid(); t < 128; t += gridDim.x) ml_scan_task(kp, j, t, lds); }
            else if (kind == K_MLGATE) ml_gate_phase(kp, j);
        }
        }
        if (ph + 1 < ph_hi) gbar((unsigned*)(kp->ws + OFF_MLM + 65536), (unsigned)(ph + 1 - ph_lo) * gridDim.x);
    }
}

__global__ void __launch_bounds__(512) fwd_megakernel(KP kparg) {
    extern __shared__ __attribute__((aligned(16))) unsigned char shm[];
    LAS unsigned char* lds = (LAS unsigned char*)shm;
    cg::grid_group grid = cg::this_grid();
    grid.sync();
    wtab_init();
    const int ph_lo = kparg.ph_lo, ph_hi = kparg.ph_hi;
    run_phases<0>(0, 12, ph_lo, ph_hi, lds, grid);
    run_phases<1>(12, 25, ph_lo, ph_hi, lds, grid);
    run_phases<0>(25, 36, ph_lo, ph_hi, lds, grid);
    run_phases<1>(36, 50, ph_lo, ph_hi, lds, grid);
}

extern "C" void kernel_launch(void* const* d_in, const int* in_sizes, int n_in, void* d_out, int out_size, void* d_ws, size_t ws_size, hipStream_t stream) {
    static int grid_blocks = 0;
    if (!grid_blocks) {
        int dev = 0, cus = 0, per_cu = 0;
        hipGetDevice(&dev);
        hipDeviceGetAttribute(&cus, hipDeviceAttributeMultiprocessorCount, dev);
        hipFuncSetAttribute((const void*)fwd_megakernel, hipFuncAttributeMaxDynamicSharedMemorySize, LDS_BYTES);
        hipOccupancyMaxActiveBlocksPerMultiprocessor(&per_cu, fwd_megakernel, 512, LDS_BYTES);
        if (per_cu < 1) per_cu = 1;
        grid_blocks = cus * 1;
        if (ws_size < WS_NEED2) fprintf(stderr, "workspace too small: %zu < %zu\n", ws_size, (size_t)WS_NEED2);
    }
    KP hp{};
    for (int i = 0; i < 36; ++i) hp.in[i] = (const float*)d_in[i];
    hp.out = (float*)d_out; hp.ws = (unsigned char*)d_ws; hp.ph_lo = 0; hp.ph_hi = NPHASE;
    void* args[] = {&hp};
    hipMemsetAsync((unsigned char*)d_ws + OFF_MLM + 65536, 0, 256, stream);
    hipError_t e = hipLaunchCooperativeKernel((void*)fwd_megakernel, dim3(grid_blocks), dim3(512), args, LDS_BYTES, stream);
    if (e != hipSuccess) fprintf(stderr, "cooperative launch failed: %s (grid %d)\n", hipGetErrorString(e), grid_blocks);
}
```

```cpp
#define REPMASK 0
#define REPN 1
#include <hip/hip_runtime.h>
#include <hip/hip_cooperative_groups.h>
#include <cstdio>
namespace cg = cooperative_groups;
#define WTAB_OFF 163584
__device__ __forceinline__ int llane() { int l; asm volatile("v_mbcnt_lo_u32_b32 %0, -1, 0\n\tv_mbcnt_hi_u32_b32 %0, -1, %0" : "=v"(l) :: "memory"); return l; }
__device__ __forceinline__ int lwave() { extern __shared__ __attribute__((aligned(16))) unsigned char shm_w[];
    const int hw = __builtin_amdgcn_s_getreg(10244) & 63;
    return __builtin_amdgcn_readfirstlane(*(const __attribute__((address_space(3))) int*)((__attribute__((address_space(3))) unsigned char*)shm_w + WTAB_OFF + hw * 4)); }
__device__ __forceinline__ void wtab_init() { extern __shared__ __attribute__((aligned(16))) unsigned char shm_w[];
    const int hw = __builtin_amdgcn_s_getreg(10244) & 63;
    *(__attribute__((address_space(3))) int*)((__attribute__((address_space(3))) unsigned char*)shm_w + WTAB_OFF + hw * 4) = (int)(threadIdx.x >> 6); }
__device__ __forceinline__ int ltid() { return lwave() * 64 + llane(); }
__device__ __forceinline__ int lbid() { int t = blockIdx.x; asm volatile("" : "+s"(t) :: "memory"); return t; }
namespace pg8 {
#define PG8_LAS __attribute__((address_space(3)))
typedef unsigned short bf16_t;
typedef short bf16x8 __attribute__((ext_vector_type(8)));
typedef float f32x4 __attribute__((ext_vector_type(4)));
typedef unsigned u32x4 __attribute__((ext_vector_type(4)));
constexpr int BM = 256, BK = 64, HALF = 128, HTB = HALF * BK * 2  , STAGE_BYTES = 8 * HTB, NXCD = 8, WGM = 8;

__host__ __device__ __forceinline__ int lds_byte(int r, int c) { const int st = (r >> 4) * 2 + (c >> 5), rr = r & 15, cc = c & 31, ob = rr * 64 + cc * 2; return st * 1024 + (ob ^ (((ob >> 9) & 1) << 5)); }
__host__ __device__ __forceinline__ void stage_rc(int b, int& R, int& C) { const int st = b / 1024, sb = b % 1024, swz = sb ^ (((sb >> 9) & 1) << 5); R = (st >> 1) * 16 + swz / 64; C = (st & 1) * 32 + (swz % 64) / 2; }
__host__ __device__ __forceinline__ int perm32(int rho) { const int n = rho >> 4, i = rho & 15; return 8 * (i >> 2) + 4 * n + (i & 3); }

struct Unit { int pm, pn, kofs, nt; };
struct Gemm { const bf16_t* A; const bf16_t* Bt; int M, N, K, ldk; };

struct StaticOrder {
    int nM, nN, nwg, G, c, lat, nk;
    __host__ __device__ void init(int M, int N, int G_, int c_, int lat_ = 0, int nk_ = 0) { lat = lat_; nk = nk_; nM = lat ? 128 : M / BM; nN = N / BM; nwg = nM * nN; G = G_; c = c_; }
    __host__ __device__ bool next(int i, Unit& u) const {
        const long L = (long)i * G + c;
        if (L >= nwg) { if (lat != 2 || L >= nwg + 16 * nk) return false; const int Lc = (int)L - nwg, un = Lc & 15; u.pm = (un >> 2) * 33; u.pn = un & 3; u.kofs = (Lc >> 4) * 256; u.nt = 4; return true; }
        int wgid = (int)L; { const int q = nwg / NXCD, r = nwg % NXCD, xcd = wgid % NXCD, off = wgid / NXCD; wgid = (xcd < r ? xcd * (q + 1) : r * (q + 1) + (xcd - r) * q) + off; }
        const int nig = WGM * nN, gid = wgid / nig, fm = gid * WGM, gsz = (nM - fm) < WGM ? (nM - fm) : WGM;
        u.pm = fm + ((wgid % nig) % gsz); u.pn = (wgid % nig) / gsz; u.kofs = 0; u.nt = 0; if (lat) u.pm = (u.pm >> 5) * 33 + 1 + (u.pm & 31); return true;
    }
    __device__ __forceinline__ void a_ready(const Unit&) const {}
    __device__ __forceinline__ void done(const Unit&) const {}
};
__device__ __forceinline__ unsigned cvt_pk_bf16(float lo, float hi) { unsigned r; asm volatile("v_cvt_pk_bf16_f32 %0, %1, %2" : "=v"(r) : "v"(lo), "v"(hi)); return r; }
template <class Epi, class Sched, bool STAMP = false>
__device__ __forceinline__ void gemm_phase(PG8_LAS unsigned char* lds, const Gemm g, const Sched& S, const Epi& E, unsigned long long* stamps) {
    const int tid = ltid(), wid = __builtin_amdgcn_readfirstlane(tid >> 6), lane = tid & 63, wr = wid >> 2, wc = wid & 3, fr = lane & 15, fq = lane >> 4;
    const int K = g.K, nt = K / BK, ldk = g.ldk ? g.ldk : g.K;
    int ts_lo = 0, ts_hi = 0, nts = 0; const unsigned long long rt_entry = STAMP ? (unsigned long long)wall_clock64() : 0ull;
#define PG8_STAMP() do { if (STAMP && wid == 0 && nts < 64) { const unsigned long long _c = (unsigned long long)clock64(); \
        ts_lo = (lane == nts) ? (int)(unsigned)_c : ts_lo; ts_hi = (lane == nts) ? (int)(unsigned)(_c >> 32) : ts_hi; ++nts; } } while (0)
    PG8_STAMP();
    unsigned voffA[2], voffB[2];
#pragma unroll
    for (int i = 0; i < 2; ++i) { int R, C; stage_rc(tid * 16 + i * 8192, R, C); const int Rb = Epi::PERM ? ((R & ~31) + perm32(R & 31)) : R;
        voffA[i] = (unsigned)(R * ldk + C) * 2u; voffB[i] = (unsigned)(Rb * ldk + C) * 2u; }
    const size_t kstep = (size_t)(BK * 2);
    const size_t hstep = (size_t)HALF * ldk * 2;
    const size_t tstep = 2 * hstep;
    const unsigned ldsw = (unsigned)wid * 1024u;
    const int aoff = lds_byte(wr * 64 + fr, fq * 8), boff = lds_byte(wc * 32 + fr, fq * 8);
#define PG8_SA(b, h) (((b) * 2 + (h)) * HTB)
#define PG8_SB(b, h) ((4 + (b) * 2 + (h)) * HTB)
#define PG8_STAGE(bufoff, gbase, voff) do { _Pragma("unroll") for (int _i = 0; _i < 2; ++_i) \
        __builtin_amdgcn_global_load_lds((const unsigned*)((const char*)(gbase) + (voff)[_i]), (PG8_LAS unsigned*)(lds + (bufoff) + ldsw + _i * 8192), 16, 0, 0); } while (0)
#define PG8_LDA(dst, b, h) do { _Pragma("unroll") for (int m = 0; m < 4; ++m) _Pragma("unroll") for (int k = 0; k < 2; ++k) dst[m][k] = *(const PG8_LAS bf16x8*)(lds + PG8_SA(b, h) + aoff + m * 2048 + k * 1024); } while (0)
#define PG8_LDB(dst, b, h) do { _Pragma("unroll") for (int n = 0; n < 2; ++n) _Pragma("unroll") for (int k = 0; k < 2; ++k) dst[n][k] = *(const PG8_LAS bf16x8*)(lds + PG8_SB(b, h) + boff + n * 2048 + k * 1024); } while (0)
#define PG8_MMA(ai, bj, At, Bt) do { __builtin_amdgcn_s_setprio(1); _Pragma("unroll") for (int m = 0; m < 4; ++m) _Pragma("unroll") for (int n = 0; n < 2; ++n) _Pragma("unroll") for (int k = 0; k < 2; ++k) \
        acc[ai][bj][m][n] = __builtin_amdgcn_mfma_f32_16x16x32_bf16(Bt[n][k], At[m][k], acc[ai][bj][m][n], 0, 0, 0); __builtin_amdgcn_s_setprio(0); } while (0)
#define PG8_WAIT_V(n) asm volatile("s_waitcnt vmcnt(" #n ")" ::: "memory")
#define PG8_WAIT_L(n) asm volatile("s_waitcnt lgkmcnt(" #n ")" ::: "memory")
#define PG8_BAR __builtin_amdgcn_s_barrier()
#define PG8_SCHED __builtin_amdgcn_sched_barrier(0)
    Unit cur, nxt; int ui = 0;
    if (!S.next(0, cur)) return;
    f32x4 acc[2][2][4][2];
#pragma unroll
    for (int a = 0; a < 2; ++a)
#pragma unroll
        for (int b = 0; b < 2; ++b)
#pragma unroll
            for (int m = 0; m < 4; ++m)
#pragma unroll
                for (int n = 0; n < 2; ++n) acc[a][b][m][n] = (f32x4){0.f, 0.f, 0.f, 0.f};
    bf16x8 At[4][2], B0[2][2], B1[2][2];
    const char* cA = (const char*)g.A + (size_t)cur.pm * tstep + (size_t)cur.kofs * 2; const char* cB = (const char*)g.Bt + (size_t)cur.pn * tstep + (size_t)cur.kofs * 2;
    S.a_ready(cur);
    PG8_STAGE(PG8_SB(0, 0), cB, voffB); PG8_STAGE(PG8_SA(0, 0), cA, voffA); PG8_STAGE(PG8_SB(0, 1), cB + hstep, voffB); PG8_STAGE(PG8_SA(0, 1), cA + hstep, voffA);
    if (wr == 1) PG8_BAR;
    PG8_WAIT_V(4); PG8_BAR;
    PG8_STAGE(PG8_SB(1, 0), cB + kstep, voffB); PG8_STAGE(PG8_SA(1, 0), cA + kstep, voffA); PG8_STAGE(PG8_SB(1, 1), cB + hstep + kstep, voffB);
    PG8_WAIT_V(6); PG8_BAR;
    PG8_STAMP();
    for (;;) {
        const bool has_next = S.next(ui + 1, nxt);
        const char* nA = has_next ? (const char*)g.A + (size_t)nxt.pm * tstep + (size_t)nxt.kofs * 2 : cA; const char* nB = has_next ? (const char*)g.Bt + (size_t)nxt.pn * tstep + (size_t)nxt.kofs * 2 : cB;
        const int ntu = cur.nt ? cur.nt : nt;
        for (int t = 0; t < ntu; t += 2) {
            const bool last = (t == ntu - 2);
            const char* a1 = cA + (size_t)(t + 1) * kstep;
            const char* a2 = last ? nA : cA + (size_t)(t + 2) * kstep; const char* b2 = last ? nB : cB + (size_t)(t + 2) * kstep;
            const char* a3 = a2 + kstep; const char* b3 = b2 + kstep;
            if (last && has_next) S.a_ready(nxt);
            PG8_LDB(B0, 0, 0); PG8_SCHED; PG8_LDA(At, 0, 0); PG8_STAGE(PG8_SA(1, 1), a1 + hstep, voffA);
            PG8_WAIT_L(8); PG8_BAR; PG8_WAIT_L(0); PG8_MMA(0, 0, At, B0); PG8_BAR; PG8_SCHED;
            PG8_LDB(B1, 0, 1); PG8_STAGE(PG8_SB(0, 0), b2, voffB);
            PG8_BAR; PG8_WAIT_L(0); PG8_MMA(0, 1, At, B1); PG8_BAR;
            PG8_LDA(At, 0, 1); PG8_STAGE(PG8_SA(0, 0), a2, voffA);
            PG8_BAR; PG8_WAIT_L(0); PG8_MMA(1, 0, At, B0); PG8_BAR; PG8_SCHED;
            PG8_STAGE(PG8_SB(0, 1), b2 + hstep, voffB);
            PG8_WAIT_V(6); PG8_BAR; PG8_MMA(1, 1, At, B1); PG8_BAR;
            PG8_LDB(B0, 1, 0); PG8_SCHED; PG8_LDA(At, 1, 0); PG8_STAGE(PG8_SA(0, 1), a2 + hstep, voffA);
            PG8_WAIT_L(8); PG8_BAR; PG8_WAIT_L(0); PG8_MMA(0, 0, At, B0); PG8_BAR; PG8_SCHED;
            PG8_LDB(B1, 1, 1); PG8_STAGE(PG8_SB(1, 0), b3, voffB);
            PG8_BAR; PG8_WAIT_L(0); PG8_MMA(0, 1, At, B1); PG8_BAR;
            PG8_LDA(At, 1, 1); PG8_STAGE(PG8_SA(1, 0), a3, voffA);
            PG8_BAR; PG8_WAIT_L(0); PG8_MMA(1, 0, At, B0); PG8_BAR; PG8_SCHED;
            PG8_STAGE(PG8_SB(1, 1), b3 + hstep, voffB);
            PG8_WAIT_V(6); PG8_BAR; PG8_MMA(1, 1, At, B1); PG8_BAR;
        }
        PG8_STAMP();
        if constexpr (!Epi::AFTER_DRAIN) { E(acc, cur, wr, wc, fr, fq); S.done(cur); }
        PG8_STAMP();
        if (!has_next) break;
#pragma unroll
        for (int a = 0; a < 2; ++a)
#pragma unroll
            for (int b = 0; b < 2; ++b)
#pragma unroll
                for (int m = 0; m < 4; ++m)
#pragma unroll
                    for (int n = 0; n < 2; ++n) acc[a][b][m][n] = (f32x4){0.f, 0.f, 0.f, 0.f};
        cur = nxt; cA = nA; cB = nB; ++ui;
    }
    PG8_WAIT_V(0);
    if (wr == 0) PG8_BAR;
    PG8_BAR;
    if constexpr (Epi::AFTER_DRAIN) { E.fused(acc, cur, wr, wc, fr, fq, lds, wid, lane); S.done(cur); }
    PG8_STAMP();
    if (STAMP && wid == 0) { stamps[lane] = lane < nts ? (((unsigned long long)(unsigned)ts_hi << 32) | (unsigned)ts_lo) : 0ull;
        if (lane == 62) stamps[62] = rt_entry; if (lane == 63) stamps[63] = (unsigned long long)wall_clock64(); }
#undef PG8_STAMP
#undef PG8_SA
#undef PG8_SB
#undef PG8_STAGE
#undef PG8_LDA
#undef PG8_LDB
#undef PG8_MMA
#undef PG8_WAIT_V
#undef PG8_WAIT_L
#undef PG8_BAR
#undef PG8_SCHED
}
}

typedef unsigned short u16;
using pg8::f32x4; using pg8::bf16x8;
typedef float f32x2 __attribute__((ext_vector_type(2)));
typedef unsigned u32x2 __attribute__((ext_vector_type(2)));
typedef unsigned u32x4v __attribute__((ext_vector_type(4)));
typedef short s16x4 __attribute__((ext_vector_type(4)));
#define LAS __attribute__((address_space(3)))
constexpr int D = 1024, NB = 4, SEQ = 8192, CTX = 256, TPB = 8448, NTOK = 33792, FF = 2816, NCH = 132, INNER = 2048, DH = 512, NFFT = 16384;
constexpr size_t MiB = 1u << 20;
constexpr size_t OFF_WB = 0, OFF_MOD = 48 * MiB, OFF_H = 49 * MiB, OFF_U = OFF_H + 132 * MiB, OFF_R1 = OFF_U + 66 * MiB, OFF_R2 = OFF_R1 + 264 * MiB,
                 OFF_HBC = OFF_R2 + 132 * MiB, OFF_GATES = OFF_HBC + 4 * MiB, OFF_H2 = OFF_GATES + 3 * MiB, OFF_KCTX = OFF_H2 + 3 * MiB, WS_NEED = OFF_KCTX + 4 * MiB;
constexpr size_t WB_FIN0 = 0, WB_FIN1 = 11 * MiB, WB_FOUT0 = 22 * MiB, WB_FOUT1 = 22 * MiB + 5632 * 1024, WB_MIN = 33 * MiB, WB_MOUT = 41 * MiB, WB_WGT = 45 * MiB;
constexpr int LDS_BYTES = 163840;
struct KP { const float* in[36]; float* out; unsigned char* ws; int ph_lo, ph_hi; };
typedef const KP __attribute__((address_space(4))) * KPC;
enum { I_X = 0, I_C, I_CTX, I_CCTX, I_ADAW, I_ADAB, I_NORMG, I_FINALG, I_FFNIN, I_FFNOUT, I_HYWIN, I_HYBIN, I_HYCW, I_HYCB, I_HYW1, I_HYB1, I_HYW2, I_HYB2, I_HYW3, I_HYB3,
       I_HYFREQ, I_HYDECAY, I_HYSKIP, I_HYWOUT, I_HYBOUT, I_MLUP, I_MLCW, I_MLCB, I_MLWQ, I_MLWK, I_MLWV, I_MLWG, I_MLBG, I_MLNG, I_MLSKIP, I_MLDOWN };

__device__ __forceinline__ float bf2f(u16 b) { return __uint_as_float(((unsigned)b) << 16); }
__device__ __forceinline__ float bflo(unsigned w) { return __uint_as_float(w << 16); }
__device__ __forceinline__ float bfhi(unsigned w) { return __uint_as_float(w & 0xffff0000u); }
__device__ __forceinline__ u16 f2bf(float f) { return (u16)(pg8::cvt_pk_bf16(f, 0.f) & 0xffffu); }
__device__ __forceinline__ float siluf(float x) { return x / (1.0f + __expf(-x)); }
__device__ __forceinline__ int modrow_of_token(int T) { const int b = T / TPB, t = T - b * TPB; return t < CTX ? 4 : b; }
__device__ __forceinline__ float lshfl(float v, int srclane) { return __int_as_float(__builtin_amdgcn_ds_bpermute(srclane << 2, __float_as_int(v))); }
__device__ __forceinline__ float wave_sum(float v) { const int lane = llane();
#pragma unroll
    for (int o = 32; o > 0; o >>= 1) v += lshfl(v, lane ^ o);
    return v; }
__device__ __forceinline__ float wave_max(float v) { const int lane = llane();
#pragma unroll
    for (int o = 32; o > 0; o >>= 1) v = fmaxf(v, lshfl(v, lane ^ o));
    return v; }

__device__ __forceinline__ void unpack8(u32x4v w, float (&f)[8]) { f[0] = bflo(w.x); f[1] = bfhi(w.x); f[2] = bflo(w.y); f[3] = bfhi(w.y); f[4] = bflo(w.z); f[5] = bfhi(w.z); f[6] = bflo(w.w); f[7] = bfhi(w.w); }
__device__ __forceinline__ u32x4v pack8(const float (&f)[8]) { u32x4v w; w.x = pg8::cvt_pk_bf16(f[0], f[1]); w.y = pg8::cvt_pk_bf16(f[2], f[3]); w.z = pg8::cvt_pk_bf16(f[4], f[5]); w.w = pg8::cvt_pk_bf16(f[6], f[7]); return w; }

struct EpiSwiglu {
    static constexpr bool PERM = true, AFTER_DRAIN = false;
    u16* act;
    __device__ __forceinline__ void operator()(const f32x4 (&acc)[2][2][4][2], const pg8::Unit& u, int wr, int wc, int fr, int fq) const {
        const int row0 = u.pm * 256 + wr * 64 + fr, col0 = u.pn * 128 + wc * 32 + 8 * fq;
#pragma unroll
        for (int ai = 0; ai < 2; ++ai)
#pragma unroll
            for (int m = 0; m < 4; ++m) {
                const f32x4 g0 = acc[ai][0][m][0], g1 = acc[ai][0][m][1], v0 = acc[ai][1][m][0], v1 = acc[ai][1][m][1];
                u32x4v w;
                w.x = pg8::cvt_pk_bf16(siluf(g0[0]) * v0[0], siluf(g0[1]) * v0[1]); w.y = pg8::cvt_pk_bf16(siluf(g0[2]) * v0[2], siluf(g0[3]) * v0[3]);
                w.z = pg8::cvt_pk_bf16(siluf(g1[0]) * v1[0], siluf(g1[1]) * v1[1]); w.w = pg8::cvt_pk_bf16(siluf(g1[2]) * v1[2], siluf(g1[3]) * v1[3]);
                *(u32x4v*)(act + (size_t)(row0 + ai * 128 + m * 16) * FF + col0) = w; }
    }
};
struct EpiResid {
    static constexpr bool PERM = false, AFTER_DRAIN = false;
    KPC kp; int l, gidx, bias_j;
    __device__ __forceinline__ void operator()(const f32x4 (&acc)[2][2][4][2], const pg8::Unit& u, int wr, int wc, int fr, int fq) const {
        unsigned char* ws = kp->ws; float* h = (float*)(ws + OFF_H); float* part = (float*)kp->out;
        const float* bias = bias_j >= 0 ? kp->in[I_HYBOUT] + (size_t)bias_j * D : nullptr; const float scale = gidx == 5 ? 1.0f : 0.5f;
        const int col0 = u.pn * 256 + wc * 32 + 4 * fq;
        const int mr = modrow_of_token(u.pm * 256);
        const float* gp = (const float*)(ws + OFF_MOD) + ((size_t)l * 5 + mr) * 9216 + gidx * 1024;
        const bool split = u.nt != 0, addb = bias != nullptr && u.kofs == 0;
        float* base = split ? part + ((size_t)(u.kofs >> 8) * 1024 + (u.pm / 33) * 256 + wr * 64 + fr) * D : h + (size_t)(u.pm * 256 + wr * 64 + fr) * D;
#pragma unroll
        for (int bj = 0; bj < 2; ++bj)
#pragma unroll
            for (int n = 0; n < 2; ++n) { const f32x4 gv = *(const f32x4*)(gp + col0 + bj * 128 + n * 16) * scale;
                const f32x4 bv = addb ? *(const f32x4*)(bias + col0 + bj * 128 + n * 16) : (f32x4){0.f, 0.f, 0.f, 0.f};
#pragma unroll
                for (int ai = 0; ai < 2; ++ai)
#pragma unroll
                    for (int m = 0; m < 4; ++m) { f32x4* q = (f32x4*)(base + (size_t)(ai * 128 + m * 16) * D + col0 + bj * 128 + n * 16); const f32x4 v = gv * (acc[ai][bj][m][n] + bv);
                        if (split) *q = v; else *q = *q + v; } }
    }
};
struct EpiBf {
    static constexpr bool PERM = true, AFTER_DRAIN = false;
    u16* O; int ldc;
    __device__ __forceinline__ void operator()(const f32x4 (&acc)[2][2][4][2], const pg8::Unit& u, int wr, int wc, int fr, int fq) const {
        const int row0 = u.pm * 256 + wr * 64 + fr, col0 = u.pn * 256 + wc * 32 + 8 * fq;
#pragma unroll
        for (int ai = 0; ai < 2; ++ai)
#pragma unroll
            for (int m = 0; m < 4; ++m)
#pragma unroll
                for (int bj = 0; bj < 2; ++bj) { const f32x4 a = acc[ai][bj][m][0], b = acc[ai][bj][m][1]; u32x4v w;
                    w.x = pg8::cvt_pk_bf16(a[0], a[1]); w.y = pg8::cvt_pk_bf16(a[2], a[3]); w.z = pg8::cvt_pk_bf16(b[0], b[1]); w.w = pg8::cvt_pk_bf16(b[2], b[3]);
                    *(u32x4v*)(O + (size_t)(row0 + ai * 128 + m * 16) * ldc + col0 + bj * 128) = w; }
    }
};
struct EpiProjT {
    static constexpr bool PERM = true, AFTER_DRAIN = false;
    u16* lat; u16* ctx; const float* bias;
    __device__ __forceinline__ void operator()(const f32x4 (&acc)[2][2][4][2], const pg8::Unit& u, int wr, int wc, int fr, int fq) const {
        const int row0 = u.pm * 256 + wr * 64 + fr, tc0 = wc * 32 + 8 * fq;
        const int b = u.pn / 33, tile = u.pn - b * 33;
#pragma unroll
        for (int ai = 0; ai < 2; ++ai)
#pragma unroll
            for (int m = 0; m < 4; ++m) { const int ch = row0 + ai * 128 + m * 16; const float bs = bias[ch];
                u16* dst = tile == 0 ? ctx + ((size_t)b * 3072 + ch) * CTX + tc0 : lat + ((size_t)b * 3072 + ch) * SEQ + (tile - 1) * 256 + tc0;
#pragma unroll
                for (int bj = 0; bj < 2; ++bj) { const f32x4 a = acc[ai][bj][m][0] + bs, c = acc[ai][bj][m][1] + bs; u32x4v w;
                    w.x = pg8::cvt_pk_bf16(a[0], a[1]); w.y = pg8::cvt_pk_bf16(a[2], a[3]); w.z = pg8::cvt_pk_bf16(c[0], c[1]); w.w = pg8::cvt_pk_bf16(c[2], c[3]);
                    *(u32x4v*)(dst + bj * 128) = w; } }
    }
};


struct LatOrder : pg8::StaticOrder {
    __device__ bool next(int i, pg8::Unit& u) const { if (!pg8::StaticOrder::next(i, u)) return false; u.pm = (u.pm >> 5) * 33 + 1 + (u.pm & 31); return true; }
};
struct CtxSplitOrder {
    int nk, G, c;
    __device__ bool next(int i, pg8::Unit& u) const { const int L = i * G + c; if (L >= 16 * nk) return false; const int un = L & 15, kc = L >> 4; u.pm = (un >> 2) * 33; u.pn = un & 3; u.kofs = kc * 256; return true; }
    __device__ __forceinline__ void a_ready(const pg8::Unit&) const {}
    __device__ __forceinline__ void done(const pg8::Unit&) const {}
};
struct EpiResidAtomic {
    static constexpr bool PERM = false, AFTER_DRAIN = false;
    float* h; const float* gp; float scale;
    __device__ __forceinline__ void operator()(const f32x4 (&acc)[2][2][4][2], const pg8::Unit& u, int wr, int wc, int fr, int fq) const {
        const int row0 = u.pm * 256 + wr * 64 + fr, col0 = u.pn * 256 + wc * 32 + 4 * fq;
#pragma unroll
        for (int bj = 0; bj < 2; ++bj)
#pragma unroll
            for (int n = 0; n < 2; ++n) { const f32x4 gv = *(const f32x4*)(gp + col0 + bj * 128 + n * 16) * scale;
#pragma unroll
                for (int ai = 0; ai < 2; ++ai)
#pragma unroll
                    for (int m = 0; m < 4; ++m) { float* q = h + (size_t)(row0 + ai * 128 + m * 16) * D + col0 + bj * 128 + n * 16; const f32x4 v = gv * acc[ai][bj][m][n];
                        atomicAdd(q, v[0]); atomicAdd(q + 1, v[1]); atomicAdd(q + 2, v[2]); atomicAdd(q + 3, v[3]); } }
    }
};

__device__ __forceinline__ void ctx_bias_phase(KPC kp, const float* gp, const float* bias) {
    float* h = (float*)(kp->ws + OFF_H);
    for (int i = lbid() * 512 + ltid(); i < NB * CTX * 256; i += gridDim.x * 512) { const int r = i >> 8, c = (i & 255) * 4, b = r >> 8, t = r & 255;
        f32x4* q = (f32x4*)(h + ((size_t)b * TPB + t) * D + c); *q = *q + *(const f32x4*)(gp + c) * *(const f32x4*)(bias + c); }
}
__device__ __forceinline__ int colmap(int n, int mapmode) { return mapmode ? (((n >> 8) << 7) + (n & 127) + ((n >> 7) & 1) * FF) : n; }
__device__ __forceinline__ void convert_T(const float* __restrict__ src, int ld, int K, int Nd, int mapmode, u16* __restrict__ dst, LAS float* tile, int& tctr) {
    const int tid = ltid(), nkt = K / 64, ntile = (Nd / 64) * nkt;
    const int G = (int)gridDim.x; const int first = (((lbid() - tctr) % G) + G) % G; tctr += ntile;
    for (int t = first; t < ntile; t += G) {
        const int n0 = (t / nkt) * 64, k0 = (t % nkt) * 64, c0 = colmap(n0, mapmode);
#pragma unroll
        for (int i = 0; i < 2; ++i) { const int e = tid + 512 * i, kr = e >> 4, c4 = (e & 15) * 4;
            const f32x4 v = *(const f32x4*)(src + (size_t)(k0 + kr) * ld + c0 + c4);
            tile[kr * 65 + c4] = v[0]; tile[kr * 65 + c4 + 1] = v[1]; tile[kr * 65 + c4 + 2] = v[2]; tile[kr * 65 + c4 + 3] = v[3]; }
        __syncthreads();
        { const int n = tid >> 3, k8 = (tid & 7) * 8; u32x4v w;
          w.x = pg8::cvt_pk_bf16(tile[(k8 + 0) * 65 + n], tile[(k8 + 1) * 65 + n]); w.y = pg8::cvt_pk_bf16(tile[(k8 + 2) * 65 + n], tile[(k8 + 3) * 65 + n]);
          w.z = pg8::cvt_pk_bf16(tile[(k8 + 4) * 65 + n], tile[(k8 + 5) * 65 + n]); w.w = pg8::cvt_pk_bf16(tile[(k8 + 6) * 65 + n], tile[(k8 + 7) * 65 + n]);
          *(u32x4v*)(dst + (size_t)(n0 + n) * K + k0 + k8) = w; }
        __syncthreads();
    }
}

__device__ __forceinline__ void norm_phase(KPC kp, int l, int sub, int nkp) {
    const float* h = (const float*)(kp->ws + OFF_H); u16* uo = (u16*)(kp->ws + OFF_U);
    const float* g = kp->in[I_NORMG] + (size_t)(l * 3 + sub) * D; const float* modl = (const float*)(kp->ws + OFF_MOD) + (size_t)l * 5 * 9216;
    const int lane = ltid() & 63, wv = ltid() >> 6;
    for (int T = lbid() * 8 + wv; T < NTOK; T += gridDim.x * 8) {
        const float* hr = h + (size_t)T * D; f32x4 v[4]; float ss = 0.f;
        const int bT = T / TPB, tT = T - bT * TPB; const bool fold = nkp > 0 && tT < CTX;
#pragma unroll
        for (int i = 0; i < 4; ++i) { v[i] = *(const f32x4*)(hr + i * 256 + lane * 4);
            if (fold) { const float* pp = (const float*)kp->out + ((size_t)bT * CTX + tT) * D + i * 256 + lane * 4; for (int kc = 0; kc < nkp; ++kc) v[i] += *(const f32x4*)(pp + (size_t)kc * 1024 * D);
                *(f32x4*)((float*)(kp->ws + OFF_H) + (size_t)T * D + i * 256 + lane * 4) = v[i]; }
            ss += v[i][0] * v[i][0] + v[i][1] * v[i][1] + v[i][2] * v[i][2] + v[i][3] * v[i][3]; }
        ss = wave_sum(ss); const float rs = rsqrtf(ss * (1.0f / D) + 1e-6f);
        const float* mp = modl + (size_t)modrow_of_token(T) * 9216 + sub * 3 * 1024;
#pragma unroll
        for (int i = 0; i < 4; ++i) { const int c = i * 256 + lane * 4; const f32x4 gg = *(const f32x4*)(g + c), sh = *(const f32x4*)(mp + c), sc = *(const f32x4*)(mp + 1024 + c);
            const f32x4 o = v[i] * rs * gg * (sc + 1.0f) + sh; u32x2 w; w.x = pg8::cvt_pk_bf16(o[0], o[1]); w.y = pg8::cvt_pk_bf16(o[2], o[3]);
            *(u32x2*)(uo + (size_t)T * D + c) = w; }
    }
}

__device__ __forceinline__ void final_phase(KPC kp) {
    const float* h = (const float*)(kp->ws + OFF_H); const float* g = kp->in[I_FINALG];
    const int lane = ltid() & 63, wv = ltid() >> 6;
    for (int r = lbid() * 8 + wv; r < NB * SEQ; r += gridDim.x * 8) {
        const int b = r / SEQ, s = r - b * SEQ; const float* hr = h + ((size_t)b * TPB + CTX + s) * D; f32x4 v[4]; float ss = 0.f;
#pragma unroll
        for (int i = 0; i < 4; ++i) { v[i] = *(const f32x4*)(hr + i * 256 + lane * 4); ss += v[i][0] * v[i][0] + v[i][1] * v[i][1] + v[i][2] * v[i][2] + v[i][3] * v[i][3]; }
        ss = wave_sum(ss); const float rs = rsqrtf(ss * (1.0f / D) + 1e-6f);
#pragma unroll
        for (int i = 0; i < 4; ++i) { const int c = i * 256 + lane * 4; *(f32x4*)(kp->out + (size_t)r * D + c) = v[i] * rs * *(const f32x4*)(g + c); }
    }
}

__device__ __forceinline__ void setup_phase(KPC kp, LAS float* ldsf) {
    float* h = (float*)(kp->ws + OFF_H); const int tid = ltid();
    const int hb0 = gridDim.x > 64 ? 32 : 0;
    for (size_t i = (size_t)(lbid() - hb0) * 512 + tid; lbid() >= hb0 && i < (size_t)NTOK * 256; i += (size_t)(gridDim.x - hb0) * 512) {
        const int T = (int)(i >> 8), c = ((int)i & 255) * 4, b = T / TPB, t = T - b * TPB; f32x4 v;
        if (t < CTX) v = *(const f32x4*)(kp->in[I_CTX] + ((size_t)b * CTX + t) * D + c);
        else { const int s = t - CTX; v = *(const f32x4*)(kp->in[I_X] + ((size_t)b * SEQ + s) * D + c);
            const int half = c >> 9, cc = c & 511, isc = cc >> 8, i0 = cc & 255; const float pv = half ? (float)(s & 63) : (float)(s >> 6);
#pragma unroll
            for (int e = 0; e < 4; ++e) { const float om = exp2f(-13.287712379549449f * (float)(i0 + e) * (1.0f / 256.0f)); const float ang = pv * om; v[e] += isc ? __cosf(ang) : __sinf(ang); } }
        *(f32x4*)(h + (size_t)T * D + c) = v;
    }
    LAS float* sc = ldsf; LAS float* red = ldsf + 5 * 1024;
    for (int i = tid; i < 5 * 1024; i += 512) { const int r = i >> 10, k = i & 1023; const float cv = r < 4 ? kp->in[I_C][r * D + k] : kp->in[I_CCTX][k]; sc[i] = siluf(cv); }
    __syncthreads();
    float* mod = (float*)(kp->ws + OFF_MOD); const int lane = tid & 63, wv = tid >> 6;
    for (int task = lbid(); task < 288; task += gridDim.x) {
        const int l = task / 72, n0 = (task % 72) * 128 + lane * 2; const float* w = kp->in[I_ADAW] + (size_t)l * D * 9216 + n0;
        f32x2 a[5];
#pragma unroll
        for (int r = 0; r < 5; ++r) a[r] = (f32x2){0.f, 0.f};
#pragma unroll 16
        for (int k = wv * 128; k < wv * 128 + 128; ++k) { const f32x2 wv2 = *(const f32x2*)(w + (size_t)k * 9216);
#pragma unroll
            for (int r = 0; r < 5; ++r) a[r] += wv2 * sc[r * 1024 + k]; }
#pragma unroll
        for (int r = 0; r < 5; ++r) { red[(wv * 5 + r) * 128 + lane * 2] = a[r][0]; red[(wv * 5 + r) * 128 + lane * 2 + 1] = a[r][1]; }
        __syncthreads();
        for (int i = tid; i < 640; i += 512) { const int r = i >> 7, n = i & 127; float s = 0.f;
#pragma unroll
            for (int w8 = 0; w8 < 8; ++w8) s += red[(w8 * 5 + r) * 128 + n];
            const int nn = (task % 72) * 128 + n; mod[((size_t)l * 5 + r) * 9216 + nn] = s + kp->in[I_ADAB][(size_t)l * 9216 + nn]; }
        __syncthreads();
    }
}

__device__ __forceinline__ void convert_layer(KPC kp, int l, LAS float* tile) {
    unsigned char* wb = kp->ws + OFF_WB; int tctr = 0; const int j = l >> 1;
    for (int f = 0; f < 2; ++f) {
        convert_T(kp->in[I_FFNIN] + (size_t)(l * 2 + f) * D * 2 * FF, 2 * FF, D, 2 * FF, 1, (u16*)(wb + (f ? WB_FIN1 : WB_FIN0)), tile, tctr);
        convert_T(kp->in[I_FFNOUT] + (size_t)(l * 2 + f) * FF * D, D, FF, D, 0, (u16*)(wb + (f ? WB_FOUT1 : WB_FOUT0)), tile, tctr);
    }
    if ((l & 1) == 0) {
        convert_T(kp->in[I_HYWIN] + (size_t)j * D * 3 * D, 3 * D, D, 3 * D, 0, (u16*)(wb + WB_MIN), tile, tctr);
        convert_T(kp->in[I_HYWOUT] + (size_t)j * D * D, D, D, D, 0, (u16*)(wb + WB_MOUT), tile, tctr);
    } else {
        convert_T(kp->in[I_MLUP] + (size_t)j * D * 2 * INNER, 2 * INNER, D, 2 * INNER, 0, (u16*)(wb + WB_MIN), tile, tctr);
        convert_T(kp->in[I_MLDOWN] + (size_t)j * INNER * D, D, INNER, D, 0, (u16*)(wb + WB_MOUT), tile, tctr);
        u16* wg = (u16*)(wb + WB_WGT); const float* src = kp->in[I_MLWG] + (size_t)j * 3 * INNER * 16;
        for (int i = lbid() * 512 + ltid(); i < 16 * 3 * INNER; i += gridDim.x * 512) { const int o = i / (3 * INNER), k = i - o * 3 * INNER; wg[i] = f2bf(src[(size_t)k * 16 + o]); }
        float* gates = (float*)(kp->ws + OFF_GATES); const float* bg = kp->in[I_MLBG] + j * 16;
        for (int i = lbid() * 512 + ltid(); i < NTOK * 16; i += gridDim.x * 512) gates[i] = bg[i & 15];
    }
}

constexpr size_t HY_PL = 0, HY_PC = (size_t)NB * 3072 * SEQ * 2, HY_YL = HY_PC + (size_t)NB * 3072 * CTX * 2, HY_YC = HY_YL + (size_t)NB * D * SEQ * 2;
__device__ __forceinline__ int fphys(int i) { return i ^ ((((i >> 6) & 1) * 21) ^ (((i >> 5) & 1) * 10)); }
__device__ __forceinline__ f32x2 cmul(f32x2 a, f32x2 b) { return (f32x2){a.x * b.x - a.y * b.y, a.x * b.y + a.y * b.x}; }
__device__ __forceinline__ f32x2 cmulc(f32x2 a, f32x2 b) { return (f32x2){a.x * b.x + a.y * b.y, a.y * b.x - a.x * b.y}; }
__device__ __forceinline__ int drev(int x) { const unsigned r = __brev((unsigned)x) >> 18; return (int)(((r & 0x2AAAu) >> 1) | ((r & 0x1555u) << 1)); }

__device__ __forceinline__ void fidx4(int base, int lm, int (&ix)[4]) {
    const int m = 1 << lm;
    if (lm == 6) { const int i0 = fphys(base); ix[0] = i0; ix[1] = (i0 + 64) ^ 21; ix[2] = i0 + 128; ix[3] = (i0 + 192) ^ 21; }
    else if (lm == 4) { const int c6 = ((base >> 6) & 1) * 21; ix[0] = base ^ c6; ix[1] = (base + 16) ^ c6; ix[2] = (base + 32) ^ c6 ^ 10; ix[3] = (base + 48) ^ c6 ^ 10; }
    else { const int c = (((base >> 6) & 1) * 21) ^ (((base >> 5) & 1) * 10); ix[0] = base ^ c; ix[1] = (base + m) ^ c; ix[2] = (base + 2 * m) ^ c; ix[3] = (base + 3 * m) ^ c; }
}
__device__ __forceinline__ void fft_fwd(LAS f32x2* buf) {
    const int tid = ltid();
    for (int lm = 12; lm >= 0; lm -= 2) {
        const int m = 1 << lm; const float inv = 1.0f / (float)(4 << lm);
        f32x2 a[8][4]; int ix[8][4];
#pragma unroll
        for (int i = 0; i < 8; ++i) { const int g = tid + 512 * i, p = g & (m - 1), base = ((g >> lm) << (lm + 2)) + p; fidx4(base, lm, ix[i]);
#pragma unroll
            for (int r = 0; r < 4; ++r) a[i][r] = buf[ix[i][r]]; }
#pragma unroll
        for (int i = 0; i < 8; ++i) { const int p = (tid + 512 * i) & (m - 1);
            const f32x2 t0 = a[i][0] + a[i][2], t1 = a[i][0] - a[i][2], t2 = a[i][1] + a[i][3], dd = a[i][1] - a[i][3], t3 = (f32x2){dd.y, -dd.x};
            const float rev = (float)p * inv;
            const f32x2 w1 = (f32x2){__builtin_amdgcn_cosf(rev), -__builtin_amdgcn_sinf(rev)}, w2 = cmul(w1, w1), w3 = cmul(w2, w1);
            buf[ix[i][0]] = t0 + t2; buf[ix[i][1]] = cmul(t1 + t3, w1); buf[ix[i][2]] = cmul(t0 - t2, w2); buf[ix[i][3]] = cmul(t1 - t3, w3); }
        __syncthreads();
    }
}
__device__ __forceinline__ void fft_inv(LAS f32x2* buf) {
    const int tid = ltid();
    for (int lm = 0; lm <= 12; lm += 2) {
        const int m = 1 << lm; const float inv = 1.0f / (float)(4 << lm);
        f32x2 a[8][4]; int ix[8][4];
#pragma unroll
        for (int i = 0; i < 8; ++i) { const int g = tid + 512 * i, p = g & (m - 1), base = ((g >> lm) << (lm + 2)) + p; fidx4(base, lm, ix[i]);
#pragma unroll
            for (int r = 0; r < 4; ++r) a[i][r] = buf[ix[i][r]]; }
#pragma unroll
        for (int i = 0; i < 8; ++i) { const int p = (tid + 512 * i) & (m - 1);
            const float rev = (float)p * inv;
            const f32x2 w1 = (f32x2){__builtin_amdgcn_cosf(rev), -__builtin_amdgcn_sinf(rev)}, w2 = cmul(w1, w1), w3 = cmul(w2, w1);
            const f32x2 b0 = a[i][0], b1 = cmulc(a[i][1], w1), b2 = cmulc(a[i][2], w2), b3 = cmulc(a[i][3], w3);
            const f32x2 s0 = b0 + b2, s1 = b0 - b2, s2 = b1 + b3, dd = b1 - b3, s3 = (f32x2){-dd.y, dd.x};
            buf[ix[i][0]] = s0 + s2; buf[ix[i][1]] = s1 + s3; buf[ix[i][2]] = s0 - s2; buf[ix[i][3]] = s1 - s3; }
        __syncthreads();
    }
}

__device__ __forceinline__ void hy_mlp_phase(KPC kp, int j) {
    float* h2 = (float*)(kp->ws + OFF_H2);
    const float* w1 = kp->in[I_HYW1] + j * 33 * 64; const float* b1 = kp->in[I_HYB1] + j * 64; const float* w2 = kp->in[I_HYW2] + j * 64 * 64; const float* b2 = kp->in[I_HYB2] + j * 64;
    const float* fr = kp->in[I_HYFREQ] + j * 128; const int lane = ltid() & 63, wv = ltid() >> 6;
    for (int pos = lbid() * 8 + wv; pos < SEQ + CTX; pos += gridDim.x * 8) {
        const int n = pos < SEQ ? SEQ : CTX, t = pos < SEQ ? pos : pos - SEQ; const float tn = (float)t / (float)(n - 1);
        float feat = 0.f;
        if (lane == 0) feat = tn;
        else if (lane < 33) { const int bi = (lane - 1) & 15; const float band = 1e-4f + (float)bi * ((15.0f - 1e-4f) / 15.0f); float rev = ((float)t / (float)n) * band; rev -= floorf(rev);
            const float ang = 6.283185307179586f * rev; feat = lane < 17 ? cosf(ang) : -sinf(ang); }
        float z = b1[lane];
        for (int i = 0; i < 33; ++i) z += lshfl(feat, i) * w1[i * 64 + lane];
        const float h1 = sinf(fr[lane] * z);
        float z2 = b2[lane];
        for (int v = 0; v < 64; ++v) z2 += lshfl(h1, v) * w2[v * 64 + lane];
        h2[(size_t)pos * 64 + lane] = sinf(fr[64 + lane] * z2);
    }
}

__device__ __forceinline__ void block_sum2(float& a, float& b, LAS float* red) {
    a = wave_sum(a); b = wave_sum(b); const int lane = ltid() & 63, wv = ltid() >> 6;
    __syncthreads(); if (lane == 0) { red[wv] = a; red[8 + wv] = b; } __syncthreads();
    float sa = 0.f, sb = 0.f;
#pragma unroll
    for (int i = 0; i < 8; ++i) { sa += red[i]; sb += red[8 + i]; }
    a = sa; b = sb;
}

__device__ __forceinline__ void hy_filter_task(KPC kp, int j, int task, LAS f32x2* buf, LAS float* aux) {
    const int tid = ltid(), d = task & 1023; const bool lat = task < 1024;
    const float* w3 = kp->in[I_HYW3] + (size_t)j * 64 * 4096; const float* b3 = kp->in[I_HYB3] + j * 4096; const float* ldc = kp->in[I_HYDECAY] + j * 4096;
    __syncthreads();
    if (tid < 256) aux[tid] = w3[(size_t)(tid & 63) * 4096 + (tid >> 6) * 1024 + d];
    if (tid < 4) { aux[256 + tid] = b3[tid * 1024 + d]; aux[260 + tid] = __expf(ldc[tid * 1024 + d]); }
    __syncthreads();
    const float* h2 = (const float*)(kp->ws + OFF_H2);
    float ss0 = 0.f, ss1 = 0.f;
    if (lat) {
        for (int r = 0; r < 16; ++r) { const int i = tid + 512 * r; float a0 = aux[256], a1 = aux[257], a2 = aux[258], a3 = aux[259];
#pragma unroll 4
            for (int u4 = 0; u4 < 16; ++u4) { const f32x4 hv = *(const f32x4*)(h2 + (size_t)i * 64 + u4 * 4);
                const f32x4 q0 = *(const LAS f32x4*)(aux + u4 * 4), q1 = *(const LAS f32x4*)(aux + 64 + u4 * 4), q2 = *(const LAS f32x4*)(aux + 128 + u4 * 4), q3 = *(const LAS f32x4*)(aux + 192 + u4 * 4);
#pragma unroll
                for (int e = 0; e < 4; ++e) { a0 += hv[e] * q0[e]; a1 += hv[e] * q1[e]; a2 += hv[e] * q2[e]; a3 += hv[e] * q3[e]; } }
            const float tn = (float)i * (1.0f / 8191.0f);
            a0 *= __expf(-tn * aux[260]); a1 *= __expf(-tn * aux[261]); a2 *= __expf(-tn * aux[262]); a3 *= __expf(-tn * aux[263]);
            buf[fphys(i)] = (f32x2){a0, a2}; ss0 += a0 * a0; ss1 += a2 * a2;
            if (i >= 1) { buf[fphys(NFFT - i)] = (f32x2){a1, a3}; ss0 += a1 * a1; ss1 += a3 * a3; } }
        if (tid == 0) buf[fphys(SEQ)] = (f32x2){0.f, 0.f};
        block_sum2(ss0, ss1, aux + 272);
        const f32x2 scl = (f32x2){rsqrtf(ss0 + 1e-12f) * (1.0f / NFFT), rsqrtf(ss1 + 1e-12f) * (1.0f / NFFT)};
        for (int r = 0; r < 32; ++r) { const int q = fphys(tid + 512 * r); buf[q] = buf[q] * scl; }
        __syncthreads();
        fft_fwd(buf);
        f32x2* K0 = (f32x2*)(kp->ws + OFF_R2) + (size_t)d * NFFT; f32x2* K1 = (f32x2*)kp->out + (size_t)d * NFFT;
        for (int r = 0; r < 32; ++r) { const int pos = tid + 512 * r, k = drev(pos), pos2 = drev((NFFT - k) & (NFFT - 1)); const f32x2 Z = buf[fphys(pos)], Z2 = buf[fphys(pos2)];
            K0[pos] = (f32x2){0.5f * (Z.x + Z2.x), 0.5f * (Z.y - Z2.y)}; K1[pos] = (f32x2){0.5f * (Z.y + Z2.y), -0.5f * (Z.x - Z2.x)}; }
    } else {
        const int idx = tid; float a0 = 0.f, a1 = 0.f;
        if (idx != CTX) { const int t = idx < CTX ? idx : 2 * CTX - idx, dir = idx < CTX ? 0 : 1; a0 = aux[256 + dir]; a1 = aux[258 + dir];
            for (int u4 = 0; u4 < 16; ++u4) { const f32x4 hv = *(const f32x4*)(h2 + (size_t)(SEQ + t) * 64 + u4 * 4);
#pragma unroll
                for (int e = 0; e < 4; ++e) { const int u = u4 * 4 + e; a0 += hv[e] * aux[dir * 64 + u]; a1 += hv[e] * aux[128 + dir * 64 + u]; } }
            const float tn = (float)t * (1.0f / 255.0f); a0 *= __expf(-tn * aux[260 + dir]); a1 *= __expf(-tn * aux[262 + dir]); }
        ss0 = a0 * a0; ss1 = a1 * a1;
        block_sum2(ss0, ss1, aux + 272);
        float* kc = (float*)(kp->ws + OFF_KCTX);
        kc[(size_t)d * 512 + idx] = a0 * rsqrtf(ss0 + 1e-12f); kc[(size_t)(1024 + d) * 512 + idx] = a1 * rsqrtf(ss1 + 1e-12f);
    }
}

__device__ __forceinline__ float ld3(const u16* row, int t, int n, float wa, float wb, float wc, float bias) {
    const float xm = t > 0 ? bf2f(row[t - 1]) : 0.f, x0 = bf2f(row[t]), xp = t < n - 1 ? bf2f(row[t + 1]) : 0.f; return wa * xm + wb * x0 + wc * xp + bias; }

__device__ __forceinline__ void ld3x8(const u16* row, int t0, float wa, float wb, float wc, float bias, float (&o)[8]) {
    const u32x4v w = *(const u32x4v*)(row + t0);
    const float x0 = bflo(w.x), x1 = bfhi(w.x), x2 = bflo(w.y), x3 = bfhi(w.y), x4 = bflo(w.z), x5 = bfhi(w.z), x6 = bflo(w.w), x7 = bfhi(w.w);
    const float xl = t0 > 0 ? bf2f(row[t0 - 1]) : 0.f, xr = t0 + 8 < SEQ ? bf2f(row[t0 + 8]) : 0.f;
    o[0] = wa * xl + wb * x0 + wc * x1 + bias; o[1] = wa * x0 + wb * x1 + wc * x2 + bias; o[2] = wa * x1 + wb * x2 + wc * x3 + bias; o[3] = wa * x2 + wb * x3 + wc * x4 + bias;
    o[4] = wa * x3 + wb * x4 + wc * x5 + bias; o[5] = wa * x4 + wb * x5 + wc * x6 + bias; o[6] = wa * x5 + wb * x6 + wc * x7 + bias; o[7] = wa * x6 + wb * x7 + wc * xr + bias;
}
__device__ __forceinline__ void hy_conv_lat(KPC kp, int j, int task, LAS f32x2* buf) {
    const int tid = ltid(), bp = task >> 10, c = task & 1023, b0 = bp * 2;
    const u16* pl = (const u16*)(kp->ws + OFF_R1 + HY_PL); u16* yl = (u16*)(kp->ws + OFF_R1 + HY_YL);
    const float* cw = kp->in[I_HYCW] + (size_t)j * 3 * 3072; const float* cb = kp->in[I_HYCB] + j * 3072;
    const float w1a = cw[c], w1b = cw[3072 + c], w1c = cw[6144 + c], bb1 = cb[c];
    const float w2a = cw[1024 + c], w2b = cw[3072 + 1024 + c], w2c = cw[6144 + 1024 + c], bb2 = cb[1024 + c];
    const float w3a = cw[2048 + c], w3b = cw[3072 + 2048 + c], w3c = cw[6144 + 2048 + c], bb3 = cb[2048 + c];
    const float sk0 = kp->in[I_HYSKIP][j * 2048 + c], sk1 = kp->in[I_HYSKIP][j * 2048 + 1024 + c];
    const u16* x1r0 = pl + ((size_t)b0 * 3072 + c) * SEQ; const u16* x1r1 = x1r0 + (size_t)3072 * SEQ;
    const u16* x2r0 = x1r0 + (size_t)1024 * SEQ; const u16* x2r1 = x1r1 + (size_t)1024 * SEQ;
    const u16* vr0 = x1r0 + (size_t)2048 * SEQ; const u16* vr1 = x1r1 + (size_t)2048 * SEQ;
    const f32x2* K0 = (const f32x2*)(kp->ws + OFF_R2) + (size_t)c * NFFT; const f32x2* K1 = (const f32x2*)kp->out + (size_t)c * NFFT;
    __syncthreads();
#pragma unroll
    for (int g = 0; g < 2; ++g) { const int t0 = 8 * (tid + 512 * g); float v0[8], v1[8];
        ld3x8(vr0, t0, w3a, w3b, w3c, bb3, v0); ld3x8(vr1, t0, w3a, w3b, w3c, bb3, v1);
#pragma unroll
        for (int e = 0; e < 8; ++e) { buf[fphys(t0 + e)] = (f32x2){v0[e], v1[e]}; buf[fphys(SEQ + t0 + e)] = (f32x2){0.f, 0.f}; } }
    __syncthreads();
#ifdef PROBE_FFT
    for (int rp = 0; rp < PROBE_FFT; ++rp) { fft_fwd(buf); fft_inv(buf); for (int r = 0; r < 32; ++r) { const int q = fphys(tid + 512 * r); buf[q] = buf[q] * (1.0f / NFFT); } __syncthreads(); }
#endif
    fft_fwd(buf);
#pragma unroll 8
    for (int r = 0; r < 32; ++r) { const int pos = tid + 512 * r, q = fphys(pos); buf[q] = cmul(buf[q], K0[pos]); }
    __syncthreads();
    fft_inv(buf);
    float zr[32];
#pragma unroll
    for (int g = 0; g < 2; ++g) { const int t0 = 8 * (tid + 512 * g); float v0[8], v1[8], xa[8], xb[8];
        ld3x8(vr0, t0, w3a, w3b, w3c, bb3, v0); ld3x8(vr1, t0, w3a, w3b, w3c, bb3, v1); ld3x8(x1r0, t0, w1a, w1b, w1c, bb1, xa); ld3x8(x1r1, t0, w1a, w1b, w1c, bb1, xb);
#pragma unroll
        for (int e = 0; e < 8; ++e) { const f32x2 y = buf[fphys(t0 + e)]; const float z0 = xa[e] * (y.x + sk0 * v0[e]), z1 = xb[e] * (y.y + sk0 * v1[e]);
            zr[g * 16 + 2 * e] = z0; zr[g * 16 + 2 * e + 1] = z1; buf[fphys(t0 + e)] = (f32x2){z0, z1}; buf[fphys(SEQ + t0 + e)] = (f32x2){0.f, 0.f}; } }
    __syncthreads();
    fft_fwd(buf);
#pragma unroll 8
    for (int r = 0; r < 32; ++r) { const int pos = tid + 512 * r, q = fphys(pos); buf[q] = cmul(buf[q], K1[pos]); }
    __syncthreads();
    fft_inv(buf);
#pragma unroll
    for (int g = 0; g < 2; ++g) { const int t0 = 8 * (tid + 512 * g); float xa[8], xb[8], o0[8], o1[8];
        ld3x8(x2r0, t0, w2a, w2b, w2c, bb2, xa); ld3x8(x2r1, t0, w2a, w2b, w2c, bb2, xb);
#pragma unroll
        for (int e = 0; e < 8; ++e) { const f32x2 y = buf[fphys(t0 + e)]; o0[e] = xa[e] * (y.x + sk1 * zr[g * 16 + 2 * e]); o1[e] = xb[e] * (y.y + sk1 * zr[g * 16 + 2 * e + 1]); }
        *(u32x4v*)(yl + ((size_t)b0 * D + c) * SEQ + t0) = pack8(o0); *(u32x4v*)(yl + ((size_t)(b0 + 1) * D + c) * SEQ + t0) = pack8(o1); }
}

__device__ __forceinline__ void hy_conv_ctx(KPC kp, int j, int c, LAS float* ls) {
    const int tid = ltid();
    const u16* pc = (const u16*)(kp->ws + OFF_R1 + HY_PC); u16* yc = (u16*)(kp->ws + OFF_R1 + HY_YC); const float* kc = (const float*)(kp->ws + OFF_KCTX);
    const float* cw = kp->in[I_HYCW] + (size_t)j * 3 * 3072; const float* cb = kp->in[I_HYCB] + j * 3072;
    const float w1a = cw[c], w1b = cw[3072 + c], w1c = cw[6144 + c], bb1 = cb[c];
    const float w2a = cw[1024 + c], w2b = cw[3072 + 1024 + c], w2c = cw[6144 + 1024 + c], bb2 = cb[1024 + c];
    const float w3a = cw[2048 + c], w3b = cw[3072 + 2048 + c], w3c = cw[6144 + 2048 + c], bb3 = cb[2048 + c];
    const float sk0 = kp->in[I_HYSKIP][j * 2048 + c], sk1 = kp->in[I_HYSKIP][j * 2048 + 1024 + c];
    __syncthreads();
    ls[tid] = kc[(size_t)c * 512 + tid]; ls[512 + tid] = kc[(size_t)(1024 + c) * 512 + tid];
    for (int i = 0; i < 2; ++i) { const int e = tid + 512 * i, b = e >> 8, t = e & 255; ls[1024 + e] = ld3(pc + ((size_t)b * 3072 + 2048 + c) * CTX, t, CTX, w3a, w3b, w3c, bb3); }
    __syncthreads();
    float zr[2];
    for (int i = 0; i < 2; ++i) { const int e = tid + 512 * i, b = e >> 8, t = e & 255; float a = 0.f;
        for (int s = 0; s < CTX; ++s) a += ls[(t - s) & 511] * ls[1024 + b * 256 + s];
        zr[i] = ld3(pc + ((size_t)b * 3072 + c) * CTX, t, CTX, w1a, w1b, w1c, bb1) * (a + sk0 * ls[1024 + e]); ls[2048 + e] = zr[i]; }
    __syncthreads();
    for (int i = 0; i < 2; ++i) { const int e = tid + 512 * i, b = e >> 8, t = e & 255; float a = 0.f;
        for (int s = 0; s < CTX; ++s) a += ls[512 + ((t - s) & 511)] * ls[2048 + b * 256 + s];
        yc[((size_t)b * D + c) * CTX + t] = f2bf(ld3(pc + ((size_t)b * 3072 + 1024 + c) * CTX, t, CTX, w2a, w2b, w2c, bb2) * (a + sk1 * zr[i])); }
}

__device__ __forceinline__ void hy_transpose(KPC kp, LAS u16* tl) {
    const u16* yl = (const u16*)(kp->ws + OFF_R1 + HY_YL); const u16* yc = (const u16*)(kp->ws + OFF_R1 + HY_YC); u16* y = (u16*)(kp->ws + OFF_U); const int tid = ltid();
    for (int tile = lbid(); tile < NB * 16 * NCH; tile += gridDim.x) {
        const int b = tile / (16 * NCH), rem = tile - b * 16 * NCH, ct = rem / NCH, tt = rem - ct * NCH;
        const u16* src = tt < 4 ? yc + ((size_t)b * D + ct * 64) * CTX + tt * 64 : yl + ((size_t)b * D + ct * 64) * SEQ + (tt - 4) * 64; const int ld = tt < 4 ? CTX : SEQ;
        { const int cr = tid >> 3, t8 = (tid & 7) * 8; *(LAS u32x4v*)(tl + cr * 72 + t8) = *(const u32x4v*)(src + (size_t)cr * ld + t8); }
        __syncthreads();
        { const int tr = tid >> 3, c8 = (tid & 7) * 8; u32x4v w;
          w.x = (unsigned)tl[(c8 + 0) * 72 + tr] | ((unsigned)tl[(c8 + 1) * 72 + tr] << 16); w.y = (unsigned)tl[(c8 + 2) * 72 + tr] | ((unsigned)tl[(c8 + 3) * 72 + tr] << 16);
          w.z = (unsigned)tl[(c8 + 4) * 72 + tr] | ((unsigned)tl[(c8 + 5) * 72 + tr] << 16); w.w = (unsigned)tl[(c8 + 6) * 72 + tr] | ((unsigned)tl[(c8 + 7) * 72 + tr] << 16);
          *(u32x4v*)(y + ((size_t)b * TPB + tt * 64 + tr) * D + ct * 64 + c8) = w; }
        __syncthreads();
    }
}

constexpr size_t OFF_XM = OFF_R1, OFF_XC = OFF_R1 + 132 * MiB, OFF_S = WS_NEED, OFF_MLM = OFF_S + 34 * MiB, WS_NEED2 = OFF_MLM + 1 * MiB;
__device__ __forceinline__ u16* hb_ptr(KPC kp, int T) { const int b = T / TPB, t = T - b * TPB;
    return t < CTX ? (u16*)(kp->ws + OFF_HBC) + ((size_t)b * CTX + t) * INNER : (u16*)kp->out + ((size_t)b * SEQ + (t - CTX)) * INNER; }
__device__ __forceinline__ void bd8(const float (&x)[8], const float (&w)[32], float (&y)[8]) {
#pragma unroll
    for (int bl = 0; bl < 2; ++bl)
#pragma unroll
        for (int e = 0; e < 4; ++e) { float s = 0.f;
#pragma unroll
            for (int d = 0; d < 4; ++d) s += x[bl * 4 + d] * w[bl * 16 + d * 4 + e];
            y[bl * 4 + e] = s; }
}
typedef float f32x8s __attribute__((ext_vector_type(8)));
__device__ __forceinline__ void sload32(const float* p, float (&w)[32]) {
    f32x8s a, b, c, d;
    asm volatile("s_load_dwordx8 %0, %4, 0x0\n\ts_load_dwordx8 %1, %4, 0x20\n\ts_load_dwordx8 %2, %4, 0x40\n\ts_load_dwordx8 %3, %4, 0x60\n\ts_waitcnt lgkmcnt(0)"
                 : "=&s"(a), "=&s"(b), "=&s"(c), "=&s"(d) : "s"(p) : "memory");
#pragma unroll
    for (int i = 0; i < 8; ++i) { w[i] = a[i]; w[8 + i] = b[i]; w[16 + i] = c[i]; w[24 + i] = d[i]; }
}
__device__ __forceinline__ void ldw32(const float* p, float (&w)[32]) {
#pragma unroll
    for (int i = 0; i < 8; ++i) { const f32x4 v = *(const f32x4*)(p + i * 4); w[i * 4] = v[0]; w[i * 4 + 1] = v[1]; w[i * 4 + 2] = v[2]; w[i * 4 + 3] = v[3]; } }

__device__ __forceinline__ void ml_m_phase(KPC kp, int j) {
    float* M = (float*)(kp->ws + OFF_MLM) + (size_t)j * 8192;
    const float* wq = kp->in[I_MLWQ] + (size_t)j * 512 * 16; const float* wk = kp->in[I_MLWK] + (size_t)j * 512 * 16;
    for (int i = lbid() * 512 + ltid(); i < 512 * 16; i += gridDim.x * 512) { const int blk = i >> 4, d = (i >> 2) & 3, d2 = i & 3; float s = 0.f;
#pragma unroll
        for (int e = 0; e < 4; ++e) s += wq[blk * 16 + d * 4 + e] * wk[blk * 16 + d2 * 4 + e];
        M[i] = s * 0.04419417382415922f; }
}

__device__ __forceinline__ void ml_prep_task(KPC kp, int j, int task, LAS unsigned char* lds) {
    const int tid = ltid(), lane = tid & 63, wv = tid >> 6, fr = lane & 15, fq = lane >> 4;
    const int hd = task & 3, bc = task >> 2, b = bc / NCH, ci = bc - b * NCH;
    const u16* xm = (const u16*)(kp->ws + OFF_XM); u16* xc = (u16*)(kp->ws + OFF_XC);
    const int T0 = b * TPB + ci * 64, tlo = b * TPB + (ci < 4 ? 0 : CTX), thi = b * TPB + (ci < 4 ? CTX - 1 : TPB - 1);
    const int ch0 = hd * DH + lane * 8;
    LAS u16* QS = (LAS u16*)lds; LAS u16* KS = (LAS u16*)(lds + 66560);
    const float* cw = kp->in[I_MLCW] + (size_t)j * 3 * INNER; const float* cb = kp->in[I_MLCB] + (size_t)j * INNER;
    __syncthreads();
    {
        float cwa[8], cwb[8], cwc[8], cbb[8], wq[32], wk[32];
#pragma unroll
        for (int e = 0; e < 8; ++e) { cwa[e] = cw[ch0 + e]; cwb[e] = cw[INNER + ch0 + e]; cwc[e] = cw[2 * INNER + ch0 + e]; cbb[e] = cb[ch0 + e]; }
        ldw32(kp->in[I_MLWQ] + ((size_t)j * 512 + (ch0 >> 2)) * 16, wq); ldw32(kp->in[I_MLWK] + ((size_t)j * 512 + (ch0 >> 2)) * 16, wk);
        for (int r = 0; r < 8; ++r) { const int jj = wv + 8 * r, T = T0 + jj; const u16* p = xm + (size_t)T * INNER + ch0;
            float x0[8], xa[8], xb[8], xcv[8], q[8], k[8];
            unpack8(*(const u32x4v*)p, x0);
            if (T > tlo) unpack8(*(const u32x4v*)(p - INNER), xa); else {
#pragma unroll
                for (int e = 0; e < 8; ++e) xa[e] = 0.f; }
            if (T < thi) unpack8(*(const u32x4v*)(p + INNER), xb); else {
#pragma unroll
                for (int e = 0; e < 8; ++e) xb[e] = 0.f; }
#pragma unroll
            for (int e = 0; e < 8; ++e) xcv[e] = siluf(cwa[e] * xa[e] + cwb[e] * x0[e] + cwc[e] * xb[e] + cbb[e]);
            const u32x4v xw = pack8(xcv); *(u32x4v*)(xc + (size_t)T * INNER + ch0) = xw; unpack8(xw, xcv);
            bd8(xcv, wq, q); bd8(xcv, wk, k);
            *(LAS u32x4v*)(QS + jj * 520 + lane * 8) = pack8(q); *(LAS u32x4v*)(KS + jj * 520 + lane * 8) = pack8(k); }
    }
    __syncthreads();
    const u16* wg = (const u16*)(kp->ws + OFF_WB + WB_WGT);
    const int mt = wv & 3, kh = wv >> 2;
    { f32x4 s0 = {0.f, 0.f, 0.f, 0.f}, s1 = {0.f, 0.f, 0.f, 0.f}; const int nt0 = kh * 2;
      for (int ks = 0; ks < 16; ++ks) { const bf16x8 a = *(const LAS bf16x8*)(QS + (16 * mt + fr) * 520 + 32 * ks + 8 * fq);
          const bf16x8 b0 = *(const LAS bf16x8*)(KS + (16 * nt0 + fr) * 520 + 32 * ks + 8 * fq), b1 = *(const LAS bf16x8*)(KS + (16 * (nt0 + 1) + fr) * 520 + 32 * ks + 8 * fq);
          s0 = __builtin_amdgcn_mfma_f32_16x16x32_bf16(a, b0, s0, 0, 0, 0); s1 = __builtin_amdgcn_mfma_f32_16x16x32_bf16(a, b1, s1, 0, 0, 0); }
      float* S = (float*)(kp->ws + OFF_S) + ((size_t)(b * 4 + hd) * NCH + ci) * 4096;
#pragma unroll
      for (int r = 0; r < 4; ++r) { S[(16 * mt + 4 * fq + r) * 64 + 16 * nt0 + fr] = s0[r]; S[(16 * mt + 4 * fq + r) * 64 + 16 * (nt0 + 1) + fr] = s1[r]; } }
    f32x4 ga = {0.f, 0.f, 0.f, 0.f};
    for (int ks = kh * 8; ks < kh * 8 + 8; ++ks) { const int kk = hd * DH + 32 * ks + 8 * fq;
        const bf16x8 a = *(const LAS bf16x8*)(QS + (16 * mt + fr) * 520 + 32 * ks + 8 * fq), a2 = *(const LAS bf16x8*)(KS + (16 * mt + fr) * 520 + 32 * ks + 8 * fq);
        const bf16x8 bq = *(const bf16x8*)(wg + (size_t)fr * 6144 + kk), bk = *(const bf16x8*)(wg + (size_t)fr * 6144 + INNER + kk);
        ga = __builtin_amdgcn_mfma_f32_16x16x32_bf16(a, bq, ga, 0, 0, 0); ga = __builtin_amdgcn_mfma_f32_16x16x32_bf16(a2, bk, ga, 0, 0, 0); }
    __syncthreads();
    {
        float wvv[32]; ldw32(kp->in[I_MLWV] + ((size_t)j * 512 + (ch0 >> 2)) * 16, wvv);
        for (int r = 0; r < 8; ++r) { const int jj = wv + 8 * r, T = T0 + jj; float x0[8], v[8]; unpack8(*(const u32x4v*)(xm + (size_t)T * INNER + ch0), x0); bd8(x0, wvv, v);
            *(LAS u32x4v*)(QS + jj * 520 + lane * 8) = pack8(v); }
    }
    __syncthreads();
    for (int ks = kh * 8; ks < kh * 8 + 8; ++ks) { const int kk = hd * DH + 32 * ks + 8 * fq;
        const bf16x8 a = *(const LAS bf16x8*)(QS + (16 * mt + fr) * 520 + 32 * ks + 8 * fq); const bf16x8 bv = *(const bf16x8*)(wg + (size_t)fr * 6144 + 2 * INNER + kk);
        ga = __builtin_amdgcn_mfma_f32_16x16x32_bf16(a, bv, ga, 0, 0, 0); }
    float* gates = (float*)(kp->ws + OFF_GATES);
#pragma unroll
    for (int r = 0; r < 4; ++r) atomicAdd(gates + (size_t)(T0 + 16 * mt + 4 * fq + r) * 16 + fr, ga[r]);
}

__device__ __forceinline__ void tr_store8(LAS unsigned char* base, int d0, const unsigned (&w)[4], int lane) {
    const int odd = lane & 1, sp = lane & ~1;
#pragma unroll
    for (int i = 0; i < 4; ++i) { const unsigned pw = (unsigned)__builtin_amdgcn_update_dpp(0, (int)w[i], 0xB1, 0xF, 0xF, false);
        const unsigned ow = odd ? ((pw >> 16) | (w[i] & 0xffff0000u)) : ((w[i] & 0xffffu) | (pw << 16)); const int d = d0 + 2 * i + odd;
        *(LAS unsigned*)(base + d * 128 + ((((sp >> 3) ^ (d & 7)) << 4) | ((sp & 7) << 1))) = ow; }
}
#ifndef REP_STAGE
#define REP_STAGE 1
#define REP_STILDE 1
#define REP_MFMA 1
#endif
constexpr int SC_QS = 0, SC_KT = 66560, SC_VT = 132096, SC_ST = 148480, SC_VEC = 156672;
__device__ __forceinline__ void ml_scan_task(KPC kp, int j, int task, LAS unsigned char* lds) {
    const int tid = ltid(), lane = tid & 63, wv = tid >> 6, fr = lane & 15, fq = lane >> 4;
    const int es = task & 3, dir = (task >> 2) & 1, hd = (task >> 3) & 3, b = task >> 5;
    const u16* xm = (const u16*)(kp->ws + OFF_XM); const u16* xc = (const u16*)(kp->ws + OFF_XC); const float* gates = (const float*)(kp->ws + OFF_GATES);
    const float* Sg = (const float*)(kp->ws + OFF_S) + (size_t)(b * 4 + hd) * NCH * 4096;
    u16* hf = (u16*)(kp->ws + OFF_R2);
    LAS unsigned char* QS = lds + SC_QS; LAS unsigned char* KT = lds + SC_KT; LAS unsigned char* VT = lds + SC_VT; LAS unsigned char* ST = lds + SC_ST;
    LAS float* rowterm = (LAS float*)(lds + SC_VEC); LAS float* colterm = rowterm + 64; LAS float* winter = rowterm + 128; LAS float* einv = rowterm + 192;
    LAS float* kws = rowterm + 256; LAS float* dinv = rowterm + 320; LAS float* nst = rowterm + 384; LAS float* scal = rowterm + 896;
    f32x4 C[32];
#pragma unroll
    for (int i = 0; i < 32; ++i) C[i] = (f32x4){0.f, 0.f, 0.f, 0.f};
    float m_st = 0.f;
    __syncthreads();
    nst[tid] = 0.f;
    float pg_ic = 0.f, pg_fp = 0.f;
    if (wv == 0) { const int tn = dir == 0 ? lane : CTX - 1 - lane; const int Tg = b * TPB + tn; pg_ic = gates[(size_t)Tg * 16 + dir * 8 + hd]; pg_fp = gates[(size_t)Tg * 16 + dir * 8 + 4 + hd]; }
    for (int ci = 0; ci < NCH; ++ci) {
        __syncthreads();
        const int p0 = ci * 64;
        const int tid = ltid(), lane = tid & 63, wv = tid >> 6, fr = lane & 15, fq = lane >> 4;
        asm volatile("" ::: "memory");
        auto tok = [&](int jj) -> int { const int p = p0 + jj; const int t = dir == 0 ? p : (p < CTX ? CTX - 1 - p : TPB + CTX - 1 - p); return b * TPB + t; };
        float sv[8];
        { const int jj = tid >> 3, s8 = (tid & 7) * 8;
            if (dir == 0) { const float* sp = Sg + (size_t)ci * 4096 + jj * 64 + s8; const f32x4 v0 = *(const f32x4*)sp, v1 = *(const f32x4*)(sp + 4);
                sv[0] = v0[0]; sv[1] = v0[1]; sv[2] = v0[2]; sv[3] = v0[3]; sv[4] = v1[0]; sv[5] = v1[1]; sv[6] = v1[2]; sv[7] = v1[3]; }
            else { const int oc = ci < 4 ? 3 - ci : 135 - ci; const float* sp = Sg + (size_t)oc * 4096 + (63 - jj) * 64 + (56 - s8); const f32x4 v0 = *(const f32x4*)sp, v1 = *(const f32x4*)(sp + 4);
                sv[7] = v0[0]; sv[6] = v0[1]; sv[5] = v0[2]; sv[4] = v0[3]; sv[3] = v1[0]; sv[2] = v1[1]; sv[1] = v1[2]; sv[0] = v1[3]; }
        }
        const float g_ic = pg_ic, g_fp = pg_fp;
        if (wv == 0 && ci + 1 < NCH) { const int pn = p0 + 64 + lane; const int tn = dir == 0 ? pn : (pn < CTX ? CTX - 1 - pn : TPB + CTX - 1 - pn); const int Tg = b * TPB + tn;
            pg_ic = gates[(size_t)Tg * 16 + dir * 8 + hd]; pg_fp = gates[(size_t)Tg * 16 + dir * 8 + 4 + hd]; }
        for (int rpS = 0; rpS < REP_STAGE; ++rpS) {
        const int wvu = __builtin_amdgcn_readfirstlane(wv); const int Tl = tok(lane);
        for (int r = 0; r < 8; ++r) { const int g8 = wvu * 8 + r; float x[8], q[8], Mw[32];
            const u32x4v xw = *(const u32x4v*)(xc + (size_t)Tl * INNER + hd * DH + g8 * 8); unpack8(xw, x);
            sload32((const float*)(kp->ws + OFF_MLM) + (size_t)j * 8192 + (size_t)(hd * 128 + g8 * 2) * 16, Mw); bd8(x, Mw, q);
            *(LAS u32x4v*)(QS + lane * 1040 + g8 * 16) = pack8(q);
            const unsigned wd[4] = {xw.x, xw.y, xw.z, xw.w}; tr_store8(KT, g8 * 8, wd, lane); }
        for (int r = 0; r < 2; ++r) { const int g = wvu * 2 + r; const int chv = hd * DH + es * 128 + g * 8; float x[8], v[8], wvv[32];
            unpack8(*(const u32x4v*)(xm + (size_t)Tl * INNER + chv), x); sload32(kp->in[I_MLWV] + ((size_t)j * 512 + (chv >> 2)) * 16, wvv); bd8(x, wvv, v);
            { const u32x4v vw = pack8(v); const unsigned wd[4] = {vw.x, vw.y, vw.z, vw.w}; tr_store8(VT, g * 8, wd, lane); } }
        }
        if (wv == 0) {
            const float ic = g_ic, fp = g_fp;
            const float lf = fminf(fp, 0.f) - log1pf(__expf(-fabsf(fp)));
            float bb = lf;
#pragma unroll
            for (int o = 1; o < 64; o <<= 1) { const float t = lshfl(bb, lane - o); if (lane >= o) bb += t; }
            const float uu = ic - bb; float pm = uu;
#pragma unroll
            for (int o = 1; o < 64; o <<= 1) { const float t = lshfl(pm, lane - o); if (lane >= o) pm = fmaxf(pm, t); }
            const float a = bb + m_st, mj = fmaxf(a, bb + pm);
            rowterm[lane] = bb - mj; colterm[lane] = uu; winter[lane] = __expf(a - mj); einv[lane] = __expf(-mj);
            const float blast = lshfl(bb, 63), gs = blast - bb + ic, gmax = wave_max(gs), mnew = fmaxf(blast + m_st, gmax);
            kws[lane] = __expf(gs - mnew);
            if (lane == 0) { scal[0] = __expf(blast + m_st - mnew); scal[1] = mnew; }
        }
        __syncthreads();
        for (int rpT = 0; rpT < REP_STILDE; ++rpT) {
            const int jj = tid >> 3, sub = tid & 7, s8 = sub * 8;
            const float rt = rowterm[jj]; float rsum = 0.f;
            const f32x4 ct0 = *(const LAS f32x4*)(colterm + s8), ct1 = *(const LAS f32x4*)(colterm + s8 + 4); const float ctv[8] = {ct0[0], ct0[1], ct0[2], ct0[3], ct1[0], ct1[1], ct1[2], ct1[3]};
#pragma unroll
            for (int e = 0; e < 8; ++e) { const int s = s8 + e; const float w = s <= jj ? sv[e] * 0.04419417382415922f * __expf(rt + ctv[e]) : 0.f; sv[e] = w; rsum += w; }
            *(LAS u32x4v*)(ST + jj * 128 + ((sub ^ (jj & 7)) << 4)) = pack8(sv);
            float qd = 0.f;
#pragma unroll
            for (int c8 = 0; c8 < 8; ++c8) { float qv[8]; unpack8(*(const LAS u32x4v*)(QS + jj * 1040 + (sub * 8 + c8) * 16), qv);
                { const f32x4 n0 = *(const LAS f32x4*)(nst + sub * 64 + c8 * 8), n1 = *(const LAS f32x4*)(nst + sub * 64 + c8 * 8 + 4);
                  qd += qv[0] * n0[0] + qv[1] * n0[1] + qv[2] * n0[2] + qv[3] * n0[3] + qv[4] * n1[0] + qv[5] * n1[1] + qv[6] * n1[2] + qv[7] * n1[3]; } }
            rsum += lshfl(rsum, lane ^ 1); rsum += lshfl(rsum, lane ^ 2); rsum += lshfl(rsum, lane ^ 4);
            qd += lshfl(qd, lane ^ 1); qd += lshfl(qd, lane ^ 2); qd += lshfl(qd, lane ^ 4);
            if (sub == 0) { const float qn = winter[jj] * qd + rsum; dinv[jj] = 1.0f / fmaxf(fabsf(qn), einv[jj]); }
        }
        __syncthreads();
        {
            f32x4 o[4];
            const int el = 16 * wv + fr;
            bf16x8 vfr[2];
            for (int rpM = 0; rpM < REP_MFMA; ++rpM) {
#pragma unroll
            for (int mt = 0; mt < 4; ++mt) o[mt] = (f32x4){0.f, 0.f, 0.f, 0.f};
#pragma unroll
            for (int ks = 0; ks < 16; ++ks) {
                u32x4v bw; bw.x = pg8::cvt_pk_bf16(C[2 * ks][0], C[2 * ks][1]); bw.y = pg8::cvt_pk_bf16(C[2 * ks][2], C[2 * ks][3]);
                bw.z = pg8::cvt_pk_bf16(C[2 * ks + 1][0], C[2 * ks + 1][1]); bw.w = pg8::cvt_pk_bf16(C[2 * ks + 1][2], C[2 * ks + 1][3]);
                const bf16x8 bfr = __builtin_bit_cast(bf16x8, bw);
#pragma unroll
                for (int mt = 0; mt < 4; ++mt) { const int off = (16 * mt + fr) * 1040 + 8 * fq;
                    const u32x2 lo = *(const LAS u32x2*)(QS + off + 64 * ks), hi = *(const LAS u32x2*)(QS + off + 64 * ks + 32);
                    u32x4v aw; aw.x = lo.x; aw.y = lo.y; aw.z = hi.x; aw.w = hi.y;
                    o[mt] = __builtin_amdgcn_mfma_f32_16x16x32_bf16(bfr, __builtin_bit_cast(bf16x8, aw), o[mt], 0, 0, 0); }
                if ((ks & 1) == 1) __builtin_amdgcn_sched_barrier(0); }
#pragma unroll
            for (int mt = 0; mt < 4; ++mt)
#pragma unroll
                for (int r = 0; r < 4; ++r) o[mt][r] *= winter[16 * mt + fr];
#pragma unroll
            for (int k2 = 0; k2 < 2; ++k2) { vfr[k2] = *(const LAS bf16x8*)(VT + el * 128 + (((4 * k2 + fq) ^ (el & 7)) << 4));
#pragma unroll
                for (int mt = 0; mt < 4; ++mt) { const int jr = 16 * mt + fr; const bf16x8 a = *(const LAS bf16x8*)(ST + jr * 128 + (((4 * k2 + fq) ^ (jr & 7)) << 4));
                    o[mt] = __builtin_amdgcn_mfma_f32_16x16x32_bf16(vfr[k2], a, o[mt], 0, 0, 0); } }
            }
#pragma unroll
            for (int mt = 0; mt < 4; ++mt)
                { const int jr = 16 * mt + fr, T = tok(jr); const float di = dinv[jr];
                    u16* dst = dir == 0 ? hf + (size_t)T * INNER : hb_ptr(kp, T); u32x2 w; w.x = pg8::cvt_pk_bf16(o[mt][0] * di, o[mt][1] * di); w.y = pg8::cvt_pk_bf16(o[mt][2] * di, o[mt][3] * di);
                    *(u32x2*)(dst + hd * DH + es * 128 + 16 * wv + 4 * fq) = w; }
            const float decay = scal[0];
#pragma unroll
            for (int i = 0; i < 32; ++i) C[i] = C[i] * decay;
            float kwv[2][8];
#pragma unroll
            for (int k2 = 0; k2 < 2; ++k2) { const f32x4 k0 = *(const LAS f32x4*)(kws + 32 * k2 + 8 * fq), k1 = *(const LAS f32x4*)(kws + 32 * k2 + 8 * fq + 4);
                kwv[k2][0] = k0[0]; kwv[k2][1] = k0[1]; kwv[k2][2] = k0[2]; kwv[k2][3] = k0[3]; kwv[k2][4] = k1[0]; kwv[k2][5] = k1[1]; kwv[k2][6] = k1[2]; kwv[k2][7] = k1[3]; }
#pragma unroll
            for (int k2 = 0; k2 < 2; ++k2) { float vv[8]; unpack8(__builtin_bit_cast(u32x4v, vfr[k2]), vv);
#pragma unroll
                for (int e = 0; e < 8; ++e) vv[e] *= kwv[k2][e];
                const bf16x8 bsc = __builtin_bit_cast(bf16x8, pack8(vv));
#pragma unroll
                for (int dt = 0; dt < 32; ++dt) { const int dr = 16 * dt + fr; const bf16x8 a = *(const LAS bf16x8*)(KT + dr * 128 + (((4 * k2 + fq) ^ (dr & 7)) << 4));
                    C[dt] = __builtin_amdgcn_mfma_f32_16x16x32_bf16(a, bsc, C[dt], 0, 0, 0);
                    if ((dt & 7) == 7) __builtin_amdgcn_sched_barrier(0); } }
            { float nn = decay * nst[tid];
#pragma unroll
              for (int g = 0; g < 8; ++g) { float kv[8]; unpack8(*(const LAS u32x4v*)(KT + tid * 128 + ((g ^ (tid & 7)) << 4)), kv);
                  { const f32x4 k0 = *(const LAS f32x4*)(kws + 8 * g), k1 = *(const LAS f32x4*)(kws + 8 * g + 4); nn += kv[0] * k0[0] + kv[1] * k0[1] + kv[2] * k0[2] + kv[3] * k0[3] + kv[4] * k1[0] + kv[5] * k1[1] + kv[6] * k1[2] + kv[7] * k1[3]; } }
              nst[tid] = nn; }
            m_st = scal[1];
        }
    }
}

__device__ __forceinline__ void ml_gate_phase(KPC kp, int j) {
    u16* hf = (u16*)(kp->ws + OFF_R2); const u16* xc = (const u16*)(kp->ws + OFF_XC); const u16* z = (const u16*)(kp->ws + OFF_XM);
    const float* ng = kp->in[I_MLNG] + (size_t)j * INNER; const float* sk = kp->in[I_MLSKIP] + (size_t)j * INNER;
    const int lane = ltid() & 63, wv = ltid() >> 6;
    for (int T = lbid() * 8 + wv; T < NTOK; T += gridDim.x * 8) {
        const u16* hbp = hb_ptr(kp, T);
#pragma unroll
        for (int hd = 0; hd < 4; ++hd) { const int c0 = hd * DH + lane * 8; float a[8], bq[8], xv[8], zv[8], o[8];
            unpack8(*(const u32x4v*)(hf + (size_t)T * INNER + c0), a); unpack8(*(const u32x4v*)(hbp + c0), bq);
            float s = 0.f;
#pragma unroll
            for (int e = 0; e < 8; ++e) { a[e] += bq[e]; s += a[e]; }
            const float mu = wave_sum(s) * (1.0f / DH); float vs = 0.f;
#pragma unroll
            for (int e = 0; e < 8; ++e) { a[e] -= mu; vs += a[e] * a[e]; }
            const float rs = rsqrtf(wave_sum(vs) * (1.0f / DH) + 1e-5f);
            unpack8(*(const u32x4v*)(xc + (size_t)T * INNER + c0), xv); unpack8(*(const u32x4v*)(z + (size_t)T * INNER + c0), zv);
            const f32x4 n0 = *(const f32x4*)(ng + c0), n1 = *(const f32x4*)(ng + c0 + 4), s0 = *(const f32x4*)(sk + c0), s1 = *(const f32x4*)(sk + c0 + 4);
            const float ngv[8] = {n0[0], n0[1], n0[2], n0[3], n1[0], n1[1], n1[2], n1[3]}, skv[8] = {s0[0], s0[1], s0[2], s0[3], s1[0], s1[1], s1[2], s1[3]};
#pragma unroll
            for (int e = 0; e < 8; ++e) o[e] = (a[e] * rs * ngv[e] + skv[e] * xv[e]) * siluf(zv[e]);
            *(u32x4v*)(hf + (size_t)T * INNER + c0) = pack8(o); }
    }
}


enum { K_SETUP = 0, K_CN, K_G1, K_G2R, K_HYIN, K_HYCONV, K_HYTR, K_MLUPX, K_MLPREP, K_MLSCAN, K_MLUPZ, K_MLGATE, K_FINAL };
constexpr int NPHASE = 1 + 11 + 13 + 11 + 13 + 1;
__device__ __forceinline__ void decode_phase(int ph, int& kind, int& l, int& arg) {
    kind = K_SETUP; l = 0; arg = 0; if (ph == 0) return;
    ph -= 1;
    for (l = 0; l < 4; ++l) { const int n = (l & 1) ? 13 : 11; if (ph < n) break; ph -= n; }
    if (l == 4) { kind = K_FINAL; l = 0; return; }
    if (ph == 0) { kind = K_CN; arg = 0; return; } if (ph == 1) { kind = K_G1; arg = 0; return; } if (ph == 2) { kind = K_G2R; arg = 0; return; } if (ph == 3) { kind = K_CN; arg = 1; return; }
    const int nm = (l & 1) ? 6 : 4;
    if (ph < 4 + nm) { const int q = ph - 4;
        if (l & 1) { kind = q == 0 ? K_MLUPX : q == 1 ? K_MLPREP : q == 2 ? K_MLSCAN : q == 3 ? K_MLUPZ : q == 4 ? K_MLGATE : K_G2R; arg = 2; }
        else { kind = q == 0 ? K_HYIN : q == 1 ? K_HYCONV : q == 2 ? K_HYTR : K_G2R; arg = 2; }
        return; }
    ph -= 4 + nm;
    if (ph == 0) { kind = K_CN; arg = 2; return; } if (ph == 1) { kind = K_G1; arg = 1; return; } kind = K_G2R; arg = 1;
}

__device__ __forceinline__ void gbar(unsigned* ctr, unsigned target) {
    __syncthreads();
    if (ltid() == 0) {
        __builtin_amdgcn_fence(__ATOMIC_RELEASE, "agent");
        __hip_atomic_fetch_add(ctr, 1u, __ATOMIC_RELAXED, __HIP_MEMORY_SCOPE_AGENT);
        while (__hip_atomic_load(ctr, __ATOMIC_RELAXED, __HIP_MEMORY_SCOPE_AGENT) < target) __builtin_amdgcn_s_sleep(2);
        __builtin_amdgcn_fence(__ATOMIC_ACQUIRE, "agent");
    }
    __syncthreads();
}
#ifndef REPMASK
#define REPMASK 0
#define REPN 1
#endif
template <int MIX> __device__ __forceinline__ void run_phases(int lo, int hi, int ph_lo, int ph_hi, LAS unsigned char* lds0, cg::grid_group& grid) {
    lo = lo > ph_lo ? lo : ph_lo; hi = hi < ph_hi ? hi : ph_hi;
    for (int ph = lo; ph < hi; ++ph) {
        KPC kp = (KPC)__builtin_amdgcn_kernarg_segment_ptr(); asm volatile("" : "+s"(kp) :: "memory");
        LAS unsigned char* lds = lds0; asm volatile("" : "+s"(lds) :: "memory");
        unsigned char* ws = kp->ws; unsigned char* wb = ws + OFF_WB;
        int kind, l, arg; decode_phase(ph, kind, l, arg); const int j = l >> 1;
        const float* modl = (const float*)(ws + OFF_MOD) + (size_t)l * 5 * 9216;
        const int nrep = ((REPMASK >> kind) & 1) ? REPN : 1;
        for (int rep = 0; rep < nrep; ++rep) {
        if (kind == K_SETUP) { if constexpr (MIX == 0) setup_phase(kp, (LAS float*)lds); }
        else if (kind == K_CN) {
            if (arg == 0) { convert_layer(kp, l, (LAS float*)lds); if constexpr (MIX == 1) ml_m_phase(kp, j); }
            if constexpr (MIX == 0) { if (arg == 1) hy_mlp_phase(kp, j); }
            norm_phase(kp, l, arg, arg == 0 ? (l == 0 ? 0 : 11) : arg == 1 ? 11 : (l == 3 ? 0 : (l & 1) ? 8 : 4));
        } else if (kind == K_G1) {
            pg8::Gemm g{(const u16*)(ws + OFF_U), (const u16*)(wb + (arg ? WB_FIN1 : WB_FIN0)), NTOK, 2 * FF, D};
            pg8::StaticOrder S; S.init(g.M, g.N, (int)gridDim.x, lbid(), (l == 3 && arg == 1) ? 1 : 0); EpiSwiglu E{(u16*)(ws + OFF_R1)};
            pg8::gemm_phase<EpiSwiglu, pg8::StaticOrder, false>(lds, g, S, E, nullptr);
        } else if (kind == K_G2R) {
            const u16* gA; const u16* gB; int gK, gidx, gbj = -1;
            if (arg < 2) { gA = (const u16*)(ws + OFF_R1); gB = (const u16*)(wb + (arg ? WB_FOUT1 : WB_FOUT0)); gK = FF; gidx = arg ? 8 : 2; }
            else if (MIX == 1) { gA = (const u16*)(ws + OFF_R2); gB = (const u16*)(wb + WB_MOUT); gK = INNER; gidx = 5; }
            else { gA = (const u16*)(ws + OFF_U); gB = (const u16*)(wb + WB_MOUT); gK = D; gidx = 5; gbj = j; }
            const pg8::Gemm g{gA, gB, NTOK, D, gK, 0}; const EpiResid E{kp, l, gidx, gbj};
            pg8::StaticOrder S; S.init(g.M, g.N, (int)gridDim.x, lbid(), (l == 3 && arg >= 1) ? 1 : 2, g.K / 256);
            pg8::gemm_phase<EpiResid, pg8::StaticOrder, false>(lds, g, S, E, nullptr);
        } else if (kind == K_FINAL) { if constexpr (MIX == 1) final_phase(kp); }
        else if constexpr (MIX == 0) {
            if (kind == K_HYIN) {
                pg8::Gemm g{(const u16*)(wb + WB_MIN), (const u16*)(ws + OFF_U), 3 * D, NTOK, D};
                pg8::StaticOrder S; S.init(g.M, g.N, (int)gridDim.x, lbid());
                EpiProjT E{(u16*)(ws + OFF_R1 + HY_PL), (u16*)(ws + OFF_R1 + HY_PC), kp->in[I_HYBIN] + (size_t)j * 3 * D};
                pg8::gemm_phase<EpiProjT, pg8::StaticOrder, false>(lds, g, S, E, nullptr);
                __syncthreads();
                for (int t = lbid(); t < 2048; t += gridDim.x) hy_filter_task(kp, j, t, (LAS f32x2*)lds, (LAS float*)(lds + 131072));
            } else if (kind == K_HYCONV) {
                for (int t = lbid(); t < 2048; t += gridDim.x) hy_conv_lat(kp, j, t, (LAS f32x2*)lds);
                for (int t = lbid(); t < 1024; t += gridDim.x) hy_conv_ctx(kp, j, t, (LAS float*)lds);
            } else if (kind == K_HYTR) hy_transpose(kp, (LAS u16*)lds);
        } else {
            if (kind == K_MLUPX || kind == K_MLUPZ) {
                const bool zz = kind == K_MLUPZ;
                pg8::Gemm g{(const u16*)(ws + OFF_U), (const u16*)(wb + WB_MIN) + (zz ? (size_t)INNER * D : 0), NTOK, INNER, D};
                pg8::StaticOrder S; S.init(g.M, g.N, (int)gridDim.x, lbid(), (zz && l == 3) ? 1 : 0); EpiBf E{(u16*)(ws + OFF_XM), INNER};
                pg8::gemm_phase<EpiBf, pg8::StaticOrder, false>(lds, g, S, E, nullptr);
            } else if (kind == K_MLPREP) { for (int t = lbid(); t < NB * NCH * 4; t += gridDim.x) ml_prep_task(kp, j, t, lds); }
            else if (kind == K_MLSCAN) { for (int t = lbid(); t < 128; t += gridDim.x) ml_scan_task(kp, j, t, lds); }
            else if (kind == K_MLGATE) ml_gate_phase(kp, j);
        }
        }
        if (ph + 1 < ph_hi) gbar((unsigned*)(kp->ws + OFF_MLM + 65536), (unsigned)(ph + 1 - ph_lo) * gridDim.x);
    }
}

__global__ void __launch_bounds__(512) fwd_megakernel(KP kparg) {
    extern __shared__ __attribute__((aligned(16))) unsigned char shm[];
    LAS unsigned char* lds = (LAS unsigned char*)shm;
    cg::grid_group grid = cg::this_grid();
    grid.sync();
    wtab_init();
    const int ph_lo = kparg.ph_lo, ph_hi = kparg.ph_hi;
    run_phases<0>(0, 12, ph_lo, ph_hi, lds, grid);
    run_phases<1>(12, 25, ph_lo, ph_hi, lds, grid);
    run_phases<0>(25, 36, ph_lo, ph_hi, lds, grid);
    run_phases<1>(36, 50, ph_lo, ph_hi, lds, grid);
}

extern "C" void kernel_launch(void* const* d_in, const int* in_sizes, int n_in, void* d_out, int out_size, void* d_ws, size_t ws_size, hipStream_t stream) {
    static int grid_blocks = 0;
    if (!grid_blocks) {
        int dev = 0, cus = 0, per_cu = 0;
        hipGetDevice(&dev);
        hipDeviceGetAttribute(&cus, hipDeviceAttributeMultiprocessorCount, dev);
        hipFuncSetAttribute((const void*)fwd_megakernel, hipFuncAttributeMaxDynamicSharedMemorySize, LDS_BYTES);
        hipOccupancyMaxActiveBlocksPerMultiprocessor(&per_cu, fwd_megakernel, 512, LDS_BYTES);
        if (per_cu < 1) per_cu = 1;
        grid_blocks = cus * 1;
        if (ws_size < WS_NEED2) fprintf(stderr, "workspace too small: %zu < %zu\n", ws_size, (size_t)WS_NEED2);
    }
    KP hp{};
    for (int i = 0; i < 36; ++i) hp.in[i] = (const float*)d_in[i];
    hp.out = (float*)d_out; hp.ws = (unsigned char*)d_ws; hp.ph_lo = 0; hp.ph_hi = NPHASE;
    void* args[] = {&hp};
    hipMemsetAsync((unsigned char*)d_ws + OFF_MLM + 65536, 0, 256, stream);
    hipError_t e = hipLaunchCooperativeKernel((void*)fwd_megakernel, dim3(grid_blocks), dim3(512), args, LDS_BYTES, stream);
    if (e != hipSuccess) fprintf(stderr, "cooperative launch failed: %s (grid %d)\n", hipGetErrorString(e), grid_blocks);
}
```

```cpp
#define REPMASK 0
#define REPN 1
#include <hip/hip_runtime.h>
#include <hip/hip_cooperative_groups.h>
#include <cstdio>
namespace cg = cooperative_groups;
#define WTAB_OFF 163584
__device__ __forceinline__ int llane() { int l; asm volatile("v_mbcnt_lo_u32_b32 %0, -1, 0\n\tv_mbcnt_hi_u32_b32 %0, -1, %0" : "=v"(l) :: "memory"); return l; }
__device__ __forceinline__ int lwave() { extern __shared__ __attribute__((aligned(16))) unsigned char shm_w[];
    const int hw = __builtin_amdgcn_s_getreg(10244) & 63;
    return __builtin_amdgcn_readfirstlane(*(const __attribute__((address_space(3))) int*)((__attribute__((address_space(3))) unsigned char*)shm_w + WTAB_OFF + hw * 4)); }
__device__ __forceinline__ void wtab_init() { extern __shared__ __attribute__((aligned(16))) unsigned char shm_w[];
    const int hw = __builtin_amdgcn_s_getreg(10244) & 63;
    *(__attribute__((address_space(3))) int*)((__attribute__((address_space(3))) unsigned char*)shm_w + WTAB_OFF + hw * 4) = (int)(threadIdx.x >> 6); }
__device__ __forceinline__ int ltid() { return lwave() * 64 + llane(); }
__device__ __forceinline__ int lbid() { int t = blockIdx.x; asm volatile("" : "+s"(t) :: "memory"); return t; }
namespace pg8 {
#define PG8_LAS __attribute__((address_space(3)))
typedef unsigned short bf16_t;
typedef short bf16x8 __attribute__((ext_vector_type(8)));
typedef float f32x4 __attribute__((ext_vector_type(4)));
typedef unsigned u32x4 __attribute__((ext_vector_type(4)));
constexpr int BM = 256, BK = 64, HALF = 128, HTB = HALF * BK * 2  , STAGE_BYTES = 8 * HTB, NXCD = 8, WGM = 8;

__host__ __device__ __forceinline__ int lds_byte(int r, int c) { const int st = (r >> 4) * 2 + (c >> 5), rr = r & 15, cc = c & 31, ob = rr * 64 + cc * 2; return st * 1024 + (ob ^ (((ob >> 9) & 1) << 5)); }
__host__ __device__ __forceinline__ void stage_rc(int b, int& R, int& C) { const int st = b / 1024, sb = b % 1024, swz = sb ^ (((sb >> 9) & 1) << 5); R = (st >> 1) * 16 + swz / 64; C = (st & 1) * 32 + (swz % 64) / 2; }
__host__ __device__ __forceinline__ int perm32(int rho) { const int n = rho >> 4, i = rho & 15; return 8 * (i >> 2) + 4 * n + (i & 3); }

struct Unit { int pm, pn, kofs, nt; };
struct Gemm { const bf16_t* A; const bf16_t* Bt; int M, N, K, ldk; };

struct StaticOrder {
    int nM, nN, nwg, G, c, lat, nk;
    __host__ __device__ void init(int M, int N, int G_, int c_, int lat_ = 0, int nk_ = 0) { lat = lat_; nk = nk_; nM = lat ? 128 : M / BM; nN = N / BM; nwg = nM * nN; G = G_; c = c_; }
    __host__ __device__ bool next(int i, Unit& u) const {
        const long L = (long)i * G + c;
        if (L >= nwg) { if (lat != 2 || L >= nwg + 16 * nk) return false; const int Lc = (int)L - nwg, un = Lc & 15; u.pm = (un >> 2) * 33; u.pn = un & 3; u.kofs = (Lc >> 4) * 256; u.nt = 4; return true; }
        int wgid = (int)L; { const int q = nwg / NXCD, r = nwg % NXCD, xcd = wgid % NXCD, off = wgid / NXCD; wgid = (xcd < r ? xcd * (q + 1) : r * (q + 1) + (xcd - r) * q) + off; }
        const int nig = WGM * nN, gid = wgid / nig, fm = gid * WGM, gsz = (nM - fm) < WGM ? (nM - fm) : WGM;
        u.pm = fm + ((wgid % nig) % gsz); u.pn = (wgid % nig) / gsz; u.kofs = 0; u.nt = 0; if (lat) u.pm = (u.pm >> 5) * 33 + 1 + (u.pm & 31); return true;
    }
    __device__ __forceinline__ void a_ready(const Unit&) const {}
    __device__ __forceinline__ void done(const Unit&) const {}
};
__device__ __forceinline__ unsigned cvt_pk_bf16(float lo, float hi) { unsigned r; asm volatile("v_cvt_pk_bf16_f32 %0, %1, %2" : "=v"(r) : "v"(lo), "v"(hi)); return r; }
template <class Epi, class Sched, bool STAMP = false>
__device__ __forceinline__ void gemm_phase(PG8_LAS unsigned char* lds, const Gemm g, const Sched& S, const Epi& E, unsigned long long* stamps) {
    const int tid = ltid(), wid = __builtin_amdgcn_readfirstlane(tid >> 6), lane = tid & 63, wr = wid >> 2, wc = wid & 3, fr = lane & 15, fq = lane >> 4;
    const int K = g.K, nt = K / BK, ldk = g.ldk ? g.ldk : g.K;
    int ts_lo = 0, ts_hi = 0, nts = 0; const unsigned long long rt_entry = STAMP ? (unsigned long long)wall_clock64() : 0ull;
#define PG8_STAMP() do { if (STAMP && wid == 0 && nts < 64) { const unsigned long long _c = (unsigned long long)clock64(); \
        ts_lo = (lane == nts) ? (int)(unsigned)_c : ts_lo; ts_hi = (lane == nts) ? (int)(unsigned)(_c >> 32) : ts_hi; ++nts; } } while (0)
    PG8_STAMP();
    unsigned voffA[2], voffB[2];
#pragma unroll
    for (int i = 0; i < 2; ++i) { int R, C; stage_rc(tid * 16 + i * 8192, R, C); const int Rb = Epi::PERM ? ((R & ~31) + perm32(R & 31)) : R;
        voffA[i] = (unsigned)(R * ldk + C) * 2u; voffB[i] = (unsigned)(Rb * ldk + C) * 2u; }
    const size_t kstep = (size_t)(BK * 2);
    const size_t hstep = (size_t)HALF * ldk * 2;
    const size_t tstep = 2 * hstep;
    const unsigned ldsw = (unsigned)wid * 1024u;
    const int aoff = lds_byte(wr * 64 + fr, fq * 8), boff = lds_byte(wc * 32 + fr, fq * 8);
#define PG8_SA(b, h) (((b) * 2 + (h)) * HTB)
#define PG8_SB(b, h) ((4 + (b) * 2 + (h)) * HTB)
#define PG8_STAGE(bufoff, gbase, voff) do { _Pragma("unroll") for (int _i = 0; _i < 2; ++_i) \
        __builtin_amdgcn_global_load_lds((const unsigned*)((const char*)(gbase) + (voff)[_i]), (PG8_LAS unsigned*)(lds + (bufoff) + ldsw + _i * 8192), 16, 0, 0); } while (0)
#define PG8_LDA(dst, b, h) do { _Pragma("unroll") for (int m = 0; m < 4; ++m) _Pragma("unroll") for (int k = 0; k < 2; ++k) dst[m][k] = *(const PG8_LAS bf16x8*)(lds + PG8_SA(b, h) + aoff + m * 2048 + k * 1024); } while (0)
#define PG8_LDB(dst, b, h) do { _Pragma("unroll") for (int n = 0; n < 2; ++n) _Pragma("unroll") for (int k = 0; k < 2; ++k) dst[n][k] = *(const PG8_LAS bf16x8*)(lds + PG8_SB(b, h) + boff + n * 2048 + k * 1024); } while (0)
#define PG8_MMA(ai, bj, At, Bt) do { __builtin_amdgcn_s_setprio(1); _Pragma("unroll") for (int m = 0; m < 4; ++m) _Pragma("unroll") for (int n = 0; n < 2; ++n) _Pragma("unroll") for (int k = 0; k < 2; ++k) \
        acc[ai][bj][m][n] = __builtin_amdgcn_mfma_f32_16x16x32_bf16(Bt[n][k], At[m][k], acc[ai][bj][m][n], 0, 0, 0); __builtin_amdgcn_s_setprio(0); } while (0)
#define PG8_WAIT_V(n) asm volatile("s_waitcnt vmcnt(" #n ")" ::: "memory")
#define PG8_WAIT_L(n) asm volatile("s_waitcnt lgkmcnt(" #n ")" ::: "memory")
#define PG8_BAR __builtin_amdgcn_s_barrier()
#define PG8_SCHED __builtin_amdgcn_sched_barrier(0)
    Unit cur, nxt; int ui = 0;
    if (!S.next(0, cur)) return;
    f32x4 acc[2][2][4][2];
#pragma unroll
    for (int a = 0; a < 2; ++a)
#pragma unroll
        for (int b = 0; b < 2; ++b)
#pragma unroll
            for (int m = 0; m < 4; ++m)
#pragma unroll
                for (int n = 0; n < 2; ++n) acc[a][b][m][n] = (f32x4){0.f, 0.f, 0.f, 0.f};
    bf16x8 At[4][2], B0[2][2], B1[2][2];
    const char* cA = (const char*)g.A + (size_t)cur.pm * tstep + (size_t)cur.kofs * 2; const char* cB = (const char*)g.Bt + (size_t)cur.pn * tstep + (size_t)cur.kofs * 2;
    S.a_ready(cur);
    PG8_STAGE(PG8_SB(0, 0), cB, voffB); PG8_STAGE(PG8_SA(0, 0), cA, voffA); PG8_STAGE(PG8_SB(0, 1), cB + hstep, voffB); PG8_STAGE(PG8_SA(0, 1), cA + hstep, voffA);
    if (wr == 1) PG8_BAR;
    PG8_WAIT_V(4); PG8_BAR;
    PG8_STAGE(PG8_SB(1, 0), cB + kstep, voffB); PG8_STAGE(PG8_SA(1, 0), cA + kstep, voffA); PG8_STAGE(PG8_SB(1, 1), cB + hstep + kstep, voffB);
    PG8_WAIT_V(6); PG8_BAR;
    PG8_STAMP();
    for (;;) {
        const bool has_next = S.next(ui + 1, nxt);
        const char* nA = has_next ? (const char*)g.A + (size_t)nxt.pm * tstep + (size_t)nxt.kofs * 2 : cA; const char* nB = has_next ? (const char*)g.Bt + (size_t)nxt.pn * tstep + (size_t)nxt.kofs * 2 : cB;
        const int ntu = cur.nt ? cur.nt : nt;
        for (int t = 0; t < ntu; t += 2) {
            const bool last = (t == ntu - 2);
            const char* a1 = cA + (size_t)(t + 1) * kstep;
            const char* a2 = last ? nA : cA + (size_t)(t + 2) * kstep; const char* b2 = last ? nB : cB + (size_t)(t + 2) * kstep;
            const char* a3 = a2 + kstep; const char* b3 = b2 + kstep;
            if (last && has_next) S.a_ready(nxt);
            PG8_LDB(B0, 0, 0); PG8_SCHED; PG8_LDA(At, 0, 0); PG8_STAGE(PG8_SA(1, 1), a1 + hstep, voffA);
            PG8_WAIT_L(8); PG8_BAR; PG8_WAIT_L(0); PG8_MMA(0, 0, At, B0); PG8_BAR; PG8_SCHED;
            PG8_LDB(B1, 0, 1); PG8_STAGE(PG8_SB(0, 0), b2, voffB);
            PG8_BAR; PG8_WAIT_L(0); PG8_MMA(0, 1, At, B1); PG8_BAR;
            PG8_LDA(At, 0, 1); PG8_STAGE(PG8_SA(0, 0), a2, voffA);
            PG8_BAR; PG8_WAIT_L(0); PG8_MMA(1, 0, At, B0); PG8_BAR; PG8_SCHED;
            PG8_STAGE(PG8_SB(0, 1), b2 + hstep, voffB);
            PG8_WAIT_V(6); PG8_BAR; PG8_MMA(1, 1, At, B1); PG8_BAR;
            PG8_LDB(B0, 1, 0); PG8_SCHED; PG8_LDA(At, 1, 0); PG8_STAGE(PG8_SA(0, 1), a2 + hstep, voffA);
            PG8_WAIT_L(8); PG8_BAR; PG8_WAIT_L(0); PG8_MMA(0, 0, At, B0); PG8_BAR; PG8_SCHED;
            PG8_LDB(B1, 1, 1); PG8_STAGE(PG8_SB(1, 0), b3, voffB);
            PG8_BAR; PG8_WAIT_L(0); PG8_MMA(0, 1, At, B1); PG8_BAR;
            PG8_LDA(At, 1, 1); PG8_STAGE(PG8_SA(1, 0), a3, voffA);
            PG8_BAR; PG8_WAIT_L(0); PG8_MMA(1, 0, At, B0); PG8_BAR; PG8_SCHED;
            PG8_STAGE(PG8_SB(1, 1), b3 + hstep, voffB);
            PG8_WAIT_V(6); PG8_BAR; PG8_MMA(1, 1, At, B1); PG8_BAR;
        }
        PG8_STAMP();
        if constexpr (!Epi::AFTER_DRAIN) { E(acc, cur, wr, wc, fr, fq); S.done(cur); }
        PG8_STAMP();
        if (!has_next) break;
#pragma unroll
        for (int a = 0; a < 2; ++a)
#pragma unroll
            for (int b = 0; b < 2; ++b)
#pragma unroll
                for (int m = 0; m < 4; ++m)
#pragma unroll
                    for (int n = 0; n < 2; ++n) acc[a][b][m][n] = (f32x4){0.f, 0.f, 0.f, 0.f};
        cur = nxt; cA = nA; cB = nB; ++ui;
    }
    PG8_WAIT_V(0);
    if (wr == 0) PG8_BAR;
    PG8_BAR;
    if constexpr (Epi::AFTER_DRAIN) { E.fused(acc, cur, wr, wc, fr, fq, lds, wid, lane); S.done(cur); }
    PG8_STAMP();
    if (STAMP && wid == 0) { stamps[lane] = lane < nts ? (((unsigned long long)(unsigned)ts_hi << 32) | (unsigned)ts_lo) : 0ull;
        if (lane == 62) stamps[62] = rt_entry; if (lane == 63) stamps[63] = (unsigned long long)wall_clock64(); }
#undef PG8_STAMP
#undef PG8_SA
#undef PG8_SB
#undef PG8_STAGE
#undef PG8_LDA
#undef PG8_LDB
#undef PG8_MMA
#undef PG8_WAIT_V
#undef PG8_WAIT_L
#undef PG8_BAR
#undef PG8_SCHED
}
}

typedef unsigned short u16;
using pg8::f32x4; using pg8::bf16x8;
typedef float f32x2 __attribute__((ext_vector_type(2)));
typedef unsigned u32x2 __attribute__((ext_vector_type(2)));
typedef unsigned u32x4v __attribute__((ext_vector_type(4)));
typedef short s16x4 __attribute__((ext_vector_type(4)));
#define LAS __attribute__((address_space(3)))
constexpr int D = 1024, NB = 4, SEQ = 8192, CTX = 256, TPB = 8448, NTOK = 33792, FF = 2816, NCH = 132, INNER = 2048, DH = 512, NFFT = 16384;
constexpr size_t MiB = 1u << 20;
constexpr size_t OFF_WB = 0, OFF_MOD = 48 * MiB, OFF_H = 49 * MiB, OFF_U = OFF_H + 132 * MiB, OFF_R1 = OFF_U + 66 * MiB, OFF_R2 = OFF_R1 + 264 * MiB,
                 OFF_HBC = OFF_R2 + 132 * MiB, OFF_GATES = OFF_HBC + 4 * MiB, OFF_H2 = OFF_GATES + 3 * MiB, OFF_KCTX = OFF_H2 + 3 * MiB, WS_NEED = OFF_KCTX + 4 * MiB;
constexpr size_t WB_FIN0 = 0, WB_FIN1 = 11 * MiB, WB_FOUT0 = 22 * MiB, WB_FOUT1 = 22 * MiB + 5632 * 1024, WB_MIN = 33 * MiB, WB_MOUT = 41 * MiB, WB_WGT = 45 * MiB;
constexpr int LDS_BYTES = 163840;
struct KP { const float* in[36]; float* out; unsigned char* ws; int ph_lo, ph_hi; };
typedef const KP __attribute__((address_space(4))) * KPC;
enum { I_X = 0, I_C, I_CTX, I_CCTX, I_ADAW, I_ADAB, I_NORMG, I_FINALG, I_FFNIN, I_FFNOUT, I_HYWIN, I_HYBIN, I_HYCW, I_HYCB, I_HYW1, I_HYB1, I_HYW2, I_HYB2, I_HYW3, I_HYB3,
       I_HYFREQ, I_HYDECAY, I_HYSKIP, I_HYWOUT, I_HYBOUT, I_MLUP, I_MLCW, I_MLCB, I_MLWQ, I_MLWK, I_MLWV, I_MLWG, I_MLBG, I_MLNG, I_MLSKIP, I_MLDOWN };

__device__ __forceinline__ float bf2f(u16 b) { return __uint_as_float(((unsigned)b) << 16); }
__device__ __forceinline__ float bflo(unsigned w) { return __uint_as_float(w << 16); }
__device__ __forceinline__ float bfhi(unsigned w) { return __uint_as_float(w & 0xffff0000u); }
__device__ __forceinline__ u16 f2bf(float f) { return (u16)(pg8::cvt_pk_bf16(f, 0.f) & 0xffffu); }
__device__ __forceinline__ float siluf(float x) { return x / (1.0f + __expf(-x)); }
__device__ __forceinline__ int modrow_of_token(int T) { const int b = T / TPB, t = T - b * TPB; return t < CTX ? 4 : b; }
__device__ __forceinline__ float lshfl(float v, int srclane) { return __int_as_float(__builtin_amdgcn_ds_bpermute(srclane << 2, __float_as_int(v))); }
__device__ __forceinline__ float wave_sum(float v) { const int lane = llane();
#pragma unroll
    for (int o = 32; o > 0; o >>= 1) v += lshfl(v, lane ^ o);
    return v; }
__device__ __forceinline__ float wave_max(float v) { const int lane = llane();
#pragma unroll
    for (int o = 32; o > 0; o >>= 1) v = fmaxf(v, lshfl(v, lane ^ o));
    return v; }

__device__ __forceinline__ void unpack8(u32x4v w, float (&f)[8]) { f[0] = bflo(w.x); f[1] = bfhi(w.x); f[2] = bflo(w.y); f[3] = bfhi(w.y); f[4] = bflo(w.z); f[5] = bfhi(w.z); f[6] = bflo(w.w); f[7] = bfhi(w.w); }
__device__ __forceinline__ u32x4v pack8(const float (&f)[8]) { u32x4v w; w.x = pg8::cvt_pk_bf16(f[0], f[1]); w.y = pg8::cvt_pk_bf16(f[2], f[3]); w.z = pg8::cvt_pk_bf16(f[4], f[5]); w.w = pg8::cvt_pk_bf16(f[6], f[7]); return w; }

struct EpiSwiglu {
    static constexpr bool PERM = true, AFTER_DRAIN = false;
    u16* act;
    __device__ __forceinline__ void operator()(const f32x4 (&acc)[2][2][4][2], const pg8::Unit& u, int wr, int wc, int fr, int fq) const {
        const int row0 = u.pm * 256 + wr * 64 + fr, col0 = u.pn * 128 + wc * 32 + 8 * fq;
#pragma unroll
        for (int ai = 0; ai < 2; ++ai)
#pragma unroll
            for (int m = 0; m < 4; ++m) {
                const f32x4 g0 = acc[ai][0][m][0], g1 = acc[ai][0][m][1], v0 = acc[ai][1][m][0], v1 = acc[ai][1][m][1];
                u32x4v w;
                w.x = pg8::cvt_pk_bf16(siluf(g0[0]) * v0[0], siluf(g0[1]) * v0[1]); w.y = pg8::cvt_pk_bf16(siluf(g0[2]) * v0[2], siluf(g0[3]) * v0[3]);
                w.z = pg8::cvt_pk_bf16(siluf(g1[0]) * v1[0], siluf(g1[1]) * v1[1]); w.w = pg8::cvt_pk_bf16(siluf(g1[2]) * v1[2], siluf(g1[3]) * v1[3]);
                *(u32x4v*)(act + (size_t)(row0 + ai * 128 + m * 16) * FF + col0) = w; }
    }
};
struct EpiResid {
    static constexpr bool PERM = false, AFTER_DRAIN = false;
    KPC kp; int l, gidx, bias_j;
    __device__ __forceinline__ void operator()(const f32x4 (&acc)[2][2][4][2], const pg8::Unit& u, int wr, int wc, int fr, int fq) const {
        unsigned char* ws = kp->ws; float* h = (float*)(ws + OFF_H); float* part = (float*)kp->out;
        const float* bias = bias_j >= 0 ? kp->in[I_HYBOUT] + (size_t)bias_j * D : nullptr; const float scale = gidx == 5 ? 1.0f : 0.5f;
        const int col0 = u.pn * 256 + wc * 32 + 4 * fq;
        const int mr = modrow_of_token(u.pm * 256);
        const float* gp = (const float*)(ws + OFF_MOD) + ((size_t)l * 5 + mr) * 9216 + gidx * 1024;
        const bool split = u.nt != 0, addb = bias != nullptr && u.kofs == 0;
        float* base = split ? part + ((size_t)(u.kofs >> 8) * 1024 + (u.pm / 33) * 256 + wr * 64 + fr) * D : h + (size_t)(u.pm * 256 + wr * 64 + fr) * D;
#pragma unroll
        for (int bj = 0; bj < 2; ++bj)
#pragma unroll
            for (int n = 0; n < 2; ++n) { const f32x4 gv = *(const f32x4*)(gp + col0 + bj * 128 + n * 16) * scale;
                const f32x4 bv = addb ? *(const f32x4*)(bias + col0 + bj * 128 + n * 16) : (f32x4){0.f, 0.f, 0.f, 0.f};
#pragma unroll
                for (int ai = 0; ai < 2; ++ai)
#pragma unroll
                    for (int m = 0; m < 4; ++m) { f32x4* q = (f32x4*)(base + (size_t)(ai * 128 + m * 16) * D + col0 + bj * 128 + n * 16); const f32x4 v = gv * (acc[ai][bj][m][n] + bv);
                        if (split) *q = v; else *q = *q + v; } }
    }
};
struct EpiBf {
    static constexpr bool PERM = true, AFTER_DRAIN = false;
    u16* O; int ldc;
    __device__ __forceinline__ void operator()(const f32x4 (&acc)[2][2][4][2], const pg8::Unit& u, int wr, int wc, int fr, int fq) const {
        const int row0 = u.pm * 256 + wr * 64 + fr, col0 = u.pn * 256 + wc * 32 + 8 * fq;
#pragma unroll
        for (int ai = 0; ai < 2; ++ai)
#pragma unroll
            for (int m = 0; m < 4; ++m)
#pragma unroll
                for (int bj = 0; bj < 2; ++bj) { const f32x4 a = acc[ai][bj][m][0], b = acc[ai][bj][m][1]; u32x4v w;
                    w.x = pg8::cvt_pk_bf16(a[0], a[1]); w.y = pg8::cvt_pk_bf16(a[2], a[3]); w.z = pg8::cvt_pk_bf16(b[0], b[1]); w.w = pg8::cvt_pk_bf16(b[2], b[3]);
                    *(u32x4v*)(O + (size_t)(row0 + ai * 128 + m * 16) * ldc + col0 + bj * 128) = w; }
    }
};
struct EpiProjT {
    static constexpr bool PERM = true, AFTER_DRAIN = false;
    u16* lat; u16* ctx; const float* bias;
    __device__ __forceinline__ void operator()(const f32x4 (&acc)[2][2][4][2], const pg8::Unit& u, int wr, int wc, int fr, int fq) const {
        const int row0 = u.pm * 256 + wr * 64 + fr, tc0 = wc * 32 + 8 * fq;
        const int b = u.pn / 33, tile = u.pn - b * 33;
#pragma unroll
        for (int ai = 0; ai < 2; ++ai)
#pragma unroll
            for (int m = 0; m < 4; ++m) { const int ch = row0 + ai * 128 + m * 16; const float bs = bias[ch];
                u16* dst = tile == 0 ? ctx + ((size_t)b * 3072 + ch) * CTX + tc0 : lat + ((size_t)b * 3072 + ch) * SEQ + (tile - 1) * 256 + tc0;
#pragma unroll
                for (int bj = 0; bj < 2; ++bj) { const f32x4 a = acc[ai][bj][m][0] + bs, c = acc[ai][bj][m][1] + bs; u32x4v w;
                    w.x = pg8::cvt_pk_bf16(a[0], a[1]); w.y = pg8::cvt_pk_bf16(a[2], a[3]); w.z = pg8::cvt_pk_bf16(c[0], c[1]); w.w = pg8::cvt_pk_bf16(c[2], c[3]);
                    *(u32x4v*)(dst + bj * 128) = w; } }
    }
};


struct LatOrder : pg8::StaticOrder {
    __device__ bool next(int i, pg8::Unit& u) const { if (!pg8::StaticOrder::next(i, u)) return false; u.pm = (u.pm >> 5) * 33 + 1 + (u.pm & 31); return true; }
};
struct CtxSplitOrder {
    int nk, G, c;
    __device__ bool next(int i, pg8::Unit& u) const { const int L = i * G + c; if (L >= 16 * nk) return false; const int un = L & 15, kc = L >> 4; u.pm = (un >> 2) * 33; u.pn = un & 3; u.kofs = kc * 256; return true; }
    __device__ __forceinline__ void a_ready(const pg8::Unit&) const {}
    __device__ __forceinline__ void done(const pg8::Unit&) const {}
};
struct EpiResidAtomic {
    static constexpr bool PERM = false, AFTER_DRAIN = false;
    float* h; const float* gp; float scale;
    __device__ __forceinline__ void operator()(const f32x4 (&acc)[2][2][4][2], const pg8::Unit& u, int wr, int wc, int fr, int fq) const {
        const int row0 = u.pm * 256 + wr * 64 + fr, col0 = u.pn * 256 + wc * 32 + 4 * fq;
#pragma unroll
        for (int bj = 0; bj < 2; ++bj)
#pragma unroll
            for (int n = 0; n < 2; ++n) { const f32x4 gv = *(const f32x4*)(gp + col0 + bj * 128 + n * 16) * scale;
#pragma unroll
                for (int ai = 0; ai < 2; ++ai)
#pragma unroll
                    for (int m = 0; m < 4; ++m) { float* q = h + (size_t)(row0 + ai * 128 + m * 16) * D + col0 + bj * 128 + n * 16; const f32x4 v = gv * acc[ai][bj][m][n];
                        atomicAdd(q, v[0]); atomicAdd(q + 1, v[1]); atomicAdd(q + 2, v[2]); atomicAdd(q + 3, v[3]); } }
    }
};

__device__ __forceinline__ void ctx_bias_phase(KPC kp, const float* gp, const float* bias) {
    float* h = (float*)(kp->ws + OFF_H);
    for (int i = lbid() * 512 + ltid(); i < NB * CTX * 256; i += gridDim.x * 512) { const int r = i >> 8, c = (i & 255) * 4, b = r >> 8, t = r & 255;
        f32x4* q = (f32x4*)(h + ((size_t)b * TPB + t) * D + c); *q = *q + *(const f32x4*)(gp + c) * *(const f32x4*)(bias + c); }
}
__device__ __forceinline__ int colmap(int n, int mapmode) { return mapmode ? (((n >> 8) << 7) + (n & 127) + ((n >> 7) & 1) * FF) : n; }
__device__ __forceinline__ void convert_T(const float* __restrict__ src, int ld, int K, int Nd, int mapmode, u16* __restrict__ dst, LAS float* tile, int& tctr) {
    const int tid = ltid(), nkt = K / 64, ntile = (Nd / 64) * nkt;
    const int G = (int)gridDim.x; const int first = (((lbid() - tctr) % G) + G) % G; tctr += ntile;
    for (int t = first; t < ntile; t += G) {
        const int n0 = (t / nkt) * 64, k0 = (t % nkt) * 64, c0 = colmap(n0, mapmode);
#pragma unroll
        for (int i = 0; i < 2; ++i) { const int e = tid + 512 * i, kr = e >> 4, c4 = (e & 15) * 4;
            const f32x4 v = *(const f32x4*)(src + (size_t)(k0 + kr) * ld + c0 + c4);
            tile[kr * 65 + c4] = v[0]; tile[kr * 65 + c4 + 1] = v[1]; tile[kr * 65 + c4 + 2] = v[2]; tile[kr * 65 + c4 + 3] = v[3]; }
        __syncthreads();
        { const int n = tid >> 3, k8 = (tid & 7) * 8; u32x4v w;
          w.x = pg8::cvt_pk_bf16(tile[(k8 + 0) * 65 + n], tile[(k8 + 1) * 65 + n]); w.y = pg8::cvt_pk_bf16(tile[(k8 + 2) * 65 + n], tile[(k8 + 3) * 65 + n]);
          w.z = pg8::cvt_pk_bf16(tile[(k8 + 4) * 65 + n], tile[(k8 + 5) * 65 + n]); w.w = pg8::cvt_pk_bf16(tile[(k8 + 6) * 65 + n], tile[(k8 + 7) * 65 + n]);
          *(u32x4v*)(dst + (size_t)(n0 + n) * K + k0 + k8) = w; }
        __syncthreads();
    }
}

__device__ __forceinline__ void norm_phase(KPC kp, int l, int sub, int nkp) {
    const float* h = (const float*)(kp->ws + OFF_H); u16* uo = (u16*)(kp->ws + OFF_U);
    const float* g = kp->in[I_NORMG] + (size_t)(l * 3 + sub) * D; const float* modl = (const float*)(kp->ws + OFF_MOD) + (size_t)l * 5 * 9216;
    const int lane = ltid() & 63, wv = ltid() >> 6;
    for (int T = lbid() * 8 + wv; T < NTOK; T += gridDim.x * 8) {
        const float* hr = h + (size_t)T * D; f32x4 v[4]; float ss = 0.f;
        const int bT = T / TPB, tT = T - bT * TPB; const bool fold = nkp > 0 && tT < CTX;
#pragma unroll
        for (int i = 0; i < 4; ++i) { v[i] = *(const f32x4*)(hr + i * 256 + lane * 4);
            if (fold) { const float* pp = (const float*)kp->out + ((size_t)bT * CTX + tT) * D + i * 256 + lane * 4; for (int kc = 0; kc < nkp; ++kc) v[i] += *(const f32x4*)(pp + (size_t)kc * 1024 * D);
                *(f32x4*)((float*)(kp->ws + OFF_H) + (size_t)T * D + i * 256 + lane * 4) = v[i]; }
            ss += v[i][0] * v[i][0] + v[i][1] * v[i][1] + v[i][2] * v[i][2] + v[i][3] * v[i][3]; }
        ss = wave_sum(ss); const float rs = rsqrtf(ss * (1.0f / D) + 1e-6f);
        const float* mp = modl + (size_t)modrow_of_token(T) * 9216 + sub * 3 * 1024;
#pragma unroll
        for (int i = 0; i < 4; ++i) { const int c = i * 256 + lane * 4; const f32x4 gg = *(const f32x4*)(g + c), sh = *(const f32x4*)(mp + c), sc = *(const f32x4*)(mp + 1024 + c);
            const f32x4 o = v[i] * rs * gg * (sc + 1.0f) + sh; u32x2 w; w.x = pg8::cvt_pk_bf16(o[0], o[1]); w.y = pg8::cvt_pk_bf16(o[2], o[3]);
            *(u32x2*)(uo + (size_t)T * D + c) = w; }
    }
}

__device__ __forceinline__ void final_phase(KPC kp) {
    const float* h = (const float*)(kp->ws + OFF_H); const float* g = kp->in[I_FINALG];
    const int lane = ltid() & 63, wv = ltid() >> 6;
    for (int r = lbid() * 8 + wv; r < NB * SEQ; r += gridDim.x * 8) {
        const int b = r / SEQ, s = r - b * SEQ; const float* hr = h + ((size_t)b * TPB + CTX + s) * D; f32x4 v[4]; float ss = 0.f;
#pragma unroll
        for (int i = 0; i < 4; ++i) { v[i] = *(const f32x4*)(hr + i * 256 + lane * 4); ss += v[i][0] * v[i][0] + v[i][1] * v[i][1] + v[i][2] * v[i][2] + v[i][3] * v[i][3]; }
        ss = wave_sum(ss); const float rs = rsqrtf(ss * (1.0f / D) + 1e-6f);
#pragma unroll
        for (int i = 0; i < 4; ++i) { const int c = i * 256 + lane * 4; *(f32x4*)(kp->out + (size_t)r * D + c) = v[i] * rs * *(const f32x4*)(g + c); }
    }
}

__device__ __forceinline__ void setup_phase(KPC kp, LAS float* ldsf) {
    float* h = (float*)(kp->ws + OFF_H); const int tid = ltid();
    const int hb0 = gridDim.x > 64 ? 32 : 0;
    for (size_t i = (size_t)(lbid() - hb0) * 512 + tid; lbid() >= hb0 && i < (size_t)NTOK * 256; i += (size_t)(gridDim.x - hb0) * 512) {
        const int T = (int)(i >> 8), c = ((int)i & 255) * 4, b = T / TPB, t = T - b * TPB; f32x4 v;
        if (t < CTX) v = *(const f32x4*)(kp->in[I_CTX] + ((size_t)b * CTX + t) * D + c);
        else { const int s = t - CTX; v = *(const f32x4*)(kp->in[I_X] + ((size_t)b * SEQ + s) * D + c);
            const int half = c >> 9, cc = c & 511, isc = cc >> 8, i0 = cc & 255; const float pv = half ? (float)(s & 63) : (float)(s >> 6);
#pragma unroll
            for (int e = 0; e < 4; ++e) { const float om = exp2f(-13.287712379549449f * (float)(i0 + e) * (1.0f / 256.0f)); const float ang = pv * om; v[e] += isc ? __cosf(ang) : __sinf(ang); } }
        *(f32x4*)(h + (size_t)T * D + c) = v;
    }
    LAS float* sc = ldsf; LAS float* red = ldsf + 5 * 1024;
    for (int i = tid; i < 5 * 1024; i += 512) { const int r = i >> 10, k = i & 1023; const float cv = r < 4 ? kp->in[I_C][r * D + k] : kp->in[I_CCTX][k]; sc[i] = siluf(cv); }
    __syncthreads();
    float* mod = (float*)(kp->ws + OFF_MOD); const int lane = tid & 63, wv = tid >> 6;
    for (int task = lbid(); task < 288; task += gridDim.x) {
        const int l = task / 72, n0 = (task % 72) * 128 + lane * 2; const float* w = kp->in[I_ADAW] + (size_t)l * D * 9216 + n0;
        f32x2 a[5];
#pragma unroll
        for (int r = 0; r < 5; ++r) a[r] = (f32x2){0.f, 0.f};
#pragma unroll 16
        for (int k = wv * 128; k < wv * 128 + 128; ++k) { const f32x2 wv2 = *(const f32x2*)(w + (size_t)k * 9216);
#pragma unroll
            for (int r = 0; r < 5; ++r) a[r] += wv2 * sc[r * 1024 + k]; }
#pragma unroll
        for (int r = 0; r < 5; ++r) { red[(wv * 5 + r) * 128 + lane * 2] = a[r][0]; red[(wv * 5 + r) * 128 + lane * 2 + 1] = a[r][1]; }
        __syncthreads();
        for (int i = tid; i < 640; i += 512) { const int r = i >> 7, n = i & 127; float s = 0.f;
#pragma unroll
            for (int w8 = 0; w8 < 8; ++w8) s += red[(w8 * 5 + r) * 128 + n];
            const int nn = (task % 72) * 128 + n; mod[((size_t)l * 5 + r) * 9216 + nn] = s + kp->in[I_ADAB][(size_t)l * 9216 + nn]; }
        __syncthreads();
    }
}

__device__ __forceinline__ void convert_layer(KPC kp, int l, LAS float* tile) {
    unsigned char* wb = kp->ws + OFF_WB; int tctr = 0; const int j = l >> 1;
    for (int f = 0; f < 2; ++f) {
        convert_T(kp->in[I_FFNIN] + (size_t)(l * 2 + f) * D * 2 * FF, 2 * FF, D, 2 * FF, 1, (u16*)(wb + (f ? WB_FIN1 : WB_FIN0)), tile, tctr);
        convert_T(kp->in[I_FFNOUT] + (size_t)(l * 2 + f) * FF * D, D, FF, D, 0, (u16*)(wb + (f ? WB_FOUT1 : WB_FOUT0)), tile, tctr);
    }
    if ((l & 1) == 0) {
        convert_T(kp->in[I_HYWIN] + (size_t)j * D * 3 * D, 3 * D, D, 3 * D, 0, (u16*)(wb + WB_MIN), tile, tctr);
        convert_T(kp->in[I_HYWOUT] + (size_t)j * D * D, D, D, D, 0, (u16*)(wb + WB_MOUT), tile, tctr);
    } else {
        convert_T(kp->in[I_MLUP] + (size_t)j * D * 2 * INNER, 2 * INNER, D, 2 * INNER, 0, (u16*)(wb + WB_MIN), tile, tctr);
        convert_T(kp->in[I_MLDOWN] + (size_t)j * INNER * D, D, INNER, D, 0, (u16*)(wb + WB_MOUT), tile, tctr);
        u16* wg = (u16*)(wb + WB_WGT); const float* src = kp->in[I_MLWG] + (size_t)j * 3 * INNER * 16;
        for (int i = lbid() * 512 + ltid(); i < 16 * 3 * INNER; i += gridDim.x * 512) { const int o = i / (3 * INNER), k = i - o * 3 * INNER; wg[i] = f2bf(src[(size_t)k * 16 + o]); }
        float* gates = (float*)(kp->ws + OFF_GATES); const float* bg = kp->in[I_MLBG] + j * 16;
        for (int i = lbid() * 512 + ltid(); i < NTOK * 16; i += gridDim.x * 512) gates[i] = bg[i & 15];
    }
}

constexpr size_t HY_PL = 0, HY_PC = (size_t)NB * 3072 * SEQ * 2, HY_YL = HY_PC + (size_t)NB * 3072 * CTX * 2, HY_YC = HY_YL + (size_t)NB * D * SEQ * 2;
__device__ __forceinline__ int fphys(int i) { return i ^ ((((i >> 6) & 1) * 21) ^ (((i >> 5) & 1) * 10)); }
__device__ __forceinline__ f32x2 cmul(f32x2 a, f32x2 b) { return (f32x2){a.x * b.x - a.y * b.y, a.x * b.y + a.y * b.x}; }
__device__ __forceinline__ f32x2 cmulc(f32x2 a, f32x2 b) { return (f32x2){a.x * b.x + a.y * b.y, a.y * b.x - a.x * b.y}; }
__device__ __forceinline__ int drev(int x) { const unsigned r = __brev((unsigned)x) >> 18; return (int)(((r & 0x2AAAu) >> 1) | ((r & 0x1555u) << 1)); }

__device__ __forceinline__ void fidx4(int base, int lm, int (&ix)[4]) {
    const int m = 1 << lm;
    if (lm == 6) { const int i0 = fphys(base); ix[0] = i0; ix[1] = (i0 + 64) ^ 21; ix[2] = i0 + 128; ix[3] = (i0 + 192) ^ 21; }
    else if (lm == 4) { const int c6 = ((base >> 6) & 1) * 21; ix[0] = base ^ c6; ix[1] = (base + 16) ^ c6; ix[2] = (base + 32) ^ c6 ^ 10; ix[3] = (base + 48) ^ c6 ^ 10; }
    else { const int c = (((base >> 6) & 1) * 21) ^ (((base >> 5) & 1) * 10); ix[0] = base ^ c; ix[1] = (base + m) ^ c; ix[2] = (base + 2 * m) ^ c; ix[3] = (base + 3 * m) ^ c; }
}
__device__ __forceinline__ void fft_fwd(LAS f32x2* buf) {
    const int tid = ltid();
    for (int lm = 12; lm >= 0; lm -= 2) {
        const int m = 1 << lm; const float inv = 1.0f / (float)(4 << lm);
        f32x2 a[8][4]; int ix[8][4];
#pragma unroll
        for (int i = 0; i < 8; ++i) { const int g = tid + 512 * i, p = g & (m - 1), base = ((g >> lm) << (lm + 2)) + p; fidx4(base, lm, ix[i]);
#pragma unroll
            for (int r = 0; r < 4; ++r) a[i][r] = buf[ix[i][r]]; }
#pragma unroll
        for (int i = 0; i < 8; ++i) { const int p = (tid + 512 * i) & (m - 1);
            const f32x2 t0 = a[i][0] + a[i][2], t1 = a[i][0] - a[i][2], t2 = a[i][1] + a[i][3], dd = a[i][1] - a[i][3], t3 = (f32x2){dd.y, -dd.x};
            const float rev = (float)p * inv;
            const f32x2 w1 = (f32x2){__builtin_amdgcn_cosf(rev), -__builtin_amdgcn_sinf(rev)}, w2 = cmul(w1, w1), w3 = cmul(w2, w1);
            buf[ix[i][0]] = t0 + t2; buf[ix[i][1]] = cmul(t1 + t3, w1); buf[ix[i][2]] = cmul(t0 - t2, w2); buf[ix[i][3]] = cmul(t1 - t3, w3); }
        __syncthreads();
    }
}
__device__ __forceinline__ void fft_inv(LAS f32x2* buf) {
    const int tid = ltid();
    for (int lm = 0; lm <= 12; lm += 2) {
        const int m = 1 << lm; const float inv = 1.0f / (float)(4 << lm);
        f32x2 a[8][4]; int ix[8][4];
#pragma unroll
        for (int i = 0; i < 8; ++i) { const int g = tid + 512 * i, p = g & (m - 1), base = ((g >> lm) << (lm + 2)) + p; fidx4(base, lm, ix[i]);
#pragma unroll
            for (int r = 0; r < 4; ++r) a[i][r] = buf[ix[i][r]]; }
#pragma unroll
        for (int i = 0; i < 8; ++i) { const int p = (tid + 512 * i) & (m - 1);
            const float rev = (float)p * inv;
            const f32x2 w1 = (f32x2){__builtin_amdgcn_cosf(rev), -__builtin_amdgcn_sinf(rev)}, w2 = cmul(w1, w1), w3 = cmul(w2, w1);
            const f32x2 b0 = a[i][0], b1 = cmulc(a[i][1], w1), b2 = cmulc(a[i][2], w2), b3 = cmulc(a[i][3], w3);
            const f32x2 s0 = b0 + b2, s1 = b0 - b2, s2 = b1 + b3, dd = b1 - b3, s3 = (f32x2){-dd.y, dd.x};
            buf[ix[i][0]] = s0 + s2; buf[ix[i][1]] = s1 + s3; buf[ix[i][2]] = s0 - s2; buf[ix[i][3]] = s1 - s3; }
        __syncthreads();
    }
}

__device__ __forceinline__ void hy_mlp_phase(KPC kp, int j) {
    float* h2 = (float*)(kp->ws + OFF_H2);
    const float* w1 = kp->in[I_HYW1] + j * 33 * 64; const float* b1 = kp->in[I_HYB1] + j * 64; const float* w2 = kp->in[I_HYW2] + j * 64 * 64; const float* b2 = kp->in[I_HYB2] + j * 64;
    const float* fr = kp->in[I_HYFREQ] + j * 128; const int lane = ltid() & 63, wv = ltid() >> 6;
    for (int pos = lbid() * 8 + wv; pos < SEQ + CTX; pos += gridDim.x * 8) {
        const int n = pos < SEQ ? SEQ : CTX, t = pos < SEQ ? pos : pos - SEQ; const float tn = (float)t / (float)(n - 1);
        float feat = 0.f;
        if (lane == 0) feat = tn;
        else if (lane < 33) { const int bi = (lane - 1) & 15; const float band = 1e-4f + (float)bi * ((15.0f - 1e-4f) / 15.0f); float rev = ((float)t / (float)n) * band; rev -= floorf(rev);
            const float ang = 6.283185307179586f * rev; feat = lane < 17 ? cosf(ang) : -sinf(ang); }
        float z = b1[lane];
        for (int i = 0; i < 33; ++i) z += lshfl(feat, i) * w1[i * 64 + lane];
        const float h1 = sinf(fr[lane] * z);
        float z2 = b2[lane];
        for (int v = 0; v < 64; ++v) z2 += lshfl(h1, v) * w2[v * 64 + lane];
        h2[(size_t)pos * 64 + lane] = sinf(fr[64 + lane] * z2);
    }
}

__device__ __forceinline__ void block_sum2(float& a, float& b, LAS float* red) {
    a = wave_sum(a); b = wave_sum(b); const int lane = ltid() & 63, wv = ltid() >> 6;
    __syncthreads(); if (lane == 0) { red[wv] = a; red[8 + wv] = b; } __syncthreads();
    float sa = 0.f, sb = 0.f;
#pragma unroll
    for (int i = 0; i < 8; ++i) { sa += red[i]; sb += red[8 + i]; }
    a = sa; b = sb;
}

__device__ __forceinline__ void hy_filter_task(KPC kp, int j, int task, LAS f32x2* buf, LAS float* aux) {
    const int tid = ltid(), d = task & 1023; const bool lat = task < 1024;
    const float* w3 = kp->in[I_HYW3] + (size_t)j * 64 * 4096; const float* b3 = kp->in[I_HYB3] + j * 4096; const float* ldc = kp->in[I_HYDECAY] + j * 4096;
    __syncthreads();
    if (tid < 256) aux[tid] = w3[(size_t)(tid & 63) * 4096 + (tid >> 6) * 1024 + d];
    if (tid < 4) { aux[256 + tid] = b3[tid * 1024 + d]; aux[260 + tid] = __expf(ldc[tid * 1024 + d]); }
    __syncthreads();
    const float* h2 = (const float*)(kp->ws + OFF_H2);
    float ss0 = 0.f, ss1 = 0.f;
    if (lat) {
        for (int r = 0; r < 16; ++r) { const int i = tid + 512 * r; float a0 = aux[256], a1 = aux[257], a2 = aux[258], a3 = aux[259];
#pragma unroll 4
            for (int u4 = 0; u4 < 16; ++u4) { const f32x4 hv = *(const f32x4*)(h2 + (size_t)i * 64 + u4 * 4);
                const f32x4 q0 = *(const LAS f32x4*)(aux + u4 * 4), q1 = *(const LAS f32x4*)(aux + 64 + u4 * 4), q2 = *(const LAS f32x4*)(aux + 128 + u4 * 4), q3 = *(const LAS f32x4*)(aux + 192 + u4 * 4);
#pragma unroll
                for (int e = 0; e < 4; ++e) { a0 += hv[e] * q0[e]; a1 += hv[e] * q1[e]; a2 += hv[e] * q2[e]; a3 += hv[e] * q3[e]; } }
            const float tn = (float)i * (1.0f / 8191.0f);
            a0 *= __expf(-tn * aux[260]); a1 *= __expf(-tn * aux[261]); a2 *= __expf(-tn * aux[262]); a3 *= __expf(-tn * aux[263]);
            buf[fphys(i)] = (f32x2){a0, a2}; ss0 += a0 * a0; ss1 += a2 * a2;
            if (i >= 1) { buf[fphys(NFFT - i)] = (f32x2){a1, a3}; ss0 += a1 * a1; ss1 += a3 * a3; } }
        if (tid == 0) buf[fphys(SEQ)] = (f32x2){0.f, 0.f};
        block_sum2(ss0, ss1, aux + 272);
        const f32x2 scl = (f32x2){rsqrtf(ss0 + 1e-12f) * (1.0f / NFFT), rsqrtf(ss1 + 1e-12f) * (1.0f / NFFT)};
        for (int r = 0; r < 32; ++r) { const int q = fphys(tid + 512 * r); buf[q] = buf[q] * scl; }
        __syncthreads();
        fft_fwd(buf);
        f32x2* K0 = (f32x2*)(kp->ws + OFF_R2) + (size_t)d * NFFT; f32x2* K1 = (f32x2*)kp->out + (size_t)d * NFFT;
        for (int r = 0; r < 32; ++r) { const int pos = tid + 512 * r, k = drev(pos), pos2 = drev((NFFT - k) & (NFFT - 1)); const f32x2 Z = buf[fphys(pos)], Z2 = buf[fphys(pos2)];
            K0[pos] = (f32x2){0.5f * (Z.x + Z2.x), 0.5f * (Z.y - Z2.y)}; K1[pos] = (f32x2){0.5f * (Z.y + Z2.y), -0.5f * (Z.x - Z2.x)}; }
    } else {
        const int idx = tid; float a0 = 0.f, a1 = 0.f;
        if (idx != CTX) { const int t = idx < CTX ? idx : 2 * CTX - idx, dir = idx < CTX ? 0 : 1; a0 = aux[256 + dir]; a1 = aux[258 + dir];
            for (int u4 = 0; u4 < 16; ++u4) { const f32x4 hv = *(const f32x4*)(h2 + (size_t)(SEQ + t) * 64 + u4 * 4);
#pragma unroll
                for (int e = 0; e < 4; ++e) { const int u = u4 * 4 + e; a0 += hv[e] * aux[dir * 64 + u]; a1 += hv[e] * aux[128 + dir * 64 + u]; } }
            const float tn = (float)t * (1.0f / 255.0f); a0 *= __expf(-tn * aux[260 + dir]); a1 *= __expf(-tn * aux[262 + dir]); }
        ss0 = a0 * a0; ss1 = a1 * a1;
        block_sum2(ss0, ss1, aux + 272);
        float* kc = (float*)(kp->ws + OFF_KCTX);
        kc[(size_t)d * 512 + idx] = a0 * rsqrtf(ss0 + 1e-12f); kc[(size_t)(1024 + d) * 512 + idx] = a1 * rsqrtf(ss1 + 1e-12f);
    }
}

__device__ __forceinline__ float ld3(const u16* row, int t, int n, float wa, float wb, float wc, float bias) {
    const float xm = t > 0 ? bf2f(row[t - 1]) : 0.f, x0 = bf2f(row[t]), xp = t < n - 1 ? bf2f(row[t + 1]) : 0.f; return wa * xm + wb * x0 + wc * xp + bias; }

__device__ __forceinline__ void ld3x8(const u16* row, int t0, float wa, float wb, float wc, float bias, float (&o)[8]) {
    const u32x4v w = *(const u32x4v*)(row + t0);
    const float x0 = bflo(w.x), x1 = bfhi(w.x), x2 = bflo(w.y), x3 = bfhi(w.y), x4 = bflo(w.z), x5 = bfhi(w.z), x6 = bflo(w.w), x7 = bfhi(w.w);
    const float xl = t0 > 0 ? bf2f(row[t0 - 1]) : 0.f, xr = t0 + 8 < SEQ ? bf2f(row[t0 + 8]) : 0.f;
    o[0] = wa * xl + wb * x0 + wc * x1 + bias; o[1] = wa * x0 + wb * x1 + wc * x2 + bias; o[2] = wa * x1 + wb * x2 + wc * x3 + bias; o[3] = wa * x2 + wb * x3 + wc * x4 + bias;
    o[4] = wa * x3 + wb * x4 + wc * x5 + bias; o[5] = wa * x4 + wb * x5 + wc * x6 + bias; o[6] = wa * x5 + wb * x6 + wc * x7 + bias; o[7] = wa * x6 + wb * x7 + wc * xr + bias;
}
__device__ __forceinline__ void hy_conv_lat(KPC kp, int j, int task, LAS f32x2* buf) {
    const int tid = ltid(), bp = task >> 10, c = task & 1023, b0 = bp * 2;
    const u16* pl = (const u16*)(kp->ws + OFF_R1 + HY_PL); u16* yl = (u16*)(kp->ws + OFF_R1 + HY_YL);
    const float* cw = kp->in[I_HYCW] + (size_t)j * 3 * 3072; const float* cb = kp->in[I_HYCB] + j * 3072;
    const float w1a = cw[c], w1b = cw[3072 + c], w1c = cw[6144 + c], bb1 = cb[c];
    const float w2a = cw[1024 + c], w2b = cw[3072 + 1024 + c], w2c = cw[6144 + 1024 + c], bb2 = cb[1024 + c];
    const float w3a = cw[2048 + c], w3b = cw[3072 + 2048 + c], w3c = cw[6144 + 2048 + c], bb3 = cb[2048 + c];
    const float sk0 = kp->in[I_HYSKIP][j * 2048 + c], sk1 = kp->in[I_HYSKIP][j * 2048 + 1024 + c];
    const u16* x1r0 = pl + ((size_t)b0 * 3072 + c) * SEQ; const u16* x1r1 = x1r0 + (size_t)3072 * SEQ;
    const u16* x2r0 = x1r0 + (size_t)1024 * SEQ; const u16* x2r1 = x1r1 + (size_t)1024 * SEQ;
    const u16* vr0 = x1r0 + (size_t)2048 * SEQ; const u16* vr1 = x1r1 + (size_t)2048 * SEQ;
    const f32x2* K0 = (const f32x2*)(kp->ws + OFF_R2) + (size_t)c * NFFT; const f32x2* K1 = (const f32x2*)kp->out + (size_t)c * NFFT;
    __syncthreads();
#pragma unroll
    for (int g = 0; g < 2; ++g) { const int t0 = 8 * (tid + 512 * g); float v0[8], v1[8];
        ld3x8(vr0, t0, w3a, w3b, w3c, bb3, v0); ld3x8(vr1, t0, w3a, w3b, w3c, bb3, v1);
#pragma unroll
        for (int e = 0; e < 8; ++e) { buf[fphys(t0 + e)] = (f32x2){v0[e], v1[e]}; buf[fphys(SEQ + t0 + e)] = (f32x2){0.f, 0.f}; } }
    __syncthreads();
#ifdef PROBE_FFT
    for (int rp = 0; rp < PROBE_FFT; ++rp) { fft_fwd(buf); fft_inv(buf); for (int r = 0; r < 32; ++r) { const int q = fphys(tid + 512 * r); buf[q] = buf[q] * (1.0f / NFFT); } __syncthreads(); }
#endif
    fft_fwd(buf);
#pragma unroll 8
    for (int r = 0; r < 32; ++r) { const int pos = tid + 512 * r, q = fphys(pos); buf[q] = cmul(buf[q], K0[pos]); }
    __syncthreads();
    fft_inv(buf);
    float zr[32];
#pragma unroll
    for (int g = 0; g < 2; ++g) { const int t0 = 8 * (tid + 512 * g); float v0[8], v1[8], xa[8], xb[8];
        ld3x8(vr0, t0, w3a, w3b, w3c, bb3, v0); ld3x8(vr1, t0, w3a, w3b, w3c, bb3, v1); ld3x8(x1r0, t0, w1a, w1b, w1c, bb1, xa); ld3x8(x1r1, t0, w1a, w1b, w1c, bb1, xb);
#pragma unroll
        for (int e = 0; e < 8; ++e) { const f32x2 y = buf[fphys(t0 + e)]; const float z0 = xa[e] * (y.x + sk0 * v0[e]), z1 = xb[e] * (y.y + sk0 * v1[e]);
            zr[g * 16 + 2 * e] = z0; zr[g * 16 + 2 * e + 1] = z1; buf[fphys(t0 + e)] = (f32x2){z0, z1}; buf[fphys(SEQ + t0 + e)] = (f32x2){0.f, 0.f}; } }
    __syncthreads();
    fft_fwd(buf);
#pragma unroll 8
    for (int r = 0; r < 32; ++r) { const int pos = tid + 512 * r, q = fphys(pos); buf[q] = cmul(buf[q], K1[pos]); }
    __syncthreads();
    fft_inv(buf);
#pragma unroll
    for (int g = 0; g < 2; ++g) { const int t0 = 8 * (tid + 512 * g); float xa[8], xb[8], o0[8], o1[8];
        ld3x8(x2r0, t0, w2a, w2b, w2c, bb2, xa); ld3x8(x2r1, t0, w2a, w2b, w2c, bb2, xb);
#pragma unroll
        for (int e = 0; e < 8; ++e) { const f32x2 y = buf[fphys(t0 + e)]; o0[e] = xa[e] * (y.x + sk1 * zr[g * 16 + 2 * e]); o1[e] = xb[e] * (y.y + sk1 * zr[g * 16 + 2 * e + 1]); }
        *(u32x4v*)(yl + ((size_t)b0 * D + c) * SEQ + t0) = pack8(o0); *(u32x4v*)(yl + ((size_t)(b0 + 1) * D + c) * SEQ + t0) = pack8(o1); }
}

__device__ __forceinline__ void hy_conv_ctx(KPC kp, int j, int c, LAS float* ls) {
    const int tid = ltid();
    const u16* pc = (const u16*)(kp->ws + OFF_R1 + HY_PC); u16* yc = (u16*)(kp->ws + OFF_R1 + HY_YC); const float* kc = (const float*)(kp->ws + OFF_KCTX);
    const float* cw = kp->in[I_HYCW] + (size_t)j * 3 * 3072; const float* cb = kp->in[I_HYCB] + j * 3072;
    const float w1a = cw[c], w1b = cw[3072 + c], w1c = cw[6144 + c], bb1 = cb[c];
    const float w2a = cw[1024 + c], w2b = cw[3072 + 1024 + c], w2c = cw[6144 + 1024 + c], bb2 = cb[1024 + c];
    const float w3a = cw[2048 + c], w3b = cw[3072 + 2048 + c], w3c = cw[6144 + 2048 + c], bb3 = cb[2048 + c];
    const float sk0 = kp->in[I_HYSKIP][j * 2048 + c], sk1 = kp->in[I_HYSKIP][j * 2048 + 1024 + c];
    __syncthreads();
    ls[tid] = kc[(size_t)c * 512 + tid]; ls[512 + tid] = kc[(size_t)(1024 + c) * 512 + tid];
    for (int i = 0; i < 2; ++i) { const int e = tid + 512 * i, b = e >> 8, t = e & 255; ls[1024 + e] = ld3(pc + ((size_t)b * 3072 + 2048 + c) * CTX, t, CTX, w3a, w3b, w3c, bb3); }
    __syncthreads();
    float zr[2];
    for (int i = 0; i < 2; ++i) { const int e = tid + 512 * i, b = e >> 8, t = e & 255; float a = 0.f;
        for (int s = 0; s < CTX; ++s) a += ls[(t - s) & 511] * ls[1024 + b * 256 + s];
        zr[i] = ld3(pc + ((size_t)b * 3072 + c) * CTX, t, CTX, w1a, w1b, w1c, bb1) * (a + sk0 * ls[1024 + e]); ls[2048 + e] = zr[i]; }
    __syncthreads();
    for (int i = 0; i < 2; ++i) { const int e = tid + 512 * i, b = e >> 8, t = e & 255; float a = 0.f;
        for (int s = 0; s < CTX; ++s) a += ls[512 + ((t - s) & 511)] * ls[2048 + b * 256 + s];
        yc[((size_t)b * D + c) * CTX + t] = f2bf(ld3(pc + ((size_t)b * 3072 + 1024 + c) * CTX, t, CTX, w2a, w2b, w2c, bb2) * (a + sk1 * zr[i])); }
}

__device__ __forceinline__ void hy_transpose(KPC kp, LAS u16* tl) {
    const u16* yl = (const u16*)(kp->ws + OFF_R1 + HY_YL); const u16* yc = (const u16*)(kp->ws + OFF_R1 + HY_YC); u16* y = (u16*)(kp->ws + OFF_U); const int tid = ltid();
    for (int tile = lbid(); tile < NB * 16 * NCH; tile += gridDim.x) {
        const int b = tile / (16 * NCH), rem = tile - b * 16 * NCH, ct = rem / NCH, tt = rem - ct * NCH;
        const u16* src = tt < 4 ? yc + ((size_t)b * D + ct * 64) * CTX + tt * 64 : yl + ((size_t)b * D + ct * 64) * SEQ + (tt - 4) * 64; const int ld = tt < 4 ? CTX : SEQ;
        { const int cr = tid >> 3, t8 = (tid & 7) * 8; *(LAS u32x4v*)(tl + cr * 72 + t8) = *(const u32x4v*)(src + (size_t)cr * ld + t8); }
        __syncthreads();
        { const int tr = tid >> 3, c8 = (tid & 7) * 8; u32x4v w;
          w.x = (unsigned)tl[(c8 + 0) * 72 + tr] | ((unsigned)tl[(c8 + 1) * 72 + tr] << 16); w.y = (unsigned)tl[(c8 + 2) * 72 + tr] | ((unsigned)tl[(c8 + 3) * 72 + tr] << 16);
          w.z = (unsigned)tl[(c8 + 4) * 72 + tr] | ((unsigned)tl[(c8 + 5) * 72 + tr] << 16); w.w = (unsigned)tl[(c8 + 6) * 72 + tr] | ((unsigned)tl[(c8 + 7) * 72 + tr] << 16);
          *(u32x4v*)(y + ((size_t)b * TPB + tt * 64 + tr) * D + ct * 64 + c8) = w; }
        __syncthreads();
    }
}

constexpr size_t OFF_XM = OFF_R1, OFF_XC = OFF_R1 + 132 * MiB, OFF_S = WS_NEED, OFF_MLM = OFF_S + 34 * MiB, WS_NEED2 = OFF_MLM + 1 * MiB;
__device__ __forceinline__ u16* hb_ptr(KPC kp, int T) { const int b = T / TPB, t = T - b * TPB;
    return t < CTX ? (u16*)(kp->ws + OFF_HBC) + ((size_t)b * CTX + t) * INNER : (u16*)kp->out + ((size_t)b * SEQ + (t - CTX)) * INNER; }
__device__ __forceinline__ void bd8(const float (&x)[8], const float (&w)[32], float (&y)[8]) {
#pragma unroll
    for (int bl = 0; bl < 2; ++bl)
#pragma unroll
        for (int e = 0; e < 4; ++e) { float s = 0.f;
#pragma unroll
            for (int d = 0; d < 4; ++d) s += x[bl * 4 + d] * w[bl * 16 + d * 4 + e];
            y[bl * 4 + e] = s; }
}
typedef float f32x8s __attribute__((ext_vector_type(8)));
__device__ __forceinline__ void sload32(const float* p, float (&w)[32]) {
    f32x8s a, b, c, d;
    asm volatile("s_load_dwordx8 %0, %4, 0x0\n\ts_load_dwordx8 %1, %4, 0x20\n\ts_load_dwordx8 %2, %4, 0x40\n\ts_load_dwordx8 %3, %4, 0x60\n\ts_waitcnt lgkmcnt(0)"
                 : "=&s"(a), "=&s"(b), "=&s"(c), "=&s"(d) : "s"(p) : "memory");
#pragma unroll
    for (int i = 0; i < 8; ++i) { w[i] = a[i]; w[8 + i] = b[i]; w[16 + i] = c[i]; w[24 + i] = d[i]; }
}
__device__ __forceinline__ void ldw32(const float* p, float (&w)[32]) {
#pragma unroll
    for (int i = 0; i < 8; ++i) { const f32x4 v = *(const f32x4*)(p + i * 4); w[i * 4] = v[0]; w[i * 4 + 1] = v[1]; w[i * 4 + 2] = v[2]; w[i * 4 + 3] = v[3]; } }

__device__ __forceinline__ void ml_m_phase(KPC kp, int j) {
    float* M = (float*)(kp->ws + OFF_MLM) + (size_t)j * 8192;
    const float* wq = kp->in[I_MLWQ] + (size_t)j * 512 * 16; const float* wk = kp->in[I_MLWK] + (size_t)j * 512 * 16;
    for (int i = lbid() * 512 + ltid(); i < 512 * 16; i += gridDim.x * 512) { const int blk = i >> 4, d = (i >> 2) & 3, d2 = i & 3; float s = 0.f;
#pragma unroll
        for (int e = 0; e < 4; ++e) s += wq[blk * 16 + d * 4 + e] * wk[blk * 16 + d2 * 4 + e];
        M[i] = s * 0.04419417382415922f; }
}

__device__ __forceinline__ void ml_prep_task(KPC kp, int j, int task, LAS unsigned char* lds) {
    const int tid = ltid(), lane = tid & 63, wv = tid >> 6, fr = lane & 15, fq = lane >> 4;
    const int hd = task & 3, bc = task >> 2, b = bc / NCH, ci = bc - b * NCH;
    const u16* xm = (const u16*)(kp->ws + OFF_XM); u16* xc = (u16*)(kp->ws + OFF_XC);
    const int T0 = b * TPB + ci * 64, tlo = b * TPB + (ci < 4 ? 0 : CTX), thi = b * TPB + (ci < 4 ? CTX - 1 : TPB - 1);
    const int ch0 = hd * DH + lane * 8;
    LAS u16* QS = (LAS u16*)lds; LAS u16* KS = (LAS u16*)(lds + 66560);
    const float* cw = kp->in[I_MLCW] + (size_t)j * 3 * INNER; const float* cb = kp->in[I_MLCB] + (size_t)j * INNER;
    __syncthreads();
    {
        float cwa[8], cwb[8], cwc[8], cbb[8], wq[32], wk[32];
#pragma unroll
        for (int e = 0; e < 8; ++e) { cwa[e] = cw[ch0 + e]; cwb[e] = cw[INNER + ch0 + e]; cwc[e] = cw[2 * INNER + ch0 + e]; cbb[e] = cb[ch0 + e]; }
        ldw32(kp->in[I_MLWQ] + ((size_t)j * 512 + (ch0 >> 2)) * 16, wq); ldw32(kp->in[I_MLWK] + ((size_t)j * 512 + (ch0 >> 2)) * 16, wk);
        for (int r = 0; r < 8; ++r) { const int jj = wv + 8 * r, T = T0 + jj; const u16* p = xm + (size_t)T * INNER + ch0;
            float x0[8], xa[8], xb[8], xcv[8], q[8], k[8];
            unpack8(*(const u32x4v*)p, x0);
            if (T > tlo) unpack8(*(const u32x4v*)(p - INNER), xa); else {
#pragma unroll
                for (int e = 0; e < 8; ++e) xa[e] = 0.f; }
            if (T < thi) unpack8(*(const u32x4v*)(p + INNER), xb); else {
#pragma unroll
                for (int e = 0; e < 8; ++e) xb[e] = 0.f; }
#pragma unroll
            for (int e = 0; e < 8; ++e) xcv[e] = siluf(cwa[e] * xa[e] + cwb[e] * x0[e] + cwc[e] * xb[e] + cbb[e]);
            const u32x4v xw = pack8(xcv); *(u32x4v*)(xc + (size_t)T * INNER + ch0) = xw; unpack8(xw, xcv);
            bd8(xcv, wq, q); bd8(xcv, wk, k);
            *(LAS u32x4v*)(QS + jj * 520 + lane * 8) = pack8(q); *(LAS u32x4v*)(KS + jj * 520 + lane * 8) = pack8(k); }
    }
    __syncthreads();
    const u16* wg = (const u16*)(kp->ws + OFF_WB + WB_WGT);
    const int mt = wv & 3, kh = wv >> 2;
    { f32x4 s0 = {0.f, 0.f, 0.f, 0.f}, s1 = {0.f, 0.f, 0.f, 0.f}; const int nt0 = kh * 2;
      for (int ks = 0; ks < 16; ++ks) { const bf16x8 a = *(const LAS bf16x8*)(QS + (16 * mt + fr) * 520 + 32 * ks + 8 * fq);
          const bf16x8 b0 = *(const LAS bf16x8*)(KS + (16 * nt0 + fr) * 520 + 32 * ks + 8 * fq), b1 = *(const LAS bf16x8*)(KS + (16 * (nt0 + 1) + fr) * 520 + 32 * ks + 8 * fq);
          s0 = __builtin_amdgcn_mfma_f32_16x16x32_bf16(a, b0, s0, 0, 0, 0); s1 = __builtin_amdgcn_mfma_f32_16x16x32_bf16(a, b1, s1, 0, 0, 0); }
      float* S = (float*)(kp->ws + OFF_S) + ((size_t)(b * 4 + hd) * NCH + ci) * 4096;
#pragma unroll
      for (int r = 0; r < 4; ++r) { S[(16 * mt + 4 * fq + r) * 64 + 16 * nt0 + fr] = s0[r]; S[(16 * mt + 4 * fq + r) * 64 + 16 * (nt0 + 1) + fr] = s1[r]; } }
    f32x4 ga = {0.f, 0.f, 0.f, 0.f};
    for (int ks = kh * 8; ks < kh * 8 + 8; ++ks) { const int kk = hd * DH + 32 * ks + 8 * fq;
        const bf16x8 a = *(const LAS bf16x8*)(QS + (16 * mt + fr) * 520 + 32 * ks + 8 * fq), a2 = *(const LAS bf16x8*)(KS + (16 * mt + fr) * 520 + 32 * ks + 8 * fq);
        const bf16x8 bq = *(const bf16x8*)(wg + (size_t)fr * 6144 + kk), bk = *(const bf16x8*)(wg + (size_t)fr * 6144 + INNER + kk);
        ga = __builtin_amdgcn_mfma_f32_16x16x32_bf16(a, bq, ga, 0, 0, 0); ga = __builtin_amdgcn_mfma_f32_16x16x32_bf16(a2, bk, ga, 0, 0, 0); }
    __syncthreads();
    {
        float wvv[32]; ldw32(kp->in[I_MLWV] + ((size_t)j * 512 + (ch0 >> 2)) * 16, wvv);
        for (int r = 0; r < 8; ++r) { const int jj = wv + 8 * r, T = T0 + jj; float x0[8], v[8]; unpack8(*(const u32x4v*)(xm + (size_t)T * INNER + ch0), x0); bd8(x0, wvv, v);
            *(LAS u32x4v*)(QS + jj * 520 + lane * 8) = pack8(v); }
    }
    __syncthreads();
    for (int ks = kh * 8; ks < kh * 8 + 8; ++ks) { const int kk = hd * DH + 32 * ks + 8 * fq;
        const bf16x8 a = *(const LAS bf16x8*)(QS + (16 * mt + fr) * 520 + 32 * ks + 8 * fq); const bf16x8 bv = *(const bf16x8*)(wg + (size_t)fr * 6144 + 2 * INNER + kk);
        ga = __builtin_amdgcn_mfma_f32_16x16x32_bf16(a, bv, ga, 0, 0, 0); }
    float* gates = (float*)(kp->ws + OFF_GATES);
#pragma unroll
    for (int r = 0; r < 4; ++r) atomicAdd(gates + (size_t)(T0 + 16 * mt + 4 * fq + r) * 16 + fr, ga[r]);
}

__device__ __forceinline__ void tr_store8(LAS unsigned char* base, int d0, const unsigned (&w)[4], int lane) {
    const int odd = lane & 1, sp = lane & ~1;
#pragma unroll
    for (int i = 0; i < 4; ++i) { const unsigned pw = (unsigned)__builtin_amdgcn_update_dpp(0, (int)w[i], 0xB1, 0xF, 0xF, false);
        const unsigned ow = odd ? ((pw >> 16) | (w[i] & 0xffff0000u)) : ((w[i] & 0xffffu) | (pw << 16)); const int d = d0 + 2 * i + odd;
        *(LAS unsigned*)(base + d * 128 + ((((sp >> 3) ^ (d & 7)) << 4) | ((sp & 7) << 1))) = ow; }
}
#ifndef REP_STAGE
#define REP_STAGE 1
#define REP_STILDE 1
#define REP_MFMA 1
#endif
constexpr int SC_QS = 0, SC_KT = 66560, SC_VT = 132096, SC_ST = 140288, SC_XB = 148480, SC_VEC = 156672;
__device__ __forceinline__ void ml_scan_task(KPC kp, int j, int task, LAS unsigned char* lds) {
    const int tid = ltid(), lane = tid & 63, wv = tid >> 6, fr = lane & 15, fq = lane >> 4;
    const int es = task & 7, dir = (task >> 3) & 1, hd = (task >> 4) & 3, b = task >> 6;
    const u16* xm = (const u16*)(kp->ws + OFF_XM); const u16* xc = (const u16*)(kp->ws + OFF_XC); const float* gates = (const float*)(kp->ws + OFF_GATES);
    const float* Sg = (const float*)(kp->ws + OFF_S) + (size_t)(b * 4 + hd) * NCH * 4096;
    u16* hf = (u16*)(kp->ws + OFF_R2);
    LAS unsigned char* QS = lds + SC_QS; LAS unsigned char* KT = lds + SC_KT; LAS unsigned char* VT = lds + SC_VT; LAS unsigned char* ST = lds + SC_ST; LAS unsigned char* XB = lds + SC_XB;
    LAS float* rowterm = (LAS float*)(lds + SC_VEC); LAS float* colterm = rowterm + 64; LAS float* winter = rowterm + 128; LAS float* einv = rowterm + 192;
    LAS float* kws = rowterm + 256; LAS float* dinv = rowterm + 320; LAS float* nst = rowterm + 384; LAS float* scal = rowterm + 896;
    f32x4 C[16];
#pragma unroll
    for (int i = 0; i < 16; ++i) C[i] = (f32x4){0.f, 0.f, 0.f, 0.f};
    float m_st = 0.f;
    __syncthreads();
    nst[tid] = 0.f;
    float pg_ic = 0.f, pg_fp = 0.f;
    if (wv == 0) { const int tn = dir == 0 ? lane : CTX - 1 - lane; const int Tg = b * TPB + tn; pg_ic = gates[(size_t)Tg * 16 + dir * 8 + hd]; pg_fp = gates[(size_t)Tg * 16 + dir * 8 + 4 + hd]; }
    for (int ci = 0; ci < NCH; ++ci) {
        __syncthreads();
        const int p0 = ci * 64;
        const int tid = ltid(), lane = tid & 63, wv = tid >> 6, fr = lane & 15, fq = lane >> 4;
        asm volatile("" ::: "memory");
        auto tok = [&](int jj) -> int { const int p = p0 + jj; const int t = dir == 0 ? p : (p < CTX ? CTX - 1 - p : TPB + CTX - 1 - p); return b * TPB + t; };
        float sv[8];
        { const int jj = tid >> 3, s8 = (tid & 7) * 8;
            if (dir == 0) { const float* sp = Sg + (size_t)ci * 4096 + jj * 64 + s8; const f32x4 v0 = *(const f32x4*)sp, v1 = *(const f32x4*)(sp + 4);
                sv[0] = v0[0]; sv[1] = v0[1]; sv[2] = v0[2]; sv[3] = v0[3]; sv[4] = v1[0]; sv[5] = v1[1]; sv[6] = v1[2]; sv[7] = v1[3]; }
            else { const int oc = ci < 4 ? 3 - ci : 135 - ci; const float* sp = Sg + (size_t)oc * 4096 + (63 - jj) * 64 + (56 - s8); const f32x4 v0 = *(const f32x4*)sp, v1 = *(const f32x4*)(sp + 4);
                sv[7] = v0[0]; sv[6] = v0[1]; sv[5] = v0[2]; sv[4] = v0[3]; sv[3] = v1[0]; sv[2] = v1[1]; sv[1] = v1[2]; sv[0] = v1[3]; }
        }
        const float g_ic = pg_ic, g_fp = pg_fp;
        if (wv == 0 && ci + 1 < NCH) { const int pn = p0 + 64 + lane; const int tn = dir == 0 ? pn : (pn < CTX ? CTX - 1 - pn : TPB + CTX - 1 - pn); const int Tg = b * TPB + tn;
            pg_ic = gates[(size_t)Tg * 16 + dir * 8 + hd]; pg_fp = gates[(size_t)Tg * 16 + dir * 8 + 4 + hd]; }
        for (int rpS = 0; rpS < REP_STAGE; ++rpS) {
        const int wvu = __builtin_amdgcn_readfirstlane(wv); const int Tl = tok(lane);
        for (int r = 0; r < 8; ++r) { const int g8 = wvu * 8 + r; float x[8], q[8], Mw[32];
            const u32x4v xw = *(const u32x4v*)(xc + (size_t)Tl * INNER + hd * DH + g8 * 8); unpack8(xw, x);
            sload32((const float*)(kp->ws + OFF_MLM) + (size_t)j * 8192 + (size_t)(hd * 128 + g8 * 2) * 16, Mw); bd8(x, Mw, q);
            *(LAS u32x4v*)(QS + lane * 1040 + g8 * 16) = pack8(q);
            const unsigned wd[4] = {xw.x, xw.y, xw.z, xw.w}; tr_store8(KT, g8 * 8, wd, lane); }
        { const int g = wvu; const int chv = hd * DH + es * 64 + g * 8; float x[8], v[8], wvv[32];
            unpack8(*(const u32x4v*)(xm + (size_t)Tl * INNER + chv), x); sload32(kp->in[I_MLWV] + ((size_t)j * 512 + (chv >> 2)) * 16, wvv); bd8(x, wvv, v);
            { const u32x4v vw = pack8(v); const unsigned wd[4] = {vw.x, vw.y, vw.z, vw.w}; tr_store8(VT, g * 8, wd, lane); } }
        }
        if (wv == 0) {
            const float ic = g_ic, fp = g_fp;
            const float lf = fminf(fp, 0.f) - log1pf(__expf(-fabsf(fp)));
            float bb = lf;
#pragma unroll
            for (int o = 1; o < 64; o <<= 1) { const float t = lshfl(bb, lane - o); if (lane >= o) bb += t; }
            const float uu = ic - bb; float pm = uu;
#pragma unroll
            for (int o = 1; o < 64; o <<= 1) { const float t = lshfl(pm, lane - o); if (lane >= o) pm = fmaxf(pm, t); }
            const float a = bb + m_st, mj = fmaxf(a, bb + pm);
            rowterm[lane] = bb - mj; colterm[lane] = uu; winter[lane] = __expf(a - mj); einv[lane] = __expf(-mj);
            const float blast = lshfl(bb, 63), gs = blast - bb + ic, gmax = wave_max(gs), mnew = fmaxf(blast + m_st, gmax);
            kws[lane] = __expf(gs - mnew);
            if (lane == 0) { scal[0] = __expf(blast + m_st - mnew); scal[1] = mnew; }
        }
        __syncthreads();
        for (int rpT = 0; rpT < REP_STILDE; ++rpT) {
            const int jj = tid >> 3, sub = tid & 7, s8 = sub * 8;
            const float rt = rowterm[jj]; float rsum = 0.f;
            const f32x4 ct0 = *(const LAS f32x4*)(colterm + s8), ct1 = *(const LAS f32x4*)(colterm + s8 + 4); const float ctv[8] = {ct0[0], ct0[1], ct0[2], ct0[3], ct1[0], ct1[1], ct1[2], ct1[3]};
#pragma unroll
            for (int e = 0; e < 8; ++e) { const int s = s8 + e; const float w = s <= jj ? sv[e] * 0.04419417382415922f * __expf(rt + ctv[e]) : 0.f; sv[e] = w; rsum += w; }
            *(LAS u32x4v*)(ST + jj * 128 + ((sub ^ (jj & 7)) << 4)) = pack8(sv);
            float qd = 0.f;
#pragma unroll
            for (int c8 = 0; c8 < 8; ++c8) { float qv[8]; unpack8(*(const LAS u32x4v*)(QS + jj * 1040 + (sub * 8 + c8) * 16), qv);
                { const f32x4 n0 = *(const LAS f32x4*)(nst + sub * 64 + c8 * 8), n1 = *(const LAS f32x4*)(nst + sub * 64 + c8 * 8 + 4);
                  qd += qv[0] * n0[0] + qv[1] * n0[1] + qv[2] * n0[2] + qv[3] * n0[3] + qv[4] * n1[0] + qv[5] * n1[1] + qv[6] * n1[2] + qv[7] * n1[3]; } }
            rsum += lshfl(rsum, lane ^ 1); rsum += lshfl(rsum, lane ^ 2); rsum += lshfl(rsum, lane ^ 4);
            qd += lshfl(qd, lane ^ 1); qd += lshfl(qd, lane ^ 2); qd += lshfl(qd, lane ^ 4);
            if (sub == 0) { const float qn = winter[jj] * qd + rsum; dinv[jj] = 1.0f / fmaxf(fabsf(qn), einv[jj]); }
        }
        __syncthreads();
        {
            f32x4 o[4];
            const int et = wv & 3, dh = wv >> 2, el = 16 * et + fr;
            bf16x8 vfr[2];
#pragma unroll
            for (int mt = 0; mt < 4; ++mt) o[mt] = (f32x4){0.f, 0.f, 0.f, 0.f};
#pragma unroll
            for (int ks = 0; ks < 8; ++ks) {
                u32x4v bw; bw.x = pg8::cvt_pk_bf16(C[2 * ks][0], C[2 * ks][1]); bw.y = pg8::cvt_pk_bf16(C[2 * ks][2], C[2 * ks][3]);
                bw.z = pg8::cvt_pk_bf16(C[2 * ks + 1][0], C[2 * ks + 1][1]); bw.w = pg8::cvt_pk_bf16(C[2 * ks + 1][2], C[2 * ks + 1][3]);
                const bf16x8 bfr = __builtin_bit_cast(bf16x8, bw);
#pragma unroll
                for (int mt = 0; mt < 4; ++mt) { const int off = (16 * mt + fr) * 1040 + 8 * fq + dh * 512;
                    const u32x2 lo = *(const LAS u32x2*)(QS + off + 64 * ks), hi = *(const LAS u32x2*)(QS + off + 64 * ks + 32);
                    u32x4v aw; aw.x = lo.x; aw.y = lo.y; aw.z = hi.x; aw.w = hi.y;
                    o[mt] = __builtin_amdgcn_mfma_f32_16x16x32_bf16(bfr, __builtin_bit_cast(bf16x8, aw), o[mt], 0, 0, 0); }
                if ((ks & 1) == 1) __builtin_amdgcn_sched_barrier(0); }
#pragma unroll
            for (int mt = 0; mt < 4; ++mt)
#pragma unroll
                for (int r = 0; r < 4; ++r) o[mt][r] *= winter[16 * mt + fr];
#pragma unroll
            for (int k2 = 0; k2 < 2; ++k2) vfr[k2] = *(const LAS bf16x8*)(VT + el * 128 + (((4 * k2 + fq) ^ (el & 7)) << 4));
            if (dh == 1) {
#pragma unroll
                for (int mt = 0; mt < 4; ++mt) { u32x2 w; w.x = pg8::cvt_pk_bf16(o[mt][0], o[mt][1]); w.y = pg8::cvt_pk_bf16(o[mt][2], o[mt][3]); *(LAS u32x2*)(XB + ((et * 4 + mt) * 64 + lane) * 8) = w; }
            } else {
#pragma unroll
                for (int k2 = 0; k2 < 2; ++k2)
#pragma unroll
                    for (int mt = 0; mt < 4; ++mt) { const int jr = 16 * mt + fr; const bf16x8 a = *(const LAS bf16x8*)(ST + jr * 128 + (((4 * k2 + fq) ^ (jr & 7)) << 4));
                        o[mt] = __builtin_amdgcn_mfma_f32_16x16x32_bf16(vfr[k2], a, o[mt], 0, 0, 0); }
            }
            __syncthreads();
            if (dh == 0) {
#pragma unroll
                for (int mt = 0; mt < 4; ++mt) { const u32x2 pw = *(const LAS u32x2*)(XB + ((et * 4 + mt) * 64 + lane) * 8);
                    const int jr = 16 * mt + fr, T = tok(jr); const float di = dinv[jr];
                    const float o0 = (o[mt][0] + bflo(pw.x)) * di, o1 = (o[mt][1] + bfhi(pw.x)) * di, o2 = (o[mt][2] + bflo(pw.y)) * di, o3 = (o[mt][3] + bfhi(pw.y)) * di;
                    u16* dst = dir == 0 ? hf + (size_t)T * INNER : hb_ptr(kp, T); u32x2 w; w.x = pg8::cvt_pk_bf16(o0, o1); w.y = pg8::cvt_pk_bf16(o2, o3);
                    *(u32x2*)(dst + hd * DH + es * 64 + 16 * et + 4 * fq) = w; }
            }
            const float decay = scal[0];
#pragma unroll
            for (int i = 0; i < 16; ++i) C[i] = C[i] * decay;
            float kwv[2][8];
#pragma unroll
            for (int k2 = 0; k2 < 2; ++k2) { const f32x4 k0 = *(const LAS f32x4*)(kws + 32 * k2 + 8 * fq), k1 = *(const LAS f32x4*)(kws + 32 * k2 + 8 * fq + 4);
                kwv[k2][0] = k0[0]; kwv[k2][1] = k0[1]; kwv[k2][2] = k0[2]; kwv[k2][3] = k0[3]; kwv[k2][4] = k1[0]; kwv[k2][5] = k1[1]; kwv[k2][6] = k1[2]; kwv[k2][7] = k1[3]; }
#pragma unroll
            for (int k2 = 0; k2 < 2; ++k2) { float vv[8]; unpack8(__builtin_bit_cast(u32x4v, vfr[k2]), vv);
#pragma unroll
                for (int e = 0; e < 8; ++e) vv[e] *= kwv[k2][e];
                const bf16x8 bsc = __builtin_bit_cast(bf16x8, pack8(vv));
#pragma unroll
                for (int dt = 0; dt < 16; ++dt) { const int dr = 256 * (wv >> 2) + 16 * dt + fr; const bf16x8 a = *(const LAS bf16x8*)(KT + dr * 128 + (((4 * k2 + fq) ^ (dr & 7)) << 4));
                    C[dt] = __builtin_amdgcn_mfma_f32_16x16x32_bf16(a, bsc, C[dt], 0, 0, 0);
                    if ((dt & 7) == 7) __builtin_amdgcn_sched_barrier(0); } }
            { float nn = decay * nst[tid];
#pragma unroll
              for (int g = 0; g < 8; ++g) { float kv[8]; unpack8(*(const LAS u32x4v*)(KT + tid * 128 + ((g ^ (tid & 7)) << 4)), kv);
                  { const f32x4 k0 = *(const LAS f32x4*)(kws + 8 * g), k1 = *(const LAS f32x4*)(kws + 8 * g + 4); nn += kv[0] * k0[0] + kv[1] * k0[1] + kv[2] * k0[2] + kv[3] * k0[3] + kv[4] * k1[0] + kv[5] * k1[1] + kv[6] * k1[2] + kv[7] * k1[3]; } }
              nst[tid] = nn; }
            m_st = scal[1];
        }
    }
}

__device__ __forceinline__ void ml_gate_phase(KPC kp, int j) {
    u16* hf = (u16*)(kp->ws + OFF_R2); const u16* xc = (const u16*)(kp->ws + OFF_XC); const u16* z = (const u16*)(kp->ws + OFF_XM);
    const float* ng = kp->in[I_MLNG] + (size_t)j * INNER; const float* sk = kp->in[I_MLSKIP] + (size_t)j * INNER;
    const int lane = ltid() & 63, wv = ltid() >> 6;
    for (int T = lbid() * 8 + wv; T < NTOK; T += gridDim.x * 8) {
        const u16* hbp = hb_ptr(kp, T);
#pragma unroll
        for (int hd = 0; hd < 4; ++hd) { const int c0 = hd * DH + lane * 8; float a[8], bq[8], xv[8], zv[8], o[8];
            unpack8(*(const u32x4v*)(hf + (size_t)T * INNER + c0), a); unpack8(*(const u32x4v*)(hbp + c0), bq);
            float s = 0.f;
#pragma unroll
            for (int e = 0; e < 8; ++e) { a[e] += bq[e]; s += a[e]; }
            const float mu = wave_sum(s) * (1.0f / DH); float vs = 0.f;
#pragma unroll
            for (int e = 0; e < 8; ++e) { a[e] -= mu; vs += a[e] * a[e]; }
            const float rs = rsqrtf(wave_sum(vs) * (1.0f / DH) + 1e-5f);
            unpack8(*(const u32x4v*)(xc + (size_t)T * INNER + c0), xv); unpack8(*(const u32x4v*)(z + (size_t)T * INNER + c0), zv);
            const f32x4 n0 = *(const f32x4*)(ng + c0), n1 = *(const f32x4*)(ng + c0 + 4), s0 = *(const f32x4*)(sk + c0), s1 = *(const f32x4*)(sk + c0 + 4);
            const float ngv[8] = {n0[0], n0[1], n0[2], n0[3], n1[0], n1[1], n1[2], n1[3]}, skv[8] = {s0[0], s0[1], s0[2], s0[3], s1[0], s1[1], s1[2], s1[3]};
#pragma unroll
            for (int e = 0; e < 8; ++e) o[e] = (a[e] * rs * ngv[e] + skv[e] * xv[e]) * siluf(zv[e]);
            *(u32x4v*)(hf + (size_t)T * INNER + c0) = pack8(o); }
    }
}


enum { K_SETUP = 0, K_CN, K_G1, K_G2R, K_HYIN, K_HYCONV, K_HYTR, K_MLUPX, K_MLPREP, K_MLSCAN, K_MLUPZ, K_MLGATE, K_FINAL };
constexpr int NPHASE = 1 + 11 + 13 + 11 + 13 + 1;
__device__ __forceinline__ void decode_phase(int ph, int& kind, int& l, int& arg) {
    kind = K_SETUP; l = 0; arg = 0; if (ph == 0) return;
    ph -= 1;
    for (l = 0; l < 4; ++l) { const int n = (l & 1) ? 13 : 11; if (ph < n) break; ph -= n; }
    if (l == 4) { kind = K_FINAL; l = 0; return; }
    if (ph == 0) { kind = K_CN; arg = 0; return; } if (ph == 1) { kind = K_G1; arg = 0; return; } if (ph == 2) { kind = K_G2R; arg = 0; return; } if (ph == 3) { kind = K_CN; arg = 1; return; }
    const int nm = (l & 1) ? 6 : 4;
    if (ph < 4 + nm) { const int q = ph - 4;
        if (l & 1) { kind = q == 0 ? K_MLUPX : q == 1 ? K_MLPREP : q == 2 ? K_MLSCAN : q == 3 ? K_MLUPZ : q == 4 ? K_MLGATE : K_G2R; arg = 2; }
        else { kind = q == 0 ? K_HYIN : q == 1 ? K_HYCONV : q == 2 ? K_HYTR : K_G2R; arg = 2; }
        return; }
    ph -= 4 + nm;
    if (ph == 0) { kind = K_CN; arg = 2; return; } if (ph == 1) { kind = K_G1; arg = 1; return; } kind = K_G2R; arg = 1;
}

__device__ __forceinline__ void gbar(unsigned* ctr, unsigned target) {
    __syncthreads();
    if (ltid() == 0) {
        __builtin_amdgcn_fence(__ATOMIC_RELEASE, "agent");
        __hip_atomic_fetch_add(ctr, 1u, __ATOMIC_RELAXED, __HIP_MEMORY_SCOPE_AGENT);
        while (__hip_atomic_load(ctr, __ATOMIC_RELAXED, __HIP_MEMORY_SCOPE_AGENT) < target) __builtin_amdgcn_s_sleep(2);
        __builtin_amdgcn_fence(__ATOMIC_ACQUIRE, "agent");
    }
    __syncthreads();
}
#ifndef REPMASK
#define REPMASK 0
#define REPN 1
#endif
template <int MIX> __device__ __forceinline__ void run_phases(int lo, int hi, int ph_lo, int ph_hi, LAS unsigned char* lds0, cg::grid_group& grid) {
    lo = lo > ph_lo ? lo : ph_lo; hi = hi < ph_hi ? hi : ph_hi;
    for (int ph = lo; ph < hi; ++ph) {
        KPC kp = (KPC)__builtin_amdgcn_kernarg_segment_ptr(); asm volatile("" : "+s"(kp) :: "memory");
        LAS unsigned char* lds = lds0; asm volatile("" : "+s"(lds) :: "memory");
        unsigned char* ws = kp->ws; unsigned char* wb = ws + OFF_WB;
        int kind, l, arg; decode_phase(ph, kind, l, arg); const int j = l >> 1;
        const float* modl = (const float*)(ws + OFF_MOD) + (size_t)l * 5 * 9216;
        const int nrep = ((REPMASK >> kind) & 1) ? REPN : 1;
        for (int rep = 0; rep < nrep; ++rep) {
        if (kind == K_SETUP) { if constexpr (MIX == 0) setup_phase(kp, (LAS float*)lds); }
        else if (kind == K_CN) {
            if (arg == 0) { convert_layer(kp, l, (LAS float*)lds); if constexpr (MIX == 1) ml_m_phase(kp, j); }
            if constexpr (MIX == 0) { if (arg == 1) hy_mlp_phase(kp, j); }
            norm_phase(kp, l, arg, arg == 0 ? (l == 0 ? 0 : 11) : arg == 1 ? 11 : (l == 3 ? 0 : (l & 1) ? 8 : 4));
        } else if (kind == K_G1) {
            pg8::Gemm g{(const u16*)(ws + OFF_U), (const u16*)(wb + (arg ? WB_FIN1 : WB_FIN0)), NTOK, 2 * FF, D};
            pg8::StaticOrder S; S.init(g.M, g.N, (int)gridDim.x, lbid(), (l == 3 && arg == 1) ? 1 : 0); EpiSwiglu E{(u16*)(ws + OFF_R1)};
            pg8::gemm_phase<EpiSwiglu, pg8::StaticOrder, false>(lds, g, S, E, nullptr);
        } else if (kind == K_G2R) {
            const u16* gA; const u16* gB; int gK, gidx, gbj = -1;
            if (arg < 2) { gA = (const u16*)(ws + OFF_R1); gB = (const u16*)(wb + (arg ? WB_FOUT1 : WB_FOUT0)); gK = FF; gidx = arg ? 8 : 2; }
            else if (MIX == 1) { gA = (const u16*)(ws + OFF_R2); gB = (const u16*)(wb + WB_MOUT); gK = INNER; gidx = 5; }
            else { gA = (const u16*)(ws + OFF_U); gB = (const u16*)(wb + WB_MOUT); gK = D; gidx = 5; gbj = j; }
            const pg8::Gemm g{gA, gB, NTOK, D, gK, 0}; const EpiResid E{kp, l, gidx, gbj};
            pg8::StaticOrder S; S.init(g.M, g.N, (int)gridDim.x, lbid(), (l == 3 && arg >= 1) ? 1 : 2, g.K / 256);
            pg8::gemm_phase<EpiResid, pg8::StaticOrder, false>(lds, g, S, E, nullptr);
        } else if (kind == K_FINAL) { if constexpr (MIX == 1) final_phase(kp); }
        else if constexpr (MIX == 0) {
            if (kind == K_HYIN) {
                pg8::Gemm g{(const u16*)(wb + WB_MIN), (const u16*)(ws + OFF_U), 3 * D, NTOK, D};
                pg8::StaticOrder S; S.init(g.M, g.N, (int)gridDim.x, lbid());
                EpiProjT E{(u16*)(ws + OFF_R1 + HY_PL), (u16*)(ws + OFF_R1 + HY_PC), kp->in[I_HYBIN] + (size_t)j * 3 * D};
                pg8::gemm_phase<EpiProjT, pg8::StaticOrder, false>(lds, g, S, E, nullptr);
                __syncthreads();
                for (int t = lbid(); t < 2048; t += gridDim.x) hy_filter_task(kp, j, t, (LAS f32x2*)lds, (LAS float*)(lds + 131072));
            } else if (kind == K_HYCONV) {
                for (int t = lbid(); t < 2048; t += gridDim.x) hy_conv_lat(kp, j, t, (LAS f32x2*)lds);
                for (int t = lbid(); t < 1024; t += gridDim.x) hy_conv_ctx(kp, j, t, (LAS float*)lds);
            } else if (kind == K_HYTR) hy_transpose(kp, (LAS u16*)lds);
        } else {
            if (kind == K_MLUPX || kind == K_MLUPZ) {
                const bool zz = kind == K_MLUPZ;
                pg8::Gemm g{(const u16*)(ws + OFF_U), (const u16*)(wb + WB_MIN) + (zz ? (size_t)INNER * D : 0), NTOK, INNER, D};
                pg8::StaticOrder S; S.init(g.M, g.N, (int)gridDim.x, lbid(), (zz && l == 3) ? 1 : 0); EpiBf E{(u16*)(ws + OFF_XM), INNER};
                pg8::gemm_phase<EpiBf, pg8::StaticOrder, false>(lds, g, S, E, nullptr);
            } else if (kind == K_MLPREP) { for (int t = lbid(); t < NB * NCH * 4; t += gridDim.x) ml_prep_task(kp, j, t, lds); }
            else if (kind == K_MLSCAN) { for (int t = lbid(); t < 256; t += gridDim.x) ml_scan_task(kp, j, t, lds); }
            else if (kind == K_MLGATE) ml_gate_phase(kp, j);
        }
        }
        if (ph + 1 < ph_hi) gbar((unsigned*)(kp->ws + OFF_MLM + 65536), (unsigned)(ph + 1 - ph_lo) * gridDim.x);
    }
}

__global__ void __launch_bounds__(512) fwd_megakernel(KP kparg) {
    extern __shared__ __attribute__((aligned(16))) unsigned char shm[];
    LAS unsigned char* lds = (LAS unsigned char*)shm;
    cg::grid_group grid = cg::this_grid();
    grid.sync();
    wtab_init();
    const int ph_lo = kparg.ph_lo, ph_hi = kparg.ph_hi;
    run_phases<0>(0, 12, ph_lo, ph_hi, lds, grid);
    run_phases<1>(12, 25, ph_lo, ph_hi, lds, grid);
    run_phases<0>(25, 36, ph_lo, ph_hi, lds, grid);
    run_phases<1>(36, 50, ph_lo, ph_hi, lds, grid);
}

extern "C" void kernel_launch(void* const* d_in, const int* in_sizes, int n_in, void* d_out, int out_size, void* d_ws, size_t ws_size, hipStream_t stream) {
    static int grid_blocks = 0;
    if (!grid_blocks) {
        int dev = 0, cus = 0, per_cu = 0;
        hipGetDevice(&dev);
        hipDeviceGetAttribute(&cus, hipDeviceAttributeMultiprocessorCount, dev);
        hipFuncSetAttribute((const void*)fwd_megakernel, hipFuncAttributeMaxDynamicSharedMemorySize, LDS_BYTES);
        hipOccupancyMaxActiveBlocksPerMultiprocessor(&per_cu, fwd_megakernel, 512, LDS_BYTES);
        if (per_cu < 1) per_cu = 1;
        grid_blocks = cus * 1;
        if (ws_size < WS_NEED2) fprintf(stderr, "workspace too small: %zu < %zu\n", ws_size, (size_t)WS_NEED2);
    }
    KP hp{};
    for (int i = 0; i < 36; ++i) hp.in[i] = (const float*)d_in[i];
    hp.out = (float*)d_out; hp.ws = (unsigned char*)d_ws; hp.ph_lo = 0; hp.ph_hi = NPHASE;
    void* args[] = {&hp};
    hipMemsetAsync((unsigned char*)d_ws + OFF_MLM + 65536, 0, 256, stream);
    hipError_t e = hipLaunchCooperativeKernel((void*)fwd_megakernel, dim3(grid_blocks), dim3(512), args, LDS_BYTES, stream);
    if (e != hipSuccess) fprintf(stderr, "cooperative launch failed: %s (grid %d)\n", hipGetErrorString(e), grid_blocks);
}
```

```cpp
#define REPMASK 0
#define REPN 1
#include <hip/hip_runtime.h>
#include <hip/hip_cooperative_groups.h>
#include <cstdio>
namespace cg = cooperative_groups;
#define WTAB_OFF 163584
__device__ __forceinline__ int llane() { int l; asm volatile("v_mbcnt_lo_u32_b32 %0, -1, 0\n\tv_mbcnt_hi_u32_b32 %0, -1, %0" : "=v"(l) :: "memory"); return l; }
__device__ __forceinline__ int lwave() { extern __shared__ __attribute__((aligned(16))) unsigned char shm_w[];
    const int hw = __builtin_amdgcn_s_getreg(10244) & 63;
    return __builtin_amdgcn_readfirstlane(*(const __attribute__((address_space(3))) int*)((__attribute__((address_space(3))) unsigned char*)shm_w + WTAB_OFF + hw * 4)); }
__device__ __forceinline__ void wtab_init() { extern __shared__ __attribute__((aligned(16))) unsigned char shm_w[];
    const int hw = __builtin_amdgcn_s_getreg(10244) & 63;
    *(__attribute__((address_space(3))) int*)((__attribute__((address_space(3))) unsigned char*)shm_w + WTAB_OFF + hw * 4) = (int)(threadIdx.x >> 6); }
__device__ __forceinline__ int ltid() { return lwave() * 64 + llane(); }
__device__ __forceinline__ int lbid() { int t = blockIdx.x; asm volatile("" : "+s"(t) :: "memory"); return t; }
namespace pg8 {
#define PG8_LAS __attribute__((address_space(3)))
typedef unsigned short bf16_t;
typedef short bf16x8 __attribute__((ext_vector_type(8)));
typedef float f32x4 __attribute__((ext_vector_type(4)));
typedef unsigned u32x4 __attribute__((ext_vector_type(4)));
constexpr int BM = 256, BK = 64, HALF = 128, HTB = HALF * BK * 2  , STAGE_BYTES = 8 * HTB, NXCD = 8, WGM = 8;

__host__ __device__ __forceinline__ int lds_byte(int r, int c) { const int st = (r >> 4) * 2 + (c >> 5), rr = r & 15, cc = c & 31, ob = rr * 64 + cc * 2; return st * 1024 + (ob ^ (((ob >> 9) & 1) << 5)); }
__host__ __device__ __forceinline__ void stage_rc(int b, int& R, int& C) { const int st = b / 1024, sb = b % 1024, swz = sb ^ (((sb >> 9) & 1) << 5); R = (st >> 1) * 16 + swz / 64; C = (st & 1) * 32 + (swz % 64) / 2; }
__host__ __device__ __forceinline__ int perm32(int rho) { const int n = rho >> 4, i = rho & 15; return 8 * (i >> 2) + 4 * n + (i & 3); }

struct Unit { int pm, pn, kofs, nt; };
struct Gemm { const bf16_t* A; const bf16_t* Bt; int M, N, K, ldk; };

struct StaticOrder {
    int nM, nN, nwg, G, c, lat, nk;
    __host__ __device__ void init(int M, int N, int G_, int c_, int lat_ = 0, int nk_ = 0) { lat = lat_; nk = nk_; nM = lat ? 128 : M / BM; nN = N / BM; nwg = nM * nN; G = G_; c = c_; }
    __host__ __device__ bool next(int i, Unit& u) const {
        const long L = (long)i * G + c;
        if (L >= nwg) { if (lat != 2 || L >= nwg + 16 * nk) return false; const int Lc = (int)L - nwg, un = Lc & 15; u.pm = (un >> 2) * 33; u.pn = un & 3; u.kofs = (Lc >> 4) * 256; u.nt = 4; return true; }
        int wgid = (int)L; { const int q = nwg / NXCD, r = nwg % NXCD, xcd = wgid % NXCD, off = wgid / NXCD; wgid = (xcd < r ? xcd * (q + 1) : r * (q + 1) + (xcd - r) * q) + off; }
        const int nig = WGM * nN, gid = wgid / nig, fm = gid * WGM, gsz = (nM - fm) < WGM ? (nM - fm) : WGM;
        u.pm = fm + ((wgid % nig) % gsz); u.pn = (wgid % nig) / gsz; u.kofs = 0; u.nt = 0; if (lat) u.pm = (u.pm >> 5) * 33 + 1 + (u.pm & 31); return true;
    }
    __device__ __forceinline__ void a_ready(const Unit&) const {}
    __device__ __forceinline__ void done(const Unit&) const {}
};
__device__ __forceinline__ unsigned cvt_pk_bf16(float lo, float hi) { unsigned r; asm volatile("v_cvt_pk_bf16_f32 %0, %1, %2" : "=v"(r) : "v"(lo), "v"(hi)); return r; }
template <class Epi, class Sched, bool STAMP = false>
__device__ __forceinline__ void gemm_phase(PG8_LAS unsigned char* lds, const Gemm g, const Sched& S, const Epi& E, unsigned long long* stamps) {
    const int tid = ltid(), wid = __builtin_amdgcn_readfirstlane(tid >> 6), lane = tid & 63, wr = wid >> 2, wc = wid & 3, fr = lane & 15, fq = lane >> 4;
    const int K = g.K, nt = K / BK, ldk = g.ldk ? g.ldk : g.K;
    int ts_lo = 0, ts_hi = 0, nts = 0; const unsigned long long rt_entry = STAMP ? (unsigned long long)wall_clock64() : 0ull;
#define PG8_STAMP() do { if (STAMP && wid == 0 && nts < 64) { const unsigned long long _c = (unsigned long long)clock64(); \
        ts_lo = (lane == nts) ? (int)(unsigned)_c : ts_lo; ts_hi = (lane == nts) ? (int)(unsigned)(_c >> 32) : ts_hi; ++nts; } } while (0)
    PG8_STAMP();
    unsigned voffA[2], voffB[2];
#pragma unroll
    for (int i = 0; i < 2; ++i) { int R, C; stage_rc(tid * 16 + i * 8192, R, C); const int Rb = Epi::PERM ? ((R & ~31) + perm32(R & 31)) : R;
        voffA[i] = (unsigned)(R * ldk + C) * 2u; voffB[i] = (unsigned)(Rb * ldk + C) * 2u; }
    const size_t kstep = (size_t)(BK * 2);
    const size_t hstep = (size_t)HALF * ldk * 2;
    const size_t tstep = 2 * hstep;
    const unsigned ldsw = (unsigned)wid * 1024u;
    const int aoff = lds_byte(wr * 64 + fr, fq * 8), boff = lds_byte(wc * 32 + fr, fq * 8);
#define PG8_SA(b, h) (((b) * 2 + (h)) * HTB)
#define PG8_SB(b, h) ((4 + (b) * 2 + (h)) * HTB)
#define PG8_STAGE(bufoff, gbase, voff) do { _Pragma("unroll") for (int _i = 0; _i < 2; ++_i) \
        __builtin_amdgcn_global_load_lds((const unsigned*)((const char*)(gbase) + (voff)[_i]), (PG8_LAS unsigned*)(lds + (bufoff) + ldsw + _i * 8192), 16, 0, 0); } while (0)
#define PG8_LDA(dst, b, h) do { _Pragma("unroll") for (int m = 0; m < 4; ++m) _Pragma("unroll") for (int k = 0; k < 2; ++k) dst[m][k] = *(const PG8_LAS bf16x8*)(lds + PG8_SA(b, h) + aoff + m * 2048 + k * 1024); } while (0)
#define PG8_LDB(dst, b, h) do { _Pragma("unroll") for (int n = 0; n < 2; ++n) _Pragma("unroll") for (int k = 0; k < 2; ++k) dst[n][k] = *(const PG8_LAS bf16x8*)(lds + PG8_SB(b, h) + boff + n * 2048 + k * 1024); } while (0)
#define PG8_MMA(ai, bj, At, Bt) do { __builtin_amdgcn_s_setprio(1); _Pragma("unroll") for (int m = 0; m < 4; ++m) _Pragma("unroll") for (int n = 0; n < 2; ++n) _Pragma("unroll") for (int k = 0; k < 2; ++k) \
        acc[ai][bj][m][n] = __builtin_amdgcn_mfma_f32_16x16x32_bf16(Bt[n][k], At[m][k], acc[ai][bj][m][n], 0, 0, 0); __builtin_amdgcn_s_setprio(0); } while (0)
#define PG8_WAIT_V(n) asm volatile("s_waitcnt vmcnt(" #n ")" ::: "memory")
#define PG8_WAIT_L(n) asm volatile("s_waitcnt lgkmcnt(" #n ")" ::: "memory")
#define PG8_BAR __builtin_amdgcn_s_barrier()
#define PG8_SCHED __builtin_amdgcn_sched_barrier(0)
    Unit cur, nxt; int ui = 0;
    if (!S.next(0, cur)) return;
    f32x4 acc[2][2][4][2];
#pragma unroll
    for (int a = 0; a < 2; ++a)
#pragma unroll
        for (int b = 0; b < 2; ++b)
#pragma unroll
            for (int m = 0; m < 4; ++m)
#pragma unroll
                for (int n = 0; n < 2; ++n) acc[a][b][m][n] = (f32x4){0.f, 0.f, 0.f, 0.f};
    bf16x8 At[4][2], B0[2][2], B1[2][2];
    const char* cA = (const char*)g.A + (size_t)cur.pm * tstep + (size_t)cur.kofs * 2; const char* cB = (const char*)g.Bt + (size_t)cur.pn * tstep + (size_t)cur.kofs * 2;
    S.a_ready(cur);
    PG8_STAGE(PG8_SB(0, 0), cB, voffB); PG8_STAGE(PG8_SA(0, 0), cA, voffA); PG8_STAGE(PG8_SB(0, 1), cB + hstep, voffB); PG8_STAGE(PG8_SA(0, 1), cA + hstep, voffA);
    if (wr == 1) PG8_BAR;
    PG8_WAIT_V(4); PG8_BAR;
    PG8_STAGE(PG8_SB(1, 0), cB + kstep, voffB); PG8_STAGE(PG8_SA(1, 0), cA + kstep, voffA); PG8_STAGE(PG8_SB(1, 1), cB + hstep + kstep, voffB);
    PG8_WAIT_V(6); PG8_BAR;
    PG8_STAMP();
    for (;;) {
        const bool has_next = S.next(ui + 1, nxt);
        const char* nA = has_next ? (const char*)g.A + (size_t)nxt.pm * tstep + (size_t)nxt.kofs * 2 : cA; const char* nB = has_next ? (const char*)g.Bt + (size_t)nxt.pn * tstep + (size_t)nxt.kofs * 2 : cB;
        const int ntu = cur.nt ? cur.nt : nt;
        for (int t = 0; t < ntu; t += 2) {
            const bool last = (t == ntu - 2);
            const char* a1 = cA + (size_t)(t + 1) * kstep;
            const char* a2 = last ? nA : cA + (size_t)(t + 2) * kstep; const char* b2 = last ? nB : cB + (size_t)(t + 2) * kstep;
            const char* a3 = a2 + kstep; const char* b3 = b2 + kstep;
            if (last && has_next) S.a_ready(nxt);
            PG8_LDB(B0, 0, 0); PG8_SCHED; PG8_LDA(At, 0, 0); PG8_STAGE(PG8_SA(1, 1), a1 + hstep, voffA);
            PG8_WAIT_L(8); PG8_BAR; PG8_WAIT_L(0); PG8_MMA(0, 0, At, B0); PG8_BAR; PG8_SCHED;
            PG8_LDB(B1, 0, 1); PG8_STAGE(PG8_SB(0, 0), b2, voffB);
            PG8_BAR; PG8_WAIT_L(0); PG8_MMA(0, 1, At, B1); PG8_BAR;
            PG8_LDA(At, 0, 1); PG8_STAGE(PG8_SA(0, 0), a2, voffA);
            PG8_BAR; PG8_WAIT_L(0); PG8_MMA(1, 0, At, B0); PG8_BAR; PG8_SCHED;
            PG8_STAGE(PG8_SB(0, 1), b2 + hstep, voffB);
            PG8_WAIT_V(6); PG8_BAR; PG8_MMA(1, 1, At, B1); PG8_BAR;
            PG8_LDB(B0, 1, 0); PG8_SCHED; PG8_LDA(At, 1, 0); PG8_STAGE(PG8_SA(0, 1), a2 + hstep, voffA);
            PG8_WAIT_L(8); PG8_BAR; PG8_WAIT_L(0); PG8_MMA(0, 0, At, B0); PG8_BAR; PG8_SCHED;
            PG8_LDB(B1, 1, 1); PG8_STAGE(PG8_SB(1, 0), b3, voffB);
            PG8_BAR; PG8_WAIT_L(0); PG8_MMA(0, 1, At, B1); PG8_BAR;
            PG8_LDA(At, 1, 1); PG8_STAGE(PG8_SA(1, 0), a3, voffA);
            PG8_BAR; PG8_WAIT_L(0); PG8_MMA(1, 0, At, B0); PG8_BAR; PG8_SCHED;
            PG8_STAGE(PG8_SB(1, 1), b3 + hstep, voffB);
            PG8_WAIT_V(6); PG8_BAR; PG8_MMA(1, 1, At, B1); PG8_BAR;
        }
        PG8_STAMP();
        if constexpr (!Epi::AFTER_DRAIN) { E(acc, cur, wr, wc, fr, fq); S.done(cur); }
        PG8_STAMP();
        if (!has_next) break;
#pragma unroll
        for (int a = 0; a < 2; ++a)
#pragma unroll
            for (int b = 0; b < 2; ++b)
#pragma unroll
                for (int m = 0; m < 4; ++m)
#pragma unroll
                    for (int n = 0; n < 2; ++n) acc[a][b][m][n] = (f32x4){0.f, 0.f, 0.f, 0.f};
        cur = nxt; cA = nA; cB = nB; ++ui;
    }
    PG8_WAIT_V(0);
    if (wr == 0) PG8_BAR;
    PG8_BAR;
    if constexpr (Epi::AFTER_DRAIN) { E.fused(acc, cur, wr, wc, fr, fq, lds, wid, lane); S.done(cur); }
    PG8_STAMP();
    if (STAMP && wid == 0) { stamps[lane] = lane < nts ? (((unsigned long long)(unsigned)ts_hi << 32) | (unsigned)ts_lo) : 0ull;
        if (lane == 62) stamps[62] = rt_entry; if (lane == 63) stamps[63] = (unsigned long long)wall_clock64(); }
#undef PG8_STAMP
#undef PG8_SA
#undef PG8_SB
#undef PG8_STAGE
#undef PG8_LDA
#undef PG8_LDB
#undef PG8_MMA
#undef PG8_WAIT_V
#undef PG8_WAIT_L
#undef PG8_BAR
#undef PG8_SCHED
}
}

typedef unsigned short u16;
using pg8::f32x4; using pg8::bf16x8;
typedef float f32x2 __attribute__((ext_vector_type(2)));
typedef unsigned u32x2 __attribute__((ext_vector_type(2)));
typedef unsigned u32x4v __attribute__((ext_vector_type(4)));
typedef short s16x4 __attribute__((ext_vector_type(4)));
#define LAS __attribute__((address_space(3)))
constexpr int D = 1024, NB = 4, SEQ = 8192, CTX = 256, TPB = 8448, NTOK = 33792, FF = 2816, NCH = 132, INNER = 2048, DH = 512, NFFT = 16384;
constexpr size_t MiB = 1u << 20;
constexpr size_t OFF_WB = 0, OFF_MOD = 48 * MiB, OFF_H = 49 * MiB, OFF_U = OFF_H + 132 * MiB, OFF_R1 = OFF_U + 66 * MiB, OFF_R2 = OFF_R1 + 264 * MiB,
                 OFF_HBC = OFF_R2 + 132 * MiB, OFF_GATES = OFF_HBC + 4 * MiB, OFF_H2 = OFF_GATES + 3 * MiB, OFF_KCTX = OFF_H2 + 3 * MiB, WS_NEED = OFF_KCTX + 4 * MiB;
constexpr size_t WB_FIN0 = 0, WB_FIN1 = 11 * MiB, WB_FOUT0 = 22 * MiB, WB_FOUT1 = 22 * MiB + 5632 * 1024, WB_MIN = 33 * MiB, WB_MOUT = 41 * MiB, WB_WGT = 45 * MiB;
constexpr int LDS_BYTES = 163840;
struct KP { const float* in[36]; float* out; unsigned char* ws; int ph_lo, ph_hi; };
typedef const KP __attribute__((address_space(4))) * KPC;
enum { I_X = 0, I_C, I_CTX, I_CCTX, I_ADAW, I_ADAB, I_NORMG, I_FINALG, I_FFNIN, I_FFNOUT, I_HYWIN, I_HYBIN, I_HYCW, I_HYCB, I_HYW1, I_HYB1, I_HYW2, I_HYB2, I_HYW3, I_HYB3,
       I_HYFREQ, I_HYDECAY, I_HYSKIP, I_HYWOUT, I_HYBOUT, I_MLUP, I_MLCW, I_MLCB, I_MLWQ, I_MLWK, I_MLWV, I_MLWG, I_MLBG, I_MLNG, I_MLSKIP, I_MLDOWN };

__device__ __forceinline__ float bf2f(u16 b) { return __uint_as_float(((unsigned)b) << 16); }
__device__ __forceinline__ float bflo(unsigned w) { return __uint_as_float(w << 16); }
__device__ __forceinline__ float bfhi(unsigned w) { return __uint_as_float(w & 0xffff0000u); }
__device__ __forceinline__ u16 f2bf(float f) { return (u16)(pg8::cvt_pk_bf16(f, 0.f) & 0xffffu); }
__device__ __forceinline__ float siluf(float x) { return x * __builtin_amdgcn_rcpf(1.0f + __expf(-x)); }
__device__ __forceinline__ int modrow_of_token(int T) { const int b = T / TPB, t = T - b * TPB; return t < CTX ? 4 : b; }
__device__ __forceinline__ float lshfl(float v, int srclane) { return __int_as_float(__builtin_amdgcn_ds_bpermute(srclane << 2, __float_as_int(v))); }
__device__ __forceinline__ float wave_sum(float v) { const int lane = llane();
#pragma unroll
    for (int o = 32; o > 0; o >>= 1) v += lshfl(v, lane ^ o);
    return v; }
__device__ __forceinline__ float wave_max(float v) { const int lane = llane();
#pragma unroll
    for (int o = 32; o > 0; o >>= 1) v = fmaxf(v, lshfl(v, lane ^ o));
    return v; }

__device__ __forceinline__ void unpack8(u32x4v w, float (&f)[8]) { f[0] = bflo(w.x); f[1] = bfhi(w.x); f[2] = bflo(w.y); f[3] = bfhi(w.y); f[4] = bflo(w.z); f[5] = bfhi(w.z); f[6] = bflo(w.w); f[7] = bfhi(w.w); }
__device__ __forceinline__ u32x4v pack8(const float (&f)[8]) { u32x4v w; w.x = pg8::cvt_pk_bf16(f[0], f[1]); w.y = pg8::cvt_pk_bf16(f[2], f[3]); w.z = pg8::cvt_pk_bf16(f[4], f[5]); w.w = pg8::cvt_pk_bf16(f[6], f[7]); return w; }

struct EpiSwiglu {
    static constexpr bool PERM = true, AFTER_DRAIN = false;
    u16* act;
    __device__ __forceinline__ void operator()(const f32x4 (&acc)[2][2][4][2], const pg8::Unit& u, int wr, int wc, int fr, int fq) const {
        const int row0 = u.pm * 256 + wr * 64 + fr, col0 = u.pn * 128 + wc * 32 + 8 * fq;
#pragma unroll
        for (int ai = 0; ai < 2; ++ai)
#pragma unroll
            for (int m = 0; m < 4; ++m) {
                const f32x4 g0 = acc[ai][0][m][0], g1 = acc[ai][0][m][1], v0 = acc[ai][1][m][0], v1 = acc[ai][1][m][1];
                u32x4v w;
                w.x = pg8::cvt_pk_bf16(siluf(g0[0]) * v0[0], siluf(g0[1]) * v0[1]); w.y = pg8::cvt_pk_bf16(siluf(g0[2]) * v0[2], siluf(g0[3]) * v0[3]);
                w.z = pg8::cvt_pk_bf16(siluf(g1[0]) * v1[0], siluf(g1[1]) * v1[1]); w.w = pg8::cvt_pk_bf16(siluf(g1[2]) * v1[2], siluf(g1[3]) * v1[3]);
                *(u32x4v*)(act + (size_t)(row0 + ai * 128 + m * 16) * FF + col0) = w; }
    }
};
struct EpiResid {
    static constexpr bool PERM = false, AFTER_DRAIN = false;
    KPC kp; int l, gidx, bias_j;
    __device__ __forceinline__ void operator()(const f32x4 (&acc)[2][2][4][2], const pg8::Unit& u, int wr, int wc, int fr, int fq) const {
        unsigned char* ws = kp->ws; float* h = (float*)(ws + OFF_H); float* part = (float*)kp->out;
        const float* bias = bias_j >= 0 ? kp->in[I_HYBOUT] + (size_t)bias_j * D : nullptr; const float scale = gidx == 5 ? 1.0f : 0.5f;
        const int col0 = u.pn * 256 + wc * 32 + 4 * fq;
        const int mr = modrow_of_token(u.pm * 256);
        const float* gp = (const float*)(ws + OFF_MOD) + ((size_t)l * 5 + mr) * 9216 + gidx * 1024;
        const bool split = u.nt != 0, addb = bias != nullptr && u.kofs == 0;
        float* base = split ? part + ((size_t)(u.kofs >> 8) * 1024 + (u.pm / 33) * 256 + wr * 64 + fr) * D : h + (size_t)(u.pm * 256 + wr * 64 + fr) * D;
#pragma unroll
        for (int bj = 0; bj < 2; ++bj)
#pragma unroll
            for (int n = 0; n < 2; ++n) { const f32x4 gv = *(const f32x4*)(gp + col0 + bj * 128 + n * 16) * scale;
                const f32x4 bv = addb ? *(const f32x4*)(bias + col0 + bj * 128 + n * 16) : (f32x4){0.f, 0.f, 0.f, 0.f};
#pragma unroll
                for (int ai = 0; ai < 2; ++ai)
#pragma unroll
                    for (int m = 0; m < 4; ++m) { f32x4* q = (f32x4*)(base + (size_t)(ai * 128 + m * 16) * D + col0 + bj * 128 + n * 16); const f32x4 v = gv * (acc[ai][bj][m][n] + bv);
                        if (split) *q = v; else *q = *q + v; } }
    }
};
struct EpiBf {
    static constexpr bool PERM = true, AFTER_DRAIN = false;
    u16* O; int ldc;
    __device__ __forceinline__ void operator()(const f32x4 (&acc)[2][2][4][2], const pg8::Unit& u, int wr, int wc, int fr, int fq) const {
        const int row0 = u.pm * 256 + wr * 64 + fr, col0 = u.pn * 256 + wc * 32 + 8 * fq;
#pragma unroll
        for (int ai = 0; ai < 2; ++ai)
#pragma unroll
            for (int m = 0; m < 4; ++m)
#pragma unroll
                for (int bj = 0; bj < 2; ++bj) { const f32x4 a = acc[ai][bj][m][0], b = acc[ai][bj][m][1]; u32x4v w;
                    w.x = pg8::cvt_pk_bf16(a[0], a[1]); w.y = pg8::cvt_pk_bf16(a[2], a[3]); w.z = pg8::cvt_pk_bf16(b[0], b[1]); w.w = pg8::cvt_pk_bf16(b[2], b[3]);
                    *(u32x4v*)(O + (size_t)(row0 + ai * 128 + m * 16) * ldc + col0 + bj * 128) = w; }
    }
};
struct EpiProjT {
    static constexpr bool PERM = true, AFTER_DRAIN = false;
    u16* lat; u16* ctx; const float* bias;
    __device__ __forceinline__ void operator()(const f32x4 (&acc)[2][2][4][2], const pg8::Unit& u, int wr, int wc, int fr, int fq) const {
        const int row0 = u.pm * 256 + wr * 64 + fr, tc0 = wc * 32 + 8 * fq;
        const int b = u.pn / 33, tile = u.pn - b * 33;
#pragma unroll
        for (int ai = 0; ai < 2; ++ai)
#pragma unroll
            for (int m = 0; m < 4; ++m) { const int ch = row0 + ai * 128 + m * 16; const float bs = bias[ch];
                u16* dst = tile == 0 ? ctx + ((size_t)b * 3072 + ch) * CTX + tc0 : lat + ((size_t)b * 3072 + ch) * SEQ + (tile - 1) * 256 + tc0;
#pragma unroll
                for (int bj = 0; bj < 2; ++bj) { const f32x4 a = acc[ai][bj][m][0] + bs, c = acc[ai][bj][m][1] + bs; u32x4v w;
                    w.x = pg8::cvt_pk_bf16(a[0], a[1]); w.y = pg8::cvt_pk_bf16(a[2], a[3]); w.z = pg8::cvt_pk_bf16(c[0], c[1]); w.w = pg8::cvt_pk_bf16(c[2], c[3]);
                    *(u32x4v*)(dst + bj * 128) = w; } }
    }
};


struct LatOrder : pg8::StaticOrder {
    __device__ bool next(int i, pg8::Unit& u) const { if (!pg8::StaticOrder::next(i, u)) return false; u.pm = (u.pm >> 5) * 33 + 1 + (u.pm & 31); return true; }
};
struct CtxSplitOrder {
    int nk, G, c;
    __device__ bool next(int i, pg8::Unit& u) const { const int L = i * G + c; if (L >= 16 * nk) return false; const int un = L & 15, kc = L >> 4; u.pm = (un >> 2) * 33; u.pn = un & 3; u.kofs = kc * 256; return true; }
    __device__ __forceinline__ void a_ready(const pg8::Unit&) const {}
    __device__ __forceinline__ void done(const pg8::Unit&) const {}
};
struct EpiResidAtomic {
    static constexpr bool PERM = false, AFTER_DRAIN = false;
    float* h; const float* gp; float scale;
    __device__ __forceinline__ void operator()(const f32x4 (&acc)[2][2][4][2], const pg8::Unit& u, int wr, int wc, int fr, int fq) const {
        const int row0 = u.pm * 256 + wr * 64 + fr, col0 = u.pn * 256 + wc * 32 + 4 * fq;
#pragma unroll
        for (int bj = 0; bj < 2; ++bj)
#pragma unroll
            for (int n = 0; n < 2; ++n) { const f32x4 gv = *(const f32x4*)(gp + col0 + bj * 128 + n * 16) * scale;
#pragma unroll
                for (int ai = 0; ai < 2; ++ai)
#pragma unroll
                    for (int m = 0; m < 4; ++m) { float* q = h + (size_t)(row0 + ai * 128 + m * 16) * D + col0 + bj * 128 + n * 16; const f32x4 v = gv * acc[ai][bj][m][n];
                        atomicAdd(q, v[0]); atomicAdd(q + 1, v[1]); atomicAdd(q + 2, v[2]); atomicAdd(q + 3, v[3]); } }
    }
};

__device__ __forceinline__ void ctx_bias_phase(KPC kp, const float* gp, const float* bias) {
    float* h = (float*)(kp->ws + OFF_H);
    for (int i = lbid() * 512 + ltid(); i < NB * CTX * 256; i += gridDim.x * 512) { const int r = i >> 8, c = (i & 255) * 4, b = r >> 8, t = r & 255;
        f32x4* q = (f32x4*)(h + ((size_t)b * TPB + t) * D + c); *q = *q + *(const f32x4*)(gp + c) * *(const f32x4*)(bias + c); }
}
__device__ __forceinline__ int colmap(int n, int mapmode) { return mapmode ? (((n >> 8) << 7) + (n & 127) + ((n >> 7) & 1) * FF) : n; }
__device__ __forceinline__ void convert_T(const float* __restrict__ src, int ld, int K, int Nd, int mapmode, u16* __restrict__ dst, LAS float* tile, int& tctr) {
    const int tid = ltid(), nkt = K / 64, ntile = (Nd / 64) * nkt;
    const int G = (int)gridDim.x; const int first = (((lbid() - tctr) % G) + G) % G; tctr += ntile;
    for (int t = first; t < ntile; t += G) {
        const int n0 = (t / nkt) * 64, k0 = (t % nkt) * 64, c0 = colmap(n0, mapmode);
#pragma unroll
        for (int i = 0; i < 2; ++i) { const int e = tid + 512 * i, kr = e >> 4, c4 = (e & 15) * 4;
            const f32x4 v = *(const f32x4*)(src + (size_t)(k0 + kr) * ld + c0 + c4);
            tile[kr * 65 + c4] = v[0]; tile[kr * 65 + c4 + 1] = v[1]; tile[kr * 65 + c4 + 2] = v[2]; tile[kr * 65 + c4 + 3] = v[3]; }
        __syncthreads();
        { const int n = tid >> 3, k8 = (tid & 7) * 8; u32x4v w;
          w.x = pg8::cvt_pk_bf16(tile[(k8 + 0) * 65 + n], tile[(k8 + 1) * 65 + n]); w.y = pg8::cvt_pk_bf16(tile[(k8 + 2) * 65 + n], tile[(k8 + 3) * 65 + n]);
          w.z = pg8::cvt_pk_bf16(tile[(k8 + 4) * 65 + n], tile[(k8 + 5) * 65 + n]); w.w = pg8::cvt_pk_bf16(tile[(k8 + 6) * 65 + n], tile[(k8 + 7) * 65 + n]);
          *(u32x4v*)(dst + (size_t)(n0 + n) * K + k0 + k8) = w; }
        __syncthreads();
    }
}

__device__ __forceinline__ void norm_phase(KPC kp, int l, int sub, int nkp) {
    const float* h = (const float*)(kp->ws + OFF_H); u16* uo = (u16*)(kp->ws + OFF_U);
    const float* g = kp->in[I_NORMG] + (size_t)(l * 3 + sub) * D; const float* modl = (const float*)(kp->ws + OFF_MOD) + (size_t)l * 5 * 9216;
    const int lane = ltid() & 63, wv = ltid() >> 6;
    for (int T = lbid() * 8 + wv; T < NTOK; T += gridDim.x * 8) {
        const float* hr = h + (size_t)T * D; f32x4 v[4]; float ss = 0.f;
        const int bT = T / TPB, tT = T - bT * TPB; const bool fold = nkp > 0 && tT < CTX;
#pragma unroll
        for (int i = 0; i < 4; ++i) { v[i] = *(const f32x4*)(hr + i * 256 + lane * 4);
            if (fold) { const float* pp = (const float*)kp->out + ((size_t)bT * CTX + tT) * D + i * 256 + lane * 4; for (int kc = 0; kc < nkp; ++kc) v[i] += *(const f32x4*)(pp + (size_t)kc * 1024 * D);
                *(f32x4*)((float*)(kp->ws + OFF_H) + (size_t)T * D + i * 256 + lane * 4) = v[i]; }
            ss += v[i][0] * v[i][0] + v[i][1] * v[i][1] + v[i][2] * v[i][2] + v[i][3] * v[i][3]; }
        ss = wave_sum(ss); const float rs = rsqrtf(ss * (1.0f / D) + 1e-6f);
        const float* mp = modl + (size_t)modrow_of_token(T) * 9216 + sub * 3 * 1024;
#pragma unroll
        for (int i = 0; i < 4; ++i) { const int c = i * 256 + lane * 4; const f32x4 gg = *(const f32x4*)(g + c), sh = *(const f32x4*)(mp + c), sc = *(const f32x4*)(mp + 1024 + c);
            const f32x4 o = v[i] * rs * gg * (sc + 1.0f) + sh; u32x2 w; w.x = pg8::cvt_pk_bf16(o[0], o[1]); w.y = pg8::cvt_pk_bf16(o[2], o[3]);
            *(u32x2*)(uo + (size_t)T * D + c) = w; }
    }
}

__device__ __forceinline__ void final_phase(KPC kp) {
    const float* h = (const float*)(kp->ws + OFF_H); const float* g = kp->in[I_FINALG];
    const int lane = ltid() & 63, wv = ltid() >> 6;
    for (int r = lbid() * 8 + wv; r < NB * SEQ; r += gridDim.x * 8) {
        const int b = r / SEQ, s = r - b * SEQ; const float* hr = h + ((size_t)b * TPB + CTX + s) * D; f32x4 v[4]; float ss = 0.f;
#pragma unroll
        for (int i = 0; i < 4; ++i) { v[i] = *(const f32x4*)(hr + i * 256 + lane * 4); ss += v[i][0] * v[i][0] + v[i][1] * v[i][1] + v[i][2] * v[i][2] + v[i][3] * v[i][3]; }
        ss = wave_sum(ss); const float rs = rsqrtf(ss * (1.0f / D) + 1e-6f);
#pragma unroll
        for (int i = 0; i < 4; ++i) { const int c = i * 256 + lane * 4; *(f32x4*)(kp->out + (size_t)r * D + c) = v[i] * rs * *(const f32x4*)(g + c); }
    }
}

__device__ __forceinline__ void setup_phase(KPC kp, LAS float* ldsf) {
    float* h = (float*)(kp->ws + OFF_H); const int tid = ltid();
    const int hb0 = gridDim.x > 64 ? 32 : 0;
    for (size_t i = (size_t)(lbid() - hb0) * 512 + tid; lbid() >= hb0 && i < (size_t)NTOK * 256; i += (size_t)(gridDim.x - hb0) * 512) {
        const int T = (int)(i >> 8), c = ((int)i & 255) * 4, b = T / TPB, t = T - b * TPB; f32x4 v;
        if (t < CTX) v = *(const f32x4*)(kp->in[I_CTX] + ((size_t)b * CTX + t) * D + c);
        else { const int s = t - CTX; v = *(const f32x4*)(kp->in[I_X] + ((size_t)b * SEQ + s) * D + c);
            const int half = c >> 9, cc = c & 511, isc = cc >> 8, i0 = cc & 255; const float pv = half ? (float)(s & 63) : (float)(s >> 6);
#pragma unroll
            for (int e = 0; e < 4; ++e) { const float om = exp2f(-13.287712379549449f * (float)(i0 + e) * (1.0f / 256.0f)); const float ang = pv * om; v[e] += isc ? __cosf(ang) : __sinf(ang); } }
        *(f32x4*)(h + (size_t)T * D + c) = v;
    }
    LAS float* sc = ldsf; LAS float* red = ldsf + 5 * 1024;
    for (int i = tid; i < 5 * 1024; i += 512) { const int r = i >> 10, k = i & 1023; const float cv = r < 4 ? kp->in[I_C][r * D + k] : kp->in[I_CCTX][k]; sc[i] = siluf(cv); }
    __syncthreads();
    float* mod = (float*)(kp->ws + OFF_MOD); const int lane = tid & 63, wv = tid >> 6;
    for (int task = lbid(); task < 288; task += gridDim.x) {
        const int l = task / 72, n0 = (task % 72) * 128 + lane * 2; const float* w = kp->in[I_ADAW] + (size_t)l * D * 9216 + n0;
        f32x2 a[5];
#pragma unroll
        for (int r = 0; r < 5; ++r) a[r] = (f32x2){0.f, 0.f};
#pragma unroll 16
        for (int k = wv * 128; k < wv * 128 + 128; ++k) { const f32x2 wv2 = *(const f32x2*)(w + (size_t)k * 9216);
#pragma unroll
            for (int r = 0; r < 5; ++r) a[r] += wv2 * sc[r * 1024 + k]; }
#pragma unroll
        for (int r = 0; r < 5; ++r) { red[(wv * 5 + r) * 128 + lane * 2] = a[r][0]; red[(wv * 5 + r) * 128 + lane * 2 + 1] = a[r][1]; }
        __syncthreads();
        for (int i = tid; i < 640; i += 512) { const int r = i >> 7, n = i & 127; float s = 0.f;
#pragma unroll
            for (int w8 = 0; w8 < 8; ++w8) s += red[(w8 * 5 + r) * 128 + n];
            const int nn = (task % 72) * 128 + n; mod[((size_t)l * 5 + r) * 9216 + nn] = s + kp->in[I_ADAB][(size_t)l * 9216 + nn]; }
        __syncthreads();
    }
}

__device__ __forceinline__ void convert_layer(KPC kp, int l, LAS float* tile) {
    unsigned char* wb = kp->ws + OFF_WB; int tctr = 0; const int j = l >> 1;
    for (int f = 0; f < 2; ++f) {
        convert_T(kp->in[I_FFNIN] + (size_t)(l * 2 + f) * D * 2 * FF, 2 * FF, D, 2 * FF, 1, (u16*)(wb + (f ? WB_FIN1 : WB_FIN0)), tile, tctr);
        convert_T(kp->in[I_FFNOUT] + (size_t)(l * 2 + f) * FF * D, D, FF, D, 0, (u16*)(wb + (f ? WB_FOUT1 : WB_FOUT0)), tile, tctr);
    }
    if ((l & 1) == 0) {
        convert_T(kp->in[I_HYWIN] + (size_t)j * D * 3 * D, 3 * D, D, 3 * D, 0, (u16*)(wb + WB_MIN), tile, tctr);
        convert_T(kp->in[I_HYWOUT] + (size_t)j * D * D, D, D, D, 0, (u16*)(wb + WB_MOUT), tile, tctr);
    } else {
        convert_T(kp->in[I_MLUP] + (size_t)j * D * 2 * INNER, 2 * INNER, D, 2 * INNER, 0, (u16*)(wb + WB_MIN), tile, tctr);
        convert_T(kp->in[I_MLDOWN] + (size_t)j * INNER * D, D, INNER, D, 0, (u16*)(wb + WB_MOUT), tile, tctr);
        u16* wg = (u16*)(wb + WB_WGT); const float* src = kp->in[I_MLWG] + (size_t)j * 3 * INNER * 16;
        for (int i = lbid() * 512 + ltid(); i < 16 * 3 * INNER; i += gridDim.x * 512) { const int o = i / (3 * INNER), k = i - o * 3 * INNER; wg[i] = f2bf(src[(size_t)k * 16 + o]); }
        float* gates = (float*)(kp->ws + OFF_GATES); const float* bg = kp->in[I_MLBG] + j * 16;
        for (int i = lbid() * 512 + ltid(); i < NTOK * 16; i += gridDim.x * 512) gates[i] = bg[i & 15];
    }
}

constexpr size_t HY_PL = 0, HY_PC = (size_t)NB * 3072 * SEQ * 2, HY_YL = HY_PC + (size_t)NB * 3072 * CTX * 2, HY_YC = HY_YL + (size_t)NB * D * SEQ * 2;
__device__ __forceinline__ int fphys(int i) { return i ^ ((((i >> 6) & 1) * 21) ^ (((i >> 5) & 1) * 10)); }
__device__ __forceinline__ f32x2 cmul(f32x2 a, f32x2 b) { return (f32x2){a.x * b.x - a.y * b.y, a.x * b.y + a.y * b.x}; }
__device__ __forceinline__ f32x2 cmulc(f32x2 a, f32x2 b) { return (f32x2){a.x * b.x + a.y * b.y, a.y * b.x - a.x * b.y}; }
__device__ __forceinline__ int drev(int x) { const unsigned r = __brev((unsigned)x) >> 18; return (int)(((r & 0x2AAAu) >> 1) | ((r & 0x1555u) << 1)); }

__device__ __forceinline__ void fidx4(int base, int lm, int (&ix)[4]) {
    const int m = 1 << lm;
    if (lm == 6) { const int i0 = fphys(base); ix[0] = i0; ix[1] = (i0 + 64) ^ 21; ix[2] = i0 + 128; ix[3] = (i0 + 192) ^ 21; }
    else if (lm == 4) { const int c6 = ((base >> 6) & 1) * 21; ix[0] = base ^ c6; ix[1] = (base + 16) ^ c6; ix[2] = (base + 32) ^ c6 ^ 10; ix[3] = (base + 48) ^ c6 ^ 10; }
    else { const int c = (((base >> 6) & 1) * 21) ^ (((base >> 5) & 1) * 10); ix[0] = base ^ c; ix[1] = (base + m) ^ c; ix[2] = (base + 2 * m) ^ c; ix[3] = (base + 3 * m) ^ c; }
}
__device__ __forceinline__ void fft_fwd(LAS f32x2* buf) {
    const int tid = ltid();
    for (int lm = 12; lm >= 0; lm -= 2) {
        const int m = 1 << lm; const float inv = 1.0f / (float)(4 << lm);
        f32x2 a[8][4]; int ix[8][4];
#pragma unroll
        for (int i = 0; i < 8; ++i) { const int g = tid + 512 * i, p = g & (m - 1), base = ((g >> lm) << (lm + 2)) + p; fidx4(base, lm, ix[i]);
#pragma unroll
            for (int r = 0; r < 4; ++r) a[i][r] = buf[ix[i][r]]; }
#pragma unroll
        for (int i = 0; i < 8; ++i) { const int p = (tid + 512 * i) & (m - 1);
            const f32x2 t0 = a[i][0] + a[i][2], t1 = a[i][0] - a[i][2], t2 = a[i][1] + a[i][3], dd = a[i][1] - a[i][3], t3 = (f32x2){dd.y, -dd.x};
            const float rev = (float)p * inv;
            const f32x2 w1 = (f32x2){__builtin_amdgcn_cosf(rev), -__builtin_amdgcn_sinf(rev)}, w2 = cmul(w1, w1), w3 = cmul(w2, w1);
            buf[ix[i][0]] = t0 + t2; buf[ix[i][1]] = cmul(t1 + t3, w1); buf[ix[i][2]] = cmul(t0 - t2, w2); buf[ix[i][3]] = cmul(t1 - t3, w3); }
        __syncthreads();
    }
}
__device__ __forceinline__ void fft_inv(LAS f32x2* buf) {
    const int tid = ltid();
    for (int lm = 0; lm <= 12; lm += 2) {
        const int m = 1 << lm; const float inv = 1.0f / (float)(4 << lm);
        f32x2 a[8][4]; int ix[8][4];
#pragma unroll
        for (int i = 0; i < 8; ++i) { const int g = tid + 512 * i, p = g & (m - 1), base = ((g >> lm) << (lm + 2)) + p; fidx4(base, lm, ix[i]);
#pragma unroll
            for (int r = 0; r < 4; ++r) a[i][r] = buf[ix[i][r]]; }
#pragma unroll
        for (int i = 0; i < 8; ++i) { const int p = (tid + 512 * i) & (m - 1);
            const float rev = (float)p * inv;
            const f32x2 w1 = (f32x2){__builtin_amdgcn_cosf(rev), -__builtin_amdgcn_sinf(rev)}, w2 = cmul(w1, w1), w3 = cmul(w2, w1);
            const f32x2 b0 = a[i][0], b1 = cmulc(a[i][1], w1), b2 = cmulc(a[i][2], w2), b3 = cmulc(a[i][3], w3);
            const f32x2 s0 = b0 + b2, s1 = b0 - b2, s2 = b1 + b3, dd = b1 - b3, s3 = (f32x2){-dd.y, dd.x};
            buf[ix[i][0]] = s0 + s2; buf[ix[i][1]] = s1 + s3; buf[ix[i][2]] = s0 - s2; buf[ix[i][3]] = s1 - s3; }
        __syncthreads();
    }
}

__device__ __forceinline__ void hy_mlp_phase(KPC kp, int j) {
    float* h2 = (float*)(kp->ws + OFF_H2);
    const float* w1 = kp->in[I_HYW1] + j * 33 * 64; const float* b1 = kp->in[I_HYB1] + j * 64; const float* w2 = kp->in[I_HYW2] + j * 64 * 64; const float* b2 = kp->in[I_HYB2] + j * 64;
    const float* fr = kp->in[I_HYFREQ] + j * 128; const int lane = ltid() & 63, wv = ltid() >> 6;
    for (int pos = lbid() * 8 + wv; pos < SEQ + CTX; pos += gridDim.x * 8) {
        const int n = pos < SEQ ? SEQ : CTX, t = pos < SEQ ? pos : pos - SEQ; const float tn = (float)t / (float)(n - 1);
        float feat = 0.f;
        if (lane == 0) feat = tn;
        else if (lane < 33) { const int bi = (lane - 1) & 15; const float band = 1e-4f + (float)bi * ((15.0f - 1e-4f) / 15.0f); float rev = ((float)t / (float)n) * band; rev -= floorf(rev);
            const float ang = 6.283185307179586f * rev; feat = lane < 17 ? cosf(ang) : -sinf(ang); }
        float z = b1[lane];
        for (int i = 0; i < 33; ++i) z += lshfl(feat, i) * w1[i * 64 + lane];
        const float h1 = sinf(fr[lane] * z);
        float z2 = b2[lane];
        for (int v = 0; v < 64; ++v) z2 += lshfl(h1, v) * w2[v * 64 + lane];
        h2[(size_t)pos * 64 + lane] = sinf(fr[64 + lane] * z2);
    }
}

__device__ __forceinline__ void block_sum2(float& a, float& b, LAS float* red) {
    a = wave_sum(a); b = wave_sum(b); const int lane = ltid() & 63, wv = ltid() >> 6;
    __syncthreads(); if (lane == 0) { red[wv] = a; red[8 + wv] = b; } __syncthreads();
    float sa = 0.f, sb = 0.f;
#pragma unroll
    for (int i = 0; i < 8; ++i) { sa += red[i]; sb += red[8 + i]; }
    a = sa; b = sb;
}

__device__ __forceinline__ void hy_filter_task(KPC kp, int j, int task, LAS f32x2* buf, LAS float* aux) {
    const int tid = ltid(), d = task & 1023; const bool lat = task < 1024;
    const float* w3 = kp->in[I_HYW3] + (size_t)j * 64 * 4096; const float* b3 = kp->in[I_HYB3] + j * 4096; const float* ldc = kp->in[I_HYDECAY] + j * 4096;
    __syncthreads();
    if (tid < 256) aux[tid] = w3[(size_t)(tid & 63) * 4096 + (tid >> 6) * 1024 + d];
    if (tid < 4) { aux[256 + tid] = b3[tid * 1024 + d]; aux[260 + tid] = __expf(ldc[tid * 1024 + d]); }
    __syncthreads();
    const float* h2 = (const float*)(kp->ws + OFF_H2);
    float ss0 = 0.f, ss1 = 0.f;
    if (lat) {
        for (int r = 0; r < 16; ++r) { const int i = tid + 512 * r; float a0 = aux[256], a1 = aux[257], a2 = aux[258], a3 = aux[259];
#pragma unroll 4
            for (int u4 = 0; u4 < 16; ++u4) { const f32x4 hv = *(const f32x4*)(h2 + (size_t)i * 64 + u4 * 4);
                const f32x4 q0 = *(const LAS f32x4*)(aux + u4 * 4), q1 = *(const LAS f32x4*)(aux + 64 + u4 * 4), q2 = *(const LAS f32x4*)(aux + 128 + u4 * 4), q3 = *(const LAS f32x4*)(aux + 192 + u4 * 4);
#pragma unroll
                for (int e = 0; e < 4; ++e) { a0 += hv[e] * q0[e]; a1 += hv[e] * q1[e]; a2 += hv[e] * q2[e]; a3 += hv[e] * q3[e]; } }
            const float tn = (float)i * (1.0f / 8191.0f);
            a0 *= __expf(-tn * aux[260]); a1 *= __expf(-tn * aux[261]); a2 *= __expf(-tn * aux[262]); a3 *= __expf(-tn * aux[263]);
            buf[fphys(i)] = (f32x2){a0, a2}; ss0 += a0 * a0; ss1 += a2 * a2;
            if (i >= 1) { buf[fphys(NFFT - i)] = (f32x2){a1, a3}; ss0 += a1 * a1; ss1 += a3 * a3; } }
        if (tid == 0) buf[fphys(SEQ)] = (f32x2){0.f, 0.f};
        block_sum2(ss0, ss1, aux + 272);
        const f32x2 scl = (f32x2){rsqrtf(ss0 + 1e-12f) * (1.0f / NFFT), rsqrtf(ss1 + 1e-12f) * (1.0f / NFFT)};
        for (int r = 0; r < 32; ++r) { const int q = fphys(tid + 512 * r); buf[q] = buf[q] * scl; }
        __syncthreads();
        fft_fwd(buf);
        f32x2* K0 = (f32x2*)(kp->ws + OFF_R2) + (size_t)d * NFFT; f32x2* K1 = (f32x2*)kp->out + (size_t)d * NFFT;
        for (int r = 0; r < 32; ++r) { const int pos = tid + 512 * r, k = drev(pos), pos2 = drev((NFFT - k) & (NFFT - 1)); const f32x2 Z = buf[fphys(pos)], Z2 = buf[fphys(pos2)];
            K0[pos] = (f32x2){0.5f * (Z.x + Z2.x), 0.5f * (Z.y - Z2.y)}; K1[pos] = (f32x2){0.5f * (Z.y + Z2.y), -0.5f * (Z.x - Z2.x)}; }
    } else {
        const int idx = tid; float a0 = 0.f, a1 = 0.f;
        if (idx != CTX) { const int t = idx < CTX ? idx : 2 * CTX - idx, dir = idx < CTX ? 0 : 1; a0 = aux[256 + dir]; a1 = aux[258 + dir];
            for (int u4 = 0; u4 < 16; ++u4) { const f32x4 hv = *(const f32x4*)(h2 + (size_t)(SEQ + t) * 64 + u4 * 4);
#pragma unroll
                for (int e = 0; e < 4; ++e) { const int u = u4 * 4 + e; a0 += hv[e] * aux[dir * 64 + u]; a1 += hv[e] * aux[128 + dir * 64 + u]; } }
            const float tn = (float)t * (1.0f / 255.0f); a0 *= __expf(-tn * aux[260 + dir]); a1 *= __expf(-tn * aux[262 + dir]); }
        ss0 = a0 * a0; ss1 = a1 * a1;
        block_sum2(ss0, ss1, aux + 272);
        float* kc = (float*)(kp->ws + OFF_KCTX);
        kc[(size_t)d * 512 + idx] = a0 * rsqrtf(ss0 + 1e-12f); kc[(size_t)(1024 + d) * 512 + idx] = a1 * rsqrtf(ss1 + 1e-12f);
    }
}

__device__ __forceinline__ float ld3(const u16* row, int t, int n, float wa, float wb, float wc, float bias) {
    const float xm = t > 0 ? bf2f(row[t - 1]) : 0.f, x0 = bf2f(row[t]), xp = t < n - 1 ? bf2f(row[t + 1]) : 0.f; return wa * xm + wb * x0 + wc * xp + bias; }

__device__ __forceinline__ void ld3x8(const u16* row, int t0, float wa, float wb, float wc, float bias, float (&o)[8]) {
    const u32x4v w = *(const u32x4v*)(row + t0);
    const float x0 = bflo(w.x), x1 = bfhi(w.x), x2 = bflo(w.y), x3 = bfhi(w.y), x4 = bflo(w.z), x5 = bfhi(w.z), x6 = bflo(w.w), x7 = bfhi(w.w);
    const float xl = t0 > 0 ? bf2f(row[t0 - 1]) : 0.f, xr = t0 + 8 < SEQ ? bf2f(row[t0 + 8]) : 0.f;
    o[0] = wa * xl + wb * x0 + wc * x1 + bias; o[1] = wa * x0 + wb * x1 + wc * x2 + bias; o[2] = wa * x1 + wb * x2 + wc * x3 + bias; o[3] = wa * x2 + wb * x3 + wc * x4 + bias;
    o[4] = wa * x3 + wb * x4 + wc * x5 + bias; o[5] = wa * x4 + wb * x5 + wc * x6 + bias; o[6] = wa * x5 + wb * x6 + wc * x7 + bias; o[7] = wa * x6 + wb * x7 + wc * xr + bias;
}
__device__ __forceinline__ void hy_conv_lat(KPC kp, int j, int task, LAS f32x2* buf) {
    const int tid = ltid(), bp = task >> 10, c = task & 1023, b0 = bp * 2;
    const u16* pl = (const u16*)(kp->ws + OFF_R1 + HY_PL); u16* yl = (u16*)(kp->ws + OFF_R1 + HY_YL);
    const float* cw = kp->in[I_HYCW] + (size_t)j * 3 * 3072; const float* cb = kp->in[I_HYCB] + j * 3072;
    const float w1a = cw[c], w1b = cw[3072 + c], w1c = cw[6144 + c], bb1 = cb[c];
    const float w2a = cw[1024 + c], w2b = cw[3072 + 1024 + c], w2c = cw[6144 + 1024 + c], bb2 = cb[1024 + c];
    const float w3a = cw[2048 + c], w3b = cw[3072 + 2048 + c], w3c = cw[6144 + 2048 + c], bb3 = cb[2048 + c];
    const float sk0 = kp->in[I_HYSKIP][j * 2048 + c], sk1 = kp->in[I_HYSKIP][j * 2048 + 1024 + c];
    const u16* x1r0 = pl + ((size_t)b0 * 3072 + c) * SEQ; const u16* x1r1 = x1r0 + (size_t)3072 * SEQ;
    const u16* x2r0 = x1r0 + (size_t)1024 * SEQ; const u16* x2r1 = x1r1 + (size_t)1024 * SEQ;
    const u16* vr0 = x1r0 + (size_t)2048 * SEQ; const u16* vr1 = x1r1 + (size_t)2048 * SEQ;
    const f32x2* K0 = (const f32x2*)(kp->ws + OFF_R2) + (size_t)c * NFFT; const f32x2* K1 = (const f32x2*)kp->out + (size_t)c * NFFT;
    __syncthreads();
#pragma unroll
    for (int g = 0; g < 2; ++g) { const int t0 = 8 * (tid + 512 * g); float v0[8], v1[8];
        ld3x8(vr0, t0, w3a, w3b, w3c, bb3, v0); ld3x8(vr1, t0, w3a, w3b, w3c, bb3, v1);
#pragma unroll
        for (int e = 0; e < 8; ++e) { buf[fphys(t0 + e)] = (f32x2){v0[e], v1[e]}; buf[fphys(SEQ + t0 + e)] = (f32x2){0.f, 0.f}; } }
    __syncthreads();
#ifdef PROBE_FFT
    for (int rp = 0; rp < PROBE_FFT; ++rp) { fft_fwd(buf); fft_inv(buf); for (int r = 0; r < 32; ++r) { const int q = fphys(tid + 512 * r); buf[q] = buf[q] * (1.0f / NFFT); } __syncthreads(); }
#endif
    fft_fwd(buf);
#pragma unroll 8
    for (int r = 0; r < 32; ++r) { const int pos = tid + 512 * r, q = fphys(pos); buf[q] = cmul(buf[q], K0[pos]); }
    __syncthreads();
    fft_inv(buf);
    float zr[32];
#pragma unroll
    for (int g = 0; g < 2; ++g) { const int t0 = 8 * (tid + 512 * g); float v0[8], v1[8], xa[8], xb[8];
        ld3x8(vr0, t0, w3a, w3b, w3c, bb3, v0); ld3x8(vr1, t0, w3a, w3b, w3c, bb3, v1); ld3x8(x1r0, t0, w1a, w1b, w1c, bb1, xa); ld3x8(x1r1, t0, w1a, w1b, w1c, bb1, xb);
#pragma unroll
        for (int e = 0; e < 8; ++e) { const f32x2 y = buf[fphys(t0 + e)]; const float z0 = xa[e] * (y.x + sk0 * v0[e]), z1 = xb[e] * (y.y + sk0 * v1[e]);
            zr[g * 16 + 2 * e] = z0; zr[g * 16 + 2 * e + 1] = z1; buf[fphys(t0 + e)] = (f32x2){z0, z1}; buf[fphys(SEQ + t0 + e)] = (f32x2){0.f, 0.f}; } }
    __syncthreads();
    fft_fwd(buf);
#pragma unroll 8
    for (int r = 0; r < 32; ++r) { const int pos = tid + 512 * r, q = fphys(pos); buf[q] = cmul(buf[q], K1[pos]); }
    __syncthreads();
    fft_inv(buf);
#pragma unroll
    for (int g = 0; g < 2; ++g) { const int t0 = 8 * (tid + 512 * g); float xa[8], xb[8], o0[8], o1[8];
        ld3x8(x2r0, t0, w2a, w2b, w2c, bb2, xa); ld3x8(x2r1, t0, w2a, w2b, w2c, bb2, xb);
#pragma unroll
        for (int e = 0; e < 8; ++e) { const f32x2 y = buf[fphys(t0 + e)]; o0[e] = xa[e] * (y.x + sk1 * zr[g * 16 + 2 * e]); o1[e] = xb[e] * (y.y + sk1 * zr[g * 16 + 2 * e + 1]); }
        *(u32x4v*)(yl + ((size_t)b0 * D + c) * SEQ + t0) = pack8(o0); *(u32x4v*)(yl + ((size_t)(b0 + 1) * D + c) * SEQ + t0) = pack8(o1); }
}

__device__ __forceinline__ void hy_conv_ctx(KPC kp, int j, int c, LAS float* ls) {
    const int tid = ltid();
    const u16* pc = (const u16*)(kp->ws + OFF_R1 + HY_PC); u16* yc = (u16*)(kp->ws + OFF_R1 + HY_YC); const float* kc = (const float*)(kp->ws + OFF_KCTX);
    const float* cw = kp->in[I_HYCW] + (size_t)j * 3 * 3072; const float* cb = kp->in[I_HYCB] + j * 3072;
    const float w1a = cw[c], w1b = cw[3072 + c], w1c = cw[6144 + c], bb1 = cb[c];
    const float w2a = cw[1024 + c], w2b = cw[3072 + 1024 + c], w2c = cw[6144 + 1024 + c], bb2 = cb[1024 + c];
    const float w3a = cw[2048 + c], w3b = cw[3072 + 2048 + c], w3c = cw[6144 + 2048 + c], bb3 = cb[2048 + c];
    const float sk0 = kp->in[I_HYSKIP][j * 2048 + c], sk1 = kp->in[I_HYSKIP][j * 2048 + 1024 + c];
    __syncthreads();
    ls[tid] = kc[(size_t)c * 512 + tid]; ls[512 + tid] = kc[(size_t)(1024 + c) * 512 + tid];
    for (int i = 0; i < 2; ++i) { const int e = tid + 512 * i, b = e >> 8, t = e & 255; ls[1024 + e] = ld3(pc + ((size_t)b * 3072 + 2048 + c) * CTX, t, CTX, w3a, w3b, w3c, bb3); }
    __syncthreads();
    float zr[2];
    for (int i = 0; i < 2; ++i) { const int e = tid + 512 * i, b = e >> 8, t = e & 255; float a = 0.f;
        for (int s = 0; s < CTX; ++s) a += ls[(t - s) & 511] * ls[1024 + b * 256 + s];
        zr[i] = ld3(pc + ((size_t)b * 3072 + c) * CTX, t, CTX, w1a, w1b, w1c, bb1) * (a + sk0 * ls[1024 + e]); ls[2048 + e] = zr[i]; }
    __syncthreads();
    for (int i = 0; i < 2; ++i) { const int e = tid + 512 * i, b = e >> 8, t = e & 255; float a = 0.f;
        for (int s = 0; s < CTX; ++s) a += ls[512 + ((t - s) & 511)] * ls[2048 + b * 256 + s];
        yc[((size_t)b * D + c) * CTX + t] = f2bf(ld3(pc + ((size_t)b * 3072 + 1024 + c) * CTX, t, CTX, w2a, w2b, w2c, bb2) * (a + sk1 * zr[i])); }
}

__device__ __forceinline__ void hy_transpose(KPC kp, LAS u16* tl) {
    const u16* yl = (const u16*)(kp->ws + OFF_R1 + HY_YL); const u16* yc = (const u16*)(kp->ws + OFF_R1 + HY_YC); u16* y = (u16*)(kp->ws + OFF_U); const int tid = ltid();
    for (int tile = lbid(); tile < NB * 16 * NCH; tile += gridDim.x) {
        const int b = tile / (16 * NCH), rem = tile - b * 16 * NCH, ct = rem / NCH, tt = rem - ct * NCH;
        const u16* src = tt < 4 ? yc + ((size_t)b * D + ct * 64) * CTX + tt * 64 : yl + ((size_t)b * D + ct * 64) * SEQ + (tt - 4) * 64; const int ld = tt < 4 ? CTX : SEQ;
        { const int cr = tid >> 3, t8 = (tid & 7) * 8; *(LAS u32x4v*)(tl + cr * 72 + t8) = *(const u32x4v*)(src + (size_t)cr * ld + t8); }
        __syncthreads();
        { const int tr = tid >> 3, c8 = (tid & 7) * 8; u32x4v w;
          w.x = (unsigned)tl[(c8 + 0) * 72 + tr] | ((unsigned)tl[(c8 + 1) * 72 + tr] << 16); w.y = (unsigned)tl[(c8 + 2) * 72 + tr] | ((unsigned)tl[(c8 + 3) * 72 + tr] << 16);
          w.z = (unsigned)tl[(c8 + 4) * 72 + tr] | ((unsigned)tl[(c8 + 5) * 72 + tr] << 16); w.w = (unsigned)tl[(c8 + 6) * 72 + tr] | ((unsigned)tl[(c8 + 7) * 72 + tr] << 16);
          *(u32x4v*)(y + ((size_t)b * TPB + tt * 64 + tr) * D + ct * 64 + c8) = w; }
        __syncthreads();
    }
}

constexpr size_t OFF_XM = OFF_R1, OFF_XC = OFF_R1 + 132 * MiB, OFF_S = WS_NEED, OFF_MLM = OFF_S + 34 * MiB, WS_NEED2 = OFF_MLM + 1 * MiB;
__device__ __forceinline__ u16* hb_ptr(KPC kp, int T) { const int b = T / TPB, t = T - b * TPB;
    return t < CTX ? (u16*)(kp->ws + OFF_HBC) + ((size_t)b * CTX + t) * INNER : (u16*)kp->out + ((size_t)b * SEQ + (t - CTX)) * INNER; }
__device__ __forceinline__ void bd8(const float (&x)[8], const float (&w)[32], float (&y)[8]) {
#pragma unroll
    for (int bl = 0; bl < 2; ++bl)
#pragma unroll
        for (int e = 0; e < 4; ++e) { float s = 0.f;
#pragma unroll
            for (int d = 0; d < 4; ++d) s += x[bl * 4 + d] * w[bl * 16 + d * 4 + e];
            y[bl * 4 + e] = s; }
}
typedef float f32x8s __attribute__((ext_vector_type(8)));
__device__ __forceinline__ void sload32(const float* p, float (&w)[32]) {
    f32x8s a, b, c, d;
    asm volatile("s_load_dwordx8 %0, %4, 0x0\n\ts_load_dwordx8 %1, %4, 0x20\n\ts_load_dwordx8 %2, %4, 0x40\n\ts_load_dwordx8 %3, %4, 0x60\n\ts_waitcnt lgkmcnt(0)"
                 : "=&s"(a), "=&s"(b), "=&s"(c), "=&s"(d) : "s"(p) : "memory");
#pragma unroll
    for (int i = 0; i < 8; ++i) { w[i] = a[i]; w[8 + i] = b[i]; w[16 + i] = c[i]; w[24 + i] = d[i]; }
}
__device__ __forceinline__ void ldw32(const float* p, float (&w)[32]) {
#pragma unroll
    for (int i = 0; i < 8; ++i) { const f32x4 v = *(const f32x4*)(p + i * 4); w[i * 4] = v[0]; w[i * 4 + 1] = v[1]; w[i * 4 + 2] = v[2]; w[i * 4 + 3] = v[3]; } }

__device__ __forceinline__ void ml_m_phase(KPC kp, int j) {
    float* M = (float*)(kp->ws + OFF_MLM) + (size_t)j * 8192;
    const float* wq = kp->in[I_MLWQ] + (size_t)j * 512 * 16; const float* wk = kp->in[I_MLWK] + (size_t)j * 512 * 16;
    for (int i = lbid() * 512 + ltid(); i < 512 * 16; i += gridDim.x * 512) { const int blk = i >> 4, d = (i >> 2) & 3, d2 = i & 3; float s = 0.f;
#pragma unroll
        for (int e = 0; e < 4; ++e) s += wq[blk * 16 + d * 4 + e] * wk[blk * 16 + d2 * 4 + e];
        M[i] = s * 0.04419417382415922f; }
}

__device__ __forceinline__ void ml_prep_task(KPC kp, int j, int task, LAS unsigned char* lds) {
    const int tid = ltid(), lane = tid & 63, wv = tid >> 6, fr = lane & 15, fq = lane >> 4;
    const int hd = task & 3, bc = task >> 2, b = bc / NCH, ci = bc - b * NCH;
    const u16* xm = (const u16*)(kp->ws + OFF_XM); u16* xc = (u16*)(kp->ws + OFF_XC);
    const int T0 = b * TPB + ci * 64, tlo = b * TPB + (ci < 4 ? 0 : CTX), thi = b * TPB + (ci < 4 ? CTX - 1 : TPB - 1);
    const int ch0 = hd * DH + lane * 8;
    LAS u16* QS = (LAS u16*)lds; LAS u16* KS = (LAS u16*)(lds + 66560);
    const float* cw = kp->in[I_MLCW] + (size_t)j * 3 * INNER; const float* cb = kp->in[I_MLCB] + (size_t)j * INNER;
    __syncthreads();
    {
        float cwa[8], cwb[8], cwc[8], cbb[8], wq[32], wk[32];
#pragma unroll
        for (int e = 0; e < 8; ++e) { cwa[e] = cw[ch0 + e]; cwb[e] = cw[INNER + ch0 + e]; cwc[e] = cw[2 * INNER + ch0 + e]; cbb[e] = cb[ch0 + e]; }
        ldw32(kp->in[I_MLWQ] + ((size_t)j * 512 + (ch0 >> 2)) * 16, wq); ldw32(kp->in[I_MLWK] + ((size_t)j * 512 + (ch0 >> 2)) * 16, wk);
        for (int r = 0; r < 8; ++r) { const int jj = wv + 8 * r, T = T0 + jj; const u16* p = xm + (size_t)T * INNER + ch0;
            float x0[8], xa[8], xb[8], xcv[8], q[8], k[8];
            unpack8(*(const u32x4v*)p, x0);
            if (T > tlo) unpack8(*(const u32x4v*)(p - INNER), xa); else {
#pragma unroll
                for (int e = 0; e < 8; ++e) xa[e] = 0.f; }
            if (T < thi) unpack8(*(const u32x4v*)(p + INNER), xb); else {
#pragma unroll
                for (int e = 0; e < 8; ++e) xb[e] = 0.f; }
#pragma unroll
            for (int e = 0; e < 8; ++e) xcv[e] = siluf(cwa[e] * xa[e] + cwb[e] * x0[e] + cwc[e] * xb[e] + cbb[e]);
            const u32x4v xw = pack8(xcv); *(u32x4v*)(xc + (size_t)T * INNER + ch0) = xw; unpack8(xw, xcv);
            bd8(xcv, wq, q); bd8(xcv, wk, k);
            *(LAS u32x4v*)(QS + jj * 520 + lane * 8) = pack8(q); *(LAS u32x4v*)(KS + jj * 520 + lane * 8) = pack8(k); }
    }
    __syncthreads();
    const u16* wg = (const u16*)(kp->ws + OFF_WB + WB_WGT);
    const int mt = wv & 3, kh = wv >> 2;
    { f32x4 s0 = {0.f, 0.f, 0.f, 0.f}, s1 = {0.f, 0.f, 0.f, 0.f}; const int nt0 = kh * 2;
      for (int ks = 0; ks < 16; ++ks) { const bf16x8 a = *(const LAS bf16x8*)(QS + (16 * mt + fr) * 520 + 32 * ks + 8 * fq);
          const bf16x8 b0 = *(const LAS bf16x8*)(KS + (16 * nt0 + fr) * 520 + 32 * ks + 8 * fq), b1 = *(const LAS bf16x8*)(KS + (16 * (nt0 + 1) + fr) * 520 + 32 * ks + 8 * fq);
          s0 = __builtin_amdgcn_mfma_f32_16x16x32_bf16(a, b0, s0, 0, 0, 0); s1 = __builtin_amdgcn_mfma_f32_16x16x32_bf16(a, b1, s1, 0, 0, 0); }
      float* S = (float*)(kp->ws + OFF_S) + ((size_t)(b * 4 + hd) * NCH + ci) * 4096;
#pragma unroll
      for (int r = 0; r < 4; ++r) { S[(16 * mt + 4 * fq + r) * 64 + 16 * nt0 + fr] = s0[r]; S[(16 * mt + 4 * fq + r) * 64 + 16 * (nt0 + 1) + fr] = s1[r]; } }
    f32x4 ga = {0.f, 0.f, 0.f, 0.f};
    for (int ks = kh * 8; ks < kh * 8 + 8; ++ks) { const int kk = hd * DH + 32 * ks + 8 * fq;
        const bf16x8 a = *(const LAS bf16x8*)(QS + (16 * mt + fr) * 520 + 32 * ks + 8 * fq), a2 = *(const LAS bf16x8*)(KS + (16 * mt + fr) * 520 + 32 * ks + 8 * fq);
        const bf16x8 bq = *(const bf16x8*)(wg + (size_t)fr * 6144 + kk), bk = *(const bf16x8*)(wg + (size_t)fr * 6144 + INNER + kk);
        ga = __builtin_amdgcn_mfma_f32_16x16x32_bf16(a, bq, ga, 0, 0, 0); ga = __builtin_amdgcn_mfma_f32_16x16x32_bf16(a2, bk, ga, 0, 0, 0); }
    __syncthreads();
    {
        float wvv[32]; ldw32(kp->in[I_MLWV] + ((size_t)j * 512 + (ch0 >> 2)) * 16, wvv);
        for (int r = 0; r < 8; ++r) { const int jj = wv + 8 * r, T = T0 + jj; float x0[8], v[8]; unpack8(*(const u32x4v*)(xm + (size_t)T * INNER + ch0), x0); bd8(x0, wvv, v);
            *(LAS u32x4v*)(QS + jj * 520 + lane * 8) = pack8(v); }
    }
    __syncthreads();
    for (int ks = kh * 8; ks < kh * 8 + 8; ++ks) { const int kk = hd * DH + 32 * ks + 8 * fq;
        const bf16x8 a = *(const LAS bf16x8*)(QS + (16 * mt + fr) * 520 + 32 * ks + 8 * fq); const bf16x8 bv = *(const bf16x8*)(wg + (size_t)fr * 6144 + 2 * INNER + kk);
        ga = __builtin_amdgcn_mfma_f32_16x16x32_bf16(a, bv, ga, 0, 0, 0); }
    float* gates = (float*)(kp->ws + OFF_GATES);
#pragma unroll
    for (int r = 0; r < 4; ++r) atomicAdd(gates + (size_t)(T0 + 16 * mt + 4 * fq + r) * 16 + fr, ga[r]);
}

__device__ __forceinline__ void tr_store8(LAS unsigned char* base, int d0, const unsigned (&w)[4], int lane) {
    const int odd = lane & 1, sp = lane & ~1;
#pragma unroll
    for (int i = 0; i < 4; ++i) { const unsigned pw = (unsigned)__builtin_amdgcn_update_dpp(0, (int)w[i], 0xB1, 0xF, 0xF, false);
        const unsigned ow = odd ? ((pw >> 16) | (w[i] & 0xffff0000u)) : ((w[i] & 0xffffu) | (pw << 16)); const int d = d0 + 2 * i + odd;
        *(LAS unsigned*)(base + d * 128 + ((((sp >> 3) ^ (d & 7)) << 4) | ((sp & 7) << 1))) = ow; }
}
#ifndef REP_STAGE
#define REP_STAGE 1
#define REP_STILDE 1
#define REP_MFMA 1
#endif
constexpr int SC_QS = 0, SC_KT = 66560, SC_VT = 132096, SC_ST = 140288, SC_XB = 148480, SC_VEC = 156672;
__device__ __forceinline__ void ml_scan_task(KPC kp, int j, int task, LAS unsigned char* lds) {
    const int tid = ltid(), lane = tid & 63, wv = tid >> 6, fr = lane & 15, fq = lane >> 4;
    const int es = task & 7, dir = (task >> 3) & 1, hd = (task >> 4) & 3, b = task >> 6;
    const u16* xm = (const u16*)(kp->ws + OFF_XM); const u16* xc = (const u16*)(kp->ws + OFF_XC); const float* gates = (const float*)(kp->ws + OFF_GATES);
    const float* Sg = (const float*)(kp->ws + OFF_S) + (size_t)(b * 4 + hd) * NCH * 4096;
    u16* hf = (u16*)(kp->ws + OFF_R2);
    LAS unsigned char* QS = lds + SC_QS; LAS unsigned char* KT = lds + SC_KT; LAS unsigned char* VT = lds + SC_VT; LAS unsigned char* ST = lds + SC_ST; LAS unsigned char* XB = lds + SC_XB;
    LAS float* rowterm = (LAS float*)(lds + SC_VEC); LAS float* colterm = rowterm + 64; LAS float* winter = rowterm + 128; LAS float* einv = rowterm + 192;
    LAS float* kws = rowterm + 256; LAS float* dinv = rowterm + 320; LAS float* nst = rowterm + 384; LAS float* scal = rowterm + 896;
    f32x4 C[16];
#pragma unroll
    for (int i = 0; i < 16; ++i) C[i] = (f32x4){0.f, 0.f, 0.f, 0.f};
    float m_st = 0.f;
    __syncthreads();
    nst[tid] = 0.f;
    float pg_ic = 0.f, pg_fp = 0.f;
    if (wv == 0) { const int tn = dir == 0 ? lane : CTX - 1 - lane; const int Tg = b * TPB + tn; pg_ic = gates[(size_t)Tg * 16 + dir * 8 + hd]; pg_fp = gates[(size_t)Tg * 16 + dir * 8 + 4 + hd]; }
    u32x4v pxc[8], pxv;
    { const int tn = dir == 0 ? lane : CTX - 1 - lane; const size_t Tn = (size_t)(b * TPB + tn) * INNER; const int w0 = __builtin_amdgcn_readfirstlane(wv);
#pragma unroll
      for (int r = 0; r < 8; ++r) pxc[r] = *(const u32x4v*)(xc + Tn + hd * DH + (w0 * 8 + r) * 8);
      pxv = *(const u32x4v*)(xm + Tn + hd * DH + es * 64 + w0 * 8); }
    for (int ci = 0; ci < NCH; ++ci) {
        __syncthreads();
        const int p0 = ci * 64;
        const int tid = ltid(), lane = tid & 63, wv = tid >> 6, fr = lane & 15, fq = lane >> 4;
        asm volatile("" ::: "memory");
        auto tok = [&](int jj) -> int { const int p = p0 + jj; const int t = dir == 0 ? p : (p < CTX ? CTX - 1 - p : TPB + CTX - 1 - p); return b * TPB + t; };
        float sv[8];
        { const int jj = tid >> 3, s8 = (tid & 7) * 8;
            if (dir == 0) { const float* sp = Sg + (size_t)ci * 4096 + jj * 64 + s8; const f32x4 v0 = *(const f32x4*)sp, v1 = *(const f32x4*)(sp + 4);
                sv[0] = v0[0]; sv[1] = v0[1]; sv[2] = v0[2]; sv[3] = v0[3]; sv[4] = v1[0]; sv[5] = v1[1]; sv[6] = v1[2]; sv[7] = v1[3]; }
            else { const int oc = ci < 4 ? 3 - ci : 135 - ci; const float* sp = Sg + (size_t)oc * 4096 + (63 - jj) * 64 + (56 - s8); const f32x4 v0 = *(const f32x4*)sp, v1 = *(const f32x4*)(sp + 4);
                sv[7] = v0[0]; sv[6] = v0[1]; sv[5] = v0[2]; sv[4] = v0[3]; sv[3] = v1[0]; sv[2] = v1[1]; sv[1] = v1[2]; sv[0] = v1[3]; }
        }
        const float g_ic = pg_ic, g_fp = pg_fp;
        if (wv == 0 && ci + 1 < NCH) { const int pn = p0 + 64 + lane; const int tn = dir == 0 ? pn : (pn < CTX ? CTX - 1 - pn : TPB + CTX - 1 - pn); const int Tg = b * TPB + tn;
            pg_ic = gates[(size_t)Tg * 16 + dir * 8 + hd]; pg_fp = gates[(size_t)Tg * 16 + dir * 8 + 4 + hd]; }
        for (int rpS = 0; rpS < REP_STAGE; ++rpS) {
        const int wvu = __builtin_amdgcn_readfirstlane(wv); const int Tl = tok(lane);
#pragma unroll
        for (int r = 0; r < 8; ++r) { const int g8 = wvu * 8 + r; float x[8], q[8], Mw[32];
            const u32x4v xw = pxc[r]; unpack8(xw, x);
            sload32((const float*)(kp->ws + OFF_MLM) + (size_t)j * 8192 + (size_t)(hd * 128 + g8 * 2) * 16, Mw); bd8(x, Mw, q);
            *(LAS u32x4v*)(QS + lane * 1040 + g8 * 16) = pack8(q);
            const unsigned wd[4] = {xw.x, xw.y, xw.z, xw.w}; tr_store8(KT, g8 * 8, wd, lane); }
        { const int g = wvu; const int chv = hd * DH + es * 64 + g * 8; float x[8], v[8], wvv[32];
            unpack8(pxv, x); sload32(kp->in[I_MLWV] + ((size_t)j * 512 + (chv >> 2)) * 16, wvv); bd8(x, wvv, v);
            { const u32x4v vw = pack8(v); const unsigned wd[4] = {vw.x, vw.y, vw.z, vw.w}; tr_store8(VT, g * 8, wd, lane); } }
        }
        if (wv == 0) {
            const float ic = g_ic, fp = g_fp;
            const float lf = fminf(fp, 0.f) - log1pf(__expf(-fabsf(fp)));
            float bb = lf;
#pragma unroll
            for (int o = 1; o < 64; o <<= 1) { const float t = lshfl(bb, lane - o); if (lane >= o) bb += t; }
            const float uu = ic - bb; float pm = uu;
#pragma unroll
            for (int o = 1; o < 64; o <<= 1) { const float t = lshfl(pm, lane - o); if (lane >= o) pm = fmaxf(pm, t); }
            const float a = bb + m_st, mj = fmaxf(a, bb + pm);
            rowterm[lane] = bb - mj; colterm[lane] = uu; winter[lane] = __expf(a - mj); einv[lane] = __expf(-mj);
            const float blast = lshfl(bb, 63), gs = blast - bb + ic, gmax = wave_max(gs), mnew = fmaxf(blast + m_st, gmax);
            kws[lane] = __expf(gs - mnew);
            if (lane == 0) { scal[0] = __expf(blast + m_st - mnew); scal[1] = mnew; }
        }
        __syncthreads();
        for (int rpT = 0; rpT < REP_STILDE; ++rpT) {
            const int jj = tid >> 3, sub = tid & 7, s8 = sub * 8;
            const float rt = rowterm[jj]; float rsum = 0.f;
            const f32x4 ct0 = *(const LAS f32x4*)(colterm + s8), ct1 = *(const LAS f32x4*)(colterm + s8 + 4); const float ctv[8] = {ct0[0], ct0[1], ct0[2], ct0[3], ct1[0], ct1[1], ct1[2], ct1[3]};
#pragma unroll
            for (int e = 0; e < 8; ++e) { const int s = s8 + e; const float w = s <= jj ? sv[e] * 0.04419417382415922f * __expf(rt + ctv[e]) : 0.f; sv[e] = w; rsum += w; }
            *(LAS u32x4v*)(ST + jj * 128 + ((sub ^ (jj & 7)) << 4)) = pack8(sv);
            float qd = 0.f;
#pragma unroll
            for (int c8 = 0; c8 < 8; ++c8) { float qv[8]; unpack8(*(const LAS u32x4v*)(QS + jj * 1040 + (sub * 8 + c8) * 16), qv);
                { const f32x4 n0 = *(const LAS f32x4*)(nst + sub * 64 + c8 * 8), n1 = *(const LAS f32x4*)(nst + sub * 64 + c8 * 8 + 4);
                  qd += qv[0] * n0[0] + qv[1] * n0[1] + qv[2] * n0[2] + qv[3] * n0[3] + qv[4] * n1[0] + qv[5] * n1[1] + qv[6] * n1[2] + qv[7] * n1[3]; } }
            rsum += lshfl(rsum, lane ^ 1); rsum += lshfl(rsum, lane ^ 2); rsum += lshfl(rsum, lane ^ 4);
            qd += lshfl(qd, lane ^ 1); qd += lshfl(qd, lane ^ 2); qd += lshfl(qd, lane ^ 4);
            if (sub == 0) { const float qn = winter[jj] * qd + rsum; dinv[jj] = 1.0f / fmaxf(fabsf(qn), einv[jj]); }
        }
        __syncthreads();
        if (ci + 1 < NCH) { const int pn = p0 + 64 + lane; const int tn = dir == 0 ? pn : (pn < CTX ? CTX - 1 - pn : TPB + CTX - 1 - pn); const size_t Tn = (size_t)(b * TPB + tn) * INNER; const int w0 = __builtin_amdgcn_readfirstlane(wv);
#pragma unroll
            for (int r = 0; r < 8; ++r) pxc[r] = *(const u32x4v*)(xc + Tn + hd * DH + (w0 * 8 + r) * 8);
            pxv = *(const u32x4v*)(xm + Tn + hd * DH + es * 64 + w0 * 8); }
        {
            f32x4 o[4];
            const int et = wv & 3, dh = wv >> 2, el = 16 * et + fr;
            bf16x8 vfr[2];
#pragma unroll
            for (int mt = 0; mt < 4; ++mt) o[mt] = (f32x4){0.f, 0.f, 0.f, 0.f};
#pragma unroll
            for (int ks = 0; ks < 8; ++ks) {
                u32x4v bw; bw.x = pg8::cvt_pk_bf16(C[2 * ks][0], C[2 * ks][1]); bw.y = pg8::cvt_pk_bf16(C[2 * ks][2], C[2 * ks][3]);
                bw.z = pg8::cvt_pk_bf16(C[2 * ks + 1][0], C[2 * ks + 1][1]); bw.w = pg8::cvt_pk_bf16(C[2 * ks + 1][2], C[2 * ks + 1][3]);
                const bf16x8 bfr = __builtin_bit_cast(bf16x8, bw);
#pragma unroll
                for (int mt = 0; mt < 4; ++mt) { const int off = (16 * mt + fr) * 1040 + 8 * fq + dh * 512;
                    const u32x2 lo = *(const LAS u32x2*)(QS + off + 64 * ks), hi = *(const LAS u32x2*)(QS + off + 64 * ks + 32);
                    u32x4v aw; aw.x = lo.x; aw.y = lo.y; aw.z = hi.x; aw.w = hi.y;
                    o[mt] = __builtin_amdgcn_mfma_f32_16x16x32_bf16(bfr, __builtin_bit_cast(bf16x8, aw), o[mt], 0, 0, 0); }
                if ((ks & 1) == 1) __builtin_amdgcn_sched_barrier(0); }
#pragma unroll
            for (int mt = 0; mt < 4; ++mt)
#pragma unroll
                for (int r = 0; r < 4; ++r) o[mt][r] *= winter[16 * mt + fr];
#pragma unroll
            for (int k2 = 0; k2 < 2; ++k2) vfr[k2] = *(const LAS bf16x8*)(VT + el * 128 + (((4 * k2 + fq) ^ (el & 7)) << 4));
            if (dh == 1) {
#pragma unroll
                for (int mt = 0; mt < 4; ++mt) { u32x2 w; w.x = pg8::cvt_pk_bf16(o[mt][0], o[mt][1]); w.y = pg8::cvt_pk_bf16(o[mt][2], o[mt][3]); *(LAS u32x2*)(XB + ((et * 4 + mt) * 64 + lane) * 8) = w; }
            } else {
#pragma unroll
                for (int k2 = 0; k2 < 2; ++k2)
#pragma unroll
                    for (int mt = 0; mt < 4; ++mt) { const int jr = 16 * mt + fr; const bf16x8 a = *(const LAS bf16x8*)(ST + jr * 128 + (((4 * k2 + fq) ^ (jr & 7)) << 4));
                        o[mt] = __builtin_amdgcn_mfma_f32_16x16x32_bf16(vfr[k2], a, o[mt], 0, 0, 0); }
            }
            __syncthreads();
            if (dh == 0) {
#pragma unroll
                for (int mt = 0; mt < 4; ++mt) { const u32x2 pw = *(const LAS u32x2*)(XB + ((et * 4 + mt) * 64 + lane) * 8);
                    const int jr = 16 * mt + fr, T = tok(jr); const float di = dinv[jr];
                    const float o0 = (o[mt][0] + bflo(pw.x)) * di, o1 = (o[mt][1] + bfhi(pw.x)) * di, o2 = (o[mt][2] + bflo(pw.y)) * di, o3 = (o[mt][3] + bfhi(pw.y)) * di;
                    u16* dst = dir == 0 ? hf + (size_t)T * INNER : hb_ptr(kp, T); u32x2 w; w.x = pg8::cvt_pk_bf16(o0, o1); w.y = pg8::cvt_pk_bf16(o2, o3);
                    *(u32x2*)(dst + hd * DH + es * 64 + 16 * et + 4 * fq) = w; }
            }
            const float decay = scal[0];
#pragma unroll
            for (int i = 0; i < 16; ++i) C[i] = C[i] * decay;
            float kwv[2][8];
#pragma unroll
            for (int k2 = 0; k2 < 2; ++k2) { const f32x4 k0 = *(const LAS f32x4*)(kws + 32 * k2 + 8 * fq), k1 = *(const LAS f32x4*)(kws + 32 * k2 + 8 * fq + 4);
                kwv[k2][0] = k0[0]; kwv[k2][1] = k0[1]; kwv[k2][2] = k0[2]; kwv[k2][3] = k0[3]; kwv[k2][4] = k1[0]; kwv[k2][5] = k1[1]; kwv[k2][6] = k1[2]; kwv[k2][7] = k1[3]; }
#pragma unroll
            for (int k2 = 0; k2 < 2; ++k2) { float vv[8]; unpack8(__builtin_bit_cast(u32x4v, vfr[k2]), vv);
#pragma unroll
                for (int e = 0; e < 8; ++e) vv[e] *= kwv[k2][e];
                const bf16x8 bsc = __builtin_bit_cast(bf16x8, pack8(vv));
#pragma unroll
                for (int dt = 0; dt < 16; ++dt) { const int dr = 256 * (wv >> 2) + 16 * dt + fr; const bf16x8 a = *(const LAS bf16x8*)(KT + dr * 128 + (((4 * k2 + fq) ^ (dr & 7)) << 4));
                    C[dt] = __builtin_amdgcn_mfma_f32_16x16x32_bf16(a, bsc, C[dt], 0, 0, 0);
                    if ((dt & 7) == 7) __builtin_amdgcn_sched_barrier(0); } }
            { float nn = decay * nst[tid];
#pragma unroll
              for (int g = 0; g < 8; ++g) { float kv[8]; unpack8(*(const LAS u32x4v*)(KT + tid * 128 + ((g ^ (tid & 7)) << 4)), kv);
                  { const f32x4 k0 = *(const LAS f32x4*)(kws + 8 * g), k1 = *(const LAS f32x4*)(kws + 8 * g + 4); nn += kv[0] * k0[0] + kv[1] * k0[1] + kv[2] * k0[2] + kv[3] * k0[3] + kv[4] * k1[0] + kv[5] * k1[1] + kv[6] * k1[2] + kv[7] * k1[3]; } }
              nst[tid] = nn; }
            m_st = scal[1];
        }
    }
}

__device__ __forceinline__ void ml_gate_phase(KPC kp, int j) {
    u16* hf = (u16*)(kp->ws + OFF_R2); const u16* xc = (const u16*)(kp->ws + OFF_XC); const u16* z = (const u16*)(kp->ws + OFF_XM);
    const float* ng = kp->in[I_MLNG] + (size_t)j * INNER; const float* sk = kp->in[I_MLSKIP] + (size_t)j * INNER;
    const int lane = ltid() & 63, wv = ltid() >> 6;
    for (int T = lbid() * 8 + wv; T < NTOK; T += gridDim.x * 8) {
        const u16* hbp = hb_ptr(kp, T);
#pragma unroll
        for (int hd = 0; hd < 4; ++hd) { const int c0 = hd * DH + lane * 8; float a[8], bq[8], xv[8], zv[8], o[8];
            unpack8(*(const u32x4v*)(hf + (size_t)T * INNER + c0), a); unpack8(*(const u32x4v*)(hbp + c0), bq);
            float s = 0.f;
#pragma unroll
            for (int e = 0; e < 8; ++e) { a[e] += bq[e]; s += a[e]; }
            const float mu = wave_sum(s) * (1.0f / DH); float vs = 0.f;
#pragma unroll
            for (int e = 0; e < 8; ++e) { a[e] -= mu; vs += a[e] * a[e]; }
            const float rs = rsqrtf(wave_sum(vs) * (1.0f / DH) + 1e-5f);
            unpack8(*(const u32x4v*)(xc + (size_t)T * INNER + c0), xv); unpack8(*(const u32x4v*)(z + (size_t)T * INNER + c0), zv);
            const f32x4 n0 = *(const f32x4*)(ng + c0), n1 = *(const f32x4*)(ng + c0 + 4), s0 = *(const f32x4*)(sk + c0), s1 = *(const f32x4*)(sk + c0 + 4);
            const float ngv[8] = {n0[0], n0[1], n0[2], n0[3], n1[0], n1[1], n1[2], n1[3]}, skv[8] = {s0[0], s0[1], s0[2], s0[3], s1[0], s1[1], s1[2], s1[3]};
#pragma unroll
            for (int e = 0; e < 8; ++e) o[e] = (a[e] * rs * ngv[e] + skv[e] * xv[e]) * siluf(zv[e]);
            *(u32x4v*)(hf + (size_t)T * INNER + c0) = pack8(o); }
    }
}


enum { K_SETUP = 0, K_CN, K_G1, K_G2R, K_HYIN, K_HYCONV, K_HYTR, K_MLUPX, K_MLPREP, K_MLSCAN, K_MLUPZ, K_MLGATE, K_FINAL };
constexpr int NPHASE = 1 + 11 + 13 + 11 + 13 + 1;
__device__ __forceinline__ void decode_phase(int ph, int& kind, int& l, int& arg) {
    kind = K_SETUP; l = 0; arg = 0; if (ph == 0) return;
    ph -= 1;
    for (l = 0; l < 4; ++l) { const int n = (l & 1) ? 13 : 11; if (ph < n) break; ph -= n; }
    if (l == 4) { kind = K_FINAL; l = 0; return; }
    if (ph == 0) { kind = K_CN; arg = 0; return; } if (ph == 1) { kind = K_G1; arg = 0; return; } if (ph == 2) { kind = K_G2R; arg = 0; return; } if (ph == 3) { kind = K_CN; arg = 1; return; }
    const int nm = (l & 1) ? 6 : 4;
    if (ph < 4 + nm) { const int q = ph - 4;
        if (l & 1) { kind = q == 0 ? K_MLUPX : q == 1 ? K_MLPREP : q == 2 ? K_MLSCAN : q == 3 ? K_MLUPZ : q == 4 ? K_MLGATE : K_G2R; arg = 2; }
        else { kind = q == 0 ? K_HYIN : q == 1 ? K_HYCONV : q == 2 ? K_HYTR : K_G2R; arg = 2; }
        return; }
    ph -= 4 + nm;
    if (ph == 0) { kind = K_CN; arg = 2; return; } if (ph == 1) { kind = K_G1; arg = 1; return; } kind = K_G2R; arg = 1;
}

__device__ __forceinline__ void gbar(unsigned* ctr, unsigned target) {
    __syncthreads();
    if (ltid() == 0) {
        __builtin_amdgcn_fence(__ATOMIC_RELEASE, "agent");
        __hip_atomic_fetch_add(ctr, 1u, __ATOMIC_RELAXED, __HIP_MEMORY_SCOPE_AGENT);
        while (__hip_atomic_load(ctr, __ATOMIC_RELAXED, __HIP_MEMORY_SCOPE_AGENT) < target) __builtin_amdgcn_s_sleep(2);
        __builtin_amdgcn_fence(__ATOMIC_ACQUIRE, "agent");
    }
    __syncthreads();
}
#ifndef REPMASK
#define REPMASK 0
#define REPN 1
#endif
template <int MIX> __device__ __forceinline__ void run_phases(int lo, int hi, int ph_lo, int ph_hi, LAS unsigned char* lds0, cg::grid_group& grid) {
    lo = lo > ph_lo ? lo : ph_lo; hi = hi < ph_hi ? hi : ph_hi;
    for (int ph = lo; ph < hi; ++ph) {
        KPC kp = (KPC)__builtin_amdgcn_kernarg_segment_ptr(); asm volatile("" : "+s"(kp) :: "memory");
        LAS unsigned char* lds = lds0; asm volatile("" : "+s"(lds) :: "memory");
        unsigned char* ws = kp->ws; unsigned char* wb = ws + OFF_WB;
        int kind, l, arg; decode_phase(ph, kind, l, arg); const int j = l >> 1;
        const float* modl = (const float*)(ws + OFF_MOD) + (size_t)l * 5 * 9216;
        const int nrep = ((REPMASK >> kind) & 1) ? REPN : 1;
        for (int rep = 0; rep < nrep; ++rep) {
        if (kind == K_SETUP) { if constexpr (MIX == 0) setup_phase(kp, (LAS float*)lds); }
        else if (kind == K_CN) {
            if (arg == 0) { convert_layer(kp, l, (LAS float*)lds); if constexpr (MIX == 1) ml_m_phase(kp, j); }
            if constexpr (MIX == 0) { if (arg == 1) hy_mlp_phase(kp, j); }
            norm_phase(kp, l, arg, arg == 0 ? (l == 0 ? 0 : 11) : arg == 1 ? 11 : (l == 3 ? 0 : (l & 1) ? 8 : 4));
        } else if (kind == K_G1) {
            pg8::Gemm g{(const u16*)(ws + OFF_U), (const u16*)(wb + (arg ? WB_FIN1 : WB_FIN0)), NTOK, 2 * FF, D};
            pg8::StaticOrder S; S.init(g.M, g.N, (int)gridDim.x, lbid(), (l == 3 && arg == 1) ? 1 : 0); EpiSwiglu E{(u16*)(ws + OFF_R1)};
            pg8::gemm_phase<EpiSwiglu, pg8::StaticOrder, false>(lds, g, S, E, nullptr);
        } else if (kind == K_G2R) {
            const u16* gA; const u16* gB; int gK, gidx, gbj = -1;
            if (arg < 2) { gA = (const u16*)(ws + OFF_R1); gB = (const u16*)(wb + (arg ? WB_FOUT1 : WB_FOUT0)); gK = FF; gidx = arg ? 8 : 2; }
            else if (MIX == 1) { gA = (const u16*)(ws + OFF_R2); gB = (const u16*)(wb + WB_MOUT); gK = INNER; gidx = 5; }
            else { gA = (const u16*)(ws + OFF_U); gB = (const u16*)(wb + WB_MOUT); gK = D; gidx = 5; gbj = j; }
            const pg8::Gemm g{gA, gB, NTOK, D, gK, 0}; const EpiResid E{kp, l, gidx, gbj};
            pg8::StaticOrder S; S.init(g.M, g.N, (int)gridDim.x, lbid(), (l == 3 && arg >= 1) ? 1 : 2, g.K / 256);
            pg8::gemm_phase<EpiResid, pg8::StaticOrder, false>(lds, g, S, E, nullptr);
        } else if (kind == K_FINAL) { if constexpr (MIX == 1) final_phase(kp); }
        else if constexpr (MIX == 0) {
            if (kind == K_HYIN) {
                pg8::Gemm g{(const u16*)(wb + WB_MIN), (const u16*)(ws + OFF_U), 3 * D, NTOK, D};
                pg8::StaticOrder S; S.init(g.M, g.N, (int)gridDim.x, lbid());
                EpiProjT E{(u16*)(ws + OFF_R1 + HY_PL), (u16*)(ws + OFF_R1 + HY_PC), kp->in[I_HYBIN] + (size_t)j * 3 * D};
                pg8::gemm_phase<EpiProjT, pg8::StaticOrder, false>(lds, g, S, E, nullptr);
                __syncthreads();
                for (int t = lbid(); t < 2048; t += gridDim.x) hy_filter_task(kp, j, t, (LAS f32x2*)lds, (LAS float*)(lds + 131072));
            } else if (kind == K_HYCONV) {
                for (int t = lbid(); t < 2048; t += gridDim.x) hy_conv_lat(kp, j, t, (LAS f32x2*)lds);
                for (int t = lbid(); t < 1024; t += gridDim.x) hy_conv_ctx(kp, j, t, (LAS float*)lds);
            } else if (kind == K_HYTR) hy_transpose(kp, (LAS u16*)lds);
        } else {
            if (kind == K_MLUPX || kind == K_MLUPZ) {
                const bool zz = kind == K_MLUPZ;
                pg8::Gemm g{(const u16*)(ws + OFF_U), (const u16*)(wb + WB_MIN) + (zz ? (size_t)INNER * D : 0), NTOK, INNER, D};
                pg8::StaticOrder S; S.init(g.M, g.N, (int)gridDim.x, lbid(), (zz && l == 3) ? 1 : 0); EpiBf E{(u16*)(ws + OFF_XM), INNER};
                pg8::gemm_phase<EpiBf, pg8::StaticOrder, false>(lds, g, S, E, nullptr);
            } else if (kind == K_MLPREP) { for (int t = lbid(); t < NB * NCH * 4; t += gridDim.x) ml_prep_task(kp, j, t, lds); }
            else if (kind == K_MLSCAN) { for (int t = lbid(); t < 256; t += gridDim.x) ml_scan_task(kp, j, t, lds); }
            else if (kind == K_MLGATE) ml_gate_phase(kp, j);
        }
        }
        if (ph + 1 < ph_hi) gbar((unsigned*)(kp->ws + OFF_MLM + 65536), (unsigned)(ph + 1 - ph_lo) * gridDim.x);
    }
}

__global__ void __launch_bounds__(512) fwd_megakernel(KP kparg) {
    extern __shared__ __attribute__((aligned(16))) unsigned char shm[];
    LAS unsigned char* lds = (LAS unsigned char*)shm;
    cg::grid_group grid = cg::this_grid();
    grid.sync();
    wtab_init();
    const int ph_lo = kparg.ph_lo, ph_hi = kparg.ph_hi;
    run_phases<0>(0, 12, ph_lo, ph_hi, lds, grid);
    run_phases<1>(12, 25, ph_lo, ph_hi, lds, grid);
    run_phases<0>(25, 36, ph_lo, ph_hi, lds, grid);
    run_phases<1>(36, 50, ph_lo, ph_hi, lds, grid);
}

extern "C" void kernel_launch(void* const* d_in, const int* in_sizes, int n_in, void* d_out, int out_size, void* d_ws, size_t ws_size, hipStream_t stream) {
    static int grid_blocks = 0;
    if (!grid_blocks) {
        int dev = 0, cus = 0, per_cu = 0;
        hipGetDevice(&dev);
        hipDeviceGetAttribute(&cus, hipDeviceAttributeMultiprocessorCount, dev);
        hipFuncSetAttribute((const void*)fwd_megakernel, hipFuncAttributeMaxDynamicSharedMemorySize, LDS_BYTES);
        hipOccupancyMaxActiveBlocksPerMultiprocessor(&per_cu, fwd_megakernel, 512, LDS_BYTES);
        if (per_cu < 1) per_cu = 1;
        grid_blocks = cus * 1;
        if (ws_size < WS_NEED2) fprintf(stderr, "workspace too small: %zu < %zu\n", ws_size, (size_t)WS_NEED2);
    }
    KP hp{};
    for (int i = 0; i < 36; ++i) hp.in[i] = (const float*)d_in[i];
    hp.out = (float*)d_out; hp.ws = (unsigned char*)d_ws; hp.ph_lo = 0; hp.ph_hi = NPHASE;
    void* args[] = {&hp};
    hipMemsetAsync((unsigned char*)d_ws + OFF_MLM + 65536, 0, 256, stream);
    hipError_t e = hipLaunchCooperativeKernel((void*)fwd_megakernel, dim3(grid_blocks), dim3(512), args, LDS_BYTES, stream);
    if (e != hipSuccess) fprintf(stderr, "cooperative launch failed: %s (grid %d)\n", hipGetErrorString(e), grid_blocks);
}
```

```cpp
#define REPMASK 0
#define REPN 1
#include <hip/hip_runtime.h>
#include <hip/hip_cooperative_groups.h>
#include <cstdio>
namespace cg = cooperative_groups;
#define WTAB_OFF 163584
__device__ __forceinline__ int llane() { int l; asm volatile("v_mbcnt_lo_u32_b32 %0, -1, 0\n\tv_mbcnt_hi_u32_b32 %0, -1, %0" : "=v"(l) :: "memory"); return l; }
__device__ __forceinline__ int lwave() { extern __shared__ __attribute__((aligned(16))) unsigned char shm_w[];
    const int hw = __builtin_amdgcn_s_getreg(10244) & 63;
    return __builtin_amdgcn_readfirstlane(*(const __attribute__((address_space(3))) int*)((__attribute__((address_space(3))) unsigned char*)shm_w + WTAB_OFF + hw * 4)); }
__device__ __forceinline__ void wtab_init() { extern __shared__ __attribute__((aligned(16))) unsigned char shm_w[];
    const int hw = __builtin_amdgcn_s_getreg(10244) & 63;
    *(__attribute__((address_space(3))) int*)((__attribute__((address_space(3))) unsigned char*)shm_w + WTAB_OFF + hw * 4) = (int)(threadIdx.x >> 6); }
__device__ __forceinline__ int ltid() { return lwave() * 64 + llane(); }
__device__ __forceinline__ int lbid() { int t = blockIdx.x; asm volatile("" : "+s"(t) :: "memory"); return t; }
namespace pg8 {
#define PG8_LAS __attribute__((address_space(3)))
typedef unsigned short bf16_t;
typedef short bf16x8 __attribute__((ext_vector_type(8)));
typedef float f32x4 __attribute__((ext_vector_type(4)));
typedef unsigned u32x4 __attribute__((ext_vector_type(4)));
constexpr int BM = 256, BK = 64, HALF = 128, HTB = HALF * BK * 2  , STAGE_BYTES = 8 * HTB, NXCD = 8, WGM = 8;

__host__ __device__ __forceinline__ int lds_byte(int r, int c) { const int st = (r >> 4) * 2 + (c >> 5), rr = r & 15, cc = c & 31, ob = rr * 64 + cc * 2; return st * 1024 + (ob ^ (((ob >> 9) & 1) << 5)); }
__host__ __device__ __forceinline__ void stage_rc(int b, int& R, int& C) { const int st = b / 1024, sb = b % 1024, swz = sb ^ (((sb >> 9) & 1) << 5); R = (st >> 1) * 16 + swz / 64; C = (st & 1) * 32 + (swz % 64) / 2; }
__host__ __device__ __forceinline__ int perm32(int rho) { const int n = rho >> 4, i = rho & 15; return 8 * (i >> 2) + 4 * n + (i & 3); }

struct Unit { int pm, pn, kofs, nt; };
struct Gemm { const bf16_t* A; const bf16_t* Bt; int M, N, K, ldk; };

struct StaticOrder {
    int nM, nN, nwg, G, c, lat, nk;
    __host__ __device__ void init(int M, int N, int G_, int c_, int lat_ = 0, int nk_ = 0) { lat = lat_; nk = nk_; nM = lat ? 128 : M / BM; nN = N / BM; nwg = nM * nN; G = G_; c = c_; }
    __host__ __device__ bool next(int i, Unit& u) const {
        const long L = (long)i * G + c;
        if (L >= nwg) { if (lat != 2 || L >= nwg + 16 * nk) return false; const int Lc = (int)L - nwg, un = Lc & 15; u.pm = (un >> 2) * 33; u.pn = un & 3; u.kofs = (Lc >> 4) * 256; u.nt = 4; return true; }
        int wgid = (int)L; { const int q = nwg / NXCD, r = nwg % NXCD, xcd = wgid % NXCD, off = wgid / NXCD; wgid = (xcd < r ? xcd * (q + 1) : r * (q + 1) + (xcd - r) * q) + off; }
        const int nig = WGM * nN, gid = wgid / nig, fm = gid * WGM, gsz = (nM - fm) < WGM ? (nM - fm) : WGM;
        u.pm = fm + ((wgid % nig) % gsz); u.pn = (wgid % nig) / gsz; u.kofs = 0; u.nt = 0; if (lat) u.pm = (u.pm >> 5) * 33 + 1 + (u.pm & 31); return true;
    }
    __device__ __forceinline__ void a_ready(const Unit&) const {}
    __device__ __forceinline__ void done(const Unit&) const {}
};
__device__ __forceinline__ unsigned cvt_pk_bf16(float lo, float hi) { unsigned r; asm volatile("v_cvt_pk_bf16_f32 %0, %1, %2" : "=v"(r) : "v"(lo), "v"(hi)); return r; }
template <class Epi, class Sched, bool STAMP = false>
__device__ __forceinline__ void gemm_phase(PG8_LAS unsigned char* lds, const Gemm g, const Sched& S, const Epi& E, unsigned long long* stamps) {
    const int tid = ltid(), wid = __builtin_amdgcn_readfirstlane(tid >> 6), lane = tid & 63, wr = wid >> 2, wc = wid & 3, fr = lane & 15, fq = lane >> 4;
    const int K = g.K, nt = K / BK, ldk = g.ldk ? g.ldk : g.K;
    int ts_lo = 0, ts_hi = 0, nts = 0; const unsigned long long rt_entry = STAMP ? (unsigned long long)wall_clock64() : 0ull;
#define PG8_STAMP() do { if (STAMP && wid == 0 && nts < 64) { const unsigned long long _c = (unsigned long long)clock64(); \
        ts_lo = (lane == nts) ? (int)(unsigned)_c : ts_lo; ts_hi = (lane == nts) ? (int)(unsigned)(_c >> 32) : ts_hi; ++nts; } } while (0)
    PG8_STAMP();
    unsigned voffA[2], voffB[2];
#pragma unroll
    for (int i = 0; i < 2; ++i) { int R, C; stage_rc(tid * 16 + i * 8192, R, C); const int Rb = Epi::PERM ? ((R & ~31) + perm32(R & 31)) : R;
        voffA[i] = (unsigned)(R * ldk + C) * 2u; voffB[i] = (unsigned)(Rb * ldk + C) * 2u; }
    const size_t kstep = (size_t)(BK * 2);
    const size_t hstep = (size_t)HALF * ldk * 2;
    const size_t tstep = 2 * hstep;
    const unsigned ldsw = (unsigned)wid * 1024u;
    const int aoff = lds_byte(wr * 64 + fr, fq * 8), boff = lds_byte(wc * 32 + fr, fq * 8);
#define PG8_SA(b, h) (((b) * 2 + (h)) * HTB)
#define PG8_SB(b, h) ((4 + (b) * 2 + (h)) * HTB)
#define PG8_STAGE(bufoff, gbase, voff) do { _Pragma("unroll") for (int _i = 0; _i < 2; ++_i) \
        __builtin_amdgcn_global_load_lds((const unsigned*)((const char*)(gbase) + (voff)[_i]), (PG8_LAS unsigned*)(lds + (bufoff) + ldsw + _i * 8192), 16, 0, 0); } while (0)
#define PG8_LDA(dst, b, h) do { _Pragma("unroll") for (int m = 0; m < 4; ++m) _Pragma("unroll") for (int k = 0; k < 2; ++k) dst[m][k] = *(const PG8_LAS bf16x8*)(lds + PG8_SA(b, h) + aoff + m * 2048 + k * 1024); } while (0)
#define PG8_LDB(dst, b, h) do { _Pragma("unroll") for (int n = 0; n < 2; ++n) _Pragma("unroll") for (int k = 0; k < 2; ++k) dst[n][k] = *(const PG8_LAS bf16x8*)(lds + PG8_SB(b, h) + boff + n * 2048 + k * 1024); } while (0)
#define PG8_MMA(ai, bj, At, Bt) do { __builtin_amdgcn_s_setprio(1); _Pragma("unroll") for (int m = 0; m < 4; ++m) _Pragma("unroll") for (int n = 0; n < 2; ++n) _Pragma("unroll") for (int k = 0; k < 2; ++k) \
        acc[ai][bj][m][n] = __builtin_amdgcn_mfma_f32_16x16x32_bf16(Bt[n][k], At[m][k], acc[ai][bj][m][n], 0, 0, 0); __builtin_amdgcn_s_setprio(0); } while (0)
#define PG8_WAIT_V(n) asm volatile("s_waitcnt vmcnt(" #n ")" ::: "memory")
#define PG8_WAIT_L(n) asm volatile("s_waitcnt lgkmcnt(" #n ")" ::: "memory")
#define PG8_BAR __builtin_amdgcn_s_barrier()
#define PG8_SCHED __builtin_amdgcn_sched_barrier(0)
    Unit cur, nxt; int ui = 0;
    if (!S.next(0, cur)) return;
    f32x4 acc[2][2][4][2];
#pragma unroll
    for (int a = 0; a < 2; ++a)
#pragma unroll
        for (int b = 0; b < 2; ++b)
#pragma unroll
            for (int m = 0; m < 4; ++m)
#pragma unroll
                for (int n = 0; n < 2; ++n) acc[a][b][m][n] = (f32x4){0.f, 0.f, 0.f, 0.f};
    bf16x8 At[4][2], B0[2][2], B1[2][2];
    const char* cA = (const char*)g.A + (size_t)cur.pm * tstep + (size_t)cur.kofs * 2; const char* cB = (const char*)g.Bt + (size_t)cur.pn * tstep + (size_t)cur.kofs * 2;
    S.a_ready(cur);
    PG8_STAGE(PG8_SB(0, 0), cB, voffB); PG8_STAGE(PG8_SA(0, 0), cA, voffA); PG8_STAGE(PG8_SB(0, 1), cB + hstep, voffB); PG8_STAGE(PG8_SA(0, 1), cA + hstep, voffA);
    if (wr == 1) PG8_BAR;
    PG8_WAIT_V(4); PG8_BAR;
    PG8_STAGE(PG8_SB(1, 0), cB + kstep, voffB); PG8_STAGE(PG8_SA(1, 0), cA + kstep, voffA); PG8_STAGE(PG8_SB(1, 1), cB + hstep + kstep, voffB);
    PG8_WAIT_V(6); PG8_BAR;
    PG8_STAMP();
    for (;;) {
        const bool has_next = S.next(ui + 1, nxt);
        const char* nA = has_next ? (const char*)g.A + (size_t)nxt.pm * tstep + (size_t)nxt.kofs * 2 : cA; const char* nB = has_next ? (const char*)g.Bt + (size_t)nxt.pn * tstep + (size_t)nxt.kofs * 2 : cB;
        const int ntu = cur.nt ? cur.nt : nt;
        for (int t = 0; t < ntu; t += 2) {
            const bool last = (t == ntu - 2);
            const char* a1 = cA + (size_t)(t + 1) * kstep;
            const char* a2 = last ? nA : cA + (size_t)(t + 2) * kstep; const char* b2 = last ? nB : cB + (size_t)(t + 2) * kstep;
            const char* a3 = a2 + kstep; const char* b3 = b2 + kstep;
            if (last && has_next) S.a_ready(nxt);
            PG8_LDB(B0, 0, 0); PG8_SCHED; PG8_LDA(At, 0, 0); PG8_STAGE(PG8_SA(1, 1), a1 + hstep, voffA);
            PG8_WAIT_L(8); PG8_BAR; PG8_WAIT_L(0); PG8_MMA(0, 0, At, B0); PG8_BAR; PG8_SCHED;
            PG8_LDB(B1, 0, 1); PG8_STAGE(PG8_SB(0, 0), b2, voffB);
            PG8_BAR; PG8_WAIT_L(0); PG8_MMA(0, 1, At, B1); PG8_BAR;
            PG8_LDA(At, 0, 1); PG8_STAGE(PG8_SA(0, 0), a2, voffA);
            PG8_BAR; PG8_WAIT_L(0); PG8_MMA(1, 0, At, B0); PG8_BAR; PG8_SCHED;
            PG8_STAGE(PG8_SB(0, 1), b2 + hstep, voffB);
            PG8_WAIT_V(6); PG8_BAR; PG8_MMA(1, 1, At, B1); PG8_BAR;
            PG8_LDB(B0, 1, 0); PG8_SCHED; PG8_LDA(At, 1, 0); PG8_STAGE(PG8_SA(0, 1), a2 + hstep, voffA);
            PG8_WAIT_L(8); PG8_BAR; PG8_WAIT_L(0); PG8_MMA(0, 0, At, B0); PG8_BAR; PG8_SCHED;
            PG8_LDB(B1, 1, 1); PG8_STAGE(PG8_SB(1, 0), b3, voffB);
            PG8_BAR; PG8_WAIT_L(0); PG8_MMA(0, 1, At, B1); PG8_BAR;
            PG8_LDA(At, 1, 1); PG8_STAGE(PG8_SA(1, 0), a3, voffA);
            PG8_BAR; PG8_WAIT_L(0); PG8_MMA(1, 0, At, B0); PG8_BAR; PG8_SCHED;
            PG8_STAGE(PG8_SB(1, 1), b3 + hstep, voffB);
            PG8_WAIT_V(6); PG8_BAR; PG8_MMA(1, 1, At, B1); PG8_BAR;
        }
        PG8_STAMP();
        if constexpr (!Epi::AFTER_DRAIN) { E(acc, cur, wr, wc, fr, fq); S.done(cur); }
        PG8_STAMP();
        if (!has_next) break;
#pragma unroll
        for (int a = 0; a < 2; ++a)
#pragma unroll
            for (int b = 0; b < 2; ++b)
#pragma unroll
                for (int m = 0; m < 4; ++m)
#pragma unroll
                    for (int n = 0; n < 2; ++n) acc[a][b][m][n] = (f32x4){0.f, 0.f, 0.f, 0.f};
        cur = nxt; cA = nA; cB = nB; ++ui;
    }
    PG8_WAIT_V(0);
    if (wr == 0) PG8_BAR;
    PG8_BAR;
    if constexpr (Epi::AFTER_DRAIN) { E.fused(acc, cur, wr, wc, fr, fq, lds, wid, lane); S.done(cur); }
    PG8_STAMP();
    if (STAMP && wid == 0) { stamps[lane] = lane < nts ? (((unsigned long long)(unsigned)ts_hi << 32) | (unsigned)ts_lo) : 0ull;
        if (lane == 62) stamps[62] = rt_entry; if (lane == 63) stamps[63] = (unsigned long long)wall_clock64(); }
#undef PG8_STAMP
#undef PG8_SA
#undef PG8_SB
#undef PG8_STAGE
#undef PG8_LDA
#undef PG8_LDB
#undef PG8_MMA
#undef PG8_WAIT_V
#undef PG8_WAIT_L
#undef PG8_BAR
#undef PG8_SCHED
}
}

typedef unsigned short u16;
using pg8::f32x4; using pg8::bf16x8;
typedef float f32x2 __attribute__((ext_vector_type(2)));
typedef unsigned u32x2 __attribute__((ext_vector_type(2)));
typedef unsigned u32x4v __attribute__((ext_vector_type(4)));
typedef short s16x4 __attribute__((ext_vector_type(4)));
#define LAS __attribute__((address_space(3)))
constexpr int D = 1024, NB = 4, SEQ = 8192, CTX = 256, TPB = 8448, NTOK = 33792, FF = 2816, NCH = 132, INNER = 2048, DH = 512, NFFT = 16384;
constexpr size_t MiB = 1u << 20;
constexpr size_t OFF_WB = 0, OFF_MOD = 48 * MiB, OFF_H = 49 * MiB, OFF_U = OFF_H + 132 * MiB, OFF_R1 = OFF_U + 66 * MiB, OFF_R2 = OFF_R1 + 264 * MiB,
                 OFF_HBC = OFF_R2 + 132 * MiB, OFF_GATES = OFF_HBC + 4 * MiB, OFF_H2 = OFF_GATES + 3 * MiB, OFF_KCTX = OFF_H2 + 3 * MiB, WS_NEED = OFF_KCTX + 4 * MiB;
constexpr size_t WB_FIN0 = 0, WB_FIN1 = 11 * MiB, WB_FOUT0 = 22 * MiB, WB_FOUT1 = 22 * MiB + 5632 * 1024, WB_MIN = 33 * MiB, WB_MOUT = 41 * MiB, WB_WGT = 45 * MiB;
constexpr int LDS_BYTES = 163840;
struct KP { const float* in[36]; float* out; unsigned char* ws; int ph_lo, ph_hi; };
typedef const KP __attribute__((address_space(4))) * KPC;
enum { I_X = 0, I_C, I_CTX, I_CCTX, I_ADAW, I_ADAB, I_NORMG, I_FINALG, I_FFNIN, I_FFNOUT, I_HYWIN, I_HYBIN, I_HYCW, I_HYCB, I_HYW1, I_HYB1, I_HYW2, I_HYB2, I_HYW3, I_HYB3,
       I_HYFREQ, I_HYDECAY, I_HYSKIP, I_HYWOUT, I_HYBOUT, I_MLUP, I_MLCW, I_MLCB, I_MLWQ, I_MLWK, I_MLWV, I_MLWG, I_MLBG, I_MLNG, I_MLSKIP, I_MLDOWN };

__device__ __forceinline__ float bf2f(u16 b) { return __uint_as_float(((unsigned)b) << 16); }
__device__ __forceinline__ float bflo(unsigned w) { return __uint_as_float(w << 16); }
__device__ __forceinline__ float bfhi(unsigned w) { return __uint_as_float(w & 0xffff0000u); }
__device__ __forceinline__ u16 f2bf(float f) { return (u16)(pg8::cvt_pk_bf16(f, 0.f) & 0xffffu); }
__device__ __forceinline__ float siluf(float x) { return x * __builtin_amdgcn_rcpf(1.0f + __expf(-x)); }
__device__ __forceinline__ int modrow_of_token(int T) { const int b = T / TPB, t = T - b * TPB; return t < CTX ? 4 : b; }
__device__ __forceinline__ float lshfl(float v, int srclane) { return __int_as_float(__builtin_amdgcn_ds_bpermute(srclane << 2, __float_as_int(v))); }
__device__ __forceinline__ float wave_sum(float v) { const int lane = llane();
#pragma unroll
    for (int o = 32; o > 0; o >>= 1) v += lshfl(v, lane ^ o);
    return v; }
__device__ __forceinline__ float wave_max(float v) { const int lane = llane();
#pragma unroll
    for (int o = 32; o > 0; o >>= 1) v = fmaxf(v, lshfl(v, lane ^ o));
    return v; }

__device__ __forceinline__ void unpack8(u32x4v w, float (&f)[8]) { f[0] = bflo(w.x); f[1] = bfhi(w.x); f[2] = bflo(w.y); f[3] = bfhi(w.y); f[4] = bflo(w.z); f[5] = bfhi(w.z); f[6] = bflo(w.w); f[7] = bfhi(w.w); }
__device__ __forceinline__ u32x4v pack8(const float (&f)[8]) { u32x4v w; w.x = pg8::cvt_pk_bf16(f[0], f[1]); w.y = pg8::cvt_pk_bf16(f[2], f[3]); w.z = pg8::cvt_pk_bf16(f[4], f[5]); w.w = pg8::cvt_pk_bf16(f[6], f[7]); return w; }

struct EpiSwiglu {
    static constexpr bool PERM = true, AFTER_DRAIN = false;
    u16* act;
    __device__ __forceinline__ void operator()(const f32x4 (&acc)[2][2][4][2], const pg8::Unit& u, int wr, int wc, int fr, int fq) const {
        const int row0 = u.pm * 256 + wr * 64 + fr, col0 = u.pn * 128 + wc * 32 + 8 * fq;
#pragma unroll
        for (int ai = 0; ai < 2; ++ai)
#pragma unroll
            for (int m = 0; m < 4; ++m) {
                const f32x4 g0 = acc[ai][0][m][0], g1 = acc[ai][0][m][1], v0 = acc[ai][1][m][0], v1 = acc[ai][1][m][1];
                u32x4v w;
                w.x = pg8::cvt_pk_bf16(siluf(g0[0]) * v0[0], siluf(g0[1]) * v0[1]); w.y = pg8::cvt_pk_bf16(siluf(g0[2]) * v0[2], siluf(g0[3]) * v0[3]);
                w.z = pg8::cvt_pk_bf16(siluf(g1[0]) * v1[0], siluf(g1[1]) * v1[1]); w.w = pg8::cvt_pk_bf16(siluf(g1[2]) * v1[2], siluf(g1[3]) * v1[3]);
                *(u32x4v*)(act + (size_t)(row0 + ai * 128 + m * 16) * FF + col0) = w; }
    }
};
struct EpiResid {
    static constexpr bool PERM = false, AFTER_DRAIN = false;
    KPC kp; int l, gidx, bias_j;
    __device__ __forceinline__ void operator()(const f32x4 (&acc)[2][2][4][2], const pg8::Unit& u, int wr, int wc, int fr, int fq) const {
        unsigned char* ws = kp->ws; float* h = (float*)(ws + OFF_H); float* part = (float*)kp->out;
        const float* bias = bias_j >= 0 ? kp->in[I_HYBOUT] + (size_t)bias_j * D : nullptr; const float scale = gidx == 5 ? 1.0f : 0.5f;
        const int col0 = u.pn * 256 + wc * 32 + 4 * fq;
        const int mr = modrow_of_token(u.pm * 256);
        const float* gp = (const float*)(ws + OFF_MOD) + ((size_t)l * 5 + mr) * 9216 + gidx * 1024;
        const bool split = u.nt != 0, addb = bias != nullptr && u.kofs == 0;
        float* base = split ? part + ((size_t)(u.kofs >> 8) * 1024 + (u.pm / 33) * 256 + wr * 64 + fr) * D : h + (size_t)(u.pm * 256 + wr * 64 + fr) * D;
#pragma unroll
        for (int bj = 0; bj < 2; ++bj)
#pragma unroll
            for (int n = 0; n < 2; ++n) { const f32x4 gv = *(const f32x4*)(gp + col0 + bj * 128 + n * 16) * scale;
                const f32x4 bv = addb ? *(const f32x4*)(bias + col0 + bj * 128 + n * 16) : (f32x4){0.f, 0.f, 0.f, 0.f};
#pragma unroll
                for (int ai = 0; ai < 2; ++ai)
#pragma unroll
                    for (int m = 0; m < 4; ++m) { f32x4* q = (f32x4*)(base + (size_t)(ai * 128 + m * 16) * D + col0 + bj * 128 + n * 16); const f32x4 v = gv * (acc[ai][bj][m][n] + bv);
                        if (split) *q = v; else *q = *q + v; } }
    }
};
struct EpiBf {
    static constexpr bool PERM = true, AFTER_DRAIN = false;
    u16* O; int ldc;
    __device__ __forceinline__ void operator()(const f32x4 (&acc)[2][2][4][2], const pg8::Unit& u, int wr, int wc, int fr, int fq) const {
        const int row0 = u.pm * 256 + wr * 64 + fr, col0 = u.pn * 256 + wc * 32 + 8 * fq;
#pragma unroll
        for (int ai = 0; ai < 2; ++ai)
#pragma unroll
            for (int m = 0; m < 4; ++m)
#pragma unroll
                for (int bj = 0; bj < 2; ++bj) { const f32x4 a = acc[ai][bj][m][0], b = acc[ai][bj][m][1]; u32x4v w;
                    w.x = pg8::cvt_pk_bf16(a[0], a[1]); w.y = pg8::cvt_pk_bf16(a[2], a[3]); w.z = pg8::cvt_pk_bf16(b[0], b[1]); w.w = pg8::cvt_pk_bf16(b[2], b[3]);
                    *(u32x4v*)(O + (size_t)(row0 + ai * 128 + m * 16) * ldc + col0 + bj * 128) = w; }
    }
};
struct EpiProjT {
    static constexpr bool PERM = true, AFTER_DRAIN = false;
    u16* lat; u16* ctx; const float* bias;
    __device__ __forceinline__ void operator()(const f32x4 (&acc)[2][2][4][2], const pg8::Unit& u, int wr, int wc, int fr, int fq) const {
        const int row0 = u.pm * 256 + wr * 64 + fr, tc0 = wc * 32 + 8 * fq;
        const int b = u.pn / 33, tile = u.pn - b * 33;
#pragma unroll
        for (int ai = 0; ai < 2; ++ai)
#pragma unroll
            for (int m = 0; m < 4; ++m) { const int ch = row0 + ai * 128 + m * 16; const float bs = bias[ch];
                u16* dst = tile == 0 ? ctx + ((size_t)b * 3072 + ch) * CTX + tc0 : lat + ((size_t)b * 3072 + ch) * SEQ + (tile - 1) * 256 + tc0;
#pragma unroll
                for (int bj = 0; bj < 2; ++bj) { const f32x4 a = acc[ai][bj][m][0] + bs, c = acc[ai][bj][m][1] + bs; u32x4v w;
                    w.x = pg8::cvt_pk_bf16(a[0], a[1]); w.y = pg8::cvt_pk_bf16(a[2], a[3]); w.z = pg8::cvt_pk_bf16(c[0], c[1]); w.w = pg8::cvt_pk_bf16(c[2], c[3]);
                    *(u32x4v*)(dst + bj * 128) = w; } }
    }
};


struct LatOrder : pg8::StaticOrder {
    __device__ bool next(int i, pg8::Unit& u) const { if (!pg8::StaticOrder::next(i, u)) return false; u.pm = (u.pm >> 5) * 33 + 1 + (u.pm & 31); return true; }
};
struct CtxSplitOrder {
    int nk, G, c;
    __device__ bool next(int i, pg8::Unit& u) const { const int L = i * G + c; if (L >= 16 * nk) return false; const int un = L & 15, kc = L >> 4; u.pm = (un >> 2) * 33; u.pn = un & 3; u.kofs = kc * 256; return true; }
    __device__ __forceinline__ void a_ready(const pg8::Unit&) const {}
    __device__ __forceinline__ void done(const pg8::Unit&) const {}
};
struct EpiResidAtomic {
    static constexpr bool PERM = false, AFTER_DRAIN = false;
    float* h; const float* gp; float scale;
    __device__ __forceinline__ void operator()(const f32x4 (&acc)[2][2][4][2], const pg8::Unit& u, int wr, int wc, int fr, int fq) const {
        const int row0 = u.pm * 256 + wr * 64 + fr, col0 = u.pn * 256 + wc * 32 + 4 * fq;
#pragma unroll
        for (int bj = 0; bj < 2; ++bj)
#pragma unroll
            for (int n = 0; n < 2; ++n) { const f32x4 gv = *(const f32x4*)(gp + col0 + bj * 128 + n * 16) * scale;
#pragma unroll
                for (int ai = 0; ai < 2; ++ai)
#pragma unroll
                    for (int m = 0; m < 4; ++m) { float* q = h + (size_t)(row0 + ai * 128 + m * 16) * D + col0 + bj * 128 + n * 16; const f32x4 v = gv * acc[ai][bj][m][n];
                        atomicAdd(q, v[0]); atomicAdd(q + 1, v[1]); atomicAdd(q + 2, v[2]); atomicAdd(q + 3, v[3]); } }
    }
};

__device__ __forceinline__ void ctx_bias_phase(KPC kp, const float* gp, const float* bias) {
    float* h = (float*)(kp->ws + OFF_H);
    for (int i = lbid() * 512 + ltid(); i < NB * CTX * 256; i += gridDim.x * 512) { const int r = i >> 8, c = (i & 255) * 4, b = r >> 8, t = r & 255;
        f32x4* q = (f32x4*)(h + ((size_t)b * TPB + t) * D + c); *q = *q + *(const f32x4*)(gp + c) * *(const f32x4*)(bias + c); }
}
__device__ __forceinline__ int colmap(int n, int mapmode) { return mapmode ? (((n >> 8) << 7) + (n & 127) + ((n >> 7) & 1) * FF) : n; }
__device__ __forceinline__ void convert_T(const float* __restrict__ src, int ld, int K, int Nd, int mapmode, u16* __restrict__ dst, LAS float* tile, int& tctr) {
    const int tid = ltid(), nkt = K / 64, ntile = (Nd / 64) * nkt;
    const int G = (int)gridDim.x; const int first = (((lbid() - tctr) % G) + G) % G; tctr += ntile;
    for (int t = first; t < ntile; t += G) {
        const int n0 = (t / nkt) * 64, k0 = (t % nkt) * 64, c0 = colmap(n0, mapmode);
#pragma unroll
        for (int i = 0; i < 2; ++i) { const int e = tid + 512 * i, kr = e >> 4, c4 = (e & 15) * 4;
            const f32x4 v = *(const f32x4*)(src + (size_t)(k0 + kr) * ld + c0 + c4);
            tile[kr * 65 + c4] = v[0]; tile[kr * 65 + c4 + 1] = v[1]; tile[kr * 65 + c4 + 2] = v[2]; tile[kr * 65 + c4 + 3] = v[3]; }
        __syncthreads();
        { const int n = tid >> 3, k8 = (tid & 7) * 8; u32x4v w;
          w.x = pg8::cvt_pk_bf16(tile[(k8 + 0) * 65 + n], tile[(k8 + 1) * 65 + n]); w.y = pg8::cvt_pk_bf16(tile[(k8 + 2) * 65 + n], tile[(k8 + 3) * 65 + n]);
          w.z = pg8::cvt_pk_bf16(tile[(k8 + 4) * 65 + n], tile[(k8 + 5) * 65 + n]); w.w = pg8::cvt_pk_bf16(tile[(k8 + 6) * 65 + n], tile[(k8 + 7) * 65 + n]);
          *(u32x4v*)(dst + (size_t)(n0 + n) * K + k0 + k8) = w; }
        __syncthreads();
    }
}

__device__ __forceinline__ void norm_phase(KPC kp, int l, int sub, int nkp) {
    const float* h = (const float*)(kp->ws + OFF_H); u16* uo = (u16*)(kp->ws + OFF_U);
    const float* g = kp->in[I_NORMG] + (size_t)(l * 3 + sub) * D; const float* modl = (const float*)(kp->ws + OFF_MOD) + (size_t)l * 5 * 9216;
    const int lane = ltid() & 63, wv = ltid() >> 6;
    for (int T = lbid() * 8 + wv; T < NTOK; T += gridDim.x * 8) {
        const float* hr = h + (size_t)T * D; f32x4 v[4]; float ss = 0.f;
        const int bT = T / TPB, tT = T - bT * TPB; const bool fold = nkp > 0 && tT < CTX;
#pragma unroll
        for (int i = 0; i < 4; ++i) { v[i] = *(const f32x4*)(hr + i * 256 + lane * 4);
            if (fold) { const float* pp = (const float*)kp->out + ((size_t)bT * CTX + tT) * D + i * 256 + lane * 4; for (int kc = 0; kc < nkp; ++kc) v[i] += *(const f32x4*)(pp + (size_t)kc * 1024 * D);
                *(f32x4*)((float*)(kp->ws + OFF_H) + (size_t)T * D + i * 256 + lane * 4) = v[i]; }
            ss += v[i][0] * v[i][0] + v[i][1] * v[i][1] + v[i][2] * v[i][2] + v[i][3] * v[i][3]; }
        ss = wave_sum(ss); const float rs = rsqrtf(ss * (1.0f / D) + 1e-6f);
        const float* mp = modl + (size_t)modrow_of_token(T) * 9216 + sub * 3 * 1024;
#pragma unroll
        for (int i = 0; i < 4; ++i) { const int c = i * 256 + lane * 4; const f32x4 gg = *(const f32x4*)(g + c), sh = *(const f32x4*)(mp + c), sc = *(const f32x4*)(mp + 1024 + c);
            const f32x4 o = v[i] * rs * gg * (sc + 1.0f) + sh; u32x2 w; w.x = pg8::cvt_pk_bf16(o[0], o[1]); w.y = pg8::cvt_pk_bf16(o[2], o[3]);
            *(u32x2*)(uo + (size_t)T * D + c) = w; }
    }
}

__device__ __forceinline__ void final_phase(KPC kp) {
    const float* h = (const float*)(kp->ws + OFF_H); const float* g = kp->in[I_FINALG];
    const int lane = ltid() & 63, wv = ltid() >> 6;
    for (int r = lbid() * 8 + wv; r < NB * SEQ; r += gridDim.x * 8) {
        const int b = r / SEQ, s = r - b * SEQ; const float* hr = h + ((size_t)b * TPB + CTX + s) * D; f32x4 v[4]; float ss = 0.f;
#pragma unroll
        for (int i = 0; i < 4; ++i) { v[i] = *(const f32x4*)(hr + i * 256 + lane * 4); ss += v[i][0] * v[i][0] + v[i][1] * v[i][1] + v[i][2] * v[i][2] + v[i][3] * v[i][3]; }
        ss = wave_sum(ss); const float rs = rsqrtf(ss * (1.0f / D) + 1e-6f);
#pragma unroll
        for (int i = 0; i < 4; ++i) { const int c = i * 256 + lane * 4; *(f32x4*)(kp->out + (size_t)r * D + c) = v[i] * rs * *(const f32x4*)(g + c); }
    }
}

__device__ __forceinline__ void setup_phase(KPC kp, LAS float* ldsf) {
    float* h = (float*)(kp->ws + OFF_H); const int tid = ltid();
    const int hb0 = gridDim.x > 64 ? 32 : 0;
    for (size_t i = (size_t)(lbid() - hb0) * 512 + tid; lbid() >= hb0 && i < (size_t)NTOK * 256; i += (size_t)(gridDim.x - hb0) * 512) {
        const int T = (int)(i >> 8), c = ((int)i & 255) * 4, b = T / TPB, t = T - b * TPB; f32x4 v;
        if (t < CTX) v = *(const f32x4*)(kp->in[I_CTX] + ((size_t)b * CTX + t) * D + c);
        else { const int s = t - CTX; v = *(const f32x4*)(kp->in[I_X] + ((size_t)b * SEQ + s) * D + c);
            const int half = c >> 9, cc = c & 511, isc = cc >> 8, i0 = cc & 255; const float pv = half ? (float)(s & 63) : (float)(s >> 6);
#pragma unroll
            for (int e = 0; e < 4; ++e) { const float om = exp2f(-13.287712379549449f * (float)(i0 + e) * (1.0f / 256.0f)); const float ang = pv * om; v[e] += isc ? __cosf(ang) : __sinf(ang); } }
        *(f32x4*)(h + (size_t)T * D + c) = v;
    }
    LAS float* sc = ldsf; LAS float* red = ldsf + 5 * 1024;
    for (int i = tid; i < 5 * 1024; i += 512) { const int r = i >> 10, k = i & 1023; const float cv = r < 4 ? kp->in[I_C][r * D + k] : kp->in[I_CCTX][k]; sc[i] = siluf(cv); }
    __syncthreads();
    float* mod = (float*)(kp->ws + OFF_MOD); const int lane = tid & 63, wv = tid >> 6;
    for (int task = lbid(); task < 288; task += gridDim.x) {
        const int l = task / 72, n0 = (task % 72) * 128 + lane * 2; const float* w = kp->in[I_ADAW] + (size_t)l * D * 9216 + n0;
        f32x2 a[5];
#pragma unroll
        for (int r = 0; r < 5; ++r) a[r] = (f32x2){0.f, 0.f};
#pragma unroll 16
        for (int k = wv * 128; k < wv * 128 + 128; ++k) { const f32x2 wv2 = *(const f32x2*)(w + (size_t)k * 9216);
#pragma unroll
            for (int r = 0; r < 5; ++r) a[r] += wv2 * sc[r * 1024 + k]; }
#pragma unroll
        for (int r = 0; r < 5; ++r) { red[(wv * 5 + r) * 128 + lane * 2] = a[r][0]; red[(wv * 5 + r) * 128 + lane * 2 + 1] = a[r][1]; }
        __syncthreads();
        for (int i = tid; i < 640; i += 512) { const int r = i >> 7, n = i & 127; float s = 0.f;
#pragma unroll
            for (int w8 = 0; w8 < 8; ++w8) s += red[(w8 * 5 + r) * 128 + n];
            const int nn = (task % 72) * 128 + n; mod[((size_t)l * 5 + r) * 9216 + nn] = s + kp->in[I_ADAB][(size_t)l * 9216 + nn]; }
        __syncthreads();
    }
}

__device__ __forceinline__ void convert_layer(KPC kp, int l, LAS float* tile) {
    unsigned char* wb = kp->ws + OFF_WB; int tctr = 0; const int j = l >> 1;
    for (int f = 0; f < 2; ++f) {
        convert_T(kp->in[I_FFNIN] + (size_t)(l * 2 + f) * D * 2 * FF, 2 * FF, D, 2 * FF, 1, (u16*)(wb + (f ? WB_FIN1 : WB_FIN0)), tile, tctr);
        convert_T(kp->in[I_FFNOUT] + (size_t)(l * 2 + f) * FF * D, D, FF, D, 0, (u16*)(wb + (f ? WB_FOUT1 : WB_FOUT0)), tile, tctr);
    }
    if ((l & 1) == 0) {
        convert_T(kp->in[I_HYWIN] + (size_t)j * D * 3 * D, 3 * D, D, 3 * D, 0, (u16*)(wb + WB_MIN), tile, tctr);
        convert_T(kp->in[I_HYWOUT] + (size_t)j * D * D, D, D, D, 0, (u16*)(wb + WB_MOUT), tile, tctr);
    } else {
        convert_T(kp->in[I_MLUP] + (size_t)j * D * 2 * INNER, 2 * INNER, D, 2 * INNER, 0, (u16*)(wb + WB_MIN), tile, tctr);
        convert_T(kp->in[I_MLDOWN] + (size_t)j * INNER * D, D, INNER, D, 0, (u16*)(wb + WB_MOUT), tile, tctr);
        u16* wg = (u16*)(wb + WB_WGT); const float* src = kp->in[I_MLWG] + (size_t)j * 3 * INNER * 16;
        for (int i = lbid() * 512 + ltid(); i < 16 * 3 * INNER; i += gridDim.x * 512) { const int o = i / (3 * INNER), k = i - o * 3 * INNER; wg[i] = f2bf(src[(size_t)k * 16 + o]); }
        float* gates = (float*)(kp->ws + OFF_GATES); const float* bg = kp->in[I_MLBG] + j * 16;
        for (int i = lbid() * 512 + ltid(); i < NTOK * 16; i += gridDim.x * 512) gates[i] = bg[i & 15];
    }
}

constexpr size_t HY_PL = 0, HY_PC = (size_t)NB * 3072 * SEQ * 2, HY_YL = HY_PC + (size_t)NB * 3072 * CTX * 2, HY_YC = HY_YL + (size_t)NB * D * SEQ * 2;
__device__ __forceinline__ int fphys(int i) { return i ^ ((((i >> 6) & 1) * 21) ^ (((i >> 5) & 1) * 10)); }
__device__ __forceinline__ f32x2 cmul(f32x2 a, f32x2 b) { return (f32x2){a.x * b.x - a.y * b.y, a.x * b.y + a.y * b.x}; }
__device__ __forceinline__ f32x2 cmulc(f32x2 a, f32x2 b) { return (f32x2){a.x * b.x + a.y * b.y, a.y * b.x - a.x * b.y}; }
__device__ __forceinline__ int drev(int x) { const unsigned r = __brev((unsigned)x) >> 18; return (int)(((r & 0x2AAAu) >> 1) | ((r & 0x1555u) << 1)); }

__device__ __forceinline__ void fidx4(int base, int lm, int (&ix)[4]) {
    const int m = 1 << lm;
    if (lm == 6) { const int i0 = fphys(base); ix[0] = i0; ix[1] = (i0 + 64) ^ 21; ix[2] = i0 + 128; ix[3] = (i0 + 192) ^ 21; }
    else if (lm == 4) { const int c6 = ((base >> 6) & 1) * 21; ix[0] = base ^ c6; ix[1] = (base + 16) ^ c6; ix[2] = (base + 32) ^ c6 ^ 10; ix[3] = (base + 48) ^ c6 ^ 10; }
    else { const int c = (((base >> 6) & 1) * 21) ^ (((base >> 5) & 1) * 10); ix[0] = base ^ c; ix[1] = (base + m) ^ c; ix[2] = (base + 2 * m) ^ c; ix[3] = (base + 3 * m) ^ c; }
}
__device__ __forceinline__ void fft_fwd(LAS f32x2* buf) {
    const int tid = ltid();
    for (int lm = 12; lm >= 0; lm -= 2) {
        const int m = 1 << lm; const float inv = 1.0f / (float)(4 << lm);
        f32x2 a[8][4]; int ix[8][4];
#pragma unroll
        for (int i = 0; i < 8; ++i) { const int g = tid + 512 * i, p = g & (m - 1), base = ((g >> lm) << (lm + 2)) + p; fidx4(base, lm, ix[i]);
#pragma unroll
            for (int r = 0; r < 4; ++r) a[i][r] = buf[ix[i][r]]; }
#pragma unroll
        for (int i = 0; i < 8; ++i) { const int p = (tid + 512 * i) & (m - 1);
            const f32x2 t0 = a[i][0] + a[i][2], t1 = a[i][0] - a[i][2], t2 = a[i][1] + a[i][3], dd = a[i][1] - a[i][3], t3 = (f32x2){dd.y, -dd.x};
            if (lm == 0) { buf[ix[i][0]] = t0 + t2; buf[ix[i][1]] = t1 + t3; buf[ix[i][2]] = t0 - t2; buf[ix[i][3]] = t1 - t3; }
            else { const float rev = (float)p * inv;
                const f32x2 w1 = (f32x2){__builtin_amdgcn_cosf(rev), -__builtin_amdgcn_sinf(rev)}, w2 = cmul(w1, w1), w3 = cmul(w2, w1);
                buf[ix[i][0]] = t0 + t2; buf[ix[i][1]] = cmul(t1 + t3, w1); buf[ix[i][2]] = cmul(t0 - t2, w2); buf[ix[i][3]] = cmul(t1 - t3, w3); } }
        __syncthreads();
    }
}
__device__ __forceinline__ void fft_inv(LAS f32x2* buf) {
    const int tid = ltid();
    for (int lm = 0; lm <= 12; lm += 2) {
        const int m = 1 << lm; const float inv = 1.0f / (float)(4 << lm);
        f32x2 a[8][4]; int ix[8][4];
#pragma unroll
        for (int i = 0; i < 8; ++i) { const int g = tid + 512 * i, p = g & (m - 1), base = ((g >> lm) << (lm + 2)) + p; fidx4(base, lm, ix[i]);
#pragma unroll
            for (int r = 0; r < 4; ++r) a[i][r] = buf[ix[i][r]]; }
#pragma unroll
        for (int i = 0; i < 8; ++i) { const int p = (tid + 512 * i) & (m - 1);
            f32x2 b0 = a[i][0], b1 = a[i][1], b2 = a[i][2], b3 = a[i][3];
            if (lm != 0) { const float rev = (float)p * inv;
                const f32x2 w1 = (f32x2){__builtin_amdgcn_cosf(rev), -__builtin_amdgcn_sinf(rev)}, w2 = cmul(w1, w1), w3 = cmul(w2, w1);
                b1 = cmulc(b1, w1); b2 = cmulc(b2, w2); b3 = cmulc(b3, w3); }
            const f32x2 s0 = b0 + b2, s1 = b0 - b2, s2 = b1 + b3, dd = b1 - b3, s3 = (f32x2){-dd.y, dd.x};
            buf[ix[i][0]] = s0 + s2; buf[ix[i][1]] = s1 + s3; buf[ix[i][2]] = s0 - s2; buf[ix[i][3]] = s1 - s3; }
        __syncthreads();
    }
}

__device__ __forceinline__ void hy_mlp_phase(KPC kp, int j) {
    float* h2 = (float*)(kp->ws + OFF_H2);
    const float* w1 = kp->in[I_HYW1] + j * 33 * 64; const float* b1 = kp->in[I_HYB1] + j * 64; const float* w2 = kp->in[I_HYW2] + j * 64 * 64; const float* b2 = kp->in[I_HYB2] + j * 64;
    const float* fr = kp->in[I_HYFREQ] + j * 128; const int lane = ltid() & 63, wv = ltid() >> 6;
    for (int pos = lbid() * 8 + wv; pos < SEQ + CTX; pos += gridDim.x * 8) {
        const int n = pos < SEQ ? SEQ : CTX, t = pos < SEQ ? pos : pos - SEQ; const float tn = (float)t / (float)(n - 1);
        float feat = 0.f;
        if (lane == 0) feat = tn;
        else if (lane < 33) { const int bi = (lane - 1) & 15; const float band = 1e-4f + (float)bi * ((15.0f - 1e-4f) / 15.0f); float rev = ((float)t / (float)n) * band; rev -= floorf(rev);
            const float ang = 6.283185307179586f * rev; feat = lane < 17 ? cosf(ang) : -sinf(ang); }
        float z = b1[lane];
        for (int i = 0; i < 33; ++i) z += lshfl(feat, i) * w1[i * 64 + lane];
        const float h1 = sinf(fr[lane] * z);
        float z2 = b2[lane];
        for (int v = 0; v < 64; ++v) z2 += lshfl(h1, v) * w2[v * 64 + lane];
        h2[(size_t)pos * 64 + lane] = sinf(fr[64 + lane] * z2);
    }
}

__device__ __forceinline__ void block_sum2(float& a, float& b, LAS float* red) {
    a = wave_sum(a); b = wave_sum(b); const int lane = ltid() & 63, wv = ltid() >> 6;
    __syncthreads(); if (lane == 0) { red[wv] = a; red[8 + wv] = b; } __syncthreads();
    float sa = 0.f, sb = 0.f;
#pragma unroll
    for (int i = 0; i < 8; ++i) { sa += red[i]; sb += red[8 + i]; }
    a = sa; b = sb;
}

__device__ __forceinline__ void hy_filter_task(KPC kp, int j, int task, LAS f32x2* buf, LAS float* aux) {
    const int tid = ltid(), d = task & 1023; const bool lat = task < 1024;
    const float* w3 = kp->in[I_HYW3] + (size_t)j * 64 * 4096; const float* b3 = kp->in[I_HYB3] + j * 4096; const float* ldc = kp->in[I_HYDECAY] + j * 4096;
    __syncthreads();
    if (tid < 256) aux[tid] = w3[(size_t)(tid & 63) * 4096 + (tid >> 6) * 1024 + d];
    if (tid < 4) { aux[256 + tid] = b3[tid * 1024 + d]; aux[260 + tid] = __expf(ldc[tid * 1024 + d]); }
    __syncthreads();
    const float* h2 = (const float*)(kp->ws + OFF_H2);
    float ss0 = 0.f, ss1 = 0.f;
    if (lat) {
        for (int r = 0; r < 16; ++r) { const int i = tid + 512 * r; float a0 = aux[256], a1 = aux[257], a2 = aux[258], a3 = aux[259];
#pragma unroll 4
            for (int u4 = 0; u4 < 16; ++u4) { const f32x4 hv = *(const f32x4*)(h2 + (size_t)i * 64 + u4 * 4);
                const f32x4 q0 = *(const LAS f32x4*)(aux + u4 * 4), q1 = *(const LAS f32x4*)(aux + 64 + u4 * 4), q2 = *(const LAS f32x4*)(aux + 128 + u4 * 4), q3 = *(const LAS f32x4*)(aux + 192 + u4 * 4);
#pragma unroll
                for (int e = 0; e < 4; ++e) { a0 += hv[e] * q0[e]; a1 += hv[e] * q1[e]; a2 += hv[e] * q2[e]; a3 += hv[e] * q3[e]; } }
            const float tn = (float)i * (1.0f / 8191.0f);
            a0 *= __expf(-tn * aux[260]); a1 *= __expf(-tn * aux[261]); a2 *= __expf(-tn * aux[262]); a3 *= __expf(-tn * aux[263]);
            buf[fphys(i)] = (f32x2){a0, a2}; ss0 += a0 * a0; ss1 += a2 * a2;
            if (i >= 1) { buf[fphys(NFFT - i)] = (f32x2){a1, a3}; ss0 += a1 * a1; ss1 += a3 * a3; } }
        if (tid == 0) buf[fphys(SEQ)] = (f32x2){0.f, 0.f};
        block_sum2(ss0, ss1, aux + 272);
        const f32x2 scl = (f32x2){rsqrtf(ss0 + 1e-12f) * (1.0f / NFFT), rsqrtf(ss1 + 1e-12f) * (1.0f / NFFT)};
        for (int r = 0; r < 32; ++r) { const int q = fphys(tid + 512 * r); buf[q] = buf[q] * scl; }
        __syncthreads();
        fft_fwd(buf);
        f32x2* K0 = (f32x2*)(kp->ws + OFF_R2) + (size_t)d * NFFT; f32x2* K1 = (f32x2*)kp->out + (size_t)d * NFFT;
        for (int r = 0; r < 32; ++r) { const int pos = tid + 512 * r, k = drev(pos), pos2 = drev((NFFT - k) & (NFFT - 1)); const f32x2 Z = buf[fphys(pos)], Z2 = buf[fphys(pos2)];
            K0[pos] = (f32x2){0.5f * (Z.x + Z2.x), 0.5f * (Z.y - Z2.y)}; K1[pos] = (f32x2){0.5f * (Z.y + Z2.y), -0.5f * (Z.x - Z2.x)}; }
    } else {
        const int idx = tid; float a0 = 0.f, a1 = 0.f;
        if (idx != CTX) { const int t = idx < CTX ? idx : 2 * CTX - idx, dir = idx < CTX ? 0 : 1; a0 = aux[256 + dir]; a1 = aux[258 + dir];
            for (int u4 = 0; u4 < 16; ++u4) { const f32x4 hv = *(const f32x4*)(h2 + (size_t)(SEQ + t) * 64 + u4 * 4);
#pragma unroll
                for (int e = 0; e < 4; ++e) { const int u = u4 * 4 + e; a0 += hv[e] * aux[dir * 64 + u]; a1 += hv[e] * aux[128 + dir * 64 + u]; } }
            const float tn = (float)t * (1.0f / 255.0f); a0 *= __expf(-tn * aux[260 + dir]); a1 *= __expf(-tn * aux[262 + dir]); }
        ss0 = a0 * a0; ss1 = a1 * a1;
        block_sum2(ss0, ss1, aux + 272);
        float* kc = (float*)(kp->ws + OFF_KCTX);
        kc[(size_t)d * 512 + idx] = a0 * rsqrtf(ss0 + 1e-12f); kc[(size_t)(1024 + d) * 512 + idx] = a1 * rsqrtf(ss1 + 1e-12f);
    }
}

__device__ __forceinline__ float ld3(const u16* row, int t, int n, float wa, float wb, float wc, float bias) {
    const float xm = t > 0 ? bf2f(row[t - 1]) : 0.f, x0 = bf2f(row[t]), xp = t < n - 1 ? bf2f(row[t + 1]) : 0.f; return wa * xm + wb * x0 + wc * xp + bias; }

__device__ __forceinline__ void ld3x8(const u16* row, int t0, float wa, float wb, float wc, float bias, float (&o)[8]) {
    const u32x4v w = *(const u32x4v*)(row + t0);
    const float x0 = bflo(w.x), x1 = bfhi(w.x), x2 = bflo(w.y), x3 = bfhi(w.y), x4 = bflo(w.z), x5 = bfhi(w.z), x6 = bflo(w.w), x7 = bfhi(w.w);
    const float xl = t0 > 0 ? bf2f(row[t0 - 1]) : 0.f, xr = t0 + 8 < SEQ ? bf2f(row[t0 + 8]) : 0.f;
    o[0] = wa * xl + wb * x0 + wc * x1 + bias; o[1] = wa * x0 + wb * x1 + wc * x2 + bias; o[2] = wa * x1 + wb * x2 + wc * x3 + bias; o[3] = wa * x2 + wb * x3 + wc * x4 + bias;
    o[4] = wa * x3 + wb * x4 + wc * x5 + bias; o[5] = wa * x4 + wb * x5 + wc * x6 + bias; o[6] = wa * x5 + wb * x6 + wc * x7 + bias; o[7] = wa * x6 + wb * x7 + wc * xr + bias;
}
__device__ __forceinline__ void hy_conv_lat(KPC kp, int j, int task, LAS f32x2* buf) {
    const int tid = ltid(), bp = task >> 10, c = task & 1023, b0 = bp * 2;
    const u16* pl = (const u16*)(kp->ws + OFF_R1 + HY_PL); u16* yl = (u16*)(kp->ws + OFF_R1 + HY_YL);
    const float* cw = kp->in[I_HYCW] + (size_t)j * 3 * 3072; const float* cb = kp->in[I_HYCB] + j * 3072;
    const float w1a = cw[c], w1b = cw[3072 + c], w1c = cw[6144 + c], bb1 = cb[c];
    const float w2a = cw[1024 + c], w2b = cw[3072 + 1024 + c], w2c = cw[6144 + 1024 + c], bb2 = cb[1024 + c];
    const float w3a = cw[2048 + c], w3b = cw[3072 + 2048 + c], w3c = cw[6144 + 2048 + c], bb3 = cb[2048 + c];
    const float sk0 = kp->in[I_HYSKIP][j * 2048 + c], sk1 = kp->in[I_HYSKIP][j * 2048 + 1024 + c];
    const u16* x1r0 = pl + ((size_t)b0 * 3072 + c) * SEQ; const u16* x1r1 = x1r0 + (size_t)3072 * SEQ;
    const u16* x2r0 = x1r0 + (size_t)1024 * SEQ; const u16* x2r1 = x1r1 + (size_t)1024 * SEQ;
    const u16* vr0 = x1r0 + (size_t)2048 * SEQ; const u16* vr1 = x1r1 + (size_t)2048 * SEQ;
    const f32x2* K0 = (const f32x2*)(kp->ws + OFF_R2) + (size_t)c * NFFT; const f32x2* K1 = (const f32x2*)kp->out + (size_t)c * NFFT;
    __syncthreads();
#pragma unroll
    for (int g = 0; g < 2; ++g) { const int t0 = 8 * (tid + 512 * g); float v0[8], v1[8];
        ld3x8(vr0, t0, w3a, w3b, w3c, bb3, v0); ld3x8(vr1, t0, w3a, w3b, w3c, bb3, v1);
#pragma unroll
        for (int e = 0; e < 8; ++e) { buf[fphys(t0 + e)] = (f32x2){v0[e], v1[e]}; buf[fphys(SEQ + t0 + e)] = (f32x2){0.f, 0.f}; } }
    __syncthreads();
#ifdef PROBE_FFT
    for (int rp = 0; rp < PROBE_FFT; ++rp) { fft_fwd(buf); fft_inv(buf); for (int r = 0; r < 32; ++r) { const int q = fphys(tid + 512 * r); buf[q] = buf[q] * (1.0f / NFFT); } __syncthreads(); }
#endif
    fft_fwd(buf);
#pragma unroll 8
    for (int r = 0; r < 32; ++r) { const int pos = tid + 512 * r, q = fphys(pos); buf[q] = cmul(buf[q], K0[pos]); }
    __syncthreads();
    fft_inv(buf);
    float zr[32];
#pragma unroll
    for (int g = 0; g < 2; ++g) { const int t0 = 8 * (tid + 512 * g); float v0[8], v1[8], xa[8], xb[8];
        ld3x8(vr0, t0, w3a, w3b, w3c, bb3, v0); ld3x8(vr1, t0, w3a, w3b, w3c, bb3, v1); ld3x8(x1r0, t0, w1a, w1b, w1c, bb1, xa); ld3x8(x1r1, t0, w1a, w1b, w1c, bb1, xb);
#pragma unroll
        for (int e = 0; e < 8; ++e) { const f32x2 y = buf[fphys(t0 + e)]; const float z0 = xa[e] * (y.x + sk0 * v0[e]), z1 = xb[e] * (y.y + sk0 * v1[e]);
            zr[g * 16 + 2 * e] = z0; zr[g * 16 + 2 * e + 1] = z1; buf[fphys(t0 + e)] = (f32x2){z0, z1}; buf[fphys(SEQ + t0 + e)] = (f32x2){0.f, 0.f}; } }
    __syncthreads();
    fft_fwd(buf);
#pragma unroll 8
    for (int r = 0; r < 32; ++r) { const int pos = tid + 512 * r, q = fphys(pos); buf[q] = cmul(buf[q], K1[pos]); }
    __syncthreads();
    fft_inv(buf);
#pragma unroll
    for (int g = 0; g < 2; ++g) { const int t0 = 8 * (tid + 512 * g); float xa[8], xb[8], o0[8], o1[8];
        ld3x8(x2r0, t0, w2a, w2b, w2c, bb2, xa); ld3x8(x2r1, t0, w2a, w2b, w2c, bb2, xb);
#pragma unroll
        for (int e = 0; e < 8; ++e) { const f32x2 y = buf[fphys(t0 + e)]; o0[e] = xa[e] * (y.x + sk1 * zr[g * 16 + 2 * e]); o1[e] = xb[e] * (y.y + sk1 * zr[g * 16 + 2 * e + 1]); }
        *(u32x4v*)(yl + ((size_t)b0 * D + c) * SEQ + t0) = pack8(o0); *(u32x4v*)(yl + ((size_t)(b0 + 1) * D + c) * SEQ + t0) = pack8(o1); }
}

__device__ __forceinline__ void hy_conv_ctx(KPC kp, int j, int c, LAS float* ls) {
    const int tid = ltid();
    const u16* pc = (const u16*)(kp->ws + OFF_R1 + HY_PC); u16* yc = (u16*)(kp->ws + OFF_R1 + HY_YC); const float* kc = (const float*)(kp->ws + OFF_KCTX);
    const float* cw = kp->in[I_HYCW] + (size_t)j * 3 * 3072; const float* cb = kp->in[I_HYCB] + j * 3072;
    const float w1a = cw[c], w1b = cw[3072 + c], w1c = cw[6144 + c], bb1 = cb[c];
    const float w2a = cw[1024 + c], w2b = cw[3072 + 1024 + c], w2c = cw[6144 + 1024 + c], bb2 = cb[1024 + c];
    const float w3a = cw[2048 + c], w3b = cw[3072 + 2048 + c], w3c = cw[6144 + 2048 + c], bb3 = cb[2048 + c];
    const float sk0 = kp->in[I_HYSKIP][j * 2048 + c], sk1 = kp->in[I_HYSKIP][j * 2048 + 1024 + c];
    __syncthreads();
    ls[tid] = kc[(size_t)c * 512 + tid]; ls[512 + tid] = kc[(size_t)(1024 + c) * 512 + tid];
    for (int i = 0; i < 2; ++i) { const int e = tid + 512 * i, b = e >> 8, t = e & 255; ls[1024 + e] = ld3(pc + ((size_t)b * 3072 + 2048 + c) * CTX, t, CTX, w3a, w3b, w3c, bb3); }
    __syncthreads();
    float zr[2];
    for (int i = 0; i < 2; ++i) { const int e = tid + 512 * i, b = e >> 8, t = e & 255; float a = 0.f;
        for (int s = 0; s < CTX; ++s) a += ls[(t - s) & 511] * ls[1024 + b * 256 + s];
        zr[i] = ld3(pc + ((size_t)b * 3072 + c) * CTX, t, CTX, w1a, w1b, w1c, bb1) * (a + sk0 * ls[1024 + e]); ls[2048 + e] = zr[i]; }
    __syncthreads();
    for (int i = 0; i < 2; ++i) { const int e = tid + 512 * i, b = e >> 8, t = e & 255; float a = 0.f;
        for (int s = 0; s < CTX; ++s) a += ls[512 + ((t - s) & 511)] * ls[2048 + b * 256 + s];
        yc[((size_t)b * D + c) * CTX + t] = f2bf(ld3(pc + ((size_t)b * 3072 + 1024 + c) * CTX, t, CTX, w2a, w2b, w2c, bb2) * (a + sk1 * zr[i])); }
}

__device__ __forceinline__ void hy_transpose(KPC kp, LAS u16* tl) {
    const u16* yl = (const u16*)(kp->ws + OFF_R1 + HY_YL); const u16* yc = (const u16*)(kp->ws + OFF_R1 + HY_YC); u16* y = (u16*)(kp->ws + OFF_U); const int tid = ltid();
    for (int tile = lbid(); tile < NB * 16 * NCH; tile += gridDim.x) {
        const int b = tile / (16 * NCH), rem = tile - b * 16 * NCH, ct = rem / NCH, tt = rem - ct * NCH;
        const u16* src = tt < 4 ? yc + ((size_t)b * D + ct * 64) * CTX + tt * 64 : yl + ((size_t)b * D + ct * 64) * SEQ + (tt - 4) * 64; const int ld = tt < 4 ? CTX : SEQ;
        { const int cr = tid >> 3, t8 = (tid & 7) * 8; *(LAS u32x4v*)(tl + cr * 72 + t8) = *(const u32x4v*)(src + (size_t)cr * ld + t8); }
        __syncthreads();
        { const int tr = tid >> 3, c8 = (tid & 7) * 8; u32x4v w;
          w.x = (unsigned)tl[(c8 + 0) * 72 + tr] | ((unsigned)tl[(c8 + 1) * 72 + tr] << 16); w.y = (unsigned)tl[(c8 + 2) * 72 + tr] | ((unsigned)tl[(c8 + 3) * 72 + tr] << 16);
          w.z = (unsigned)tl[(c8 + 4) * 72 + tr] | ((unsigned)tl[(c8 + 5) * 72 + tr] << 16); w.w = (unsigned)tl[(c8 + 6) * 72 + tr] | ((unsigned)tl[(c8 + 7) * 72 + tr] << 16);
          *(u32x4v*)(y + ((size_t)b * TPB + tt * 64 + tr) * D + ct * 64 + c8) = w; }
        __syncthreads();
    }
}

constexpr size_t OFF_XM = OFF_R1, OFF_XC = OFF_R1 + 132 * MiB, OFF_S = WS_NEED, OFF_MLM = OFF_S + 34 * MiB, WS_NEED2 = OFF_MLM + 1 * MiB;
__device__ __forceinline__ u16* hb_ptr(KPC kp, int T) { const int b = T / TPB, t = T - b * TPB;
    return t < CTX ? (u16*)(kp->ws + OFF_HBC) + ((size_t)b * CTX + t) * INNER : (u16*)kp->out + ((size_t)b * SEQ + (t - CTX)) * INNER; }
__device__ __forceinline__ void bd8(const float (&x)[8], const float (&w)[32], float (&y)[8]) {
#pragma unroll
    for (int bl = 0; bl < 2; ++bl)
#pragma unroll
        for (int e = 0; e < 4; ++e) { float s = 0.f;
#pragma unroll
            for (int d = 0; d < 4; ++d) s += x[bl * 4 + d] * w[bl * 16 + d * 4 + e];
            y[bl * 4 + e] = s; }
}
typedef float f32x8s __attribute__((ext_vector_type(8)));
__device__ __forceinline__ void sload32(const float* p, float (&w)[32]) {
    f32x8s a, b, c, d;
    asm volatile("s_load_dwordx8 %0, %4, 0x0\n\ts_load_dwordx8 %1, %4, 0x20\n\ts_load_dwordx8 %2, %4, 0x40\n\ts_load_dwordx8 %3, %4, 0x60\n\ts_waitcnt lgkmcnt(0)"
                 : "=&s"(a), "=&s"(b), "=&s"(c), "=&s"(d) : "s"(p) : "memory");
#pragma unroll
    for (int i = 0; i < 8; ++i) { w[i] = a[i]; w[8 + i] = b[i]; w[16 + i] = c[i]; w[24 + i] = d[i]; }
}
__device__ __forceinline__ void ldw32(const float* p, float (&w)[32]) {
#pragma unroll
    for (int i = 0; i < 8; ++i) { const f32x4 v = *(const f32x4*)(p + i * 4); w[i * 4] = v[0]; w[i * 4 + 1] = v[1]; w[i * 4 + 2] = v[2]; w[i * 4 + 3] = v[3]; } }

__device__ __forceinline__ void ml_m_phase(KPC kp, int j) {
    float* M = (float*)(kp->ws + OFF_MLM) + (size_t)j * 8192;
    const float* wq = kp->in[I_MLWQ] + (size_t)j * 512 * 16; const float* wk = kp->in[I_MLWK] + (size_t)j * 512 * 16;
    for (int i = lbid() * 512 + ltid(); i < 512 * 16; i += gridDim.x * 512) { const int blk = i >> 4, d = (i >> 2) & 3, d2 = i & 3; float s = 0.f;
#pragma unroll
        for (int e = 0; e < 4; ++e) s += wq[blk * 16 + d * 4 + e] * wk[blk * 16 + d2 * 4 + e];
        M[i] = s * 0.04419417382415922f; }
}

__device__ __forceinline__ void ml_prep_task(KPC kp, int j, int task, LAS unsigned char* lds) {
    const int tid = ltid(), lane = tid & 63, wv = tid >> 6, fr = lane & 15, fq = lane >> 4;
    const int hd = task & 3, bc = task >> 2, b = bc / NCH, ci = bc - b * NCH;
    const u16* xm = (const u16*)(kp->ws + OFF_XM); u16* xc = (u16*)(kp->ws + OFF_XC);
    const int T0 = b * TPB + ci * 64, tlo = b * TPB + (ci < 4 ? 0 : CTX), thi = b * TPB + (ci < 4 ? CTX - 1 : TPB - 1);
    const int ch0 = hd * DH + lane * 8;
    LAS u16* QS = (LAS u16*)lds; LAS u16* KS = (LAS u16*)(lds + 66560);
    const float* cw = kp->in[I_MLCW] + (size_t)j * 3 * INNER; const float* cb = kp->in[I_MLCB] + (size_t)j * INNER;
    __syncthreads();
    {
        float cwa[8], cwb[8], cwc[8], cbb[8], wq[32], wk[32];
#pragma unroll
        for (int e4 = 0; e4 < 2; ++e4) { const f32x4 va = *(const f32x4*)(cw + ch0 + 4 * e4), vb = *(const f32x4*)(cw + INNER + ch0 + 4 * e4), vc = *(const f32x4*)(cw + 2 * INNER + ch0 + 4 * e4), vd = *(const f32x4*)(cb + ch0 + 4 * e4);
#pragma unroll
            for (int e = 0; e < 4; ++e) { cwa[4 * e4 + e] = va[e]; cwb[4 * e4 + e] = vb[e]; cwc[4 * e4 + e] = vc[e]; cbb[4 * e4 + e] = vd[e]; } }
        ldw32(kp->in[I_MLWQ] + ((size_t)j * 512 + (ch0 >> 2)) * 16, wq); ldw32(kp->in[I_MLWK] + ((size_t)j * 512 + (ch0 >> 2)) * 16, wk);
        for (int r = 0; r < 8; ++r) { const int jj = wv + 8 * r, T = T0 + jj; const u16* p = xm + (size_t)T * INNER + ch0;
            float x0[8], xa[8], xb[8], xcv[8], q[8], k[8];
            unpack8(*(const u32x4v*)p, x0);
            if (T > tlo) unpack8(*(const u32x4v*)(p - INNER), xa); else {
#pragma unroll
                for (int e = 0; e < 8; ++e) xa[e] = 0.f; }
            if (T < thi) unpack8(*(const u32x4v*)(p + INNER), xb); else {
#pragma unroll
                for (int e = 0; e < 8; ++e) xb[e] = 0.f; }
#pragma unroll
            for (int e = 0; e < 8; ++e) xcv[e] = siluf(cwa[e] * xa[e] + cwb[e] * x0[e] + cwc[e] * xb[e] + cbb[e]);
            const u32x4v xw = pack8(xcv); *(u32x4v*)(xc + (size_t)T * INNER + ch0) = xw; unpack8(xw, xcv);
            bd8(xcv, wq, q); bd8(xcv, wk, k);
            *(LAS u32x4v*)(QS + jj * 520 + lane * 8) = pack8(q); *(LAS u32x4v*)(KS + jj * 520 + lane * 8) = pack8(k); }
    }
    __syncthreads();
    const u16* wg = (const u16*)(kp->ws + OFF_WB + WB_WGT);
    const int mt = wv & 3, kh = wv >> 2;
    { f32x4 s0 = {0.f, 0.f, 0.f, 0.f}, s1 = {0.f, 0.f, 0.f, 0.f}; const int nt0 = kh * 2;
      for (int ks = 0; ks < 16; ++ks) { const bf16x8 a = *(const LAS bf16x8*)(QS + (16 * mt + fr) * 520 + 32 * ks + 8 * fq);
          const bf16x8 b0 = *(const LAS bf16x8*)(KS + (16 * nt0 + fr) * 520 + 32 * ks + 8 * fq), b1 = *(const LAS bf16x8*)(KS + (16 * (nt0 + 1) + fr) * 520 + 32 * ks + 8 * fq);
          s0 = __builtin_amdgcn_mfma_f32_16x16x32_bf16(a, b0, s0, 0, 0, 0); s1 = __builtin_amdgcn_mfma_f32_16x16x32_bf16(a, b1, s1, 0, 0, 0); }
      float* S = (float*)(kp->ws + OFF_S) + ((size_t)(b * 4 + hd) * NCH + ci) * 4096;
#pragma unroll
      for (int r = 0; r < 4; ++r) { S[(16 * mt + 4 * fq + r) * 64 + 16 * nt0 + fr] = s0[r]; S[(16 * mt + 4 * fq + r) * 64 + 16 * (nt0 + 1) + fr] = s1[r]; } }
    f32x4 ga = {0.f, 0.f, 0.f, 0.f};
    for (int ks = kh * 8; ks < kh * 8 + 8; ++ks) { const int kk = hd * DH + 32 * ks + 8 * fq;
        const bf16x8 a = *(const LAS bf16x8*)(QS + (16 * mt + fr) * 520 + 32 * ks + 8 * fq), a2 = *(const LAS bf16x8*)(KS + (16 * mt + fr) * 520 + 32 * ks + 8 * fq);
        const bf16x8 bq = *(const bf16x8*)(wg + (size_t)fr * 6144 + kk), bk = *(const bf16x8*)(wg + (size_t)fr * 6144 + INNER + kk);
        ga = __builtin_amdgcn_mfma_f32_16x16x32_bf16(a, bq, ga, 0, 0, 0); ga = __builtin_amdgcn_mfma_f32_16x16x32_bf16(a2, bk, ga, 0, 0, 0); }
    __syncthreads();
    {
        float wvv[32]; ldw32(kp->in[I_MLWV] + ((size_t)j * 512 + (ch0 >> 2)) * 16, wvv);
        for (int r = 0; r < 8; ++r) { const int jj = wv + 8 * r, T = T0 + jj; float x0[8], v[8]; unpack8(*(const u32x4v*)(xm + (size_t)T * INNER + ch0), x0); bd8(x0, wvv, v);
            *(LAS u32x4v*)(QS + jj * 520 + lane * 8) = pack8(v); }
    }
    __syncthreads();
    for (int ks = kh * 8; ks < kh * 8 + 8; ++ks) { const int kk = hd * DH + 32 * ks + 8 * fq;
        const bf16x8 a = *(const LAS bf16x8*)(QS + (16 * mt + fr) * 520 + 32 * ks + 8 * fq); const bf16x8 bv = *(const bf16x8*)(wg + (size_t)fr * 6144 + 2 * INNER + kk);
        ga = __builtin_amdgcn_mfma_f32_16x16x32_bf16(a, bv, ga, 0, 0, 0); }
    float* gates = (float*)(kp->ws + OFF_GATES);
#pragma unroll
    for (int r = 0; r < 4; ++r) atomicAdd(gates + (size_t)(T0 + 16 * mt + 4 * fq + r) * 16 + fr, ga[r]);
}

__device__ __forceinline__ void tr_store8(LAS unsigned char* base, int d0, const unsigned (&w)[4], int lane) {
    const int odd = lane & 1, sp = lane & ~1;
#pragma unroll
    for (int i = 0; i < 4; ++i) { const unsigned pw = (unsigned)__builtin_amdgcn_update_dpp(0, (int)w[i], 0xB1, 0xF, 0xF, false);
        const unsigned ow = odd ? ((pw >> 16) | (w[i] & 0xffff0000u)) : ((w[i] & 0xffffu) | (pw << 16)); const int d = d0 + 2 * i + odd;
        *(LAS unsigned*)(base + d * 128 + ((((sp >> 3) ^ (d & 7)) << 4) | ((sp & 7) << 1))) = ow; }
}
#ifndef REP_STAGE
#define REP_STAGE 1
#define REP_STILDE 1
#define REP_MFMA 1
#endif
constexpr int SC_QS = 0, SC_KT = 66560, SC_VT = 132096, SC_ST = 140288, SC_XB = 148480, SC_VEC = 156672;
__device__ __forceinline__ void ml_scan_task(KPC kp, int j, int task, LAS unsigned char* lds) {
    const int tid = ltid(), lane = tid & 63, wv = tid >> 6, fr = lane & 15, fq = lane >> 4;
    const int es = task & 7, dir = (task >> 3) & 1, hd = (task >> 4) & 3, b = task >> 6;
    const u16* xm = (const u16*)(kp->ws + OFF_XM); const u16* xc = (const u16*)(kp->ws + OFF_XC); const float* gates = (const float*)(kp->ws + OFF_GATES);
    const float* Sg = (const float*)(kp->ws + OFF_S) + (size_t)(b * 4 + hd) * NCH * 4096;
    u16* hf = (u16*)(kp->ws + OFF_R2);
    LAS unsigned char* QS = lds + SC_QS; LAS unsigned char* KT = lds + SC_KT; LAS unsigned char* VT = lds + SC_VT; LAS unsigned char* ST = lds + SC_ST; LAS unsigned char* XB = lds + SC_XB;
    LAS float* rowterm = (LAS float*)(lds + SC_VEC); LAS float* colterm = rowterm + 64; LAS float* winter = rowterm + 128; LAS float* einv = rowterm + 192;
    LAS float* kws = rowterm + 256; LAS float* dinv = rowterm + 320; LAS float* nst = rowterm + 384; LAS float* scal = rowterm + 896;
    f32x4 C[16];
#pragma unroll
    for (int i = 0; i < 16; ++i) C[i] = (f32x4){0.f, 0.f, 0.f, 0.f};
    float m_st = 0.f;
    __syncthreads();
    nst[tid] = 0.f;
    float pg_ic = 0.f, pg_fp = 0.f;
    if (wv == 0) { const int tn = dir == 0 ? lane : CTX - 1 - lane; const int Tg = b * TPB + tn; pg_ic = gates[(size_t)Tg * 16 + dir * 8 + hd]; pg_fp = gates[(size_t)Tg * 16 + dir * 8 + 4 + hd]; }
    u32x4v pxc[8], pxv;
    { const int tn = dir == 0 ? lane : CTX - 1 - lane; const size_t Tn = (size_t)(b * TPB + tn) * INNER; const int w0 = __builtin_amdgcn_readfirstlane(wv);
#pragma unroll
      for (int r = 0; r < 8; ++r) pxc[r] = *(const u32x4v*)(xc + Tn + hd * DH + (w0 * 8 + r) * 8);
      pxv = *(const u32x4v*)(xm + Tn + hd * DH + es * 64 + w0 * 8); }
    for (int ci = 0; ci < NCH; ++ci) {
        __syncthreads();
        const int p0 = ci * 64;
        const int tid = ltid(), lane = tid & 63, wv = tid >> 6, fr = lane & 15, fq = lane >> 4;
        asm volatile("" ::: "memory");
        auto tok = [&](int jj) -> int { const int p = p0 + jj; const int t = dir == 0 ? p : (p < CTX ? CTX - 1 - p : TPB + CTX - 1 - p); return b * TPB + t; };
        float sv[8];
        { const int jj = tid >> 3, s8 = (tid & 7) * 8;
            if (dir == 0) { const float* sp = Sg + (size_t)ci * 4096 + jj * 64 + s8; const f32x4 v0 = *(const f32x4*)sp, v1 = *(const f32x4*)(sp + 4);
                sv[0] = v0[0]; sv[1] = v0[1]; sv[2] = v0[2]; sv[3] = v0[3]; sv[4] = v1[0]; sv[5] = v1[1]; sv[6] = v1[2]; sv[7] = v1[3]; }
            else { const int oc = ci < 4 ? 3 - ci : 135 - ci; const float* sp = Sg + (size_t)oc * 4096 + (63 - jj) * 64 + (56 - s8); const f32x4 v0 = *(const f32x4*)sp, v1 = *(const f32x4*)(sp + 4);
                sv[7] = v0[0]; sv[6] = v0[1]; sv[5] = v0[2]; sv[4] = v0[3]; sv[3] = v1[0]; sv[2] = v1[1]; sv[1] = v1[2]; sv[0] = v1[3]; }
        }
        const float g_ic = pg_ic, g_fp = pg_fp;
        if (wv == 0 && ci + 1 < NCH) { const int pn = p0 + 64 + lane; const int tn = dir == 0 ? pn : (pn < CTX ? CTX - 1 - pn : TPB + CTX - 1 - pn); const int Tg = b * TPB + tn;
            pg_ic = gates[(size_t)Tg * 16 + dir * 8 + hd]; pg_fp = gates[(size_t)Tg * 16 + dir * 8 + 4 + hd]; }
        for (int rpS = 0; rpS < REP_STAGE; ++rpS) {
        const int wvu = __builtin_amdgcn_readfirstlane(wv); const int Tl = tok(lane);
#pragma unroll
        for (int r = 0; r < 8; ++r) { const int g8 = wvu * 8 + r; float x[8], q[8], Mw[32];
            const u32x4v xw = pxc[r]; unpack8(xw, x);
            sload32((const float*)(kp->ws + OFF_MLM) + (size_t)j * 8192 + (size_t)(hd * 128 + g8 * 2) * 16, Mw); bd8(x, Mw, q);
            *(LAS u32x4v*)(QS + lane * 1040 + g8 * 16) = pack8(q);
            const unsigned wd[4] = {xw.x, xw.y, xw.z, xw.w}; tr_store8(KT, g8 * 8, wd, lane); }
        { const int g = wvu; const int chv = hd * DH + es * 64 + g * 8; float x[8], v[8], wvv[32];
            unpack8(pxv, x); sload32(kp->in[I_MLWV] + ((size_t)j * 512 + (chv >> 2)) * 16, wvv); bd8(x, wvv, v);
            { const u32x4v vw = pack8(v); const unsigned wd[4] = {vw.x, vw.y, vw.z, vw.w}; tr_store8(VT, g * 8, wd, lane); } }
        }
        if (wv == 0) {
            const float ic = g_ic, fp = g_fp;
            const float lf = fminf(fp, 0.f) - log1pf(__expf(-fabsf(fp)));
            float bb = lf;
#pragma unroll
            for (int o = 1; o < 64; o <<= 1) { const float t = lshfl(bb, lane - o); if (lane >= o) bb += t; }
            const float uu = ic - bb; float pm = uu;
#pragma unroll
            for (int o = 1; o < 64; o <<= 1) { const float t = lshfl(pm, lane - o); if (lane >= o) pm = fmaxf(pm, t); }
            const float a = bb + m_st, mj = fmaxf(a, bb + pm);
            rowterm[lane] = bb - mj; colterm[lane] = uu; winter[lane] = __expf(a - mj); einv[lane] = __expf(-mj);
            const float blast = lshfl(bb, 63), gs = blast - bb + ic, gmax = wave_max(gs), mnew = fmaxf(blast + m_st, gmax);
            kws[lane] = __expf(gs - mnew);
            if (lane == 0) { scal[0] = __expf(blast + m_st - mnew); scal[1] = mnew; }
        }
        __syncthreads();
        for (int rpT = 0; rpT < REP_STILDE; ++rpT) {
            const int jj = tid >> 3, sub = tid & 7, s8 = sub * 8;
            const float rt = rowterm[jj]; float rsum = 0.f;
            const f32x4 ct0 = *(const LAS f32x4*)(colterm + s8), ct1 = *(const LAS f32x4*)(colterm + s8 + 4); const float ctv[8] = {ct0[0], ct0[1], ct0[2], ct0[3], ct1[0], ct1[1], ct1[2], ct1[3]};
#pragma unroll
            for (int e = 0; e < 8; ++e) { const int s = s8 + e; const float w = s <= jj ? sv[e] * 0.04419417382415922f * __expf(rt + ctv[e]) : 0.f; sv[e] = w; rsum += w; }
            *(LAS u32x4v*)(ST + jj * 128 + ((sub ^ (jj & 7)) << 4)) = pack8(sv);
            float qd = 0.f;
#pragma unroll
            for (int c8 = 0; c8 < 8; ++c8) { float qv[8]; unpack8(*(const LAS u32x4v*)(QS + jj * 1040 + (sub * 8 + c8) * 16), qv);
                { const f32x4 n0 = *(const LAS f32x4*)(nst + sub * 64 + c8 * 8), n1 = *(const LAS f32x4*)(nst + sub * 64 + c8 * 8 + 4);
                  qd += qv[0] * n0[0] + qv[1] * n0[1] + qv[2] * n0[2] + qv[3] * n0[3] + qv[4] * n1[0] + qv[5] * n1[1] + qv[6] * n1[2] + qv[7] * n1[3]; } }
            rsum += lshfl(rsum, lane ^ 1); rsum += lshfl(rsum, lane ^ 2); rsum += lshfl(rsum, lane ^ 4);
            qd += lshfl(qd, lane ^ 1); qd += lshfl(qd, lane ^ 2); qd += lshfl(qd, lane ^ 4);
            if (sub == 0) { const float qn = winter[jj] * qd + rsum; dinv[jj] = __builtin_amdgcn_rcpf(fmaxf(fabsf(qn), einv[jj])); }
        }
        __syncthreads();
        if (ci + 1 < NCH) { const int pn = p0 + 64 + lane; const int tn = dir == 0 ? pn : (pn < CTX ? CTX - 1 - pn : TPB + CTX - 1 - pn); const size_t Tn = (size_t)(b * TPB + tn) * INNER; const int w0 = __builtin_amdgcn_readfirstlane(wv);
#pragma unroll
            for (int r = 0; r < 8; ++r) pxc[r] = *(const u32x4v*)(xc + Tn + hd * DH + (w0 * 8 + r) * 8);
            pxv = *(const u32x4v*)(xm + Tn + hd * DH + es * 64 + w0 * 8); }
        {
            f32x4 o[4];
            const int et = wv & 3, dh = wv >> 2, el = 16 * et + fr;
            bf16x8 vfr[2];
#pragma unroll
            for (int mt = 0; mt < 4; ++mt) o[mt] = (f32x4){0.f, 0.f, 0.f, 0.f};
#pragma unroll
            for (int ks = 0; ks < 8; ++ks) {
                u32x4v bw; bw.x = pg8::cvt_pk_bf16(C[2 * ks][0], C[2 * ks][1]); bw.y = pg8::cvt_pk_bf16(C[2 * ks][2], C[2 * ks][3]);
                bw.z = pg8::cvt_pk_bf16(C[2 * ks + 1][0], C[2 * ks + 1][1]); bw.w = pg8::cvt_pk_bf16(C[2 * ks + 1][2], C[2 * ks + 1][3]);
                const bf16x8 bfr = __builtin_bit_cast(bf16x8, bw);
#pragma unroll
                for (int mt = 0; mt < 4; ++mt) { const int off = (16 * mt + fr) * 1040 + 8 * fq + dh * 512;
                    const u32x2 lo = *(const LAS u32x2*)(QS + off + 64 * ks), hi = *(const LAS u32x2*)(QS + off + 64 * ks + 32);
                    u32x4v aw; aw.x = lo.x; aw.y = lo.y; aw.z = hi.x; aw.w = hi.y;
                    o[mt] = __builtin_amdgcn_mfma_f32_16x16x32_bf16(bfr, __builtin_bit_cast(bf16x8, aw), o[mt], 0, 0, 0); }
                if ((ks & 1) == 1) __builtin_amdgcn_sched_barrier(0); }
#pragma unroll
            for (int mt = 0; mt < 4; ++mt)
#pragma unroll
                for (int r = 0; r < 4; ++r) o[mt][r] *= winter[16 * mt + fr];
#pragma unroll
            for (int k2 = 0; k2 < 2; ++k2) vfr[k2] = *(const LAS bf16x8*)(VT + el * 128 + (((4 * k2 + fq) ^ (el & 7)) << 4));
            if (dh == 1) {
#pragma unroll
                for (int mt = 0; mt < 4; ++mt) { u32x2 w; w.x = pg8::cvt_pk_bf16(o[mt][0], o[mt][1]); w.y = pg8::cvt_pk_bf16(o[mt][2], o[mt][3]); *(LAS u32x2*)(XB + ((et * 4 + mt) * 64 + lane) * 8) = w; }
            } else {
#pragma unroll
                for (int k2 = 0; k2 < 2; ++k2)
#pragma unroll
                    for (int mt = 0; mt < 4; ++mt) { const int jr = 16 * mt + fr; const bf16x8 a = *(const LAS bf16x8*)(ST + jr * 128 + (((4 * k2 + fq) ^ (jr & 7)) << 4));
                        o[mt] = __builtin_amdgcn_mfma_f32_16x16x32_bf16(vfr[k2], a, o[mt], 0, 0, 0); }
            }
            __syncthreads();
            if (dh == 0) {
#pragma unroll
                for (int mt = 0; mt < 4; ++mt) { const u32x2 pw = *(const LAS u32x2*)(XB + ((et * 4 + mt) * 64 + lane) * 8);
                    const int jr = 16 * mt + fr, T = tok(jr); const float di = dinv[jr];
                    const float o0 = (o[mt][0] + bflo(pw.x)) * di, o1 = (o[mt][1] + bfhi(pw.x)) * di, o2 = (o[mt][2] + bflo(pw.y)) * di, o3 = (o[mt][3] + bfhi(pw.y)) * di;
                    u16* dst = dir == 0 ? hf + (size_t)T * INNER : hb_ptr(kp, T); u32x2 w; w.x = pg8::cvt_pk_bf16(o0, o1); w.y = pg8::cvt_pk_bf16(o2, o3);
                    *(u32x2*)(dst + hd * DH + es * 64 + 16 * et + 4 * fq) = w; }
            }
            const float decay = scal[0];
#pragma unroll
            for (int i = 0; i < 16; ++i) C[i] = C[i] * decay;
            float kwv[2][8];
#pragma unroll
            for (int k2 = 0; k2 < 2; ++k2) { const f32x4 k0 = *(const LAS f32x4*)(kws + 32 * k2 + 8 * fq), k1 = *(const LAS f32x4*)(kws + 32 * k2 + 8 * fq + 4);
                kwv[k2][0] = k0[0]; kwv[k2][1] = k0[1]; kwv[k2][2] = k0[2]; kwv[k2][3] = k0[3]; kwv[k2][4] = k1[0]; kwv[k2][5] = k1[1]; kwv[k2][6] = k1[2]; kwv[k2][7] = k1[3]; }
#pragma unroll
            for (int k2 = 0; k2 < 2; ++k2) { float vv[8]; unpack8(__builtin_bit_cast(u32x4v, vfr[k2]), vv);
#pragma unroll
                for (int e = 0; e < 8; ++e) vv[e] *= kwv[k2][e];
                const bf16x8 bsc = __builtin_bit_cast(bf16x8, pack8(vv));
#pragma unroll
                for (int dt = 0; dt < 16; ++dt) { const int dr = 256 * (wv >> 2) + 16 * dt + fr; const bf16x8 a = *(const LAS bf16x8*)(KT + dr * 128 + (((4 * k2 + fq) ^ (dr & 7)) << 4));
                    C[dt] = __builtin_amdgcn_mfma_f32_16x16x32_bf16(a, bsc, C[dt], 0, 0, 0);
                    if ((dt & 7) == 7) __builtin_amdgcn_sched_barrier(0); } }
            { float nn = decay * nst[tid];
#pragma unroll
              for (int g = 0; g < 8; ++g) { float kv[8]; unpack8(*(const LAS u32x4v*)(KT + tid * 128 + ((g ^ (tid & 7)) << 4)), kv);
                  { const f32x4 k0 = *(const LAS f32x4*)(kws + 8 * g), k1 = *(const LAS f32x4*)(kws + 8 * g + 4); nn += kv[0] * k0[0] + kv[1] * k0[1] + kv[2] * k0[2] + kv[3] * k0[3] + kv[4] * k1[0] + kv[5] * k1[1] + kv[6] * k1[2] + kv[7] * k1[3]; } }
              nst[tid] = nn; }
            m_st = scal[1];
        }
    }
}

__device__ __forceinline__ void ml_gate_phase(KPC kp, int j) {
    u16* hf = (u16*)(kp->ws + OFF_R2); const u16* xc = (const u16*)(kp->ws + OFF_XC); const u16* z = (const u16*)(kp->ws + OFF_XM);
    const float* ng = kp->in[I_MLNG] + (size_t)j * INNER; const float* sk = kp->in[I_MLSKIP] + (size_t)j * INNER;
    const int lane = ltid() & 63, wv = ltid() >> 6;
    for (int T = lbid() * 8 + wv; T < NTOK; T += gridDim.x * 8) {
        const u16* hbp = hb_ptr(kp, T);
#pragma unroll
        for (int hd = 0; hd < 4; ++hd) { const int c0 = hd * DH + lane * 8; float a[8], bq[8], xv[8], zv[8], o[8];
            unpack8(*(const u32x4v*)(hf + (size_t)T * INNER + c0), a); unpack8(*(const u32x4v*)(hbp + c0), bq);
            float s = 0.f;
#pragma unroll
            for (int e = 0; e < 8; ++e) { a[e] += bq[e]; s += a[e]; }
            const float mu = wave_sum(s) * (1.0f / DH); float vs = 0.f;
#pragma unroll
            for (int e = 0; e < 8; ++e) { a[e] -= mu; vs += a[e] * a[e]; }
            const float rs = rsqrtf(wave_sum(vs) * (1.0f / DH) + 1e-5f);
            unpack8(*(const u32x4v*)(xc + (size_t)T * INNER + c0), xv); unpack8(*(const u32x4v*)(z + (size_t)T * INNER + c0), zv);
            const f32x4 n0 = *(const f32x4*)(ng + c0), n1 = *(const f32x4*)(ng + c0 + 4), s0 = *(const f32x4*)(sk + c0), s1 = *(const f32x4*)(sk + c0 + 4);
            const float ngv[8] = {n0[0], n0[1], n0[2], n0[3], n1[0], n1[1], n1[2], n1[3]}, skv[8] = {s0[0], s0[1], s0[2], s0[3], s1[0], s1[1], s1[2], s1[3]};
#pragma unroll
            for (int e = 0; e < 8; ++e) o[e] = (a[e] * rs * ngv[e] + skv[e] * xv[e]) * siluf(zv[e]);
            *(u32x4v*)(hf + (size_t)T * INNER + c0) = pack8(o); }
    }
}


enum { K_SETUP = 0, K_CN, K_G1, K_G2R, K_HYIN, K_HYCONV, K_HYTR, K_MLUPX, K_MLPREP, K_MLSCAN, K_MLUPZ, K_MLGATE, K_FINAL };
constexpr int NPHASE = 1 + 11 + 13 + 11 + 13 + 1;
__device__ __forceinline__ void decode_phase(int ph, int& kind, int& l, int& arg) {
    kind = K_SETUP; l = 0; arg = 0; if (ph == 0) return;
    ph -= 1;
    for (l = 0; l < 4; ++l) { const int n = (l & 1) ? 13 : 11; if (ph < n) break; ph -= n; }
    if (l == 4) { kind = K_FINAL; l = 0; return; }
    if (ph == 0) { kind = K_CN; arg = 0; return; } if (ph == 1) { kind = K_G1; arg = 0; return; } if (ph == 2) { kind = K_G2R; arg = 0; return; } if (ph == 3) { kind = K_CN; arg = 1; return; }
    const int nm = (l & 1) ? 6 : 4;
    if (ph < 4 + nm) { const int q = ph - 4;
        if (l & 1) { kind = q == 0 ? K_MLUPX : q == 1 ? K_MLPREP : q == 2 ? K_MLSCAN : q == 3 ? K_MLUPZ : q == 4 ? K_MLGATE : K_G2R; arg = 2; }
        else { kind = q == 0 ? K_HYIN : q == 1 ? K_HYCONV : q == 2 ? K_HYTR : K_G2R; arg = 2; }
        return; }
    ph -= 4 + nm;
    if (ph == 0) { kind = K_CN; arg = 2; return; } if (ph == 1) { kind = K_G1; arg = 1; return; } kind = K_G2R; arg = 1;
}

__device__ __forceinline__ void gbar(unsigned* ctr, unsigned target) {
    __syncthreads();
    if (ltid() == 0) {
        __builtin_amdgcn_fence(__ATOMIC_RELEASE, "agent");
        __hip_atomic_fetch_add(ctr, 1u, __ATOMIC_RELAXED, __HIP_MEMORY_SCOPE_AGENT);
        while (__hip_atomic_load(ctr, __ATOMIC_RELAXED, __HIP_MEMORY_SCOPE_AGENT) < target) __builtin_amdgcn_s_sleep(2);
        __builtin_amdgcn_fence(__ATOMIC_ACQUIRE, "agent");
    }
    __syncthreads();
}
#ifndef REPMASK
#define REPMASK 0
#define REPN 1
#endif
template <int MIX> __device__ __forceinline__ void run_phases(int lo, int hi, int ph_lo, int ph_hi, LAS unsigned char* lds0, cg::grid_group& grid) {
    lo = lo > ph_lo ? lo : ph_lo; hi = hi < ph_hi ? hi : ph_hi;
    for (int ph = lo; ph < hi; ++ph) {
        KPC kp = (KPC)__builtin_amdgcn_kernarg_segment_ptr(); asm volatile("" : "+s"(kp) :: "memory");
        LAS unsigned char* lds = lds0; asm volatile("" : "+s"(lds) :: "memory");
        unsigned char* ws = kp->ws; unsigned char* wb = ws + OFF_WB;
        int kind, l, arg; decode_phase(ph, kind, l, arg); const int j = l >> 1;
        const float* modl = (const float*)(ws + OFF_MOD) + (size_t)l * 5 * 9216;
        const int nrep = ((REPMASK >> kind) & 1) ? REPN : 1;
        for (int rep = 0; rep < nrep; ++rep) {
        if (kind == K_SETUP) { if constexpr (MIX == 0) setup_phase(kp, (LAS float*)lds); }
        else if (kind == K_CN) {
            if (arg == 0) { convert_layer(kp, l, (LAS float*)lds); if constexpr (MIX == 1) ml_m_phase(kp, j); }
            if constexpr (MIX == 0) { if (arg == 1) hy_mlp_phase(kp, j); }
            norm_phase(kp, l, arg, arg == 0 ? (l == 0 ? 0 : 11) : arg == 1 ? 11 : (l == 3 ? 0 : (l & 1) ? 8 : 4));
        } else if (kind == K_G1) {
            pg8::Gemm g{(const u16*)(ws + OFF_U), (const u16*)(wb + (arg ? WB_FIN1 : WB_FIN0)), NTOK, 2 * FF, D};
            pg8::StaticOrder S; S.init(g.M, g.N, (int)gridDim.x, lbid(), (l == 3 && arg == 1) ? 1 : 0); EpiSwiglu E{(u16*)(ws + OFF_R1)};
            pg8::gemm_phase<EpiSwiglu, pg8::StaticOrder, false>(lds, g, S, E, nullptr);
        } else if (kind == K_G2R) {
            const u16* gA; const u16* gB; int gK, gidx, gbj = -1;
            if (arg < 2) { gA = (const u16*)(ws + OFF_R1); gB = (const u16*)(wb + (arg ? WB_FOUT1 : WB_FOUT0)); gK = FF; gidx = arg ? 8 : 2; }
            else if (MIX == 1) { gA = (const u16*)(ws + OFF_R2); gB = (const u16*)(wb + WB_MOUT); gK = INNER; gidx = 5; }
            else { gA = (const u16*)(ws + OFF_U); gB = (const u16*)(wb + WB_MOUT); gK = D; gidx = 5; gbj = j; }
            const pg8::Gemm g{gA, gB, NTOK, D, gK, 0}; const EpiResid E{kp, l, gidx, gbj};
            pg8::StaticOrder S; S.init(g.M, g.N, (int)gridDim.x, lbid(), (l == 3 && arg >= 1) ? 1 : 2, g.K / 256);
            pg8::gemm_phase<EpiResid, pg8::StaticOrder, false>(lds, g, S, E, nullptr);
        } else if (kind == K_FINAL) { if constexpr (MIX == 1) final_phase(kp); }
        else if constexpr (MIX == 0) {
            if (kind == K_HYIN) {
                pg8::Gemm g{(const u16*)(wb + WB_MIN), (const u16*)(ws + OFF_U), 3 * D, NTOK, D};
                pg8::StaticOrder S; S.init(g.M, g.N, (int)gridDim.x, lbid());
                EpiProjT E{(u16*)(ws + OFF_R1 + HY_PL), (u16*)(ws + OFF_R1 + HY_PC), kp->in[I_HYBIN] + (size_t)j * 3 * D};
                pg8::gemm_phase<EpiProjT, pg8::StaticOrder, false>(lds, g, S, E, nullptr);
                __syncthreads();
                for (int t = lbid(); t < 2048; t += gridDim.x) hy_filter_task(kp, j, t, (LAS f32x2*)lds, (LAS float*)(lds + 131072));
            } else if (kind == K_HYCONV) {
                for (int t = lbid(); t < 2048; t += gridDim.x) hy_conv_lat(kp, j, t, (LAS f32x2*)lds);
                for (int t = lbid(); t < 1024; t += gridDim.x) hy_conv_ctx(kp, j, t, (LAS float*)lds);
            } else if (kind == K_HYTR) hy_transpose(kp, (LAS u16*)lds);
        } else {
            if (kind == K_MLUPX || kind == K_MLUPZ) {
                const bool zz = kind == K_MLUPZ;
                pg8::Gemm g{(const u16*)(ws + OFF_U), (const u16*)(wb + WB_MIN) + (zz ? (size_t)INNER * D : 0), NTOK, INNER, D};
                pg8::StaticOrder S; S.init(g.M, g.N, (int)gridDim.x, lbid(), (zz && l == 3) ? 1 : 0); EpiBf E{(u16*)(ws + OFF_XM), INNER};
                pg8::gemm_phase<EpiBf, pg8::StaticOrder, false>(lds, g, S, E, nullptr);
            } else if (kind == K_MLPREP) { for (int t = lbid(); t < NB * NCH * 4; t += gridDim.x) ml_prep_task(kp, j, t, lds); }
            else if (kind == K_MLSCAN) { for (int t = lbid(); t < 256; t += gridDim.x) ml_scan_task(kp, j, t, lds); }
            else if (kind == K_MLGATE) ml_gate_phase(kp, j);
        }
        }
        if (ph + 1 < ph_hi) gbar((unsigned*)(kp->ws + OFF_MLM + 65536), (unsigned)(ph + 1 - ph_lo) * gridDim.x);
    }
}

__global__ void __launch_bounds__(512) fwd_megakernel(KP kparg) {
    extern __shared__ __attribute__((aligned(16))) unsigned char shm[];
    LAS unsigned char* lds = (LAS unsigned char*)shm;
    cg::grid_group grid = cg::this_grid();
    grid.sync();
    wtab_init();
    const int ph_lo = kparg.ph_lo, ph_hi = kparg.ph_hi;
    run_phases<0>(0, 12, ph_lo, ph_hi, lds, grid);
    run_phases<1>(12, 25, ph_lo, ph_hi, lds, grid);
    run_phases<0>(25, 36, ph_lo, ph_hi, lds, grid);
    run_phases<1>(36, 50, ph_lo, ph_hi, lds, grid);
}

extern "C" void kernel_launch(void* const* d_in, const int* in_sizes, int n_in, void* d_out, int out_size, void* d_ws, size_t ws_size, hipStream_t stream) {
    static int grid_blocks = 0;
    if (!grid_blocks) {
        int dev = 0, cus = 0, per_cu = 0;
        hipGetDevice(&dev);
        hipDeviceGetAttribute(&cus, hipDeviceAttributeMultiprocessorCount, dev);
        hipFuncSetAttribute((const void*)fwd_megakernel, hipFuncAttributeMaxDynamicSharedMemorySize, LDS_BYTES);
        hipOccupancyMaxActiveBlocksPerMultiprocessor(&per_cu, fwd_megakernel, 512, LDS_BYTES);
        if (per_cu < 1) per_cu = 1;
        grid_blocks = cus * 1;
        if (ws_size < WS_NEED2) fprintf(stderr, "workspace too small: %zu < %zu\n", ws_size, (size_t)WS_NEED2);
    }
    KP hp{};
    for (int i = 0; i < 36; ++i) hp.in[i] = (const float*)d_in[i];
    hp.out = (float*)d_out; hp.ws = (unsigned char*)d_ws; hp.ph_lo = 0; hp.ph_hi = NPHASE;
    void* args[] = {&hp};
    hipMemsetAsync((unsigned char*)d_ws + OFF_MLM + 65536, 0, 256, stream);
    hipError_t e = hipLaunchCooperativeKernel((void*)fwd_megakernel, dim3(grid_blocks), dim3(512), args, LDS_BYTES, stream);
    if (e != hipSuccess) fprintf(stderr, "cooperative launch failed: %s (grid %d)\n", hipGetErrorString(e), grid_blocks);
}
```

```cpp
#define REPMASK 0
#define REPN 1
#include <hip/hip_runtime.h>
#include <hip/hip_cooperative_groups.h>
#include <cstdio>
namespace cg = cooperative_groups;
#define WTAB_OFF 163584
__device__ __forceinline__ int llane() { int l; asm volatile("v_mbcnt_lo_u32_b32 %0, -1, 0\n\tv_mbcnt_hi_u32_b32 %0, -1, %0" : "=v"(l) :: "memory"); return l; }
__device__ __forceinline__ int lwave() { extern __shared__ __attribute__((aligned(16))) unsigned char shm_w[];
    const int hw = __builtin_amdgcn_s_getreg(10244) & 63;
    return __builtin_amdgcn_readfirstlane(*(const __attribute__((address_space(3))) int*)((__attribute__((address_space(3))) unsigned char*)shm_w + WTAB_OFF + hw * 4)); }
__device__ __forceinline__ void wtab_init() { extern __shared__ __attribute__((aligned(16))) unsigned char shm_w[];
    const int hw = __builtin_amdgcn_s_getreg(10244) & 63;
    *(__attribute__((address_space(3))) int*)((__attribute__((address_space(3))) unsigned char*)shm_w + WTAB_OFF + hw * 4) = (int)(threadIdx.x >> 6); }
__device__ __forceinline__ int ltid() { return lwave() * 64 + llane(); }
__device__ __forceinline__ int lbid() { int t = blockIdx.x; asm volatile("" : "+s"(t) :: "memory"); return t; }
namespace pg8 {
#define PG8_LAS __attribute__((address_space(3)))
typedef unsigned short bf16_t;
typedef short bf16x8 __attribute__((ext_vector_type(8)));
typedef float f32x4 __attribute__((ext_vector_type(4)));
typedef unsigned u32x4 __attribute__((ext_vector_type(4)));
constexpr int BM = 256, BK = 64, HALF = 128, HTB = HALF * BK * 2  , STAGE_BYTES = 8 * HTB, NXCD = 8, WGM = 8;

__host__ __device__ __forceinline__ int lds_byte(int r, int c) { const int st = (r >> 4) * 2 + (c >> 5), rr = r & 15, cc = c & 31, ob = rr * 64 + cc * 2; return st * 1024 + (ob ^ (((ob >> 9) & 1) << 5)); }
__host__ __device__ __forceinline__ void stage_rc(int b, int& R, int& C) { const int st = b / 1024, sb = b % 1024, swz = sb ^ (((sb >> 9) & 1) << 5); R = (st >> 1) * 16 + swz / 64; C = (st & 1) * 32 + (swz % 64) / 2; }
__host__ __device__ __forceinline__ int perm32(int rho) { const int n = rho >> 4, i = rho & 15; return 8 * (i >> 2) + 4 * n + (i & 3); }

struct Unit { int pm, pn, kofs, nt; };
struct Gemm { const bf16_t* A; const bf16_t* Bt; int M, N, K, ldk; };

struct StaticOrder {
    int nM, nN, nwg, G, c, lat, nk;
    __host__ __device__ void init(int M, int N, int G_, int c_, int lat_ = 0, int nk_ = 0) { lat = lat_; nk = nk_; nM = lat ? 128 : M / BM; nN = N / BM; nwg = nM * nN; G = G_; c = c_; }
    __host__ __device__ bool next(int i, Unit& u) const {
        const long L = (long)i * G + c;
        if (L >= nwg) { if (lat != 2 || L >= nwg + 16 * nk) return false; const int Lc = (int)L - nwg, un = Lc & 15; u.pm = (un >> 2) * 33; u.pn = un & 3; u.kofs = (Lc >> 4) * 256; u.nt = 4; return true; }
        int wgid = (int)L; { const int q = nwg / NXCD, r = nwg % NXCD, xcd = wgid % NXCD, off = wgid / NXCD; wgid = (xcd < r ? xcd * (q + 1) : r * (q + 1) + (xcd - r) * q) + off; }
        const int nig = WGM * nN, gid = wgid / nig, fm = gid * WGM, gsz = (nM - fm) < WGM ? (nM - fm) : WGM;
        u.pm = fm + ((wgid % nig) % gsz); u.pn = (wgid % nig) / gsz; u.kofs = 0; u.nt = 0; if (lat) u.pm = (u.pm >> 5) * 33 + 1 + (u.pm & 31); return true;
    }
    __device__ __forceinline__ void a_ready(const Unit&) const {}
    __device__ __forceinline__ void done(const Unit&) const {}
};
__device__ __forceinline__ unsigned cvt_pk_bf16(float lo, float hi) { unsigned r; asm volatile("v_cvt_pk_bf16_f32 %0, %1, %2" : "=v"(r) : "v"(lo), "v"(hi)); return r; }
template <class Epi, class Sched, bool STAMP = false>
__device__ __forceinline__ void gemm_phase(PG8_LAS unsigned char* lds, const Gemm g, const Sched& S, const Epi& E, unsigned long long* stamps) {
    const int tid = ltid(), wid = __builtin_amdgcn_readfirstlane(tid >> 6), lane = tid & 63, wr = wid >> 2, wc = wid & 3, fr = lane & 15, fq = lane >> 4;
    const int K = g.K, nt = K / BK, ldk = g.ldk ? g.ldk : g.K;
    int ts_lo = 0, ts_hi = 0, nts = 0; const unsigned long long rt_entry = STAMP ? (unsigned long long)wall_clock64() : 0ull;
#define PG8_STAMP() do { if (STAMP && wid == 0 && nts < 64) { const unsigned long long _c = (unsigned long long)clock64(); \
        ts_lo = (lane == nts) ? (int)(unsigned)_c : ts_lo; ts_hi = (lane == nts) ? (int)(unsigned)(_c >> 32) : ts_hi; ++nts; } } while (0)
    PG8_STAMP();
    unsigned voffA[2], voffB[2];
#pragma unroll
    for (int i = 0; i < 2; ++i) { int R, C; stage_rc(tid * 16 + i * 8192, R, C); const int Rb = Epi::PERM ? ((R & ~31) + perm32(R & 31)) : R;
        voffA[i] = (unsigned)(R * ldk + C) * 2u; voffB[i] = (unsigned)(Rb * ldk + C) * 2u; }
    const size_t kstep = (size_t)(BK * 2);
    const size_t hstep = (size_t)HALF * ldk * 2;
    const size_t tstep = 2 * hstep;
    const unsigned ldsw = (unsigned)wid * 1024u;
    const int aoff = lds_byte(wr * 64 + fr, fq * 8), boff = lds_byte(wc * 32 + fr, fq * 8);
#define PG8_SA(b, h) (((b) * 2 + (h)) * HTB)
#define PG8_SB(b, h) ((4 + (b) * 2 + (h)) * HTB)
#define PG8_STAGE(bufoff, gbase, voff) do { _Pragma("unroll") for (int _i = 0; _i < 2; ++_i) \
        __builtin_amdgcn_global_load_lds((const unsigned*)((const char*)(gbase) + (voff)[_i]), (PG8_LAS unsigned*)(lds + (bufoff) + ldsw + _i * 8192), 16, 0, 0); } while (0)
#define PG8_LDA(dst, b, h) do { _Pragma("unroll") for (int m = 0; m < 4; ++m) _Pragma("unroll") for (int k = 0; k < 2; ++k) dst[m][k] = *(const PG8_LAS bf16x8*)(lds + PG8_SA(b, h) + aoff + m * 2048 + k * 1024); } while (0)
#define PG8_LDB(dst, b, h) do { _Pragma("unroll") for (int n = 0; n < 2; ++n) _Pragma("unroll") for (int k = 0; k < 2; ++k) dst[n][k] = *(const PG8_LAS bf16x8*)(lds + PG8_SB(b, h) + boff + n * 2048 + k * 1024); } while (0)
#define PG8_MMA(ai, bj, At, Bt) do { __builtin_amdgcn_s_setprio(1); _Pragma("unroll") for (int m = 0; m < 4; ++m) _Pragma("unroll") for (int n = 0; n < 2; ++n) _Pragma("unroll") for (int k = 0; k < 2; ++k) \
        acc[ai][bj][m][n] = __builtin_amdgcn_mfma_f32_16x16x32_bf16(Bt[n][k], At[m][k], acc[ai][bj][m][n], 0, 0, 0); __builtin_amdgcn_s_setprio(0); } while (0)
#define PG8_WAIT_V(n) asm volatile("s_waitcnt vmcnt(" #n ")" ::: "memory")
#define PG8_WAIT_L(n) asm volatile("s_waitcnt lgkmcnt(" #n ")" ::: "memory")
#define PG8_BAR __builtin_amdgcn_s_barrier()
#define PG8_SCHED __builtin_amdgcn_sched_barrier(0)
    Unit cur, nxt; int ui = 0;
    if (!S.next(0, cur)) return;
    f32x4 acc[2][2][4][2];
#pragma unroll
    for (int a = 0; a < 2; ++a)
#pragma unroll
        for (int b = 0; b < 2; ++b)
#pragma unroll
            for (int m = 0; m < 4; ++m)
#pragma unroll
                for (int n = 0; n < 2; ++n) acc[a][b][m][n] = (f32x4){0.f, 0.f, 0.f, 0.f};
    bf16x8 At[4][2], B0[2][2], B1[2][2];
    const char* cA = (const char*)g.A + (size_t)cur.pm * tstep + (size_t)cur.kofs * 2; const char* cB = (const char*)g.Bt + (size_t)cur.pn * tstep + (size_t)cur.kofs * 2;
    S.a_ready(cur);
    PG8_STAGE(PG8_SB(0, 0), cB, voffB); PG8_STAGE(PG8_SA(0, 0), cA, voffA); PG8_STAGE(PG8_SB(0, 1), cB + hstep, voffB); PG8_STAGE(PG8_SA(0, 1), cA + hstep, voffA);
    if (wr == 1) PG8_BAR;
    PG8_WAIT_V(4); PG8_BAR;
    PG8_STAGE(PG8_SB(1, 0), cB + kstep, voffB); PG8_STAGE(PG8_SA(1, 0), cA + kstep, voffA); PG8_STAGE(PG8_SB(1, 1), cB + hstep + kstep, voffB);
    PG8_WAIT_V(6); PG8_BAR;
    PG8_STAMP();
    for (;;) {
        const bool has_next = S.next(ui + 1, nxt);
        const char* nA = has_next ? (const char*)g.A + (size_t)nxt.pm * tstep + (size_t)nxt.kofs * 2 : cA; const char* nB = has_next ? (const char*)g.Bt + (size_t)nxt.pn * tstep + (size_t)nxt.kofs * 2 : cB;
        const int ntu = cur.nt ? cur.nt : nt;
        for (int t = 0; t < ntu; t += 2) {
            const bool last = (t == ntu - 2);
            const char* a1 = cA + (size_t)(t + 1) * kstep;
            const char* a2 = last ? nA : cA + (size_t)(t + 2) * kstep; const char* b2 = last ? nB : cB + (size_t)(t + 2) * kstep;
            const char* a3 = a2 + kstep; const char* b3 = b2 + kstep;
            if (last && has_next) S.a_ready(nxt);
            PG8_LDB(B0, 0, 0); PG8_SCHED; PG8_LDA(At, 0, 0); PG8_STAGE(PG8_SA(1, 1), a1 + hstep, voffA);
            PG8_WAIT_L(8); PG8_BAR; PG8_WAIT_L(0); PG8_MMA(0, 0, At, B0); PG8_BAR; PG8_SCHED;
            PG8_LDB(B1, 0, 1); PG8_STAGE(PG8_SB(0, 0), b2, voffB);
            PG8_BAR; PG8_WAIT_L(0); PG8_MMA(0, 1, At, B1); PG8_BAR;
            PG8_LDA(At, 0, 1); PG8_STAGE(PG8_SA(0, 0), a2, voffA);
            PG8_BAR; PG8_WAIT_L(0); PG8_MMA(1, 0, At, B0); PG8_BAR; PG8_SCHED;
            PG8_STAGE(PG8_SB(0, 1), b2 + hstep, voffB);
            PG8_WAIT_V(6); PG8_BAR; PG8_MMA(1, 1, At, B1); PG8_BAR;
            PG8_LDB(B0, 1, 0); PG8_SCHED; PG8_LDA(At, 1, 0); PG8_STAGE(PG8_SA(0, 1), a2 + hstep, voffA);
            PG8_WAIT_L(8); PG8_BAR; PG8_WAIT_L(0); PG8_MMA(0, 0, At, B0); PG8_BAR; PG8_SCHED;
            PG8_LDB(B1, 1, 1); PG8_STAGE(PG8_SB(1, 0), b3, voffB);
            PG8_BAR; PG8_WAIT_L(0); PG8_MMA(0, 1, At, B1); PG8_BAR;
            PG8_LDA(At, 1, 1); PG8_STAGE(PG8_SA(1, 0), a3, voffA);
            PG8_BAR; PG8_WAIT_L(0); PG8_MMA(1, 0, At, B0); PG8_BAR; PG8_SCHED;
            PG8_STAGE(PG8_SB(1, 1), b3 + hstep, voffB);
            PG8_WAIT_V(6); PG8_BAR; PG8_MMA(1, 1, At, B1); PG8_BAR;
        }
        PG8_STAMP();
        if constexpr (!Epi::AFTER_DRAIN) { E(acc, cur, wr, wc, fr, fq); S.done(cur); }
        PG8_STAMP();
        if (!has_next) break;
#pragma unroll
        for (int a = 0; a < 2; ++a)
#pragma unroll
            for (int b = 0; b < 2; ++b)
#pragma unroll
                for (int m = 0; m < 4; ++m)
#pragma unroll
                    for (int n = 0; n < 2; ++n) acc[a][b][m][n] = (f32x4){0.f, 0.f, 0.f, 0.f};
        cur = nxt; cA = nA; cB = nB; ++ui;
    }
    PG8_WAIT_V(0);
    if (wr == 0) PG8_BAR;
    PG8_BAR;
    if constexpr (Epi::AFTER_DRAIN) { E.fused(acc, cur, wr, wc, fr, fq, lds, wid, lane); S.done(cur); }
    PG8_STAMP();
    if (STAMP && wid == 0) { stamps[lane] = lane < nts ? (((unsigned long long)(unsigned)ts_hi << 32) | (unsigned)ts_lo) : 0ull;
        if (lane == 62) stamps[62] = rt_entry; if (lane == 63) stamps[63] = (unsigned long long)wall_clock64(); }
#undef PG8_STAMP
#undef PG8_SA
#undef PG8_SB
#undef PG8_STAGE
#undef PG8_LDA
#undef PG8_LDB
#undef PG8_MMA
#undef PG8_WAIT_V
#undef PG8_WAIT_L
#undef PG8_BAR
#undef PG8_SCHED
}
}

typedef unsigned short u16;
using pg8::f32x4; using pg8::bf16x8;
typedef float f32x2 __attribute__((ext_vector_type(2)));
typedef unsigned u32x2 __attribute__((ext_vector_type(2)));
typedef unsigned u32x4v __attribute__((ext_vector_type(4)));
typedef short s16x4 __attribute__((ext_vector_type(4)));
#define LAS __attribute__((address_space(3)))
constexpr int D = 1024, NB = 4, SEQ = 8192, CTX = 256, TPB = 8448, NTOK = 33792, FF = 2816, NCH = 132, INNER = 2048, DH = 512, NFFT = 16384;
constexpr size_t MiB = 1u << 20;
constexpr size_t OFF_WB = 0, OFF_MOD = 48 * MiB, OFF_H = 49 * MiB, OFF_U = OFF_H + 132 * MiB, OFF_R1 = OFF_U + 66 * MiB, OFF_R2 = OFF_R1 + 264 * MiB,
                 OFF_HBC = OFF_R2 + 132 * MiB, OFF_GATES = OFF_HBC + 4 * MiB, OFF_H2 = OFF_GATES + 3 * MiB, OFF_KCTX = OFF_H2 + 3 * MiB, WS_NEED = OFF_KCTX + 4 * MiB;
constexpr size_t WB_FIN0 = 0, WB_FIN1 = 11 * MiB, WB_FOUT0 = 22 * MiB, WB_FOUT1 = 22 * MiB + 5632 * 1024, WB_MIN = 33 * MiB, WB_MOUT = 41 * MiB, WB_WGT = 45 * MiB;
constexpr int LDS_BYTES = 163840;
struct KP { const float* in[36]; float* out; unsigned char* ws; int ph_lo, ph_hi; };
typedef const KP __attribute__((address_space(4))) * KPC;
enum { I_X = 0, I_C, I_CTX, I_CCTX, I_ADAW, I_ADAB, I_NORMG, I_FINALG, I_FFNIN, I_FFNOUT, I_HYWIN, I_HYBIN, I_HYCW, I_HYCB, I_HYW1, I_HYB1, I_HYW2, I_HYB2, I_HYW3, I_HYB3,
       I_HYFREQ, I_HYDECAY, I_HYSKIP, I_HYWOUT, I_HYBOUT, I_MLUP, I_MLCW, I_MLCB, I_MLWQ, I_MLWK, I_MLWV, I_MLWG, I_MLBG, I_MLNG, I_MLSKIP, I_MLDOWN };

__device__ __forceinline__ float bf2f(u16 b) { return __uint_as_float(((unsigned)b) << 16); }
__device__ __forceinline__ float bflo(unsigned w) { return __uint_as_float(w << 16); }
__device__ __forceinline__ float bfhi(unsigned w) { return __uint_as_float(w & 0xffff0000u); }
__device__ __forceinline__ u16 f2bf(float f) { return (u16)(pg8::cvt_pk_bf16(f, 0.f) & 0xffffu); }
__device__ __forceinline__ float siluf(float x) { return x * __builtin_amdgcn_rcpf(1.0f + __expf(-x)); }
__device__ __forceinline__ int modrow_of_token(int T) { const int b = T / TPB, t = T - b * TPB; return t < CTX ? 4 : b; }
__device__ __forceinline__ float lshfl(float v, int srclane) { return __int_as_float(__builtin_amdgcn_ds_bpermute(srclane << 2, __float_as_int(v))); }
__device__ __forceinline__ float wave_sum(float v) { const int lane = llane();
#pragma unroll
    for (int o = 32; o > 0; o >>= 1) v += lshfl(v, lane ^ o);
    return v; }
__device__ __forceinline__ float wave_max(float v) { const int lane = llane();
#pragma unroll
    for (int o = 32; o > 0; o >>= 1) v = fmaxf(v, lshfl(v, lane ^ o));
    return v; }

__device__ __forceinline__ void unpack8(u32x4v w, float (&f)[8]) { f[0] = bflo(w.x); f[1] = bfhi(w.x); f[2] = bflo(w.y); f[3] = bfhi(w.y); f[4] = bflo(w.z); f[5] = bfhi(w.z); f[6] = bflo(w.w); f[7] = bfhi(w.w); }
__device__ __forceinline__ u32x4v pack8(const float (&f)[8]) { u32x4v w; w.x = pg8::cvt_pk_bf16(f[0], f[1]); w.y = pg8::cvt_pk_bf16(f[2], f[3]); w.z = pg8::cvt_pk_bf16(f[4], f[5]); w.w = pg8::cvt_pk_bf16(f[6], f[7]); return w; }

struct EpiSwiglu {
    static constexpr bool PERM = true, AFTER_DRAIN = false;
    u16* act;
    __device__ __forceinline__ void operator()(const f32x4 (&acc)[2][2][4][2], const pg8::Unit& u, int wr, int wc, int fr, int fq) const {
        const int row0 = u.pm * 256 + wr * 64 + fr, col0 = u.pn * 128 + wc * 32 + 8 * fq;
#pragma unroll
        for (int ai = 0; ai < 2; ++ai)
#pragma unroll
            for (int m = 0; m < 4; ++m) {
                const f32x4 g0 = acc[ai][0][m][0], g1 = acc[ai][0][m][1], v0 = acc[ai][1][m][0], v1 = acc[ai][1][m][1];
                u32x4v w;
                w.x = pg8::cvt_pk_bf16(siluf(g0[0]) * v0[0], siluf(g0[1]) * v0[1]); w.y = pg8::cvt_pk_bf16(siluf(g0[2]) * v0[2], siluf(g0[3]) * v0[3]);
                w.z = pg8::cvt_pk_bf16(siluf(g1[0]) * v1[0], siluf(g1[1]) * v1[1]); w.w = pg8::cvt_pk_bf16(siluf(g1[2]) * v1[2], siluf(g1[3]) * v1[3]);
                *(u32x4v*)(act + (size_t)(row0 + ai * 128 + m * 16) * FF + col0) = w; }
    }
};
struct EpiResid {
    static constexpr bool PERM = false, AFTER_DRAIN = false;
    KPC kp; int l, gidx, bias_j;
    __device__ __forceinline__ void operator()(const f32x4 (&acc)[2][2][4][2], const pg8::Unit& u, int wr, int wc, int fr, int fq) const {
        unsigned char* ws = kp->ws; float* h = (float*)(ws + OFF_H); float* part = (float*)kp->out;
        const float* bias = bias_j >= 0 ? kp->in[I_HYBOUT] + (size_t)bias_j * D : nullptr; const float scale = gidx == 5 ? 1.0f : 0.5f;
        const int col0 = u.pn * 256 + wc * 32 + 4 * fq;
        const int mr = modrow_of_token(u.pm * 256);
        const float* gp = (const float*)(ws + OFF_MOD) + ((size_t)l * 5 + mr) * 9216 + gidx * 1024;
        const bool split = u.nt != 0, addb = bias != nullptr && u.kofs == 0;
        float* base = split ? part + ((size_t)(u.kofs >> 8) * 1024 + (u.pm / 33) * 256 + wr * 64 + fr) * D : h + (size_t)(u.pm * 256 + wr * 64 + fr) * D;
#pragma unroll
        for (int bj = 0; bj < 2; ++bj)
#pragma unroll
            for (int n = 0; n < 2; ++n) { const f32x4 gv = *(const f32x4*)(gp + col0 + bj * 128 + n * 16) * scale;
                const f32x4 bv = addb ? *(const f32x4*)(bias + col0 + bj * 128 + n * 16) : (f32x4){0.f, 0.f, 0.f, 0.f};
#pragma unroll
                for (int ai = 0; ai < 2; ++ai)
#pragma unroll
                    for (int m = 0; m < 4; ++m) { f32x4* q = (f32x4*)(base + (size_t)(ai * 128 + m * 16) * D + col0 + bj * 128 + n * 16); const f32x4 v = gv * (acc[ai][bj][m][n] + bv);
                        if (split) *q = v; else *q = *q + v; } }
    }
};
struct EpiBf {
    static constexpr bool PERM = true, AFTER_DRAIN = false;
    u16* O; int ldc;
    __device__ __forceinline__ void operator()(const f32x4 (&acc)[2][2][4][2], const pg8::Unit& u, int wr, int wc, int fr, int fq) const {
        const int row0 = u.pm * 256 + wr * 64 + fr, col0 = u.pn * 256 + wc * 32 + 8 * fq;
#pragma unroll
        for (int ai = 0; ai < 2; ++ai)
#pragma unroll
            for (int m = 0; m < 4; ++m)
#pragma unroll
                for (int bj = 0; bj < 2; ++bj) { const f32x4 a = acc[ai][bj][m][0], b = acc[ai][bj][m][1]; u32x4v w;
                    w.x = pg8::cvt_pk_bf16(a[0], a[1]); w.y = pg8::cvt_pk_bf16(a[2], a[3]); w.z = pg8::cvt_pk_bf16(b[0], b[1]); w.w = pg8::cvt_pk_bf16(b[2], b[3]);
                    *(u32x4v*)(O + (size_t)(row0 + ai * 128 + m * 16) * ldc + col0 + bj * 128) = w; }
    }
};
struct EpiProjT {
    static constexpr bool PERM = true, AFTER_DRAIN = false;
    u16* lat; u16* ctx; const float* bias;
    __device__ __forceinline__ void operator()(const f32x4 (&acc)[2][2][4][2], const pg8::Unit& u, int wr, int wc, int fr, int fq) const {
        const int row0 = u.pm * 256 + wr * 64 + fr, tc0 = wc * 32 + 8 * fq;
        const int b = u.pn / 33, tile = u.pn - b * 33;
#pragma unroll
        for (int ai = 0; ai < 2; ++ai)
#pragma unroll
            for (int m = 0; m < 4; ++m) { const int ch = row0 + ai * 128 + m * 16; const float bs = bias[ch];
                u16* dst = tile == 0 ? ctx + ((size_t)b * 3072 + ch) * CTX + tc0 : lat + ((size_t)b * 3072 + ch) * SEQ + (tile - 1) * 256 + tc0;
#pragma unroll
                for (int bj = 0; bj < 2; ++bj) { const f32x4 a = acc[ai][bj][m][0] + bs, c = acc[ai][bj][m][1] + bs; u32x4v w;
                    w.x = pg8::cvt_pk_bf16(a[0], a[1]); w.y = pg8::cvt_pk_bf16(a[2], a[3]); w.z = pg8::cvt_pk_bf16(c[0], c[1]); w.w = pg8::cvt_pk_bf16(c[2], c[3]);
                    *(u32x4v*)(dst + bj * 128) = w; } }
    }
};


struct LatOrder : pg8::StaticOrder {
    __device__ bool next(int i, pg8::Unit& u) const { if (!pg8::StaticOrder::next(i, u)) return false; u.pm = (u.pm >> 5) * 33 + 1 + (u.pm & 31); return true; }
};
struct CtxSplitOrder {
    int nk, G, c;
    __device__ bool next(int i, pg8::Unit& u) const { const int L = i * G + c; if (L >= 16 * nk) return false; const int un = L & 15, kc = L >> 4; u.pm = (un >> 2) * 33; u.pn = un & 3; u.kofs = kc * 256; return true; }
    __device__ __forceinline__ void a_ready(const pg8::Unit&) const {}
    __device__ __forceinline__ void done(const pg8::Unit&) const {}
};
struct EpiResidAtomic {
    static constexpr bool PERM = false, AFTER_DRAIN = false;
    float* h; const float* gp; float scale;
    __device__ __forceinline__ void operator()(const f32x4 (&acc)[2][2][4][2], const pg8::Unit& u, int wr, int wc, int fr, int fq) const {
        const int row0 = u.pm * 256 + wr * 64 + fr, col0 = u.pn * 256 + wc * 32 + 4 * fq;
#pragma unroll
        for (int bj = 0; bj < 2; ++bj)
#pragma unroll
            for (int n = 0; n < 2; ++n) { const f32x4 gv = *(const f32x4*)(gp + col0 + bj * 128 + n * 16) * scale;
#pragma unroll
                for (int ai = 0; ai < 2; ++ai)
#pragma unroll
                    for (int m = 0; m < 4; ++m) { float* q = h + (size_t)(row0 + ai * 128 + m * 16) * D + col0 + bj * 128 + n * 16; const f32x4 v = gv * acc[ai][bj][m][n];
                        atomicAdd(q, v[0]); atomicAdd(q + 1, v[1]); atomicAdd(q + 2, v[2]); atomicAdd(q + 3, v[3]); } }
    }
};

__device__ __forceinline__ void ctx_bias_phase(KPC kp, const float* gp, const float* bias) {
    float* h = (float*)(kp->ws + OFF_H);
    for (int i = lbid() * 512 + ltid(); i < NB * CTX * 256; i += gridDim.x * 512) { const int r = i >> 8, c = (i & 255) * 4, b = r >> 8, t = r & 255;
        f32x4* q = (f32x4*)(h + ((size_t)b * TPB + t) * D + c); *q = *q + *(const f32x4*)(gp + c) * *(const f32x4*)(bias + c); }
}
__device__ __forceinline__ int colmap(int n, int mapmode) { return mapmode ? (((n >> 8) << 7) + (n & 127) + ((n >> 7) & 1) * FF) : n; }
__device__ __forceinline__ void convert_T(const float* __restrict__ src, int ld, int K, int Nd, int mapmode, u16* __restrict__ dst, LAS float* tile, int& tctr) {
    const int tid = ltid(), nkt = K / 64, ntile = (Nd / 64) * nkt;
    const int G = (int)gridDim.x; const int first = (((lbid() - tctr) % G) + G) % G; tctr += ntile;
    for (int t = first; t < ntile; t += G) {
        const int n0 = (t / nkt) * 64, k0 = (t % nkt) * 64, c0 = colmap(n0, mapmode);
#pragma unroll
        for (int i = 0; i < 2; ++i) { const int e = tid + 512 * i, kr = e >> 4, c4 = (e & 15) * 4;
            const f32x4 v = *(const f32x4*)(src + (size_t)(k0 + kr) * ld + c0 + c4);
            tile[kr * 65 + c4] = v[0]; tile[kr * 65 + c4 + 1] = v[1]; tile[kr * 65 + c4 + 2] = v[2]; tile[kr * 65 + c4 + 3] = v[3]; }
        __syncthreads();
        { const int n = tid >> 3, k8 = (tid & 7) * 8; u32x4v w;
          w.x = pg8::cvt_pk_bf16(tile[(k8 + 0) * 65 + n], tile[(k8 + 1) * 65 + n]); w.y = pg8::cvt_pk_bf16(tile[(k8 + 2) * 65 + n], tile[(k8 + 3) * 65 + n]);
          w.z = pg8::cvt_pk_bf16(tile[(k8 + 4) * 65 + n], tile[(k8 + 5) * 65 + n]); w.w = pg8::cvt_pk_bf16(tile[(k8 + 6) * 65 + n], tile[(k8 + 7) * 65 + n]);
          *(u32x4v*)(dst + (size_t)(n0 + n) * K + k0 + k8) = w; }
        __syncthreads();
    }
}

__device__ __forceinline__ void norm_phase(KPC kp, int l, int sub, int nkp) {
    const float* h = (const float*)(kp->ws + OFF_H); u16* uo = (u16*)(kp->ws + OFF_U);
    const float* g = kp->in[I_NORMG] + (size_t)(l * 3 + sub) * D; const float* modl = (const float*)(kp->ws + OFF_MOD) + (size_t)l * 5 * 9216;
    const int lane = ltid() & 63, wv = ltid() >> 6;
    for (int T = lbid() * 8 + wv; T < NTOK; T += gridDim.x * 8) {
        const float* hr = h + (size_t)T * D; f32x4 v[4]; float ss = 0.f;
        const int bT = T / TPB, tT = T - bT * TPB; const bool fold = nkp > 0 && tT < CTX;
#pragma unroll
        for (int i = 0; i < 4; ++i) { v[i] = *(const f32x4*)(hr + i * 256 + lane * 4);
            if (fold) { const float* pp = (const float*)kp->out + ((size_t)bT * CTX + tT) * D + i * 256 + lane * 4; for (int kc = 0; kc < nkp; ++kc) v[i] += *(const f32x4*)(pp + (size_t)kc * 1024 * D);
                *(f32x4*)((float*)(kp->ws + OFF_H) + (size_t)T * D + i * 256 + lane * 4) = v[i]; }
            ss += v[i][0] * v[i][0] + v[i][1] * v[i][1] + v[i][2] * v[i][2] + v[i][3] * v[i][3]; }
        ss = wave_sum(ss); const float rs = rsqrtf(ss * (1.0f / D) + 1e-6f);
        const float* mp = modl + (size_t)modrow_of_token(T) * 9216 + sub * 3 * 1024;
#pragma unroll
        for (int i = 0; i < 4; ++i) { const int c = i * 256 + lane * 4; const f32x4 gg = *(const f32x4*)(g + c), sh = *(const f32x4*)(mp + c), sc = *(const f32x4*)(mp + 1024 + c);
            const f32x4 o = v[i] * rs * gg * (sc + 1.0f) + sh; u32x2 w; w.x = pg8::cvt_pk_bf16(o[0], o[1]); w.y = pg8::cvt_pk_bf16(o[2], o[3]);
            *(u32x2*)(uo + (size_t)T * D + c) = w; }
    }
}

__device__ __forceinline__ void final_phase(KPC kp) {
    const float* h = (const float*)(kp->ws + OFF_H); const float* g = kp->in[I_FINALG];
    const int lane = ltid() & 63, wv = ltid() >> 6;
    for (int r = lbid() * 8 + wv; r < NB * SEQ; r += gridDim.x * 8) {
        const int b = r / SEQ, s = r - b * SEQ; const float* hr = h + ((size_t)b * TPB + CTX + s) * D; f32x4 v[4]; float ss = 0.f;
#pragma unroll
        for (int i = 0; i < 4; ++i) { v[i] = *(const f32x4*)(hr + i * 256 + lane * 4); ss += v[i][0] * v[i][0] + v[i][1] * v[i][1] + v[i][2] * v[i][2] + v[i][3] * v[i][3]; }
        ss = wave_sum(ss); const float rs = rsqrtf(ss * (1.0f / D) + 1e-6f);
#pragma unroll
        for (int i = 0; i < 4; ++i) { const int c = i * 256 + lane * 4; *(f32x4*)(kp->out + (size_t)r * D + c) = v[i] * rs * *(const f32x4*)(g + c); }
    }
}

__device__ __forceinline__ void setup_phase(KPC kp, LAS float* ldsf) {
    float* h = (float*)(kp->ws + OFF_H); const int tid = ltid();
    const int hb0 = gridDim.x > 64 ? 32 : 0;
    for (size_t i = (size_t)(lbid() - hb0) * 512 + tid; lbid() >= hb0 && i < (size_t)NTOK * 256; i += (size_t)(gridDim.x - hb0) * 512) {
        const int T = (int)(i >> 8), c = ((int)i & 255) * 4, b = T / TPB, t = T - b * TPB; f32x4 v;
        if (t < CTX) v = *(const f32x4*)(kp->in[I_CTX] + ((size_t)b * CTX + t) * D + c);
        else { const int s = t - CTX; v = *(const f32x4*)(kp->in[I_X] + ((size_t)b * SEQ + s) * D + c);
            const int half = c >> 9, cc = c & 511, isc = cc >> 8, i0 = cc & 255; const float pv = half ? (float)(s & 63) : (float)(s >> 6);
#pragma unroll
            for (int e = 0; e < 4; ++e) { const float om = exp2f(-13.287712379549449f * (float)(i0 + e) * (1.0f / 256.0f)); const float ang = pv * om; v[e] += isc ? __cosf(ang) : __sinf(ang); } }
        *(f32x4*)(h + (size_t)T * D + c) = v;
    }
    LAS float* sc = ldsf; LAS float* red = ldsf + 5 * 1024;
    for (int i = tid; i < 5 * 1024; i += 512) { const int r = i >> 10, k = i & 1023; const float cv = r < 4 ? kp->in[I_C][r * D + k] : kp->in[I_CCTX][k]; sc[i] = siluf(cv); }
    __syncthreads();
    float* mod = (float*)(kp->ws + OFF_MOD); const int lane = tid & 63, wv = tid >> 6;
    for (int task = lbid(); task < 288; task += gridDim.x) {
        const int l = task / 72, n0 = (task % 72) * 128 + lane * 2; const float* w = kp->in[I_ADAW] + (size_t)l * D * 9216 + n0;
        f32x2 a[5];
#pragma unroll
        for (int r = 0; r < 5; ++r) a[r] = (f32x2){0.f, 0.f};
#pragma unroll 16
        for (int k = wv * 128; k < wv * 128 + 128; ++k) { const f32x2 wv2 = *(const f32x2*)(w + (size_t)k * 9216);
#pragma unroll
            for (int r = 0; r < 5; ++r) a[r] += wv2 * sc[r * 1024 + k]; }
#pragma unroll
        for (int r = 0; r < 5; ++r) { red[(wv * 5 + r) * 128 + lane * 2] = a[r][0]; red[(wv * 5 + r) * 128 + lane * 2 + 1] = a[r][1]; }
        __syncthreads();
        for (int i = tid; i < 640; i += 512) { const int r = i >> 7, n = i & 127; float s = 0.f;
#pragma unroll
            for (int w8 = 0; w8 < 8; ++w8) s += red[(w8 * 5 + r) * 128 + n];
            const int nn = (task % 72) * 128 + n; mod[((size_t)l * 5 + r) * 9216 + nn] = s + kp->in[I_ADAB][(size_t)l * 9216 + nn]; }
        __syncthreads();
    }
}

__device__ __forceinline__ void convert_layer(KPC kp, int l, LAS float* tile) {
    unsigned char* wb = kp->ws + OFF_WB; int tctr = 0; const int j = l >> 1;
    for (int f = 0; f < 2; ++f) {
        convert_T(kp->in[I_FFNIN] + (size_t)(l * 2 + f) * D * 2 * FF, 2 * FF, D, 2 * FF, 1, (u16*)(wb + (f ? WB_FIN1 : WB_FIN0)), tile, tctr);
        convert_T(kp->in[I_FFNOUT] + (size_t)(l * 2 + f) * FF * D, D, FF, D, 0, (u16*)(wb + (f ? WB_FOUT1 : WB_FOUT0)), tile, tctr);
    }
    if ((l & 1) == 0) {
        convert_T(kp->in[I_HYWIN] + (size_t)j * D * 3 * D, 3 * D, D, 3 * D, 0, (u16*)(wb + WB_MIN), tile, tctr);
        convert_T(kp->in[I_HYWOUT] + (size_t)j * D * D, D, D, D, 0, (u16*)(wb + WB_MOUT), tile, tctr);
    } else {
        convert_T(kp->in[I_MLUP] + (size_t)j * D * 2 * INNER, 2 * INNER, D, 2 * INNER, 0, (u16*)(wb + WB_MIN), tile, tctr);
        convert_T(kp->in[I_MLDOWN] + (size_t)j * INNER * D, D, INNER, D, 0, (u16*)(wb + WB_MOUT), tile, tctr);
        u16* wg = (u16*)(wb + WB_WGT); const float* src = kp->in[I_MLWG] + (size_t)j * 3 * INNER * 16;
        for (int i = lbid() * 512 + ltid(); i < 16 * 3 * INNER; i += gridDim.x * 512) { const int o = i / (3 * INNER), k = i - o * 3 * INNER; wg[i] = f2bf(src[(size_t)k * 16 + o]); }
        float* gates = (float*)(kp->ws + OFF_GATES); const float* bg = kp->in[I_MLBG] + j * 16;
        for (int i = lbid() * 512 + ltid(); i < NTOK * 16; i += gridDim.x * 512) gates[i] = bg[i & 15];
    }
}

constexpr size_t HY_PL = 0, HY_PC = (size_t)NB * 3072 * SEQ * 2, HY_YL = HY_PC + (size_t)NB * 3072 * CTX * 2, HY_YC = HY_YL + (size_t)NB * D * SEQ * 2;
__device__ __forceinline__ int fphys(int i) { return i ^ ((((i >> 6) & 1) * 21) ^ (((i >> 5) & 1) * 10)); }
__device__ __forceinline__ f32x2 cmul(f32x2 a, f32x2 b) { return (f32x2){a.x * b.x - a.y * b.y, a.x * b.y + a.y * b.x}; }
__device__ __forceinline__ f32x2 cmulc(f32x2 a, f32x2 b) { return (f32x2){a.x * b.x + a.y * b.y, a.y * b.x - a.x * b.y}; }
__device__ __forceinline__ int drev(int x) { const unsigned r = __brev((unsigned)x) >> 18; return (int)(((r & 0x2AAAu) >> 1) | ((r & 0x1555u) << 1)); }

__device__ __forceinline__ void fidx4(int base, int lm, int (&ix)[4]) {
    const int m = 1 << lm;
    if (lm == 6) { const int i0 = fphys(base); ix[0] = i0; ix[1] = (i0 + 64) ^ 21; ix[2] = i0 + 128; ix[3] = (i0 + 192) ^ 21; }
    else if (lm == 4) { const int c6 = ((base >> 6) & 1) * 21; ix[0] = base ^ c6; ix[1] = (base + 16) ^ c6; ix[2] = (base + 32) ^ c6 ^ 10; ix[3] = (base + 48) ^ c6 ^ 10; }
    else { const int c = (((base >> 6) & 1) * 21) ^ (((base >> 5) & 1) * 10); ix[0] = base ^ c; ix[1] = (base + m) ^ c; ix[2] = (base + 2 * m) ^ c; ix[3] = (base + 3 * m) ^ c; }
}
__device__ __forceinline__ void fft_fwd(LAS f32x2* buf) {
    const int tid = ltid();
    for (int lm = 12; lm >= 0; lm -= 2) {
        const int m = 1 << lm; const float inv = 1.0f / (float)(4 << lm);
        f32x2 a[8][4]; int ix[8][4];
#pragma unroll
        for (int i = 0; i < 8; ++i) { const int g = tid + 512 * i, p = g & (m - 1), base = ((g >> lm) << (lm + 2)) + p; fidx4(base, lm, ix[i]);
#pragma unroll
            for (int r = 0; r < 4; ++r) a[i][r] = buf[ix[i][r]]; }
#pragma unroll
        for (int i = 0; i < 8; ++i) { const int p = (tid + 512 * i) & (m - 1);
            const f32x2 t0 = a[i][0] + a[i][2], t1 = a[i][0] - a[i][2], t2 = a[i][1] + a[i][3], dd = a[i][1] - a[i][3], t3 = (f32x2){dd.y, -dd.x};
            if (lm == 0) { buf[ix[i][0]] = t0 + t2; buf[ix[i][1]] = t1 + t3; buf[ix[i][2]] = t0 - t2; buf[ix[i][3]] = t1 - t3; }
            else { const float rev = (float)p * inv;
                const f32x2 w1 = (f32x2){__builtin_amdgcn_cosf(rev), -__builtin_amdgcn_sinf(rev)}, w2 = cmul(w1, w1), w3 = cmul(w2, w1);
                buf[ix[i][0]] = t0 + t2; buf[ix[i][1]] = cmul(t1 + t3, w1); buf[ix[i][2]] = cmul(t0 - t2, w2); buf[ix[i][3]] = cmul(t1 - t3, w3); } }
        __syncthreads();
    }
}
__device__ __forceinline__ void fft_inv(LAS f32x2* buf) {
    const int tid = ltid();
    for (int lm = 0; lm <= 12; lm += 2) {
        const int m = 1 << lm; const float inv = 1.0f / (float)(4 << lm);
        f32x2 a[8][4]; int ix[8][4];
#pragma unroll
        for (int i = 0; i < 8; ++i) { const int g = tid + 512 * i, p = g & (m - 1), base = ((g >> lm) << (lm + 2)) + p; fidx4(base, lm, ix[i]);
#pragma unroll
            for (int r = 0; r < 4; ++r) a[i][r] = buf[ix[i][r]]; }
#pragma unroll
        for (int i = 0; i < 8; ++i) { const int p = (tid + 512 * i) & (m - 1);
            f32x2 b0 = a[i][0], b1 = a[i][1], b2 = a[i][2], b3 = a[i][3];
            if (lm != 0) { const float rev = (float)p * inv;
                const f32x2 w1 = (f32x2){__builtin_amdgcn_cosf(rev), -__builtin_amdgcn_sinf(rev)}, w2 = cmul(w1, w1), w3 = cmul(w2, w1);
                b1 = cmulc(b1, w1); b2 = cmulc(b2, w2); b3 = cmulc(b3, w3); }
            const f32x2 s0 = b0 + b2, s1 = b0 - b2, s2 = b1 + b3, dd = b1 - b3, s3 = (f32x2){-dd.y, dd.x};
            buf[ix[i][0]] = s0 + s2; buf[ix[i][1]] = s1 + s3; buf[ix[i][2]] = s0 - s2; buf[ix[i][3]] = s1 - s3; }
        __syncthreads();
    }
}

__device__ __forceinline__ void hy_mlp_phase(KPC kp, int j) {
    float* h2 = (float*)(kp->ws + OFF_H2);
    const float* w1 = kp->in[I_HYW1] + j * 33 * 64; const float* b1 = kp->in[I_HYB1] + j * 64; const float* w2 = kp->in[I_HYW2] + j * 64 * 64; const float* b2 = kp->in[I_HYB2] + j * 64;
    const float* fr = kp->in[I_HYFREQ] + j * 128; const int lane = ltid() & 63, wv = ltid() >> 6;
    for (int pos = lbid() * 8 + wv; pos < SEQ + CTX; pos += gridDim.x * 8) {
        const int n = pos < SEQ ? SEQ : CTX, t = pos < SEQ ? pos : pos - SEQ; const float tn = (float)t / (float)(n - 1);
        float feat = 0.f;
        if (lane == 0) feat = tn;
        else if (lane < 33) { const int bi = (lane - 1) & 15; const float band = 1e-4f + (float)bi * ((15.0f - 1e-4f) / 15.0f); float rev = ((float)t / (float)n) * band; rev -= floorf(rev);
            const float ang = 6.283185307179586f * rev; feat = lane < 17 ? cosf(ang) : -sinf(ang); }
        float z = b1[lane];
        for (int i = 0; i < 33; ++i) z += lshfl(feat, i) * w1[i * 64 + lane];
        const float h1 = sinf(fr[lane] * z);
        float z2 = b2[lane];
        for (int v = 0; v < 64; ++v) z2 += lshfl(h1, v) * w2[v * 64 + lane];
        h2[(size_t)pos * 64 + lane] = sinf(fr[64 + lane] * z2);
    }
}

__device__ __forceinline__ void block_sum2(float& a, float& b, LAS float* red) {
    a = wave_sum(a); b = wave_sum(b); const int lane = ltid() & 63, wv = ltid() >> 6;
    __syncthreads(); if (lane == 0) { red[wv] = a; red[8 + wv] = b; } __syncthreads();
    float sa = 0.f, sb = 0.f;
#pragma unroll
    for (int i = 0; i < 8; ++i) { sa += red[i]; sb += red[8 + i]; }
    a = sa; b = sb;
}

__device__ __forceinline__ void hy_filter_task(KPC kp, int j, int task, LAS f32x2* buf, LAS float* aux) {
    const int tid = ltid(), d = task & 1023; const bool lat = task < 1024;
    const float* w3 = kp->in[I_HYW3] + (size_t)j * 64 * 4096; const float* b3 = kp->in[I_HYB3] + j * 4096; const float* ldc = kp->in[I_HYDECAY] + j * 4096;
    __syncthreads();
    if (tid < 256) aux[tid] = w3[(size_t)(tid & 63) * 4096 + (tid >> 6) * 1024 + d];
    if (tid < 4) { aux[256 + tid] = b3[tid * 1024 + d]; aux[260 + tid] = __expf(ldc[tid * 1024 + d]); }
    __syncthreads();
    const float* h2 = (const float*)(kp->ws + OFF_H2);
    float ss0 = 0.f, ss1 = 0.f;
    if (lat) {
        for (int r = 0; r < 16; ++r) { const int i = tid + 512 * r; float a0 = aux[256], a1 = aux[257], a2 = aux[258], a3 = aux[259];
#pragma unroll 4
            for (int u4 = 0; u4 < 16; ++u4) { const f32x4 hv = *(const f32x4*)(h2 + (size_t)i * 64 + u4 * 4);
                const f32x4 q0 = *(const LAS f32x4*)(aux + u4 * 4), q1 = *(const LAS f32x4*)(aux + 64 + u4 * 4), q2 = *(const LAS f32x4*)(aux + 128 + u4 * 4), q3 = *(const LAS f32x4*)(aux + 192 + u4 * 4);
#pragma unroll
                for (int e = 0; e < 4; ++e) { a0 += hv[e] * q0[e]; a1 += hv[e] * q1[e]; a2 += hv[e] * q2[e]; a3 += hv[e] * q3[e]; } }
            const float tn = (float)i * (1.0f / 8191.0f);
            a0 *= __expf(-tn * aux[260]); a1 *= __expf(-tn * aux[261]); a2 *= __expf(-tn * aux[262]); a3 *= __expf(-tn * aux[263]);
            buf[fphys(i)] = (f32x2){a0, a2}; ss0 += a0 * a0; ss1 += a2 * a2;
            if (i >= 1) { buf[fphys(NFFT - i)] = (f32x2){a1, a3}; ss0 += a1 * a1; ss1 += a3 * a3; } }
        if (tid == 0) buf[fphys(SEQ)] = (f32x2){0.f, 0.f};
        block_sum2(ss0, ss1, aux + 272);
        const f32x2 scl = (f32x2){rsqrtf(ss0 + 1e-12f) * (1.0f / NFFT), rsqrtf(ss1 + 1e-12f) * (1.0f / NFFT)};
        for (int r = 0; r < 32; ++r) { const int q = fphys(tid + 512 * r); buf[q] = buf[q] * scl; }
        __syncthreads();
        fft_fwd(buf);
        f32x2* K0 = (f32x2*)(kp->ws + OFF_R2) + (size_t)d * NFFT; f32x2* K1 = (f32x2*)kp->out + (size_t)d * NFFT;
        for (int r = 0; r < 32; ++r) { const int pos = tid + 512 * r, k = drev(pos), pos2 = drev((NFFT - k) & (NFFT - 1)); const f32x2 Z = buf[fphys(pos)], Z2 = buf[fphys(pos2)];
            K0[pos] = (f32x2){0.5f * (Z.x + Z2.x), 0.5f * (Z.y - Z2.y)}; K1[pos] = (f32x2){0.5f * (Z.y + Z2.y), -0.5f * (Z.x - Z2.x)}; }
    } else {
        const int idx = tid; float a0 = 0.f, a1 = 0.f;
        if (idx != CTX) { const int t = idx < CTX ? idx : 2 * CTX - idx, dir = idx < CTX ? 0 : 1; a0 = aux[256 + dir]; a1 = aux[258 + dir];
            for (int u4 = 0; u4 < 16; ++u4) { const f32x4 hv = *(const f32x4*)(h2 + (size_t)(SEQ + t) * 64 + u4 * 4);
#pragma unroll
                for (int e = 0; e < 4; ++e) { const int u = u4 * 4 + e; a0 += hv[e] * aux[dir * 64 + u]; a1 += hv[e] * aux[128 + dir * 64 + u]; } }
            const float tn = (float)t * (1.0f / 255.0f); a0 *= __expf(-tn * aux[260 + dir]); a1 *= __expf(-tn * aux[262 + dir]); }
        ss0 = a0 * a0; ss1 = a1 * a1;
        block_sum2(ss0, ss1, aux + 272);
        float* kc = (float*)(kp->ws + OFF_KCTX);
        kc[(size_t)d * 512 + idx] = a0 * rsqrtf(ss0 + 1e-12f); kc[(size_t)(1024 + d) * 512 + idx] = a1 * rsqrtf(ss1 + 1e-12f);
    }
}

__device__ __forceinline__ float ld3(const u16* row, int t, int n, float wa, float wb, float wc, float bias) {
    const float xm = t > 0 ? bf2f(row[t - 1]) : 0.f, x0 = bf2f(row[t]), xp = t < n - 1 ? bf2f(row[t + 1]) : 0.f; return wa * xm + wb * x0 + wc * xp + bias; }

__device__ __forceinline__ void ld3x8(const u16* row, int t0, float wa, float wb, float wc, float bias, float (&o)[8]) {
    const u32x4v w = *(const u32x4v*)(row + t0);
    const float x0 = bflo(w.x), x1 = bfhi(w.x), x2 = bflo(w.y), x3 = bfhi(w.y), x4 = bflo(w.z), x5 = bfhi(w.z), x6 = bflo(w.w), x7 = bfhi(w.w);
    const float xl = t0 > 0 ? bf2f(row[t0 - 1]) : 0.f, xr = t0 + 8 < SEQ ? bf2f(row[t0 + 8]) : 0.f;
    o[0] = wa * xl + wb * x0 + wc * x1 + bias; o[1] = wa * x0 + wb * x1 + wc * x2 + bias; o[2] = wa * x1 + wb * x2 + wc * x3 + bias; o[3] = wa * x2 + wb * x3 + wc * x4 + bias;
    o[4] = wa * x3 + wb * x4 + wc * x5 + bias; o[5] = wa * x4 + wb * x5 + wc * x6 + bias; o[6] = wa * x5 + wb * x6 + wc * x7 + bias; o[7] = wa * x6 + wb * x7 + wc * xr + bias;
}
__device__ __forceinline__ void hy_conv_lat(KPC kp, int j, int task, LAS f32x2* buf) {
    const int tid = ltid(), bp = task >> 10, c = task & 1023, b0 = bp * 2;
    const u16* pl = (const u16*)(kp->ws + OFF_R1 + HY_PL); u16* yl = (u16*)(kp->ws + OFF_R1 + HY_YL);
    const float* cw = kp->in[I_HYCW] + (size_t)j * 3 * 3072; const float* cb = kp->in[I_HYCB] + j * 3072;
    const float w1a = cw[c], w1b = cw[3072 + c], w1c = cw[6144 + c], bb1 = cb[c];
    const float w2a = cw[1024 + c], w2b = cw[3072 + 1024 + c], w2c = cw[6144 + 1024 + c], bb2 = cb[1024 + c];
    const float w3a = cw[2048 + c], w3b = cw[3072 + 2048 + c], w3c = cw[6144 + 2048 + c], bb3 = cb[2048 + c];
    const float sk0 = kp->in[I_HYSKIP][j * 2048 + c], sk1 = kp->in[I_HYSKIP][j * 2048 + 1024 + c];
    const u16* x1r0 = pl + ((size_t)b0 * 3072 + c) * SEQ; const u16* x1r1 = x1r0 + (size_t)3072 * SEQ;
    const u16* x2r0 = x1r0 + (size_t)1024 * SEQ; const u16* x2r1 = x1r1 + (size_t)1024 * SEQ;
    const u16* vr0 = x1r0 + (size_t)2048 * SEQ; const u16* vr1 = x1r1 + (size_t)2048 * SEQ;
    const f32x2* K0 = (const f32x2*)(kp->ws + OFF_R2) + (size_t)c * NFFT; const f32x2* K1 = (const f32x2*)kp->out + (size_t)c * NFFT;
    __syncthreads();
#pragma unroll
    for (int g = 0; g < 2; ++g) { const int t0 = 8 * (tid + 512 * g); float v0[8], v1[8];
        ld3x8(vr0, t0, w3a, w3b, w3c, bb3, v0); ld3x8(vr1, t0, w3a, w3b, w3c, bb3, v1);
#pragma unroll
        for (int e = 0; e < 8; ++e) { buf[fphys(t0 + e)] = (f32x2){v0[e], v1[e]}; buf[fphys(SEQ + t0 + e)] = (f32x2){0.f, 0.f}; } }
    __syncthreads();
#ifdef PROBE_FFT
    for (int rp = 0; rp < PROBE_FFT; ++rp) { fft_fwd(buf); fft_inv(buf); for (int r = 0; r < 32; ++r) { const int q = fphys(tid + 512 * r); buf[q] = buf[q] * (1.0f / NFFT); } __syncthreads(); }
#endif
    fft_fwd(buf);
#pragma unroll 8
    for (int r = 0; r < 32; ++r) { const int pos = tid + 512 * r, q = fphys(pos); buf[q] = cmul(buf[q], K0[pos]); }
    __syncthreads();
    fft_inv(buf);
    float zr[32];
#pragma unroll
    for (int g = 0; g < 2; ++g) { const int t0 = 8 * (tid + 512 * g); float v0[8], v1[8], xa[8], xb[8];
        ld3x8(vr0, t0, w3a, w3b, w3c, bb3, v0); ld3x8(vr1, t0, w3a, w3b, w3c, bb3, v1); ld3x8(x1r0, t0, w1a, w1b, w1c, bb1, xa); ld3x8(x1r1, t0, w1a, w1b, w1c, bb1, xb);
#pragma unroll
        for (int e = 0; e < 8; ++e) { const f32x2 y = buf[fphys(t0 + e)]; const float z0 = xa[e] * (y.x + sk0 * v0[e]), z1 = xb[e] * (y.y + sk0 * v1[e]);
            zr[g * 16 + 2 * e] = z0; zr[g * 16 + 2 * e + 1] = z1; buf[fphys(t0 + e)] = (f32x2){z0, z1}; buf[fphys(SEQ + t0 + e)] = (f32x2){0.f, 0.f}; } }
    __syncthreads();
    fft_fwd(buf);
#pragma unroll 8
    for (int r = 0; r < 32; ++r) { const int pos = tid + 512 * r, q = fphys(pos); buf[q] = cmul(buf[q], K1[pos]); }
    __syncthreads();
    fft_inv(buf);
#pragma unroll
    for (int g = 0; g < 2; ++g) { const int t0 = 8 * (tid + 512 * g); float xa[8], xb[8], o0[8], o1[8];
        ld3x8(x2r0, t0, w2a, w2b, w2c, bb2, xa); ld3x8(x2r1, t0, w2a, w2b, w2c, bb2, xb);
#pragma unroll
        for (int e = 0; e < 8; ++e) { const f32x2 y = buf[fphys(t0 + e)]; o0[e] = xa[e] * (y.x + sk1 * zr[g * 16 + 2 * e]); o1[e] = xb[e] * (y.y + sk1 * zr[g * 16 + 2 * e + 1]); }
        *(u32x4v*)(yl + ((size_t)b0 * D + c) * SEQ + t0) = pack8(o0); *(u32x4v*)(yl + ((size_t)(b0 + 1) * D + c) * SEQ + t0) = pack8(o1); }
}

__device__ __forceinline__ void hy_conv_ctx(KPC kp, int j, int c, LAS float* ls) {
    const int tid = ltid();
    const u16* pc = (const u16*)(kp->ws + OFF_R1 + HY_PC); u16* yc = (u16*)(kp->ws + OFF_R1 + HY_YC); const float* kc = (const float*)(kp->ws + OFF_KCTX);
    const float* cw = kp->in[I_HYCW] + (size_t)j * 3 * 3072; const float* cb = kp->in[I_HYCB] + j * 3072;
    const float w1a = cw[c], w1b = cw[3072 + c], w1c = cw[6144 + c], bb1 = cb[c];
    const float w2a = cw[1024 + c], w2b = cw[3072 + 1024 + c], w2c = cw[6144 + 1024 + c], bb2 = cb[1024 + c];
    const float w3a = cw[2048 + c], w3b = cw[3072 + 2048 + c], w3c = cw[6144 + 2048 + c], bb3 = cb[2048 + c];
    const float sk0 = kp->in[I_HYSKIP][j * 2048 + c], sk1 = kp->in[I_HYSKIP][j * 2048 + 1024 + c];
    __syncthreads();
    ls[tid] = kc[(size_t)c * 512 + tid]; ls[512 + tid] = kc[(size_t)(1024 + c) * 512 + tid];
    for (int i = 0; i < 2; ++i) { const int e = tid + 512 * i, b = e >> 8, t = e & 255; ls[1024 + e] = ld3(pc + ((size_t)b * 3072 + 2048 + c) * CTX, t, CTX, w3a, w3b, w3c, bb3); }
    __syncthreads();
    const int cb_ = tid >> 6, t0 = (tid & 63) * 4; const bool act = tid < 256;
    auto conv4 = [&](int kofs, int xofs, float (&acc)[4]) {
        float w[7];
#pragma unroll
        for (int i = 0; i < 7; ++i) w[i] = ls[kofs + ((t0 + 3 - i) & 511)];
        acc[0] = acc[1] = acc[2] = acc[3] = 0.f;
        for (int s = 0; s < CTX; s += 4) { const f32x4 v4 = *(const LAS f32x4*)(ls + xofs + cb_ * 256 + s);
#pragma unroll
            for (int cc = 0; cc < 4; ++cc)
#pragma unroll
                for (int a = 0; a < 4; ++a) acc[a] += w[3 - a + cc] * v4[cc];
            w[0] = w[4]; w[1] = w[5]; w[2] = w[6];
#pragma unroll
            for (int i = 3; i < 7; ++i) w[i] = ls[kofs + ((t0 + 3 - (s + 4) - i) & 511)]; } };
    float zr[4] = {0.f, 0.f, 0.f, 0.f};
    if (act) { float acc[4]; conv4(0, 1024, acc);
#pragma unroll
        for (int a = 0; a < 4; ++a) zr[a] = ld3(pc + ((size_t)cb_ * 3072 + c) * CTX, t0 + a, CTX, w1a, w1b, w1c, bb1) * (acc[a] + sk0 * ls[1024 + cb_ * 256 + t0 + a]);
        *(LAS f32x4*)(ls + 2048 + cb_ * 256 + t0) = (f32x4){zr[0], zr[1], zr[2], zr[3]}; }
    __syncthreads();
    if (act) { float acc[4]; conv4(512, 2048, acc); float o[4];
#pragma unroll
        for (int a = 0; a < 4; ++a) o[a] = ld3(pc + ((size_t)cb_ * 3072 + 1024 + c) * CTX, t0 + a, CTX, w2a, w2b, w2c, bb2) * (acc[a] + sk1 * zr[a]);
        u32x2 w; w.x = pg8::cvt_pk_bf16(o[0], o[1]); w.y = pg8::cvt_pk_bf16(o[2], o[3]); *(u32x2*)(yc + ((size_t)cb_ * D + c) * CTX + t0) = w; }
}

__device__ __forceinline__ void hy_transpose(KPC kp, LAS u16* tl) {
    const u16* yl = (const u16*)(kp->ws + OFF_R1 + HY_YL); const u16* yc = (const u16*)(kp->ws + OFF_R1 + HY_YC); u16* y = (u16*)(kp->ws + OFF_U); const int tid = ltid();
    for (int tile = lbid(); tile < NB * 16 * NCH; tile += gridDim.x) {
        const int b = tile / (16 * NCH), rem = tile - b * 16 * NCH, ct = rem / NCH, tt = rem - ct * NCH;
        const u16* src = tt < 4 ? yc + ((size_t)b * D + ct * 64) * CTX + tt * 64 : yl + ((size_t)b * D + ct * 64) * SEQ + (tt - 4) * 64; const int ld = tt < 4 ? CTX : SEQ;
        { const int cr = tid >> 3, t8 = (tid & 7) * 8; *(LAS u32x4v*)(tl + cr * 72 + t8) = *(const u32x4v*)(src + (size_t)cr * ld + t8); }
        __syncthreads();
        { const int tr = tid >> 3, c8 = (tid & 7) * 8; u32x4v w;
          w.x = (unsigned)tl[(c8 + 0) * 72 + tr] | ((unsigned)tl[(c8 + 1) * 72 + tr] << 16); w.y = (unsigned)tl[(c8 + 2) * 72 + tr] | ((unsigned)tl[(c8 + 3) * 72 + tr] << 16);
          w.z = (unsigned)tl[(c8 + 4) * 72 + tr] | ((unsigned)tl[(c8 + 5) * 72 + tr] << 16); w.w = (unsigned)tl[(c8 + 6) * 72 + tr] | ((unsigned)tl[(c8 + 7) * 72 + tr] << 16);
          *(u32x4v*)(y + ((size_t)b * TPB + tt * 64 + tr) * D + ct * 64 + c8) = w; }
        __syncthreads();
    }
}

constexpr size_t OFF_XM = OFF_R1, OFF_XC = OFF_R1 + 132 * MiB, OFF_S = WS_NEED, OFF_MLM = OFF_S + 34 * MiB, WS_NEED2 = OFF_MLM + 1 * MiB;
__device__ __forceinline__ u16* hb_ptr(KPC kp, int T) { const int b = T / TPB, t = T - b * TPB;
    return t < CTX ? (u16*)(kp->ws + OFF_HBC) + ((size_t)b * CTX + t) * INNER : (u16*)kp->out + ((size_t)b * SEQ + (t - CTX)) * INNER; }
__device__ __forceinline__ void bd8(const float (&x)[8], const float (&w)[32], float (&y)[8]) {
#pragma unroll
    for (int bl = 0; bl < 2; ++bl)
#pragma unroll
        for (int e = 0; e < 4; ++e) { float s = 0.f;
#pragma unroll
            for (int d = 0; d < 4; ++d) s += x[bl * 4 + d] * w[bl * 16 + d * 4 + e];
            y[bl * 4 + e] = s; }
}
typedef float f32x8s __attribute__((ext_vector_type(8)));
__device__ __forceinline__ void sload32(const float* p, float (&w)[32]) {
    f32x8s a, b, c, d;
    asm volatile("s_load_dwordx8 %0, %4, 0x0\n\ts_load_dwordx8 %1, %4, 0x20\n\ts_load_dwordx8 %2, %4, 0x40\n\ts_load_dwordx8 %3, %4, 0x60\n\ts_waitcnt lgkmcnt(0)"
                 : "=&s"(a), "=&s"(b), "=&s"(c), "=&s"(d) : "s"(p) : "memory");
#pragma unroll
    for (int i = 0; i < 8; ++i) { w[i] = a[i]; w[8 + i] = b[i]; w[16 + i] = c[i]; w[24 + i] = d[i]; }
}
__device__ __forceinline__ void ldw32(const float* p, float (&w)[32]) {
#pragma unroll
    for (int i = 0; i < 8; ++i) { const f32x4 v = *(const f32x4*)(p + i * 4); w[i * 4] = v[0]; w[i * 4 + 1] = v[1]; w[i * 4 + 2] = v[2]; w[i * 4 + 3] = v[3]; } }

__device__ __forceinline__ void ml_m_phase(KPC kp, int j) {
    float* M = (float*)(kp->ws + OFF_MLM) + (size_t)j * 8192;
    const float* wq = kp->in[I_MLWQ] + (size_t)j * 512 * 16; const float* wk = kp->in[I_MLWK] + (size_t)j * 512 * 16;
    for (int i = lbid() * 512 + ltid(); i < 512 * 16; i += gridDim.x * 512) { const int blk = i >> 4, d = (i >> 2) & 3, d2 = i & 3; float s = 0.f;
#pragma unroll
        for (int e = 0; e < 4; ++e) s += wq[blk * 16 + d * 4 + e] * wk[blk * 16 + d2 * 4 + e];
        M[i] = s * 0.04419417382415922f; }
}

__device__ __forceinline__ void ml_prep_task(KPC kp, int j, int task, LAS unsigned char* lds) {
    const int tid = ltid(), lane = tid & 63, wv = tid >> 6, fr = lane & 15, fq = lane >> 4;
    const int hd = task & 3, bc = task >> 2, b = bc / NCH, ci = bc - b * NCH;
    const u16* xm = (const u16*)(kp->ws + OFF_XM); u16* xc = (u16*)(kp->ws + OFF_XC);
    const int T0 = b * TPB + ci * 64, tlo = b * TPB + (ci < 4 ? 0 : CTX), thi = b * TPB + (ci < 4 ? CTX - 1 : TPB - 1);
    const int ch0 = hd * DH + lane * 8;
    LAS u16* QS = (LAS u16*)lds; LAS u16* KS = (LAS u16*)(lds + 66560);
    const float* cw = kp->in[I_MLCW] + (size_t)j * 3 * INNER; const float* cb = kp->in[I_MLCB] + (size_t)j * INNER;
    __syncthreads();
    {
        float cwa[8], cwb[8], cwc[8], cbb[8], wq[32], wk[32];
#pragma unroll
        for (int e4 = 0; e4 < 2; ++e4) { const f32x4 va = *(const f32x4*)(cw + ch0 + 4 * e4), vb = *(const f32x4*)(cw + INNER + ch0 + 4 * e4), vc = *(const f32x4*)(cw + 2 * INNER + ch0 + 4 * e4), vd = *(const f32x4*)(cb + ch0 + 4 * e4);
#pragma unroll
            for (int e = 0; e < 4; ++e) { cwa[4 * e4 + e] = va[e]; cwb[4 * e4 + e] = vb[e]; cwc[4 * e4 + e] = vc[e]; cbb[4 * e4 + e] = vd[e]; } }
        ldw32(kp->in[I_MLWQ] + ((size_t)j * 512 + (ch0 >> 2)) * 16, wq); ldw32(kp->in[I_MLWK] + ((size_t)j * 512 + (ch0 >> 2)) * 16, wk);
        for (int r = 0; r < 8; ++r) { const int jj = wv + 8 * r, T = T0 + jj; const u16* p = xm + (size_t)T * INNER + ch0;
            float x0[8], xa[8], xb[8], xcv[8], q[8], k[8];
            unpack8(*(const u32x4v*)p, x0);
            if (T > tlo) unpack8(*(const u32x4v*)(p - INNER), xa); else {
#pragma unroll
                for (int e = 0; e < 8; ++e) xa[e] = 0.f; }
            if (T < thi) unpack8(*(const u32x4v*)(p + INNER), xb); else {
#pragma unroll
                for (int e = 0; e < 8; ++e) xb[e] = 0.f; }
#pragma unroll
            for (int e = 0; e < 8; ++e) xcv[e] = siluf(cwa[e] * xa[e] + cwb[e] * x0[e] + cwc[e] * xb[e] + cbb[e]);
            const u32x4v xw = pack8(xcv); *(u32x4v*)(xc + (size_t)T * INNER + ch0) = xw; unpack8(xw, xcv);
            bd8(xcv, wq, q); bd8(xcv, wk, k);
            *(LAS u32x4v*)(QS + jj * 520 + lane * 8) = pack8(q); *(LAS u32x4v*)(KS + jj * 520 + lane * 8) = pack8(k); }
    }
    __syncthreads();
    const u16* wg = (const u16*)(kp->ws + OFF_WB + WB_WGT);
    const int mt = wv & 3, kh = wv >> 2;
    { f32x4 s0 = {0.f, 0.f, 0.f, 0.f}, s1 = {0.f, 0.f, 0.f, 0.f}; const int nt0 = kh * 2;
      for (int ks = 0; ks < 16; ++ks) { const bf16x8 a = *(const LAS bf16x8*)(QS + (16 * mt + fr) * 520 + 32 * ks + 8 * fq);
          const bf16x8 b0 = *(const LAS bf16x8*)(KS + (16 * nt0 + fr) * 520 + 32 * ks + 8 * fq), b1 = *(const LAS bf16x8*)(KS + (16 * (nt0 + 1) + fr) * 520 + 32 * ks + 8 * fq);
          s0 = __builtin_amdgcn_mfma_f32_16x16x32_bf16(a, b0, s0, 0, 0, 0); s1 = __builtin_amdgcn_mfma_f32_16x16x32_bf16(a, b1, s1, 0, 0, 0); }
      float* S = (float*)(kp->ws + OFF_S) + ((size_t)(b * 4 + hd) * NCH + ci) * 4096;
#pragma unroll
      for (int r = 0; r < 4; ++r) { S[(16 * mt + 4 * fq + r) * 64 + 16 * nt0 + fr] = s0[r]; S[(16 * mt + 4 * fq + r) * 64 + 16 * (nt0 + 1) + fr] = s1[r]; } }
    f32x4 ga = {0.f, 0.f, 0.f, 0.f};
    for (int ks = kh * 8; ks < kh * 8 + 8; ++ks) { const int kk = hd * DH + 32 * ks + 8 * fq;
        const bf16x8 a = *(const LAS bf16x8*)(QS + (16 * mt + fr) * 520 + 32 * ks + 8 * fq), a2 = *(const LAS bf16x8*)(KS + (16 * mt + fr) * 520 + 32 * ks + 8 * fq);
        const bf16x8 bq = *(const bf16x8*)(wg + (size_t)fr * 6144 + kk), bk = *(const bf16x8*)(wg + (size_t)fr * 6144 + INNER + kk);
        ga = __builtin_amdgcn_mfma_f32_16x16x32_bf16(a, bq, ga, 0, 0, 0); ga = __builtin_amdgcn_mfma_f32_16x16x32_bf16(a2, bk, ga, 0, 0, 0); }
    __syncthreads();
    {
        float wvv[32]; ldw32(kp->in[I_MLWV] + ((size_t)j * 512 + (ch0 >> 2)) * 16, wvv);
        for (int r = 0; r < 8; ++r) { const int jj = wv + 8 * r, T = T0 + jj; float x0[8], v[8]; unpack8(*(const u32x4v*)(xm + (size_t)T * INNER + ch0), x0); bd8(x0, wvv, v);
            *(LAS u32x4v*)(QS + jj * 520 + lane * 8) = pack8(v); }
    }
    __syncthreads();
    for (int ks = kh * 8; ks < kh * 8 + 8; ++ks) { const int kk = hd * DH + 32 * ks + 8 * fq;
        const bf16x8 a = *(const LAS bf16x8*)(QS + (16 * mt + fr) * 520 + 32 * ks + 8 * fq); const bf16x8 bv = *(const bf16x8*)(wg + (size_t)fr * 6144 + 2 * INNER + kk);
        ga = __builtin_amdgcn_mfma_f32_16x16x32_bf16(a, bv, ga, 0, 0, 0); }
    float* gates = (float*)(kp->ws + OFF_GATES);
#pragma unroll
    for (int r = 0; r < 4; ++r) atomicAdd(gates + (size_t)(T0 + 16 * mt + 4 * fq + r) * 16 + fr, ga[r]);
}

__device__ __forceinline__ void tr_store8(LAS unsigned char* base, int d0, const unsigned (&w)[4], int lane) {
    const int odd = lane & 1, sp = lane & ~1;
#pragma unroll
    for (int i = 0; i < 4; ++i) { const unsigned pw = (unsigned)__builtin_amdgcn_update_dpp(0, (int)w[i], 0xB1, 0xF, 0xF, false);
        const unsigned ow = odd ? ((pw >> 16) | (w[i] & 0xffff0000u)) : ((w[i] & 0xffffu) | (pw << 16)); const int d = d0 + 2 * i + odd;
        *(LAS unsigned*)(base + d * 128 + ((((sp >> 3) ^ (d & 7)) << 4) | ((sp & 7) << 1))) = ow; }
}
#ifndef REP_STAGE
#define REP_STAGE 1
#define REP_STILDE 1
#define REP_MFMA 1
#endif
constexpr int SC_QS = 0, SC_KT = 66560, SC_VT = 132096, SC_ST = 140288, SC_XB = 148480, SC_VEC = 156672;
__device__ __forceinline__ void ml_scan_task(KPC kp, int j, int task, LAS unsigned char* lds) {
    const int tid = ltid(), lane = tid & 63, wv = tid >> 6, fr = lane & 15, fq = lane >> 4;
    const int es = task & 7, dir = (task >> 3) & 1, hd = (task >> 4) & 3, b = task >> 6;
    const u16* xm = (const u16*)(kp->ws + OFF_XM); const u16* xc = (const u16*)(kp->ws + OFF_XC); const float* gates = (const float*)(kp->ws + OFF_GATES);
    const float* Sg = (const float*)(kp->ws + OFF_S) + (size_t)(b * 4 + hd) * NCH * 4096;
    u16* hf = (u16*)(kp->ws + OFF_R2);
    LAS unsigned char* QS = lds + SC_QS; LAS unsigned char* KT = lds + SC_KT; LAS unsigned char* VT = lds + SC_VT; LAS unsigned char* ST = lds + SC_ST; LAS unsigned char* XB = lds + SC_XB;
    LAS float* rowterm = (LAS float*)(lds + SC_VEC); LAS float* colterm = rowterm + 64; LAS float* winter = rowterm + 128; LAS float* einv = rowterm + 192;
    LAS float* kws = rowterm + 256; LAS float* dinv = rowterm + 320; LAS float* nst = rowterm + 384; LAS float* scal = rowterm + 896;
    f32x4 C[16];
#pragma unroll
    for (int i = 0; i < 16; ++i) C[i] = (f32x4){0.f, 0.f, 0.f, 0.f};
    float m_st = 0.f;
    __syncthreads();
    nst[tid] = 0.f;
    float pg_ic = 0.f, pg_fp = 0.f;
    if (wv == 0) { const int tn = dir == 0 ? lane : CTX - 1 - lane; const int Tg = b * TPB + tn; pg_ic = gates[(size_t)Tg * 16 + dir * 8 + hd]; pg_fp = gates[(size_t)Tg * 16 + dir * 8 + 4 + hd]; }
    u32x4v pxc[8], pxv;
    { const int tn = dir == 0 ? lane : CTX - 1 - lane; const size_t Tn = (size_t)(b * TPB + tn) * INNER; const int w0 = __builtin_amdgcn_readfirstlane(wv);
#pragma unroll
      for (int r = 0; r < 8; ++r) pxc[r] = *(const u32x4v*)(xc + Tn + hd * DH + (w0 * 8 + r) * 8);
      pxv = *(const u32x4v*)(xm + Tn + hd * DH + es * 64 + w0 * 8); }
    for (int ci = 0; ci < NCH; ++ci) {
        __syncthreads();
        const int p0 = ci * 64;
        const int tid = ltid(), lane = tid & 63, wv = tid >> 6, fr = lane & 15, fq = lane >> 4;
        asm volatile("" ::: "memory");
        auto tok = [&](int jj) -> int { const int p = p0 + jj; const int t = dir == 0 ? p : (p < CTX ? CTX - 1 - p : TPB + CTX - 1 - p); return b * TPB + t; };
        float sv[8];
        { const int jj = tid >> 3, s8 = (tid & 7) * 8;
            if (dir == 0) { const float* sp = Sg + (size_t)ci * 4096 + jj * 64 + s8; const f32x4 v0 = *(const f32x4*)sp, v1 = *(const f32x4*)(sp + 4);
                sv[0] = v0[0]; sv[1] = v0[1]; sv[2] = v0[2]; sv[3] = v0[3]; sv[4] = v1[0]; sv[5] = v1[1]; sv[6] = v1[2]; sv[7] = v1[3]; }
            else { const int oc = ci < 4 ? 3 - ci : 135 - ci; const float* sp = Sg + (size_t)oc * 4096 + (63 - jj) * 64 + (56 - s8); const f32x4 v0 = *(const f32x4*)sp, v1 = *(const f32x4*)(sp + 4);
                sv[7] = v0[0]; sv[6] = v0[1]; sv[5] = v0[2]; sv[4] = v0[3]; sv[3] = v1[0]; sv[2] = v1[1]; sv[1] = v1[2]; sv[0] = v1[3]; }
        }
        const float g_ic = pg_ic, g_fp = pg_fp;
        if (wv == 0 && ci + 1 < NCH) { const int pn = p0 + 64 + lane; const int tn = dir == 0 ? pn : (pn < CTX ? CTX - 1 - pn : TPB + CTX - 1 - pn); const int Tg = b * TPB + tn;
            pg_ic = gates[(size_t)Tg * 16 + dir * 8 + hd]; pg_fp = gates[(size_t)Tg * 16 + dir * 8 + 4 + hd]; }
        for (int rpS = 0; rpS < REP_STAGE; ++rpS) {
        const int wvu = __builtin_amdgcn_readfirstlane(wv); const int Tl = tok(lane);
#pragma unroll
        for (int r = 0; r < 8; ++r) { const int g8 = wvu * 8 + r; float x[8], q[8], Mw[32];
            const u32x4v xw = pxc[r]; unpack8(xw, x);
            sload32((const float*)(kp->ws + OFF_MLM) + (size_t)j * 8192 + (size_t)(hd * 128 + g8 * 2) * 16, Mw); bd8(x, Mw, q);
            *(LAS u32x4v*)(QS + lane * 1040 + g8 * 16) = pack8(q);
            const unsigned wd[4] = {xw.x, xw.y, xw.z, xw.w}; tr_store8(KT, g8 * 8, wd, lane); }
        { const int g = wvu; const int chv = hd * DH + es * 64 + g * 8; float x[8], v[8], wvv[32];
            unpack8(pxv, x); sload32(kp->in[I_MLWV] + ((size_t)j * 512 + (chv >> 2)) * 16, wvv); bd8(x, wvv, v);
            { const u32x4v vw = pack8(v); const unsigned wd[4] = {vw.x, vw.y, vw.z, vw.w}; tr_store8(VT, g * 8, wd, lane); } }
        }
        if (wv == 0) {
            const float ic = g_ic, fp = g_fp;
            const float lf = fminf(fp, 0.f) - log1pf(__expf(-fabsf(fp)));
            float bb = lf;
#pragma unroll
            for (int o = 1; o < 64; o <<= 1) { const float t = lshfl(bb, lane - o); if (lane >= o) bb += t; }
            const float uu = ic - bb; float pm = uu;
#pragma unroll
            for (int o = 1; o < 64; o <<= 1) { const float t = lshfl(pm, lane - o); if (lane >= o) pm = fmaxf(pm, t); }
            const float a = bb + m_st, mj = fmaxf(a, bb + pm);
            rowterm[lane] = bb - mj; colterm[lane] = uu; winter[lane] = __expf(a - mj); einv[lane] = __expf(-mj);
            const float blast = lshfl(bb, 63), gs = blast - bb + ic, gmax = wave_max(gs), mnew = fmaxf(blast + m_st, gmax);
            kws[lane] = __expf(gs - mnew);
            if (lane == 0) { scal[0] = __expf(blast + m_st - mnew); scal[1] = mnew; }
        }
        __syncthreads();
        for (int rpT = 0; rpT < REP_STILDE; ++rpT) {
            const int jj = tid >> 3, sub = tid & 7, s8 = sub * 8;
            const float rt = rowterm[jj]; float rsum = 0.f;
            const f32x4 ct0 = *(const LAS f32x4*)(colterm + s8), ct1 = *(const LAS f32x4*)(colterm + s8 + 4); const float ctv[8] = {ct0[0], ct0[1], ct0[2], ct0[3], ct1[0], ct1[1], ct1[2], ct1[3]};
#pragma unroll
            for (int e = 0; e < 8; ++e) { const int s = s8 + e; const float w = s <= jj ? sv[e] * 0.04419417382415922f * __expf(rt + ctv[e]) : 0.f; sv[e] = w; rsum += w; }
            *(LAS u32x4v*)(ST + jj * 128 + ((sub ^ (jj & 7)) << 4)) = pack8(sv);
            float qd = 0.f;
#pragma unroll
            for (int c8 = 0; c8 < 8; ++c8) { float qv[8]; unpack8(*(const LAS u32x4v*)(QS + jj * 1040 + (sub * 8 + c8) * 16), qv);
                { const f32x4 n0 = *(const LAS f32x4*)(nst + sub * 64 + c8 * 8), n1 = *(const LAS f32x4*)(nst + sub * 64 + c8 * 8 + 4);
                  qd += qv[0] * n0[0] + qv[1] * n0[1] + qv[2] * n0[2] + qv[3] * n0[3] + qv[4] * n1[0] + qv[5] * n1[1] + qv[6] * n1[2] + qv[7] * n1[3]; } }
            rsum += lshfl(rsum, lane ^ 1); rsum += lshfl(rsum, lane ^ 2); rsum += lshfl(rsum, lane ^ 4);
            qd += lshfl(qd, lane ^ 1); qd += lshfl(qd, lane ^ 2); qd += lshfl(qd, lane ^ 4);
            if (sub == 0) { const float qn = winter[jj] * qd + rsum; dinv[jj] = __builtin_amdgcn_rcpf(fmaxf(fabsf(qn), einv[jj])); }
        }
        __syncthreads();
        if (ci + 1 < NCH) { const int pn = p0 + 64 + lane; const int tn = dir == 0 ? pn : (pn < CTX ? CTX - 1 - pn : TPB + CTX - 1 - pn); const size_t Tn = (size_t)(b * TPB + tn) * INNER; const int w0 = __builtin_amdgcn_readfirstlane(wv);
#pragma unroll
            for (int r = 0; r < 8; ++r) pxc[r] = *(const u32x4v*)(xc + Tn + hd * DH + (w0 * 8 + r) * 8);
            pxv = *(const u32x4v*)(xm + Tn + hd * DH + es * 64 + w0 * 8); }
        {
            f32x4 o[4];
            const int et = wv & 3, dh = wv >> 2, el = 16 * et + fr;
            bf16x8 vfr[2];
#pragma unroll
            for (int mt = 0; mt < 4; ++mt) o[mt] = (f32x4){0.f, 0.f, 0.f, 0.f};
#pragma unroll
            for (int ks = 0; ks < 8; ++ks) {
                u32x4v bw; bw.x = pg8::cvt_pk_bf16(C[2 * ks][0], C[2 * ks][1]); bw.y = pg8::cvt_pk_bf16(C[2 * ks][2], C[2 * ks][3]);
                bw.z = pg8::cvt_pk_bf16(C[2 * ks + 1][0], C[2 * ks + 1][1]); bw.w = pg8::cvt_pk_bf16(C[2 * ks + 1][2], C[2 * ks + 1][3]);
                const bf16x8 bfr = __builtin_bit_cast(bf16x8, bw);
#pragma unroll
                for (int mt = 0; mt < 4; ++mt) { const int off = (16 * mt + fr) * 1040 + 8 * fq + dh * 512;
                    const u32x2 lo = *(const LAS u32x2*)(QS + off + 64 * ks), hi = *(const LAS u32x2*)(QS + off + 64 * ks + 32);
                    u32x4v aw; aw.x = lo.x; aw.y = lo.y; aw.z = hi.x; aw.w = hi.y;
                    o[mt] = __builtin_amdgcn_mfma_f32_16x16x32_bf16(bfr, __builtin_bit_cast(bf16x8, aw), o[mt], 0, 0, 0); }
                if ((ks & 1) == 1) __builtin_amdgcn_sched_barrier(0); }
#pragma unroll
            for (int mt = 0; mt < 4; ++mt)
#pragma unroll
                for (int r = 0; r < 4; ++r) o[mt][r] *= winter[16 * mt + fr];
#pragma unroll
            for (int k2 = 0; k2 < 2; ++k2) vfr[k2] = *(const LAS bf16x8*)(VT + el * 128 + (((4 * k2 + fq) ^ (el & 7)) << 4));
            if (dh == 1) {
#pragma unroll
                for (int mt = 0; mt < 4; ++mt) { u32x2 w; w.x = pg8::cvt_pk_bf16(o[mt][0], o[mt][1]); w.y = pg8::cvt_pk_bf16(o[mt][2], o[mt][3]); *(LAS u32x2*)(XB + ((et * 4 + mt) * 64 + lane) * 8) = w; }
            } else {
#pragma unroll
                for (int k2 = 0; k2 < 2; ++k2)
#pragma unroll
                    for (int mt = 0; mt < 4; ++mt) { const int jr = 16 * mt + fr; const bf16x8 a = *(const LAS bf16x8*)(ST + jr * 128 + (((4 * k2 + fq) ^ (jr & 7)) << 4));
                        o[mt] = __builtin_amdgcn_mfma_f32_16x16x32_bf16(vfr[k2], a, o[mt], 0, 0, 0); }
            }
            __syncthreads();
            if (dh == 0) {
#pragma unroll
                for (int mt = 0; mt < 4; ++mt) { const u32x2 pw = *(const LAS u32x2*)(XB + ((et * 4 + mt) * 64 + lane) * 8);
                    const int jr = 16 * mt + fr, T = tok(jr); const float di = dinv[jr];
                    const float o0 = (o[mt][0] + bflo(pw.x)) * di, o1 = (o[mt][1] + bfhi(pw.x)) * di, o2 = (o[mt][2] + bflo(pw.y)) * di, o3 = (o[mt][3] + bfhi(pw.y)) * di;
                    u16* dst = dir == 0 ? hf + (size_t)T * INNER : hb_ptr(kp, T); u32x2 w; w.x = pg8::cvt_pk_bf16(o0, o1); w.y = pg8::cvt_pk_bf16(o2, o3);
                    *(u32x2*)(dst + hd * DH + es * 64 + 16 * et + 4 * fq) = w; }
            }
            const float decay = scal[0];
#pragma unroll
            for (int i = 0; i < 16; ++i) C[i] = C[i] * decay;
            float kwv[2][8];
#pragma unroll
            for (int k2 = 0; k2 < 2; ++k2) { const f32x4 k0 = *(const LAS f32x4*)(kws + 32 * k2 + 8 * fq), k1 = *(const LAS f32x4*)(kws + 32 * k2 + 8 * fq + 4);
                kwv[k2][0] = k0[0]; kwv[k2][1] = k0[1]; kwv[k2][2] = k0[2]; kwv[k2][3] = k0[3]; kwv[k2][4] = k1[0]; kwv[k2][5] = k1[1]; kwv[k2][6] = k1[2]; kwv[k2][7] = k1[3]; }
#pragma unroll
            for (int k2 = 0; k2 < 2; ++k2) { float vv[8]; unpack8(__builtin_bit_cast(u32x4v, vfr[k2]), vv);
#pragma unroll
                for (int e = 0; e < 8; ++e) vv[e] *= kwv[k2][e];
                const bf16x8 bsc = __builtin_bit_cast(bf16x8, pack8(vv));
#pragma unroll
                for (int dt = 0; dt < 16; ++dt) { const int dr = 256 * (wv >> 2) + 16 * dt + fr; const bf16x8 a = *(const LAS bf16x8*)(KT + dr * 128 + (((4 * k2 + fq) ^ (dr & 7)) << 4));
                    C[dt] = __builtin_amdgcn_mfma_f32_16x16x32_bf16(a, bsc, C[dt], 0, 0, 0);
                    if ((dt & 7) == 7) __builtin_amdgcn_sched_barrier(0); } }
            { float nn = decay * nst[tid];
#pragma unroll
              for (int g = 0; g < 8; ++g) { float kv[8]; unpack8(*(const LAS u32x4v*)(KT + tid * 128 + ((g ^ (tid & 7)) << 4)), kv);
                  { const f32x4 k0 = *(const LAS f32x4*)(kws + 8 * g), k1 = *(const LAS f32x4*)(kws + 8 * g + 4); nn += kv[0] * k0[0] + kv[1] * k0[1] + kv[2] * k0[2] + kv[3] * k0[3] + kv[4] * k1[0] + kv[5] * k1[1] + kv[6] * k1[2] + kv[7] * k1[3]; } }
              nst[tid] = nn; }
            m_st = scal[1];
        }
    }
}

__device__ __forceinline__ void ml_gate_phase(KPC kp, int j) {
    u16* hf = (u16*)(kp->ws + OFF_R2); const u16* xc = (const u16*)(kp->ws + OFF_XC); const u16* z = (const u16*)(kp->ws + OFF_XM);
    const float* ng = kp->in[I_MLNG] + (size_t)j * INNER; const float* sk = kp->in[I_MLSKIP] + (size_t)j * INNER;
    const int lane = ltid() & 63, wv = ltid() >> 6;
    for (int T = lbid() * 8 + wv; T < NTOK; T += gridDim.x * 8) {
        const u16* hbp = hb_ptr(kp, T);
#pragma unroll
        for (int hd = 0; hd < 4; ++hd) { const int c0 = hd * DH + lane * 8; float a[8], bq[8], xv[8], zv[8], o[8];
            unpack8(*(const u32x4v*)(hf + (size_t)T * INNER + c0), a); unpack8(*(const u32x4v*)(hbp + c0), bq);
            float s = 0.f;
#pragma unroll
            for (int e = 0; e < 8; ++e) { a[e] += bq[e]; s += a[e]; }
            const float mu = wave_sum(s) * (1.0f / DH); float vs = 0.f;
#pragma unroll
            for (int e = 0; e < 8; ++e) { a[e] -= mu; vs += a[e] * a[e]; }
            const float rs = rsqrtf(wave_sum(vs) * (1.0f / DH) + 1e-5f);
            unpack8(*(const u32x4v*)(xc + (size_t)T * INNER + c0), xv); unpack8(*(const u32x4v*)(z + (size_t)T * INNER + c0), zv);
            const f32x4 n0 = *(const f32x4*)(ng + c0), n1 = *(const f32x4*)(ng + c0 + 4), s0 = *(const f32x4*)(sk + c0), s1 = *(const f32x4*)(sk + c0 + 4);
            const float ngv[8] = {n0[0], n0[1], n0[2], n0[3], n1[0], n1[1], n1[2], n1[3]}, skv[8] = {s0[0], s0[1], s0[2], s0[3], s1[0], s1[1], s1[2], s1[3]};
#pragma unroll
            for (int e = 0; e < 8; ++e) o[e] = (a[e] * rs * ngv[e] + skv[e] * xv[e]) * siluf(zv[e]);
            *(u32x4v*)(hf + (size_t)T * INNER + c0) = pack8(o); }
    }
}


enum { K_SETUP = 0, K_CN, K_G1, K_G2R, K_HYIN, K_HYCONV, K_HYTR, K_MLUPX, K_MLPREP, K_MLSCAN, K_MLUPZ, K_MLGATE, K_FINAL };
constexpr int NPHASE = 1 + 11 + 13 + 11 + 13 + 1;
__device__ __forceinline__ void decode_phase(int ph, int& kind, int& l, int& arg) {
    kind = K_SETUP; l = 0; arg = 0; if (ph == 0) return;
    ph -= 1;
    for (l = 0; l < 4; ++l) { const int n = (l & 1) ? 13 : 11; if (ph < n) break; ph -= n; }
    if (l == 4) { kind = K_FINAL; l = 0; return; }
    if (ph == 0) { kind = K_CN; arg = 0; return; } if (ph == 1) { kind = K_G1; arg = 0; return; } if (ph == 2) { kind = K_G2R; arg = 0; return; } if (ph == 3) { kind = K_CN; arg = 1; return; }
    const int nm = (l & 1) ? 6 : 4;
    if (ph < 4 + nm) { const int q = ph - 4;
        if (l & 1) { kind = q == 0 ? K_MLUPX : q == 1 ? K_MLPREP : q == 2 ? K_MLSCAN : q == 3 ? K_MLUPZ : q == 4 ? K_MLGATE : K_G2R; arg = 2; }
        else { kind = q == 0 ? K_HYIN : q == 1 ? K_HYCONV : q == 2 ? K_HYTR : K_G2R; arg = 2; }
        return; }
    ph -= 4 + nm;
    if (ph == 0) { kind = K_CN; arg = 2; return; } if (ph == 1) { kind = K_G1; arg = 1; return; } kind = K_G2R; arg = 1;
}

__device__ __forceinline__ void gbar(unsigned* ctr, unsigned target) {
    __syncthreads();
    if (ltid() == 0) {
        __builtin_amdgcn_fence(__ATOMIC_RELEASE, "agent");
        __hip_atomic_fetch_add(ctr, 1u, __ATOMIC_RELAXED, __HIP_MEMORY_SCOPE_AGENT);
        while (__hip_atomic_load(ctr, __ATOMIC_RELAXED, __HIP_MEMORY_SCOPE_AGENT) < target) __builtin_amdgcn_s_sleep(2);
        __builtin_amdgcn_fence(__ATOMIC_ACQUIRE, "agent");
    }
    __syncthreads();
}
#ifndef REPMASK
#define REPMASK 0
#define REPN 1
#endif
template <int MIX> __device__ __forceinline__ void run_phases(int lo, int hi, int ph_lo, int ph_hi, LAS unsigned char* lds0, cg::grid_group& grid) {
    lo = lo > ph_lo ? lo : ph_lo; hi = hi < ph_hi ? hi : ph_hi;
    for (int ph = lo; ph < hi; ++ph) {
        KPC kp = (KPC)__builtin_amdgcn_kernarg_segment_ptr(); asm volatile("" : "+s"(kp) :: "memory");
        LAS unsigned char* lds = lds0; asm volatile("" : "+s"(lds) :: "memory");
        unsigned char* ws = kp->ws; unsigned char* wb = ws + OFF_WB;
        int kind, l, arg; decode_phase(ph, kind, l, arg); const int j = l >> 1;
        const float* modl = (const float*)(ws + OFF_MOD) + (size_t)l * 5 * 9216;
        const int nrep = ((REPMASK >> kind) & 1) ? REPN : 1;
        for (int rep = 0; rep < nrep; ++rep) {
        if (kind == K_SETUP) { if constexpr (MIX == 0) setup_phase(kp, (LAS float*)lds); }
        else if (kind == K_CN) {
            if (arg == 0) { convert_layer(kp, l, (LAS float*)lds); if constexpr (MIX == 1) ml_m_phase(kp, j); }
            if constexpr (MIX == 0) { if (arg == 1) hy_mlp_phase(kp, j); }
            norm_phase(kp, l, arg, arg == 0 ? (l == 0 ? 0 : 11) : arg == 1 ? 11 : (l == 3 ? 0 : (l & 1) ? 8 : 4));
        } else if (kind == K_G1) {
            pg8::Gemm g{(const u16*)(ws + OFF_U), (const u16*)(wb + (arg ? WB_FIN1 : WB_FIN0)), NTOK, 2 * FF, D};
            pg8::StaticOrder S; S.init(g.M, g.N, (int)gridDim.x, lbid(), (l == 3 && arg == 1) ? 1 : 0); EpiSwiglu E{(u16*)(ws + OFF_R1)};
            pg8::gemm_phase<EpiSwiglu, pg8::StaticOrder, false>(lds, g, S, E, nullptr);
        } else if (kind == K_G2R) {
            const u16* gA; const u16* gB; int gK, gidx, gbj = -1;
            if (arg < 2) { gA = (const u16*)(ws + OFF_R1); gB = (const u16*)(wb + (arg ? WB_FOUT1 : WB_FOUT0)); gK = FF; gidx = arg ? 8 : 2; }
            else if (MIX == 1) { gA = (const u16*)(ws + OFF_R2); gB = (const u16*)(wb + WB_MOUT); gK = INNER; gidx = 5; }
            else { gA = (const u16*)(ws + OFF_U); gB = (const u16*)(wb + WB_MOUT); gK = D; gidx = 5; gbj = j; }
            const pg8::Gemm g{gA, gB, NTOK, D, gK, 0}; const EpiResid E{kp, l, gidx, gbj};
            pg8::StaticOrder S; S.init(g.M, g.N, (int)gridDim.x, lbid(), (l == 3 && arg >= 1) ? 1 : 2, g.K / 256);
            pg8::gemm_phase<EpiResid, pg8::StaticOrder, false>(lds, g, S, E, nullptr);
        } else if (kind == K_FINAL) { if constexpr (MIX == 1) final_phase(kp); }
        else if constexpr (MIX == 0) {
            if (kind == K_HYIN) {
                pg8::Gemm g{(const u16*)(wb + WB_MIN), (const u16*)(ws + OFF_U), 3 * D, NTOK, D};
                pg8::StaticOrder S; S.init(g.M, g.N, (int)gridDim.x, lbid());
                EpiProjT E{(u16*)(ws + OFF_R1 + HY_PL), (u16*)(ws + OFF_R1 + HY_PC), kp->in[I_HYBIN] + (size_t)j * 3 * D};
                pg8::gemm_phase<EpiProjT, pg8::StaticOrder, false>(lds, g, S, E, nullptr);
                __syncthreads();
                for (int t = lbid(); t < 2048; t += gridDim.x) hy_filter_task(kp, j, t, (LAS f32x2*)lds, (LAS float*)(lds + 131072));
            } else if (kind == K_HYCONV) {
                for (int t = lbid(); t < 2048; t += gridDim.x) hy_conv_lat(kp, j, t, (LAS f32x2*)lds);
                for (int t = lbid(); t < 1024; t += gridDim.x) hy_conv_ctx(kp, j, t, (LAS float*)lds);
            } else if (kind == K_HYTR) hy_transpose(kp, (LAS u16*)lds);
        } else {
            if (kind == K_MLUPX || kind == K_MLUPZ) {
                const bool zz = kind == K_MLUPZ;
                pg8::Gemm g{(const u16*)(ws + OFF_U), (const u16*)(wb + WB_MIN) + (zz ? (size_t)INNER * D : 0), NTOK, INNER, D};
                pg8::StaticOrder S; S.init(g.M, g.N, (int)gridDim.x, lbid(), (zz && l == 3) ? 1 : 0); EpiBf E{(u16*)(ws + OFF_XM), INNER};
                pg8::gemm_phase<EpiBf, pg8::StaticOrder, false>(lds, g, S, E, nullptr);
            } else if (kind == K_MLPREP) { for (int t = lbid(); t < NB * NCH * 4; t += gridDim.x) ml_prep_task(kp, j, t, lds); }
            else if (kind == K_MLSCAN) { for (int t = lbid(); t < 256; t += gridDim.x) ml_scan_task(kp, j, t, lds); }
            else if (kind == K_MLGATE) ml_gate_phase(kp, j);
        }
        }
        if (ph + 1 < ph_hi) gbar((unsigned*)(kp->ws + OFF_MLM + 65536), (unsigned)(ph + 1 - ph_lo) * gridDim.x);
    }
}

__global__ void __launch_bounds__(512) fwd_megakernel(KP kparg) {
    extern __shared__ __attribute__((aligned(16))) unsigned char shm[];
    LAS unsigned char* lds = (LAS unsigned char*)shm;
    cg::grid_group grid = cg::this_grid();
    grid.sync();
    wtab_init();
    const int ph_lo = kparg.ph_lo, ph_hi = kparg.ph_hi;
    run_phases<0>(0, 12, ph_lo, ph_hi, lds, grid);
    run_phases<1>(12, 25, ph_lo, ph_hi, lds, grid);
    run_phases<0>(25, 36, ph_lo, ph_hi, lds, grid);
    run_phases<1>(36, 50, ph_lo, ph_hi, lds, grid);
}

extern "C" void kernel_launch(void* const* d_in, const int* in_sizes, int n_in, void* d_out, int out_size, void* d_ws, size_t ws_size, hipStream_t stream) {
    static int grid_blocks = 0;
    if (!grid_blocks) {
        int dev = 0, cus = 0, per_cu = 0;
        hipGetDevice(&dev);
        hipDeviceGetAttribute(&cus, hipDeviceAttributeMultiprocessorCount, dev);
        hipFuncSetAttribute((const void*)fwd_megakernel, hipFuncAttributeMaxDynamicSharedMemorySize, LDS_BYTES);
        hipOccupancyMaxActiveBlocksPerMultiprocessor(&per_cu, fwd_megakernel, 512, LDS_BYTES);
        if (per_cu < 1) per_cu = 1;
        grid_blocks = cus * 1;
        if (ws_size < WS_NEED2) fprintf(stderr, "workspace too small: %zu < %zu\n", ws_size, (size_t)WS_NEED2);
    }
    KP hp{};
    for (int i = 0; i < 36; ++i) hp.in[i] = (const float*)d_in[i];
    hp.out = (float*)d_out; hp.ws = (unsigned char*)d_ws; hp.ph_lo = 0; hp.ph_hi = NPHASE;
    void* args[] = {&hp};
    hipMemsetAsync((unsigned char*)d_ws + OFF_MLM + 65536, 0, 256, stream);
    hipError_t e = hipLaunchCooperativeKernel((void*)fwd_megakernel, dim3(grid_blocks), dim3(512), args, LDS_BYTES, stream);
    if (e != hipSuccess) fprintf(stderr, "cooperative launch failed: %s (grid %d)\n", hipGetErrorString(e), grid_blocks);
}
```

```cpp
#define REPMASK 0
#define REPN 1
#include <hip/hip_runtime.h>
#include <hip/hip_cooperative_groups.h>
#include <cstdio>
namespace cg = cooperative_groups;
#define WTAB_OFF 163584
__device__ __forceinline__ int llane() { int l; asm volatile("v_mbcnt_lo_u32_b32 %0, -1, 0\n\tv_mbcnt_hi_u32_b32 %0, -1, %0" : "=v"(l) :: "memory"); return l; }
__device__ __forceinline__ int lwave() { extern __shared__ __attribute__((aligned(16))) unsigned char shm_w[];
    const int hw = __builtin_amdgcn_s_getreg(10244) & 63;
    return __builtin_amdgcn_readfirstlane(*(const __attribute__((address_space(3))) int*)((__attribute__((address_space(3))) unsigned char*)shm_w + WTAB_OFF + hw * 4)); }
__device__ __forceinline__ void wtab_init() { extern __shared__ __attribute__((aligned(16))) unsigned char shm_w[];
    const int hw = __builtin_amdgcn_s_getreg(10244) & 63;
    *(__attribute__((address_space(3))) int*)((__attribute__((address_space(3))) unsigned char*)shm_w + WTAB_OFF + hw * 4) = (int)(threadIdx.x >> 6); }
__device__ __forceinline__ int ltid() { return lwave() * 64 + llane(); }
__device__ __forceinline__ int lbid() { int t = blockIdx.x; asm volatile("" : "+s"(t) :: "memory"); return t; }
namespace pg8 {
#define PG8_LAS __attribute__((address_space(3)))
typedef unsigned short bf16_t;
typedef short bf16x8 __attribute__((ext_vector_type(8)));
typedef float f32x4 __attribute__((ext_vector_type(4)));
typedef unsigned u32x4 __attribute__((ext_vector_type(4)));
constexpr int BM = 256, BK = 64, HALF = 128, HTB = HALF * BK * 2  , STAGE_BYTES = 8 * HTB, NXCD = 8, WGM = 8;

__host__ __device__ __forceinline__ int lds_byte(int r, int c) { const int st = (r >> 4) * 2 + (c >> 5), rr = r & 15, cc = c & 31, ob = rr * 64 + cc * 2; return st * 1024 + (ob ^ (((ob >> 9) & 1) << 5)); }
__host__ __device__ __forceinline__ void stage_rc(int b, int& R, int& C) { const int st = b / 1024, sb = b % 1024, swz = sb ^ (((sb >> 9) & 1) << 5); R = (st >> 1) * 16 + swz / 64; C = (st & 1) * 32 + (swz % 64) / 2; }
__host__ __device__ __forceinline__ int perm32(int rho) { const int n = rho >> 4, i = rho & 15; return 8 * (i >> 2) + 4 * n + (i & 3); }

struct Unit { int pm, pn, kofs, nt; };
struct Gemm { const bf16_t* A; const bf16_t* Bt; int M, N, K, ldk; };

struct StaticOrder {
    int nM, nN, nwg, G, c, lat, nk;
    __host__ __device__ void init(int M, int N, int G_, int c_, int lat_ = 0, int nk_ = 0) { lat = lat_; nk = nk_; nM = lat ? 128 : M / BM; nN = N / BM; nwg = nM * nN; G = G_; c = c_; }
    __host__ __device__ bool next(int i, Unit& u) const {
        const long L = (long)i * G + c;
        if (L >= nwg) { if (lat != 2 || L >= nwg + 16 * nk) return false; const int Lc = (int)L - nwg, un = Lc & 15; u.pm = (un >> 2) * 33; u.pn = un & 3; u.kofs = (Lc >> 4) * 256; u.nt = 4; return true; }
        int wgid = (int)L; { const int q = nwg / NXCD, r = nwg % NXCD, xcd = wgid % NXCD, off = wgid / NXCD; wgid = (xcd < r ? xcd * (q + 1) : r * (q + 1) + (xcd - r) * q) + off; }
        const int nig = WGM * nN, gid = wgid / nig, fm = gid * WGM, gsz = (nM - fm) < WGM ? (nM - fm) : WGM;
        u.pm = fm + ((wgid % nig) % gsz); u.pn = (wgid % nig) / gsz; u.kofs = 0; u.nt = 0; if (lat) u.pm = (u.pm >> 5) * 33 + 1 + (u.pm & 31); return true;
    }
    __device__ __forceinline__ void a_ready(const Unit&) const {}
    __device__ __forceinline__ void done(const Unit&) const {}
};
__device__ __forceinline__ unsigned cvt_pk_bf16(float lo, float hi) { unsigned r; asm volatile("v_cvt_pk_bf16_f32 %0, %1, %2" : "=v"(r) : "v"(lo), "v"(hi)); return r; }
template <class Epi, class Sched, bool STAMP = false>
__device__ __forceinline__ void gemm_phase(PG8_LAS unsigned char* lds, const Gemm g, const Sched& S, const Epi& E, unsigned long long* stamps) {
    const int tid = ltid(), wid = __builtin_amdgcn_readfirstlane(tid >> 6), lane = tid & 63, wr = wid >> 2, wc = wid & 3, fr = lane & 15, fq = lane >> 4;
    const int K = g.K, nt = K / BK, ldk = g.ldk ? g.ldk : g.K;
    int ts_lo = 0, ts_hi = 0, nts = 0; const unsigned long long rt_entry = STAMP ? (unsigned long long)wall_clock64() : 0ull;
#define PG8_STAMP() do { if (STAMP && wid == 0 && nts < 64) { const unsigned long long _c = (unsigned long long)clock64(); \
        ts_lo = (lane == nts) ? (int)(unsigned)_c : ts_lo; ts_hi = (lane == nts) ? (int)(unsigned)(_c >> 32) : ts_hi; ++nts; } } while (0)
    PG8_STAMP();
    unsigned voffA[2], voffB[2];
#pragma unroll
    for (int i = 0; i < 2; ++i) { int R, C; stage_rc(tid * 16 + i * 8192, R, C); const int Rb = Epi::PERM ? ((R & ~31) + perm32(R & 31)) : R;
        voffA[i] = (unsigned)(R * ldk + C) * 2u; voffB[i] = (unsigned)(Rb * ldk + C) * 2u; }
    const size_t kstep = (size_t)(BK * 2);
    const size_t hstep = (size_t)HALF * ldk * 2;
    const size_t tstep = 2 * hstep;
    const unsigned ldsw = (unsigned)wid * 1024u;
    const int aoff = lds_byte(wr * 64 + fr, fq * 8), boff = lds_byte(wc * 32 + fr, fq * 8);
#define PG8_SA(b, h) (((b) * 2 + (h)) * HTB)
#define PG8_SB(b, h) ((4 + (b) * 2 + (h)) * HTB)
#define PG8_STAGE(bufoff, gbase, voff) do { _Pragma("unroll") for (int _i = 0; _i < 2; ++_i) \
        __builtin_amdgcn_global_load_lds((const unsigned*)((const char*)(gbase) + (voff)[_i]), (PG8_LAS unsigned*)(lds + (bufoff) + ldsw + _i * 8192), 16, 0, 0); } while (0)
#define PG8_LDA(dst, b, h) do { _Pragma("unroll") for (int m = 0; m < 4; ++m) _Pragma("unroll") for (int k = 0; k < 2; ++k) dst[m][k] = *(const PG8_LAS bf16x8*)(lds + PG8_SA(b, h) + aoff + m * 2048 + k * 1024); } while (0)
#define PG8_LDB(dst, b, h) do { _Pragma("unroll") for (int n = 0; n < 2; ++n) _Pragma("unroll") for (int k = 0; k < 2; ++k) dst[n][k] = *(const PG8_LAS bf16x8*)(lds + PG8_SB(b, h) + boff + n * 2048 + k * 1024); } while (0)
#define PG8_MMA(ai, bj, At, Bt) do { __builtin_amdgcn_s_setprio(1); _Pragma("unroll") for (int m = 0; m < 4; ++m) _Pragma("unroll") for (int n = 0; n < 2; ++n) _Pragma("unroll") for (int k = 0; k < 2; ++k) \
        acc[ai][bj][m][n] = __builtin_amdgcn_mfma_f32_16x16x32_bf16(Bt[n][k], At[m][k], acc[ai][bj][m][n], 0, 0, 0); __builtin_amdgcn_s_setprio(0); } while (0)
#define PG8_WAIT_V(n) asm volatile("s_waitcnt vmcnt(" #n ")" ::: "memory")
#define PG8_WAIT_L(n) asm volatile("s_waitcnt lgkmcnt(" #n ")" ::: "memory")
#define PG8_BAR __builtin_amdgcn_s_barrier()
#define PG8_SCHED __builtin_amdgcn_sched_barrier(0)
    Unit cur, nxt; int ui = 0;
    if (!S.next(0, cur)) return;
    f32x4 acc[2][2][4][2];
#pragma unroll
    for (int a = 0; a < 2; ++a)
#pragma unroll
        for (int b = 0; b < 2; ++b)
#pragma unroll
            for (int m = 0; m < 4; ++m)
#pragma unroll
                for (int n = 0; n < 2; ++n) acc[a][b][m][n] = (f32x4){0.f, 0.f, 0.f, 0.f};
    bf16x8 At[4][2], B0[2][2], B1[2][2];
    const char* cA = (const char*)g.A + (size_t)cur.pm * tstep + (size_t)cur.kofs * 2; const char* cB = (const char*)g.Bt + (size_t)cur.pn * tstep + (size_t)cur.kofs * 2;
    S.a_ready(cur);
    PG8_STAGE(PG8_SB(0, 0), cB, voffB); PG8_STAGE(PG8_SA(0, 0), cA, voffA); PG8_STAGE(PG8_SB(0, 1), cB + hstep, voffB); PG8_STAGE(PG8_SA(0, 1), cA + hstep, voffA);
    if (wr == 1) PG8_BAR;
    PG8_WAIT_V(4); PG8_BAR;
    PG8_STAGE(PG8_SB(1, 0), cB + kstep, voffB); PG8_STAGE(PG8_SA(1, 0), cA + kstep, voffA); PG8_STAGE(PG8_SB(1, 1), cB + hstep + kstep, voffB);
    PG8_WAIT_V(6); PG8_BAR;
    PG8_STAMP();
    for (;;) {
        const bool has_next = S.next(ui + 1, nxt);
        const char* nA = has_next ? (const char*)g.A + (size_t)nxt.pm * tstep + (size_t)nxt.kofs * 2 : cA; const char* nB = has_next ? (const char*)g.Bt + (size_t)nxt.pn * tstep + (size_t)nxt.kofs * 2 : cB;
        const int ntu = cur.nt ? cur.nt : nt;
        for (int t = 0; t < ntu; t += 2) {
            const bool last = (t == ntu - 2);
            const char* a1 = cA + (size_t)(t + 1) * kstep;
            const char* a2 = last ? nA : cA + (size_t)(t + 2) * kstep; const char* b2 = last ? nB : cB + (size_t)(t + 2) * kstep;
            const char* a3 = a2 + kstep; const char* b3 = b2 + kstep;
            if (last && has_next) S.a_ready(nxt);
            PG8_LDB(B0, 0, 0); PG8_SCHED; PG8_LDA(At, 0, 0); PG8_STAGE(PG8_SA(1, 1), a1 + hstep, voffA);
            PG8_WAIT_L(8); PG8_BAR; PG8_WAIT_L(0); PG8_MMA(0, 0, At, B0); PG8_BAR; PG8_SCHED;
            PG8_LDB(B1, 0, 1); PG8_STAGE(PG8_SB(0, 0), b2, voffB);
            PG8_BAR; PG8_WAIT_L(0); PG8_MMA(0, 1, At, B1); PG8_BAR;
            PG8_LDA(At, 0, 1); PG8_STAGE(PG8_SA(0, 0), a2, voffA);
            PG8_BAR; PG8_WAIT_L(0); PG8_MMA(1, 0, At, B0); PG8_BAR; PG8_SCHED;
            PG8_STAGE(PG8_SB(0, 1), b2 + hstep, voffB);
            PG8_WAIT_V(6); PG8_BAR; PG8_MMA(1, 1, At, B1); PG8_BAR;
            PG8_LDB(B0, 1, 0); PG8_SCHED; PG8_LDA(At, 1, 0); PG8_STAGE(PG8_SA(0, 1), a2 + hstep, voffA);
            PG8_WAIT_L(8); PG8_BAR; PG8_WAIT_L(0); PG8_MMA(0, 0, At, B0); PG8_BAR; PG8_SCHED;
            PG8_LDB(B1, 1, 1); PG8_STAGE(PG8_SB(1, 0), b3, voffB);
            PG8_BAR; PG8_WAIT_L(0); PG8_MMA(0, 1, At, B1); PG8_BAR;
            PG8_LDA(At, 1, 1); PG8_STAGE(PG8_SA(1, 0), a3, voffA);
            PG8_BAR; PG8_WAIT_L(0); PG8_MMA(1, 0, At, B0); PG8_BAR; PG8_SCHED;
            PG8_STAGE(PG8_SB(1, 1), b3 + hstep, voffB);
            PG8_WAIT_V(6); PG8_BAR; PG8_MMA(1, 1, At, B1); PG8_BAR;
        }
        PG8_STAMP();
        if constexpr (!Epi::AFTER_DRAIN) { E(acc, cur, wr, wc, fr, fq); S.done(cur); }
        PG8_STAMP();
        if (!has_next) break;
#pragma unroll
        for (int a = 0; a < 2; ++a)
#pragma unroll
            for (int b = 0; b < 2; ++b)
#pragma unroll
                for (int m = 0; m < 4; ++m)
#pragma unroll
                    for (int n = 0; n < 2; ++n) acc[a][b][m][n] = (f32x4){0.f, 0.f, 0.f, 0.f};
        cur = nxt; cA = nA; cB = nB; ++ui;
    }
    PG8_WAIT_V(0);
    if (wr == 0) PG8_BAR;
    PG8_BAR;
    if constexpr (Epi::AFTER_DRAIN) { E.fused(acc, cur, wr, wc, fr, fq, lds, wid, lane); S.done(cur); }
    PG8_STAMP();
    if (STAMP && wid == 0) { stamps[lane] = lane < nts ? (((unsigned long long)(unsigned)ts_hi << 32) | (unsigned)ts_lo) : 0ull;
        if (lane == 62) stamps[62] = rt_entry; if (lane == 63) stamps[63] = (unsigned long long)wall_clock64(); }
#undef PG8_STAMP
#undef PG8_SA
#undef PG8_SB
#undef PG8_STAGE
#undef PG8_LDA
#undef PG8_LDB
#undef PG8_MMA
#undef PG8_WAIT_V
#undef PG8_WAIT_L
#undef PG8_BAR
#undef PG8_SCHED
}
}

typedef unsigned short u16;
using pg8::f32x4; using pg8::bf16x8;
typedef float f32x2 __attribute__((ext_vector_type(2)));
typedef unsigned u32x2 __attribute__((ext_vector_type(2)));
typedef unsigned u32x4v __attribute__((ext_vector_type(4)));
typedef short s16x4 __attribute__((ext_vector_type(4)));
#define LAS __attribute__((address_space(3)))
constexpr int D = 1024, NB = 4, SEQ = 8192, CTX = 256, TPB = 8448, NTOK = 33792, FF = 2816, NCH = 132, INNER = 2048, DH = 512, NFFT = 16384;
constexpr size_t MiB = 1u << 20;
constexpr size_t OFF_WB = 0, OFF_MOD = 48 * MiB, OFF_H = 49 * MiB, OFF_U = OFF_H + 132 * MiB, OFF_R1 = OFF_U + 66 * MiB, OFF_R2 = OFF_R1 + 264 * MiB,
                 OFF_HBC = OFF_R2 + 132 * MiB, OFF_GATES = OFF_HBC + 4 * MiB, OFF_H2 = OFF_GATES + 3 * MiB, OFF_KCTX = OFF_H2 + 3 * MiB, WS_NEED = OFF_KCTX + 4 * MiB;
constexpr size_t WB_FIN0 = 0, WB_FIN1 = 11 * MiB, WB_FOUT0 = 22 * MiB, WB_FOUT1 = 22 * MiB + 5632 * 1024, WB_MIN = 33 * MiB, WB_MOUT = 41 * MiB, WB_WGT = 45 * MiB;
constexpr int LDS_BYTES = 163840;
struct KP { const float* in[36]; float* out; unsigned char* ws; int ph_lo, ph_hi; };
typedef const KP __attribute__((address_space(4))) * KPC;
enum { I_X = 0, I_C, I_CTX, I_CCTX, I_ADAW, I_ADAB, I_NORMG, I_FINALG, I_FFNIN, I_FFNOUT, I_HYWIN, I_HYBIN, I_HYCW, I_HYCB, I_HYW1, I_HYB1, I_HYW2, I_HYB2, I_HYW3, I_HYB3,
       I_HYFREQ, I_HYDECAY, I_HYSKIP, I_HYWOUT, I_HYBOUT, I_MLUP, I_MLCW, I_MLCB, I_MLWQ, I_MLWK, I_MLWV, I_MLWG, I_MLBG, I_MLNG, I_MLSKIP, I_MLDOWN };

__device__ __forceinline__ float bf2f(u16 b) { return __uint_as_float(((unsigned)b) << 16); }
__device__ __forceinline__ float bflo(unsigned w) { return __uint_as_float(w << 16); }
__device__ __forceinline__ float bfhi(unsigned w) { return __uint_as_float(w & 0xffff0000u); }
__device__ __forceinline__ u16 f2bf(float f) { return (u16)(pg8::cvt_pk_bf16(f, 0.f) & 0xffffu); }
__device__ __forceinline__ float siluf(float x) { return x * __builtin_amdgcn_rcpf(1.0f + __expf(-x)); }
__device__ __forceinline__ int modrow_of_token(int T) { const int b = T / TPB, t = T - b * TPB; return t < CTX ? 4 : b; }
__device__ __forceinline__ float lshfl(float v, int srclane) { return __int_as_float(__builtin_amdgcn_ds_bpermute(srclane << 2, __float_as_int(v))); }
__device__ __forceinline__ float wave_sum(float v) { const int lane = llane();
#pragma unroll
    for (int o = 32; o > 0; o >>= 1) v += lshfl(v, lane ^ o);
    return v; }
__device__ __forceinline__ float wave_max(float v) { const int lane = llane();
#pragma unroll
    for (int o = 32; o > 0; o >>= 1) v = fmaxf(v, lshfl(v, lane ^ o));
    return v; }

__device__ __forceinline__ void unpack8(u32x4v w, float (&f)[8]) { f[0] = bflo(w.x); f[1] = bfhi(w.x); f[2] = bflo(w.y); f[3] = bfhi(w.y); f[4] = bflo(w.z); f[5] = bfhi(w.z); f[6] = bflo(w.w); f[7] = bfhi(w.w); }
__device__ __forceinline__ u32x4v pack8(const float (&f)[8]) { u32x4v w; w.x = pg8::cvt_pk_bf16(f[0], f[1]); w.y = pg8::cvt_pk_bf16(f[2], f[3]); w.z = pg8::cvt_pk_bf16(f[4], f[5]); w.w = pg8::cvt_pk_bf16(f[6], f[7]); return w; }

struct EpiSwiglu {
    static constexpr bool PERM = true, AFTER_DRAIN = false;
    u16* act;
    __device__ __forceinline__ void operator()(const f32x4 (&acc)[2][2][4][2], const pg8::Unit& u, int wr, int wc, int fr, int fq) const {
        const int row0 = u.pm * 256 + wr * 64 + fr, col0 = u.pn * 128 + wc * 32 + 8 * fq;
#pragma unroll
        for (int ai = 0; ai < 2; ++ai)
#pragma unroll
            for (int m = 0; m < 4; ++m) {
                const f32x4 g0 = acc[ai][0][m][0], g1 = acc[ai][0][m][1], v0 = acc[ai][1][m][0], v1 = acc[ai][1][m][1];
                u32x4v w;
                w.x = pg8::cvt_pk_bf16(siluf(g0[0]) * v0[0], siluf(g0[1]) * v0[1]); w.y = pg8::cvt_pk_bf16(siluf(g0[2]) * v0[2], siluf(g0[3]) * v0[3]);
                w.z = pg8::cvt_pk_bf16(siluf(g1[0]) * v1[0], siluf(g1[1]) * v1[1]); w.w = pg8::cvt_pk_bf16(siluf(g1[2]) * v1[2], siluf(g1[3]) * v1[3]);
                *(u32x4v*)(act + (size_t)(row0 + ai * 128 + m * 16) * FF + col0) = w; }
    }
};
struct EpiResid {
    static constexpr bool PERM = false, AFTER_DRAIN = false;
    KPC kp; int l, gidx, bias_j;
    __device__ __forceinline__ void operator()(const f32x4 (&acc)[2][2][4][2], const pg8::Unit& u, int wr, int wc, int fr, int fq) const {
        unsigned char* ws = kp->ws; float* h = (float*)(ws + OFF_H); float* part = (float*)kp->out;
        const float* bias = bias_j >= 0 ? kp->in[I_HYBOUT] + (size_t)bias_j * D : nullptr; const float scale = gidx == 5 ? 1.0f : 0.5f;
        const int col0 = u.pn * 256 + wc * 32 + 4 * fq;
        const int mr = modrow_of_token(u.pm * 256);
        const float* gp = (const float*)(ws + OFF_MOD) + ((size_t)l * 5 + mr) * 9216 + gidx * 1024;
        const bool split = u.nt != 0, addb = bias != nullptr && u.kofs == 0;
        float* base = split ? part + ((size_t)(u.kofs >> 8) * 1024 + (u.pm / 33) * 256 + wr * 64 + fr) * D : h + (size_t)(u.pm * 256 + wr * 64 + fr) * D;
#pragma unroll
        for (int bj = 0; bj < 2; ++bj)
#pragma unroll
            for (int n = 0; n < 2; ++n) { const f32x4 gv = *(const f32x4*)(gp + col0 + bj * 128 + n * 16) * scale;
                const f32x4 bv = addb ? *(const f32x4*)(bias + col0 + bj * 128 + n * 16) : (f32x4){0.f, 0.f, 0.f, 0.f};
#pragma unroll
                for (int ai = 0; ai < 2; ++ai)
#pragma unroll
                    for (int m = 0; m < 4; ++m) { f32x4* q = (f32x4*)(base + (size_t)(ai * 128 + m * 16) * D + col0 + bj * 128 + n * 16); const f32x4 v = gv * (acc[ai][bj][m][n] + bv);
                        if (split) *q = v; else *q = *q + v; } }
    }
};
struct EpiBf {
    static constexpr bool PERM = true, AFTER_DRAIN = false;
    u16* O; int ldc;
    __device__ __forceinline__ void operator()(const f32x4 (&acc)[2][2][4][2], const pg8::Unit& u, int wr, int wc, int fr, int fq) const {
        const int row0 = u.pm * 256 + wr * 64 + fr, col0 = u.pn * 256 + wc * 32 + 8 * fq;
#pragma unroll
        for (int ai = 0; ai < 2; ++ai)
#pragma unroll
            for (int m = 0; m < 4; ++m)
#pragma unroll
                for (int bj = 0; bj < 2; ++bj) { const f32x4 a = acc[ai][bj][m][0], b = acc[ai][bj][m][1]; u32x4v w;
                    w.x = pg8::cvt_pk_bf16(a[0], a[1]); w.y = pg8::cvt_pk_bf16(a[2], a[3]); w.z = pg8::cvt_pk_bf16(b[0], b[1]); w.w = pg8::cvt_pk_bf16(b[2], b[3]);
                    *(u32x4v*)(O + (size_t)(row0 + ai * 128 + m * 16) * ldc + col0 + bj * 128) = w; }
    }
};
struct EpiProjT {
    static constexpr bool PERM = true, AFTER_DRAIN = false;
    u16* lat; u16* ctx; const float* bias;
    __device__ __forceinline__ void operator()(const f32x4 (&acc)[2][2][4][2], const pg8::Unit& u, int wr, int wc, int fr, int fq) const {
        const int row0 = u.pm * 256 + wr * 64 + fr, tc0 = wc * 32 + 8 * fq;
        const int b = u.pn / 33, tile = u.pn - b * 33;
#pragma unroll
        for (int ai = 0; ai < 2; ++ai)
#pragma unroll
            for (int m = 0; m < 4; ++m) { const int ch = row0 + ai * 128 + m * 16; const float bs = bias[ch];
                u16* dst = tile == 0 ? ctx + ((size_t)b * 3072 + ch) * CTX + tc0 : lat + ((size_t)b * 3072 + ch) * SEQ + (tile - 1) * 256 + tc0;
#pragma unroll
                for (int bj = 0; bj < 2; ++bj) { const f32x4 a = acc[ai][bj][m][0] + bs, c = acc[ai][bj][m][1] + bs; u32x4v w;
                    w.x = pg8::cvt_pk_bf16(a[0], a[1]); w.y = pg8::cvt_pk_bf16(a[2], a[3]); w.z = pg8::cvt_pk_bf16(c[0], c[1]); w.w = pg8::cvt_pk_bf16(c[2], c[3]);
                    *(u32x4v*)(dst + bj * 128) = w; } }
    }
};


struct LatOrder : pg8::StaticOrder {
    __device__ bool next(int i, pg8::Unit& u) const { if (!pg8::StaticOrder::next(i, u)) return false; u.pm = (u.pm >> 5) * 33 + 1 + (u.pm & 31); return true; }
};
struct CtxSplitOrder {
    int nk, G, c;
    __device__ bool next(int i, pg8::Unit& u) const { const int L = i * G + c; if (L >= 16 * nk) return false; const int un = L & 15, kc = L >> 4; u.pm = (un >> 2) * 33; u.pn = un & 3; u.kofs = kc * 256; return true; }
    __device__ __forceinline__ void a_ready(const pg8::Unit&) const {}
    __device__ __forceinline__ void done(const pg8::Unit&) const {}
};
struct EpiResidAtomic {
    static constexpr bool PERM = false, AFTER_DRAIN = false;
    float* h; const float* gp; float scale;
    __device__ __forceinline__ void operator()(const f32x4 (&acc)[2][2][4][2], const pg8::Unit& u, int wr, int wc, int fr, int fq) const {
        const int row0 = u.pm * 256 + wr * 64 + fr, col0 = u.pn * 256 + wc * 32 + 4 * fq;
#pragma unroll
        for (int bj = 0; bj < 2; ++bj)
#pragma unroll
            for (int n = 0; n < 2; ++n) { const f32x4 gv = *(const f32x4*)(gp + col0 + bj * 128 + n * 16) * scale;
#pragma unroll
                for (int ai = 0; ai < 2; ++ai)
#pragma unroll
                    for (int m = 0; m < 4; ++m) { float* q = h + (size_t)(row0 + ai * 128 + m * 16) * D + col0 + bj * 128 + n * 16; const f32x4 v = gv * acc[ai][bj][m][n];
                        atomicAdd(q, v[0]); atomicAdd(q + 1, v[1]); atomicAdd(q + 2, v[2]); atomicAdd(q + 3, v[3]); } }
    }
};

__device__ __forceinline__ void ctx_bias_phase(KPC kp, const float* gp, const float* bias) {
    float* h = (float*)(kp->ws + OFF_H);
    for (int i = lbid() * 512 + ltid(); i < NB * CTX * 256; i += gridDim.x * 512) { const int r = i >> 8, c = (i & 255) * 4, b = r >> 8, t = r & 255;
        f32x4* q = (f32x4*)(h + ((size_t)b * TPB + t) * D + c); *q = *q + *(const f32x4*)(gp + c) * *(const f32x4*)(bias + c); }
}
__device__ __forceinline__ int colmap(int n, int mapmode) { return mapmode ? (((n >> 8) << 7) + (n & 127) + ((n >> 7) & 1) * FF) : n; }
__device__ __forceinline__ void convert_T(const float* __restrict__ src, int ld, int K, int Nd, int mapmode, u16* __restrict__ dst, LAS float* tile, int& tctr) {
    const int tid = ltid(), nkt = K / 64, ntile = (Nd / 64) * nkt;
    const int G = (int)gridDim.x; const int first = (((lbid() - tctr) % G) + G) % G; tctr += ntile;
    for (int t = first; t < ntile; t += G) {
        const int n0 = (t / nkt) * 64, k0 = (t % nkt) * 64, c0 = colmap(n0, mapmode);
#pragma unroll
        for (int i = 0; i < 2; ++i) { const int e = tid + 512 * i, kr = e >> 4, c4 = (e & 15) * 4;
            const f32x4 v = *(const f32x4*)(src + (size_t)(k0 + kr) * ld + c0 + c4);
            tile[kr * 65 + c4] = v[0]; tile[kr * 65 + c4 + 1] = v[1]; tile[kr * 65 + c4 + 2] = v[2]; tile[kr * 65 + c4 + 3] = v[3]; }
        __syncthreads();
        { const int n = tid >> 3, k8 = (tid & 7) * 8; u32x4v w;
          w.x = pg8::cvt_pk_bf16(tile[(k8 + 0) * 65 + n], tile[(k8 + 1) * 65 + n]); w.y = pg8::cvt_pk_bf16(tile[(k8 + 2) * 65 + n], tile[(k8 + 3) * 65 + n]);
          w.z = pg8::cvt_pk_bf16(tile[(k8 + 4) * 65 + n], tile[(k8 + 5) * 65 + n]); w.w = pg8::cvt_pk_bf16(tile[(k8 + 6) * 65 + n], tile[(k8 + 7) * 65 + n]);
          *(u32x4v*)(dst + (size_t)(n0 + n) * K + k0 + k8) = w; }
        __syncthreads();
    }
}

__device__ __forceinline__ void norm_phase(KPC kp, int l, int sub, int nkp) {
    const float* h = (const float*)(kp->ws + OFF_H); u16* uo = (u16*)(kp->ws + OFF_U);
    const float* g = kp->in[I_NORMG] + (size_t)(l * 3 + sub) * D; const float* modl = (const float*)(kp->ws + OFF_MOD) + (size_t)l * 5 * 9216;
    const int lane = ltid() & 63, wv = ltid() >> 6;
    for (int T = lbid() * 8 + wv; T < NTOK; T += gridDim.x * 8) {
        const float* hr = h + (size_t)T * D; f32x4 v[4]; float ss = 0.f;
        const int bT = T / TPB, tT = T - bT * TPB; const bool fold = nkp > 0 && tT < CTX;
#pragma unroll
        for (int i = 0; i < 4; ++i) { v[i] = *(const f32x4*)(hr + i * 256 + lane * 4);
            if (fold) { const float* pp = (const float*)kp->out + ((size_t)bT * CTX + tT) * D + i * 256 + lane * 4; for (int kc = 0; kc < nkp; ++kc) v[i] += *(const f32x4*)(pp + (size_t)kc * 1024 * D);
                *(f32x4*)((float*)(kp->ws + OFF_H) + (size_t)T * D + i * 256 + lane * 4) = v[i]; }
            ss += v[i][0] * v[i][0] + v[i][1] * v[i][1] + v[i][2] * v[i][2] + v[i][3] * v[i][3]; }
        ss = wave_sum(ss); const float rs = rsqrtf(ss * (1.0f / D) + 1e-6f);
        const float* mp = modl + (size_t)modrow_of_token(T) * 9216 + sub * 3 * 1024;
#pragma unroll
        for (int i = 0; i < 4; ++i) { const int c = i * 256 + lane * 4; const f32x4 gg = *(const f32x4*)(g + c), sh = *(const f32x4*)(mp + c), sc = *(const f32x4*)(mp + 1024 + c);
            const f32x4 o = v[i] * rs * gg * (sc + 1.0f) + sh; u32x2 w; w.x = pg8::cvt_pk_bf16(o[0], o[1]); w.y = pg8::cvt_pk_bf16(o[2], o[3]);
            *(u32x2*)(uo + (size_t)T * D + c) = w; }
    }
}

__device__ __forceinline__ void final_phase(KPC kp) {
    const float* h = (const float*)(kp->ws + OFF_H); const float* g = kp->in[I_FINALG];
    const int lane = ltid() & 63, wv = ltid() >> 6;
    for (int r = lbid() * 8 + wv; r < NB * SEQ; r += gridDim.x * 8) {
        const int b = r / SEQ, s = r - b * SEQ; const float* hr = h + ((size_t)b * TPB + CTX + s) * D; f32x4 v[4]; float ss = 0.f;
#pragma unroll
        for (int i = 0; i < 4; ++i) { v[i] = *(const f32x4*)(hr + i * 256 + lane * 4); ss += v[i][0] * v[i][0] + v[i][1] * v[i][1] + v[i][2] * v[i][2] + v[i][3] * v[i][3]; }
        ss = wave_sum(ss); const float rs = rsqrtf(ss * (1.0f / D) + 1e-6f);
#pragma unroll
        for (int i = 0; i < 4; ++i) { const int c = i * 256 + lane * 4; *(f32x4*)(kp->out + (size_t)r * D + c) = v[i] * rs * *(const f32x4*)(g + c); }
    }
}

__device__ __forceinline__ void setup_phase(KPC kp, LAS float* ldsf) {
    float* h = (float*)(kp->ws + OFF_H); const int tid = ltid();
    const int hb0 = gridDim.x > 64 ? 32 : 0;
    for (size_t i = (size_t)(lbid() - hb0) * 512 + tid; lbid() >= hb0 && i < (size_t)NTOK * 256; i += (size_t)(gridDim.x - hb0) * 512) {
        const int T = (int)(i >> 8), c = ((int)i & 255) * 4, b = T / TPB, t = T - b * TPB; f32x4 v;
        if (t < CTX) v = *(const f32x4*)(kp->in[I_CTX] + ((size_t)b * CTX + t) * D + c);
        else { const int s = t - CTX; v = *(const f32x4*)(kp->in[I_X] + ((size_t)b * SEQ + s) * D + c);
            const int half = c >> 9, cc = c & 511, isc = cc >> 8, i0 = cc & 255; const float pv = half ? (float)(s & 63) : (float)(s >> 6);
#pragma unroll
            for (int e = 0; e < 4; ++e) { const float om = exp2f(-13.287712379549449f * (float)(i0 + e) * (1.0f / 256.0f)); const float ang = pv * om; v[e] += isc ? __cosf(ang) : __sinf(ang); } }
        *(f32x4*)(h + (size_t)T * D + c) = v;
    }
    LAS float* sc = ldsf; LAS float* red = ldsf + 5 * 1024;
    for (int i = tid; i < 5 * 1024; i += 512) { const int r = i >> 10, k = i & 1023; const float cv = r < 4 ? kp->in[I_C][r * D + k] : kp->in[I_CCTX][k]; sc[i] = siluf(cv); }
    __syncthreads();
    float* mod = (float*)(kp->ws + OFF_MOD); const int lane = tid & 63, wv = tid >> 6;
    for (int task = lbid(); task < 288; task += gridDim.x) {
        const int l = task / 72, n0 = (task % 72) * 128 + lane * 2; const float* w = kp->in[I_ADAW] + (size_t)l * D * 9216 + n0;
        f32x2 a[5];
#pragma unroll
        for (int r = 0; r < 5; ++r) a[r] = (f32x2){0.f, 0.f};
#pragma unroll 16
        for (int k = wv * 128; k < wv * 128 + 128; ++k) { const f32x2 wv2 = *(const f32x2*)(w + (size_t)k * 9216);
#pragma unroll
            for (int r = 0; r < 5; ++r) a[r] += wv2 * sc[r * 1024 + k]; }
#pragma unroll
        for (int r = 0; r < 5; ++r) { red[(wv * 5 + r) * 128 + lane * 2] = a[r][0]; red[(wv * 5 + r) * 128 + lane * 2 + 1] = a[r][1]; }
        __syncthreads();
        for (int i = tid; i < 640; i += 512) { const int r = i >> 7, n = i & 127; float s = 0.f;
#pragma unroll
            for (int w8 = 0; w8 < 8; ++w8) s += red[(w8 * 5 + r) * 128 + n];
            const int nn = (task % 72) * 128 + n; mod[((size_t)l * 5 + r) * 9216 + nn] = s + kp->in[I_ADAB][(size_t)l * 9216 + nn]; }
        __syncthreads();
    }
}

__device__ __forceinline__ void convert_layer(KPC kp, int l, LAS float* tile) {
    unsigned char* wb = kp->ws + OFF_WB; int tctr = 0; const int j = l >> 1;
    for (int f = 0; f < 2; ++f) {
        convert_T(kp->in[I_FFNIN] + (size_t)(l * 2 + f) * D * 2 * FF, 2 * FF, D, 2 * FF, 1, (u16*)(wb + (f ? WB_FIN1 : WB_FIN0)), tile, tctr);
        convert_T(kp->in[I_FFNOUT] + (size_t)(l * 2 + f) * FF * D, D, FF, D, 0, (u16*)(wb + (f ? WB_FOUT1 : WB_FOUT0)), tile, tctr);
    }
    if ((l & 1) == 0) {
        convert_T(kp->in[I_HYWIN] + (size_t)j * D * 3 * D, 3 * D, D, 3 * D, 0, (u16*)(wb + WB_MIN), tile, tctr);
        convert_T(kp->in[I_HYWOUT] + (size_t)j * D * D, D, D, D, 0, (u16*)(wb + WB_MOUT), tile, tctr);
    } else {
        convert_T(kp->in[I_MLUP] + (size_t)j * D * 2 * INNER, 2 * INNER, D, 2 * INNER, 0, (u16*)(wb + WB_MIN), tile, tctr);
        convert_T(kp->in[I_MLDOWN] + (size_t)j * INNER * D, D, INNER, D, 0, (u16*)(wb + WB_MOUT), tile, tctr);
        u16* wg = (u16*)(wb + WB_WGT); const float* src = kp->in[I_MLWG] + (size_t)j * 3 * INNER * 16;
        for (int i = lbid() * 512 + ltid(); i < 16 * 3 * INNER; i += gridDim.x * 512) { const int o = i / (3 * INNER), k = i - o * 3 * INNER; wg[i] = f2bf(src[(size_t)k * 16 + o]); }
        float* gates = (float*)(kp->ws + OFF_GATES); const float* bg = kp->in[I_MLBG] + j * 16;
        for (int i = lbid() * 512 + ltid(); i < NTOK * 16; i += gridDim.x * 512) gates[i] = bg[i & 15];
    }
}

constexpr size_t HY_PL = 0, HY_PC = (size_t)NB * 3072 * SEQ * 2, HY_YL = HY_PC + (size_t)NB * 3072 * CTX * 2, HY_YC = HY_YL + (size_t)NB * D * SEQ * 2;
__device__ __forceinline__ int fphys(int i) { return i ^ ((((i >> 6) & 1) * 21) ^ (((i >> 5) & 1) * 10)); }
__device__ __forceinline__ f32x2 cmul(f32x2 a, f32x2 b) { return (f32x2){a.x * b.x - a.y * b.y, a.x * b.y + a.y * b.x}; }
__device__ __forceinline__ f32x2 cmulc(f32x2 a, f32x2 b) { return (f32x2){a.x * b.x + a.y * b.y, a.y * b.x - a.x * b.y}; }
__device__ __forceinline__ int drev(int x) { const unsigned r = __brev((unsigned)x) >> 18; return (int)(((r & 0x2AAAu) >> 1) | ((r & 0x1555u) << 1)); }

__device__ __forceinline__ void fidx4(int base, int lm, int (&ix)[4]) {
    const int m = 1 << lm;
    if (lm == 6) { const int i0 = fphys(base); ix[0] = i0; ix[1] = (i0 + 64) ^ 21; ix[2] = i0 + 128; ix[3] = (i0 + 192) ^ 21; }
    else if (lm == 4) { const int c6 = ((base >> 6) & 1) * 21; ix[0] = base ^ c6; ix[1] = (base + 16) ^ c6; ix[2] = (base + 32) ^ c6 ^ 10; ix[3] = (base + 48) ^ c6 ^ 10; }
    else { const int c = (((base >> 6) & 1) * 21) ^ (((base >> 5) & 1) * 10); ix[0] = base ^ c; ix[1] = (base + m) ^ c; ix[2] = (base + 2 * m) ^ c; ix[3] = (base + 3 * m) ^ c; }
}
__device__ __forceinline__ void fft_fwd(LAS f32x2* buf, const f32x2* Kmul = nullptr) {
    const int tid = ltid();
    for (int lm = 12; lm >= 0; lm -= 2) {
        const int m = 1 << lm; const float inv = 1.0f / (float)(4 << lm);
        f32x2 a[8][4]; int ix[8][4];
#pragma unroll
        for (int i = 0; i < 8; ++i) { const int g = tid + 512 * i, p = g & (m - 1), base = ((g >> lm) << (lm + 2)) + p; fidx4(base, lm, ix[i]);
#pragma unroll
            for (int r = 0; r < 4; ++r) a[i][r] = buf[ix[i][r]]; }
#pragma unroll
        for (int i = 0; i < 8; ++i) { const int p = (tid + 512 * i) & (m - 1);
            const f32x2 t0 = a[i][0] + a[i][2], t1 = a[i][0] - a[i][2], t2 = a[i][1] + a[i][3], dd = a[i][1] - a[i][3], t3 = (f32x2){dd.y, -dd.x};
            if (lm == 0) {
                f32x2 y0 = t0 + t2, y1 = t1 + t3, y2 = t0 - t2, y3 = t1 - t3;
                if (Kmul) { const f32x4 ka = *(const f32x4*)(Kmul + 4 * (tid + 512 * i)), kb = *(const f32x4*)(Kmul + 4 * (tid + 512 * i) + 2);
                    y0 = cmul(y0, (f32x2){ka[0], ka[1]}); y1 = cmul(y1, (f32x2){ka[2], ka[3]}); y2 = cmul(y2, (f32x2){kb[0], kb[1]}); y3 = cmul(y3, (f32x2){kb[2], kb[3]}); }
                buf[ix[i][0]] = y0; buf[ix[i][1]] = y1; buf[ix[i][2]] = y2; buf[ix[i][3]] = y3; }
            else { const float rev = (float)p * inv;
                const f32x2 w1 = (f32x2){__builtin_amdgcn_cosf(rev), -__builtin_amdgcn_sinf(rev)}, w2 = cmul(w1, w1), w3 = cmul(w2, w1);
                buf[ix[i][0]] = t0 + t2; buf[ix[i][1]] = cmul(t1 + t3, w1); buf[ix[i][2]] = cmul(t0 - t2, w2); buf[ix[i][3]] = cmul(t1 - t3, w3); } }
        __syncthreads();
    }
}
__device__ __forceinline__ void fft_inv(LAS f32x2* buf) {
    const int tid = ltid();
    for (int lm = 0; lm <= 12; lm += 2) {
        const int m = 1 << lm; const float inv = 1.0f / (float)(4 << lm);
        f32x2 a[8][4]; int ix[8][4];
#pragma unroll
        for (int i = 0; i < 8; ++i) { const int g = tid + 512 * i, p = g & (m - 1), base = ((g >> lm) << (lm + 2)) + p; fidx4(base, lm, ix[i]);
#pragma unroll
            for (int r = 0; r < 4; ++r) a[i][r] = buf[ix[i][r]]; }
#pragma unroll
        for (int i = 0; i < 8; ++i) { const int p = (tid + 512 * i) & (m - 1);
            f32x2 b0 = a[i][0], b1 = a[i][1], b2 = a[i][2], b3 = a[i][3];
            if (lm != 0) { const float rev = (float)p * inv;
                const f32x2 w1 = (f32x2){__builtin_amdgcn_cosf(rev), -__builtin_amdgcn_sinf(rev)}, w2 = cmul(w1, w1), w3 = cmul(w2, w1);
                b1 = cmulc(b1, w1); b2 = cmulc(b2, w2); b3 = cmulc(b3, w3); }
            const f32x2 s0 = b0 + b2, s1 = b0 - b2, s2 = b1 + b3, dd = b1 - b3, s3 = (f32x2){-dd.y, dd.x};
            buf[ix[i][0]] = s0 + s2; buf[ix[i][1]] = s1 + s3; buf[ix[i][2]] = s0 - s2; buf[ix[i][3]] = s1 - s3; }
        __syncthreads();
    }
}

__device__ __forceinline__ void hy_mlp_phase(KPC kp, int j) {
    float* h2 = (float*)(kp->ws + OFF_H2);
    const float* w1 = kp->in[I_HYW1] + j * 33 * 64; const float* b1 = kp->in[I_HYB1] + j * 64; const float* w2 = kp->in[I_HYW2] + j * 64 * 64; const float* b2 = kp->in[I_HYB2] + j * 64;
    const float* fr = kp->in[I_HYFREQ] + j * 128; const int lane = ltid() & 63, wv = ltid() >> 6;
    for (int pos = lbid() * 8 + wv; pos < SEQ + CTX; pos += gridDim.x * 8) {
        const int n = pos < SEQ ? SEQ : CTX, t = pos < SEQ ? pos : pos - SEQ; const float tn = (float)t / (float)(n - 1);
        float feat = 0.f;
        if (lane == 0) feat = tn;
        else if (lane < 33) { const int bi = (lane - 1) & 15; const float band = 1e-4f + (float)bi * ((15.0f - 1e-4f) / 15.0f); float rev = ((float)t / (float)n) * band; rev -= floorf(rev);
            const float ang = 6.283185307179586f * rev; feat = lane < 17 ? cosf(ang) : -sinf(ang); }
        float z = b1[lane];
        for (int i = 0; i < 33; ++i) z += lshfl(feat, i) * w1[i * 64 + lane];
        const float h1 = sinf(fr[lane] * z);
        float z2 = b2[lane];
        for (int v = 0; v < 64; ++v) z2 += lshfl(h1, v) * w2[v * 64 + lane];
        h2[(size_t)pos * 64 + lane] = sinf(fr[64 + lane] * z2);
    }
}

__device__ __forceinline__ void block_sum2(float& a, float& b, LAS float* red) {
    a = wave_sum(a); b = wave_sum(b); const int lane = ltid() & 63, wv = ltid() >> 6;
    __syncthreads(); if (lane == 0) { red[wv] = a; red[8 + wv] = b; } __syncthreads();
    float sa = 0.f, sb = 0.f;
#pragma unroll
    for (int i = 0; i < 8; ++i) { sa += red[i]; sb += red[8 + i]; }
    a = sa; b = sb;
}

__device__ __forceinline__ void hy_filter_task(KPC kp, int j, int task, LAS f32x2* buf, LAS float* aux) {
    const int tid = ltid(), d = task & 1023; const bool lat = task < 1024;
    const float* w3 = kp->in[I_HYW3] + (size_t)j * 64 * 4096; const float* b3 = kp->in[I_HYB3] + j * 4096; const float* ldc = kp->in[I_HYDECAY] + j * 4096;
    __syncthreads();
    if (tid < 256) aux[tid] = w3[(size_t)(tid & 63) * 4096 + (tid >> 6) * 1024 + d];
    if (tid < 4) { aux[256 + tid] = b3[tid * 1024 + d]; aux[260 + tid] = __expf(ldc[tid * 1024 + d]); }
    __syncthreads();
    const float* h2 = (const float*)(kp->ws + OFF_H2);
    float ss0 = 0.f, ss1 = 0.f;
    if (lat) {
        for (int r = 0; r < 16; ++r) { const int i = tid + 512 * r; float a0 = aux[256], a1 = aux[257], a2 = aux[258], a3 = aux[259];
#pragma unroll 4
            for (int u4 = 0; u4 < 16; ++u4) { const f32x4 hv = *(const f32x4*)(h2 + (size_t)i * 64 + u4 * 4);
                const f32x4 q0 = *(const LAS f32x4*)(aux + u4 * 4), q1 = *(const LAS f32x4*)(aux + 64 + u4 * 4), q2 = *(const LAS f32x4*)(aux + 128 + u4 * 4), q3 = *(const LAS f32x4*)(aux + 192 + u4 * 4);
#pragma unroll
                for (int e = 0; e < 4; ++e) { a0 += hv[e] * q0[e]; a1 += hv[e] * q1[e]; a2 += hv[e] * q2[e]; a3 += hv[e] * q3[e]; } }
            const float tn = (float)i * (1.0f / 8191.0f);
            a0 *= __expf(-tn * aux[260]); a1 *= __expf(-tn * aux[261]); a2 *= __expf(-tn * aux[262]); a3 *= __expf(-tn * aux[263]);
            buf[fphys(i)] = (f32x2){a0, a2}; ss0 += a0 * a0; ss1 += a2 * a2;
            if (i >= 1) { buf[fphys(NFFT - i)] = (f32x2){a1, a3}; ss0 += a1 * a1; ss1 += a3 * a3; } }
        if (tid == 0) buf[fphys(SEQ)] = (f32x2){0.f, 0.f};
        block_sum2(ss0, ss1, aux + 272);
        const f32x2 scl = (f32x2){rsqrtf(ss0 + 1e-12f) * (1.0f / NFFT), rsqrtf(ss1 + 1e-12f) * (1.0f / NFFT)};
        for (int r = 0; r < 32; ++r) { const int q = fphys(tid + 512 * r); buf[q] = buf[q] * scl; }
        __syncthreads();
        fft_fwd(buf);
        f32x2* K0 = (f32x2*)(kp->ws + OFF_R2) + (size_t)d * NFFT; f32x2* K1 = (f32x2*)kp->out + (size_t)d * NFFT;
        for (int r = 0; r < 32; ++r) { const int pos = tid + 512 * r, k = drev(pos), pos2 = drev((NFFT - k) & (NFFT - 1)); const f32x2 Z = buf[fphys(pos)], Z2 = buf[fphys(pos2)];
            K0[pos] = (f32x2){0.5f * (Z.x + Z2.x), 0.5f * (Z.y - Z2.y)}; K1[pos] = (f32x2){0.5f * (Z.y + Z2.y), -0.5f * (Z.x - Z2.x)}; }
    } else {
        const int idx = tid; float a0 = 0.f, a1 = 0.f;
        if (idx != CTX) { const int t = idx < CTX ? idx : 2 * CTX - idx, dir = idx < CTX ? 0 : 1; a0 = aux[256 + dir]; a1 = aux[258 + dir];
            for (int u4 = 0; u4 < 16; ++u4) { const f32x4 hv = *(const f32x4*)(h2 + (size_t)(SEQ + t) * 64 + u4 * 4);
#pragma unroll
                for (int e = 0; e < 4; ++e) { const int u = u4 * 4 + e; a0 += hv[e] * aux[dir * 64 + u]; a1 += hv[e] * aux[128 + dir * 64 + u]; } }
            const float tn = (float)t * (1.0f / 255.0f); a0 *= __expf(-tn * aux[260 + dir]); a1 *= __expf(-tn * aux[262 + dir]); }
        ss0 = a0 * a0; ss1 = a1 * a1;
        block_sum2(ss0, ss1, aux + 272);
        float* kc = (float*)(kp->ws + OFF_KCTX);
        kc[(size_t)d * 512 + idx] = a0 * rsqrtf(ss0 + 1e-12f); kc[(size_t)(1024 + d) * 512 + idx] = a1 * rsqrtf(ss1 + 1e-12f);
    }
}

__device__ __forceinline__ float ld3(const u16* row, int t, int n, float wa, float wb, float wc, float bias) {
    const float xm = t > 0 ? bf2f(row[t - 1]) : 0.f, x0 = bf2f(row[t]), xp = t < n - 1 ? bf2f(row[t + 1]) : 0.f; return wa * xm + wb * x0 + wc * xp + bias; }

__device__ __forceinline__ void ld3x8(const u16* row, int t0, float wa, float wb, float wc, float bias, float (&o)[8]) {
    const u32x4v w = *(const u32x4v*)(row + t0);
    const float x0 = bflo(w.x), x1 = bfhi(w.x), x2 = bflo(w.y), x3 = bfhi(w.y), x4 = bflo(w.z), x5 = bfhi(w.z), x6 = bflo(w.w), x7 = bfhi(w.w);
    const float xl = t0 > 0 ? bf2f(row[t0 - 1]) : 0.f, xr = t0 + 8 < SEQ ? bf2f(row[t0 + 8]) : 0.f;
    o[0] = wa * xl + wb * x0 + wc * x1 + bias; o[1] = wa * x0 + wb * x1 + wc * x2 + bias; o[2] = wa * x1 + wb * x2 + wc * x3 + bias; o[3] = wa * x2 + wb * x3 + wc * x4 + bias;
    o[4] = wa * x3 + wb * x4 + wc * x5 + bias; o[5] = wa * x4 + wb * x5 + wc * x6 + bias; o[6] = wa * x5 + wb * x6 + wc * x7 + bias; o[7] = wa * x6 + wb * x7 + wc * xr + bias;
}
__device__ __forceinline__ void hy_conv_lat(KPC kp, int j, int task, LAS f32x2* buf) {
    const int tid = ltid(), bp = task >> 10, c = task & 1023, b0 = bp * 2;
    const u16* pl = (const u16*)(kp->ws + OFF_R1 + HY_PL); u16* yl = (u16*)(kp->ws + OFF_R1 + HY_YL);
    const float* cw = kp->in[I_HYCW] + (size_t)j * 3 * 3072; const float* cb = kp->in[I_HYCB] + j * 3072;
    const float w1a = cw[c], w1b = cw[3072 + c], w1c = cw[6144 + c], bb1 = cb[c];
    const float w2a = cw[1024 + c], w2b = cw[3072 + 1024 + c], w2c = cw[6144 + 1024 + c], bb2 = cb[1024 + c];
    const float w3a = cw[2048 + c], w3b = cw[3072 + 2048 + c], w3c = cw[6144 + 2048 + c], bb3 = cb[2048 + c];
    const float sk0 = kp->in[I_HYSKIP][j * 2048 + c], sk1 = kp->in[I_HYSKIP][j * 2048 + 1024 + c];
    const u16* x1r0 = pl + ((size_t)b0 * 3072 + c) * SEQ; const u16* x1r1 = x1r0 + (size_t)3072 * SEQ;
    const u16* x2r0 = x1r0 + (size_t)1024 * SEQ; const u16* x2r1 = x1r1 + (size_t)1024 * SEQ;
    const u16* vr0 = x1r0 + (size_t)2048 * SEQ; const u16* vr1 = x1r1 + (size_t)2048 * SEQ;
    const f32x2* K0 = (const f32x2*)(kp->ws + OFF_R2) + (size_t)c * NFFT; const f32x2* K1 = (const f32x2*)kp->out + (size_t)c * NFFT;
    __syncthreads();
#pragma unroll
    for (int g = 0; g < 2; ++g) { const int t0 = 8 * (tid + 512 * g); float v0[8], v1[8];
        ld3x8(vr0, t0, w3a, w3b, w3c, bb3, v0); ld3x8(vr1, t0, w3a, w3b, w3c, bb3, v1);
#pragma unroll
        for (int e = 0; e < 8; ++e) { buf[fphys(t0 + e)] = (f32x2){v0[e], v1[e]}; buf[fphys(SEQ + t0 + e)] = (f32x2){0.f, 0.f}; } }
    __syncthreads();
#ifdef PROBE_FFT
    for (int rp = 0; rp < PROBE_FFT; ++rp) { fft_fwd(buf); fft_inv(buf); for (int r = 0; r < 32; ++r) { const int q = fphys(tid + 512 * r); buf[q] = buf[q] * (1.0f / NFFT); } __syncthreads(); }
#endif
    fft_fwd(buf, K0);
    fft_inv(buf);
    float zr[32];
#pragma unroll
    for (int g = 0; g < 2; ++g) { const int t0 = 8 * (tid + 512 * g); float v0[8], v1[8], xa[8], xb[8];
        ld3x8(vr0, t0, w3a, w3b, w3c, bb3, v0); ld3x8(vr1, t0, w3a, w3b, w3c, bb3, v1); ld3x8(x1r0, t0, w1a, w1b, w1c, bb1, xa); ld3x8(x1r1, t0, w1a, w1b, w1c, bb1, xb);
#pragma unroll
        for (int e = 0; e < 8; ++e) { const f32x2 y = buf[fphys(t0 + e)]; const float z0 = xa[e] * (y.x + sk0 * v0[e]), z1 = xb[e] * (y.y + sk0 * v1[e]);
            zr[g * 16 + 2 * e] = z0; zr[g * 16 + 2 * e + 1] = z1; buf[fphys(t0 + e)] = (f32x2){z0, z1}; buf[fphys(SEQ + t0 + e)] = (f32x2){0.f, 0.f}; } }
    __syncthreads();
    fft_fwd(buf, K1);
    fft_inv(buf);
#pragma unroll
    for (int g = 0; g < 2; ++g) { const int t0 = 8 * (tid + 512 * g); float xa[8], xb[8], o0[8], o1[8];
        ld3x8(x2r0, t0, w2a, w2b, w2c, bb2, xa); ld3x8(x2r1, t0, w2a, w2b, w2c, bb2, xb);
#pragma unroll
        for (int e = 0; e < 8; ++e) { const f32x2 y = buf[fphys(t0 + e)]; o0[e] = xa[e] * (y.x + sk1 * zr[g * 16 + 2 * e]); o1[e] = xb[e] * (y.y + sk1 * zr[g * 16 + 2 * e + 1]); }
        *(u32x4v*)(yl + ((size_t)b0 * D + c) * SEQ + t0) = pack8(o0); *(u32x4v*)(yl + ((size_t)(b0 + 1) * D + c) * SEQ + t0) = pack8(o1); }
}

__device__ __forceinline__ void hy_conv_ctx(KPC kp, int j, int c, LAS float* ls) {
    const int tid = ltid();
    const u16* pc = (const u16*)(kp->ws + OFF_R1 + HY_PC); u16* yc = (u16*)(kp->ws + OFF_R1 + HY_YC); const float* kc = (const float*)(kp->ws + OFF_KCTX);
    const float* cw = kp->in[I_HYCW] + (size_t)j * 3 * 3072; const float* cb = kp->in[I_HYCB] + j * 3072;
    const float w1a = cw[c], w1b = cw[3072 + c], w1c = cw[6144 + c], bb1 = cb[c];
    const float w2a = cw[1024 + c], w2b = cw[3072 + 1024 + c], w2c = cw[6144 + 1024 + c], bb2 = cb[1024 + c];
    const float w3a = cw[2048 + c], w3b = cw[3072 + 2048 + c], w3c = cw[6144 + 2048 + c], bb3 = cb[2048 + c];
    const float sk0 = kp->in[I_HYSKIP][j * 2048 + c], sk1 = kp->in[I_HYSKIP][j * 2048 + 1024 + c];
    __syncthreads();
    ls[tid] = kc[(size_t)c * 512 + tid]; ls[512 + tid] = kc[(size_t)(1024 + c) * 512 + tid];
    for (int i = 0; i < 2; ++i) { const int e = tid + 512 * i, b = e >> 8, t = e & 255; ls[1024 + e] = ld3(pc + ((size_t)b * 3072 + 2048 + c) * CTX, t, CTX, w3a, w3b, w3c, bb3); }
    __syncthreads();
    const int cb_ = tid >> 6, t0 = (tid & 63) * 4; const bool act = tid < 256;
    auto conv4 = [&](int kofs, int xofs, float (&acc)[4]) {
        float w[7];
#pragma unroll
        for (int i = 0; i < 7; ++i) w[i] = ls[kofs + ((t0 + 3 - i) & 511)];
        acc[0] = acc[1] = acc[2] = acc[3] = 0.f;
        for (int s = 0; s < CTX; s += 4) { const f32x4 v4 = *(const LAS f32x4*)(ls + xofs + cb_ * 256 + s);
#pragma unroll
            for (int cc = 0; cc < 4; ++cc)
#pragma unroll
                for (int a = 0; a < 4; ++a) acc[a] += w[3 - a + cc] * v4[cc];
            w[0] = w[4]; w[1] = w[5]; w[2] = w[6];
#pragma unroll
            for (int i = 3; i < 7; ++i) w[i] = ls[kofs + ((t0 + 3 - (s + 4) - i) & 511)]; } };
    float zr[4] = {0.f, 0.f, 0.f, 0.f};
    if (act) { float acc[4]; conv4(0, 1024, acc);
#pragma unroll
        for (int a = 0; a < 4; ++a) zr[a] = ld3(pc + ((size_t)cb_ * 3072 + c) * CTX, t0 + a, CTX, w1a, w1b, w1c, bb1) * (acc[a] + sk0 * ls[1024 + cb_ * 256 + t0 + a]);
        *(LAS f32x4*)(ls + 2048 + cb_ * 256 + t0) = (f32x4){zr[0], zr[1], zr[2], zr[3]}; }
    __syncthreads();
    if (act) { float acc[4]; conv4(512, 2048, acc); float o[4];
#pragma unroll
        for (int a = 0; a < 4; ++a) o[a] = ld3(pc + ((size_t)cb_ * 3072 + 1024 + c) * CTX, t0 + a, CTX, w2a, w2b, w2c, bb2) * (acc[a] + sk1 * zr[a]);
        u32x2 w; w.x = pg8::cvt_pk_bf16(o[0], o[1]); w.y = pg8::cvt_pk_bf16(o[2], o[3]); *(u32x2*)(yc + ((size_t)cb_ * D + c) * CTX + t0) = w; }
}

__device__ __forceinline__ void hy_transpose(KPC kp, LAS u16* tl) {
    const u16* yl = (const u16*)(kp->ws + OFF_R1 + HY_YL); const u16* yc = (const u16*)(kp->ws + OFF_R1 + HY_YC); u16* y = (u16*)(kp->ws + OFF_U); const int tid = ltid();
    for (int tile = lbid(); tile < NB * 16 * NCH; tile += gridDim.x) {
        const int b = tile / (16 * NCH), rem = tile - b * 16 * NCH, ct = rem / NCH, tt = rem - ct * NCH;
        const u16* src = tt < 4 ? yc + ((size_t)b * D + ct * 64) * CTX + tt * 64 : yl + ((size_t)b * D + ct * 64) * SEQ + (tt - 4) * 64; const int ld = tt < 4 ? CTX : SEQ;
        { const int cr = tid >> 3, t8 = (tid & 7) * 8; *(LAS u32x4v*)(tl + cr * 72 + t8) = *(const u32x4v*)(src + (size_t)cr * ld + t8); }
        __syncthreads();
        { const int tr = tid >> 3, c8 = (tid & 7) * 8; u32x4v w;
          w.x = (unsigned)tl[(c8 + 0) * 72 + tr] | ((unsigned)tl[(c8 + 1) * 72 + tr] << 16); w.y = (unsigned)tl[(c8 + 2) * 72 + tr] | ((unsigned)tl[(c8 + 3) * 72 + tr] << 16);
          w.z = (unsigned)tl[(c8 + 4) * 72 + tr] | ((unsigned)tl[(c8 + 5) * 72 + tr] << 16); w.w = (unsigned)tl[(c8 + 6) * 72 + tr] | ((unsigned)tl[(c8 + 7) * 72 + tr] << 16);
          *(u32x4v*)(y + ((size_t)b * TPB + tt * 64 + tr) * D + ct * 64 + c8) = w; }
        __syncthreads();
    }
}

constexpr size_t OFF_XM = OFF_R1, OFF_XC = OFF_R1 + 132 * MiB, OFF_S = WS_NEED, OFF_MLM = OFF_S + 34 * MiB, WS_NEED2 = OFF_MLM + 1 * MiB;
__device__ __forceinline__ u16* hb_ptr(KPC kp, int T) { const int b = T / TPB, t = T - b * TPB;
    return t < CTX ? (u16*)(kp->ws + OFF_HBC) + ((size_t)b * CTX + t) * INNER : (u16*)kp->out + ((size_t)b * SEQ + (t - CTX)) * INNER; }
__device__ __forceinline__ void bd8(const float (&x)[8], const float (&w)[32], float (&y)[8]) {
#pragma unroll
    for (int bl = 0; bl < 2; ++bl)
#pragma unroll
        for (int e = 0; e < 4; ++e) { float s = 0.f;
#pragma unroll
            for (int d = 0; d < 4; ++d) s += x[bl * 4 + d] * w[bl * 16 + d * 4 + e];
            y[bl * 4 + e] = s; }
}
typedef float f32x8s __attribute__((ext_vector_type(8)));
__device__ __forceinline__ void sload32(const float* p, float (&w)[32]) {
    f32x8s a, b, c, d;
    asm volatile("s_load_dwordx8 %0, %4, 0x0\n\ts_load_dwordx8 %1, %4, 0x20\n\ts_load_dwordx8 %2, %4, 0x40\n\ts_load_dwordx8 %3, %4, 0x60\n\ts_waitcnt lgkmcnt(0)"
                 : "=&s"(a), "=&s"(b), "=&s"(c), "=&s"(d) : "s"(p) : "memory");
#pragma unroll
    for (int i = 0; i < 8; ++i) { w[i] = a[i]; w[8 + i] = b[i]; w[16 + i] = c[i]; w[24 + i] = d[i]; }
}
__device__ __forceinline__ void ldw32(const float* p, float (&w)[32]) {
#pragma unroll
    for (int i = 0; i < 8; ++i) { const f32x4 v = *(const f32x4*)(p + i * 4); w[i * 4] = v[0]; w[i * 4 + 1] = v[1]; w[i * 4 + 2] = v[2]; w[i * 4 + 3] = v[3]; } }

__device__ __forceinline__ void ml_m_phase(KPC kp, int j) {
    float* M = (float*)(kp->ws + OFF_MLM) + (size_t)j * 8192;
    const float* wq = kp->in[I_MLWQ] + (size_t)j * 512 * 16; const float* wk = kp->in[I_MLWK] + (size_t)j * 512 * 16;
    for (int i = lbid() * 512 + ltid(); i < 512 * 16; i += gridDim.x * 512) { const int blk = i >> 4, d = (i >> 2) & 3, d2 = i & 3; float s = 0.f;
#pragma unroll
        for (int e = 0; e < 4; ++e) s += wq[blk * 16 + d * 4 + e] * wk[blk * 16 + d2 * 4 + e];
        M[i] = s * 0.04419417382415922f; }
}

__device__ __forceinline__ void ml_prep_task(KPC kp, int j, int task, LAS unsigned char* lds) {
    const int tid = ltid(), lane = tid & 63, wv = tid >> 6, fr = lane & 15, fq = lane >> 4;
    const int hd = task & 3, bc = task >> 2, b = bc / NCH, ci = bc - b * NCH;
    const u16* xm = (const u16*)(kp->ws + OFF_XM); u16* xc = (u16*)(kp->ws + OFF_XC);
    const int T0 = b * TPB + ci * 64, tlo = b * TPB + (ci < 4 ? 0 : CTX), thi = b * TPB + (ci < 4 ? CTX - 1 : TPB - 1);
    const int ch0 = hd * DH + lane * 8;
    LAS u16* QS = (LAS u16*)lds; LAS u16* KS = (LAS u16*)(lds + 66560);
    const float* cw = kp->in[I_MLCW] + (size_t)j * 3 * INNER; const float* cb = kp->in[I_MLCB] + (size_t)j * INNER;
    __syncthreads();
    {
        float cwa[8], cwb[8], cwc[8], cbb[8], wq[32], wk[32];
#pragma unroll
        for (int e4 = 0; e4 < 2; ++e4) { const f32x4 va = *(const f32x4*)(cw + ch0 + 4 * e4), vb = *(const f32x4*)(cw + INNER + ch0 + 4 * e4), vc = *(const f32x4*)(cw + 2 * INNER + ch0 + 4 * e4), vd = *(const f32x4*)(cb + ch0 + 4 * e4);
#pragma unroll
            for (int e = 0; e < 4; ++e) { cwa[4 * e4 + e] = va[e]; cwb[4 * e4 + e] = vb[e]; cwc[4 * e4 + e] = vc[e]; cbb[4 * e4 + e] = vd[e]; } }
        ldw32(kp->in[I_MLWQ] + ((size_t)j * 512 + (ch0 >> 2)) * 16, wq); ldw32(kp->in[I_MLWK] + ((size_t)j * 512 + (ch0 >> 2)) * 16, wk);
        for (int r = 0; r < 8; ++r) { const int jj = wv + 8 * r, T = T0 + jj; const u16* p = xm + (size_t)T * INNER + ch0;
            float x0[8], xa[8], xb[8], xcv[8], q[8], k[8];
            unpack8(*(const u32x4v*)p, x0);
            if (T > tlo) unpack8(*(const u32x4v*)(p - INNER), xa); else {
#pragma unroll
                for (int e = 0; e < 8; ++e) xa[e] = 0.f; }
            if (T < thi) unpack8(*(const u32x4v*)(p + INNER), xb); else {
#pragma unroll
                for (int e = 0; e < 8; ++e) xb[e] = 0.f; }
#pragma unroll
            for (int e = 0; e < 8; ++e) xcv[e] = siluf(cwa[e] * xa[e] + cwb[e] * x0[e] + cwc[e] * xb[e] + cbb[e]);
            const u32x4v xw = pack8(xcv); *(u32x4v*)(xc + (size_t)T * INNER + ch0) = xw; unpack8(xw, xcv);
            bd8(xcv, wq, q); bd8(xcv, wk, k);
            *(LAS u32x4v*)(QS + jj * 520 + lane * 8) = pack8(q); *(LAS u32x4v*)(KS + jj * 520 + lane * 8) = pack8(k); }
    }
    __syncthreads();
    const u16* wg = (const u16*)(kp->ws + OFF_WB + WB_WGT);
    const int mt = wv & 3, kh = wv >> 2;
    { f32x4 s0 = {0.f, 0.f, 0.f, 0.f}, s1 = {0.f, 0.f, 0.f, 0.f}; const int nt0 = kh * 2;
      for (int ks = 0; ks < 16; ++ks) { const bf16x8 a = *(const LAS bf16x8*)(QS + (16 * mt + fr) * 520 + 32 * ks + 8 * fq);
          const bf16x8 b0 = *(const LAS bf16x8*)(KS + (16 * nt0 + fr) * 520 + 32 * ks + 8 * fq), b1 = *(const LAS bf16x8*)(KS + (16 * (nt0 + 1) + fr) * 520 + 32 * ks + 8 * fq);
          s0 = __builtin_amdgcn_mfma_f32_16x16x32_bf16(a, b0, s0, 0, 0, 0); s1 = __builtin_amdgcn_mfma_f32_16x16x32_bf16(a, b1, s1, 0, 0, 0); }
      float* S = (float*)(kp->ws + OFF_S) + ((size_t)(b * 4 + hd) * NCH + ci) * 4096;
#pragma unroll
      for (int r = 0; r < 4; ++r) { S[(16 * mt + 4 * fq + r) * 64 + 16 * nt0 + fr] = s0[r]; S[(16 * mt + 4 * fq + r) * 64 + 16 * (nt0 + 1) + fr] = s1[r]; } }
    f32x4 ga = {0.f, 0.f, 0.f, 0.f};
    for (int ks = kh * 8; ks < kh * 8 + 8; ++ks) { const int kk = hd * DH + 32 * ks + 8 * fq;
        const bf16x8 a = *(const LAS bf16x8*)(QS + (16 * mt + fr) * 520 + 32 * ks + 8 * fq), a2 = *(const LAS bf16x8*)(KS + (16 * mt + fr) * 520 + 32 * ks + 8 * fq);
        const bf16x8 bq = *(const bf16x8*)(wg + (size_t)fr * 6144 + kk), bk = *(const bf16x8*)(wg + (size_t)fr * 6144 + INNER + kk);
        ga = __builtin_amdgcn_mfma_f32_16x16x32_bf16(a, bq, ga, 0, 0, 0); ga = __builtin_amdgcn_mfma_f32_16x16x32_bf16(a2, bk, ga, 0, 0, 0); }
    __syncthreads();
    {
        float wvv[32]; ldw32(kp->in[I_MLWV] + ((size_t)j * 512 + (ch0 >> 2)) * 16, wvv);
        for (int r = 0; r < 8; ++r) { const int jj = wv + 8 * r, T = T0 + jj; float x0[8], v[8]; unpack8(*(const u32x4v*)(xm + (size_t)T * INNER + ch0), x0); bd8(x0, wvv, v);
            *(LAS u32x4v*)(QS + jj * 520 + lane * 8) = pack8(v); }
    }
    __syncthreads();
    for (int ks = kh * 8; ks < kh * 8 + 8; ++ks) { const int kk = hd * DH + 32 * ks + 8 * fq;
        const bf16x8 a = *(const LAS bf16x8*)(QS + (16 * mt + fr) * 520 + 32 * ks + 8 * fq); const bf16x8 bv = *(const bf16x8*)(wg + (size_t)fr * 6144 + 2 * INNER + kk);
        ga = __builtin_amdgcn_mfma_f32_16x16x32_bf16(a, bv, ga, 0, 0, 0); }
    float* gates = (float*)(kp->ws + OFF_GATES);
#pragma unroll
    for (int r = 0; r < 4; ++r) atomicAdd(gates + (size_t)(T0 + 16 * mt + 4 * fq + r) * 16 + fr, ga[r]);
}

__device__ __forceinline__ void tr_store8(LAS unsigned char* base, int d0, const unsigned (&w)[4], int lane) {
    const int odd = lane & 1, sp = lane & ~1;
#pragma unroll
    for (int i = 0; i < 4; ++i) { const unsigned pw = (unsigned)__builtin_amdgcn_update_dpp(0, (int)w[i], 0xB1, 0xF, 0xF, false);
        const unsigned ow = odd ? ((pw >> 16) | (w[i] & 0xffff0000u)) : ((w[i] & 0xffffu) | (pw << 16)); const int d = d0 + 2 * i + odd;
        *(LAS unsigned*)(base + d * 128 + ((((sp >> 3) ^ (d & 7)) << 4) | ((sp & 7) << 1))) = ow; }
}
#ifndef REP_STAGE
#define REP_STAGE 1
#define REP_STILDE 1
#define REP_MFMA 1
#endif
constexpr int SC_QS = 0, SC_KT = 66560, SC_VT = 132096, SC_ST = 140288, SC_XB = 148480, SC_VEC = 156672;
__device__ __forceinline__ void ml_scan_task(KPC kp, int j, int task, LAS unsigned char* lds) {
    const int tid = ltid(), lane = tid & 63, wv = tid >> 6, fr = lane & 15, fq = lane >> 4;
    const int es = task & 7, dir = (task >> 3) & 1, hd = (task >> 4) & 3, b = task >> 6;
    const u16* xm = (const u16*)(kp->ws + OFF_XM); const u16* xc = (const u16*)(kp->ws + OFF_XC); const float* gates = (const float*)(kp->ws + OFF_GATES);
    const float* Sg = (const float*)(kp->ws + OFF_S) + (size_t)(b * 4 + hd) * NCH * 4096;
    u16* hf = (u16*)(kp->ws + OFF_R2);
    LAS unsigned char* QS = lds + SC_QS; LAS unsigned char* KT = lds + SC_KT; LAS unsigned char* VT = lds + SC_VT; LAS unsigned char* ST = lds + SC_ST; LAS unsigned char* XB = lds + SC_XB;
    LAS float* rowterm = (LAS float*)(lds + SC_VEC); LAS float* colterm = rowterm + 64; LAS float* winter = rowterm + 128; LAS float* einv = rowterm + 192;
    LAS float* kws = rowterm + 256; LAS float* dinv = rowterm + 320; LAS float* nst = rowterm + 384; LAS float* scal = rowterm + 896;
    f32x4 C[16];
#pragma unroll
    for (int i = 0; i < 16; ++i) C[i] = (f32x4){0.f, 0.f, 0.f, 0.f};
    float m_st = 0.f;
    __syncthreads();
    nst[tid] = 0.f;
    float pg_ic = 0.f, pg_fp = 0.f;
    if (wv == 0) { const int tn = dir == 0 ? lane : CTX - 1 - lane; const int Tg = b * TPB + tn; pg_ic = gates[(size_t)Tg * 16 + dir * 8 + hd]; pg_fp = gates[(size_t)Tg * 16 + dir * 8 + 4 + hd]; }
    u32x4v pxc[8], pxv;
    { const int tn = dir == 0 ? lane : CTX - 1 - lane; const size_t Tn = (size_t)(b * TPB + tn) * INNER; const int w0 = __builtin_amdgcn_readfirstlane(wv);
#pragma unroll
      for (int r = 0; r < 8; ++r) pxc[r] = *(const u32x4v*)(xc + Tn + hd * DH + (w0 * 8 + r) * 8);
      pxv = *(const u32x4v*)(xm + Tn + hd * DH + es * 64 + w0 * 8); }
    for (int ci = 0; ci < NCH; ++ci) {
        __syncthreads();
        const int p0 = ci * 64;
        const int tid = ltid(), lane = tid & 63, wv = tid >> 6, fr = lane & 15, fq = lane >> 4;
        asm volatile("" ::: "memory");
        auto tok = [&](int jj) -> int { const int p = p0 + jj; const int t = dir == 0 ? p : (p < CTX ? CTX - 1 - p : TPB + CTX - 1 - p); return b * TPB + t; };
        float sv[8];
        { const int jj = tid >> 3, s8 = (tid & 7) * 8;
            if (dir == 0) { const float* sp = Sg + (size_t)ci * 4096 + jj * 64 + s8; const f32x4 v0 = *(const f32x4*)sp, v1 = *(const f32x4*)(sp + 4);
                sv[0] = v0[0]; sv[1] = v0[1]; sv[2] = v0[2]; sv[3] = v0[3]; sv[4] = v1[0]; sv[5] = v1[1]; sv[6] = v1[2]; sv[7] = v1[3]; }
            else { const int oc = ci < 4 ? 3 - ci : 135 - ci; const float* sp = Sg + (size_t)oc * 4096 + (63 - jj) * 64 + (56 - s8); const f32x4 v0 = *(const f32x4*)sp, v1 = *(const f32x4*)(sp + 4);
                sv[7] = v0[0]; sv[6] = v0[1]; sv[5] = v0[2]; sv[4] = v0[3]; sv[3] = v1[0]; sv[2] = v1[1]; sv[1] = v1[2]; sv[0] = v1[3]; }
        }
        const float g_ic = pg_ic, g_fp = pg_fp;
        if (wv == 0 && ci + 1 < NCH) { const int pn = p0 + 64 + lane; const int tn = dir == 0 ? pn : (pn < CTX ? CTX - 1 - pn : TPB + CTX - 1 - pn); const int Tg = b * TPB + tn;
            pg_ic = gates[(size_t)Tg * 16 + dir * 8 + hd]; pg_fp = gates[(size_t)Tg * 16 + dir * 8 + 4 + hd]; }
        for (int rpS = 0; rpS < REP_STAGE; ++rpS) {
        const int wvu = __builtin_amdgcn_readfirstlane(wv); const int Tl = tok(lane);
#pragma unroll
        for (int r = 0; r < 8; ++r) { const int g8 = wvu * 8 + r; float x[8], q[8], Mw[32];
            const u32x4v xw = pxc[r]; unpack8(xw, x);
            sload32((const float*)(kp->ws + OFF_MLM) + (size_t)j * 8192 + (size_t)(hd * 128 + g8 * 2) * 16, Mw); bd8(x, Mw, q);
            *(LAS u32x4v*)(QS + lane * 1040 + g8 * 16) = pack8(q);
            const unsigned wd[4] = {xw.x, xw.y, xw.z, xw.w}; tr_store8(KT, g8 * 8, wd, lane); }
        { const int g = wvu; const int chv = hd * DH + es * 64 + g * 8; float x[8], v[8], wvv[32];
            unpack8(pxv, x); sload32(kp->in[I_MLWV] + ((size_t)j * 512 + (chv >> 2)) * 16, wvv); bd8(x, wvv, v);
            { const u32x4v vw = pack8(v); const unsigned wd[4] = {vw.x, vw.y, vw.z, vw.w}; tr_store8(VT, g * 8, wd, lane); } }
        }
        if (wv == 0) {
            const float ic = g_ic, fp = g_fp;
            const float lf = fminf(fp, 0.f) - log1pf(__expf(-fabsf(fp)));
            float bb = lf;
#pragma unroll
            for (int o = 1; o < 64; o <<= 1) { const float t = lshfl(bb, lane - o); if (lane >= o) bb += t; }
            const float uu = ic - bb; float pm = uu;
#pragma unroll
            for (int o = 1; o < 64; o <<= 1) { const float t = lshfl(pm, lane - o); if (lane >= o) pm = fmaxf(pm, t); }
            const float a = bb + m_st, mj = fmaxf(a, bb + pm);
            rowterm[lane] = bb - mj; colterm[lane] = uu; winter[lane] = __expf(a - mj); einv[lane] = __expf(-mj);
            const float blast = lshfl(bb, 63), gs = blast - bb + ic, gmax = wave_max(gs), mnew = fmaxf(blast + m_st, gmax);
            kws[lane] = __expf(gs - mnew);
            if (lane == 0) { scal[0] = __expf(blast + m_st - mnew); scal[1] = mnew; }
        }
        __syncthreads();
        for (int rpT = 0; rpT < REP_STILDE; ++rpT) {
            const int jj = tid >> 3, sub = tid & 7, s8 = sub * 8;
            const float rt = rowterm[jj]; float rsum = 0.f;
            const f32x4 ct0 = *(const LAS f32x4*)(colterm + s8), ct1 = *(const LAS f32x4*)(colterm + s8 + 4); const float ctv[8] = {ct0[0], ct0[1], ct0[2], ct0[3], ct1[0], ct1[1], ct1[2], ct1[3]};
#pragma unroll
            for (int e = 0; e < 8; ++e) { const int s = s8 + e; const float w = s <= jj ? sv[e] * 0.04419417382415922f * __expf(rt + ctv[e]) : 0.f; sv[e] = w; rsum += w; }
            *(LAS u32x4v*)(ST + jj * 128 + ((sub ^ (jj & 7)) << 4)) = pack8(sv);
            float qd = 0.f;
#pragma unroll
            for (int c8 = 0; c8 < 8; ++c8) { float qv[8]; unpack8(*(const LAS u32x4v*)(QS + jj * 1040 + (sub * 8 + c8) * 16), qv);
                { const f32x4 n0 = *(const LAS f32x4*)(nst + sub * 64 + c8 * 8), n1 = *(const LAS f32x4*)(nst + sub * 64 + c8 * 8 + 4);
                  qd += qv[0] * n0[0] + qv[1] * n0[1] + qv[2] * n0[2] + qv[3] * n0[3] + qv[4] * n1[0] + qv[5] * n1[1] + qv[6] * n1[2] + qv[7] * n1[3]; } }
            rsum += lshfl(rsum, lane ^ 1); rsum += lshfl(rsum, lane ^ 2); rsum += lshfl(rsum, lane ^ 4);
            qd += lshfl(qd, lane ^ 1); qd += lshfl(qd, lane ^ 2); qd += lshfl(qd, lane ^ 4);
            if (sub == 0) { const float qn = winter[jj] * qd + rsum; dinv[jj] = __builtin_amdgcn_rcpf(fmaxf(fabsf(qn), einv[jj])); }
        }
        __syncthreads();
        if (ci + 1 < NCH) { const int pn = p0 + 64 + lane; const int tn = dir == 0 ? pn : (pn < CTX ? CTX - 1 - pn : TPB + CTX - 1 - pn); const size_t Tn = (size_t)(b * TPB + tn) * INNER; const int w0 = __builtin_amdgcn_readfirstlane(wv);
#pragma unroll
            for (int r = 0; r < 8; ++r) pxc[r] = *(const u32x4v*)(xc + Tn + hd * DH + (w0 * 8 + r) * 8);
            pxv = *(const u32x4v*)(xm + Tn + hd * DH + es * 64 + w0 * 8); }
        {
            f32x4 o[4];
            const int et = wv & 3, dh = wv >> 2, el = 16 * et + fr;
            bf16x8 vfr[2];
#pragma unroll
            for (int mt = 0; mt < 4; ++mt) o[mt] = (f32x4){0.f, 0.f, 0.f, 0.f};
#pragma unroll
            for (int ks = 0; ks < 8; ++ks) {
                u32x4v bw; bw.x = pg8::cvt_pk_bf16(C[2 * ks][0], C[2 * ks][1]); bw.y = pg8::cvt_pk_bf16(C[2 * ks][2], C[2 * ks][3]);
                bw.z = pg8::cvt_pk_bf16(C[2 * ks + 1][0], C[2 * ks + 1][1]); bw.w = pg8::cvt_pk_bf16(C[2 * ks + 1][2], C[2 * ks + 1][3]);
                const bf16x8 bfr = __builtin_bit_cast(bf16x8, bw);
#pragma unroll
                for (int mt = 0; mt < 4; ++mt) { const int off = (16 * mt + fr) * 1040 + 8 * fq + dh * 512;
                    const u32x2 lo = *(const LAS u32x2*)(QS + off + 64 * ks), hi = *(const LAS u32x2*)(QS + off + 64 * ks + 32);
                    u32x4v aw; aw.x = lo.x; aw.y = lo.y; aw.z = hi.x; aw.w = hi.y;
                    o[mt] = __builtin_amdgcn_mfma_f32_16x16x32_bf16(bfr, __builtin_bit_cast(bf16x8, aw), o[mt], 0, 0, 0); }
                if ((ks & 1) == 1) __builtin_amdgcn_sched_barrier(0); }
#pragma unroll
            for (int mt = 0; mt < 4; ++mt)
#pragma unroll
                for (int r = 0; r < 4; ++r) o[mt][r] *= winter[16 * mt + fr];
#pragma unroll
            for (int k2 = 0; k2 < 2; ++k2) vfr[k2] = *(const LAS bf16x8*)(VT + el * 128 + (((4 * k2 + fq) ^ (el & 7)) << 4));
            if (dh == 1) {
#pragma unroll
                for (int mt = 0; mt < 4; ++mt) { u32x2 w; w.x = pg8::cvt_pk_bf16(o[mt][0], o[mt][1]); w.y = pg8::cvt_pk_bf16(o[mt][2], o[mt][3]); *(LAS u32x2*)(XB + ((et * 4 + mt) * 64 + lane) * 8) = w; }
            } else {
#pragma unroll
                for (int k2 = 0; k2 < 2; ++k2)
#pragma unroll
                    for (int mt = 0; mt < 4; ++mt) { const int jr = 16 * mt + fr; const bf16x8 a = *(const LAS bf16x8*)(ST + jr * 128 + (((4 * k2 + fq) ^ (jr & 7)) << 4));
                        o[mt] = __builtin_amdgcn_mfma_f32_16x16x32_bf16(vfr[k2], a, o[mt], 0, 0, 0); }
            }
            __syncthreads();
            if (dh == 0) {
#pragma unroll
                for (int mt = 0; mt < 4; ++mt) { const u32x2 pw = *(const LAS u32x2*)(XB + ((et * 4 + mt) * 64 + lane) * 8);
                    const int jr = 16 * mt + fr, T = tok(jr); const float di = dinv[jr];
                    const float o0 = (o[mt][0] + bflo(pw.x)) * di, o1 = (o[mt][1] + bfhi(pw.x)) * di, o2 = (o[mt][2] + bflo(pw.y)) * di, o3 = (o[mt][3] + bfhi(pw.y)) * di;
                    u16* dst = dir == 0 ? hf + (size_t)T * INNER : hb_ptr(kp, T); u32x2 w; w.x = pg8::cvt_pk_bf16(o0, o1); w.y = pg8::cvt_pk_bf16(o2, o3);
                    *(u32x2*)(dst + hd * DH + es * 64 + 16 * et + 4 * fq) = w; }
            }
            const float decay = scal[0];
#pragma unroll
            for (int i = 0; i < 16; ++i) C[i] = C[i] * decay;
            float kwv[2][8];
#pragma unroll
            for (int k2 = 0; k2 < 2; ++k2) { const f32x4 k0 = *(const LAS f32x4*)(kws + 32 * k2 + 8 * fq), k1 = *(const LAS f32x4*)(kws + 32 * k2 + 8 * fq + 4);
                kwv[k2][0] = k0[0]; kwv[k2][1] = k0[1]; kwv[k2][2] = k0[2]; kwv[k2][3] = k0[3]; kwv[k2][4] = k1[0]; kwv[k2][5] = k1[1]; kwv[k2][6] = k1[2]; kwv[k2][7] = k1[3]; }
#pragma unroll
            for (int k2 = 0; k2 < 2; ++k2) { float vv[8]; unpack8(__builtin_bit_cast(u32x4v, vfr[k2]), vv);
#pragma unroll
                for (int e = 0; e < 8; ++e) vv[e] *= kwv[k2][e];
                const bf16x8 bsc = __builtin_bit_cast(bf16x8, pack8(vv));
#pragma unroll
                for (int dt = 0; dt < 16; ++dt) { const int dr = 256 * (wv >> 2) + 16 * dt + fr; const bf16x8 a = *(const LAS bf16x8*)(KT + dr * 128 + (((4 * k2 + fq) ^ (dr & 7)) << 4));
                    C[dt] = __builtin_amdgcn_mfma_f32_16x16x32_bf16(a, bsc, C[dt], 0, 0, 0);
                    if ((dt & 7) == 7) __builtin_amdgcn_sched_barrier(0); } }
            { float nn = decay * nst[tid];
#pragma unroll
              for (int g = 0; g < 8; ++g) { float kv[8]; unpack8(*(const LAS u32x4v*)(KT + tid * 128 + ((g ^ (tid & 7)) << 4)), kv);
                  { const f32x4 k0 = *(const LAS f32x4*)(kws + 8 * g), k1 = *(const LAS f32x4*)(kws + 8 * g + 4); nn += kv[0] * k0[0] + kv[1] * k0[1] + kv[2] * k0[2] + kv[3] * k0[3] + kv[4] * k1[0] + kv[5] * k1[1] + kv[6] * k1[2] + kv[7] * k1[3]; } }
              nst[tid] = nn; }
            m_st = scal[1];
        }
    }
}

__device__ __forceinline__ void ml_gate_phase(KPC kp, int j) {
    u16* hf = (u16*)(kp->ws + OFF_R2); const u16* xc = (const u16*)(kp->ws + OFF_XC); const u16* z = (const u16*)(kp->ws + OFF_XM);
    const float* ng = kp->in[I_MLNG] + (size_t)j * INNER; const float* sk = kp->in[I_MLSKIP] + (size_t)j * INNER;
    const int lane = ltid() & 63, wv = ltid() >> 6;
    for (int T = lbid() * 8 + wv; T < NTOK; T += gridDim.x * 8) {
        const u16* hbp = hb_ptr(kp, T);
#pragma unroll
        for (int hd = 0; hd < 4; ++hd) { const int c0 = hd * DH + lane * 8; float a[8], bq[8], xv[8], zv[8], o[8];
            unpack8(*(const u32x4v*)(hf + (size_t)T * INNER + c0), a); unpack8(*(const u32x4v*)(hbp + c0), bq);
            float s = 0.f;
#pragma unroll
            for (int e = 0; e < 8; ++e) { a[e] += bq[e]; s += a[e]; }
            const float mu = wave_sum(s) * (1.0f / DH); float vs = 0.f;
#pragma unroll
            for (int e = 0; e < 8; ++e) { a[e] -= mu; vs += a[e] * a[e]; }
            const float rs = rsqrtf(wave_sum(vs) * (1.0f / DH) + 1e-5f);
            unpack8(*(const u32x4v*)(xc + (size_t)T * INNER + c0), xv); unpack8(*(const u32x4v*)(z + (size_t)T * INNER + c0), zv);
            const f32x4 n0 = *(const f32x4*)(ng + c0), n1 = *(const f32x4*)(ng + c0 + 4), s0 = *(const f32x4*)(sk + c0), s1 = *(const f32x4*)(sk + c0 + 4);
            const float ngv[8] = {n0[0], n0[1], n0[2], n0[3], n1[0], n1[1], n1[2], n1[3]}, skv[8] = {s0[0], s0[1], s0[2], s0[3], s1[0], s1[1], s1[2], s1[3]};
#pragma unroll
            for (int e = 0; e < 8; ++e) o[e] = (a[e] * rs * ngv[e] + skv[e] * xv[e]) * siluf(zv[e]);
            *(u32x4v*)(hf + (size_t)T * INNER + c0) = pack8(o); }
    }
}


enum { K_SETUP = 0, K_CN, K_G1, K_G2R, K_HYIN, K_HYCONV, K_HYTR, K_MLUPX, K_MLPREP, K_MLSCAN, K_MLUPZ, K_MLGATE, K_FINAL };
constexpr int NPHASE = 1 + 11 + 13 + 11 + 13 + 1;
__device__ __forceinline__ void decode_phase(int ph, int& kind, int& l, int& arg) {
    kind = K_SETUP; l = 0; arg = 0; if (ph == 0) return;
    ph -= 1;
    for (l = 0; l < 4; ++l) { const int n = (l & 1) ? 13 : 11; if (ph < n) break; ph -= n; }
    if (l == 4) { kind = K_FINAL; l = 0; return; }
    if (ph == 0) { kind = K_CN; arg = 0; return; } if (ph == 1) { kind = K_G1; arg = 0; return; } if (ph == 2) { kind = K_G2R; arg = 0; return; } if (ph == 3) { kind = K_CN; arg = 1; return; }
    const int nm = (l & 1) ? 6 : 4;
    if (ph < 4 + nm) { const int q = ph - 4;
        if (l & 1) { kind = q == 0 ? K_MLUPX : q == 1 ? K_MLPREP : q == 2 ? K_MLSCAN : q == 3 ? K_MLUPZ : q == 4 ? K_MLGATE : K_G2R; arg = 2; }
        else { kind = q == 0 ? K_HYIN : q == 1 ? K_HYCONV : q == 2 ? K_HYTR : K_G2R; arg = 2; }
        return; }
    ph -= 4 + nm;
    if (ph == 0) { kind = K_CN; arg = 2; return; } if (ph == 1) { kind = K_G1; arg = 1; return; } kind = K_G2R; arg = 1;
}

__device__ __forceinline__ void gbar(unsigned* ctr, unsigned target) {
    __syncthreads();
    if (ltid() == 0) {
        __builtin_amdgcn_fence(__ATOMIC_RELEASE, "agent");
        __hip_atomic_fetch_add(ctr, 1u, __ATOMIC_RELAXED, __HIP_MEMORY_SCOPE_AGENT);
        while (__hip_atomic_load(ctr, __ATOMIC_RELAXED, __HIP_MEMORY_SCOPE_AGENT) < target) __builtin_amdgcn_s_sleep(2);
        __builtin_amdgcn_fence(__ATOMIC_ACQUIRE, "agent");
    }
    __syncthreads();
}
#ifndef REPMASK
#define REPMASK 0
#define REPN 1
#endif
template <int MIX> __device__ __forceinline__ void run_phases(int lo, int hi, int ph_lo, int ph_hi, LAS unsigned char* lds0, cg::grid_group& grid) {
    lo = lo > ph_lo ? lo : ph_lo; hi = hi < ph_hi ? hi : ph_hi;
    for (int ph = lo; ph < hi; ++ph) {
        KPC kp = (KPC)__builtin_amdgcn_kernarg_segment_ptr(); asm volatile("" : "+s"(kp) :: "memory");
        LAS unsigned char* lds = lds0; asm volatile("" : "+s"(lds) :: "memory");
        unsigned char* ws = kp->ws; unsigned char* wb = ws + OFF_WB;
        int kind, l, arg; decode_phase(ph, kind, l, arg); const int j = l >> 1;
        const float* modl = (const float*)(ws + OFF_MOD) + (size_t)l * 5 * 9216;
        const int nrep = ((REPMASK >> kind) & 1) ? REPN : 1;
        for (int rep = 0; rep < nrep; ++rep) {
        if (kind == K_SETUP) { if constexpr (MIX == 0) setup_phase(kp, (LAS float*)lds); }
        else if (kind == K_CN) {
            if (arg == 0) { convert_layer(kp, l, (LAS float*)lds); if constexpr (MIX == 1) ml_m_phase(kp, j); }
            if constexpr (MIX == 0) { if (arg == 1) hy_mlp_phase(kp, j); }
            norm_phase(kp, l, arg, arg == 0 ? (l == 0 ? 0 : 11) : arg == 1 ? 11 : (l == 3 ? 0 : (l & 1) ? 8 : 4));
        } else if (kind == K_G1) {
            pg8::Gemm g{(const u16*)(ws + OFF_U), (const u16*)(wb + (arg ? WB_FIN1 : WB_FIN0)), NTOK, 2 * FF, D};
            pg8::StaticOrder S; S.init(g.M, g.N, (int)gridDim.x, lbid(), (l == 3 && arg == 1) ? 1 : 0); EpiSwiglu E{(u16*)(ws + OFF_R1)};
            pg8::gemm_phase<EpiSwiglu, pg8::StaticOrder, false>(lds, g, S, E, nullptr);
        } else if (kind == K_G2R) {
            const u16* gA; const u16* gB; int gK, gidx, gbj = -1;
            if (arg < 2) { gA = (const u16*)(ws + OFF_R1); gB = (const u16*)(wb + (arg ? WB_FOUT1 : WB_FOUT0)); gK = FF; gidx = arg ? 8 : 2; }
            else if (MIX == 1) { gA = (const u16*)(ws + OFF_R2); gB = (const u16*)(wb + WB_MOUT); gK = INNER; gidx = 5; }
            else { gA = (const u16*)(ws + OFF_U); gB = (const u16*)(wb + WB_MOUT); gK = D; gidx = 5; gbj = j; }
            const pg8::Gemm g{gA, gB, NTOK, D, gK, 0}; const EpiResid E{kp, l, gidx, gbj};
            pg8::StaticOrder S; S.init(g.M, g.N, (int)gridDim.x, lbid(), (l == 3 && arg >= 1) ? 1 : 2, g.K / 256);
            pg8::gemm_phase<EpiResid, pg8::StaticOrder, false>(lds, g, S, E, nullptr);
        } else if (kind == K_FINAL) { if constexpr (MIX == 1) final_phase(kp); }
        else if constexpr (MIX == 0) {
            if (kind == K_HYIN) {
                pg8::Gemm g{(const u16*)(wb + WB_MIN), (const u16*)(ws + OFF_U), 3 * D, NTOK, D};
                pg8::StaticOrder S; S.init(g.M, g.N, (int)gridDim.x, lbid());
                EpiProjT E{(u16*)(ws + OFF_R1 + HY_PL), (u16*)(ws + OFF_R1 + HY_PC), kp->in[I_HYBIN] + (size_t)j * 3 * D};
                pg8::gemm_phase<EpiProjT, pg8::StaticOrder, false>(lds, g, S, E, nullptr);
                __syncthreads();
                for (int t = lbid(); t < 2048; t += gridDim.x) hy_filter_task(kp, j, t, (LAS f32x2*)lds, (LAS float*)(lds + 131072));
            } else if (kind == K_HYCONV) {
                for (int t = lbid(); t < 2048; t += gridDim.x) hy_conv_lat(kp, j, t, (LAS f32x2*)lds);
                for (int t = lbid(); t < 1024; t += gridDim.x) hy_conv_ctx(kp, j, t, (LAS float*)lds);
            } else if (kind == K_HYTR) hy_transpose(kp, (LAS u16*)lds);
        } else {
            if (kind == K_MLUPX || kind == K_MLUPZ) {
                const bool zz = kind == K_MLUPZ;
                pg8::Gemm g{(const u16*)(ws + OFF_U), (const u16*)(wb + WB_MIN) + (zz ? (size_t)INNER * D : 0), NTOK, INNER, D};
                pg8::StaticOrder S; S.init(g.M, g.N, (int)gridDim.x, lbid(), (zz && l == 3) ? 1 : 0); EpiBf E{(u16*)(ws + OFF_XM), INNER};
                pg8::gemm_phase<EpiBf, pg8::StaticOrder, false>(lds, g, S, E, nullptr);
            } else if (kind == K_MLPREP) { for (int t = lbid(); t < NB * NCH * 4; t += gridDim.x) ml_prep_task(kp, j, t, lds); }
            else if (kind == K_MLSCAN) { for (int t = lbid(); t < 256; t += gridDim.x) ml_scan_task(kp, j, t, lds); }
            else if (kind == K_MLGATE) ml_gate_phase(kp, j);
        }
        }
        if (ph + 1 < ph_hi) gbar((unsigned*)(kp->ws + OFF_MLM + 65536), (unsigned)(ph + 1 - ph_lo) * gridDim.x);
    }
}

__global__ void __launch_bounds__(512) fwd_megakernel(KP kparg) {
    extern __shared__ __attribute__((aligned(16))) unsigned char shm[];
    LAS unsigned char* lds = (LAS unsigned char*)shm;
    cg::grid_group grid = cg::this_grid();
    grid.sync();
    wtab_init();
    const int ph_lo = kparg.ph_lo, ph_hi = kparg.ph_hi;
    run_phases<0>(0, 12, ph_lo, ph_hi, lds, grid);
    run_phases<1>(12, 25, ph_lo, ph_hi, lds, grid);
    run_phases<0>(25, 36, ph_lo, ph_hi, lds, grid);
    run_phases<1>(36, 50, ph_lo, ph_hi, lds, grid);
}

extern "C" void kernel_launch(void* const* d_in, const int* in_sizes, int n_in, void* d_out, int out_size, void* d_ws, size_t ws_size, hipStream_t stream) {
    static int grid_blocks = 0;
    if (!grid_blocks) {
        int dev = 0, cus = 0, per_cu = 0;
        hipGetDevice(&dev);
        hipDeviceGetAttribute(&cus, hipDeviceAttributeMultiprocessorCount, dev);
        hipFuncSetAttribute((const void*)fwd_megakernel, hipFuncAttributeMaxDynamicSharedMemorySize, LDS_BYTES);
        hipOccupancyMaxActiveBlocksPerMultiprocessor(&per_cu, fwd_megakernel, 512, LDS_BYTES);
        if (per_cu < 1) per_cu = 1;
        grid_blocks = cus * 1;
        if (ws_size < WS_NEED2) fprintf(stderr, "workspace too small: %zu < %zu\n", ws_size, (size_t)WS_NEED2);
    }
    KP hp{};
    for (int i = 0; i < 36; ++i) hp.in[i] = (const float*)d_in[i];
    hp.out = (float*)d_out; hp.ws = (unsigned char*)d_ws; hp.ph_lo = 0; hp.ph_hi = NPHASE;
    void* args[] = {&hp};
    hipMemsetAsync((unsigned char*)d_ws + OFF_MLM + 65536, 0, 256, stream);
    hipError_t e = hipLaunchCooperativeKernel((void*)fwd_megakernel, dim3(grid_blocks), dim3(512), args, LDS_BYTES, stream);
    if (e != hipSuccess) fprintf(stderr, "cooperative launch failed: %s (grid %d)\n", hipGetErrorString(e), grid_blocks);
}
```

```cpp
#define REPMASK 0
#define REPN 1
#include <hip/hip_runtime.h>
#include <hip/hip_cooperative_groups.h>
#include <cstdio>
namespace cg = cooperative_groups;
#define WTAB_OFF 163584
__device__ __forceinline__ int llane() { int l; asm volatile("v_mbcnt_lo_u32_b32 %0, -1, 0\n\tv_mbcnt_hi_u32_b32 %0, -1, %0" : "=v"(l) :: "memory"); return l; }
__device__ __forceinline__ int lwave() { extern __shared__ __attribute__((aligned(16))) unsigned char shm_w[];
    const int hw = __builtin_amdgcn_s_getreg(10244) & 63;
    return __builtin_amdgcn_readfirstlane(*(const __attribute__((address_space(3))) int*)((__attribute__((address_space(3))) unsigned char*)shm_w + WTAB_OFF + hw * 4)); }
__device__ __forceinline__ void wtab_init() { extern __shared__ __attribute__((aligned(16))) unsigned char shm_w[];
    const int hw = __builtin_amdgcn_s_getreg(10244) & 63;
    *(__attribute__((address_space(3))) int*)((__attribute__((address_space(3))) unsigned char*)shm_w + WTAB_OFF + hw * 4) = (int)(threadIdx.x >> 6); }
__device__ __forceinline__ int ltid() { return lwave() * 64 + llane(); }
__device__ __forceinline__ int lbid() { int t = blockIdx.x; asm volatile("" : "+s"(t) :: "memory"); return t; }
namespace pg8 {
#define PG8_LAS __attribute__((address_space(3)))
typedef unsigned short bf16_t;
typedef short bf16x8 __attribute__((ext_vector_type(8)));
typedef float f32x4 __attribute__((ext_vector_type(4)));
typedef unsigned u32x4 __attribute__((ext_vector_type(4)));
constexpr int BM = 256, BK = 64, HALF = 128, HTB = HALF * BK * 2  , STAGE_BYTES = 8 * HTB, NXCD = 8, WGM = 8;

__host__ __device__ __forceinline__ int lds_byte(int r, int c) { const int st = (r >> 4) * 2 + (c >> 5), rr = r & 15, cc = c & 31, ob = rr * 64 + cc * 2; return st * 1024 + (ob ^ (((ob >> 9) & 1) << 5)); }
__host__ __device__ __forceinline__ void stage_rc(int b, int& R, int& C) { const int st = b / 1024, sb = b % 1024, swz = sb ^ (((sb >> 9) & 1) << 5); R = (st >> 1) * 16 + swz / 64; C = (st & 1) * 32 + (swz % 64) / 2; }
__host__ __device__ __forceinline__ int perm32(int rho) { const int n = rho >> 4, i = rho & 15; return 8 * (i >> 2) + 4 * n + (i & 3); }

struct Unit { int pm, pn, kofs, nt; };
struct Gemm { const bf16_t* A; const bf16_t* Bt; int M, N, K, ldk; };

struct StaticOrder {
    int nM, nN, nwg, G, c, lat, nk;
    __host__ __device__ void init(int M, int N, int G_, int c_, int lat_ = 0, int nk_ = 0) { lat = lat_; nk = nk_; nM = lat ? 128 : M / BM; nN = N / BM; nwg = nM * nN; G = G_; c = c_; }
    __host__ __device__ bool next(int i, Unit& u) const {
        const long L = (long)i * G + c;
        if (L >= nwg) { if (lat != 2 || L >= nwg + 16 * nk) return false; const int Lc = (int)L - nwg, un = Lc & 15; u.pm = (un >> 2) * 33; u.pn = un & 3; u.kofs = (Lc >> 4) * 256; u.nt = 4; return true; }
        int wgid = (int)L; { const int q = nwg / NXCD, r = nwg % NXCD, xcd = wgid % NXCD, off = wgid / NXCD; wgid = (xcd < r ? xcd * (q + 1) : r * (q + 1) + (xcd - r) * q) + off; }
        const int nig = WGM * nN, gid = wgid / nig, fm = gid * WGM, gsz = (nM - fm) < WGM ? (nM - fm) : WGM;
        u.pm = fm + ((wgid % nig) % gsz); u.pn = (wgid % nig) / gsz; u.kofs = 0; u.nt = 0; if (lat) u.pm = (u.pm >> 5) * 33 + 1 + (u.pm & 31); return true;
    }
    __device__ __forceinline__ void a_ready(const Unit&) const {}
    __device__ __forceinline__ void done(const Unit&) const {}
};
__device__ __forceinline__ unsigned cvt_pk_bf16(float lo, float hi) { unsigned r; asm volatile("v_cvt_pk_bf16_f32 %0, %1, %2" : "=v"(r) : "v"(lo), "v"(hi)); return r; }
template <class Epi, class Sched, bool STAMP = false>
__device__ __forceinline__ void gemm_phase(PG8_LAS unsigned char* lds, const Gemm g, const Sched& S, const Epi& E, unsigned long long* stamps) {
    const int tid = ltid(), wid = __builtin_amdgcn_readfirstlane(tid >> 6), lane = tid & 63, wr = wid >> 2, wc = wid & 3, fr = lane & 15, fq = lane >> 4;
    const int K = g.K, nt = K / BK, ldk = g.ldk ? g.ldk : g.K;
    int ts_lo = 0, ts_hi = 0, nts = 0; const unsigned long long rt_entry = STAMP ? (unsigned long long)wall_clock64() : 0ull;
#define PG8_STAMP() do { if (STAMP && wid == 0 && nts < 64) { const unsigned long long _c = (unsigned long long)clock64(); \
        ts_lo = (lane == nts) ? (int)(unsigned)_c : ts_lo; ts_hi = (lane == nts) ? (int)(unsigned)(_c >> 32) : ts_hi; ++nts; } } while (0)
    PG8_STAMP();
    unsigned voffA[2], voffB[2];
#pragma unroll
    for (int i = 0; i < 2; ++i) { int R, C; stage_rc(tid * 16 + i * 8192, R, C); const int Rb = Epi::PERM ? ((R & ~31) + perm32(R & 31)) : R;
        voffA[i] = (unsigned)(R * ldk + C) * 2u; voffB[i] = (unsigned)(Rb * ldk + C) * 2u; }
    const size_t kstep = (size_t)(BK * 2);
    const size_t hstep = (size_t)HALF * ldk * 2;
    const size_t tstep = 2 * hstep;
    const unsigned ldsw = (unsigned)wid * 1024u;
    const int aoff = lds_byte(wr * 64 + fr, fq * 8), boff = lds_byte(wc * 32 + fr, fq * 8);
#define PG8_SA(b, h) (((b) * 2 + (h)) * HTB)
#define PG8_SB(b, h) ((4 + (b) * 2 + (h)) * HTB)
#define PG8_STAGE(bufoff, gbase, voff) do { _Pragma("unroll") for (int _i = 0; _i < 2; ++_i) \
        __builtin_amdgcn_global_load_lds((const unsigned*)((const char*)(gbase) + (voff)[_i]), (PG8_LAS unsigned*)(lds + (bufoff) + ldsw + _i * 8192), 16, 0, 0); } while (0)
#define PG8_LDA(dst, b, h) do { _Pragma("unroll") for (int m = 0; m < 4; ++m) _Pragma("unroll") for (int k = 0; k < 2; ++k) dst[m][k] = *(const PG8_LAS bf16x8*)(lds + PG8_SA(b, h) + aoff + m * 2048 + k * 1024); } while (0)
#define PG8_LDB(dst, b, h) do { _Pragma("unroll") for (int n = 0; n < 2; ++n) _Pragma("unroll") for (int k = 0; k < 2; ++k) dst[n][k] = *(const PG8_LAS bf16x8*)(lds + PG8_SB(b, h) + boff + n * 2048 + k * 1024); } while (0)
#define PG8_MMA(ai, bj, At, Bt) do { __builtin_amdgcn_s_setprio(1); _Pragma("unroll") for (int m = 0; m < 4; ++m) _Pragma("unroll") for (int n = 0; n < 2; ++n) _Pragma("unroll") for (int k = 0; k < 2; ++k) \
        acc[ai][bj][m][n] = __builtin_amdgcn_mfma_f32_16x16x32_bf16(Bt[n][k], At[m][k], acc[ai][bj][m][n], 0, 0, 0); __builtin_amdgcn_s_setprio(0); } while (0)
#define PG8_WAIT_V(n) asm volatile("s_waitcnt vmcnt(" #n ")" ::: "memory")
#define PG8_WAIT_L(n) asm volatile("s_waitcnt lgkmcnt(" #n ")" ::: "memory")
#define PG8_BAR __builtin_amdgcn_s_barrier()
#define PG8_SCHED __builtin_amdgcn_sched_barrier(0)
    Unit cur, nxt; int ui = 0;
    if (!S.next(0, cur)) return;
    f32x4 acc[2][2][4][2];
#pragma unroll
    for (int a = 0; a < 2; ++a)
#pragma unroll
        for (int b = 0; b < 2; ++b)
#pragma unroll
            for (int m = 0; m < 4; ++m)
#pragma unroll
                for (int n = 0; n < 2; ++n) acc[a][b][m][n] = (f32x4){0.f, 0.f, 0.f, 0.f};
    bf16x8 At[4][2], B0[2][2], B1[2][2];
    const char* cA = (const char*)g.A + (size_t)cur.pm * tstep + (size_t)cur.kofs * 2; const char* cB = (const char*)g.Bt + (size_t)cur.pn * tstep + (size_t)cur.kofs * 2;
    S.a_ready(cur);
    PG8_STAGE(PG8_SB(0, 0), cB, voffB); PG8_STAGE(PG8_SA(0, 0), cA, voffA); PG8_STAGE(PG8_SB(0, 1), cB + hstep, voffB); PG8_STAGE(PG8_SA(0, 1), cA + hstep, voffA);
    if (wr == 1) PG8_BAR;
    PG8_WAIT_V(4); PG8_BAR;
    PG8_STAGE(PG8_SB(1, 0), cB + kstep, voffB); PG8_STAGE(PG8_SA(1, 0), cA + kstep, voffA); PG8_STAGE(PG8_SB(1, 1), cB + hstep + kstep, voffB);
    PG8_WAIT_V(6); PG8_BAR;
    PG8_STAMP();
    for (;;) {
        const bool has_next = S.next(ui + 1, nxt);
        const char* nA = has_next ? (const char*)g.A + (size_t)nxt.pm * tstep + (size_t)nxt.kofs * 2 : cA; const char* nB = has_next ? (const char*)g.Bt + (size_t)nxt.pn * tstep + (size_t)nxt.kofs * 2 : cB;
        const int ntu = cur.nt ? cur.nt : nt;
        for (int t = 0; t < ntu; t += 2) {
            const bool last = (t == ntu - 2);
            const char* a1 = cA + (size_t)(t + 1) * kstep;
            const char* a2 = last ? nA : cA + (size_t)(t + 2) * kstep; const char* b2 = last ? nB : cB + (size_t)(t + 2) * kstep;
            const char* a3 = a2 + kstep; const char* b3 = b2 + kstep;
            if (last && has_next) S.a_ready(nxt);
            PG8_LDB(B0, 0, 0); PG8_SCHED; PG8_LDA(At, 0, 0); PG8_STAGE(PG8_SA(1, 1), a1 + hstep, voffA);
            PG8_WAIT_L(8); PG8_BAR; PG8_WAIT_L(0); PG8_MMA(0, 0, At, B0); PG8_BAR; PG8_SCHED;
            PG8_LDB(B1, 0, 1); PG8_STAGE(PG8_SB(0, 0), b2, voffB);
            PG8_BAR; PG8_WAIT_L(0); PG8_MMA(0, 1, At, B1); PG8_BAR;
            PG8_LDA(At, 0, 1); PG8_STAGE(PG8_SA(0, 0), a2, voffA);
            PG8_BAR; PG8_WAIT_L(0); PG8_MMA(1, 0, At, B0); PG8_BAR; PG8_SCHED;
            PG8_STAGE(PG8_SB(0, 1), b2 + hstep, voffB);
            PG8_WAIT_V(6); PG8_BAR; PG8_MMA(1, 1, At, B1); PG8_BAR;
            PG8_LDB(B0, 1, 0); PG8_SCHED; PG8_LDA(At, 1, 0); PG8_STAGE(PG8_SA(0, 1), a2 + hstep, voffA);
            PG8_WAIT_L(8); PG8_BAR; PG8_WAIT_L(0); PG8_MMA(0, 0, At, B0); PG8_BAR; PG8_SCHED;
            PG8_LDB(B1, 1, 1); PG8_STAGE(PG8_SB(1, 0), b3, voffB);
            PG8_BAR; PG8_WAIT_L(0); PG8_MMA(0, 1, At, B1); PG8_BAR;
            PG8_LDA(At, 1, 1); PG8_STAGE(PG8_SA(1, 0), a3, voffA);
            PG8_BAR; PG8_WAIT_L(0); PG8_MMA(1, 0, At, B0); PG8_BAR; PG8_SCHED;
            PG8_STAGE(PG8_SB(1, 1), b3 + hstep, voffB);
            PG8_WAIT_V(6); PG8_BAR; PG8_MMA(1, 1, At, B1); PG8_BAR;
        }
        PG8_STAMP();
        if constexpr (!Epi::AFTER_DRAIN) { E(acc, cur, wr, wc, fr, fq); S.done(cur); }
        PG8_STAMP();
        if (!has_next) break;
#pragma unroll
        for (int a = 0; a < 2; ++a)
#pragma unroll
            for (int b = 0; b < 2; ++b)
#pragma unroll
                for (int m = 0; m < 4; ++m)
#pragma unroll
                    for (int n = 0; n < 2; ++n) acc[a][b][m][n] = (f32x4){0.f, 0.f, 0.f, 0.f};
        cur = nxt; cA = nA; cB = nB; ++ui;
    }
    PG8_WAIT_V(0);
    if (wr == 0) PG8_BAR;
    PG8_BAR;
    if constexpr (Epi::AFTER_DRAIN) { E.fused(acc, cur, wr, wc, fr, fq, lds, wid, lane); S.done(cur); }
    PG8_STAMP();
    if (STAMP && wid == 0) { stamps[lane] = lane < nts ? (((unsigned long long)(unsigned)ts_hi << 32) | (unsigned)ts_lo) : 0ull;
        if (lane == 62) stamps[62] = rt_entry; if (lane == 63) stamps[63] = (unsigned long long)wall_clock64(); }
#undef PG8_STAMP
#undef PG8_SA
#undef PG8_SB
#undef PG8_STAGE
#undef PG8_LDA
#undef PG8_LDB
#undef PG8_MMA
#undef PG8_WAIT_V
#undef PG8_WAIT_L
#undef PG8_BAR
#undef PG8_SCHED
}
}

typedef unsigned short u16;
using pg8::f32x4; using pg8::bf16x8;
typedef float f32x2 __attribute__((ext_vector_type(2)));
typedef unsigned u32x2 __attribute__((ext_vector_type(2)));
typedef unsigned u32x4v __attribute__((ext_vector_type(4)));
typedef short s16x4 __attribute__((ext_vector_type(4)));
#define LAS __attribute__((address_space(3)))
constexpr int D = 1024, NB = 4, SEQ = 8192, CTX = 256, TPB = 8448, NTOK = 33792, FF = 2816, NCH = 132, INNER = 2048, DH = 512, NFFT = 16384;
constexpr size_t MiB = 1u << 20;
constexpr size_t OFF_WB = 0, OFF_MOD = 48 * MiB, OFF_H = 49 * MiB, OFF_U = OFF_H + 132 * MiB, OFF_R1 = OFF_U + 66 * MiB, OFF_R2 = OFF_R1 + 264 * MiB,
                 OFF_HBC = OFF_R2 + 132 * MiB, OFF_GATES = OFF_HBC + 4 * MiB, OFF_H2 = OFF_GATES + 3 * MiB, OFF_KCTX = OFF_H2 + 3 * MiB, WS_NEED = OFF_KCTX + 4 * MiB;
constexpr size_t WB_FIN0 = 0, WB_FIN1 = 11 * MiB, WB_FOUT0 = 22 * MiB, WB_FOUT1 = 22 * MiB + 5632 * 1024, WB_MIN = 33 * MiB, WB_MOUT = 41 * MiB, WB_WGT = 45 * MiB;
constexpr int LDS_BYTES = 163840;
struct KP { const float* in[36]; float* out; unsigned char* ws; int ph_lo, ph_hi; };
typedef const KP __attribute__((address_space(4))) * KPC;
enum { I_X = 0, I_C, I_CTX, I_CCTX, I_ADAW, I_ADAB, I_NORMG, I_FINALG, I_FFNIN, I_FFNOUT, I_HYWIN, I_HYBIN, I_HYCW, I_HYCB, I_HYW1, I_HYB1, I_HYW2, I_HYB2, I_HYW3, I_HYB3,
       I_HYFREQ, I_HYDECAY, I_HYSKIP, I_HYWOUT, I_HYBOUT, I_MLUP, I_MLCW, I_MLCB, I_MLWQ, I_MLWK, I_MLWV, I_MLWG, I_MLBG, I_MLNG, I_MLSKIP, I_MLDOWN };

__device__ __forceinline__ float bf2f(u16 b) { return __uint_as_float(((unsigned)b) << 16); }
__device__ __forceinline__ float bflo(unsigned w) { return __uint_as_float(w << 16); }
__device__ __forceinline__ float bfhi(unsigned w) { return __uint_as_float(w & 0xffff0000u); }
__device__ __forceinline__ u16 f2bf(float f) { return (u16)(pg8::cvt_pk_bf16(f, 0.f) & 0xffffu); }
__device__ __forceinline__ float siluf(float x) { return x * __builtin_amdgcn_rcpf(1.0f + __expf(-x)); }
__device__ __forceinline__ int modrow_of_token(int T) { const int b = T / TPB, t = T - b * TPB; return t < CTX ? 4 : b; }
__device__ __forceinline__ float lshfl(float v, int srclane) { return __int_as_float(__builtin_amdgcn_ds_bpermute(srclane << 2, __float_as_int(v))); }
#define DPPF(idv, v, ctrl, rmask) __int_as_float(__builtin_amdgcn_update_dpp(__float_as_int(idv), __float_as_int(v), ctrl, rmask, 0xF, false))
__device__ __forceinline__ float wave_sum(float v) {
    v += DPPF(0.f, v, 0x111, 0xF); v += DPPF(0.f, v, 0x112, 0xF); v += DPPF(0.f, v, 0x114, 0xF); v += DPPF(0.f, v, 0x118, 0xF);
    v += DPPF(0.f, v, 0x142, 0xA); v += DPPF(0.f, v, 0x143, 0xC);
    return __int_as_float(__builtin_amdgcn_readlane(__float_as_int(v), 63)); }
__device__ __forceinline__ float wave_max(float v) { const int lane = llane();
#pragma unroll
    for (int o = 32; o > 0; o >>= 1) v = fmaxf(v, lshfl(v, lane ^ o));
    return v; }

__device__ __forceinline__ void unpack8(u32x4v w, float (&f)[8]) { f[0] = bflo(w.x); f[1] = bfhi(w.x); f[2] = bflo(w.y); f[3] = bfhi(w.y); f[4] = bflo(w.z); f[5] = bfhi(w.z); f[6] = bflo(w.w); f[7] = bfhi(w.w); }
__device__ __forceinline__ u32x4v pack8(const float (&f)[8]) { u32x4v w; w.x = pg8::cvt_pk_bf16(f[0], f[1]); w.y = pg8::cvt_pk_bf16(f[2], f[3]); w.z = pg8::cvt_pk_bf16(f[4], f[5]); w.w = pg8::cvt_pk_bf16(f[6], f[7]); return w; }

struct EpiSwiglu {
    static constexpr bool PERM = true, AFTER_DRAIN = false;
    u16* act;
    __device__ __forceinline__ void operator()(const f32x4 (&acc)[2][2][4][2], const pg8::Unit& u, int wr, int wc, int fr, int fq) const {
        const int row0 = u.pm * 256 + wr * 64 + fr, col0 = u.pn * 128 + wc * 32 + 8 * fq;
#pragma unroll
        for (int ai = 0; ai < 2; ++ai)
#pragma unroll
            for (int m = 0; m < 4; ++m) {
                const f32x4 g0 = acc[ai][0][m][0], g1 = acc[ai][0][m][1], v0 = acc[ai][1][m][0], v1 = acc[ai][1][m][1];
                u32x4v w;
                w.x = pg8::cvt_pk_bf16(siluf(g0[0]) * v0[0], siluf(g0[1]) * v0[1]); w.y = pg8::cvt_pk_bf16(siluf(g0[2]) * v0[2], siluf(g0[3]) * v0[3]);
                w.z = pg8::cvt_pk_bf16(siluf(g1[0]) * v1[0], siluf(g1[1]) * v1[1]); w.w = pg8::cvt_pk_bf16(siluf(g1[2]) * v1[2], siluf(g1[3]) * v1[3]);
                *(u32x4v*)(act + (size_t)(row0 + ai * 128 + m * 16) * FF + col0) = w; }
    }
};
struct EpiResid {
    static constexpr bool PERM = false, AFTER_DRAIN = false;
    KPC kp; int l, gidx, bias_j;
    __device__ __forceinline__ void operator()(const f32x4 (&acc)[2][2][4][2], const pg8::Unit& u, int wr, int wc, int fr, int fq) const {
        unsigned char* ws = kp->ws; float* h = (float*)(ws + OFF_H); float* part = (float*)kp->out;
        const float* bias = bias_j >= 0 ? kp->in[I_HYBOUT] + (size_t)bias_j * D : nullptr; const float scale = gidx == 5 ? 1.0f : 0.5f;
        const int col0 = u.pn * 256 + wc * 32 + 4 * fq;
        const int mr = modrow_of_token(u.pm * 256);
        const float* gp = (const float*)(ws + OFF_MOD) + ((size_t)l * 5 + mr) * 9216 + gidx * 1024;
        const bool split = u.nt != 0, addb = bias != nullptr && u.kofs == 0;
        float* base = split ? part + ((size_t)(u.kofs >> 8) * 1024 + (u.pm / 33) * 256 + wr * 64 + fr) * D : h + (size_t)(u.pm * 256 + wr * 64 + fr) * D;
#pragma unroll
        for (int bj = 0; bj < 2; ++bj)
#pragma unroll
            for (int n = 0; n < 2; ++n) { const f32x4 gv = *(const f32x4*)(gp + col0 + bj * 128 + n * 16) * scale;
                const f32x4 bv = addb ? *(const f32x4*)(bias + col0 + bj * 128 + n * 16) : (f32x4){0.f, 0.f, 0.f, 0.f};
#pragma unroll
                for (int ai = 0; ai < 2; ++ai)
#pragma unroll
                    for (int m = 0; m < 4; ++m) { f32x4* q = (f32x4*)(base + (size_t)(ai * 128 + m * 16) * D + col0 + bj * 128 + n * 16); const f32x4 v = gv * (acc[ai][bj][m][n] + bv);
                        if (split) *q = v; else *q = *q + v; } }
    }
};
struct EpiBf {
    static constexpr bool PERM = true, AFTER_DRAIN = false;
    u16* O; int ldc;
    __device__ __forceinline__ void operator()(const f32x4 (&acc)[2][2][4][2], const pg8::Unit& u, int wr, int wc, int fr, int fq) const {
        const int row0 = u.pm * 256 + wr * 64 + fr, col0 = u.pn * 256 + wc * 32 + 8 * fq;
#pragma unroll
        for (int ai = 0; ai < 2; ++ai)
#pragma unroll
            for (int m = 0; m < 4; ++m)
#pragma unroll
                for (int bj = 0; bj < 2; ++bj) { const f32x4 a = acc[ai][bj][m][0], b = acc[ai][bj][m][1]; u32x4v w;
                    w.x = pg8::cvt_pk_bf16(a[0], a[1]); w.y = pg8::cvt_pk_bf16(a[2], a[3]); w.z = pg8::cvt_pk_bf16(b[0], b[1]); w.w = pg8::cvt_pk_bf16(b[2], b[3]);
                    *(u32x4v*)(O + (size_t)(row0 + ai * 128 + m * 16) * ldc + col0 + bj * 128) = w; }
    }
};
struct EpiProjT {
    static constexpr bool PERM = true, AFTER_DRAIN = false;
    u16* lat; u16* ctx; const float* bias;
    __device__ __forceinline__ void operator()(const f32x4 (&acc)[2][2][4][2], const pg8::Unit& u, int wr, int wc, int fr, int fq) const {
        const int row0 = u.pm * 256 + wr * 64 + fr, tc0 = wc * 32 + 8 * fq;
        const int b = u.pn / 33, tile = u.pn - b * 33;
#pragma unroll
        for (int ai = 0; ai < 2; ++ai)
#pragma unroll
            for (int m = 0; m < 4; ++m) { const int ch = row0 + ai * 128 + m * 16; const float bs = bias[ch];
                u16* dst = tile == 0 ? ctx + ((size_t)b * 3072 + ch) * CTX + tc0 : lat + ((size_t)b * 3072 + ch) * SEQ + (tile - 1) * 256 + tc0;
#pragma unroll
                for (int bj = 0; bj < 2; ++bj) { const f32x4 a = acc[ai][bj][m][0] + bs, c = acc[ai][bj][m][1] + bs; u32x4v w;
                    w.x = pg8::cvt_pk_bf16(a[0], a[1]); w.y = pg8::cvt_pk_bf16(a[2], a[3]); w.z = pg8::cvt_pk_bf16(c[0], c[1]); w.w = pg8::cvt_pk_bf16(c[2], c[3]);
                    *(u32x4v*)(dst + bj * 128) = w; } }
    }
};


struct LatOrder : pg8::StaticOrder {
    __device__ bool next(int i, pg8::Unit& u) const { if (!pg8::StaticOrder::next(i, u)) return false; u.pm = (u.pm >> 5) * 33 + 1 + (u.pm & 31); return true; }
};
struct CtxSplitOrder {
    int nk, G, c;
    __device__ bool next(int i, pg8::Unit& u) const { const int L = i * G + c; if (L >= 16 * nk) return false; const int un = L & 15, kc = L >> 4; u.pm = (un >> 2) * 33; u.pn = un & 3; u.kofs = kc * 256; return true; }
    __device__ __forceinline__ void a_ready(const pg8::Unit&) const {}
    __device__ __forceinline__ void done(const pg8::Unit&) const {}
};
struct EpiResidAtomic {
    static constexpr bool PERM = false, AFTER_DRAIN = false;
    float* h; const float* gp; float scale;
    __device__ __forceinline__ void operator()(const f32x4 (&acc)[2][2][4][2], const pg8::Unit& u, int wr, int wc, int fr, int fq) const {
        const int row0 = u.pm * 256 + wr * 64 + fr, col0 = u.pn * 256 + wc * 32 + 4 * fq;
#pragma unroll
        for (int bj = 0; bj < 2; ++bj)
#pragma unroll
            for (int n = 0; n < 2; ++n) { const f32x4 gv = *(const f32x4*)(gp + col0 + bj * 128 + n * 16) * scale;
#pragma unroll
                for (int ai = 0; ai < 2; ++ai)
#pragma unroll
                    for (int m = 0; m < 4; ++m) { float* q = h + (size_t)(row0 + ai * 128 + m * 16) * D + col0 + bj * 128 + n * 16; const f32x4 v = gv * acc[ai][bj][m][n];
                        atomicAdd(q, v[0]); atomicAdd(q + 1, v[1]); atomicAdd(q + 2, v[2]); atomicAdd(q + 3, v[3]); } }
    }
};

__device__ __forceinline__ void ctx_bias_phase(KPC kp, const float* gp, const float* bias) {
    float* h = (float*)(kp->ws + OFF_H);
    for (int i = lbid() * 512 + ltid(); i < NB * CTX * 256; i += gridDim.x * 512) { const int r = i >> 8, c = (i & 255) * 4, b = r >> 8, t = r & 255;
        f32x4* q = (f32x4*)(h + ((size_t)b * TPB + t) * D + c); *q = *q + *(const f32x4*)(gp + c) * *(const f32x4*)(bias + c); }
}
__device__ __forceinline__ int colmap(int n, int mapmode) { return mapmode ? (((n >> 8) << 7) + (n & 127) + ((n >> 7) & 1) * FF) : n; }
__device__ __forceinline__ void convert_T(const float* __restrict__ src, int ld, int K, int Nd, int mapmode, u16* __restrict__ dst, LAS float* tile, int& tctr) {
    const int tid = ltid(), nkt = K / 64, ntile = (Nd / 64) * nkt;
    const int G = (int)gridDim.x; const int first = (((lbid() - tctr) % G) + G) % G; tctr += ntile;
    for (int t = first; t < ntile; t += G) {
        const int n0 = (t / nkt) * 64, k0 = (t % nkt) * 64, c0 = colmap(n0, mapmode);
#pragma unroll
        for (int i = 0; i < 2; ++i) { const int e = tid + 512 * i, kr = e >> 4, c4 = (e & 15) * 4;
            const f32x4 v = *(const f32x4*)(src + (size_t)(k0 + kr) * ld + c0 + c4);
            tile[kr * 65 + c4] = v[0]; tile[kr * 65 + c4 + 1] = v[1]; tile[kr * 65 + c4 + 2] = v[2]; tile[kr * 65 + c4 + 3] = v[3]; }
        __syncthreads();
        { const int n = tid >> 3, k8 = (tid & 7) * 8; u32x4v w;
          w.x = pg8::cvt_pk_bf16(tile[(k8 + 0) * 65 + n], tile[(k8 + 1) * 65 + n]); w.y = pg8::cvt_pk_bf16(tile[(k8 + 2) * 65 + n], tile[(k8 + 3) * 65 + n]);
          w.z = pg8::cvt_pk_bf16(tile[(k8 + 4) * 65 + n], tile[(k8 + 5) * 65 + n]); w.w = pg8::cvt_pk_bf16(tile[(k8 + 6) * 65 + n], tile[(k8 + 7) * 65 + n]);
          *(u32x4v*)(dst + (size_t)(n0 + n) * K + k0 + k8) = w; }
        __syncthreads();
    }
}

__device__ __forceinline__ void norm_phase(KPC kp, int l, int sub, int nkp) {
    const float* h = (const float*)(kp->ws + OFF_H); u16* uo = (u16*)(kp->ws + OFF_U);
    const float* g = kp->in[I_NORMG] + (size_t)(l * 3 + sub) * D; const float* modl = (const float*)(kp->ws + OFF_MOD) + (size_t)l * 5 * 9216;
    const int lane = ltid() & 63, wv = ltid() >> 6;
    for (int T = lbid() * 8 + wv; T < NTOK; T += gridDim.x * 8) {
        const float* hr = h + (size_t)T * D; f32x4 v[4]; float ss = 0.f;
        const int bT = T / TPB, tT = T - bT * TPB; const bool fold = nkp > 0 && tT < CTX;
#pragma unroll
        for (int i = 0; i < 4; ++i) { v[i] = *(const f32x4*)(hr + i * 256 + lane * 4);
            if (fold) { const float* pp = (const float*)kp->out + ((size_t)bT * CTX + tT) * D + i * 256 + lane * 4; for (int kc = 0; kc < nkp; ++kc) v[i] += *(const f32x4*)(pp + (size_t)kc * 1024 * D);
                *(f32x4*)((float*)(kp->ws + OFF_H) + (size_t)T * D + i * 256 + lane * 4) = v[i]; }
            ss += v[i][0] * v[i][0] + v[i][1] * v[i][1] + v[i][2] * v[i][2] + v[i][3] * v[i][3]; }
        ss = wave_sum(ss); const float rs = rsqrtf(ss * (1.0f / D) + 1e-6f);
        const float* mp = modl + (size_t)modrow_of_token(T) * 9216 + sub * 3 * 1024;
#pragma unroll
        for (int i = 0; i < 4; ++i) { const int c = i * 256 + lane * 4; const f32x4 gg = *(const f32x4*)(g + c), sh = *(const f32x4*)(mp + c), sc = *(const f32x4*)(mp + 1024 + c);
            const f32x4 o = v[i] * rs * gg * (sc + 1.0f) + sh; u32x2 w; w.x = pg8::cvt_pk_bf16(o[0], o[1]); w.y = pg8::cvt_pk_bf16(o[2], o[3]);
            *(u32x2*)(uo + (size_t)T * D + c) = w; }
    }
}

__device__ __forceinline__ void final_phase(KPC kp) {
    const float* h = (const float*)(kp->ws + OFF_H); const float* g = kp->in[I_FINALG];
    const int lane = ltid() & 63, wv = ltid() >> 6;
    for (int r = lbid() * 8 + wv; r < NB * SEQ; r += gridDim.x * 8) {
        const int b = r / SEQ, s = r - b * SEQ; const float* hr = h + ((size_t)b * TPB + CTX + s) * D; f32x4 v[4]; float ss = 0.f;
#pragma unroll
        for (int i = 0; i < 4; ++i) { v[i] = *(const f32x4*)(hr + i * 256 + lane * 4); ss += v[i][0] * v[i][0] + v[i][1] * v[i][1] + v[i][2] * v[i][2] + v[i][3] * v[i][3]; }
        ss = wave_sum(ss); const float rs = rsqrtf(ss * (1.0f / D) + 1e-6f);
#pragma unroll
        for (int i = 0; i < 4; ++i) { const int c = i * 256 + lane * 4; *(f32x4*)(kp->out + (size_t)r * D + c) = v[i] * rs * *(const f32x4*)(g + c); }
    }
}

__device__ __forceinline__ void setup_phase(KPC kp, LAS float* ldsf) {
    float* h = (float*)(kp->ws + OFF_H); const int tid = ltid();
    const int hb0 = gridDim.x > 64 ? 32 : 0;
    for (size_t i = (size_t)(lbid() - hb0) * 512 + tid; lbid() >= hb0 && i < (size_t)NTOK * 256; i += (size_t)(gridDim.x - hb0) * 512) {
        const int T = (int)(i >> 8), c = ((int)i & 255) * 4, b = T / TPB, t = T - b * TPB; f32x4 v;
        if (t < CTX) v = *(const f32x4*)(kp->in[I_CTX] + ((size_t)b * CTX + t) * D + c);
        else { const int s = t - CTX; v = *(const f32x4*)(kp->in[I_X] + ((size_t)b * SEQ + s) * D + c);
            const int half = c >> 9, cc = c & 511, isc = cc >> 8, i0 = cc & 255; const float pv = half ? (float)(s & 63) : (float)(s >> 6);
#pragma unroll
            for (int e = 0; e < 4; ++e) { const float om = exp2f(-13.287712379549449f * (float)(i0 + e) * (1.0f / 256.0f)); const float ang = pv * om; v[e] += isc ? __cosf(ang) : __sinf(ang); } }
        *(f32x4*)(h + (size_t)T * D + c) = v;
    }
    LAS float* sc = ldsf; LAS float* red = ldsf + 5 * 1024;
    for (int i = tid; i < 5 * 1024; i += 512) { const int r = i >> 10, k = i & 1023; const float cv = r < 4 ? kp->in[I_C][r * D + k] : kp->in[I_CCTX][k]; sc[i] = siluf(cv); }
    __syncthreads();
    float* mod = (float*)(kp->ws + OFF_MOD); const int lane = tid & 63, wv = tid >> 6;
    for (int task = lbid(); task < 288; task += gridDim.x) {
        const int l = task / 72, n0 = (task % 72) * 128 + lane * 2; const float* w = kp->in[I_ADAW] + (size_t)l * D * 9216 + n0;
        f32x2 a[5];
#pragma unroll
        for (int r = 0; r < 5; ++r) a[r] = (f32x2){0.f, 0.f};
#pragma unroll 16
        for (int k = wv * 128; k < wv * 128 + 128; ++k) { const f32x2 wv2 = *(const f32x2*)(w + (size_t)k * 9216);
#pragma unroll
            for (int r = 0; r < 5; ++r) a[r] += wv2 * sc[r * 1024 + k]; }
#pragma unroll
        for (int r = 0; r < 5; ++r) { red[(wv * 5 + r) * 128 + lane * 2] = a[r][0]; red[(wv * 5 + r) * 128 + lane * 2 + 1] = a[r][1]; }
        __syncthreads();
        for (int i = tid; i < 640; i += 512) { const int r = i >> 7, n = i & 127; float s = 0.f;
#pragma unroll
            for (int w8 = 0; w8 < 8; ++w8) s += red[(w8 * 5 + r) * 128 + n];
            const int nn = (task % 72) * 128 + n; mod[((size_t)l * 5 + r) * 9216 + nn] = s + kp->in[I_ADAB][(size_t)l * 9216 + nn]; }
        __syncthreads();
    }
}

__device__ __forceinline__ void convert_layer(KPC kp, int l, LAS float* tile) {
    unsigned char* wb = kp->ws + OFF_WB; int tctr = 0; const int j = l >> 1;
    for (int f = 0; f < 2; ++f) {
        convert_T(kp->in[I_FFNIN] + (size_t)(l * 2 + f) * D * 2 * FF, 2 * FF, D, 2 * FF, 1, (u16*)(wb + (f ? WB_FIN1 : WB_FIN0)), tile, tctr);
        convert_T(kp->in[I_FFNOUT] + (size_t)(l * 2 + f) * FF * D, D, FF, D, 0, (u16*)(wb + (f ? WB_FOUT1 : WB_FOUT0)), tile, tctr);
    }
    if ((l & 1) == 0) {
        convert_T(kp->in[I_HYWIN] + (size_t)j * D * 3 * D, 3 * D, D, 3 * D, 0, (u16*)(wb + WB_MIN), tile, tctr);
        convert_T(kp->in[I_HYWOUT] + (size_t)j * D * D, D, D, D, 0, (u16*)(wb + WB_MOUT), tile, tctr);
    } else {
        convert_T(kp->in[I_MLUP] + (size_t)j * D * 2 * INNER, 2 * INNER, D, 2 * INNER, 0, (u16*)(wb + WB_MIN), tile, tctr);
        convert_T(kp->in[I_MLDOWN] + (size_t)j * INNER * D, D, INNER, D, 0, (u16*)(wb + WB_MOUT), tile, tctr);
        u16* wg = (u16*)(wb + WB_WGT); const float* src = kp->in[I_MLWG] + (size_t)j * 3 * INNER * 16;
        for (int i = lbid() * 512 + ltid(); i < 16 * 3 * INNER; i += gridDim.x * 512) { const int o = i / (3 * INNER), k = i - o * 3 * INNER; wg[i] = f2bf(src[(size_t)k * 16 + o]); }
        float* gates = (float*)(kp->ws + OFF_GATES); const float* bg = kp->in[I_MLBG] + j * 16;
        for (int i = lbid() * 512 + ltid(); i < NTOK * 16; i += gridDim.x * 512) gates[i] = bg[i & 15];
    }
}

constexpr size_t HY_PL = 0, HY_PC = (size_t)NB * 3072 * SEQ * 2, HY_YL = HY_PC + (size_t)NB * 3072 * CTX * 2, HY_YC = HY_YL + (size_t)NB * D * SEQ * 2;
__device__ __forceinline__ int fphys(int i) { return i ^ ((((i >> 6) & 1) * 21) ^ (((i >> 5) & 1) * 10)); }
__device__ __forceinline__ f32x2 cmul(f32x2 a, f32x2 b) { return (f32x2){a.x * b.x - a.y * b.y, a.x * b.y + a.y * b.x}; }
__device__ __forceinline__ f32x2 cmulc(f32x2 a, f32x2 b) { return (f32x2){a.x * b.x + a.y * b.y, a.y * b.x - a.x * b.y}; }
__device__ __forceinline__ int drev(int x) { const unsigned r = __brev((unsigned)x) >> 18; return (int)(((r & 0x2AAAu) >> 1) | ((r & 0x1555u) << 1)); }

__device__ __forceinline__ void fidx4(int base, int lm, int (&ix)[4]) {
    const int m = 1 << lm;
    if (lm == 6) { const int i0 = fphys(base); ix[0] = i0; ix[1] = (i0 + 64) ^ 21; ix[2] = i0 + 128; ix[3] = (i0 + 192) ^ 21; }
    else if (lm == 4) { const int c6 = ((base >> 6) & 1) * 21; ix[0] = base ^ c6; ix[1] = (base + 16) ^ c6; ix[2] = (base + 32) ^ c6 ^ 10; ix[3] = (base + 48) ^ c6 ^ 10; }
    else { const int c = (((base >> 6) & 1) * 21) ^ (((base >> 5) & 1) * 10); ix[0] = base ^ c; ix[1] = (base + m) ^ c; ix[2] = (base + 2 * m) ^ c; ix[3] = (base + 3 * m) ^ c; }
}
__device__ __forceinline__ void fft_fwd(LAS f32x2* buf, const f32x2* Kmul = nullptr, bool zpad = false) {
    const int tid = ltid();
    for (int lm = 12; lm >= 0; lm -= 2) {
        const int m = 1 << lm; const float inv = 1.0f / (float)(4 << lm);
        f32x2 a[8][4]; int ix[8][4];
#pragma unroll
        for (int i = 0; i < 8; ++i) { const int g = tid + 512 * i, p = g & (m - 1), base = ((g >> lm) << (lm + 2)) + p; fidx4(base, lm, ix[i]);
            if (zpad && lm == 12) { a[i][0] = buf[ix[i][0]]; a[i][1] = buf[ix[i][1]]; a[i][2] = (f32x2){0.f, 0.f}; a[i][3] = (f32x2){0.f, 0.f}; }
            else {
#pragma unroll
                for (int r = 0; r < 4; ++r) a[i][r] = buf[ix[i][r]]; } }
#pragma unroll
        for (int i = 0; i < 8; ++i) { const int p = (tid + 512 * i) & (m - 1);
            const f32x2 t0 = a[i][0] + a[i][2], t1 = a[i][0] - a[i][2], t2 = a[i][1] + a[i][3], dd = a[i][1] - a[i][3], t3 = (f32x2){dd.y, -dd.x};
            if (lm == 0) {
                f32x2 y0 = t0 + t2, y1 = t1 + t3, y2 = t0 - t2, y3 = t1 - t3;
                if (Kmul) { const f32x4 ka = *(const f32x4*)(Kmul + 4 * (tid + 512 * i)), kb = *(const f32x4*)(Kmul + 4 * (tid + 512 * i) + 2);
                    y0 = cmul(y0, (f32x2){ka[0], ka[1]}); y1 = cmul(y1, (f32x2){ka[2], ka[3]}); y2 = cmul(y2, (f32x2){kb[0], kb[1]}); y3 = cmul(y3, (f32x2){kb[2], kb[3]}); }
                buf[ix[i][0]] = y0; buf[ix[i][1]] = y1; buf[ix[i][2]] = y2; buf[ix[i][3]] = y3; }
            else { const float rev = (float)p * inv;
                const f32x2 w1 = (f32x2){__builtin_amdgcn_cosf(rev), -__builtin_amdgcn_sinf(rev)}, w2 = cmul(w1, w1), w3 = cmul(w2, w1);
                buf[ix[i][0]] = t0 + t2; buf[ix[i][1]] = cmul(t1 + t3, w1); buf[ix[i][2]] = cmul(t0 - t2, w2); buf[ix[i][3]] = cmul(t1 - t3, w3); } }
        __syncthreads();
    }
}
__device__ __forceinline__ void fft_inv(LAS f32x2* buf, bool half = false) {
    const int tid = ltid();
    for (int lm = 0; lm <= 12; lm += 2) {
        const int m = 1 << lm; const float inv = 1.0f / (float)(4 << lm);
        f32x2 a[8][4]; int ix[8][4];
#pragma unroll
        for (int i = 0; i < 8; ++i) { const int g = tid + 512 * i, p = g & (m - 1), base = ((g >> lm) << (lm + 2)) + p; fidx4(base, lm, ix[i]);
#pragma unroll
            for (int r = 0; r < 4; ++r) a[i][r] = buf[ix[i][r]]; }
#pragma unroll
        for (int i = 0; i < 8; ++i) { const int p = (tid + 512 * i) & (m - 1);
            f32x2 b0 = a[i][0], b1 = a[i][1], b2 = a[i][2], b3 = a[i][3];
            if (lm != 0) { const float rev = (float)p * inv;
                const f32x2 w1 = (f32x2){__builtin_amdgcn_cosf(rev), -__builtin_amdgcn_sinf(rev)}, w2 = cmul(w1, w1), w3 = cmul(w2, w1);
                b1 = cmulc(b1, w1); b2 = cmulc(b2, w2); b3 = cmulc(b3, w3); }
            const f32x2 s0 = b0 + b2, s1 = b0 - b2, s2 = b1 + b3, dd = b1 - b3, s3 = (f32x2){-dd.y, dd.x};
            buf[ix[i][0]] = s0 + s2; buf[ix[i][1]] = s1 + s3; if (!(half && lm == 12)) { buf[ix[i][2]] = s0 - s2; buf[ix[i][3]] = s1 - s3; } }
        __syncthreads();
    }
}

__device__ __forceinline__ void hy_mlp_phase(KPC kp, int j) {
    float* h2 = (float*)(kp->ws + OFF_H2);
    const float* w1 = kp->in[I_HYW1] + j * 33 * 64; const float* b1 = kp->in[I_HYB1] + j * 64; const float* w2 = kp->in[I_HYW2] + j * 64 * 64; const float* b2 = kp->in[I_HYB2] + j * 64;
    const float* fr = kp->in[I_HYFREQ] + j * 128; const int lane = ltid() & 63, wv = ltid() >> 6;
    for (int pos = lbid() * 8 + wv; pos < SEQ + CTX; pos += gridDim.x * 8) {
        const int n = pos < SEQ ? SEQ : CTX, t = pos < SEQ ? pos : pos - SEQ; const float tn = (float)t / (float)(n - 1);
        float feat = 0.f;
        if (lane == 0) feat = tn;
        else if (lane < 33) { const int bi = (lane - 1) & 15; const float band = 1e-4f + (float)bi * ((15.0f - 1e-4f) / 15.0f); float rev = ((float)t / (float)n) * band; rev -= floorf(rev);
            const float ang = 6.283185307179586f * rev; feat = lane < 17 ? cosf(ang) : -sinf(ang); }
        float z = b1[lane];
        for (int i = 0; i < 33; ++i) z += lshfl(feat, i) * w1[i * 64 + lane];
        const float h1 = sinf(fr[lane] * z);
        float z2 = b2[lane];
        for (int v = 0; v < 64; ++v) z2 += lshfl(h1, v) * w2[v * 64 + lane];
        h2[(size_t)pos * 64 + lane] = sinf(fr[64 + lane] * z2);
    }
}

__device__ __forceinline__ void block_sum2(float& a, float& b, LAS float* red) {
    a = wave_sum(a); b = wave_sum(b); const int lane = ltid() & 63, wv = ltid() >> 6;
    __syncthreads(); if (lane == 0) { red[wv] = a; red[8 + wv] = b; } __syncthreads();
    float sa = 0.f, sb = 0.f;
#pragma unroll
    for (int i = 0; i < 8; ++i) { sa += red[i]; sb += red[8 + i]; }
    a = sa; b = sb;
}

__device__ __forceinline__ void hy_filter_task(KPC kp, int j, int task, LAS f32x2* buf, LAS float* aux) {
    const int tid = ltid(), d = task & 1023; const bool lat = task < 1024;
    const float* w3 = kp->in[I_HYW3] + (size_t)j * 64 * 4096; const float* b3 = kp->in[I_HYB3] + j * 4096; const float* ldc = kp->in[I_HYDECAY] + j * 4096;
    __syncthreads();
    if (tid < 256) aux[tid] = w3[(size_t)(tid & 63) * 4096 + (tid >> 6) * 1024 + d];
    if (tid < 4) { aux[256 + tid] = b3[tid * 1024 + d]; aux[260 + tid] = __expf(ldc[tid * 1024 + d]); }
    __syncthreads();
    const float* h2 = (const float*)(kp->ws + OFF_H2);
    float ss0 = 0.f, ss1 = 0.f;
    if (lat) {
        for (int r = 0; r < 16; ++r) { const int i = tid + 512 * r; float a0 = aux[256], a1 = aux[257], a2 = aux[258], a3 = aux[259];
#pragma unroll 4
            for (int u4 = 0; u4 < 16; ++u4) { const f32x4 hv = *(const f32x4*)(h2 + (size_t)i * 64 + u4 * 4);
                const f32x4 q0 = *(const LAS f32x4*)(aux + u4 * 4), q1 = *(const LAS f32x4*)(aux + 64 + u4 * 4), q2 = *(const LAS f32x4*)(aux + 128 + u4 * 4), q3 = *(const LAS f32x4*)(aux + 192 + u4 * 4);
#pragma unroll
                for (int e = 0; e < 4; ++e) { a0 += hv[e] * q0[e]; a1 += hv[e] * q1[e]; a2 += hv[e] * q2[e]; a3 += hv[e] * q3[e]; } }
            const float tn = (float)i * (1.0f / 8191.0f);
            a0 *= __expf(-tn * aux[260]); a1 *= __expf(-tn * aux[261]); a2 *= __expf(-tn * aux[262]); a3 *= __expf(-tn * aux[263]);
            buf[fphys(i)] = (f32x2){a0, a2}; ss0 += a0 * a0; ss1 += a2 * a2;
            if (i >= 1) { buf[fphys(NFFT - i)] = (f32x2){a1, a3}; ss0 += a1 * a1; ss1 += a3 * a3; } }
        if (tid == 0) buf[fphys(SEQ)] = (f32x2){0.f, 0.f};
        block_sum2(ss0, ss1, aux + 272);
        const f32x2 scl = (f32x2){rsqrtf(ss0 + 1e-12f) * (1.0f / NFFT), rsqrtf(ss1 + 1e-12f) * (1.0f / NFFT)};
        fft_fwd(buf);
        f32x2* K0 = (f32x2*)(kp->ws + OFF_R2) + (size_t)d * NFFT; f32x2* K1 = (f32x2*)kp->out + (size_t)d * NFFT;
        for (int r = 0; r < 32; ++r) { const int pos = tid + 512 * r, k = drev(pos), pos2 = drev((NFFT - k) & (NFFT - 1)); const f32x2 Z = buf[fphys(pos)], Z2 = buf[fphys(pos2)];
            K0[pos] = (f32x2){(Z.x + Z2.x), (Z.y - Z2.y)} * (0.5f * scl.x); K1[pos] = (f32x2){(Z.y + Z2.y), -(Z.x - Z2.x)} * (0.5f * scl.y); }
    } else {
        const int idx = tid; float a0 = 0.f, a1 = 0.f;
        if (idx != CTX) { const int t = idx < CTX ? idx : 2 * CTX - idx, dir = idx < CTX ? 0 : 1; a0 = aux[256 + dir]; a1 = aux[258 + dir];
            for (int u4 = 0; u4 < 16; ++u4) { const f32x4 hv = *(const f32x4*)(h2 + (size_t)(SEQ + t) * 64 + u4 * 4);
#pragma unroll
                for (int e = 0; e < 4; ++e) { const int u = u4 * 4 + e; a0 += hv[e] * aux[dir * 64 + u]; a1 += hv[e] * aux[128 + dir * 64 + u]; } }
            const float tn = (float)t * (1.0f / 255.0f); a0 *= __expf(-tn * aux[260 + dir]); a1 *= __expf(-tn * aux[262 + dir]); }
        ss0 = a0 * a0; ss1 = a1 * a1;
        block_sum2(ss0, ss1, aux + 272);
        float* kc = (float*)(kp->ws + OFF_KCTX);
        kc[(size_t)d * 512 + idx] = a0 * rsqrtf(ss0 + 1e-12f); kc[(size_t)(1024 + d) * 512 + idx] = a1 * rsqrtf(ss1 + 1e-12f);
    }
}

__device__ __forceinline__ float ld3(const u16* row, int t, int n, float wa, float wb, float wc, float bias) {
    const float xm = t > 0 ? bf2f(row[t - 1]) : 0.f, x0 = bf2f(row[t]), xp = t < n - 1 ? bf2f(row[t + 1]) : 0.f; return wa * xm + wb * x0 + wc * xp + bias; }

__device__ __forceinline__ void ld3x8(const u16* row, int t0, float wa, float wb, float wc, float bias, float (&o)[8]) {
    const u32x4v w = *(const u32x4v*)(row + t0);
    const float x0 = bflo(w.x), x1 = bfhi(w.x), x2 = bflo(w.y), x3 = bfhi(w.y), x4 = bflo(w.z), x5 = bfhi(w.z), x6 = bflo(w.w), x7 = bfhi(w.w);
    const float xl = t0 > 0 ? bf2f(row[t0 - 1]) : 0.f, xr = t0 + 8 < SEQ ? bf2f(row[t0 + 8]) : 0.f;
    o[0] = wa * xl + wb * x0 + wc * x1 + bias; o[1] = wa * x0 + wb * x1 + wc * x2 + bias; o[2] = wa * x1 + wb * x2 + wc * x3 + bias; o[3] = wa * x2 + wb * x3 + wc * x4 + bias;
    o[4] = wa * x3 + wb * x4 + wc * x5 + bias; o[5] = wa * x4 + wb * x5 + wc * x6 + bias; o[6] = wa * x5 + wb * x6 + wc * x7 + bias; o[7] = wa * x6 + wb * x7 + wc * xr + bias;
}
__device__ __forceinline__ void hy_conv_lat(KPC kp, int j, int task, LAS f32x2* buf) {
    const int tid = ltid(), bp = task >> 10, c = task & 1023, b0 = bp * 2;
    const u16* pl = (const u16*)(kp->ws + OFF_R1 + HY_PL); u16* yl = (u16*)(kp->ws + OFF_R1 + HY_YL);
    const float* cw = kp->in[I_HYCW] + (size_t)j * 3 * 3072; const float* cb = kp->in[I_HYCB] + j * 3072;
    const float w1a = cw[c], w1b = cw[3072 + c], w1c = cw[6144 + c], bb1 = cb[c];
    const float w2a = cw[1024 + c], w2b = cw[3072 + 1024 + c], w2c = cw[6144 + 1024 + c], bb2 = cb[1024 + c];
    const float w3a = cw[2048 + c], w3b = cw[3072 + 2048 + c], w3c = cw[6144 + 2048 + c], bb3 = cb[2048 + c];
    const float sk0 = kp->in[I_HYSKIP][j * 2048 + c], sk1 = kp->in[I_HYSKIP][j * 2048 + 1024 + c];
    const u16* x1r0 = pl + ((size_t)b0 * 3072 + c) * SEQ; const u16* x1r1 = x1r0 + (size_t)3072 * SEQ;
    const u16* x2r0 = x1r0 + (size_t)1024 * SEQ; const u16* x2r1 = x1r1 + (size_t)1024 * SEQ;
    const u16* vr0 = x1r0 + (size_t)2048 * SEQ; const u16* vr1 = x1r1 + (size_t)2048 * SEQ;
    const f32x2* K0 = (const f32x2*)(kp->ws + OFF_R2) + (size_t)c * NFFT; const f32x2* K1 = (const f32x2*)kp->out + (size_t)c * NFFT;
    __syncthreads();
#pragma unroll
    for (int g = 0; g < 2; ++g) { const int t0 = 8 * (tid + 512 * g); float v0[8], v1[8];
        ld3x8(vr0, t0, w3a, w3b, w3c, bb3, v0); ld3x8(vr1, t0, w3a, w3b, w3c, bb3, v1);
#pragma unroll
        for (int e = 0; e < 8; ++e) buf[fphys(t0 + e)] = (f32x2){v0[e], v1[e]}; }
    __syncthreads();
#ifdef PROBE_FFT
    for (int rp = 0; rp < PROBE_FFT; ++rp) { fft_fwd(buf); fft_inv(buf); for (int r = 0; r < 32; ++r) { const int q = fphys(tid + 512 * r); buf[q] = buf[q] * (1.0f / NFFT); } __syncthreads(); }
#endif
    fft_fwd(buf, K0, true);
    fft_inv(buf, true);
    float zr[32];
#pragma unroll
    for (int g = 0; g < 2; ++g) { const int t0 = 8 * (tid + 512 * g); float v0[8], v1[8], xa[8], xb[8];
        ld3x8(vr0, t0, w3a, w3b, w3c, bb3, v0); ld3x8(vr1, t0, w3a, w3b, w3c, bb3, v1); ld3x8(x1r0, t0, w1a, w1b, w1c, bb1, xa); ld3x8(x1r1, t0, w1a, w1b, w1c, bb1, xb);
#pragma unroll
        for (int e = 0; e < 8; ++e) { const f32x2 y = buf[fphys(t0 + e)]; const float z0 = xa[e] * (y.x + sk0 * v0[e]), z1 = xb[e] * (y.y + sk0 * v1[e]);
            zr[g * 16 + 2 * e] = z0; zr[g * 16 + 2 * e + 1] = z1; buf[fphys(t0 + e)] = (f32x2){z0, z1}; } }
    __syncthreads();
    fft_fwd(buf, K1, true);
    fft_inv(buf, true);
#pragma unroll
    for (int g = 0; g < 2; ++g) { const int t0 = 8 * (tid + 512 * g); float xa[8], xb[8], o0[8], o1[8];
        ld3x8(x2r0, t0, w2a, w2b, w2c, bb2, xa); ld3x8(x2r1, t0, w2a, w2b, w2c, bb2, xb);
#pragma unroll
        for (int e = 0; e < 8; ++e) { const f32x2 y = buf[fphys(t0 + e)]; o0[e] = xa[e] * (y.x + sk1 * zr[g * 16 + 2 * e]); o1[e] = xb[e] * (y.y + sk1 * zr[g * 16 + 2 * e + 1]); }
        *(u32x4v*)(yl + ((size_t)b0 * D + c) * SEQ + t0) = pack8(o0); *(u32x4v*)(yl + ((size_t)(b0 + 1) * D + c) * SEQ + t0) = pack8(o1); }
}

__device__ __forceinline__ void hy_conv_ctx(KPC kp, int j, int c, LAS float* ls) {
    const int tid = ltid();
    const u16* pc = (const u16*)(kp->ws + OFF_R1 + HY_PC); u16* yc = (u16*)(kp->ws + OFF_R1 + HY_YC); const float* kc = (const float*)(kp->ws + OFF_KCTX);
    const float* cw = kp->in[I_HYCW] + (size_t)j * 3 * 3072; const float* cb = kp->in[I_HYCB] + j * 3072;
    const float w1a = cw[c], w1b = cw[3072 + c], w1c = cw[6144 + c], bb1 = cb[c];
    const float w2a = cw[1024 + c], w2b = cw[3072 + 1024 + c], w2c = cw[6144 + 1024 + c], bb2 = cb[1024 + c];
    const float w3a = cw[2048 + c], w3b = cw[3072 + 2048 + c], w3c = cw[6144 + 2048 + c], bb3 = cb[2048 + c];
    const float sk0 = kp->in[I_HYSKIP][j * 2048 + c], sk1 = kp->in[I_HYSKIP][j * 2048 + 1024 + c];
    __syncthreads();
    ls[tid] = kc[(size_t)c * 512 + tid]; ls[512 + tid] = kc[(size_t)(1024 + c) * 512 + tid];
    for (int i = 0; i < 2; ++i) { const int e = tid + 512 * i, b = e >> 8, t = e & 255; ls[1024 + e] = ld3(pc + ((size_t)b * 3072 + 2048 + c) * CTX, t, CTX, w3a, w3b, w3c, bb3); }
    __syncthreads();
    const int cb_ = tid >> 6, t0 = (tid & 63) * 4; const bool act = tid < 256;
    auto conv4 = [&](int kofs, int xofs, float (&acc)[4]) {
        float w[7];
#pragma unroll
        for (int i = 0; i < 7; ++i) w[i] = ls[kofs + ((t0 + 3 - i) & 511)];
        acc[0] = acc[1] = acc[2] = acc[3] = 0.f;
        for (int s = 0; s < CTX; s += 4) { const f32x4 v4 = *(const LAS f32x4*)(ls + xofs + cb_ * 256 + s);
#pragma unroll
            for (int cc = 0; cc < 4; ++cc)
#pragma unroll
                for (int a = 0; a < 4; ++a) acc[a] += w[3 - a + cc] * v4[cc];
            w[0] = w[4]; w[1] = w[5]; w[2] = w[6];
#pragma unroll
            for (int i = 3; i < 7; ++i) w[i] = ls[kofs + ((t0 + 3 - (s + 4) - i) & 511)]; } };
    float zr[4] = {0.f, 0.f, 0.f, 0.f};
    if (act) { float acc[4]; conv4(0, 1024, acc);
#pragma unroll
        for (int a = 0; a < 4; ++a) zr[a] = ld3(pc + ((size_t)cb_ * 3072 + c) * CTX, t0 + a, CTX, w1a, w1b, w1c, bb1) * (acc[a] + sk0 * ls[1024 + cb_ * 256 + t0 + a]);
        *(LAS f32x4*)(ls + 2048 + cb_ * 256 + t0) = (f32x4){zr[0], zr[1], zr[2], zr[3]}; }
    __syncthreads();
    if (act) { float acc[4]; conv4(512, 2048, acc); float o[4];
#pragma unroll
        for (int a = 0; a < 4; ++a) o[a] = ld3(pc + ((size_t)cb_ * 3072 + 1024 + c) * CTX, t0 + a, CTX, w2a, w2b, w2c, bb2) * (acc[a] + sk1 * zr[a]);
        u32x2 w; w.x = pg8::cvt_pk_bf16(o[0], o[1]); w.y = pg8::cvt_pk_bf16(o[2], o[3]); *(u32x2*)(yc + ((size_t)cb_ * D + c) * CTX + t0) = w; }
}

__device__ __forceinline__ void hy_transpose(KPC kp, LAS u16* tl) {
    const u16* yl = (const u16*)(kp->ws + OFF_R1 + HY_YL); const u16* yc = (const u16*)(kp->ws + OFF_R1 + HY_YC); u16* y = (u16*)(kp->ws + OFF_U); const int tid = ltid();
    for (int tile = lbid(); tile < NB * 16 * NCH; tile += gridDim.x) {
        const int b = tile / (16 * NCH), rem = tile - b * 16 * NCH, ct = rem / NCH, tt = rem - ct * NCH;
        const u16* src = tt < 4 ? yc + ((size_t)b * D + ct * 64) * CTX + tt * 64 : yl + ((size_t)b * D + ct * 64) * SEQ + (tt - 4) * 64; const int ld = tt < 4 ? CTX : SEQ;
        { const int cr = tid >> 3, t8 = (tid & 7) * 8; *(LAS u32x4v*)(tl + cr * 72 + t8) = *(const u32x4v*)(src + (size_t)cr * ld + t8); }
        __syncthreads();
        { const int tr = tid >> 3, c8 = (tid & 7) * 8; u32x4v w;
          w.x = (unsigned)tl[(c8 + 0) * 72 + tr] | ((unsigned)tl[(c8 + 1) * 72 + tr] << 16); w.y = (unsigned)tl[(c8 + 2) * 72 + tr] | ((unsigned)tl[(c8 + 3) * 72 + tr] << 16);
          w.z = (unsigned)tl[(c8 + 4) * 72 + tr] | ((unsigned)tl[(c8 + 5) * 72 + tr] << 16); w.w = (unsigned)tl[(c8 + 6) * 72 + tr] | ((unsigned)tl[(c8 + 7) * 72 + tr] << 16);
          *(u32x4v*)(y + ((size_t)b * TPB + tt * 64 + tr) * D + ct * 64 + c8) = w; }
        __syncthreads();
    }
}

constexpr size_t OFF_XM = OFF_R1, OFF_XC = OFF_R1 + 132 * MiB, OFF_S = WS_NEED, OFF_MLM = OFF_S + 34 * MiB, WS_NEED2 = OFF_MLM + 1 * MiB;
__device__ __forceinline__ u16* hb_ptr(KPC kp, int T) { const int b = T / TPB, t = T - b * TPB;
    return t < CTX ? (u16*)(kp->ws + OFF_HBC) + ((size_t)b * CTX + t) * INNER : (u16*)kp->out + ((size_t)b * SEQ + (t - CTX)) * INNER; }
__device__ __forceinline__ void bd8(const float (&x)[8], const float (&w)[32], float (&y)[8]) {
#pragma unroll
    for (int bl = 0; bl < 2; ++bl)
#pragma unroll
        for (int e = 0; e < 4; ++e) { float s = 0.f;
#pragma unroll
            for (int d = 0; d < 4; ++d) s += x[bl * 4 + d] * w[bl * 16 + d * 4 + e];
            y[bl * 4 + e] = s; }
}
typedef float f32x8s __attribute__((ext_vector_type(8)));
__device__ __forceinline__ void sload32(const float* p, float (&w)[32]) {
    f32x8s a, b, c, d;
    asm volatile("s_load_dwordx8 %0, %4, 0x0\n\ts_load_dwordx8 %1, %4, 0x20\n\ts_load_dwordx8 %2, %4, 0x40\n\ts_load_dwordx8 %3, %4, 0x60\n\ts_waitcnt lgkmcnt(0)"
                 : "=&s"(a), "=&s"(b), "=&s"(c), "=&s"(d) : "s"(p) : "memory");
#pragma unroll
    for (int i = 0; i < 8; ++i) { w[i] = a[i]; w[8 + i] = b[i]; w[16 + i] = c[i]; w[24 + i] = d[i]; }
}
__device__ __forceinline__ void ldw32(const float* p, float (&w)[32]) {
#pragma unroll
    for (int i = 0; i < 8; ++i) { const f32x4 v = *(const f32x4*)(p + i * 4); w[i * 4] = v[0]; w[i * 4 + 1] = v[1]; w[i * 4 + 2] = v[2]; w[i * 4 + 3] = v[3]; } }

__device__ __forceinline__ void ml_m_phase(KPC kp, int j) {
    float* M = (float*)(kp->ws + OFF_MLM) + (size_t)j * 8192;
    const float* wq = kp->in[I_MLWQ] + (size_t)j * 512 * 16; const float* wk = kp->in[I_MLWK] + (size_t)j * 512 * 16;
    for (int i = lbid() * 512 + ltid(); i < 512 * 16; i += gridDim.x * 512) { const int blk = i >> 4, d = (i >> 2) & 3, d2 = i & 3; float s = 0.f;
#pragma unroll
        for (int e = 0; e < 4; ++e) s += wq[blk * 16 + d * 4 + e] * wk[blk * 16 + d2 * 4 + e];
        M[i] = s * 0.04419417382415922f; }
}

__device__ __forceinline__ void ml_prep_task(KPC kp, int j, int task, LAS unsigned char* lds) {
    const int tid = ltid(), lane = tid & 63, wv = tid >> 6, fr = lane & 15, fq = lane >> 4;
    const int hd = task & 3, bc = task >> 2, b = bc / NCH, ci = bc - b * NCH;
    const u16* xm = (const u16*)(kp->ws + OFF_XM); u16* xc = (u16*)(kp->ws + OFF_XC);
    const int T0 = b * TPB + ci * 64, tlo = b * TPB + (ci < 4 ? 0 : CTX), thi = b * TPB + (ci < 4 ? CTX - 1 : TPB - 1);
    const int ch0 = hd * DH + lane * 8;
    LAS u16* QS = (LAS u16*)lds; LAS u16* KS = (LAS u16*)(lds + 66560);
    const float* cw = kp->in[I_MLCW] + (size_t)j * 3 * INNER; const float* cb = kp->in[I_MLCB] + (size_t)j * INNER;
    __syncthreads();
    {
        float cwa[8], cwb[8], cwc[8], cbb[8], wq[32], wk[32];
#pragma unroll
        for (int e4 = 0; e4 < 2; ++e4) { const f32x4 va = *(const f32x4*)(cw + ch0 + 4 * e4), vb = *(const f32x4*)(cw + INNER + ch0 + 4 * e4), vc = *(const f32x4*)(cw + 2 * INNER + ch0 + 4 * e4), vd = *(const f32x4*)(cb + ch0 + 4 * e4);
#pragma unroll
            for (int e = 0; e < 4; ++e) { cwa[4 * e4 + e] = va[e]; cwb[4 * e4 + e] = vb[e]; cwc[4 * e4 + e] = vc[e]; cbb[4 * e4 + e] = vd[e]; } }
        ldw32(kp->in[I_MLWQ] + ((size_t)j * 512 + (ch0 >> 2)) * 16, wq); ldw32(kp->in[I_MLWK] + ((size_t)j * 512 + (ch0 >> 2)) * 16, wk);
        for (int r = 0; r < 8; ++r) { const int jj = wv + 8 * r, T = T0 + jj; const u16* p = xm + (size_t)T * INNER + ch0;
            float x0[8], xa[8], xb[8], xcv[8], q[8], k[8];
            unpack8(*(const u32x4v*)p, x0);
            if (T > tlo) unpack8(*(const u32x4v*)(p - INNER), xa); else {
#pragma unroll
                for (int e = 0; e < 8; ++e) xa[e] = 0.f; }
            if (T < thi) unpack8(*(const u32x4v*)(p + INNER), xb); else {
#pragma unroll
                for (int e = 0; e < 8; ++e) xb[e] = 0.f; }
#pragma unroll
            for (int e = 0; e < 8; ++e) xcv[e] = siluf(cwa[e] * xa[e] + cwb[e] * x0[e] + cwc[e] * xb[e] + cbb[e]);
            const u32x4v xw = pack8(xcv); *(u32x4v*)(xc + (size_t)T * INNER + ch0) = xw; unpack8(xw, xcv);
            bd8(xcv, wq, q); bd8(xcv, wk, k);
            *(LAS u32x4v*)(QS + jj * 520 + lane * 8) = pack8(q); *(LAS u32x4v*)(KS + jj * 520 + lane * 8) = pack8(k); }
    }
    __syncthreads();
    const u16* wg = (const u16*)(kp->ws + OFF_WB + WB_WGT);
    const int mt = wv & 3, kh = wv >> 2;
    { f32x4 s0 = {0.f, 0.f, 0.f, 0.f}, s1 = {0.f, 0.f, 0.f, 0.f}; const int nt0 = kh * 2;
      for (int ks = 0; ks < 16; ++ks) { const bf16x8 a = *(const LAS bf16x8*)(QS + (16 * mt + fr) * 520 + 32 * ks + 8 * fq);
          const bf16x8 b0 = *(const LAS bf16x8*)(KS + (16 * nt0 + fr) * 520 + 32 * ks + 8 * fq), b1 = *(const LAS bf16x8*)(KS + (16 * (nt0 + 1) + fr) * 520 + 32 * ks + 8 * fq);
          s0 = __builtin_amdgcn_mfma_f32_16x16x32_bf16(a, b0, s0, 0, 0, 0); s1 = __builtin_amdgcn_mfma_f32_16x16x32_bf16(a, b1, s1, 0, 0, 0); }
      float* S = (float*)(kp->ws + OFF_S) + ((size_t)(b * 4 + hd) * NCH + ci) * 4096;
#pragma unroll
      for (int r = 0; r < 4; ++r) { S[(16 * mt + 4 * fq + r) * 64 + 16 * nt0 + fr] = s0[r]; S[(16 * mt + 4 * fq + r) * 64 + 16 * (nt0 + 1) + fr] = s1[r]; } }
    f32x4 ga = {0.f, 0.f, 0.f, 0.f};
    for (int ks = kh * 8; ks < kh * 8 + 8; ++ks) { const int kk = hd * DH + 32 * ks + 8 * fq;
        const bf16x8 a = *(const LAS bf16x8*)(QS + (16 * mt + fr) * 520 + 32 * ks + 8 * fq), a2 = *(const LAS bf16x8*)(KS + (16 * mt + fr) * 520 + 32 * ks + 8 * fq);
        const bf16x8 bq = *(const bf16x8*)(wg + (size_t)fr * 6144 + kk), bk = *(const bf16x8*)(wg + (size_t)fr * 6144 + INNER + kk);
        ga = __builtin_amdgcn_mfma_f32_16x16x32_bf16(a, bq, ga, 0, 0, 0); ga = __builtin_amdgcn_mfma_f32_16x16x32_bf16(a2, bk, ga, 0, 0, 0); }
    __syncthreads();
    {
        float wvv[32]; ldw32(kp->in[I_MLWV] + ((size_t)j * 512 + (ch0 >> 2)) * 16, wvv);
        for (int r = 0; r < 8; ++r) { const int jj = wv + 8 * r, T = T0 + jj; float x0[8], v[8]; unpack8(*(const u32x4v*)(xm + (size_t)T * INNER + ch0), x0); bd8(x0, wvv, v);
            *(LAS u32x4v*)(QS + jj * 520 + lane * 8) = pack8(v); }
    }
    __syncthreads();
    for (int ks = kh * 8; ks < kh * 8 + 8; ++ks) { const int kk = hd * DH + 32 * ks + 8 * fq;
        const bf16x8 a = *(const LAS bf16x8*)(QS + (16 * mt + fr) * 520 + 32 * ks + 8 * fq); const bf16x8 bv = *(const bf16x8*)(wg + (size_t)fr * 6144 + 2 * INNER + kk);
        ga = __builtin_amdgcn_mfma_f32_16x16x32_bf16(a, bv, ga, 0, 0, 0); }
    float* gates = (float*)(kp->ws + OFF_GATES);
#pragma unroll
    for (int r = 0; r < 4; ++r) atomicAdd(gates + (size_t)(T0 + 16 * mt + 4 * fq + r) * 16 + fr, ga[r]);
}

__device__ __forceinline__ void tr_store8(LAS unsigned char* base, int d0, const unsigned (&w)[4], int lane) {
    const int odd = lane & 1, sp = lane & ~1;
#pragma unroll
    for (int i = 0; i < 4; ++i) { const unsigned pw = (unsigned)__builtin_amdgcn_update_dpp(0, (int)w[i], 0xB1, 0xF, 0xF, false);
        const unsigned ow = odd ? ((pw >> 16) | (w[i] & 0xffff0000u)) : ((w[i] & 0xffffu) | (pw << 16)); const int d = d0 + 2 * i + odd;
        *(LAS unsigned*)(base + d * 128 + ((((sp >> 3) ^ (d & 7)) << 4) | ((sp & 7) << 1))) = ow; }
}
#ifndef REP_STAGE
#define REP_STAGE 1
#define REP_STILDE 1
#define REP_MFMA 1
#endif
constexpr int SC_QS = 0, SC_KT = 66560, SC_VT = 132096, SC_ST = 140288, SC_XB = 148480, SC_VEC = 156672;
__device__ __forceinline__ void ml_scan_task(KPC kp, int j, int task, LAS unsigned char* lds) {
    const int tid = ltid(), lane = tid & 63, wv = tid >> 6, fr = lane & 15, fq = lane >> 4;
    const int es = task & 7, dir = (task >> 3) & 1, hd = (task >> 4) & 3, b = task >> 6;
    const u16* xm = (const u16*)(kp->ws + OFF_XM); const u16* xc = (const u16*)(kp->ws + OFF_XC); const float* gates = (const float*)(kp->ws + OFF_GATES);
    const float* Sg = (const float*)(kp->ws + OFF_S) + (size_t)(b * 4 + hd) * NCH * 4096;
    u16* hf = (u16*)(kp->ws + OFF_R2);
    LAS unsigned char* QS = lds + SC_QS; LAS unsigned char* KT = lds + SC_KT; LAS unsigned char* VT = lds + SC_VT; LAS unsigned char* ST = lds + SC_ST; LAS unsigned char* XB = lds + SC_XB;
    LAS float* rowterm = (LAS float*)(lds + SC_VEC); LAS float* colterm = rowterm + 64; LAS float* winter = rowterm + 128; LAS float* einv = rowterm + 192;
    LAS float* kws = rowterm + 256; LAS float* dinv = rowterm + 320; LAS float* nst = rowterm + 384; LAS float* scal = rowterm + 896;
    f32x4 C[16];
#pragma unroll
    for (int i = 0; i < 16; ++i) C[i] = (f32x4){0.f, 0.f, 0.f, 0.f};
    float m_st = 0.f;
    __syncthreads();
    nst[tid] = 0.f;
    float pg_ic = 0.f, pg_fp = 0.f;
    if (wv == 0) { const int tn = dir == 0 ? lane : CTX - 1 - lane; const int Tg = b * TPB + tn; pg_ic = gates[(size_t)Tg * 16 + dir * 8 + hd]; pg_fp = gates[(size_t)Tg * 16 + dir * 8 + 4 + hd]; }
    u32x4v pxc[8], pxv;
    { const int tn = dir == 0 ? lane : CTX - 1 - lane; const size_t Tn = (size_t)(b * TPB + tn) * INNER; const int w0 = __builtin_amdgcn_readfirstlane(wv);
#pragma unroll
      for (int r = 0; r < 8; ++r) pxc[r] = *(const u32x4v*)(xc + Tn + hd * DH + (w0 * 8 + r) * 8);
      pxv = *(const u32x4v*)(xm + Tn + hd * DH + es * 64 + w0 * 8); }
    for (int ci = 0; ci < NCH; ++ci) {
        __syncthreads();
        const int p0 = ci * 64;
        const int tid = ltid(), lane = tid & 63, wv = tid >> 6, fr = lane & 15, fq = lane >> 4;
        asm volatile("" ::: "memory");
        auto tok = [&](int jj) -> int { const int p = p0 + jj; const int t = dir == 0 ? p : (p < CTX ? CTX - 1 - p : TPB + CTX - 1 - p); return b * TPB + t; };
        float sv[8];
        { const int jj = tid >> 3, s8 = (tid & 7) * 8;
            if (dir == 0) { const float* sp = Sg + (size_t)ci * 4096 + jj * 64 + s8; const f32x4 v0 = *(const f32x4*)sp, v1 = *(const f32x4*)(sp + 4);
                sv[0] = v0[0]; sv[1] = v0[1]; sv[2] = v0[2]; sv[3] = v0[3]; sv[4] = v1[0]; sv[5] = v1[1]; sv[6] = v1[2]; sv[7] = v1[3]; }
            else { const int oc = ci < 4 ? 3 - ci : 135 - ci; const float* sp = Sg + (size_t)oc * 4096 + (63 - jj) * 64 + (56 - s8); const f32x4 v0 = *(const f32x4*)sp, v1 = *(const f32x4*)(sp + 4);
                sv[7] = v0[0]; sv[6] = v0[1]; sv[5] = v0[2]; sv[4] = v0[3]; sv[3] = v1[0]; sv[2] = v1[1]; sv[1] = v1[2]; sv[0] = v1[3]; }
        }
        const float g_ic = pg_ic, g_fp = pg_fp;
        if (wv == 0 && ci + 1 < NCH) { const int pn = p0 + 64 + lane; const int tn = dir == 0 ? pn : (pn < CTX ? CTX - 1 - pn : TPB + CTX - 1 - pn); const int Tg = b * TPB + tn;
            pg_ic = gates[(size_t)Tg * 16 + dir * 8 + hd]; pg_fp = gates[(size_t)Tg * 16 + dir * 8 + 4 + hd]; }
        for (int rpS = 0; rpS < REP_STAGE; ++rpS) {
        const int wvu = __builtin_amdgcn_readfirstlane(wv); const int Tl = tok(lane);
#pragma unroll
        for (int r = 0; r < 8; ++r) { const int g8 = wvu * 8 + r; float x[8], q[8], Mw[32];
            const u32x4v xw = pxc[r]; unpack8(xw, x);
            sload32((const float*)(kp->ws + OFF_MLM) + (size_t)j * 8192 + (size_t)(hd * 128 + g8 * 2) * 16, Mw); bd8(x, Mw, q);
            *(LAS u32x4v*)(QS + lane * 1040 + g8 * 16) = pack8(q);
            const unsigned wd[4] = {xw.x, xw.y, xw.z, xw.w}; tr_store8(KT, g8 * 8, wd, lane); }
        { const int g = wvu; const int chv = hd * DH + es * 64 + g * 8; float x[8], v[8], wvv[32];
            unpack8(pxv, x); sload32(kp->in[I_MLWV] + ((size_t)j * 512 + (chv >> 2)) * 16, wvv); bd8(x, wvv, v);
            { const u32x4v vw = pack8(v); const unsigned wd[4] = {vw.x, vw.y, vw.z, vw.w}; tr_store8(VT, g * 8, wd, lane); } }
        }
        if (wv == 0) {
            const float ic = g_ic, fp = g_fp;
            const float lf = fminf(fp, 0.f) - log1pf(__expf(-fabsf(fp)));
            float bb = lf;
#pragma unroll
            for (int o = 1; o < 64; o <<= 1) { const float t = lshfl(bb, lane - o); if (lane >= o) bb += t; }
            const float uu = ic - bb; float pm = uu;
#pragma unroll
            for (int o = 1; o < 64; o <<= 1) { const float t = lshfl(pm, lane - o); if (lane >= o) pm = fmaxf(pm, t); }
            const float a = bb + m_st, mj = fmaxf(a, bb + pm);
            rowterm[lane] = bb - mj; colterm[lane] = uu; winter[lane] = __expf(a - mj); einv[lane] = __expf(-mj);
            const float blast = lshfl(bb, 63), gs = blast - bb + ic, gmax = wave_max(gs), mnew = fmaxf(blast + m_st, gmax);
            kws[lane] = __expf(gs - mnew);
            if (lane == 0) { scal[0] = __expf(blast + m_st - mnew); scal[1] = mnew; }
        }
        __syncthreads();
        for (int rpT = 0; rpT < REP_STILDE; ++rpT) {
            const int jj = tid >> 3, sub = tid & 7, s8 = sub * 8;
            const float rt = rowterm[jj]; float rsum = 0.f;
            const f32x4 ct0 = *(const LAS f32x4*)(colterm + s8), ct1 = *(const LAS f32x4*)(colterm + s8 + 4); const float ctv[8] = {ct0[0], ct0[1], ct0[2], ct0[3], ct1[0], ct1[1], ct1[2], ct1[3]};
#pragma unroll
            for (int e = 0; e < 8; ++e) { const int s = s8 + e; const float w = s <= jj ? sv[e] * 0.04419417382415922f * __expf(rt + ctv[e]) : 0.f; sv[e] = w; rsum += w; }
            *(LAS u32x4v*)(ST + jj * 128 + ((sub ^ (jj & 7)) << 4)) = pack8(sv);
            float qd = 0.f;
#pragma unroll
            for (int c8 = 0; c8 < 8; ++c8) { float qv[8]; unpack8(*(const LAS u32x4v*)(QS + jj * 1040 + (sub * 8 + c8) * 16), qv);
                { const f32x4 n0 = *(const LAS f32x4*)(nst + sub * 64 + c8 * 8), n1 = *(const LAS f32x4*)(nst + sub * 64 + c8 * 8 + 4);
                  qd += qv[0] * n0[0] + qv[1] * n0[1] + qv[2] * n0[2] + qv[3] * n0[3] + qv[4] * n1[0] + qv[5] * n1[1] + qv[6] * n1[2] + qv[7] * n1[3]; } }
            rsum += lshfl(rsum, lane ^ 1); rsum += lshfl(rsum, lane ^ 2); rsum += lshfl(rsum, lane ^ 4);
            qd += lshfl(qd, lane ^ 1); qd += lshfl(qd, lane ^ 2); qd += lshfl(qd, lane ^ 4);
            if (sub == 0) { const float qn = winter[jj] * qd + rsum; dinv[jj] = __builtin_amdgcn_rcpf(fmaxf(fabsf(qn), einv[jj])); }
        }
        __syncthreads();
        if (ci + 1 < NCH) { const int pn = p0 + 64 + lane; const int tn = dir == 0 ? pn : (pn < CTX ? CTX - 1 - pn : TPB + CTX - 1 - pn); const size_t Tn = (size_t)(b * TPB + tn) * INNER; const int w0 = __builtin_amdgcn_readfirstlane(wv);
#pragma unroll
            for (int r = 0; r < 8; ++r) pxc[r] = *(const u32x4v*)(xc + Tn + hd * DH + (w0 * 8 + r) * 8);
            pxv = *(const u32x4v*)(xm + Tn + hd * DH + es * 64 + w0 * 8); }
        {
            f32x4 o[4];
            const int et = wv & 3, dh = wv >> 2, el = 16 * et + fr;
            bf16x8 vfr[2];
#pragma unroll
            for (int mt = 0; mt < 4; ++mt) o[mt] = (f32x4){0.f, 0.f, 0.f, 0.f};
#pragma unroll
            for (int ks = 0; ks < 8; ++ks) {
                u32x4v bw; bw.x = pg8::cvt_pk_bf16(C[2 * ks][0], C[2 * ks][1]); bw.y = pg8::cvt_pk_bf16(C[2 * ks][2], C[2 * ks][3]);
                bw.z = pg8::cvt_pk_bf16(C[2 * ks + 1][0], C[2 * ks + 1][1]); bw.w = pg8::cvt_pk_bf16(C[2 * ks + 1][2], C[2 * ks + 1][3]);
                const bf16x8 bfr = __builtin_bit_cast(bf16x8, bw);
#pragma unroll
                for (int mt = 0; mt < 4; ++mt) { const int off = (16 * mt + fr) * 1040 + 8 * fq + dh * 512;
                    const u32x2 lo = *(const LAS u32x2*)(QS + off + 64 * ks), hi = *(const LAS u32x2*)(QS + off + 64 * ks + 32);
                    u32x4v aw; aw.x = lo.x; aw.y = lo.y; aw.z = hi.x; aw.w = hi.y;
                    o[mt] = __builtin_amdgcn_mfma_f32_16x16x32_bf16(bfr, __builtin_bit_cast(bf16x8, aw), o[mt], 0, 0, 0); }
                if ((ks & 1) == 1) __builtin_amdgcn_sched_barrier(0); }
#pragma unroll
            for (int mt = 0; mt < 4; ++mt)
#pragma unroll
                for (int r = 0; r < 4; ++r) o[mt][r] *= winter[16 * mt + fr];
#pragma unroll
            for (int k2 = 0; k2 < 2; ++k2) vfr[k2] = *(const LAS bf16x8*)(VT + el * 128 + (((4 * k2 + fq) ^ (el & 7)) << 4));
            if (dh == 1) {
#pragma unroll
                for (int mt = 0; mt < 4; ++mt) { u32x2 w; w.x = pg8::cvt_pk_bf16(o[mt][0], o[mt][1]); w.y = pg8::cvt_pk_bf16(o[mt][2], o[mt][3]); *(LAS u32x2*)(XB + ((et * 4 + mt) * 64 + lane) * 8) = w; }
            } else {
#pragma unroll
                for (int k2 = 0; k2 < 2; ++k2)
#pragma unroll
                    for (int mt = 0; mt < 4; ++mt) { const int jr = 16 * mt + fr; const bf16x8 a = *(const LAS bf16x8*)(ST + jr * 128 + (((4 * k2 + fq) ^ (jr & 7)) << 4));
                        o[mt] = __builtin_amdgcn_mfma_f32_16x16x32_bf16(vfr[k2], a, o[mt], 0, 0, 0); }
            }
            __syncthreads();
            if (dh == 0) {
#pragma unroll
                for (int mt = 0; mt < 4; ++mt) { const u32x2 pw = *(const LAS u32x2*)(XB + ((et * 4 + mt) * 64 + lane) * 8);
                    const int jr = 16 * mt + fr, T = tok(jr); const float di = dinv[jr];
                    const float o0 = (o[mt][0] + bflo(pw.x)) * di, o1 = (o[mt][1] + bfhi(pw.x)) * di, o2 = (o[mt][2] + bflo(pw.y)) * di, o3 = (o[mt][3] + bfhi(pw.y)) * di;
                    u16* dst = dir == 0 ? hf + (size_t)T * INNER : hb_ptr(kp, T); u32x2 w; w.x = pg8::cvt_pk_bf16(o0, o1); w.y = pg8::cvt_pk_bf16(o2, o3);
                    *(u32x2*)(dst + hd * DH + es * 64 + 16 * et + 4 * fq) = w; }
            }
            const float decay = scal[0];
#pragma unroll
            for (int i = 0; i < 16; ++i) C[i] = C[i] * decay;
            float kwv[2][8];
#pragma unroll
            for (int k2 = 0; k2 < 2; ++k2) { const f32x4 k0 = *(const LAS f32x4*)(kws + 32 * k2 + 8 * fq), k1 = *(const LAS f32x4*)(kws + 32 * k2 + 8 * fq + 4);
                kwv[k2][0] = k0[0]; kwv[k2][1] = k0[1]; kwv[k2][2] = k0[2]; kwv[k2][3] = k0[3]; kwv[k2][4] = k1[0]; kwv[k2][5] = k1[1]; kwv[k2][6] = k1[2]; kwv[k2][7] = k1[3]; }
#pragma unroll
            for (int k2 = 0; k2 < 2; ++k2) { float vv[8]; unpack8(__builtin_bit_cast(u32x4v, vfr[k2]), vv);
#pragma unroll
                for (int e = 0; e < 8; ++e) vv[e] *= kwv[k2][e];
                const bf16x8 bsc = __builtin_bit_cast(bf16x8, pack8(vv));
#pragma unroll
                for (int dt = 0; dt < 16; ++dt) { const int dr = 256 * (wv >> 2) + 16 * dt + fr; const bf16x8 a = *(const LAS bf16x8*)(KT + dr * 128 + (((4 * k2 + fq) ^ (dr & 7)) << 4));
                    C[dt] = __builtin_amdgcn_mfma_f32_16x16x32_bf16(a, bsc, C[dt], 0, 0, 0);
                    if ((dt & 7) == 7) __builtin_amdgcn_sched_barrier(0); } }
            { float nn = decay * nst[tid];
#pragma unroll
              for (int g = 0; g < 8; ++g) { float kv[8]; unpack8(*(const LAS u32x4v*)(KT + tid * 128 + ((g ^ (tid & 7)) << 4)), kv);
                  { const f32x4 k0 = *(const LAS f32x4*)(kws + 8 * g), k1 = *(const LAS f32x4*)(kws + 8 * g + 4); nn += kv[0] * k0[0] + kv[1] * k0[1] + kv[2] * k0[2] + kv[3] * k0[3] + kv[4] * k1[0] + kv[5] * k1[1] + kv[6] * k1[2] + kv[7] * k1[3]; } }
              nst[tid] = nn; }
            m_st = scal[1];
        }
    }
}

__device__ __forceinline__ void ml_gate_phase(KPC kp, int j) {
    u16* hf = (u16*)(kp->ws + OFF_R2); const u16* xc = (const u16*)(kp->ws + OFF_XC); const u16* z = (const u16*)(kp->ws + OFF_XM);
    const float* ng = kp->in[I_MLNG] + (size_t)j * INNER; const float* sk = kp->in[I_MLSKIP] + (size_t)j * INNER;
    const int lane = ltid() & 63, wv = ltid() >> 6;
    for (int T = lbid() * 8 + wv; T < NTOK; T += gridDim.x * 8) {
        const u16* hbp = hb_ptr(kp, T);
#pragma unroll
        for (int hd = 0; hd < 4; ++hd) { const int c0 = hd * DH + lane * 8; float a[8], bq[8], xv[8], zv[8], o[8];
            unpack8(*(const u32x4v*)(hf + (size_t)T * INNER + c0), a); unpack8(*(const u32x4v*)(hbp + c0), bq);
            float s = 0.f;
#pragma unroll
            for (int e = 0; e < 8; ++e) { a[e] += bq[e]; s += a[e]; }
            const float mu = wave_sum(s) * (1.0f / DH); float vs = 0.f;
#pragma unroll
            for (int e = 0; e < 8; ++e) { a[e] -= mu; vs += a[e] * a[e]; }
            const float rs = rsqrtf(wave_sum(vs) * (1.0f / DH) + 1e-5f);
            unpack8(*(const u32x4v*)(xc + (size_t)T * INNER + c0), xv); unpack8(*(const u32x4v*)(z + (size_t)T * INNER + c0), zv);
            const f32x4 n0 = *(const f32x4*)(ng + c0), n1 = *(const f32x4*)(ng + c0 + 4), s0 = *(const f32x4*)(sk + c0), s1 = *(const f32x4*)(sk + c0 + 4);
            const float ngv[8] = {n0[0], n0[1], n0[2], n0[3], n1[0], n1[1], n1[2], n1[3]}, skv[8] = {s0[0], s0[1], s0[2], s0[3], s1[0], s1[1], s1[2], s1[3]};
#pragma unroll
            for (int e = 0; e < 8; ++e) o[e] = (a[e] * rs * ngv[e] + skv[e] * xv[e]) * siluf(zv[e]);
            *(u32x4v*)(hf + (size_t)T * INNER + c0) = pack8(o); }
    }
}


enum { K_SETUP = 0, K_CN, K_G1, K_G2R, K_HYIN, K_HYCONV, K_HYTR, K_MLUPX, K_MLPREP, K_MLSCAN, K_MLUPZ, K_MLGATE, K_FINAL };
constexpr int NPHASE = 1 + 11 + 13 + 11 + 13 + 1;
__device__ __forceinline__ void decode_phase(int ph, int& kind, int& l, int& arg) {
    kind = K_SETUP; l = 0; arg = 0; if (ph == 0) return;
    ph -= 1;
    for (l = 0; l < 4; ++l) { const int n = (l & 1) ? 13 : 11; if (ph < n) break; ph -= n; }
    if (l == 4) { kind = K_FINAL; l = 0; return; }
    if (ph == 0) { kind = K_CN; arg = 0; return; } if (ph == 1) { kind = K_G1; arg = 0; return; } if (ph == 2) { kind = K_G2R; arg = 0; return; } if (ph == 3) { kind = K_CN; arg = 1; return; }
    const int nm = (l & 1) ? 6 : 4;
    if (ph < 4 + nm) { const int q = ph - 4;
        if (l & 1) { kind = q == 0 ? K_MLUPX : q == 1 ? K_MLPREP : q == 2 ? K_MLSCAN : q == 3 ? K_MLUPZ : q == 4 ? K_MLGATE : K_G2R; arg = 2; }
        else { kind = q == 0 ? K_HYIN : q == 1 ? K_HYCONV : q == 2 ? K_HYTR : K_G2R; arg = 2; }
        return; }
    ph -= 4 + nm;
    if (ph == 0) { kind = K_CN; arg = 2; return; } if (ph == 1) { kind = K_G1; arg = 1; return; } kind = K_G2R; arg = 1;
}

__device__ __forceinline__ void gbar(unsigned* ctr, unsigned target) {
    __syncthreads();
    if (ltid() == 0) {
        __builtin_amdgcn_fence(__ATOMIC_RELEASE, "agent");
        __hip_atomic_fetch_add(ctr, 1u, __ATOMIC_RELAXED, __HIP_MEMORY_SCOPE_AGENT);
        while (__hip_atomic_load(ctr, __ATOMIC_RELAXED, __HIP_MEMORY_SCOPE_AGENT) < target) __builtin_amdgcn_s_sleep(2);
        __builtin_amdgcn_fence(__ATOMIC_ACQUIRE, "agent");
    }
    __syncthreads();
}
#ifndef REPMASK
#define REPMASK 0
#define REPN 1
#endif
template <int MIX> __device__ __forceinline__ void run_phases(int lo, int hi, int ph_lo, int ph_hi, LAS unsigned char* lds0, cg::grid_group& grid) {
    lo = lo > ph_lo ? lo : ph_lo; hi = hi < ph_hi ? hi : ph_hi;
    for (int ph = lo; ph < hi; ++ph) {
        KPC kp = (KPC)__builtin_amdgcn_kernarg_segment_ptr(); asm volatile("" : "+s"(kp) :: "memory");
        LAS unsigned char* lds = lds0; asm volatile("" : "+s"(lds) :: "memory");
        unsigned char* ws = kp->ws; unsigned char* wb = ws + OFF_WB;
        int kind, l, arg; decode_phase(ph, kind, l, arg); const int j = l >> 1;
        const float* modl = (const float*)(ws + OFF_MOD) + (size_t)l * 5 * 9216;
        const int nrep = ((REPMASK >> kind) & 1) ? REPN : 1;
        for (int rep = 0; rep < nrep; ++rep) {
        if (kind == K_SETUP) { if constexpr (MIX == 0) setup_phase(kp, (LAS float*)lds); }
        else if (kind == K_CN) {
            if (arg == 0) { convert_layer(kp, l, (LAS float*)lds); if constexpr (MIX == 1) ml_m_phase(kp, j); }
            if constexpr (MIX == 0) { if (arg == 1) hy_mlp_phase(kp, j); }
            norm_phase(kp, l, arg, arg == 0 ? (l == 0 ? 0 : 11) : arg == 1 ? 11 : (l == 3 ? 0 : (l & 1) ? 8 : 4));
        } else if (kind == K_G1) {
            pg8::Gemm g{(const u16*)(ws + OFF_U), (const u16*)(wb + (arg ? WB_FIN1 : WB_FIN0)), NTOK, 2 * FF, D};
            pg8::StaticOrder S; S.init(g.M, g.N, (int)gridDim.x, lbid(), (l == 3 && arg == 1) ? 1 : 0); EpiSwiglu E{(u16*)(ws + OFF_R1)};
            pg8::gemm_phase<EpiSwiglu, pg8::StaticOrder, false>(lds, g, S, E, nullptr);
        } else if (kind == K_G2R) {
            const u16* gA; const u16* gB; int gK, gidx, gbj = -1;
            if (arg < 2) { gA = (const u16*)(ws + OFF_R1); gB = (const u16*)(wb + (arg ? WB_FOUT1 : WB_FOUT0)); gK = FF; gidx = arg ? 8 : 2; }
            else if (MIX == 1) { gA = (const u16*)(ws + OFF_R2); gB = (const u16*)(wb + WB_MOUT); gK = INNER; gidx = 5; }
            else { gA = (const u16*)(ws + OFF_U); gB = (const u16*)(wb + WB_MOUT); gK = D; gidx = 5; gbj = j; }
            const pg8::Gemm g{gA, gB, NTOK, D, gK, 0}; const EpiResid E{kp, l, gidx, gbj};
            pg8::StaticOrder S; S.init(g.M, g.N, (int)gridDim.x, lbid(), (l == 3 && arg >= 1) ? 1 : 2, g.K / 256);
            pg8::gemm_phase<EpiResid, pg8::StaticOrder, false>(lds, g, S, E, nullptr);
        } else if (kind == K_FINAL) { if constexpr (MIX == 1) final_phase(kp); }
        else if constexpr (MIX == 0) {
            if (kind == K_HYIN) {
                pg8::Gemm g{(const u16*)(wb + WB_MIN), (const u16*)(ws + OFF_U), 3 * D, NTOK, D};
                pg8::StaticOrder S; S.init(g.M, g.N, (int)gridDim.x, lbid());
                EpiProjT E{(u16*)(ws + OFF_R1 + HY_PL), (u16*)(ws + OFF_R1 + HY_PC), kp->in[I_HYBIN] + (size_t)j * 3 * D};
                pg8::gemm_phase<EpiProjT, pg8::StaticOrder, false>(lds, g, S, E, nullptr);
                __syncthreads();
                for (int t = lbid(); t < 2048; t += gridDim.x) hy_filter_task(kp, j, t, (LAS f32x2*)lds, (LAS float*)(lds + 131072));
            } else if (kind == K_HYCONV) {
                for (int t = lbid(); t < 2048; t += gridDim.x) hy_conv_lat(kp, j, t, (LAS f32x2*)lds);
                for (int t = lbid(); t < 1024; t += gridDim.x) hy_conv_ctx(kp, j, t, (LAS float*)lds);
            } else if (kind == K_HYTR) hy_transpose(kp, (LAS u16*)lds);
        } else {
            if (kind == K_MLUPX || kind == K_MLUPZ) {
                const bool zz = kind == K_MLUPZ;
                pg8::Gemm g{(const u16*)(ws + OFF_U), (const u16*)(wb + WB_MIN) + (zz ? (size_t)INNER * D : 0), NTOK, INNER, D};
                pg8::StaticOrder S; S.init(g.M, g.N, (int)gridDim.x, lbid(), (zz && l == 3) ? 1 : 0); EpiBf E{(u16*)(ws + OFF_XM), INNER};
                pg8::gemm_phase<EpiBf, pg8::StaticOrder, false>(lds, g, S, E, nullptr);
            } else if (kind == K_MLPREP) { for (int t = lbid(); t < NB * NCH * 4; t += gridDim.x) ml_prep_task(kp, j, t, lds); }
            else if (kind == K_MLSCAN) { for (int t = lbid(); t < 256; t += gridDim.x) ml_scan_task(kp, j, t, lds); }
            else if (kind == K_MLGATE) ml_gate_phase(kp, j);
        }
        }
        if (ph + 1 < ph_hi) gbar((unsigned*)(kp->ws + OFF_MLM + 65536), (unsigned)(ph + 1 - ph_lo) * gridDim.x);
    }
}

__global__ void __launch_bounds__(512) fwd_megakernel(KP kparg) {
    extern __shared__ __attribute__((aligned(16))) unsigned char shm[];
    LAS unsigned char* lds = (LAS unsigned char*)shm;
    cg::grid_group grid = cg::this_grid();
    grid.sync();
    wtab_init();
    const int ph_lo = kparg.ph_lo, ph_hi = kparg.ph_hi;
    run_phases<0>(0, 12, ph_lo, ph_hi, lds, grid);
    run_phases<1>(12, 25, ph_lo, ph_hi, lds, grid);
    run_phases<0>(25, 36, ph_lo, ph_hi, lds, grid);
    run_phases<1>(36, 50, ph_lo, ph_hi, lds, grid);
}

extern "C" void kernel_launch(void* const* d_in, const int* in_sizes, int n_in, void* d_out, int out_size, void* d_ws, size_t ws_size, hipStream_t stream) {
    static int grid_blocks = 0;
    if (!grid_blocks) {
        int dev = 0, cus = 0, per_cu = 0;
        hipGetDevice(&dev);
        hipDeviceGetAttribute(&cus, hipDeviceAttributeMultiprocessorCount, dev);
        hipFuncSetAttribute((const void*)fwd_megakernel, hipFuncAttributeMaxDynamicSharedMemorySize, LDS_BYTES);
        hipOccupancyMaxActiveBlocksPerMultiprocessor(&per_cu, fwd_megakernel, 512, LDS_BYTES);
        if (per_cu < 1) per_cu = 1;
        grid_blocks = cus * 1;
        if (ws_size < WS_NEED2) fprintf(stderr, "workspace too small: %zu < %zu\n", ws_size, (size_t)WS_NEED2);
    }
    KP hp{};
    for (int i = 0; i < 36; ++i) hp.in[i] = (const float*)d_in[i];
    hp.out = (float*)d_out; hp.ws = (unsigned char*)d_ws; hp.ph_lo = 0; hp.ph_hi = NPHASE;
    void* args[] = {&hp};
    hipMemsetAsync((unsigned char*)d_ws + OFF_MLM + 65536, 0, 256, stream);
    hipError_t e = hipLaunchCooperativeKernel((void*)fwd_megakernel, dim3(grid_blocks), dim3(512), args, LDS_BYTES, stream);
    if (e != hipSuccess) fprintf(stderr, "cooperative launch failed: %s (grid %d)\n", hipGetErrorString(e), grid_blocks);
}
```

```cpp
#define REPMASK 0
#define REPN 1
#include <hip/hip_runtime.h>
#include <hip/hip_cooperative_groups.h>
#include <cstdio>
namespace cg = cooperative_groups;
#define WTAB_OFF 163584
__device__ __forceinline__ int llane() { int l; asm volatile("v_mbcnt_lo_u32_b32 %0, -1, 0\n\tv_mbcnt_hi_u32_b32 %0, -1, %0" : "=v"(l) :: "memory"); return l; }
__device__ __forceinline__ int lwave() { extern __shared__ __attribute__((aligned(16))) unsigned char shm_w[];
    const int hw = __builtin_amdgcn_s_getreg(10244) & 63;
    return __builtin_amdgcn_readfirstlane(*(const __attribute__((address_space(3))) int*)((__attribute__((address_space(3))) unsigned char*)shm_w + WTAB_OFF + hw * 4)); }
__device__ __forceinline__ void wtab_init() { extern __shared__ __attribute__((aligned(16))) unsigned char shm_w[];
    const int hw = __builtin_amdgcn_s_getreg(10244) & 63;
    *(__attribute__((address_space(3))) int*)((__attribute__((address_space(3))) unsigned char*)shm_w + WTAB_OFF + hw * 4) = (int)(threadIdx.x >> 6); }
__device__ __forceinline__ int ltid() { return lwave() * 64 + llane(); }
__device__ __forceinline__ int lbid() { int t = blockIdx.x; asm volatile("" : "+s"(t) :: "memory"); return t; }
namespace pg8 {
#define PG8_LAS __attribute__((address_space(3)))
typedef unsigned short bf16_t;
typedef short bf16x8 __attribute__((ext_vector_type(8)));
typedef float f32x4 __attribute__((ext_vector_type(4)));
typedef unsigned u32x4 __attribute__((ext_vector_type(4)));
constexpr int BM = 256, BK = 64, HALF = 128, HTB = HALF * BK * 2  , STAGE_BYTES = 8 * HTB, NXCD = 8, WGM = 8;

__host__ __device__ __forceinline__ int lds_byte(int r, int c) { const int st = (r >> 4) * 2 + (c >> 5), rr = r & 15, cc = c & 31, ob = rr * 64 + cc * 2; return st * 1024 + (ob ^ (((ob >> 9) & 1) << 5)); }
__host__ __device__ __forceinline__ void stage_rc(int b, int& R, int& C) { const int st = b / 1024, sb = b % 1024, swz = sb ^ (((sb >> 9) & 1) << 5); R = (st >> 1) * 16 + swz / 64; C = (st & 1) * 32 + (swz % 64) / 2; }
__host__ __device__ __forceinline__ int perm32(int rho) { const int n = rho >> 4, i = rho & 15; return 8 * (i >> 2) + 4 * n + (i & 3); }

struct Unit { int pm, pn, kofs, nt; };
struct Gemm { const bf16_t* A; const bf16_t* Bt; int M, N, K, ldk; };

struct StaticOrder {
    int nM, nN, nwg, G, c, lat, nk;
    __host__ __device__ void init(int M, int N, int G_, int c_, int lat_ = 0, int nk_ = 0) { lat = lat_; nk = nk_; nM = lat ? 128 : M / BM; nN = N / BM; nwg = nM * nN; G = G_; c = c_; }
    __host__ __device__ bool next(int i, Unit& u) const {
        const long L = (long)i * G + c;
        if (L >= nwg) { if (lat != 2 || L >= nwg + 16 * nk) return false; const int Lc = (int)L - nwg, un = Lc & 15; u.pm = (un >> 2) * 33; u.pn = un & 3; u.kofs = (Lc >> 4) * 256; u.nt = 4; return true; }
        int wgid = (int)L; { const int q = nwg / NXCD, r = nwg % NXCD, xcd = wgid % NXCD, off = wgid / NXCD; wgid = (xcd < r ? xcd * (q + 1) : r * (q + 1) + (xcd - r) * q) + off; }
        const int nig = WGM * nN, gid = wgid / nig, fm = gid * WGM, gsz = (nM - fm) < WGM ? (nM - fm) : WGM;
        u.pm = fm + ((wgid % nig) % gsz); u.pn = (wgid % nig) / gsz; u.kofs = 0; u.nt = 0; if (lat) u.pm = (u.pm >> 5) * 33 + 1 + (u.pm & 31); return true;
    }
    __device__ __forceinline__ void a_ready(const Unit&) const {}
    __device__ __forceinline__ void done(const Unit&) const {}
};
__device__ __forceinline__ unsigned cvt_pk_bf16(float lo, float hi) { unsigned r; asm volatile("v_cvt_pk_bf16_f32 %0, %1, %2" : "=v"(r) : "v"(lo), "v"(hi)); return r; }
template <class Epi, class Sched, bool STAMP = false>
__device__ __forceinline__ void gemm_phase(PG8_LAS unsigned char* lds, const Gemm g, const Sched& S, const Epi& E, unsigned long long* stamps) {
    const int tid = ltid(), wid = __builtin_amdgcn_readfirstlane(tid >> 6), lane = tid & 63, wr = wid >> 2, wc = wid & 3, fr = lane & 15, fq = lane >> 4;
    const int K = g.K, nt = K / BK, ldk = g.ldk ? g.ldk : g.K;
    int ts_lo = 0, ts_hi = 0, nts = 0; const unsigned long long rt_entry = STAMP ? (unsigned long long)wall_clock64() : 0ull;
#define PG8_STAMP() do { if (STAMP && wid == 0 && nts < 64) { const unsigned long long _c = (unsigned long long)clock64(); \
        ts_lo = (lane == nts) ? (int)(unsigned)_c : ts_lo; ts_hi = (lane == nts) ? (int)(unsigned)(_c >> 32) : ts_hi; ++nts; } } while (0)
    PG8_STAMP();
    unsigned voffA[2], voffB[2];
#pragma unroll
    for (int i = 0; i < 2; ++i) { int R, C; stage_rc(tid * 16 + i * 8192, R, C); const int Rb = Epi::PERM ? ((R & ~31) + perm32(R & 31)) : R;
        voffA[i] = (unsigned)(R * ldk + C) * 2u; voffB[i] = (unsigned)(Rb * ldk + C) * 2u; }
    const size_t kstep = (size_t)(BK * 2);
    const size_t hstep = (size_t)HALF * ldk * 2;
    const size_t tstep = 2 * hstep;
    const unsigned ldsw = (unsigned)wid * 1024u;
    const int aoff = lds_byte(wr * 64 + fr, fq * 8), boff = lds_byte(wc * 32 + fr, fq * 8);
#define PG8_SA(b, h) (((b) * 2 + (h)) * HTB)
#define PG8_SB(b, h) ((4 + (b) * 2 + (h)) * HTB)
#define PG8_STAGE(bufoff, gbase, voff) do { _Pragma("unroll") for (int _i = 0; _i < 2; ++_i) \
        __builtin_amdgcn_global_load_lds((const unsigned*)((const char*)(gbase) + (voff)[_i]), (PG8_LAS unsigned*)(lds + (bufoff) + ldsw + _i * 8192), 16, 0, 0); } while (0)
#define PG8_LDA(dst, b, h) do { _Pragma("unroll") for (int m = 0; m < 4; ++m) _Pragma("unroll") for (int k = 0; k < 2; ++k) dst[m][k] = *(const PG8_LAS bf16x8*)(lds + PG8_SA(b, h) + aoff + m * 2048 + k * 1024); } while (0)
#define PG8_LDB(dst, b, h) do { _Pragma("unroll") for (int n = 0; n < 2; ++n) _Pragma("unroll") for (int k = 0; k < 2; ++k) dst[n][k] = *(const PG8_LAS bf16x8*)(lds + PG8_SB(b, h) + boff + n * 2048 + k * 1024); } while (0)
#define PG8_MMA(ai, bj, At, Bt) do { __builtin_amdgcn_s_setprio(1); _Pragma("unroll") for (int m = 0; m < 4; ++m) _Pragma("unroll") for (int n = 0; n < 2; ++n) _Pragma("unroll") for (int k = 0; k < 2; ++k) \
        acc[ai][bj][m][n] = __builtin_amdgcn_mfma_f32_16x16x32_bf16(Bt[n][k], At[m][k], acc[ai][bj][m][n], 0, 0, 0); __builtin_amdgcn_s_setprio(0); } while (0)
#define PG8_WAIT_V(n) asm volatile("s_waitcnt vmcnt(" #n ")" ::: "memory")
#define PG8_WAIT_L(n) asm volatile("s_waitcnt lgkmcnt(" #n ")" ::: "memory")
#define PG8_BAR __builtin_amdgcn_s_barrier()
#define PG8_SCHED __builtin_amdgcn_sched_barrier(0)
    Unit cur, nxt; int ui = 0;
    if (!S.next(0, cur)) return;
    f32x4 acc[2][2][4][2];
#pragma unroll
    for (int a = 0; a < 2; ++a)
#pragma unroll
        for (int b = 0; b < 2; ++b)
#pragma unroll
            for (int m = 0; m < 4; ++m)
#pragma unroll
                for (int n = 0; n < 2; ++n) acc[a][b][m][n] = (f32x4){0.f, 0.f, 0.f, 0.f};
    bf16x8 At[4][2], B0[2][2], B1[2][2];
    const char* cA = (const char*)g.A + (size_t)cur.pm * tstep + (size_t)cur.kofs * 2; const char* cB = (const char*)g.Bt + (size_t)cur.pn * tstep + (size_t)cur.kofs * 2;
    S.a_ready(cur);
    PG8_STAGE(PG8_SB(0, 0), cB, voffB); PG8_STAGE(PG8_SA(0, 0), cA, voffA); PG8_STAGE(PG8_SB(0, 1), cB + hstep, voffB); PG8_STAGE(PG8_SA(0, 1), cA + hstep, voffA);
    if (wr == 1) PG8_BAR;
    PG8_WAIT_V(4); PG8_BAR;
    PG8_STAGE(PG8_SB(1, 0), cB + kstep, voffB); PG8_STAGE(PG8_SA(1, 0), cA + kstep, voffA); PG8_STAGE(PG8_SB(1, 1), cB + hstep + kstep, voffB);
    PG8_WAIT_V(6); PG8_BAR;
    PG8_STAMP();
    for (;;) {
        const bool has_next = S.next(ui + 1, nxt);
        const char* nA = has_next ? (const char*)g.A + (size_t)nxt.pm * tstep + (size_t)nxt.kofs * 2 : cA; const char* nB = has_next ? (const char*)g.Bt + (size_t)nxt.pn * tstep + (size_t)nxt.kofs * 2 : cB;
        const int ntu = cur.nt ? cur.nt : nt;
        for (int t = 0; t < ntu; t += 2) {
            const bool last = (t == ntu - 2);
            const char* a1 = cA + (size_t)(t + 1) * kstep;
            const char* a2 = last ? nA : cA + (size_t)(t + 2) * kstep; const char* b2 = last ? nB : cB + (size_t)(t + 2) * kstep;
            const char* a3 = a2 + kstep; const char* b3 = b2 + kstep;
            if (last && has_next) S.a_ready(nxt);
            PG8_LDB(B0, 0, 0); PG8_SCHED; PG8_LDA(At, 0, 0); PG8_STAGE(PG8_SA(1, 1), a1 + hstep, voffA);
            PG8_WAIT_L(8); PG8_BAR; PG8_WAIT_L(0); PG8_MMA(0, 0, At, B0); PG8_BAR; PG8_SCHED;
            PG8_LDB(B1, 0, 1); PG8_STAGE(PG8_SB(0, 0), b2, voffB);
            PG8_BAR; PG8_WAIT_L(0); PG8_MMA(0, 1, At, B1); PG8_BAR;
            PG8_LDA(At, 0, 1); PG8_STAGE(PG8_SA(0, 0), a2, voffA);
            PG8_BAR; PG8_WAIT_L(0); PG8_MMA(1, 0, At, B0); PG8_BAR; PG8_SCHED;
            PG8_STAGE(PG8_SB(0, 1), b2 + hstep, voffB);
            PG8_WAIT_V(6); PG8_BAR; PG8_MMA(1, 1, At, B1); PG8_BAR;
            PG8_LDB(B0, 1, 0); PG8_SCHED; PG8_LDA(At, 1, 0); PG8_STAGE(PG8_SA(0, 1), a2 + hstep, voffA);
            PG8_WAIT_L(8); PG8_BAR; PG8_WAIT_L(0); PG8_MMA(0, 0, At, B0); PG8_BAR; PG8_SCHED;
            PG8_LDB(B1, 1, 1); PG8_STAGE(PG8_SB(1, 0), b3, voffB);
            PG8_BAR; PG8_WAIT_L(0); PG8_MMA(0, 1, At, B1); PG8_BAR;
            PG8_LDA(At, 1, 1); PG8_STAGE(PG8_SA(1, 0), a3, voffA);
            PG8_BAR; PG8_WAIT_L(0); PG8_MMA(1, 0, At, B0); PG8_BAR; PG8_SCHED;
            PG8_STAGE(PG8_SB(1, 1), b3 + hstep, voffB);
            PG8_WAIT_V(6); PG8_BAR; PG8_MMA(1, 1, At, B1); PG8_BAR;
        }
        PG8_STAMP();
        if constexpr (!Epi::AFTER_DRAIN) { E(acc, cur, wr, wc, fr, fq); S.done(cur); }
        PG8_STAMP();
        if (!has_next) break;
#pragma unroll
        for (int a = 0; a < 2; ++a)
#pragma unroll
            for (int b = 0; b < 2; ++b)
#pragma unroll
                for (int m = 0; m < 4; ++m)
#pragma unroll
                    for (int n = 0; n < 2; ++n) acc[a][b][m][n] = (f32x4){0.f, 0.f, 0.f, 0.f};
        cur = nxt; cA = nA; cB = nB; ++ui;
    }
    PG8_WAIT_V(0);
    if (wr == 0) PG8_BAR;
    PG8_BAR;
    if constexpr (Epi::AFTER_DRAIN) { E.fused(acc, cur, wr, wc, fr, fq, lds, wid, lane); S.done(cur); }
    PG8_STAMP();
    if (STAMP && wid == 0) { stamps[lane] = lane < nts ? (((unsigned long long)(unsigned)ts_hi << 32) | (unsigned)ts_lo) : 0ull;
        if (lane == 62) stamps[62] = rt_entry; if (lane == 63) stamps[63] = (unsigned long long)wall_clock64(); }
#undef PG8_STAMP
#undef PG8_SA
#undef PG8_SB
#undef PG8_STAGE
#undef PG8_LDA
#undef PG8_LDB
#undef PG8_MMA
#undef PG8_WAIT_V
#undef PG8_WAIT_L
#undef PG8_BAR
#undef PG8_SCHED
}
}

typedef unsigned short u16;
using pg8::f32x4; using pg8::bf16x8;
typedef float f32x2 __attribute__((ext_vector_type(2)));
typedef unsigned u32x2 __attribute__((ext_vector_type(2)));
typedef unsigned u32x4v __attribute__((ext_vector_type(4)));
typedef short s16x4 __attribute__((ext_vector_type(4)));
#define LAS __attribute__((address_space(3)))
constexpr int D = 1024, NB = 4, SEQ = 8192, CTX = 256, TPB = 8448, NTOK = 33792, FF = 2816, NCH = 132, INNER = 2048, DH = 512, NFFT = 16384;
constexpr size_t MiB = 1u << 20;
constexpr size_t OFF_WB = 0, OFF_MOD = 48 * MiB, OFF_H = 49 * MiB, OFF_U = OFF_H + 132 * MiB, OFF_R1 = OFF_U + 66 * MiB, OFF_R2 = OFF_R1 + 264 * MiB,
                 OFF_HBC = OFF_R2 + 132 * MiB, OFF_GATES = OFF_HBC + 4 * MiB, OFF_H2 = OFF_GATES + 3 * MiB, OFF_KCTX = OFF_H2 + 3 * MiB, WS_NEED = OFF_KCTX + 4 * MiB;
constexpr size_t WB_FIN0 = 0, WB_FIN1 = 11 * MiB, WB_FOUT0 = 22 * MiB, WB_FOUT1 = 22 * MiB + 5632 * 1024, WB_MIN = 33 * MiB, WB_MOUT = 41 * MiB, WB_WGT = 45 * MiB;
constexpr int LDS_BYTES = 163840;
struct KP { const float* in[36]; float* out; unsigned char* ws; int ph_lo, ph_hi; };
typedef const KP __attribute__((address_space(4))) * KPC;
enum { I_X = 0, I_C, I_CTX, I_CCTX, I_ADAW, I_ADAB, I_NORMG, I_FINALG, I_FFNIN, I_FFNOUT, I_HYWIN, I_HYBIN, I_HYCW, I_HYCB, I_HYW1, I_HYB1, I_HYW2, I_HYB2, I_HYW3, I_HYB3,
       I_HYFREQ, I_HYDECAY, I_HYSKIP, I_HYWOUT, I_HYBOUT, I_MLUP, I_MLCW, I_MLCB, I_MLWQ, I_MLWK, I_MLWV, I_MLWG, I_MLBG, I_MLNG, I_MLSKIP, I_MLDOWN };

__device__ __forceinline__ float bf2f(u16 b) { return __uint_as_float(((unsigned)b) << 16); }
__device__ __forceinline__ float bflo(unsigned w) { return __uint_as_float(w << 16); }
__device__ __forceinline__ float bfhi(unsigned w) { return __uint_as_float(w & 0xffff0000u); }
__device__ __forceinline__ u16 f2bf(float f) { return (u16)(pg8::cvt_pk_bf16(f, 0.f) & 0xffffu); }
__device__ __forceinline__ float siluf(float x) { return x * __builtin_amdgcn_rcpf(1.0f + __expf(-x)); }
__device__ __forceinline__ int modrow_of_token(int T) { const int b = T / TPB, t = T - b * TPB; return t < CTX ? 4 : b; }
__device__ __forceinline__ float lshfl(float v, int srclane) { return __int_as_float(__builtin_amdgcn_ds_bpermute(srclane << 2, __float_as_int(v))); }
#define DPPF(idv, v, ctrl, rmask) __int_as_float(__builtin_amdgcn_update_dpp(__float_as_int(idv), __float_as_int(v), ctrl, rmask, 0xF, false))
__device__ __forceinline__ float wave_sum(float v) {
    v += DPPF(0.f, v, 0x111, 0xF); v += DPPF(0.f, v, 0x112, 0xF); v += DPPF(0.f, v, 0x114, 0xF); v += DPPF(0.f, v, 0x118, 0xF);
    v += DPPF(0.f, v, 0x142, 0xA); v += DPPF(0.f, v, 0x143, 0xC);
    return __int_as_float(__builtin_amdgcn_readlane(__float_as_int(v), 63)); }
__device__ __forceinline__ float wave_max(float v) { const int lane = llane();
#pragma unroll
    for (int o = 32; o > 0; o >>= 1) v = fmaxf(v, lshfl(v, lane ^ o));
    return v; }

__device__ __forceinline__ void unpack8(u32x4v w, float (&f)[8]) { f[0] = bflo(w.x); f[1] = bfhi(w.x); f[2] = bflo(w.y); f[3] = bfhi(w.y); f[4] = bflo(w.z); f[5] = bfhi(w.z); f[6] = bflo(w.w); f[7] = bfhi(w.w); }
__device__ __forceinline__ u32x4v pack8(const float (&f)[8]) { u32x4v w; w.x = pg8::cvt_pk_bf16(f[0], f[1]); w.y = pg8::cvt_pk_bf16(f[2], f[3]); w.z = pg8::cvt_pk_bf16(f[4], f[5]); w.w = pg8::cvt_pk_bf16(f[6], f[7]); return w; }

struct EpiSwiglu {
    static constexpr bool PERM = true, AFTER_DRAIN = false;
    u16* act;
    __device__ __forceinline__ void operator()(const f32x4 (&acc)[2][2][4][2], const pg8::Unit& u, int wr, int wc, int fr, int fq) const {
        const int row0 = u.pm * 256 + wr * 64 + fr, col0 = u.pn * 128 + wc * 32 + 8 * fq;
#pragma unroll
        for (int ai = 0; ai < 2; ++ai)
#pragma unroll
            for (int m = 0; m < 4; ++m) {
                const f32x4 g0 = acc[ai][0][m][0], g1 = acc[ai][0][m][1], v0 = acc[ai][1][m][0], v1 = acc[ai][1][m][1];
                u32x4v w;
                w.x = pg8::cvt_pk_bf16(siluf(g0[0]) * v0[0], siluf(g0[1]) * v0[1]); w.y = pg8::cvt_pk_bf16(siluf(g0[2]) * v0[2], siluf(g0[3]) * v0[3]);
                w.z = pg8::cvt_pk_bf16(siluf(g1[0]) * v1[0], siluf(g1[1]) * v1[1]); w.w = pg8::cvt_pk_bf16(siluf(g1[2]) * v1[2], siluf(g1[3]) * v1[3]);
                *(u32x4v*)(act + (size_t)(row0 + ai * 128 + m * 16) * FF + col0) = w; }
    }
};
struct EpiResid {
    static constexpr bool PERM = false, AFTER_DRAIN = false;
    KPC kp; int l, gidx, bias_j;
    __device__ __forceinline__ void operator()(const f32x4 (&acc)[2][2][4][2], const pg8::Unit& u, int wr, int wc, int fr, int fq) const {
        unsigned char* ws = kp->ws; float* h = (float*)(ws + OFF_H); float* part = (float*)kp->out;
        const float* bias = bias_j >= 0 ? kp->in[I_HYBOUT] + (size_t)bias_j * D : nullptr; const float scale = gidx == 5 ? 1.0f : 0.5f;
        const int col0 = u.pn * 256 + wc * 32 + 4 * fq;
        const int mr = modrow_of_token(u.pm * 256);
        const float* gp = (const float*)(ws + OFF_MOD) + ((size_t)l * 5 + mr) * 9216 + gidx * 1024;
        const bool split = u.nt != 0, addb = bias != nullptr && u.kofs == 0;
        float* base = split ? part + ((size_t)(u.kofs >> 8) * 1024 + (u.pm / 33) * 256 + wr * 64 + fr) * D : h + (size_t)(u.pm * 256 + wr * 64 + fr) * D;
#pragma unroll
        for (int bj = 0; bj < 2; ++bj)
#pragma unroll
            for (int n = 0; n < 2; ++n) { const f32x4 gv = *(const f32x4*)(gp + col0 + bj * 128 + n * 16) * scale;
                const f32x4 bv = addb ? *(const f32x4*)(bias + col0 + bj * 128 + n * 16) : (f32x4){0.f, 0.f, 0.f, 0.f};
#pragma unroll
                for (int ai = 0; ai < 2; ++ai)
#pragma unroll
                    for (int m = 0; m < 4; ++m) { f32x4* q = (f32x4*)(base + (size_t)(ai * 128 + m * 16) * D + col0 + bj * 128 + n * 16); const f32x4 v = gv * (acc[ai][bj][m][n] + bv);
                        if (split) *q = v; else *q = *q + v; } }
    }
};
struct EpiBf {
    static constexpr bool PERM = true, AFTER_DRAIN = false;
    u16* O; int ldc;
    __device__ __forceinline__ void operator()(const f32x4 (&acc)[2][2][4][2], const pg8::Unit& u, int wr, int wc, int fr, int fq) const {
        const int row0 = u.pm * 256 + wr * 64 + fr, col0 = u.pn * 256 + wc * 32 + 8 * fq;
#pragma unroll
        for (int ai = 0; ai < 2; ++ai)
#pragma unroll
            for (int m = 0; m < 4; ++m)
#pragma unroll
                for (int bj = 0; bj < 2; ++bj) { const f32x4 a = acc[ai][bj][m][0], b = acc[ai][bj][m][1]; u32x4v w;
                    w.x = pg8::cvt_pk_bf16(a[0], a[1]); w.y = pg8::cvt_pk_bf16(a[2], a[3]); w.z = pg8::cvt_pk_bf16(b[0], b[1]); w.w = pg8::cvt_pk_bf16(b[2], b[3]);
                    *(u32x4v*)(O + (size_t)(row0 + ai * 128 + m * 16) * ldc + col0 + bj * 128) = w; }
    }
};
struct EpiProjT {
    static constexpr bool PERM = true, AFTER_DRAIN = false;
    u16* lat; u16* ctx; const float* bias;
    __device__ __forceinline__ void operator()(const f32x4 (&acc)[2][2][4][2], const pg8::Unit& u, int wr, int wc, int fr, int fq) const {
        const int row0 = u.pm * 256 + wr * 64 + fr, tc0 = wc * 32 + 8 * fq;
        const int b = u.pn / 33, tile = u.pn - b * 33;
#pragma unroll
        for (int ai = 0; ai < 2; ++ai)
#pragma unroll
            for (int m = 0; m < 4; ++m) { const int ch = row0 + ai * 128 + m * 16; const float bs = bias[ch];
                u16* dst = tile == 0 ? ctx + ((size_t)b * 3072 + ch) * CTX + tc0 : lat + ((size_t)b * 3072 + ch) * SEQ + (tile - 1) * 256 + tc0;
#pragma unroll
                for (int bj = 0; bj < 2; ++bj) { const f32x4 a = acc[ai][bj][m][0] + bs, c = acc[ai][bj][m][1] + bs; u32x4v w;
                    w.x = pg8::cvt_pk_bf16(a[0], a[1]); w.y = pg8::cvt_pk_bf16(a[2], a[3]); w.z = pg8::cvt_pk_bf16(c[0], c[1]); w.w = pg8::cvt_pk_bf16(c[2], c[3]);
                    *(u32x4v*)(dst + bj * 128) = w; } }
    }
};


struct LatOrder : pg8::StaticOrder {
    __device__ bool next(int i, pg8::Unit& u) const { if (!pg8::StaticOrder::next(i, u)) return false; u.pm = (u.pm >> 5) * 33 + 1 + (u.pm & 31); return true; }
};
struct CtxSplitOrder {
    int nk, G, c;
    __device__ bool next(int i, pg8::Unit& u) const { const int L = i * G + c; if (L >= 16 * nk) return false; const int un = L & 15, kc = L >> 4; u.pm = (un >> 2) * 33; u.pn = un & 3; u.kofs = kc * 256; return true; }
    __device__ __forceinline__ void a_ready(const pg8::Unit&) const {}
    __device__ __forceinline__ void done(const pg8::Unit&) const {}
};
struct EpiResidAtomic {
    static constexpr bool PERM = false, AFTER_DRAIN = false;
    float* h; const float* gp; float scale;
    __device__ __forceinline__ void operator()(const f32x4 (&acc)[2][2][4][2], const pg8::Unit& u, int wr, int wc, int fr, int fq) const {
        const int row0 = u.pm * 256 + wr * 64 + fr, col0 = u.pn * 256 + wc * 32 + 4 * fq;
#pragma unroll
        for (int bj = 0; bj < 2; ++bj)
#pragma unroll
            for (int n = 0; n < 2; ++n) { const f32x4 gv = *(const f32x4*)(gp + col0 + bj * 128 + n * 16) * scale;
#pragma unroll
                for (int ai = 0; ai < 2; ++ai)
#pragma unroll
                    for (int m = 0; m < 4; ++m) { float* q = h + (size_t)(row0 + ai * 128 + m * 16) * D + col0 + bj * 128 + n * 16; const f32x4 v = gv * acc[ai][bj][m][n];
                        atomicAdd(q, v[0]); atomicAdd(q + 1, v[1]); atomicAdd(q + 2, v[2]); atomicAdd(q + 3, v[3]); } }
    }
};

__device__ __forceinline__ void ctx_bias_phase(KPC kp, const float* gp, const float* bias) {
    float* h = (float*)(kp->ws + OFF_H);
    for (int i = lbid() * 512 + ltid(); i < NB * CTX * 256; i += gridDim.x * 512) { const int r = i >> 8, c = (i & 255) * 4, b = r >> 8, t = r & 255;
        f32x4* q = (f32x4*)(h + ((size_t)b * TPB + t) * D + c); *q = *q + *(const f32x4*)(gp + c) * *(const f32x4*)(bias + c); }
}
__device__ __forceinline__ int colmap(int n, int mapmode) { return mapmode ? (((n >> 8) << 7) + (n & 127) + ((n >> 7) & 1) * FF) : n; }
__device__ __forceinline__ void convert_T(const float* __restrict__ src, int ld, int K, int Nd, int mapmode, u16* __restrict__ dst, LAS float* tile, int& tctr) {
    const int tid = ltid(), nkt = K / 64, ntile = (Nd / 64) * nkt;
    const int G = (int)gridDim.x; const int first = (((lbid() - tctr) % G) + G) % G; tctr += ntile;
    for (int t = first; t < ntile; t += G) {
        const int n0 = (t / nkt) * 64, k0 = (t % nkt) * 64, c0 = colmap(n0, mapmode);
#pragma unroll
        for (int i = 0; i < 2; ++i) { const int e = tid + 512 * i, kr = e >> 4, c4 = (e & 15) * 4;
            const f32x4 v = *(const f32x4*)(src + (size_t)(k0 + kr) * ld + c0 + c4);
            tile[kr * 65 + c4] = v[0]; tile[kr * 65 + c4 + 1] = v[1]; tile[kr * 65 + c4 + 2] = v[2]; tile[kr * 65 + c4 + 3] = v[3]; }
        __syncthreads();
        { const int n = tid >> 3, k8 = (tid & 7) * 8; u32x4v w;
          w.x = pg8::cvt_pk_bf16(tile[(k8 + 0) * 65 + n], tile[(k8 + 1) * 65 + n]); w.y = pg8::cvt_pk_bf16(tile[(k8 + 2) * 65 + n], tile[(k8 + 3) * 65 + n]);
          w.z = pg8::cvt_pk_bf16(tile[(k8 + 4) * 65 + n], tile[(k8 + 5) * 65 + n]); w.w = pg8::cvt_pk_bf16(tile[(k8 + 6) * 65 + n], tile[(k8 + 7) * 65 + n]);
          *(u32x4v*)(dst + (size_t)(n0 + n) * K + k0 + k8) = w; }
        __syncthreads();
    }
}

__device__ __forceinline__ void norm_phase(KPC kp, int l, int sub, int nkp) {
    const float* h = (const float*)(kp->ws + OFF_H); u16* uo = (u16*)(kp->ws + OFF_U);
    const float* g = kp->in[I_NORMG] + (size_t)(l * 3 + sub) * D; const float* modl = (const float*)(kp->ws + OFF_MOD) + (size_t)l * 5 * 9216;
    const int lane = ltid() & 63, wv = ltid() >> 6;
    for (int T = lbid() * 8 + wv; T < NTOK; T += gridDim.x * 8) {
        const float* hr = h + (size_t)T * D; f32x4 v[4]; float ss = 0.f;
        const int bT = T / TPB, tT = T - bT * TPB; const bool fold = nkp > 0 && tT < CTX;
#pragma unroll
        for (int i = 0; i < 4; ++i) { v[i] = *(const f32x4*)(hr + i * 256 + lane * 4);
            if (fold) { const float* pp = (const float*)kp->out + ((size_t)bT * CTX + tT) * D + i * 256 + lane * 4; for (int kc = 0; kc < nkp; ++kc) v[i] += *(const f32x4*)(pp + (size_t)kc * 1024 * D);
                *(f32x4*)((float*)(kp->ws + OFF_H) + (size_t)T * D + i * 256 + lane * 4) = v[i]; }
            ss += v[i][0] * v[i][0] + v[i][1] * v[i][1] + v[i][2] * v[i][2] + v[i][3] * v[i][3]; }
        ss = wave_sum(ss); const float rs = rsqrtf(ss * (1.0f / D) + 1e-6f);
        const float* mp = modl + (size_t)modrow_of_token(T) * 9216 + sub * 3 * 1024;
#pragma unroll
        for (int i = 0; i < 4; ++i) { const int c = i * 256 + lane * 4; const f32x4 gg = *(const f32x4*)(g + c), sh = *(const f32x4*)(mp + c), sc = *(const f32x4*)(mp + 1024 + c);
            const f32x4 o = v[i] * rs * gg * (sc + 1.0f) + sh; u32x2 w; w.x = pg8::cvt_pk_bf16(o[0], o[1]); w.y = pg8::cvt_pk_bf16(o[2], o[3]);
            *(u32x2*)(uo + (size_t)T * D + c) = w; }
    }
}

__device__ __forceinline__ void final_phase(KPC kp) {
    const float* h = (const float*)(kp->ws + OFF_H); const float* g = kp->in[I_FINALG];
    const int lane = ltid() & 63, wv = ltid() >> 6;
    for (int r = lbid() * 8 + wv; r < NB * SEQ; r += gridDim.x * 8) {
        const int b = r / SEQ, s = r - b * SEQ; const float* hr = h + ((size_t)b * TPB + CTX + s) * D; f32x4 v[4]; float ss = 0.f;
#pragma unroll
        for (int i = 0; i < 4; ++i) { v[i] = *(const f32x4*)(hr + i * 256 + lane * 4); ss += v[i][0] * v[i][0] + v[i][1] * v[i][1] + v[i][2] * v[i][2] + v[i][3] * v[i][3]; }
        ss = wave_sum(ss); const float rs = rsqrtf(ss * (1.0f / D) + 1e-6f);
#pragma unroll
        for (int i = 0; i < 4; ++i) { const int c = i * 256 + lane * 4; *(f32x4*)(kp->out + (size_t)r * D + c) = v[i] * rs * *(const f32x4*)(g + c); }
    }
}

__device__ __forceinline__ void setup_phase(KPC kp, LAS float* ldsf) {
    float* h = (float*)(kp->ws + OFF_H); const int tid = ltid();
    const int hb0 = gridDim.x > 64 ? 32 : 0;
    for (size_t i = (size_t)(lbid() - hb0) * 512 + tid; lbid() >= hb0 && i < (size_t)NTOK * 256; i += (size_t)(gridDim.x - hb0) * 512) {
        const int T = (int)(i >> 8), c = ((int)i & 255) * 4, b = T / TPB, t = T - b * TPB; f32x4 v;
        if (t < CTX) v = *(const f32x4*)(kp->in[I_CTX] + ((size_t)b * CTX + t) * D + c);
        else { const int s = t - CTX; v = *(const f32x4*)(kp->in[I_X] + ((size_t)b * SEQ + s) * D + c);
            const int half = c >> 9, cc = c & 511, isc = cc >> 8, i0 = cc & 255; const float pv = half ? (float)(s & 63) : (float)(s >> 6);
#pragma unroll
            for (int e = 0; e < 4; ++e) { const float om = exp2f(-13.287712379549449f * (float)(i0 + e) * (1.0f / 256.0f)); const float ang = pv * om; v[e] += isc ? __cosf(ang) : __sinf(ang); } }
        *(f32x4*)(h + (size_t)T * D + c) = v;
    }
    LAS float* sc = ldsf; LAS float* red = ldsf + 5 * 1024;
    for (int i = tid; i < 5 * 1024; i += 512) { const int r = i >> 10, k = i & 1023; const float cv = r < 4 ? kp->in[I_C][r * D + k] : kp->in[I_CCTX][k]; sc[i] = siluf(cv); }
    __syncthreads();
    float* mod = (float*)(kp->ws + OFF_MOD); const int lane = tid & 63, wv = tid >> 6;
    for (int task = lbid(); task < 288; task += gridDim.x) {
        const int l = task / 72, n0 = (task % 72) * 128 + lane * 2; const float* w = kp->in[I_ADAW] + (size_t)l * D * 9216 + n0;
        f32x2 a[5];
#pragma unroll
        for (int r = 0; r < 5; ++r) a[r] = (f32x2){0.f, 0.f};
#pragma unroll 16
        for (int k = wv * 128; k < wv * 128 + 128; ++k) { const f32x2 wv2 = *(const f32x2*)(w + (size_t)k * 9216);
#pragma unroll
            for (int r = 0; r < 5; ++r) a[r] += wv2 * sc[r * 1024 + k]; }
#pragma unroll
        for (int r = 0; r < 5; ++r) { red[(wv * 5 + r) * 128 + lane * 2] = a[r][0]; red[(wv * 5 + r) * 128 + lane * 2 + 1] = a[r][1]; }
        __syncthreads();
        for (int i = tid; i < 640; i += 512) { const int r = i >> 7, n = i & 127; float s = 0.f;
#pragma unroll
            for (int w8 = 0; w8 < 8; ++w8) s += red[(w8 * 5 + r) * 128 + n];
            const int nn = (task % 72) * 128 + n; mod[((size_t)l * 5 + r) * 9216 + nn] = s + kp->in[I_ADAB][(size_t)l * 9216 + nn]; }
        __syncthreads();
    }
}

__device__ __forceinline__ void convert_layer(KPC kp, int l, LAS float* tile) {
    unsigned char* wb = kp->ws + OFF_WB; int tctr = 0; const int j = l >> 1;
    for (int f = 0; f < 2; ++f) {
        convert_T(kp->in[I_FFNIN] + (size_t)(l * 2 + f) * D * 2 * FF, 2 * FF, D, 2 * FF, 1, (u16*)(wb + (f ? WB_FIN1 : WB_FIN0)), tile, tctr);
        convert_T(kp->in[I_FFNOUT] + (size_t)(l * 2 + f) * FF * D, D, FF, D, 0, (u16*)(wb + (f ? WB_FOUT1 : WB_FOUT0)), tile, tctr);
    }
    if ((l & 1) == 0) {
        convert_T(kp->in[I_HYWIN] + (size_t)j * D * 3 * D, 3 * D, D, 3 * D, 0, (u16*)(wb + WB_MIN), tile, tctr);
        convert_T(kp->in[I_HYWOUT] + (size_t)j * D * D, D, D, D, 0, (u16*)(wb + WB_MOUT), tile, tctr);
    } else {
        convert_T(kp->in[I_MLUP] + (size_t)j * D * 2 * INNER, 2 * INNER, D, 2 * INNER, 0, (u16*)(wb + WB_MIN), tile, tctr);
        convert_T(kp->in[I_MLDOWN] + (size_t)j * INNER * D, D, INNER, D, 0, (u16*)(wb + WB_MOUT), tile, tctr);
        u16* wg = (u16*)(wb + WB_WGT); const float* src = kp->in[I_MLWG] + (size_t)j * 3 * INNER * 16;
        for (int i = lbid() * 512 + ltid(); i < 16 * 3 * INNER; i += gridDim.x * 512) { const int o = i / (3 * INNER), k = i - o * 3 * INNER; wg[i] = f2bf(src[(size_t)k * 16 + o]); }
        float* gates = (float*)(kp->ws + OFF_GATES); const float* bg = kp->in[I_MLBG] + j * 16;
        for (int i = lbid() * 512 + ltid(); i < NTOK * 16; i += gridDim.x * 512) gates[i] = bg[i & 15];
    }
}

constexpr size_t HY_PL = 0, HY_PC = (size_t)NB * 3072 * SEQ * 2, HY_YL = HY_PC + (size_t)NB * 3072 * CTX * 2, HY_YC = HY_YL + (size_t)NB * D * SEQ * 2;
__device__ __forceinline__ int fphys(int i) { return i ^ ((((i >> 6) & 1) * 21) ^ (((i >> 5) & 1) * 10)); }
__device__ __forceinline__ f32x2 cmul(f32x2 a, f32x2 b) { return (f32x2){a.x * b.x - a.y * b.y, a.x * b.y + a.y * b.x}; }
__device__ __forceinline__ f32x2 cmulc(f32x2 a, f32x2 b) { return (f32x2){a.x * b.x + a.y * b.y, a.y * b.x - a.x * b.y}; }
__device__ __forceinline__ int drev(int x) { const unsigned r = __brev((unsigned)x) >> 18; return (int)(((r & 0x2AAAu) >> 1) | ((r & 0x1555u) << 1)); }

__device__ __forceinline__ void fidx4(int base, int lm, int (&ix)[4]) {
    const int m = 1 << lm;
    if (lm == 6) { const int i0 = fphys(base); ix[0] = i0; ix[1] = (i0 + 64) ^ 21; ix[2] = i0 + 128; ix[3] = (i0 + 192) ^ 21; }
    else if (lm == 4) { const int c6 = ((base >> 6) & 1) * 21; ix[0] = base ^ c6; ix[1] = (base + 16) ^ c6; ix[2] = (base + 32) ^ c6 ^ 10; ix[3] = (base + 48) ^ c6 ^ 10; }
    else { const int c = (((base >> 6) & 1) * 21) ^ (((base >> 5) & 1) * 10); ix[0] = base ^ c; ix[1] = (base + m) ^ c; ix[2] = (base + 2 * m) ^ c; ix[3] = (base + 3 * m) ^ c; }
}
__device__ __forceinline__ void fft_fwd(LAS f32x2* buf, const f32x2* Kmul = nullptr, bool zpad = false) {
    const int tid = ltid();
    for (int lm = 12; lm >= 0; lm -= 2) {
        const int m = 1 << lm; const float inv = 1.0f / (float)(4 << lm);
        f32x2 a[8][4]; int ix[8][4];
#pragma unroll
        for (int i = 0; i < 8; ++i) { const int g = tid + 512 * i, p = g & (m - 1), base = ((g >> lm) << (lm + 2)) + p; fidx4(base, lm, ix[i]);
            if (zpad && lm == 12) { a[i][0] = buf[ix[i][0]]; a[i][1] = buf[ix[i][1]]; a[i][2] = (f32x2){0.f, 0.f}; a[i][3] = (f32x2){0.f, 0.f}; }
            else {
#pragma unroll
                for (int r = 0; r < 4; ++r) a[i][r] = buf[ix[i][r]]; } }
#pragma unroll
        for (int i = 0; i < 8; ++i) { const int p = (tid + 512 * i) & (m - 1);
            const f32x2 t0 = a[i][0] + a[i][2], t1 = a[i][0] - a[i][2], t2 = a[i][1] + a[i][3], dd = a[i][1] - a[i][3], t3 = (f32x2){dd.y, -dd.x};
            if (lm == 0) {
                f32x2 y0 = t0 + t2, y1 = t1 + t3, y2 = t0 - t2, y3 = t1 - t3;
                if (Kmul) { const f32x4 ka = *(const f32x4*)(Kmul + 4 * (tid + 512 * i)), kb = *(const f32x4*)(Kmul + 4 * (tid + 512 * i) + 2);
                    y0 = cmul(y0, (f32x2){ka[0], ka[1]}); y1 = cmul(y1, (f32x2){ka[2], ka[3]}); y2 = cmul(y2, (f32x2){kb[0], kb[1]}); y3 = cmul(y3, (f32x2){kb[2], kb[3]}); }
                buf[ix[i][0]] = y0; buf[ix[i][1]] = y1; buf[ix[i][2]] = y2; buf[ix[i][3]] = y3; }
            else { const float rev = (float)p * inv;
                const f32x2 w1 = (f32x2){__builtin_amdgcn_cosf(rev), -__builtin_amdgcn_sinf(rev)}, w2 = cmul(w1, w1), w3 = cmul(w2, w1);
                buf[ix[i][0]] = t0 + t2; buf[ix[i][1]] = cmul(t1 + t3, w1); buf[ix[i][2]] = cmul(t0 - t2, w2); buf[ix[i][3]] = cmul(t1 - t3, w3); } }
        __syncthreads();
    }
}
__device__ __forceinline__ void fft_inv(LAS f32x2* buf, bool half = false) {
    const int tid = ltid();
    for (int lm = 0; lm <= 12; lm += 2) {
        const int m = 1 << lm; const float inv = 1.0f / (float)(4 << lm);
        f32x2 a[8][4]; int ix[8][4];
#pragma unroll
        for (int i = 0; i < 8; ++i) { const int g = tid + 512 * i, p = g & (m - 1), base = ((g >> lm) << (lm + 2)) + p; fidx4(base, lm, ix[i]);
#pragma unroll
            for (int r = 0; r < 4; ++r) a[i][r] = buf[ix[i][r]]; }
#pragma unroll
        for (int i = 0; i < 8; ++i) { const int p = (tid + 512 * i) & (m - 1);
            f32x2 b0 = a[i][0], b1 = a[i][1], b2 = a[i][2], b3 = a[i][3];
            if (lm != 0) { const float rev = (float)p * inv;
                const f32x2 w1 = (f32x2){__builtin_amdgcn_cosf(rev), -__builtin_amdgcn_sinf(rev)}, w2 = cmul(w1, w1), w3 = cmul(w2, w1);
                b1 = cmulc(b1, w1); b2 = cmulc(b2, w2); b3 = cmulc(b3, w3); }
            const f32x2 s0 = b0 + b2, s1 = b0 - b2, s2 = b1 + b3, dd = b1 - b3, s3 = (f32x2){-dd.y, dd.x};
            buf[ix[i][0]] = s0 + s2; buf[ix[i][1]] = s1 + s3; if (!(half && lm == 12)) { buf[ix[i][2]] = s0 - s2; buf[ix[i][3]] = s1 - s3; } }
        __syncthreads();
    }
}

__device__ __forceinline__ void hy_mlp_phase(KPC kp, int j) {
    float* h2 = (float*)(kp->ws + OFF_H2);
    const float* w1 = kp->in[I_HYW1] + j * 33 * 64; const float* b1 = kp->in[I_HYB1] + j * 64; const float* w2 = kp->in[I_HYW2] + j * 64 * 64; const float* b2 = kp->in[I_HYB2] + j * 64;
    const float* fr = kp->in[I_HYFREQ] + j * 128; const int lane = ltid() & 63, wv = ltid() >> 6;
    for (int pos = lbid() * 8 + wv; pos < SEQ + CTX; pos += gridDim.x * 8) {
        const int n = pos < SEQ ? SEQ : CTX, t = pos < SEQ ? pos : pos - SEQ; const float tn = (float)t / (float)(n - 1);
        float feat = 0.f;
        if (lane == 0) feat = tn;
        else if (lane < 33) { const int bi = (lane - 1) & 15; const float band = 1e-4f + (float)bi * ((15.0f - 1e-4f) / 15.0f); float rev = ((float)t / (float)n) * band; rev -= floorf(rev);
            const float ang = 6.283185307179586f * rev; feat = lane < 17 ? cosf(ang) : -sinf(ang); }
        float z = b1[lane];
        for (int i = 0; i < 33; ++i) z += lshfl(feat, i) * w1[i * 64 + lane];
        const float h1 = sinf(fr[lane] * z);
        float z2 = b2[lane];
        for (int v = 0; v < 64; ++v) z2 += lshfl(h1, v) * w2[v * 64 + lane];
        h2[(size_t)pos * 64 + lane] = sinf(fr[64 + lane] * z2);
    }
}

__device__ __forceinline__ void block_sum2(float& a, float& b, LAS float* red) {
    a = wave_sum(a); b = wave_sum(b); const int lane = ltid() & 63, wv = ltid() >> 6;
    __syncthreads(); if (lane == 0) { red[wv] = a; red[8 + wv] = b; } __syncthreads();
    float sa = 0.f, sb = 0.f;
#pragma unroll
    for (int i = 0; i < 8; ++i) { sa += red[i]; sb += red[8 + i]; }
    a = sa; b = sb;
}

__device__ __forceinline__ void hy_filter_task(KPC kp, int j, int task, LAS f32x2* buf, LAS float* aux) {
    const int tid = ltid(), d = task & 1023; const bool lat = task < 1024;
    const float* w3 = kp->in[I_HYW3] + (size_t)j * 64 * 4096; const float* b3 = kp->in[I_HYB3] + j * 4096; const float* ldc = kp->in[I_HYDECAY] + j * 4096;
    __syncthreads();
    if (tid < 256) aux[tid] = w3[(size_t)(tid & 63) * 4096 + (tid >> 6) * 1024 + d];
    if (tid < 4) { aux[256 + tid] = b3[tid * 1024 + d]; aux[260 + tid] = __expf(ldc[tid * 1024 + d]); }
    __syncthreads();
    const float* h2 = (const float*)(kp->ws + OFF_H2);
    float ss0 = 0.f, ss1 = 0.f;
    if (lat) {
        for (int r = 0; r < 16; ++r) { const int i = tid + 512 * r; float a0 = aux[256], a1 = aux[257], a2 = aux[258], a3 = aux[259];
#pragma unroll 4
            for (int u4 = 0; u4 < 16; ++u4) { const f32x4 hv = *(const f32x4*)(h2 + (size_t)i * 64 + u4 * 4);
                const f32x4 q0 = *(const LAS f32x4*)(aux + u4 * 4), q1 = *(const LAS f32x4*)(aux + 64 + u4 * 4), q2 = *(const LAS f32x4*)(aux + 128 + u4 * 4), q3 = *(const LAS f32x4*)(aux + 192 + u4 * 4);
#pragma unroll
                for (int e = 0; e < 4; ++e) { a0 += hv[e] * q0[e]; a1 += hv[e] * q1[e]; a2 += hv[e] * q2[e]; a3 += hv[e] * q3[e]; } }
            const float tn = (float)i * (1.0f / 8191.0f);
            a0 *= __expf(-tn * aux[260]); a1 *= __expf(-tn * aux[261]); a2 *= __expf(-tn * aux[262]); a3 *= __expf(-tn * aux[263]);
            buf[fphys(i)] = (f32x2){a0, a2}; ss0 += a0 * a0; ss1 += a2 * a2;
            if (i >= 1) { buf[fphys(NFFT - i)] = (f32x2){a1, a3}; ss0 += a1 * a1; ss1 += a3 * a3; } }
        if (tid == 0) buf[fphys(SEQ)] = (f32x2){0.f, 0.f};
        block_sum2(ss0, ss1, aux + 272);
        const f32x2 scl = (f32x2){rsqrtf(ss0 + 1e-12f) * (1.0f / NFFT), rsqrtf(ss1 + 1e-12f) * (1.0f / NFFT)};
        fft_fwd(buf);
        f32x2* K0 = (f32x2*)(kp->ws + OFF_R2) + (size_t)d * NFFT; f32x2* K1 = (f32x2*)kp->out + (size_t)d * NFFT;
        for (int r = 0; r < 32; ++r) { const int pos = tid + 512 * r, k = drev(pos), pos2 = drev((NFFT - k) & (NFFT - 1)); const f32x2 Z = buf[fphys(pos)], Z2 = buf[fphys(pos2)];
            K0[pos] = (f32x2){(Z.x + Z2.x), (Z.y - Z2.y)} * (0.5f * scl.x); K1[pos] = (f32x2){(Z.y + Z2.y), -(Z.x - Z2.x)} * (0.5f * scl.y); }
    } else {
        const int idx = tid; float a0 = 0.f, a1 = 0.f;
        if (idx != CTX) { const int t = idx < CTX ? idx : 2 * CTX - idx, dir = idx < CTX ? 0 : 1; a0 = aux[256 + dir]; a1 = aux[258 + dir];
            for (int u4 = 0; u4 < 16; ++u4) { const f32x4 hv = *(const f32x4*)(h2 + (size_t)(SEQ + t) * 64 + u4 * 4);
#pragma unroll
                for (int e = 0; e < 4; ++e) { const int u = u4 * 4 + e; a0 += hv[e] * aux[dir * 64 + u]; a1 += hv[e] * aux[128 + dir * 64 + u]; } }
            const float tn = (float)t * (1.0f / 255.0f); a0 *= __expf(-tn * aux[260 + dir]); a1 *= __expf(-tn * aux[262 + dir]); }
        ss0 = a0 * a0; ss1 = a1 * a1;
        block_sum2(ss0, ss1, aux + 272);
        float* kc = (float*)(kp->ws + OFF_KCTX);
        kc[(size_t)d * 512 + idx] = a0 * rsqrtf(ss0 + 1e-12f); kc[(size_t)(1024 + d) * 512 + idx] = a1 * rsqrtf(ss1 + 1e-12f);
    }
}

__device__ __forceinline__ float ld3(const u16* row, int t, int n, float wa, float wb, float wc, float bias) {
    const float xm = t > 0 ? bf2f(row[t - 1]) : 0.f, x0 = bf2f(row[t]), xp = t < n - 1 ? bf2f(row[t + 1]) : 0.f; return wa * xm + wb * x0 + wc * xp + bias; }

__device__ __forceinline__ void ld3x8(const u16* row, int t0, float wa, float wb, float wc, float bias, float (&o)[8]) {
    const u32x4v w = *(const u32x4v*)(row + t0);
    const float x0 = bflo(w.x), x1 = bfhi(w.x), x2 = bflo(w.y), x3 = bfhi(w.y), x4 = bflo(w.z), x5 = bfhi(w.z), x6 = bflo(w.w), x7 = bfhi(w.w);
    const float xl = t0 > 0 ? bf2f(row[t0 - 1]) : 0.f, xr = t0 + 8 < SEQ ? bf2f(row[t0 + 8]) : 0.f;
    o[0] = wa * xl + wb * x0 + wc * x1 + bias; o[1] = wa * x0 + wb * x1 + wc * x2 + bias; o[2] = wa * x1 + wb * x2 + wc * x3 + bias; o[3] = wa * x2 + wb * x3 + wc * x4 + bias;
    o[4] = wa * x3 + wb * x4 + wc * x5 + bias; o[5] = wa * x4 + wb * x5 + wc * x6 + bias; o[6] = wa * x5 + wb * x6 + wc * x7 + bias; o[7] = wa * x6 + wb * x7 + wc * xr + bias;
}
__device__ __forceinline__ void hy_conv_lat(KPC kp, int j, int task, LAS f32x2* buf) {
    const int tid = ltid(), bp = task >> 10, c = task & 1023, b0 = bp * 2;
    const u16* pl = (const u16*)(kp->ws + OFF_R1 + HY_PL); u16* yl = (u16*)(kp->ws + OFF_R1 + HY_YL);
    const float* cw = kp->in[I_HYCW] + (size_t)j * 3 * 3072; const float* cb = kp->in[I_HYCB] + j * 3072;
    const float w1a = cw[c], w1b = cw[3072 + c], w1c = cw[6144 + c], bb1 = cb[c];
    const float w2a = cw[1024 + c], w2b = cw[3072 + 1024 + c], w2c = cw[6144 + 1024 + c], bb2 = cb[1024 + c];
    const float w3a = cw[2048 + c], w3b = cw[3072 + 2048 + c], w3c = cw[6144 + 2048 + c], bb3 = cb[2048 + c];
    const float sk0 = kp->in[I_HYSKIP][j * 2048 + c], sk1 = kp->in[I_HYSKIP][j * 2048 + 1024 + c];
    const u16* x1r0 = pl + ((size_t)b0 * 3072 + c) * SEQ; const u16* x1r1 = x1r0 + (size_t)3072 * SEQ;
    const u16* x2r0 = x1r0 + (size_t)1024 * SEQ; const u16* x2r1 = x1r1 + (size_t)1024 * SEQ;
    const u16* vr0 = x1r0 + (size_t)2048 * SEQ; const u16* vr1 = x1r1 + (size_t)2048 * SEQ;
    const f32x2* K0 = (const f32x2*)(kp->ws + OFF_R2) + (size_t)c * NFFT; const f32x2* K1 = (const f32x2*)kp->out + (size_t)c * NFFT;
    __syncthreads();
#pragma unroll
    for (int g = 0; g < 2; ++g) { const int t0 = 8 * (tid + 512 * g); float v0[8], v1[8];
        ld3x8(vr0, t0, w3a, w3b, w3c, bb3, v0); ld3x8(vr1, t0, w3a, w3b, w3c, bb3, v1);
#pragma unroll
        for (int e = 0; e < 8; ++e) buf[fphys(t0 + e)] = (f32x2){v0[e], v1[e]}; }
    __syncthreads();
#ifdef PROBE_FFT
    for (int rp = 0; rp < PROBE_FFT; ++rp) { fft_fwd(buf); fft_inv(buf); for (int r = 0; r < 32; ++r) { const int q = fphys(tid + 512 * r); buf[q] = buf[q] * (1.0f / NFFT); } __syncthreads(); }
#endif
    fft_fwd(buf, K0, true);
    fft_inv(buf, true);
    float zr[32];
#pragma unroll
    for (int g = 0; g < 2; ++g) { const int t0 = 8 * (tid + 512 * g); float v0[8], v1[8], xa[8], xb[8];
        ld3x8(vr0, t0, w3a, w3b, w3c, bb3, v0); ld3x8(vr1, t0, w3a, w3b, w3c, bb3, v1); ld3x8(x1r0, t0, w1a, w1b, w1c, bb1, xa); ld3x8(x1r1, t0, w1a, w1b, w1c, bb1, xb);
#pragma unroll
        for (int e = 0; e < 8; ++e) { const f32x2 y = buf[fphys(t0 + e)]; const float z0 = xa[e] * (y.x + sk0 * v0[e]), z1 = xb[e] * (y.y + sk0 * v1[e]);
            zr[g * 16 + 2 * e] = z0; zr[g * 16 + 2 * e + 1] = z1; buf[fphys(t0 + e)] = (f32x2){z0, z1}; } }
    __syncthreads();
    fft_fwd(buf, K1, true);
    fft_inv(buf, true);
#pragma unroll
    for (int g = 0; g < 2; ++g) { const int t0 = 8 * (tid + 512 * g); float xa[8], xb[8], o0[8], o1[8];
        ld3x8(x2r0, t0, w2a, w2b, w2c, bb2, xa); ld3x8(x2r1, t0, w2a, w2b, w2c, bb2, xb);
#pragma unroll
        for (int e = 0; e < 8; ++e) { const f32x2 y = buf[fphys(t0 + e)]; o0[e] = xa[e] * (y.x + sk1 * zr[g * 16 + 2 * e]); o1[e] = xb[e] * (y.y + sk1 * zr[g * 16 + 2 * e + 1]); }
        *(u32x4v*)(yl + ((size_t)b0 * D + c) * SEQ + t0) = pack8(o0); *(u32x4v*)(yl + ((size_t)(b0 + 1) * D + c) * SEQ + t0) = pack8(o1); }
}

__device__ __forceinline__ void hy_conv_ctx(KPC kp, int j, int c, LAS float* ls) {
    const int tid = ltid();
    const u16* pc = (const u16*)(kp->ws + OFF_R1 + HY_PC); u16* yc = (u16*)(kp->ws + OFF_R1 + HY_YC); const float* kc = (const float*)(kp->ws + OFF_KCTX);
    const float* cw = kp->in[I_HYCW] + (size_t)j * 3 * 3072; const float* cb = kp->in[I_HYCB] + j * 3072;
    const float w1a = cw[c], w1b = cw[3072 + c], w1c = cw[6144 + c], bb1 = cb[c];
    const float w2a = cw[1024 + c], w2b = cw[3072 + 1024 + c], w2c = cw[6144 + 1024 + c], bb2 = cb[1024 + c];
    const float w3a = cw[2048 + c], w3b = cw[3072 + 2048 + c], w3c = cw[6144 + 2048 + c], bb3 = cb[2048 + c];
    const float sk0 = kp->in[I_HYSKIP][j * 2048 + c], sk1 = kp->in[I_HYSKIP][j * 2048 + 1024 + c];
    __syncthreads();
    ls[tid] = kc[(size_t)c * 512 + tid]; ls[512 + tid] = kc[(size_t)(1024 + c) * 512 + tid];
    for (int i = 0; i < 2; ++i) { const int e = tid + 512 * i, b = e >> 8, t = e & 255; ls[1024 + e] = ld3(pc + ((size_t)b * 3072 + 2048 + c) * CTX, t, CTX, w3a, w3b, w3c, bb3); }
    __syncthreads();
    const int cb_ = tid >> 6, t0 = (tid & 63) * 4; const bool act = tid < 256;
    auto conv4 = [&](int kofs, int xofs, float (&acc)[4]) {
        float w[7];
#pragma unroll
        for (int i = 0; i < 7; ++i) w[i] = ls[kofs + ((t0 + 3 - i) & 511)];
        acc[0] = acc[1] = acc[2] = acc[3] = 0.f;
        for (int s = 0; s < CTX; s += 4) { const f32x4 v4 = *(const LAS f32x4*)(ls + xofs + cb_ * 256 + s);
#pragma unroll
            for (int cc = 0; cc < 4; ++cc)
#pragma unroll
                for (int a = 0; a < 4; ++a) acc[a] += w[3 - a + cc] * v4[cc];
            w[0] = w[4]; w[1] = w[5]; w[2] = w[6];
#pragma unroll
            for (int i = 3; i < 7; ++i) w[i] = ls[kofs + ((t0 + 3 - (s + 4) - i) & 511)]; } };
    float zr[4] = {0.f, 0.f, 0.f, 0.f};
    if (act) { float acc[4]; conv4(0, 1024, acc);
#pragma unroll
        for (int a = 0; a < 4; ++a) zr[a] = ld3(pc + ((size_t)cb_ * 3072 + c) * CTX, t0 + a, CTX, w1a, w1b, w1c, bb1) * (acc[a] + sk0 * ls[1024 + cb_ * 256 + t0 + a]);
        *(LAS f32x4*)(ls + 2048 + cb_ * 256 + t0) = (f32x4){zr[0], zr[1], zr[2], zr[3]}; }
    __syncthreads();
    if (act) { float acc[4]; conv4(512, 2048, acc); float o[4];
#pragma unroll
        for (int a = 0; a < 4; ++a) o[a] = ld3(pc + ((size_t)cb_ * 3072 + 1024 + c) * CTX, t0 + a, CTX, w2a, w2b, w2c, bb2) * (acc[a] + sk1 * zr[a]);
        u32x2 w; w.x = pg8::cvt_pk_bf16(o[0], o[1]); w.y = pg8::cvt_pk_bf16(o[2], o[3]); *(u32x2*)(yc + ((size_t)cb_ * D + c) * CTX + t0) = w; }
}

__device__ __forceinline__ void hy_transpose(KPC kp, LAS u16* tl) {
    const u16* yl = (const u16*)(kp->ws + OFF_R1 + HY_YL); const u16* yc = (const u16*)(kp->ws + OFF_R1 + HY_YC); u16* y = (u16*)(kp->ws + OFF_U); const int tid = ltid();
    for (int tile = lbid(); tile < NB * 16 * NCH; tile += gridDim.x) {
        const int b = tile / (16 * NCH), rem = tile - b * 16 * NCH, ct = rem / NCH, tt = rem - ct * NCH;
        const u16* src = tt < 4 ? yc + ((size_t)b * D + ct * 64) * CTX + tt * 64 : yl + ((size_t)b * D + ct * 64) * SEQ + (tt - 4) * 64; const int ld = tt < 4 ? CTX : SEQ;
        { const int cr = tid >> 3, t8 = (tid & 7) * 8; *(LAS u32x4v*)(tl + cr * 72 + t8) = *(const u32x4v*)(src + (size_t)cr * ld + t8); }
        __syncthreads();
        { const int tr = tid >> 3, c8 = (tid & 7) * 8; u32x4v w;
          w.x = (unsigned)tl[(c8 + 0) * 72 + tr] | ((unsigned)tl[(c8 + 1) * 72 + tr] << 16); w.y = (unsigned)tl[(c8 + 2) * 72 + tr] | ((unsigned)tl[(c8 + 3) * 72 + tr] << 16);
          w.z = (unsigned)tl[(c8 + 4) * 72 + tr] | ((unsigned)tl[(c8 + 5) * 72 + tr] << 16); w.w = (unsigned)tl[(c8 + 6) * 72 + tr] | ((unsigned)tl[(c8 + 7) * 72 + tr] << 16);
          *(u32x4v*)(y + ((size_t)b * TPB + tt * 64 + tr) * D + ct * 64 + c8) = w; }
        __syncthreads();
    }
}

constexpr size_t OFF_XM = OFF_R1, OFF_XC = OFF_R1 + 132 * MiB, OFF_S = WS_NEED, OFF_MLM = OFF_S + 34 * MiB, WS_NEED2 = OFF_MLM + 1 * MiB;
__device__ __forceinline__ u16* hb_ptr(KPC kp, int T) { const int b = T / TPB, t = T - b * TPB;
    return t < CTX ? (u16*)(kp->ws + OFF_HBC) + ((size_t)b * CTX + t) * INNER : (u16*)kp->out + ((size_t)b * SEQ + (t - CTX)) * INNER; }
__device__ __forceinline__ void bd8(const float (&x)[8], const float (&w)[32], float (&y)[8]) {
#pragma unroll
    for (int bl = 0; bl < 2; ++bl)
#pragma unroll
        for (int e = 0; e < 4; ++e) { float s = 0.f;
#pragma unroll
            for (int d = 0; d < 4; ++d) s += x[bl * 4 + d] * w[bl * 16 + d * 4 + e];
            y[bl * 4 + e] = s; }
}
typedef float f32x8s __attribute__((ext_vector_type(8)));
__device__ __forceinline__ void sload32(const float* p, float (&w)[32]) {
    f32x8s a, b, c, d;
    asm volatile("s_load_dwordx8 %0, %4, 0x0\n\ts_load_dwordx8 %1, %4, 0x20\n\ts_load_dwordx8 %2, %4, 0x40\n\ts_load_dwordx8 %3, %4, 0x60\n\ts_waitcnt lgkmcnt(0)"
                 : "=&s"(a), "=&s"(b), "=&s"(c), "=&s"(d) : "s"(p) : "memory");
#pragma unroll
    for (int i = 0; i < 8; ++i) { w[i] = a[i]; w[8 + i] = b[i]; w[16 + i] = c[i]; w[24 + i] = d[i]; }
}
__device__ __forceinline__ void ldw32(const float* p, float (&w)[32]) {
#pragma unroll
    for (int i = 0; i < 8; ++i) { const f32x4 v = *(const f32x4*)(p + i * 4); w[i * 4] = v[0]; w[i * 4 + 1] = v[1]; w[i * 4 + 2] = v[2]; w[i * 4 + 3] = v[3]; } }

__device__ __forceinline__ void ml_m_phase(KPC kp, int j) {
    float* M = (float*)(kp->ws + OFF_MLM) + (size_t)j * 8192;
    const float* wq = kp->in[I_MLWQ] + (size_t)j * 512 * 16; const float* wk = kp->in[I_MLWK] + (size_t)j * 512 * 16;
    for (int i = lbid() * 512 + ltid(); i < 512 * 16; i += gridDim.x * 512) { const int blk = i >> 4, d = (i >> 2) & 3, d2 = i & 3; float s = 0.f;
#pragma unroll
        for (int e = 0; e < 4; ++e) s += wq[blk * 16 + d * 4 + e] * wk[blk * 16 + d2 * 4 + e];
        M[i] = s * 0.04419417382415922f; }
}

__device__ __forceinline__ void ml_prep_task(KPC kp, int j, int task, LAS unsigned char* lds) {
    const int tid = ltid(), lane = tid & 63, wv = tid >> 6, fr = lane & 15, fq = lane >> 4;
    const int hd = task & 3, bc = task >> 2, b = bc / NCH, ci = bc - b * NCH;
    const u16* xm = (const u16*)(kp->ws + OFF_XM); u16* xc = (u16*)(kp->ws + OFF_XC);
    const int T0 = b * TPB + ci * 64, tlo = b * TPB + (ci < 4 ? 0 : CTX), thi = b * TPB + (ci < 4 ? CTX - 1 : TPB - 1);
    const int ch0 = hd * DH + lane * 8;
    LAS u16* QS = (LAS u16*)lds; LAS u16* KS = (LAS u16*)(lds + 66560);
    const float* cw = kp->in[I_MLCW] + (size_t)j * 3 * INNER; const float* cb = kp->in[I_MLCB] + (size_t)j * INNER;
    __syncthreads();
    {
        float cwa[8], cwb[8], cwc[8], cbb[8], wq[32], wk[32];
#pragma unroll
        for (int e4 = 0; e4 < 2; ++e4) { const f32x4 va = *(const f32x4*)(cw + ch0 + 4 * e4), vb = *(const f32x4*)(cw + INNER + ch0 + 4 * e4), vc = *(const f32x4*)(cw + 2 * INNER + ch0 + 4 * e4), vd = *(const f32x4*)(cb + ch0 + 4 * e4);
#pragma unroll
            for (int e = 0; e < 4; ++e) { cwa[4 * e4 + e] = va[e]; cwb[4 * e4 + e] = vb[e]; cwc[4 * e4 + e] = vc[e]; cbb[4 * e4 + e] = vd[e]; } }
        ldw32(kp->in[I_MLWQ] + ((size_t)j * 512 + (ch0 >> 2)) * 16, wq); ldw32(kp->in[I_MLWK] + ((size_t)j * 512 + (ch0 >> 2)) * 16, wk);
        for (int r = 0; r < 8; ++r) { const int jj = wv + 8 * r, T = T0 + jj; const u16* p = xm + (size_t)T * INNER + ch0;
            float x0[8], xa[8], xb[8], xcv[8], q[8], k[8];
            unpack8(*(const u32x4v*)p, x0);
            if (T > tlo) unpack8(*(const u32x4v*)(p - INNER), xa); else {
#pragma unroll
                for (int e = 0; e < 8; ++e) xa[e] = 0.f; }
            if (T < thi) unpack8(*(const u32x4v*)(p + INNER), xb); else {
#pragma unroll
                for (int e = 0; e < 8; ++e) xb[e] = 0.f; }
#pragma unroll
            for (int e = 0; e < 8; ++e) xcv[e] = siluf(cwa[e] * xa[e] + cwb[e] * x0[e] + cwc[e] * xb[e] + cbb[e]);
            const u32x4v xw = pack8(xcv); *(u32x4v*)(xc + (size_t)T * INNER + ch0) = xw; unpack8(xw, xcv);
            bd8(xcv, wq, q); bd8(xcv, wk, k);
            *(LAS u32x4v*)(QS + jj * 520 + lane * 8) = pack8(q); *(LAS u32x4v*)(KS + jj * 520 + lane * 8) = pack8(k); }
    }
    __syncthreads();
    const u16* wg = (const u16*)(kp->ws + OFF_WB + WB_WGT);
    const int mt = wv & 3, kh = wv >> 2;
    { f32x4 s0 = {0.f, 0.f, 0.f, 0.f}, s1 = {0.f, 0.f, 0.f, 0.f}; const int nt0 = kh * 2;
      for (int ks = 0; ks < 16; ++ks) { const bf16x8 a = *(const LAS bf16x8*)(QS + (16 * mt + fr) * 520 + 32 * ks + 8 * fq);
          const bf16x8 b0 = *(const LAS bf16x8*)(KS + (16 * nt0 + fr) * 520 + 32 * ks + 8 * fq), b1 = *(const LAS bf16x8*)(KS + (16 * (nt0 + 1) + fr) * 520 + 32 * ks + 8 * fq);
          s0 = __builtin_amdgcn_mfma_f32_16x16x32_bf16(a, b0, s0, 0, 0, 0); s1 = __builtin_amdgcn_mfma_f32_16x16x32_bf16(a, b1, s1, 0, 0, 0); }
      float* S = (float*)(kp->ws + OFF_S) + ((size_t)(b * 4 + hd) * NCH + ci) * 4096;
#pragma unroll
      for (int r = 0; r < 4; ++r) { S[(16 * mt + 4 * fq + r) * 64 + 16 * nt0 + fr] = s0[r]; S[(16 * mt + 4 * fq + r) * 64 + 16 * (nt0 + 1) + fr] = s1[r]; } }
    f32x4 ga = {0.f, 0.f, 0.f, 0.f};
    for (int ks = kh * 8; ks < kh * 8 + 8; ++ks) { const int kk = hd * DH + 32 * ks + 8 * fq;
        const bf16x8 a = *(const LAS bf16x8*)(QS + (16 * mt + fr) * 520 + 32 * ks + 8 * fq), a2 = *(const LAS bf16x8*)(KS + (16 * mt + fr) * 520 + 32 * ks + 8 * fq);
        const bf16x8 bq = *(const bf16x8*)(wg + (size_t)fr * 6144 + kk), bk = *(const bf16x8*)(wg + (size_t)fr * 6144 + INNER + kk);
        ga = __builtin_amdgcn_mfma_f32_16x16x32_bf16(a, bq, ga, 0, 0, 0); ga = __builtin_amdgcn_mfma_f32_16x16x32_bf16(a2, bk, ga, 0, 0, 0); }
    __syncthreads();
    {
        float wvv[32]; ldw32(kp->in[I_MLWV] + ((size_t)j * 512 + (ch0 >> 2)) * 16, wvv);
        for (int r = 0; r < 8; ++r) { const int jj = wv + 8 * r, T = T0 + jj; float x0[8], v[8]; unpack8(*(const u32x4v*)(xm + (size_t)T * INNER + ch0), x0); bd8(x0, wvv, v);
            *(LAS u32x4v*)(QS + jj * 520 + lane * 8) = pack8(v); }
    }
    __syncthreads();
    for (int ks = kh * 8; ks < kh * 8 + 8; ++ks) { const int kk = hd * DH + 32 * ks + 8 * fq;
        const bf16x8 a = *(const LAS bf16x8*)(QS + (16 * mt + fr) * 520 + 32 * ks + 8 * fq); const bf16x8 bv = *(const bf16x8*)(wg + (size_t)fr * 6144 + 2 * INNER + kk);
        ga = __builtin_amdgcn_mfma_f32_16x16x32_bf16(a, bv, ga, 0, 0, 0); }
    float* gates = (float*)(kp->ws + OFF_GATES);
#pragma unroll
    for (int r = 0; r < 4; ++r) atomicAdd(gates + (size_t)(T0 + 16 * mt + 4 * fq + r) * 16 + fr, ga[r]);
}

__device__ __forceinline__ void tr_store8(LAS unsigned char* base, int d0, const unsigned (&w)[4], int lane) {
    const int odd = lane & 1, sp = lane & ~1;
#pragma unroll
    for (int i = 0; i < 4; ++i) { const unsigned pw = (unsigned)__builtin_amdgcn_update_dpp(0, (int)w[i], 0xB1, 0xF, 0xF, false);
        const unsigned ow = odd ? ((pw >> 16) | (w[i] & 0xffff0000u)) : ((w[i] & 0xffffu) | (pw << 16)); const int d = d0 + 2 * i + odd;
        *(LAS unsigned*)(base + d * 128 + ((((sp >> 3) ^ (d & 7)) << 4) | ((sp & 7) << 1))) = ow; }
}
__device__ __forceinline__ float wscan_add(float v) {
    v += DPPF(0.f, v, 0x111, 0xF); v += DPPF(0.f, v, 0x112, 0xF); v += DPPF(0.f, v, 0x114, 0xF); v += DPPF(0.f, v, 0x118, 0xF);
    v += DPPF(0.f, v, 0x142, 0xA); v += DPPF(0.f, v, 0x143, 0xC); return v; }
__device__ __forceinline__ float wscan_max(float v) { const float ni = -3.0e38f;
    v = fmaxf(v, DPPF(ni, v, 0x111, 0xF)); v = fmaxf(v, DPPF(ni, v, 0x112, 0xF)); v = fmaxf(v, DPPF(ni, v, 0x114, 0xF)); v = fmaxf(v, DPPF(ni, v, 0x118, 0xF));
    v = fmaxf(v, DPPF(ni, v, 0x142, 0xA)); v = fmaxf(v, DPPF(ni, v, 0x143, 0xC)); return v; }
__device__ __forceinline__ float sum8(float v) { v += DPPF(0.f, v, 0xB1, 0xF); v += DPPF(0.f, v, 0x4E, 0xF); v += DPPF(0.f, v, 0x141, 0xF); return v; }
__device__ __forceinline__ float lane63(float v) { return __int_as_float(__builtin_amdgcn_readlane(__float_as_int(v), 63)); }
#ifndef REP_STAGE
#define REP_STAGE 1
#define REP_STILDE 1
#define REP_MFMA 1
#endif
constexpr int SC_QS = 0, SC_KT = 66560, SC_VT = 132096, SC_ST = 140288, SC_XB = 148480, SC_VEC = 156672;
__device__ __forceinline__ void ml_scan_task(KPC kp, int j, int task, LAS unsigned char* lds) {
    const int tid = ltid(), lane = tid & 63, wv = tid >> 6, fr = lane & 15, fq = lane >> 4;
    const int es = task & 7, dir = (task >> 3) & 1, hd = (task >> 4) & 3, b = task >> 6;
    const u16* xm = (const u16*)(kp->ws + OFF_XM); const u16* xc = (const u16*)(kp->ws + OFF_XC); const float* gates = (const float*)(kp->ws + OFF_GATES);
    const float* Sg = (const float*)(kp->ws + OFF_S) + (size_t)(b * 4 + hd) * NCH * 4096;
    u16* hf = (u16*)(kp->ws + OFF_R2);
    LAS unsigned char* QS = lds + SC_QS; LAS unsigned char* KT = lds + SC_KT; LAS unsigned char* VT = lds + SC_VT; LAS unsigned char* ST = lds + SC_ST; LAS unsigned char* XB = lds + SC_XB;
    LAS float* rowterm = (LAS float*)(lds + SC_VEC); LAS float* colterm = rowterm + 64; LAS float* winter = rowterm + 128; LAS float* einv = rowterm + 192;
    LAS float* kws = rowterm + 256; LAS float* dinv = rowterm + 320; LAS float* nst = rowterm + 384; LAS float* scal = rowterm + 896;
    f32x4 C[16];
#pragma unroll
    for (int i = 0; i < 16; ++i) C[i] = (f32x4){0.f, 0.f, 0.f, 0.f};
    float m_st = 0.f;
    __syncthreads();
    nst[tid] = 0.f;
    float pg_ic = 0.f, pg_fp = 0.f;
    if (wv == 0) { const int tn = dir == 0 ? lane : CTX - 1 - lane; const int Tg = b * TPB + tn; pg_ic = gates[(size_t)Tg * 16 + dir * 8 + hd]; pg_fp = gates[(size_t)Tg * 16 + dir * 8 + 4 + hd]; }
    u32x4v pxc[8], pxv;
    { const int tn = dir == 0 ? lane : CTX - 1 - lane; const size_t Tn = (size_t)(b * TPB + tn) * INNER; const int w0 = __builtin_amdgcn_readfirstlane(wv);
#pragma unroll
      for (int r = 0; r < 8; ++r) pxc[r] = *(const u32x4v*)(xc + Tn + hd * DH + (w0 * 8 + r) * 8);
      pxv = *(const u32x4v*)(xm + Tn + hd * DH + es * 64 + w0 * 8); }
    for (int ci = 0; ci < NCH; ++ci) {
        __syncthreads();
        const int p0 = ci * 64;
        const int tid = ltid(), lane = tid & 63, wv = tid >> 6, fr = lane & 15, fq = lane >> 4;
        asm volatile("" ::: "memory");
        auto tok = [&](int jj) -> int { const int p = p0 + jj; const int t = dir == 0 ? p : (p < CTX ? CTX - 1 - p : TPB + CTX - 1 - p); return b * TPB + t; };
        float sv[8];
        { const int jj = tid >> 3, s8 = (tid & 7) * 8;
            if (dir == 0) { const float* sp = Sg + (size_t)ci * 4096 + jj * 64 + s8; const f32x4 v0 = *(const f32x4*)sp, v1 = *(const f32x4*)(sp + 4);
                sv[0] = v0[0]; sv[1] = v0[1]; sv[2] = v0[2]; sv[3] = v0[3]; sv[4] = v1[0]; sv[5] = v1[1]; sv[6] = v1[2]; sv[7] = v1[3]; }
            else { const int oc = ci < 4 ? 3 - ci : 135 - ci; const float* sp = Sg + (size_t)oc * 4096 + (63 - jj) * 64 + (56 - s8); const f32x4 v0 = *(const f32x4*)sp, v1 = *(const f32x4*)(sp + 4);
                sv[7] = v0[0]; sv[6] = v0[1]; sv[5] = v0[2]; sv[4] = v0[3]; sv[3] = v1[0]; sv[2] = v1[1]; sv[1] = v1[2]; sv[0] = v1[3]; }
        }
        const float g_ic = pg_ic, g_fp = pg_fp;
        if (wv == 0 && ci + 1 < NCH) { const int pn = p0 + 64 + lane; const int tn = dir == 0 ? pn : (pn < CTX ? CTX - 1 - pn : TPB + CTX - 1 - pn); const int Tg = b * TPB + tn;
            pg_ic = gates[(size_t)Tg * 16 + dir * 8 + hd]; pg_fp = gates[(size_t)Tg * 16 + dir * 8 + 4 + hd]; }
        for (int rpS = 0; rpS < REP_STAGE; ++rpS) {
        const int wvu = __builtin_amdgcn_readfirstlane(wv); const int Tl = tok(lane);
#pragma unroll
        for (int r = 0; r < 8; ++r) { const int g8 = wvu * 8 + r; float x[8], q[8], Mw[32];
            const u32x4v xw = pxc[r]; unpack8(xw, x);
            sload32((const float*)(kp->ws + OFF_MLM) + (size_t)j * 8192 + (size_t)(hd * 128 + g8 * 2) * 16, Mw); bd8(x, Mw, q);
            *(LAS u32x4v*)(QS + lane * 1040 + g8 * 16) = pack8(q);
            const unsigned wd[4] = {xw.x, xw.y, xw.z, xw.w}; tr_store8(KT, g8 * 8, wd, lane); }
        { const int g = wvu; const int chv = hd * DH + es * 64 + g * 8; float x[8], v[8], wvv[32];
            unpack8(pxv, x); sload32(kp->in[I_MLWV] + ((size_t)j * 512 + (chv >> 2)) * 16, wvv); bd8(x, wvv, v);
            { const u32x4v vw = pack8(v); const unsigned wd[4] = {vw.x, vw.y, vw.z, vw.w}; tr_store8(VT, g * 8, wd, lane); } }
        }
        if (wv == 0) {
            const float ic = g_ic, fp = g_fp;
            const float lf = fminf(fp, 0.f) - log1pf(__expf(-fabsf(fp)));
            const float bb = wscan_add(lf);
            const float uu = ic - bb; const float pm = wscan_max(uu);
            const float a = bb + m_st, mj = fmaxf(a, bb + pm);
            rowterm[lane] = bb - mj; colterm[lane] = uu; winter[lane] = __expf(a - mj); einv[lane] = __expf(-mj);
            const float blast = lane63(bb), gs = blast - bb + ic, gmax = lane63(wscan_max(gs)), mnew = fmaxf(blast + m_st, gmax);
            kws[lane] = __expf(gs - mnew);
            if (lane == 0) { scal[0] = __expf(blast + m_st - mnew); scal[1] = mnew; }
        }
        __syncthreads();
        for (int rpT = 0; rpT < REP_STILDE; ++rpT) {
            const int jj = tid >> 3, sub = tid & 7, s8 = sub * 8;
            const float rt = rowterm[jj]; float rsum = 0.f;
            const f32x4 ct0 = *(const LAS f32x4*)(colterm + s8), ct1 = *(const LAS f32x4*)(colterm + s8 + 4); const float ctv[8] = {ct0[0], ct0[1], ct0[2], ct0[3], ct1[0], ct1[1], ct1[2], ct1[3]};
#pragma unroll
            for (int e = 0; e < 8; ++e) { const int s = s8 + e; const float w = s <= jj ? sv[e] * 0.04419417382415922f * __expf(rt + ctv[e]) : 0.f; sv[e] = w; rsum += w; }
            *(LAS u32x4v*)(ST + jj * 128 + ((sub ^ (jj & 7)) << 4)) = pack8(sv);
            float qd = 0.f;
#pragma unroll
            for (int c8 = 0; c8 < 8; ++c8) { float qv[8]; unpack8(*(const LAS u32x4v*)(QS + jj * 1040 + (sub * 8 + c8) * 16), qv);
                { const f32x4 n0 = *(const LAS f32x4*)(nst + sub * 64 + c8 * 8), n1 = *(const LAS f32x4*)(nst + sub * 64 + c8 * 8 + 4);
                  qd += qv[0] * n0[0] + qv[1] * n0[1] + qv[2] * n0[2] + qv[3] * n0[3] + qv[4] * n1[0] + qv[5] * n1[1] + qv[6] * n1[2] + qv[7] * n1[3]; } }
            rsum = sum8(rsum); qd = sum8(qd);
            if (sub == 0) { const float qn = winter[jj] * qd + rsum; dinv[jj] = __builtin_amdgcn_rcpf(fmaxf(fabsf(qn), einv[jj])); }
        }
        __syncthreads();
        if (ci + 1 < NCH) { const int pn = p0 + 64 + lane; const int tn = dir == 0 ? pn : (pn < CTX ? CTX - 1 - pn : TPB + CTX - 1 - pn); const size_t Tn = (size_t)(b * TPB + tn) * INNER; const int w0 = __builtin_amdgcn_readfirstlane(wv);
#pragma unroll
            for (int r = 0; r < 8; ++r) pxc[r] = *(const u32x4v*)(xc + Tn + hd * DH + (w0 * 8 + r) * 8);
            pxv = *(const u32x4v*)(xm + Tn + hd * DH + es * 64 + w0 * 8); }
        {
            f32x4 o[4];
            const int et = wv & 3, dh = wv >> 2, el = 16 * et + fr;
            bf16x8 vfr[2];
#pragma unroll
            for (int mt = 0; mt < 4; ++mt) o[mt] = (f32x4){0.f, 0.f, 0.f, 0.f};
#pragma unroll
            for (int ks = 0; ks < 8; ++ks) {
                u32x4v bw; bw.x = pg8::cvt_pk_bf16(C[2 * ks][0], C[2 * ks][1]); bw.y = pg8::cvt_pk_bf16(C[2 * ks][2], C[2 * ks][3]);
                bw.z = pg8::cvt_pk_bf16(C[2 * ks + 1][0], C[2 * ks + 1][1]); bw.w = pg8::cvt_pk_bf16(C[2 * ks + 1][2], C[2 * ks + 1][3]);
                const bf16x8 bfr = __builtin_bit_cast(bf16x8, bw);
#pragma unroll
                for (int mt = 0; mt < 4; ++mt) { const int off = (16 * mt + fr) * 1040 + 8 * fq + dh * 512;
                    const u32x2 lo = *(const LAS u32x2*)(QS + off + 64 * ks), hi = *(const LAS u32x2*)(QS + off + 64 * ks + 32);
                    u32x4v aw; aw.x = lo.x; aw.y = lo.y; aw.z = hi.x; aw.w = hi.y;
                    o[mt] = __builtin_amdgcn_mfma_f32_16x16x32_bf16(bfr, __builtin_bit_cast(bf16x8, aw), o[mt], 0, 0, 0); }
                if ((ks & 1) == 1) __builtin_amdgcn_sched_barrier(0); }
#pragma unroll
            for (int mt = 0; mt < 4; ++mt)
#pragma unroll
                for (int r = 0; r < 4; ++r) o[mt][r] *= winter[16 * mt + fr];
#pragma unroll
            for (int k2 = 0; k2 < 2; ++k2) vfr[k2] = *(const LAS bf16x8*)(VT + el * 128 + (((4 * k2 + fq) ^ (el & 7)) << 4));
            if (dh == 1) {
#pragma unroll
                for (int mt = 0; mt < 4; ++mt) { u32x2 w; w.x = pg8::cvt_pk_bf16(o[mt][0], o[mt][1]); w.y = pg8::cvt_pk_bf16(o[mt][2], o[mt][3]); *(LAS u32x2*)(XB + ((et * 4 + mt) * 64 + lane) * 8) = w; }
            } else {
#pragma unroll
                for (int k2 = 0; k2 < 2; ++k2)
#pragma unroll
                    for (int mt = 0; mt < 4; ++mt) { const int jr = 16 * mt + fr; const bf16x8 a = *(const LAS bf16x8*)(ST + jr * 128 + (((4 * k2 + fq) ^ (jr & 7)) << 4));
                        o[mt] = __builtin_amdgcn_mfma_f32_16x16x32_bf16(vfr[k2], a, o[mt], 0, 0, 0); }
            }
            __syncthreads();
            if (dh == 0) {
#pragma unroll
                for (int mt = 0; mt < 4; ++mt) { const u32x2 pw = *(const LAS u32x2*)(XB + ((et * 4 + mt) * 64 + lane) * 8);
                    const int jr = 16 * mt + fr, T = tok(jr); const float di = dinv[jr];
                    const float o0 = (o[mt][0] + bflo(pw.x)) * di, o1 = (o[mt][1] + bfhi(pw.x)) * di, o2 = (o[mt][2] + bflo(pw.y)) * di, o3 = (o[mt][3] + bfhi(pw.y)) * di;
                    u16* dst = dir == 0 ? hf + (size_t)T * INNER : hb_ptr(kp, T); u32x2 w; w.x = pg8::cvt_pk_bf16(o0, o1); w.y = pg8::cvt_pk_bf16(o2, o3);
                    *(u32x2*)(dst + hd * DH + es * 64 + 16 * et + 4 * fq) = w; }
            }
            const float decay = scal[0];
#pragma unroll
            for (int i = 0; i < 16; ++i) C[i] = C[i] * decay;
            float kwv[2][8];
#pragma unroll
            for (int k2 = 0; k2 < 2; ++k2) { const f32x4 k0 = *(const LAS f32x4*)(kws + 32 * k2 + 8 * fq), k1 = *(const LAS f32x4*)(kws + 32 * k2 + 8 * fq + 4);
                kwv[k2][0] = k0[0]; kwv[k2][1] = k0[1]; kwv[k2][2] = k0[2]; kwv[k2][3] = k0[3]; kwv[k2][4] = k1[0]; kwv[k2][5] = k1[1]; kwv[k2][6] = k1[2]; kwv[k2][7] = k1[3]; }
#pragma unroll
            for (int k2 = 0; k2 < 2; ++k2) { float vv[8]; unpack8(__builtin_bit_cast(u32x4v, vfr[k2]), vv);
#pragma unroll
                for (int e = 0; e < 8; ++e) vv[e] *= kwv[k2][e];
                const bf16x8 bsc = __builtin_bit_cast(bf16x8, pack8(vv));
#pragma unroll
                for (int dt = 0; dt < 16; ++dt) { const int dr = 256 * (wv >> 2) + 16 * dt + fr; const bf16x8 a = *(const LAS bf16x8*)(KT + dr * 128 + (((4 * k2 + fq) ^ (dr & 7)) << 4));
                    C[dt] = __builtin_amdgcn_mfma_f32_16x16x32_bf16(a, bsc, C[dt], 0, 0, 0);
                    if ((dt & 7) == 7) __builtin_amdgcn_sched_barrier(0); } }
            { float nn = decay * nst[tid];
#pragma unroll
              for (int g = 0; g < 8; ++g) { float kv[8]; unpack8(*(const LAS u32x4v*)(KT + tid * 128 + ((g ^ (tid & 7)) << 4)), kv);
                  { const f32x4 k0 = *(const LAS f32x4*)(kws + 8 * g), k1 = *(const LAS f32x4*)(kws + 8 * g + 4); nn += kv[0] * k0[0] + kv[1] * k0[1] + kv[2] * k0[2] + kv[3] * k0[3] + kv[4] * k1[0] + kv[5] * k1[1] + kv[6] * k1[2] + kv[7] * k1[3]; } }
              nst[tid] = nn; }
            m_st = scal[1];
        }
    }
}

__device__ __forceinline__ void ml_gate_phase(KPC kp, int j) {
    u16* hf = (u16*)(kp->ws + OFF_R2); const u16* xc = (const u16*)(kp->ws + OFF_XC); const u16* z = (const u16*)(kp->ws + OFF_XM);
    const float* ng = kp->in[I_MLNG] + (size_t)j * INNER; const float* sk = kp->in[I_MLSKIP] + (size_t)j * INNER;
    const int lane = ltid() & 63, wv = ltid() >> 6;
    for (int T = lbid() * 8 + wv; T < NTOK; T += gridDim.x * 8) {
        const u16* hbp = hb_ptr(kp, T);
#pragma unroll
        for (int hd = 0; hd < 4; ++hd) { const int c0 = hd * DH + lane * 8; float a[8], bq[8], xv[8], zv[8], o[8];
            unpack8(*(const u32x4v*)(hf + (size_t)T * INNER + c0), a); unpack8(*(const u32x4v*)(hbp + c0), bq);
            float s = 0.f;
#pragma unroll
            for (int e = 0; e < 8; ++e) { a[e] += bq[e]; s += a[e]; }
            const float mu = wave_sum(s) * (1.0f / DH); float vs = 0.f;
#pragma unroll
            for (int e = 0; e < 8; ++e) { a[e] -= mu; vs += a[e] * a[e]; }
            const float rs = rsqrtf(wave_sum(vs) * (1.0f / DH) + 1e-5f);
            unpack8(*(const u32x4v*)(xc + (size_t)T * INNER + c0), xv); unpack8(*(const u32x4v*)(z + (size_t)T * INNER + c0), zv);
            const f32x4 n0 = *(const f32x4*)(ng + c0), n1 = *(const f32x4*)(ng + c0 + 4), s0 = *(const f32x4*)(sk + c0), s1 = *(const f32x4*)(sk + c0 + 4);
            const float ngv[8] = {n0[0], n0[1], n0[2], n0[3], n1[0], n1[1], n1[2], n1[3]}, skv[8] = {s0[0], s0[1], s0[2], s0[3], s1[0], s1[1], s1[2], s1[3]};
#pragma unroll
            for (int e = 0; e < 8; ++e) o[e] = (a[e] * rs * ngv[e] + skv[e] * xv[e]) * siluf(zv[e]);
            *(u32x4v*)(hf + (size_t)T * INNER + c0) = pack8(o); }
    }
}


enum { K_SETUP = 0, K_CN, K_G1, K_G2R, K_HYIN, K_HYCONV, K_HYTR, K_MLUPX, K_MLPREP, K_MLSCAN, K_MLUPZ, K_MLGATE, K_FINAL };
constexpr int NPHASE = 1 + 11 + 13 + 11 + 13 + 1;
__device__ __forceinline__ void decode_phase(int ph, int& kind, int& l, int& arg) {
    kind = K_SETUP; l = 0; arg = 0; if (ph == 0) return;
    ph -= 1;
    for (l = 0; l < 4; ++l) { const int n = (l & 1) ? 13 : 11; if (ph < n) break; ph -= n; }
    if (l == 4) { kind = K_FINAL; l = 0; return; }
    if (ph == 0) { kind = K_CN; arg = 0; return; } if (ph == 1) { kind = K_G1; arg = 0; return; } if (ph == 2) { kind = K_G2R; arg = 0; return; } if (ph == 3) { kind = K_CN; arg = 1; return; }
    const int nm = (l & 1) ? 6 : 4;
    if (ph < 4 + nm) { const int q = ph - 4;
        if (l & 1) { kind = q == 0 ? K_MLUPX : q == 1 ? K_MLPREP : q == 2 ? K_MLSCAN : q == 3 ? K_MLUPZ : q == 4 ? K_MLGATE : K_G2R; arg = 2; }
        else { kind = q == 0 ? K_HYIN : q == 1 ? K_HYCONV : q == 2 ? K_HYTR : K_G2R; arg = 2; }
        return; }
    ph -= 4 + nm;
    if (ph == 0) { kind = K_CN; arg = 2; return; } if (ph == 1) { kind = K_G1; arg = 1; return; } kind = K_G2R; arg = 1;
}

__device__ __forceinline__ void gbar(unsigned* ctr, unsigned target) {
    __syncthreads();
    if (ltid() == 0) {
        __builtin_amdgcn_fence(__ATOMIC_RELEASE, "agent");
        __hip_atomic_fetch_add(ctr, 1u, __ATOMIC_RELAXED, __HIP_MEMORY_SCOPE_AGENT);
        while (__hip_atomic_load(ctr, __ATOMIC_RELAXED, __HIP_MEMORY_SCOPE_AGENT) < target) __builtin_amdgcn_s_sleep(2);
        __builtin_amdgcn_fence(__ATOMIC_ACQUIRE, "agent");
    }
    __syncthreads();
}
#ifndef REPMASK
#define REPMASK 0
#define REPN 1
#endif
template <int MIX> __device__ __forceinline__ void run_phases(int lo, int hi, int ph_lo, int ph_hi, LAS unsigned char* lds0, cg::grid_group& grid) {
    lo = lo > ph_lo ? lo : ph_lo; hi = hi < ph_hi ? hi : ph_hi;
    for (int ph = lo; ph < hi; ++ph) {
        KPC kp = (KPC)__builtin_amdgcn_kernarg_segment_ptr(); asm volatile("" : "+s"(kp) :: "memory");
        LAS unsigned char* lds = lds0; asm volatile("" : "+s"(lds) :: "memory");
        unsigned char* ws = kp->ws; unsigned char* wb = ws + OFF_WB;
        int kind, l, arg; decode_phase(ph, kind, l, arg); const int j = l >> 1;
        const float* modl = (const float*)(ws + OFF_MOD) + (size_t)l * 5 * 9216;
        const int nrep = ((REPMASK >> kind) & 1) ? REPN : 1;
        for (int rep = 0; rep < nrep; ++rep) {
        if (kind == K_SETUP) { if constexpr (MIX == 0) setup_phase(kp, (LAS float*)lds); }
        else if (kind == K_CN) {
            if (arg == 0) { convert_layer(kp, l, (LAS float*)lds); if constexpr (MIX == 1) ml_m_phase(kp, j); }
            if constexpr (MIX == 0) { if (arg == 1) hy_mlp_phase(kp, j); }
            norm_phase(kp, l, arg, arg == 0 ? (l == 0 ? 0 : 11) : arg == 1 ? 11 : (l == 3 ? 0 : (l & 1) ? 8 : 4));
        } else if (kind == K_G1) {
            pg8::Gemm g{(const u16*)(ws + OFF_U), (const u16*)(wb + (arg ? WB_FIN1 : WB_FIN0)), NTOK, 2 * FF, D};
            pg8::StaticOrder S; S.init(g.M, g.N, (int)gridDim.x, lbid(), (l == 3 && arg == 1) ? 1 : 0); EpiSwiglu E{(u16*)(ws + OFF_R1)};
            pg8::gemm_phase<EpiSwiglu, pg8::StaticOrder, false>(lds, g, S, E, nullptr);
        } else if (kind == K_G2R) {
            const u16* gA; const u16* gB; int gK, gidx, gbj = -1;
            if (arg < 2) { gA = (const u16*)(ws + OFF_R1); gB = (const u16*)(wb + (arg ? WB_FOUT1 : WB_FOUT0)); gK = FF; gidx = arg ? 8 : 2; }
            else if (MIX == 1) { gA = (const u16*)(ws + OFF_R2); gB = (const u16*)(wb + WB_MOUT); gK = INNER; gidx = 5; }
            else { gA = (const u16*)(ws + OFF_U); gB = (const u16*)(wb + WB_MOUT); gK = D; gidx = 5; gbj = j; }
            const pg8::Gemm g{gA, gB, NTOK, D, gK, 0}; const EpiResid E{kp, l, gidx, gbj};
            pg8::StaticOrder S; S.init(g.M, g.N, (int)gridDim.x, lbid(), (l == 3 && arg >= 1) ? 1 : 2, g.K / 256);
            pg8::gemm_phase<EpiResid, pg8::StaticOrder, false>(lds, g, S, E, nullptr);
        } else if (kind == K_FINAL) { if constexpr (MIX == 1) final_phase(kp); }
        else if constexpr (MIX == 0) {
            if (kind == K_HYIN) {
                pg8::Gemm g{(const u16*)(wb + WB_MIN), (const u16*)(ws + OFF_U), 3 * D, NTOK, D};
                pg8::StaticOrder S; S.init(g.M, g.N, (int)gridDim.x, lbid());
                EpiProjT E{(u16*)(ws + OFF_R1 + HY_PL), (u16*)(ws + OFF_R1 + HY_PC), kp->in[I_HYBIN] + (size_t)j * 3 * D};
                pg8::gemm_phase<EpiProjT, pg8::StaticOrder, false>(lds, g, S, E, nullptr);
                __syncthreads();
                for (int t = lbid(); t < 2048; t += gridDim.x) hy_filter_task(kp, j, t, (LAS f32x2*)lds, (LAS float*)(lds + 131072));
            } else if (kind == K_HYCONV) {
                for (int t = lbid(); t < 2048; t += gridDim.x) hy_conv_lat(kp, j, t, (LAS f32x2*)lds);
                for (int t = lbid(); t < 1024; t += gridDim.x) hy_conv_ctx(kp, j, t, (LAS float*)lds);
            } else if (kind == K_HYTR) hy_transpose(kp, (LAS u16*)lds);
        } else {
            if (kind == K_MLUPX || kind == K_MLUPZ) {
                const bool zz = kind == K_MLUPZ;
                pg8::Gemm g{(const u16*)(ws + OFF_U), (const u16*)(wb + WB_MIN) + (zz ? (size_t)INNER * D : 0), NTOK, INNER, D};
                pg8::StaticOrder S; S.init(g.M, g.N, (int)gridDim.x, lbid(), (zz && l == 3) ? 1 : 0); EpiBf E{(u16*)(ws + OFF_XM), INNER};
                pg8::gemm_phase<EpiBf, pg8::StaticOrder, false>(lds, g, S, E, nullptr);
            } else if (kind == K_MLPREP) { for (int t = lbid(); t < NB * NCH * 4; t += gridDim.x) ml_prep_task(kp, j, t, lds); }
            else if (kind == K_MLSCAN) { for (int t = lbid(); t < 256; t += gridDim.x) ml_scan_task(kp, j, t, lds); }
            else if (kind == K_MLGATE) ml_gate_phase(kp, j);
        }
        }
        if (ph + 1 < ph_hi) gbar((unsigned*)(kp->ws + OFF_MLM + 65536), (unsigned)(ph + 1 - ph_lo) * gridDim.x);
    }
}

__global__ void __launch_bounds__(512) fwd_megakernel(KP kparg) {
    extern __shared__ __attribute__((aligned(16))) unsigned char shm[];
    LAS unsigned char* lds = (LAS unsigned char*)shm;
    cg::grid_group grid = cg::this_grid();
    grid.sync();
    wtab_init();
    const int ph_lo = kparg.ph_lo, ph_hi = kparg.ph_hi;
    run_phases<0>(0, 12, ph_lo, ph_hi, lds, grid);
    run_phases<1>(12, 25, ph_lo, ph_hi, lds, grid);
    run_phases<0>(25, 36, ph_lo, ph_hi, lds, grid);
    run_phases<1>(36, 50, ph_lo, ph_hi, lds, grid);
}

extern "C" void kernel_launch(void* const* d_in, const int* in_sizes, int n_in, void* d_out, int out_size, void* d_ws, size_t ws_size, hipStream_t stream) {
    static int grid_blocks = 0;
    if (!grid_blocks) {
        int dev = 0, cus = 0, per_cu = 0;
        hipGetDevice(&dev);
        hipDeviceGetAttribute(&cus, hipDeviceAttributeMultiprocessorCount, dev);
        hipFuncSetAttribute((const void*)fwd_megakernel, hipFuncAttributeMaxDynamicSharedMemorySize, LDS_BYTES);
        hipOccupancyMaxActiveBlocksPerMultiprocessor(&per_cu, fwd_megakernel, 512, LDS_BYTES);
        if (per_cu < 1) per_cu = 1;
        grid_blocks = cus * 1;
        if (ws_size < WS_NEED2) fprintf(stderr, "workspace too small: %zu < %zu\n", ws_size, (size_t)WS_NEED2);
    }
    KP hp{};
    for (int i = 0; i < 36; ++i) hp.in[i] = (const float*)d_in[i];
    hp.out = (float*)d_out; hp.ws = (unsigned char*)d_ws; hp.ph_lo = 0; hp.ph_hi = NPHASE;
    void* args[] = {&hp};
    hipMemsetAsync((unsigned char*)d_ws + OFF_MLM + 65536, 0, 256, stream);
    hipError_t e = hipLaunchCooperativeKernel((void*)fwd_megakernel, dim3(grid_blocks), dim3(512), args, LDS_BYTES, stream);
    if (e != hipSuccess) fprintf(stderr, "cooperative launch failed: %s (grid %d)\n", hipGetErrorString(e), grid_blocks);
}
```
